# Optimizing an MI355X kernel written in HIP

```python
import jax, jax.numpy as jnp
from jax import lax
import numpy as np

D_MODEL = 1024
BATCH = 4
SEQ = 8192
DEPTH = 4

N_MIXERS = 2
N_MLA_LAYERS = (DEPTH + 1) // 2
N_HGRN_LAYERS = DEPTH // 2
N_NORMS_PER_LAYER = 6
D_FF = 2816
MLA_HEADS = 8
QK_NOPE_DIM = 128
QK_ROPE_DIM = 64
V_HEAD_DIM = 128
Q_LORA_RANK = 256
KV_LORA_RANK = 128
ROPE_THETA = 10000.0
Q_BLOCK = 128
HGRN_HEADS = 8
HGRN_F_DIM = D_MODEL // HGRN_HEADS
HGRN_I_DIM = D_MODEL // HGRN_HEADS
CHUNK = 64
EPS = 1e-6
MAX_POS_OFFSET = 4096

kernel_name = "hybrid_mla_hgrn2_macaron_encoder"


def rmsnorm(x, gain):
    xf = x.astype(jnp.float32)
    y = xf * lax.rsqrt(jnp.mean(xf * xf, axis=-1, keepdims=True) + EPS)
    return (y * gain.astype(jnp.float32)).astype(x.dtype)


def swiglu(h, w_in, w_out):
    gate, up = jnp.split(h @ w_in, 2, axis=-1)
    return (jax.nn.silu(gate) * up) @ w_out


def rope_tables(positions, dtype):
    inv_freq = ROPE_THETA ** (-jnp.arange(0, QK_ROPE_DIM, 2, dtype=jnp.float32) / QK_ROPE_DIM)
    ang = positions.astype(jnp.float32)[..., None] * inv_freq
    return jnp.cos(ang).astype(dtype), jnp.sin(ang).astype(dtype)


def rope(t, cos, sin):
    t1, t2 = jnp.split(t, 2, axis=-1)
    return jnp.concatenate([t1 * cos - t2 * sin, t1 * sin + t2 * cos], axis=-1)


def mla(h, positions, w_in, q_norm, kv_norm, w_uq, w_ukv, w_o):
    B, S, _ = h.shape
    c_q, c_kv, k_r = jnp.split(h @ w_in, [Q_LORA_RANK, Q_LORA_RANK + KV_LORA_RANK], axis=-1)
    c_q = rmsnorm(c_q, q_norm)
    c_kv = rmsnorm(c_kv, kv_norm)
    q = (c_q @ w_uq).reshape(B, S, MLA_HEADS, QK_NOPE_DIM + QK_ROPE_DIM)
    q_nope, q_rope = jnp.split(q, [QK_NOPE_DIM], axis=-1)
    kv = (c_kv @ w_ukv).reshape(B, S, MLA_HEADS, QK_NOPE_DIM + V_HEAD_DIM)
    k_nope, v = jnp.split(kv, [QK_NOPE_DIM], axis=-1)
    cos, sin = rope_tables(positions, h.dtype)
    q_rope = rope(q_rope, cos[:, :, None], sin[:, :, None])
    k_rope = rope(k_r, cos, sin)
    scale = (QK_NOPE_DIM + QK_ROPE_DIM) ** -0.5
    nb = S // Q_BLOCK

    def to_blocks(t):
        return t.reshape(B, nb, Q_BLOCK, *t.shape[2:]).swapaxes(0, 1)

    def attend(blk):
        qn, qr = blk
        s = (jnp.einsum('bqhd,bkhd->bhqk', qn, k_nope)
             + jnp.einsum('bqhr,bkr->bhqk', qr, k_rope))
        p = jax.nn.softmax(s.astype(jnp.float32) * scale, axis=-1)
        return jnp.einsum('bhqk,bkhd->bqhd', p.astype(v.dtype), v)

    o = lax.map(attend, (to_blocks(q_nope), to_blocks(q_rope)))
    o = o.swapaxes(0, 1).reshape(B, S, MLA_HEADS * V_HEAD_DIM)
    return o @ w_o


def gated_chunk_scan(q, k, v, log_f):
    BB, S, H, DK = q.shape
    DV = v.shape[-1]
    n = S // CHUNK

    def to_chunks(t):
        return t.reshape(BB, n, CHUNK, H, t.shape[-1]).transpose(1, 0, 3, 2, 4)

    qc, kc, vc = to_chunks(q), to_chunks(k), to_chunks(v)
    bc = jnp.cumsum(to_chunks(log_f), axis=-2)
    lower = jnp.tril(jnp.ones((CHUNK, CHUNK), dtype=bool))[:, :, None]

    def step(state, inp):
        qt, kt, vt, bt = inp
        diff = jnp.where(lower, bt[:, :, :, None, :] - bt[:, :, None, :, :], -jnp.inf)
        scores = jnp.einsum('bhtd,bhsd,bhtsd->bhts', qt, kt, jnp.exp(diff))
        o = scores @ vt + jnp.einsum('bhtd,bhdv->bhtv', qt * jnp.exp(bt), state)
        b_last = bt[:, :, -1:, :]
        state = (jnp.exp(b_last[:, :, 0, :, None]) * state
                 + jnp.einsum('bhsd,bhsv->bhdv', kt * jnp.exp(b_last - bt), vt))
        return state, o

    state0 = jnp.zeros((BB, H, DK, DV), jnp.float32)
    _, o = lax.scan(step, state0, (qc, kc, vc, bc))
    return o.transpose(1, 0, 3, 2, 4).reshape(BB, S, H, DV)


def hgrn2(h, layer_idx, w_in, lower_bound, out_norm, w_o):
    B, S, _ = h.shape
    q, z_fw, z_bw, i, g = jnp.split(h @ w_in, 5, axis=-1)
    sm = jax.nn.softmax(lower_bound.astype(jnp.float32), axis=1)
    lb = (jnp.cumsum(sm, axis=1) - sm[:, :1])[:, layer_idx]
    lbb = lb[:, None, None, :]
    z = jnp.stack([z_fw, z_bw]).astype(jnp.float32)
    log_f = jnp.logaddexp(jnp.log(lbb), jnp.log1p(-lbb) + jax.nn.log_sigmoid(z))
    k = -jnp.expm1(log_f)
    q = jax.nn.silu(q).astype(jnp.float32)
    i = i.astype(jnp.float32)

    def heads(t):
        return t.reshape(*t.shape[:-1], HGRN_HEADS, t.shape[-1] // HGRN_HEADS)

    def flip(t):
        return t[:, ::-1]

    qq = jnp.concatenate([q, flip(q)], axis=0)
    ii = jnp.concatenate([i, flip(i)], axis=0)
    ff = jnp.concatenate([log_f[0], flip(log_f[1])], axis=0)
    kk = jnp.concatenate([k[0], flip(k[1])], axis=0)
    o = gated_chunk_scan(heads(qq), heads(kk), heads(ii), heads(ff))
    o = o[:B] + flip(o[B:])
    o = rmsnorm(o, out_norm.reshape(HGRN_HEADS, HGRN_I_DIM)) * heads(jax.nn.silu(g.astype(jnp.float32)))
    return o.reshape(B, S, D_MODEL).astype(h.dtype) @ w_o


def setup_inputs(seed: int = 0) -> dict:
    key = jax.random.key(seed)
    ks = jax.random.split(key, 15)

    def w(k, shape, fan_in):
        return jax.random.normal(k, shape, jnp.float32) * fan_in ** -0.5

    def gain(k, shape):
        return 1.0 + 0.05 * jax.random.normal(k, shape, jnp.float32)

    x = jax.random.normal(ks[0], (BATCH, SEQ, D_MODEL), jnp.float32)
    positions = (jnp.arange(SEQ, dtype=jnp.int32)[None, :]
                 + jax.random.randint(ks[1], (BATCH, 1), 0, MAX_POS_OFFSET, dtype=jnp.int32))
    norm_gains = gain(ks[2], (DEPTH, N_NORMS_PER_LAYER, D_MODEL))
    ffn_w_in = w(ks[3], (DEPTH, 2, D_MODEL, 2 * D_FF), D_MODEL)
    ffn_w_out = w(ks[4], (DEPTH, 2, D_FF, D_MODEL), D_FF)
    mla_w_in = w(ks[5], (N_MLA_LAYERS, D_MODEL, Q_LORA_RANK + KV_LORA_RANK + QK_ROPE_DIM), D_MODEL)
    mla_q_norm = gain(ks[6], (N_MLA_LAYERS, Q_LORA_RANK))
    mla_kv_norm = gain(ks[7], (N_MLA_LAYERS, KV_LORA_RANK))
    mla_w_uq = w(ks[8], (N_MLA_LAYERS, Q_LORA_RANK, MLA_HEADS * (QK_NOPE_DIM + QK_ROPE_DIM)), Q_LORA_RANK)
    mla_w_ukv = w(ks[9], (N_MLA_LAYERS, KV_LORA_RANK, MLA_HEADS * (QK_NOPE_DIM + V_HEAD_DIM)), KV_LORA_RANK)
    mla_w_o = w(ks[10], (N_MLA_LAYERS, MLA_HEADS * V_HEAD_DIM, D_MODEL), MLA_HEADS * V_HEAD_DIM)
    hgrn_w_in = w(ks[11], (N_HGRN_LAYERS, D_MODEL, 5 * D_MODEL), D_MODEL)
    hgrn_lower_bound = 0.1 * jax.random.normal(ks[12], (2, DEPTH, HGRN_HEADS * HGRN_F_DIM), jnp.float32)
    hgrn_out_norm = gain(ks[13], (N_HGRN_LAYERS, D_MODEL))
    hgrn_w_o = w(ks[14], (N_HGRN_LAYERS, D_MODEL, D_MODEL), D_MODEL)
    return {"x": x, "positions": positions, "norm_gains": norm_gains,
            "ffn_w_in": ffn_w_in, "ffn_w_out": ffn_w_out,
            "mla_w_in": mla_w_in, "mla_q_norm": mla_q_norm, "mla_kv_norm": mla_kv_norm,
            "mla_w_uq": mla_w_uq, "mla_w_ukv": mla_w_ukv, "mla_w_o": mla_w_o,
            "hgrn_w_in": hgrn_w_in, "hgrn_lower_bound": hgrn_lower_bound,
            "hgrn_out_norm": hgrn_out_norm, "hgrn_w_o": hgrn_w_o}


def reference(x, positions, norm_gains, ffn_w_in, ffn_w_out, mla_w_in, mla_q_norm, mla_kv_norm,
              mla_w_uq, mla_w_ukv, mla_w_o, hgrn_w_in, hgrn_lower_bound, hgrn_out_norm, hgrn_w_o):
    for l in range(DEPTH):
        g = norm_gains[l]
        x = x + 0.5 * rmsnorm(swiglu(rmsnorm(x, g[0]), ffn_w_in[l, 0], ffn_w_out[l, 0]), g[1])
        h = rmsnorm(x, g[2])
        j = l // N_MIXERS
        if l % N_MIXERS == 0:
            m = mla(h, positions, mla_w_in[j], mla_q_norm[j], mla_kv_norm[j],
                    mla_w_uq[j], mla_w_ukv[j], mla_w_o[j])
        else:
            m = hgrn2(h, l, hgrn_w_in[j], hgrn_lower_bound, hgrn_out_norm[j], hgrn_w_o[j])
        x = x + rmsnorm(m, g[3])
        x = x + 0.5 * rmsnorm(swiglu(rmsnorm(x, g[4]), ffn_w_in[l, 1], ffn_w_out[l, 1]), g[5])
    return x
```

```cpp
#include <hip/hip_runtime.h>
#include <hip/hip_cooperative_groups.h>
#include <hip/hip_bf16.h>
#include <hip/hip_fp16.h>
#include <cstdio>
#include <cstdint>
#include <cmath>
namespace cg = cooperative_groups;
namespace pg8 {
#define PG8_LAS __attribute__((address_space(3)))
typedef unsigned short bf16_t;
typedef short bf16x8 __attribute__((ext_vector_type(8)));
typedef float f32x4 __attribute__((ext_vector_type(4)));
typedef unsigned u32x4 __attribute__((ext_vector_type(4)));
constexpr int BM = 256, BK = 64, HALF = 128, HTB = HALF * BK * 2  , STAGE_BYTES = 8 * HTB, NXCD = 8, WGM = 8;

__host__ __device__ __forceinline__ int lds_byte(int r, int c) { const int st = (r >> 4) * 2 + (c >> 5), rr = r & 15, cc = c & 31, ob = rr * 64 + cc * 2; return st * 1024 + (ob ^ (((ob >> 9) & 1) << 5)); }
__host__ __device__ __forceinline__ void stage_rc(int b, int& R, int& C) { const int st = b / 1024, sb = b % 1024, swz = sb ^ (((sb >> 9) & 1) << 5); R = (st >> 1) * 16 + swz / 64; C = (st & 1) * 32 + (swz % 64) / 2; }
__host__ __device__ __forceinline__ int perm32(int rho) { const int n = rho >> 4, i = rho & 15; return 8 * (i >> 2) + 4 * n + (i & 3); }

struct Unit { int pm, pn; };
struct Gemm { const bf16_t* A; const bf16_t* Bt; int M, N, K; };

struct StaticOrder {
    int nM, nN, nwg, G, c;
    __host__ __device__ void init(int M, int N, int G_, int c_) { nM = M / BM; nN = N / BM; nwg = nM * nN; G = G_; c = c_; }
    __host__ __device__ bool next(int i, Unit& u) const {
        const long L = (long)i * G + c; if (L >= nwg) return false;
        int wgid = (int)L; { const int q = nwg / NXCD, r = nwg % NXCD, xcd = wgid % NXCD, off = wgid / NXCD; wgid = (xcd < r ? xcd * (q + 1) : r * (q + 1) + (xcd - r) * q) + off; }
        const int nig = WGM * nN, gid = wgid / nig, fm = gid * WGM, gsz = (nM - fm) < WGM ? (nM - fm) : WGM;
        u.pm = fm + ((wgid % nig) % gsz); u.pn = (wgid % nig) / gsz; return true;
    }
    __device__ __forceinline__ void a_ready(const Unit&) const {}
    __device__ __forceinline__ void done(const Unit&) const {}
};

__device__ __forceinline__ unsigned cvt_pk_bf16(float lo, float hi) { unsigned r; asm volatile("v_cvt_pk_bf16_f32 %0, %1, %2" : "=v"(r) : "v"(lo), "v"(hi)); return r; }
template <class Epi, class Sched, bool ALIGN_EPI = false, bool SP2 = false>
__device__ __forceinline__ void gemm_phase(PG8_LAS unsigned char* lds, const Gemm g, const Sched& S, const Epi& E) {
    int tid = threadIdx.x; asm volatile("" : "+v"(tid)); const int wid = __builtin_amdgcn_readfirstlane(tid >> 6), lane = tid & 63, wr = wid >> 2, wc = wid & 3, fr = lane & 15, fq = lane >> 4;
    const int K = g.K, nt = K / BK;
    unsigned voffA[2], voffB[2];
#pragma unroll
    for (int i = 0; i < 2; ++i) { int R, C; stage_rc(tid * 16 + i * 8192, R, C); const int Rb = Epi::PERM ? ((R & ~31) + perm32(R & 31)) : R;
        voffA[i] = (unsigned)(R * K + C) * 2u; voffB[i] = (unsigned)(Rb * K + C) * 2u; }
    const size_t kstep = (size_t)(BK * 2);
    const size_t hstep = (size_t)HALF * K * 2;
    const size_t tstep = 2 * hstep;
    const unsigned ldsw = (unsigned)wid * 1024u;
    const int aoff = lds_byte(wr * 64 + fr, fq * 8), boff = lds_byte(wc * 32 + fr, fq * 8);
#define PG8_SA(b, h) (((b) * 2 + (h)) * HTB)
#define PG8_SB(b, h) ((4 + (b) * 2 + (h)) * HTB)
#define PG8_STAGE(bufoff, gbase, voff) do { _Pragma("unroll") for (int _i = 0; _i < 2; ++_i) \
        __builtin_amdgcn_global_load_lds((const unsigned*)((const char*)(gbase) + (voff)[_i]), (PG8_LAS unsigned*)(lds + (bufoff) + ldsw + _i * 8192), 16, 0, 0); } while (0)
#define PG8_LDA(dst, b, h) do { _Pragma("unroll") for (int m = 0; m < 4; ++m) _Pragma("unroll") for (int k = 0; k < 2; ++k) dst[m][k] = *(const PG8_LAS bf16x8*)(lds + PG8_SA(b, h) + aoff + m * 2048 + k * 1024); } while (0)
#define PG8_LDB(dst, b, h) do { _Pragma("unroll") for (int n = 0; n < 2; ++n) _Pragma("unroll") for (int k = 0; k < 2; ++k) dst[n][k] = *(const PG8_LAS bf16x8*)(lds + PG8_SB(b, h) + boff + n * 2048 + k * 1024); } while (0)
#define PG8_MMA(ai, bj, At, Bt) do { __builtin_amdgcn_s_setprio(1); _Pragma("unroll") for (int m = 0; m < 4; ++m) _Pragma("unroll") for (int n = 0; n < 2; ++n) _Pragma("unroll") for (int k = 0; k < 2; ++k) \
        acc[ai][bj][m][n] = __builtin_amdgcn_mfma_f32_16x16x32_bf16(Bt[n][k], At[m][k], acc[ai][bj][m][n], 0, 0, 0); __builtin_amdgcn_s_setprio(0); } while (0)
#define PG8_WAIT_V(n) asm volatile("s_waitcnt vmcnt(" #n ")" ::: "memory")
#define PG8_WAIT_L(n) asm volatile("s_waitcnt lgkmcnt(" #n ")" ::: "memory")
#define PG8_BAR __builtin_amdgcn_s_barrier()
#define PG8_SCHED __builtin_amdgcn_sched_barrier(0)
    Unit cur, nxt; int ui = 0;
    if (!S.next(0, cur)) return;
    f32x4 acc[2][2][4][2];
#pragma unroll
    for (int a = 0; a < 2; ++a)
#pragma unroll
        for (int b = 0; b < 2; ++b)
#pragma unroll
            for (int m = 0; m < 4; ++m)
#pragma unroll
                for (int n = 0; n < 2; ++n) acc[a][b][m][n] = (f32x4){0.f, 0.f, 0.f, 0.f};
    bf16x8 At[4][2], B0[2][2], B1[2][2];
    const char* cA = (const char*)g.A + (size_t)cur.pm * tstep; const char* cB = (const char*)g.Bt + (size_t)cur.pn * tstep;
    S.a_ready(cur);
    if constexpr (SP2) {
        PG8_STAGE(PG8_SB(0, 0), cB, voffB); PG8_STAGE(PG8_SB(0, 1), cB + hstep, voffB); PG8_STAGE(PG8_SA(0, 0), cA, voffA); PG8_STAGE(PG8_SA(0, 1), cA + hstep, voffA);
        if (wr == 1) PG8_BAR;
        PG8_WAIT_V(2); PG8_BAR;
        PG8_STAGE(PG8_SB(1, 0), cB + kstep, voffB); PG8_STAGE(PG8_SA(1, 0), cA + kstep, voffA); PG8_STAGE(PG8_SB(1, 1), cB + hstep + kstep, voffB);
        PG8_WAIT_V(6); PG8_BAR;
    } else {
        PG8_STAGE(PG8_SB(0, 0), cB, voffB); PG8_STAGE(PG8_SA(0, 0), cA, voffA); PG8_STAGE(PG8_SB(0, 1), cB + hstep, voffB); PG8_STAGE(PG8_SA(0, 1), cA + hstep, voffA);
        if (wr == 1) PG8_BAR;
        PG8_WAIT_V(4); PG8_BAR;
        PG8_STAGE(PG8_SB(1, 0), cB + kstep, voffB); PG8_STAGE(PG8_SA(1, 0), cA + kstep, voffA); PG8_STAGE(PG8_SB(1, 1), cB + hstep + kstep, voffB);
        PG8_WAIT_V(6); PG8_BAR;
    }
    for (;;) {
        const bool has_next = S.next(ui + 1, nxt);
        const char* nA = has_next ? (const char*)g.A + (size_t)nxt.pm * tstep : cA; const char* nB = has_next ? (const char*)g.Bt + (size_t)nxt.pn * tstep : cB;
        for (int t = 0; t < nt; t += 2) {
            const bool last = (t == nt - 2);
            const char* a1 = cA + (size_t)(t + 1) * kstep;
            const char* a2 = last ? nA : cA + (size_t)(t + 2) * kstep; const char* b2 = last ? nB : cB + (size_t)(t + 2) * kstep;
            const char* a3 = a2 + kstep; const char* b3 = b2 + kstep;
            if (last && has_next) S.a_ready(nxt);
            if constexpr (SP2) {
            PG8_LDB(B0, 0, 0); PG8_LDB(B1, 0, 1); PG8_SCHED; PG8_LDA(At, 0, 0); PG8_STAGE(PG8_SA(1, 1), a1 + hstep, voffA);
            PG8_WAIT_V(8); PG8_WAIT_L(0); PG8_BAR; PG8_MMA(0, 0, At, B0); PG8_MMA(0, 1, At, B1); PG8_BAR; PG8_SCHED;
            PG8_LDA(At, 0, 1); PG8_STAGE(PG8_SB(0, 0), b2, voffB); PG8_STAGE(PG8_SB(0, 1), b2 + hstep, voffB); PG8_STAGE(PG8_SA(0, 0), a2, voffA);
            PG8_WAIT_V(8); PG8_WAIT_L(0); PG8_BAR; PG8_MMA(1, 0, At, B0); PG8_MMA(1, 1, At, B1); PG8_BAR; PG8_SCHED;
            PG8_LDB(B0, 1, 0); PG8_LDB(B1, 1, 1); PG8_SCHED; PG8_LDA(At, 1, 0); PG8_STAGE(PG8_SA(0, 1), a2 + hstep, voffA);
            PG8_WAIT_V(8); PG8_WAIT_L(0); PG8_BAR; PG8_MMA(0, 0, At, B0); PG8_MMA(0, 1, At, B1); PG8_BAR; PG8_SCHED;
            PG8_LDA(At, 1, 1); PG8_STAGE(PG8_SB(1, 0), b3, voffB); PG8_STAGE(PG8_SB(1, 1), b3 + hstep, voffB); PG8_STAGE(PG8_SA(1, 0), a3, voffA);
            PG8_WAIT_V(8); PG8_WAIT_L(0); PG8_BAR; PG8_MMA(1, 0, At, B0); PG8_MMA(1, 1, At, B1); PG8_BAR; PG8_SCHED;
            } else {
            PG8_LDB(B0, 0, 0); PG8_SCHED; PG8_LDA(At, 0, 0); PG8_STAGE(PG8_SA(1, 1), a1 + hstep, voffA);
            PG8_WAIT_L(8); PG8_BAR; PG8_WAIT_L(0); PG8_MMA(0, 0, At, B0); PG8_BAR; PG8_SCHED;
            PG8_LDB(B1, 0, 1); PG8_STAGE(PG8_SB(0, 0), b2, voffB);
            PG8_BAR; PG8_WAIT_L(0); PG8_MMA(0, 1, At, B1); PG8_BAR;
            PG8_LDA(At, 0, 1); PG8_STAGE(PG8_SA(0, 0), a2, voffA);
            PG8_BAR; PG8_WAIT_L(0); PG8_MMA(1, 0, At, B0); PG8_BAR; PG8_SCHED;
            PG8_STAGE(PG8_SB(0, 1), b2 + hstep, voffB);
            PG8_WAIT_V(6); PG8_BAR; PG8_MMA(1, 1, At, B1); PG8_BAR;
            PG8_LDB(B0, 1, 0); PG8_SCHED; PG8_LDA(At, 1, 0); PG8_STAGE(PG8_SA(0, 1), a2 + hstep, voffA);
            PG8_WAIT_L(8); PG8_BAR; PG8_WAIT_L(0); PG8_MMA(0, 0, At, B0); PG8_BAR; PG8_SCHED;
            PG8_LDB(B1, 1, 1); PG8_STAGE(PG8_SB(1, 0), b3, voffB);
            PG8_BAR; PG8_WAIT_L(0); PG8_MMA(0, 1, At, B1); PG8_BAR;
            PG8_LDA(At, 1, 1); PG8_STAGE(PG8_SA(1, 0), a3, voffA);
            PG8_BAR; PG8_WAIT_L(0); PG8_MMA(1, 0, At, B0); PG8_BAR; PG8_SCHED;
            PG8_STAGE(PG8_SB(1, 1), b3 + hstep, voffB);
            PG8_WAIT_V(6); PG8_BAR; PG8_MMA(1, 1, At, B1); PG8_BAR;
            }
        }
        if constexpr (ALIGN_EPI) { if (wr == 0) PG8_BAR; }
        if constexpr (!Epi::AFTER_DRAIN) { E(acc, cur, wr, wc, fr, fq); S.done(cur); }
        if (!has_next) break;
#pragma unroll
        for (int a = 0; a < 2; ++a)
#pragma unroll
            for (int b = 0; b < 2; ++b)
#pragma unroll
                for (int m = 0; m < 4; ++m)
#pragma unroll
                    for (int n = 0; n < 2; ++n) acc[a][b][m][n] = (f32x4){0.f, 0.f, 0.f, 0.f};
        cur = nxt; cA = nA; cB = nB; ++ui;
        if constexpr (ALIGN_EPI) { if (wr == 1) PG8_BAR; }
    }
    PG8_WAIT_V(0);
    if constexpr (!ALIGN_EPI) { if (wr == 0) PG8_BAR; }
    PG8_BAR;
    if constexpr (Epi::AFTER_DRAIN) { E.fused(acc, cur, wr, wc, fr, fq, lds, wid, lane); S.done(cur); }
#undef PG8_SA
#undef PG8_SB
#undef PG8_STAGE
#undef PG8_LDA
#undef PG8_LDB
#undef PG8_MMA
#undef PG8_WAIT_V
#undef PG8_WAIT_L
#undef PG8_BAR
#undef PG8_SCHED
}
}
#ifndef ATT_SDEPTH
#define ATT_SDEPTH 1
#endif
namespace att {
using bf16 = __hip_bfloat16;
constexpr int NW = 8, QBLK = 32, KVBLK = 64;
constexpr float SCALE = 0.07216878364870322f;
constexpr float THR = 8.f;
__device__ __forceinline__ int otid() { int t = threadIdx.x; asm volatile("" : "+v"(t)); return t; }
using bf16x8 = __attribute__((ext_vector_type(8))) short;
using s16x4  = __attribute__((ext_vector_type(4))) short;
using f32x16 = __attribute__((ext_vector_type(16))) float;
using f32x8  = __attribute__((ext_vector_type(8))) float;
using u32x4  = __attribute__((ext_vector_type(4))) unsigned;
#define KSWZ(row, colB) ((row) * 256 + ((colB) ^ (((row) & 7) << 4)))
#define SBAR() __builtin_amdgcn_sched_barrier(0)
__device__ __forceinline__ int crow(int r, int hi) { return (r & 3) + 8 * (r >> 2) + 4 * hi; }
__device__ __forceinline__ unsigned cvtpk(float lo, float hi) {
  unsigned r; asm volatile("v_cvt_pk_bf16_f32 %0, %1, %2" : "=v"(r) : "v"(lo), "v"(hi)); return r;
}
template <typename TIn> struct Stage;
template <> struct Stage<bf16>  { using T = bf16x8;
  __device__ static __forceinline__ T ld8(const bf16* p) { return *reinterpret_cast<const bf16x8*>(p); }
  __device__ static __forceinline__ bf16x8 tobf(T x) { return x; } };
template <> struct Stage<float> { using T = f32x8;
  __device__ static __forceinline__ T ld8(const float* p) { return *reinterpret_cast<const f32x8*>(p); }
  __device__ static __forceinline__ bf16x8 tobf(T x) {
    u32x4 w = {cvtpk(x[0], x[1]), cvtpk(x[2], x[3]), cvtpk(x[4], x[5]), cvtpk(x[6], x[7])}; return *reinterpret_cast<bf16x8*>(&w); } };

__device__ __forceinline__ void partialSM(f32x16& p0, f32x16& p1, float& m_reg, float& mn, float& alpha) {
  constexpr float C = SCALE * 1.4426950408889634f;
  float pmax = p0[0]; for (int r = 1; r < 16; ++r) pmax = fmaxf(pmax, p0[r]); for (int r = 0; r < 16; ++r) pmax = fmaxf(pmax, p1[r]);
  { auto rr = __builtin_amdgcn_permlane32_swap(__float_as_uint(pmax), __float_as_uint(pmax), false, false);
    pmax = fmaxf(__uint_as_float(rr[0]), __uint_as_float(rr[1])); }
  if (__builtin_expect(__all(pmax - m_reg <= THR / SCALE), 1)) { mn = m_reg; alpha = 1.f; }
  else { mn = fmaxf(m_reg, pmax); alpha = __builtin_amdgcn_exp2f((m_reg - mn) * C); m_reg = mn; }
  float mnC = -mn * C;
  for (int r = 0; r < 16; ++r) p0[r] = fmaf(p0[r], C, mnC); for (int r = 0; r < 16; ++r) p1[r] = fmaf(p1[r], C, mnC);
  for (int r = 0; r < 16; ++r) p0[r] = __builtin_amdgcn_exp2f(p0[r]);
}
__device__ __forceinline__ void finishSM(f32x16& p0, f32x16& p1, float alpha, float& l_reg, bf16x8& pa0, bf16x8& pa1, bf16x8& pa2, bf16x8& pa3) {
  for (int r = 0; r < 16; ++r) p1[r] = __builtin_amdgcn_exp2f(p1[r]);
  float ps = 0; for (int r = 0; r < 16; ++r) ps += p0[r]; for (int r = 0; r < 16; ++r) ps += p1[r];
  { auto rr = __builtin_amdgcn_permlane32_swap(__float_as_uint(ps), __float_as_uint(ps), false, false);
    ps = __uint_as_float(rr[0]) + __uint_as_float(rr[1]); }
  l_reg = l_reg * alpha + ps;
#define PK4(P, BASE, OUT) do { unsigned a0 = cvtpk(P[BASE + 0], P[BASE + 1]), a1 = cvtpk(P[BASE + 2], P[BASE + 3]);   \
    unsigned b0 = cvtpk(P[BASE + 4], P[BASE + 5]), b1 = cvtpk(P[BASE + 6], P[BASE + 7]);                              \
    auto r0 = __builtin_amdgcn_permlane32_swap(a0, b0, false, false); auto r1 = __builtin_amdgcn_permlane32_swap(a1, b1, false, false); \
    u32x4 w = {r0[0], r1[0], r0[1], r1[1]}; OUT = *reinterpret_cast<bf16x8*>(&w); } while (0)
  PK4(p0, 0, pa0); PK4(p0, 8, pa1); PK4(p1, 0, pa2); PK4(p1, 8, pa3);
#undef PK4
}
#define KSWZ2(row, colB) ((row) * 128 + ((colB) ^ (((row) & 7) << 4)))
__device__ __forceinline__ void qkt(f32x16& p0, f32x16& p1, const bf16* Ks, const bf16* KRs, const bf16x8* qr, const bf16x8* qrl, int r32, int hi) {
  p0 = f32x16{}; p1 = f32x16{};
#pragma unroll
  for (int d0 = 0; d0 < 8; ++d0) { int cb = (d0 * 16 + hi * 8) * 2;
    bf16x8 b0 = *reinterpret_cast<const bf16x8*>((const char*)Ks + KSWZ(r32, cb));
    bf16x8 b1 = *reinterpret_cast<const bf16x8*>((const char*)Ks + KSWZ(32 + r32, cb));
    p0 = __builtin_amdgcn_mfma_f32_32x32x16_bf16(b0, qr[d0], p0, 0, 0, 0);
    p1 = __builtin_amdgcn_mfma_f32_32x32x16_bf16(b1, qr[d0], p1, 0, 0, 0); }
#pragma unroll
  for (int d0 = 0; d0 < 4; ++d0) { int cb = (d0 * 16 + hi * 8) * 2;
    bf16x8 b0 = *reinterpret_cast<const bf16x8*>((const char*)KRs + KSWZ2(r32, cb));
    bf16x8 b1 = *reinterpret_cast<const bf16x8*>((const char*)KRs + KSWZ2(32 + r32, cb));
    const bf16x8 qv = qrl[d0 * 64];
    p0 = __builtin_amdgcn_mfma_f32_32x32x16_bf16(b0, qv, p0, 0, 0, 0);
    p1 = __builtin_amdgcn_mfma_f32_32x32x16_bf16(b1, qv, p1, 0, 0, 0); }
}
__device__ __forceinline__ int v_st(int k, int c) { const int kk = (k & ~0xC) | ((k & 4) << 1) | ((k & 8) >> 1); return ((kk >> 3) * 4 + (c >> 5)) * 512 + ((kk & 7) * 32 + (c & 31)) * 2; }
__device__ __forceinline__ int v_rd_base(int lane) { return ((lane & 3) << 3) | (((lane >> 2) & 3) << 6) | (((lane >> 4) & 1) << 5) | (((lane >> 5) & 1) << 8); }
constexpr int v_rd_off(int d0, int ks, int half) { return d0 * 512 + ks * 4096 + half * 2048; }
template <int OFF> __device__ __forceinline__ s16x4 tr_read(int vb) {
  s16x4 r; asm volatile("ds_read_b64_tr_b16 %0, %1 offset:%2" : "=&v"(r) : "v"(vb), "i"(OFF) : "memory"); return r;
}
template <int D0> __device__ __forceinline__ void pv_one(f32x16& od, int vb, bf16x8 pa0, bf16x8 pa1, bf16x8 pa2, bf16x8 pa3) {
  const s16x4 l0 = tr_read<v_rd_off(D0, 0, 0)>(vb), h0 = tr_read<v_rd_off(D0, 0, 1)>(vb), l1 = tr_read<v_rd_off(D0, 1, 0)>(vb), h1 = tr_read<v_rd_off(D0, 1, 1)>(vb);
  const s16x4 l2 = tr_read<v_rd_off(D0, 2, 0)>(vb), h2 = tr_read<v_rd_off(D0, 2, 1)>(vb), l3 = tr_read<v_rd_off(D0, 3, 0)>(vb), h3 = tr_read<v_rd_off(D0, 3, 1)>(vb);
  asm volatile("s_waitcnt lgkmcnt(0)" ::: "memory"); SBAR();
#define PK(L, H) (bf16x8){L[0], L[1], L[2], L[3], H[0], H[1], H[2], H[3]}
  od = __builtin_amdgcn_mfma_f32_32x32x16_bf16(pa0, PK(l0, h0), od, 0, 0, 0);
  od = __builtin_amdgcn_mfma_f32_32x32x16_bf16(pa1, PK(l1, h1), od, 0, 0, 0);
  od = __builtin_amdgcn_mfma_f32_32x32x16_bf16(pa2, PK(l2, h2), od, 0, 0, 0);
  od = __builtin_amdgcn_mfma_f32_32x32x16_bf16(pa3, PK(l3, h3), od, 0, 0, 0);
#undef PK
}
__device__ __forceinline__ void pv_d0(f32x16* o, int vb, bf16x8 pa0, bf16x8 pa1, bf16x8 pa2, bf16x8 pa3) {
  pv_one<0>(o[0], vb, pa0, pa1, pa2, pa3); pv_one<1>(o[1], vb, pa0, pa1, pa2, pa3); pv_one<2>(o[2], vb, pa0, pa1, pa2, pa3); pv_one<3>(o[3], vb, pa0, pa1, pa2, pa3);
}
constexpr int LDQ = 1536, LDK = 1024, LDV = 1024, LDKR = 64, LDO = 1024, SDEPTH = ATT_SDEPTH;
constexpr int SHM_V = KVBLK * 128 * 2, SHM_K = KVBLK * 128 * 2, SHM_KR = KVBLK * 64 * 2;
constexpr int SHM_QR = NW * 4 * 64 * 16;
constexpr int SHM_ATTN = 2 * SHM_V + 2 * SHM_K + 2 * SHM_KR + NW * 64 * 4 + SHM_QR;
__device__ __forceinline__ void attn_unit(const bf16* __restrict__ Qb, const bf16* __restrict__ Kh, const bf16* __restrict__ KRh, const bf16* __restrict__ Vh,
                                          bf16* __restrict__ Ob, int seq, char* lds) {
  using St = Stage<bf16>;
  const int tid = otid(), wid = tid >> 6, lane = tid & 63, r32 = lane & 31, hi = lane >> 5;
  bf16* V_lds = (bf16*)lds; bf16* K_lds = (bf16*)(lds + 2 * SHM_V); bf16* KR_lds = (bf16*)(lds + 2 * SHM_V + 2 * SHM_K);
  float* ws = (float*)(lds + 2 * SHM_V + 2 * SHM_K + 2 * SHM_KR) + wid * 64; float* li_l = ws; float* al_l = ws + 32;
  float m_reg = -1e30f, l_reg = 0; f32x16 o[4] = {}; bf16x8 qr[8];
  bf16x8* qrl = (bf16x8*)(lds + 2 * SHM_V + 2 * SHM_K + 2 * SHM_KR + NW * 64 * 4) + wid * 256 + lane;
  const bf16* Qw = Qb + (long)(wid * QBLK + r32) * LDQ + hi * 8;
#pragma unroll
  for (int d0 = 0; d0 < 8; ++d0) qr[d0] = St::ld8(Qw + d0 * 16);
#pragma unroll
  for (int d0 = 0; d0 < 4; ++d0) qrl[d0 * 64] = St::ld8(Qw + 128 + d0 * 16);
  const int sr = tid >> 4, sc = (tid & 15) * 8, vst0 = v_st(sr, sc), vst1 = v_st(32 + sr, sc);
  const int krr = tid >> 3, krc = (tid & 7) * 8;
  const int vb0 = (int)(uintptr_t)V_lds + v_rd_base(lane);
  struct { bf16x8 vs0, vs1, ks0, ks1, kr; } sr_[SDEPTH];
#define SLOAD(i, k0) do { sr_[i].vs0 = St::ld8(&Vh[(long)((k0) + sr) * LDV + sc]); sr_[i].vs1 = St::ld8(&Vh[(long)((k0) + 32 + sr) * LDV + sc]); \
    sr_[i].ks0 = St::ld8(&Kh[(long)((k0) + sr) * LDK + sc]); sr_[i].ks1 = St::ld8(&Kh[(long)((k0) + 32 + sr) * LDK + sc]); \
    sr_[i].kr = St::ld8(&KRh[(long)((k0) + krr) * LDKR + krc]); } while (0)
#define SWRITE(b, i) do { *(bf16x8*)((char*)V_lds + (b) * SHM_V + vst0) = sr_[i].vs0;          \
    *(bf16x8*)((char*)V_lds + (b) * SHM_V + vst1) = sr_[i].vs1; int kc = sc * 2;               \
    *(bf16x8*)((char*)K_lds + (b) * SHM_K + KSWZ(sr, kc)) = sr_[i].ks0;                       \
    *(bf16x8*)((char*)K_lds + (b) * SHM_K + KSWZ(32 + sr, kc)) = sr_[i].ks1;                  \
    *(bf16x8*)((char*)KR_lds + (b) * SHM_KR + KSWZ2(krr, krc * 2)) = sr_[i].kr; } while (0)
#define SWAIT() do { if constexpr (SDEPTH == 2) asm volatile("s_waitcnt vmcnt(5)" ::: "memory"); else asm volatile("s_waitcnt vmcnt(0)" ::: "memory"); } while (0)
#define RESC(a) do { if (__any((a) < 1.f)) { if (hi == 0) al_l[r32] = (a); asm volatile("s_waitcnt lgkmcnt(0)" ::: "memory"); \
    _Pragma("unroll") for (int d = 0; d < 4; ++d) _Pragma("unroll") for (int r = 0; r < 16; ++r) o[d][r] *= al_l[crow(r, hi)]; } } while (0)
  f32x16 pA0, pA1, pB0, pB1; float mnA, mnB, alA, alB; bf16x8 pa0, pa1, pa2, pa3; const int NT = seq / KVBLK;
  constexpr int SE = 0, SO = SDEPTH - 1;
  SLOAD(SE, 0); asm volatile("s_waitcnt vmcnt(0)" ::: "memory"); SWRITE(0, SE); __syncthreads();
  qkt(pA0, pA1, K_lds, KR_lds, qr, qrl, r32, hi); partialSM(pA0, pA1, m_reg, mnA, alA);
  SLOAD(SO, KVBLK); if constexpr (SDEPTH == 2) { if (2 < NT) SLOAD(SE, 2 * KVBLK); }
  SWAIT(); SWRITE(1, SO); __syncthreads();
  for (int j = 1; j + 1 < NT; j += 2) {
    SBAR(); qkt(pB0, pB1, (bf16*)((char*)K_lds + SHM_K), (bf16*)((char*)KR_lds + SHM_KR), qr, qrl, r32, hi);
    finishSM(pA0, pA1, alA, l_reg, pa0, pa1, pa2, pa3); SBAR();
    SLOAD(SO, (j + SDEPTH) * KVBLK); SBAR();
    pv_d0(o, vb0, pa0, pa1, pa2, pa3); partialSM(pB0, pB1, m_reg, mnB, alB);
    __syncthreads(); SWAIT(); SWRITE(0, SE);
    RESC(alB); __syncthreads();
    SBAR(); qkt(pA0, pA1, K_lds, KR_lds, qr, qrl, r32, hi);
    finishSM(pB0, pB1, alB, l_reg, pa0, pa1, pa2, pa3); SBAR();
    if (SDEPTH == 1 || j + 3 < NT) SLOAD(SE, (j + 1 + SDEPTH) * KVBLK); SBAR();
    pv_d0(o, vb0 + (int)SHM_V, pa0, pa1, pa2, pa3); partialSM(pA0, pA1, m_reg, mnA, alA);
    __syncthreads(); SWAIT(); SWRITE(1, SO);
    RESC(alA); __syncthreads();
  }
  SBAR(); qkt(pB0, pB1, (bf16*)((char*)K_lds + SHM_K), (bf16*)((char*)KR_lds + SHM_KR), qr, qrl, r32, hi);
  finishSM(pA0, pA1, alA, l_reg, pa0, pa1, pa2, pa3); SBAR();
  pv_d0(o, vb0, pa0, pa1, pa2, pa3); partialSM(pB0, pB1, m_reg, mnB, alB);
  __syncthreads(); RESC(alB);
  finishSM(pB0, pB1, alB, l_reg, pa0, pa1, pa2, pa3); SBAR();
  pv_d0(o, vb0 + (int)SHM_V, pa0, pa1, pa2, pa3);
  if (hi == 0) li_l[r32] = l_reg; asm volatile("s_waitcnt lgkmcnt(0)" ::: "memory");
  float rli[16];
#pragma unroll
  for (int r = 0; r < 16; ++r) rli[r] = __builtin_amdgcn_rcpf(li_l[crow(r, hi)]);
  bf16* Ow = Ob + (long)(wid * QBLK) * LDO;
#pragma unroll
  for (int r = 0; r < 16; ++r) { int orow = crow(r, hi);
#pragma unroll
    for (int d0 = 0; d0 < 4; ++d0) Ow[(long)orow * LDO + d0 * 32 + r32] = __float2bfloat16(o[d0][r] * rli[r]); }
  __syncthreads();
#undef SLOAD
#undef SWRITE
#undef SWAIT
#undef RESC
}
#undef SBAR
}
constexpr int BATCH = 4, SEQ = 8192, DM = 1024, DEPTH = 4, DFF = 2816, MT = BATCH * SEQ;
constexpr int NH = 8, QLR = 256, KVLR = 128, QKD = 192;
constexpr float EPS = 1e-6f;
constexpr size_t MiB = 1u << 20;
constexpr size_t WS_WFFI = 1 * MiB;
constexpr size_t WS_WFFO = 89 * MiB;
constexpr size_t WS_WHIN = 133 * MiB;
constexpr size_t WS_WHO  = 153 * MiB;
constexpr size_t WS_WMIN = 157 * MiB;
constexpr size_t WS_WUQ  = 159 * MiB;
constexpr size_t WS_WUKV = 161 * MiB;
constexpr size_t WS_WMO  = 162 * MiB;
constexpr size_t WS_COS  = 166 * MiB;
constexpr size_t WS_SIN  = 170 * MiB;
constexpr size_t WS_LB   = 174 * MiB;
constexpr size_t WS_HN   = 176 * MiB;
constexpr size_t WS_Y    = 240 * MiB;
constexpr size_t WS_R    = 368 * MiB;
constexpr size_t WS_END  = 704 * MiB;
constexpr size_t R_ACT = 0;
constexpr size_t R_C = 0, R_QB = 0, R_CQ = 96 * MiB, R_CKV = 112 * MiB, R_KR = 120 * MiB, R_KN = 124 * MiB, R_VB = 188 * MiB, R_O = 252 * MiB;
constexpr size_t R_QH = 0, R_VH = 64 * MiB, R_GH = 128 * MiB, R_KF = 192 * MiB, R_HO = 0;

constexpr int LDS_RING = 131072, LDS_BYTES = LDS_RING + 2048;
typedef unsigned short bf16_t;
typedef float f32x4 __attribute__((ext_vector_type(4)));
typedef float f32x2 __attribute__((ext_vector_type(2)));
typedef unsigned u32x4 __attribute__((ext_vector_type(4)));
typedef unsigned u32x2 __attribute__((ext_vector_type(2)));
typedef _Float16 h16x2 __attribute__((ext_vector_type(2)));
#define LAS __attribute__((address_space(3)))

__device__ __constant__ double ROPE_INVF[32] = {1.0, 0.7498942093324559, 0.5623413251903491, 0.4216965034285822, 0.31622776601683794, 0.23713737056616552, 0.1778279410038923, 0.1333521432163324, 0.1, 0.07498942093324558, 0.05623413251903491, 0.042169650342858224, 0.03162277660168379, 0.023713737056616554, 0.01778279410038923, 0.01333521432163324, 0.01, 0.007498942093324558, 0.005623413251903491, 0.004216965034285823, 0.0031622776601683794, 0.0023713737056616554, 0.0017782794100389228, 0.001333521432163324, 0.001, 0.0007498942093324559, 0.0005623413251903491, 0.00042169650342858224, 0.00031622776601683794, 0.00023713737056616554, 0.00017782794100389227, 0.0001333521432163324};

__device__ __forceinline__ unsigned pk2(float lo, float hi) { return pg8::cvt_pk_bf16(lo, hi); }
__device__ __forceinline__ float silu_f(float g) { return g * __builtin_amdgcn_rcpf(1.0f + __expf(-g)); }
__device__ __forceinline__ float wave_sum(float v) {
#pragma unroll
    for (int o = 1; o < 64; o <<= 1) v += __shfl_xor(v, o);
    return v;
}
__device__ __forceinline__ float half_sum(float v) {
#pragma unroll
    for (int o = 1; o < 32; o <<= 1) v += __shfl_xor(v, o);
    return v;
}

using pg8::Unit;
struct EpiSwiglu { static constexpr bool PERM = true, AFTER_DRAIN = false; bf16_t* O;
    __device__ __forceinline__ void operator()(const pg8::f32x4 (&acc)[2][2][4][2], const Unit& u, int wr, int wc, int fr, int fq) const {
        const int row0 = u.pm * 256 + wr * 64 + fr, col0 = u.pn * 128 + wc * 32 + 8 * fq;
#pragma unroll
        for (int ai = 0; ai < 2; ++ai)
#pragma unroll
            for (int m = 0; m < 4; ++m) { bf16_t* p = O + (size_t)(row0 + ai * 128 + m * 16) * DFF + col0;
                const pg8::f32x4 g0 = acc[ai][0][m][0], g1 = acc[ai][0][m][1], u0 = acc[ai][1][m][0], u1 = acc[ai][1][m][1];
                u32x4 w; w.x = pk2(silu_f(g0[0]) * u0[0], silu_f(g0[1]) * u0[1]); w.y = pk2(silu_f(g0[2]) * u0[2], silu_f(g0[3]) * u0[3]);
                w.z = pk2(silu_f(g1[0]) * u1[0], silu_f(g1[1]) * u1[1]); w.w = pk2(silu_f(g1[2]) * u1[2], silu_f(g1[3]) * u1[3]);
                *(u32x4*)p = w; }
    }
};
struct EpiF32 { static constexpr bool PERM = false, AFTER_DRAIN = false; float* O; int ldc;
    __device__ __forceinline__ void operator()(const pg8::f32x4 (&acc)[2][2][4][2], const Unit& u, int wr, int wc, int fr, int fq) const {
        const int row0 = u.pm * 256 + wr * 64 + fr, col0 = u.pn * 256 + wc * 32 + 4 * fq;
#pragma unroll
        for (int ai = 0; ai < 2; ++ai)
#pragma unroll
            for (int m = 0; m < 4; ++m) { float* p = O + (size_t)(row0 + ai * 128 + m * 16) * ldc + col0;
#pragma unroll
                for (int bj = 0; bj < 2; ++bj)
#pragma unroll
                    for (int n = 0; n < 2; ++n) *(pg8::f32x4*)(p + bj * 128 + n * 16) = acc[ai][bj][m][n]; }
    }
};
struct EpiQ { static constexpr bool PERM = true, AFTER_DRAIN = false; bf16_t* O; const float* cs; const float* sn;
    __device__ __forceinline__ void operator()(const pg8::f32x4 (&acc)[2][2][4][2], const Unit& u, int wr, int wc, int fr, int fq) const {
        const int row0 = u.pm * 256 + wr * 64 + fr;
#pragma unroll
        for (int bj = 0; bj < 2; ++bj) { const int col0 = u.pn * 256 + bj * 128 + wc * 32 + 8 * fq, d = col0 % QKD; const bool rot = d >= 128; const int i0 = (d - 128) >> 1;
#pragma unroll
            for (int ai = 0; ai < 2; ++ai)
#pragma unroll
                for (int m = 0; m < 4; ++m) { const int row = row0 + ai * 128 + m * 16; pg8::f32x4 v0 = acc[ai][bj][m][0], v1 = acc[ai][bj][m][1];
                    if (rot) { const pg8::f32x4 c = *(const pg8::f32x4*)(cs + (size_t)row * 32 + i0), s = *(const pg8::f32x4*)(sn + (size_t)row * 32 + i0);
                        pg8::f32x4 a, b; a[0] = v0[0] * c[0] - v0[1] * s[0]; a[1] = v0[0] * s[0] + v0[1] * c[0]; a[2] = v0[2] * c[1] - v0[3] * s[1]; a[3] = v0[2] * s[1] + v0[3] * c[1];
                        b[0] = v1[0] * c[2] - v1[1] * s[2]; b[1] = v1[0] * s[2] + v1[1] * c[2]; b[2] = v1[2] * c[3] - v1[3] * s[3]; b[3] = v1[2] * s[3] + v1[3] * c[3]; v0 = a; v1 = b; }
                    u32x4 w; w.x = pk2(v0[0], v0[1]); w.y = pk2(v0[2], v0[3]); w.z = pk2(v1[0], v1[1]); w.w = pk2(v1[2], v1[3]);
                    *(u32x4*)(O + (size_t)row * 1536 + col0) = w; } }
    }
};
struct EpiKV { static constexpr bool PERM = true, AFTER_DRAIN = false; bf16_t* Kn; bf16_t* Vb;
    __device__ __forceinline__ void operator()(const pg8::f32x4 (&acc)[2][2][4][2], const Unit& u, int wr, int wc, int fr, int fq) const {
        const int row0 = u.pm * 256 + wr * 64 + fr, col0 = u.pn * 128 + wc * 32 + 8 * fq;
#pragma unroll
        for (int bj = 0; bj < 2; ++bj) { bf16_t* base = bj ? Vb : Kn;
#pragma unroll
            for (int ai = 0; ai < 2; ++ai)
#pragma unroll
                for (int m = 0; m < 4; ++m) { const pg8::f32x4 v0 = acc[ai][bj][m][0], v1 = acc[ai][bj][m][1];
                    u32x4 w; w.x = pk2(v0[0], v0[1]); w.y = pk2(v0[2], v0[3]); w.z = pk2(v1[0], v1[1]); w.w = pk2(v1[2], v1[3]);
                    *(u32x4*)(base + (size_t)(row0 + ai * 128 + m * 16) * 1024 + col0) = w; } }
    }
};
__device__ __forceinline__ unsigned pkh2(float a, float b) { const h16x2 h = {(_Float16)a, (_Float16)b}; return __builtin_bit_cast(unsigned, h); }
__device__ __forceinline__ float kgate(float om, float z) { return om * __builtin_amdgcn_rcpf(1.0f + __expf(z)); }
struct EpiHgrn { static constexpr bool PERM = true, AFTER_DRAIN = false; bf16_t* Qh; bf16_t* Vh; bf16_t* Gh; unsigned short* KF; const float* lb;
    __device__ __forceinline__ void operator()(const pg8::f32x4 (&acc)[2][2][4][2], const Unit& u, int wr, int wc, int fr, int fq) const {
        const int row0 = u.pm * 256 + wr * 64 + fr, seg = u.pn >> 2;
#pragma unroll
        for (int bj = 0; bj < 2; ++bj) { const int cc = (u.pn & 3) * 256 + bj * 128 + wc * 32 + 8 * fq;
            if (seg == 1 || seg == 2) {
                const pg8::f32x4 om0 = 1.0f - *(const pg8::f32x4*)(lb + (seg - 1) * 1024 + cc), om1 = 1.0f - *(const pg8::f32x4*)(lb + (seg - 1) * 1024 + cc + 4);
                unsigned short* base = KF + (size_t)(seg - 1) * MT * 1024;
#pragma unroll
                for (int ai = 0; ai < 2; ++ai)
#pragma unroll
                    for (int m = 0; m < 4; ++m) { const size_t off = (size_t)(row0 + ai * 128 + m * 16) * 1024 + cc; const pg8::f32x4 v0 = acc[ai][bj][m][0], v1 = acc[ai][bj][m][1];
                        u32x4 w; w.x = pkh2(kgate(om0[0], v0[0]), kgate(om0[1], v0[1])); w.y = pkh2(kgate(om0[2], v0[2]), kgate(om0[3], v0[3]));
                        w.z = pkh2(kgate(om1[0], v1[0]), kgate(om1[1], v1[1])); w.w = pkh2(kgate(om1[2], v1[2]), kgate(om1[3], v1[3]));
                        *(u32x4*)(base + off) = w; }
            } else if (seg == 3) {
#pragma unroll
                for (int ai = 0; ai < 2; ++ai)
#pragma unroll
                    for (int m = 0; m < 4; ++m) { const size_t off = (size_t)(row0 + ai * 128 + m * 16) * 1024 + cc; const pg8::f32x4 v0 = acc[ai][bj][m][0], v1 = acc[ai][bj][m][1];
                        u32x4 w; w.x = pk2(v0[0], v0[1]); w.y = pk2(v0[2], v0[3]); w.z = pk2(v1[0], v1[1]); w.w = pk2(v1[2], v1[3]);
                        *(u32x4*)(Vh + off) = w; }
            } else { bf16_t* base = seg == 0 ? Qh : Gh;
#pragma unroll
                for (int ai = 0; ai < 2; ++ai)
#pragma unroll
                    for (int m = 0; m < 4; ++m) { const size_t off = (size_t)(row0 + ai * 128 + m * 16) * 1024 + cc; const pg8::f32x4 v0 = acc[ai][bj][m][0], v1 = acc[ai][bj][m][1];
                        u32x4 w; w.x = pk2(silu_f(v0[0]), silu_f(v0[1])); w.y = pk2(silu_f(v0[2]), silu_f(v0[3])); w.z = pk2(silu_f(v1[0]), silu_f(v1[1])); w.w = pk2(silu_f(v1[2]), silu_f(v1[3]));
                        *(u32x4*)(base + off) = w; } } }
    }
};

__device__ __forceinline__ int src_col(int mode, int n) {
    if (mode == 1) { const int t = n >> 8, j = n & 255; return j < 128 ? t * 128 + j : DFF + t * 128 + (j - 128); }
    if (mode == 2) { if (n < 384) return n; if (n >= 448) return -1; const int j = n - 384; return 384 + (j >> 1) + 32 * (j & 1); }
    if (mode == 3) { const int h = n / QKD, d = n % QKD; if (d < 128) return n; const int j = d - 128; return h * QKD + 128 + (j >> 1) + 32 * (j & 1); }
    return n;
}
__device__ __forceinline__ void xpose_item(const float* __restrict__ W, int K, int Nsrc, int Ndst, int mode, bf16_t* __restrict__ WT, LAS float* scr, int item, int lane) {
    const int nblk = Ndst / 32, kb = item / nblk, nb = item % nblk, k0 = 64 * kb, n0 = 32 * nb;
    const int sc = src_col(mode, n0 + (lane & 31));
#pragma unroll 8
    for (int i = 0; i < 32; ++i) { const int kk = 2 * i + (lane >> 5); scr[kk * 33 + (lane & 31)] = sc >= 0 ? W[(size_t)(k0 + kk) * Nsrc + sc] : 0.f; }
    asm volatile("s_waitcnt lgkmcnt(0)" ::: "memory");
    const int c = lane & 7;
#pragma unroll
    for (int j = 0; j < 4; ++j) { const int n = (lane >> 3) + 8 * j; const LAS float* s = scr + (8 * c) * 33 + n;
        u32x4 o; o.x = pk2(s[0 * 33], s[1 * 33]); o.y = pk2(s[2 * 33], s[3 * 33]); o.z = pk2(s[4 * 33], s[5 * 33]); o.w = pk2(s[6 * 33], s[7 * 33]);
        *(u32x4*)(WT + (size_t)(n0 + n) * K + k0 + 8 * c) = o; }
    asm volatile("s_waitcnt lgkmcnt(0)" ::: "memory");
}

__device__ __forceinline__ void row_init(const float* __restrict__ xin, float* __restrict__ X, bf16_t* __restrict__ HN, const float* __restrict__ g, int lane) {
    const f32x4* xr = (const f32x4*)xin + lane; f32x4 v[4]; float s = 0.f;
#pragma unroll
    for (int j = 0; j < 4; ++j) { v[j] = xr[64 * j]; s += (v[j][0] * v[j][0] + v[j][1] * v[j][1]) + (v[j][2] * v[j][2] + v[j][3] * v[j][3]); }
    const float r = rsqrtf(wave_sum(s) * (1.f / DM) + EPS);
#pragma unroll
    for (int j = 0; j < 4; ++j) { ((f32x4*)X + lane)[64 * j] = v[j]; const f32x4 gg = ((const f32x4*)g + lane)[64 * j];
        u32x2 w; w.x = pk2(v[j][0] * r * gg[0], v[j][1] * r * gg[1]); w.y = pk2(v[j][2] * r * gg[2], v[j][3] * r * gg[3]); ((u32x2*)HN + lane)[64 * j] = w; }
}
__device__ __forceinline__ void row_post(const float* __restrict__ Y, float* __restrict__ X, bf16_t* __restrict__ HN, float scale, const float* __restrict__ gp, const float* __restrict__ gn, int lane) {
    f32x4 y[4], x[4]; float s = 0.f;
#pragma unroll
    for (int j = 0; j < 4; ++j) { y[j] = ((const f32x4*)Y + lane)[64 * j]; x[j] = ((const f32x4*)X + lane)[64 * j]; s += (y[j][0] * y[j][0] + y[j][1] * y[j][1]) + (y[j][2] * y[j][2] + y[j][3] * y[j][3]); }
    const float r = rsqrtf(wave_sum(s) * (1.f / DM) + EPS) * scale; float s2 = 0.f;
#pragma unroll
    for (int j = 0; j < 4; ++j) { const f32x4 gg = ((const f32x4*)gp + lane)[64 * j]; x[j] = x[j] + y[j] * r * gg; ((f32x4*)X + lane)[64 * j] = x[j];
        s2 += (x[j][0] * x[j][0] + x[j][1] * x[j][1]) + (x[j][2] * x[j][2] + x[j][3] * x[j][3]); }
    if (HN) { const float r2 = rsqrtf(wave_sum(s2) * (1.f / DM) + EPS);
#pragma unroll
        for (int j = 0; j < 4; ++j) { const f32x4 gg = ((const f32x4*)gn + lane)[64 * j];
            u32x2 w; w.x = pk2(x[j][0] * r2 * gg[0], x[j][1] * r2 * gg[1]); w.y = pk2(x[j][2] * r2 * gg[2], x[j][3] * r2 * gg[3]); ((u32x2*)HN + lane)[64 * j] = w; } }
}
__device__ __forceinline__ void row_mla(const float* __restrict__ C, bf16_t* __restrict__ CQ, bf16_t* __restrict__ CKV, bf16_t* __restrict__ KR, const float* __restrict__ qn, const float* __restrict__ kvn,
                                        const float* __restrict__ cs, const float* __restrict__ sn, int lane) {
    const f32x4 a = ((const f32x4*)C)[2 * lane], b = ((const f32x4*)C)[2 * lane + 1];
    float s = (a[0] * a[0] + a[1] * a[1]) + (a[2] * a[2] + a[3] * a[3]) + (b[0] * b[0] + b[1] * b[1]) + (b[2] * b[2] + b[3] * b[3]);
#pragma unroll
    for (int o = 1; o < 16; o <<= 1) s += __shfl_xor(s, o);
    const float s16 = s, s32 = s16 + __shfl_xor(s16, 16);
    float v[8] = {a[0], a[1], a[2], a[3], b[0], b[1], b[2], b[3]};
    if (lane < 32) { const float r = rsqrtf(s32 * (1.f / QLR) + EPS); const f32x4 g0 = ((const f32x4*)qn)[2 * lane], g1 = ((const f32x4*)qn)[2 * lane + 1];
        u32x4 w; w.x = pk2(v[0] * r * g0[0], v[1] * r * g0[1]); w.y = pk2(v[2] * r * g0[2], v[3] * r * g0[3]); w.z = pk2(v[4] * r * g1[0], v[5] * r * g1[1]); w.w = pk2(v[6] * r * g1[2], v[7] * r * g1[3]);
        ((u32x4*)CQ)[lane] = w;
    } else if (lane < 48) { const int l = lane - 32; const float r = rsqrtf(s16 * (1.f / KVLR) + EPS); const f32x4 g0 = ((const f32x4*)kvn)[2 * l], g1 = ((const f32x4*)kvn)[2 * l + 1];
        u32x4 w; w.x = pk2(v[0] * r * g0[0], v[1] * r * g0[1]); w.y = pk2(v[2] * r * g0[2], v[3] * r * g0[3]); w.z = pk2(v[4] * r * g1[0], v[5] * r * g1[1]); w.w = pk2(v[6] * r * g1[2], v[7] * r * g1[3]);
        ((u32x4*)CKV)[l] = w;
    } else if (lane < 56) { const int l = lane - 48; const f32x4 c = ((const f32x4*)cs)[l], sv = ((const f32x4*)sn)[l];
        u32x4 w; w.x = pk2(v[0] * c[0] - v[1] * sv[0], v[0] * sv[0] + v[1] * c[0]); w.y = pk2(v[2] * c[1] - v[3] * sv[1], v[2] * sv[1] + v[3] * c[1]);
        w.z = pk2(v[4] * c[2] - v[5] * sv[2], v[4] * sv[2] + v[5] * c[2]); w.w = pk2(v[6] * c[3] - v[7] * sv[3], v[6] * sv[3] + v[7] * c[3]);
        ((u32x4*)KR)[l] = w; }
}
__device__ __forceinline__ void row_hgrn(const bf16_t* __restrict__ Oa, const bf16_t* __restrict__ Gh, bf16_t* __restrict__ HO, const float* __restrict__ on, int lane) {
#pragma unroll
    for (int j = 0; j < 4; ++j) { const u32x2 a = ((const u32x2*)Oa + lane)[64 * j], b = ((const u32x2*)(Oa + (size_t)MT * 1024) + lane)[64 * j];
        f32x4 o; o[0] = __uint_as_float(a.x << 16) + __uint_as_float(b.x << 16); o[1] = __uint_as_float(a.x & 0xffff0000u) + __uint_as_float(b.x & 0xffff0000u);
        o[2] = __uint_as_float(a.y << 16) + __uint_as_float(b.y << 16); o[3] = __uint_as_float(a.y & 0xffff0000u) + __uint_as_float(b.y & 0xffff0000u);
        const float s = half_sum((o[0] * o[0] + o[1] * o[1]) + (o[2] * o[2] + o[3] * o[3]));
        const float r = rsqrtf(s * (1.f / 128.f) + EPS); const f32x4 gg = ((const f32x4*)on + lane)[64 * j]; const u32x2 gb = ((const u32x2*)Gh + lane)[64 * j];
        const float g0 = __uint_as_float(gb.x << 16), g1 = __uint_as_float(gb.x & 0xffff0000u), g2 = __uint_as_float(gb.y << 16), g3 = __uint_as_float(gb.y & 0xffff0000u);
        u32x2 w; w.x = pk2(o[0] * r * gg[0] * g0, o[1] * r * gg[1] * g1); w.y = pk2(o[2] * r * gg[2] * g2, o[3] * r * gg[3] * g3); ((u32x2*)HO + lane)[64 * j] = w; }
}
__device__ __forceinline__ f32x2 h2f2_(unsigned u) { const h16x2 h = __builtin_bit_cast(h16x2, u); return (f32x2){(float)h[0], (float)h[1]}; }
__device__ __forceinline__ void scan_phase(LAS unsigned char* lds, const bf16_t* __restrict__ Qh, const bf16_t* __restrict__ Vh, const unsigned short* __restrict__ KF, bf16_t* __restrict__ OP, int G, int bx) {
    int tid = threadIdx.x; asm volatile("" : "+v"(tid)); const int wid = __builtin_amdgcn_readfirstlane(tid >> 6), lane = tid & 63;
    const int st = tid >> 4, sc8 = (tid & 15) * 8, sv = tid >> 3, vc4 = (tid & 7) * 4;
    constexpr int OFF_K = 16384, OFF_Q = 32768, OFF_V = 49152, OFF_P = 53248;
    for (int item = bx; item < 256; item += G) {
        const int dir = item & 1, dvq = (item >> 1) & 3, h = (item >> 3) & 7, b = item >> 6;
        const size_t kcol = h * 128 + sc8, vcol = h * 128 + dvq * 32 + vc4;
        const unsigned short* KFd = KF + (size_t)dir * MT * 1024; bf16_t* OPd = OP + (size_t)dir * MT * 1024;
        float S[8];
#pragma unroll
        for (int j = 0; j < 8; ++j) S[j] = 0.f;
        u32x4 rk, rq; u32x2 rv = {0u, 0u};
#define SC_GLOAD(blk) do { { const int tt = (blk) * 32 + st; const size_t m = (size_t)b * SEQ + (dir ? SEQ - 1 - tt : tt); \
        rk = *(const u32x4*)(KFd + m * 1024 + kcol); rq = *(const u32x4*)(Qh + m * 1024 + kcol); } \
        if (tid < 256) { const int tt = (blk) * 32 + sv; const size_t m = (size_t)b * SEQ + (dir ? SEQ - 1 - tt : tt); rv = *(const u32x2*)(Vh + m * 1024 + vcol); } } while (0)
#define SC_H2F(u_) h2f2_(u_)
#define SC_LWRITE() do { LAS unsigned char* B_ = lds + (st * 128 + sc8) * 4; \
        const f32x2 ka = SC_H2F(rk.x), kb = SC_H2F(rk.y), kc = SC_H2F(rk.z), kd = SC_H2F(rk.w); \
        const f32x4 k0_ = {ka[0], ka[1], kb[0], kb[1]}, k1_ = {kc[0], kc[1], kd[0], kd[1]}; \
        *(LAS f32x4*)(B_) = 1.0f - k0_; *(LAS f32x4*)(B_ + 16) = 1.0f - k1_; *(LAS f32x4*)(B_ + OFF_K) = k0_; *(LAS f32x4*)(B_ + OFF_K + 16) = k1_; \
        *(LAS f32x4*)(B_ + OFF_Q) = (f32x4){__uint_as_float(rq.x << 16), __uint_as_float(rq.x & 0xffff0000u), __uint_as_float(rq.y << 16), __uint_as_float(rq.y & 0xffff0000u)}; \
        *(LAS f32x4*)(B_ + OFF_Q + 16) = (f32x4){__uint_as_float(rq.z << 16), __uint_as_float(rq.z & 0xffff0000u), __uint_as_float(rq.w << 16), __uint_as_float(rq.w & 0xffff0000u)}; \
        if (tid < 256) *(LAS f32x4*)(lds + OFF_V + (sv * 32 + vc4) * 4) = (f32x4){__uint_as_float(rv.x << 16), __uint_as_float(rv.x & 0xffff0000u), __uint_as_float(rv.y << 16), __uint_as_float(rv.y & 0xffff0000u)}; } while (0)
        SC_GLOAD(0);
        const int sub = lane >> 5, dvl = lane & 31;
        const LAS unsigned char* Bc = lds + (16 * wid + 8 * sub) * 4;
        const LAS unsigned char* Vc = lds + OFF_V + dvl * 4;
        LAS float* P = (LAS float*)(lds + OFF_P) + (2 * wid + sub) * 1024 + dvl;
        for (int blk = 0; blk < SEQ / 32; ++blk) {
            SC_LWRITE();
            if (blk + 1 < SEQ / 32) SC_GLOAD(blk + 1);
            __syncthreads();
#pragma unroll 8
            for (int t = 0; t < 32; ++t) {
                const f32x4 f0 = *(const LAS f32x4*)(Bc + t * 512), f1 = *(const LAS f32x4*)(Bc + t * 512 + 16);
                const f32x4 k0 = *(const LAS f32x4*)(Bc + OFF_K + t * 512), k1 = *(const LAS f32x4*)(Bc + OFF_K + t * 512 + 16);
                const f32x4 q0 = *(const LAS f32x4*)(Bc + OFF_Q + t * 512), q1 = *(const LAS f32x4*)(Bc + OFF_Q + t * 512 + 16);
                const float vv = *(const LAS float*)(Vc + t * 128);
                float o = 0.f;
#pragma unroll
                for (int j = 0; j < 4; ++j) { S[j] = S[j] * f0[j] + k0[j] * vv; o += S[j] * q0[j]; }
#pragma unroll
                for (int j = 0; j < 4; ++j) { S[4 + j] = S[4 + j] * f1[j] + k1[j] * vv; o += S[4 + j] * q1[j]; }
                P[t * 32] = o;
            }
            __syncthreads();
            if (tid < 256) { const LAS float* Pr = (const LAS float*)(lds + OFF_P) + sv * 32 + vc4; f32x4 acc = *(const LAS f32x4*)Pr;
#pragma unroll
              for (int g = 1; g < 16; ++g) acc = acc + *(const LAS f32x4*)(Pr + g * 1024);
              const int tt = blk * 32 + sv; const size_t m = (size_t)b * SEQ + (dir ? SEQ - 1 - tt : tt);
              u32x2 w; w.x = pk2(acc[0], acc[1]); w.y = pk2(acc[2], acc[3]); *(u32x2*)(OPd + m * 1024 + vcol) = w; }
        }
        __syncthreads();
#undef SC_GLOAD
#undef SC_LWRITE
#undef SC_H2F
    }
}

enum Op { OP_SW0, OP_FO0, OP_RPA, OP_MIN, OP_RMLA, OP_QKV, OP_ATTN, OP_MWO, OP_RPB, OP_SW1, OP_FO1, OP_RPC, OP_HIN, OP_SCAN, OP_RHG, OP_HWO };
__device__ const unsigned char OPS_M[12] = {OP_SW0, OP_FO0, OP_RPA, OP_MIN, OP_RMLA, OP_QKV, OP_ATTN, OP_MWO, OP_RPB, OP_SW1, OP_FO1, OP_RPC};
__device__ const unsigned char OPS_H[11] = {OP_SW0, OP_FO0, OP_RPA, OP_HIN, OP_SCAN, OP_RHG, OP_HWO, OP_RPB, OP_SW1, OP_FO1, OP_RPC};

struct Args { const float* in[15]; float* out; unsigned char* ws; };
typedef const __attribute__((address_space(4))) Args* ArgsP;
__device__ __forceinline__ ArgsP get_args() { ArgsP p = (ArgsP)__builtin_amdgcn_kernarg_segment_ptr(); asm volatile("" : "+s"(p) :: "memory"); return p; }
#define GW_ ((int)blockIdx.x * 8 + __builtin_amdgcn_readfirstlane((int)threadIdx.x >> 6))
#define NGW_ ((int)gridDim.x * 8)
__device__ __forceinline__ int otid_() { int t = threadIdx.x; asm volatile("" : "+v"(t)); return t; }
#define LANE_ (otid_() & 63)

#ifdef DBG_CHECKS
__device__ __forceinline__ float bf2f(bf16_t v) { return __uint_as_float((unsigned)v << 16); }
__device__ __forceinline__ unsigned hash_u(unsigned x) { x ^= x >> 16; x *= 0x7feb352du; x ^= x >> 15; x *= 0x846ca68bu; x ^= x >> 16; return x; }
__device__ __forceinline__ void dbg_report(unsigned* DBG, int id, float got, float ref, float rtol, float atol) {
    const float err = fabsf(got - ref); const bool bad = !(err <= rtol * fabsf(ref) + atol);
    if (bad) atomicMax(DBG + id, 1u);
}
__device__ __forceinline__ int dbg_row(int sidx) { if (sidx == 0) return 0; if (sidx == 1) return MT - 1; if (sidx == 2) return SEQ - 1; if (sidx == 3) return SEQ; return (int)(hash_u(sidx * 2654435761u + 17u) % MT); }
#endif
#ifdef DBG_CHECKS
struct DbgCtx { const float* const* in; unsigned char* ws; unsigned char* R; unsigned* DBG; int bx, tid, lane, wave; };
__device__ __forceinline__ float dbg_dot_bf_w(const bf16_t* a, const float* W, int K, int ldw, int col) { float s = 0.f; for (int k = 0; k < K; ++k) s += bf2f(a[k]) * W[(size_t)k * ldw + col]; return s; }
template <class A>
__device__ __forceinline__ void dbg_after(int l, int op, A ap, unsigned char* ws, unsigned char* R, LAS unsigned char* lds) {
    unsigned* DBG = (unsigned*)ws;
    const int bx = blockIdx.x, tid = otid_(), lane = tid & 63, wave = __builtin_amdgcn_readfirstlane(tid >> 6);
    const bf16_t* HN = (const bf16_t*)(ws + WS_HN); const float* Y = (const float*)(ws + WS_Y);
    if (false && l == 0 && op == OP_SW0 && bx < 32) { const int sid = bx * 512 + tid, m = dbg_row(sid), c = hash_u(sid * 3 + 1) % DFF; const float* W = ap->in[3];
        const float g = dbg_dot_bf_w(HN + (size_t)m * 1024, W, 1024, 2 * DFF, c), u = dbg_dot_bf_w(HN + (size_t)m * 1024, W, 1024, 2 * DFF, DFF + c);
        dbg_report(DBG, 1, bf2f(((const bf16_t*)(R + R_ACT))[(size_t)m * DFF + c]), g / (1.f + expf(-g)) * u, 0.015f, 0.004f); }
    if (false && l == 0 && op == OP_FO0 && bx < 32) { const int sid = bx * 512 + tid, m = dbg_row(sid), c = hash_u(sid * 3 + 2) % 1024;
        const float r = dbg_dot_bf_w((const bf16_t*)(R + R_ACT) + (size_t)m * DFF, ap->in[4], DFF, 1024, c);
        dbg_report(DBG, 2, Y[(size_t)m * 1024 + c], r, 0.015f, 0.004f); }
    if (false && l == 0 && op == OP_RPA && bx < 32) { const int sid = bx * 512 + tid, m = dbg_row(sid), c = hash_u(sid * 3 + 3) % 1024; const float* g = ap->in[2];
        float s = 0.f; for (int k = 0; k < 1024; ++k) { const float y = Y[(size_t)m * 1024 + k]; s += y * y; }
        const float xr = ap->in[0][(size_t)m * 1024 + c] + 0.5f * Y[(size_t)m * 1024 + c] * rsqrtf(s / 1024.f + EPS) * g[1024 + c];
        dbg_report(DBG, 2, ap->out[(size_t)m * 1024 + c], xr, 1e-3f, 1e-3f);
        float s2 = 0.f; for (int k = 0; k < 1024; ++k) { const float x = ap->out[(size_t)m * 1024 + k]; s2 += x * x; }
        dbg_report(DBG, 2, bf2f(HN[(size_t)m * 1024 + c]), ap->out[(size_t)m * 1024 + c] * rsqrtf(s2 / 1024.f + EPS) * g[2048 + c], 0.01f, 0.01f); }
    if (false && l == 0 && op == OP_MIN && bx < 32) { const int sid = bx * 512 + tid, m = dbg_row(sid), c = hash_u(sid * 3 + 4) % 512; const int sc = src_col(2, c);
        const float r = sc >= 0 ? dbg_dot_bf_w(HN + (size_t)m * 1024, ap->in[5], 1024, 448, sc) : 0.f;
        dbg_report(DBG, 3, ((const float*)(R + R_C))[(size_t)m * 512 + c], r, 0.015f, 0.01f); }
    if (false && l == 0 && op == OP_RMLA && bx < 32) { const int sid = bx * 512 + tid, m = dbg_row(sid), c = hash_u(sid * 3 + 5) % 448; const float* C = (const float*)(R + R_C) + (size_t)m * 512;
        if (c < 256) { float s = 0.f; for (int k = 0; k < 256; ++k) s += C[k] * C[k];
            dbg_report(DBG, 3, bf2f(((const bf16_t*)(R + R_CQ))[(size_t)m * 256 + c]), C[c] * rsqrtf(s / 256.f + EPS) * ap->in[6][c], 0.01f, 0.01f); }
        else if (c < 384) { float s = 0.f; for (int k = 256; k < 384; ++k) s += C[k] * C[k];
            dbg_report(DBG, 3, bf2f(((const bf16_t*)(R + R_CKV))[(size_t)m * 128 + c - 256]), C[c] * rsqrtf(s / 128.f + EPS) * ap->in[7][c - 256], 0.01f, 0.01f); }
        else { const int jj = c - 384, i = jj >> 1; const float ang = (float)((const int*)ap->in[1])[m] * powf(10000.f, -(float)i / 32.f); const float cs = cosf(ang), sn = sinf(ang);
            const float t1 = C[384 + 2 * i], t2 = C[384 + 2 * i + 1]; const float r = (jj & 1) ? t1 * sn + t2 * cs : t1 * cs - t2 * sn;
            dbg_report(DBG, 3, bf2f(((const bf16_t*)(R + R_KR))[(size_t)m * 64 + jj]), r, 0.02f, 0.05f); } }
    if (false && l == 0 && op == OP_QKV && bx < 32) { const int sid = bx * 512 + tid, m = dbg_row(sid); const bf16_t* CQ = (const bf16_t*)(R + R_CQ) + (size_t)m * 256; const bf16_t* CKV = (const bf16_t*)(R + R_CKV) + (size_t)m * 128;
        { const int c = hash_u(sid * 3 + 6) % 1536, h = c / QKD, d = c % QKD; float r;
          if (d < 128) r = dbg_dot_bf_w(CQ, ap->in[8], 256, 1536, c);
          else { const int jj = d - 128, i = jj >> 1; const float t1 = dbg_dot_bf_w(CQ, ap->in[8], 256, 1536, h * QKD + 128 + i), t2 = dbg_dot_bf_w(CQ, ap->in[8], 256, 1536, h * QKD + 160 + i);
              const float ang = (float)((const int*)ap->in[1])[m] * powf(10000.f, -(float)i / 32.f); const float cs = cosf(ang), sn = sinf(ang); r = (jj & 1) ? t1 * sn + t2 * cs : t1 * cs - t2 * sn; }
          dbg_report(DBG, 4, bf2f(((const bf16_t*)(R + R_QB))[(size_t)m * 1536 + c]), r, 0.015f, 0.015f); }
        { const int c = hash_u(sid * 3 + 7) % 2048, h = c >> 8, d = c & 255; const float r = dbg_dot_bf_w(CKV, ap->in[9], 128, 2048, c);
          const float got = d < 128 ? bf2f(((const bf16_t*)(R + R_KN))[(size_t)m * 1024 + h * 128 + d]) : bf2f(((const bf16_t*)(R + R_VB))[(size_t)m * 1024 + h * 128 + d - 128]);
          dbg_report(DBG, 5, got, r, 0.015f, 0.015f); } }
    if (l == 0 && op == OP_ATTN) { const int sid = bx * 8 + wave, m = dbg_row(sid), h = hash_u(sid * 5 + 1) & 7, dv = hash_u(sid * 5 + 2) & 127, b = m / SEQ;
        LAS float* qs = (LAS float*)lds + wave * 192; const bf16_t* Q = (const bf16_t*)(R + R_QB) + (size_t)m * 1536 + h * QKD;
        for (int d = lane; d < 192; d += 64) qs[d] = bf2f(Q[d]);
        asm volatile("s_waitcnt lgkmcnt(0)" ::: "memory");
        float mx = -1e30f, ls = 0.f, acc = 0.f;
        for (int kk = lane; kk < SEQ; kk += 64) { const size_t km = (size_t)b * SEQ + kk; const bf16_t* Kn = (const bf16_t*)(R + R_KN) + km * 1024 + h * 128; const bf16_t* Kr = (const bf16_t*)(R + R_KR) + km * 64;
            float s = 0.f; for (int d = 0; d < 128; ++d) s += qs[d] * bf2f(Kn[d]); for (int d = 0; d < 64; ++d) s += qs[128 + d] * bf2f(Kr[d]);
            s *= 0.07216878364870322f; const float v = bf2f(((const bf16_t*)(R + R_VB))[km * 1024 + h * 128 + dv]);
            const float mn = fmaxf(mx, s), al = expf(mx - mn), p = expf(s - mn); ls = ls * al + p; acc = acc * al + p * v; mx = mn; }
        float gm = mx;
        for (int o = 1; o < 64; o <<= 1) gm = fmaxf(gm, __shfl_xor(gm, o));
        const float sc = expf(mx - gm); const float L = wave_sum(ls * sc), Asum = wave_sum(acc * sc);
        if (lane == 0) { const float got = bf2f(((const bf16_t*)(R + R_O))[(size_t)m * 1024 + h * 128 + dv]), ref = Asum / L; atomicMax(DBG + 20, __float_as_uint(fabsf(got - ref))); atomicAdd((float*)(DBG + 21), fabsf(ref) * (1.f / 2048.f)); } }
    if (false && l == 1 && op == OP_HIN && bx < 32) { const int sid = bx * 512 + tid, m = dbg_row(sid), c5 = hash_u(sid * 3 + 8) % 5120, seg = c5 >> 10, c = c5 & 1023;
        const float u = dbg_dot_bf_w(HN + (size_t)m * 1024, ap->in[11], 1024, 5120, c5); float got, r;
        if (seg == 0) { got = bf2f(((const bf16_t*)(R + R_QH))[(size_t)m * 1024 + c]); r = u / (1.f + expf(-u)); }
        else if (seg == 3) { got = bf2f(((const bf16_t*)(R + R_VH))[(size_t)m * 1024 + c]); r = u; }
        else if (seg == 4) { got = bf2f(((const bf16_t*)(R + R_GH))[(size_t)m * 1024 + c]); r = u / (1.f + expf(-u)); }
        else { const int dir = seg - 1; const float* lbp = ap->in[12] + (size_t)dir * DEPTH * 1024 + c; const float e0 = expf(lbp[0]), e1 = expf(lbp[1024]), e2 = expf(lbp[2048]), e3 = expf(lbp[3072]);
            const float lb = e1 / (e0 + e1 + e2 + e3); const h16x2 hv = __builtin_bit_cast(h16x2, (unsigned)((const unsigned short*)(R + R_KF))[(size_t)dir * MT * 1024 + (size_t)m * 1024 + c]);
            got = (float)hv[0]; r = (1.f - lb) / (1.f + expf(u)); }
        dbg_report(DBG, 7, got, r, 0.015f, 0.006f); }
    if (false && l == 1 && op == OP_SCAN) { const int sid = bx * 8 + wave, h = hash_u(sid * 5 + 3) & 7, dv = hash_u(sid * 5 + 4) & 127, b = hash_u(sid * 5 + 5) & 3, toff = sid & 31, dir = 0;
        const bf16_t* Qh = (const bf16_t*)(R + R_QH); const bf16_t* Vh = (const bf16_t*)(R + R_VH); const unsigned short* KF = (const unsigned short*)(R + R_KF); const bf16_t* OPb = (const bf16_t*)(ws + WS_Y);
        float S0 = 0.f, S1 = 0.f; const int n = toff + 1; const int t = toff; const size_t m = (size_t)b * SEQ + t;
        for (int i = 0; i < n; ++i) { const int tt = i; const size_t mm = (size_t)b * SEQ + tt; const unsigned short* kp = KF + (size_t)dir * MT * 1024 + mm * 1024 + h * 128;
            const h16x2 ka = __builtin_bit_cast(h16x2, (unsigned)kp[lane]), kb = __builtin_bit_cast(h16x2, (unsigned)kp[lane + 64]); const float k0 = (float)ka[0], k1 = (float)kb[0];
            const float v = bf2f(Vh[mm * 1024 + h * 128 + dv]); S0 = S0 * (1.f - k0) + k0 * v; S1 = S1 * (1.f - k1) + k1 * v; }
        const bf16_t* q = Qh + m * 1024 + h * 128; const float tot = wave_sum(S0 * bf2f(q[lane]) + S1 * bf2f(q[lane + 64]));
        if (lane == 0) { const float got = bf2f(OPb[(size_t)dir * MT * 1024 + m * 1024 + h * 128 + dv]); const float re = fabsf(got - tot) / (fabsf(tot) + 0.05f);
            if (re > 0.05f) { atomicMin(DBG + 20, (unsigned)toff); atomicAdd(DBG + 21, 1u); } } }
    if (false && l == 1 && op == OP_RHG && bx < 32) { const int sid = bx * 512 + tid, m = dbg_row(sid), c = hash_u(sid * 3 + 9) % 1024, h0 = c & ~127; const bf16_t* OPb = (const bf16_t*)(ws + WS_Y);
        float s = 0.f; for (int k = 0; k < 128; ++k) { const float y = bf2f(OPb[(size_t)m * 1024 + h0 + k]) + bf2f(OPb[(size_t)MT * 1024 + (size_t)m * 1024 + h0 + k]); s += y * y; }
        const float yc = bf2f(OPb[(size_t)m * 1024 + c]) + bf2f(OPb[(size_t)MT * 1024 + (size_t)m * 1024 + c]);
        const float r = yc * rsqrtf(s / 128.f + EPS) * ap->in[13][c] * bf2f(((const bf16_t*)(R + R_GH))[(size_t)m * 1024 + c]);
        dbg_report(DBG, 9, bf2f(((const bf16_t*)(R + R_HO))[(size_t)m * 1024 + c]), r, 0.02f, 0.005f); }
    if (false && l == 1 && op == OP_HWO && bx < 32) { const int sid = bx * 512 + tid, m = dbg_row(sid), c = hash_u(sid * 3 + 10) % 1024;
        const float r = dbg_dot_bf_w((const bf16_t*)(R + R_HO) + (size_t)m * 1024, ap->in[14], 1024, 1024, c);
        dbg_report(DBG, 9, Y[(size_t)m * 1024 + c], r, 0.03f, 0.01f); }
    if (false && l == 0 && op == OP_MWO && bx < 32) { const int sid = bx * 512 + tid, m = dbg_row(sid), c = hash_u(sid * 3 + 11) % 1024;
        const float r = dbg_dot_bf_w((const bf16_t*)(R + R_O) + (size_t)m * 1024, ap->in[10], 1024, 1024, c);
        dbg_report(DBG, 6, Y[(size_t)m * 1024 + c], r, 0.02f, 0.0004f); }
}
#endif

__device__ __forceinline__ void gsync() {
    asm volatile("s_waitcnt vmcnt(0) lgkmcnt(0)" ::: "memory");
    __syncthreads();
    cg::this_grid().sync();
    if (threadIdx.x == 0) { __builtin_amdgcn_fence(__ATOMIC_ACQUIRE, "agent"); asm volatile("s_waitcnt vmcnt(0)" ::: "memory"); }
    __syncthreads();
}
__global__ void __launch_bounds__(512, 2) mega_fwd(Args a_unused) {
    extern __shared__ __attribute__((aligned(16))) unsigned char lds_raw[];
    LAS unsigned char* lds = (LAS unsigned char*)lds_raw;

    {
        ArgsP ap = get_args(); unsigned char* ws = ap->ws;
#ifdef DBG_CHECKS
        if (blockIdx.x == 0 && threadIdx.x < 32) atomicExch((unsigned*)ws + threadIdx.x, 0u);
#endif
        const int tid = threadIdx.x, lane = tid & 63, wave = __builtin_amdgcn_readfirstlane(tid >> 6), G = gridDim.x, bx = blockIdx.x, gw = bx * 8 + wave, NGW = G * 8;
        LAS float* scr = (LAS float*)(lds + wave * 16384);
        constexpr int I_FFI = 16 * 176, I_FFO = 44 * 32, I_HIN = 16 * 160, I_SQ = 16 * 32, I_MIN = 16 * 16, I_UQ = 4 * 48, I_UKV = 2 * 64;
        constexpr int NITEMS = 8 * I_FFI + 8 * I_FFO + 2 * I_HIN + 2 * I_SQ + 2 * I_MIN + 2 * I_UQ + 2 * I_UKV + 2 * I_SQ;
        for (int it = gw; it < NITEMS; it += NGW) {
            int r = it;
#define XP(IDX_, K_, NS_, ND_, MODE_, WSOFF_, NMAT_, IPM_) if (r < (NMAT_) * (IPM_)) { const int mat = r / (IPM_); \
            xpose_item(ap->in[IDX_] + (size_t)mat * (K_) * (NS_), K_, NS_, ND_, MODE_, (bf16_t*)(ws + (WSOFF_)) + (size_t)mat * (ND_) * (K_), scr, r % (IPM_), lane); continue; } r -= (NMAT_) * (IPM_);
            XP(3, 1024, 2 * DFF, 2 * DFF, 1, WS_WFFI, 8, I_FFI)
            XP(4, DFF, 1024, 1024, 0, WS_WFFO, 8, I_FFO)
            XP(11, 1024, 5120, 5120, 0, WS_WHIN, 2, I_HIN)
            XP(14, 1024, 1024, 1024, 0, WS_WHO, 2, I_SQ)
            XP(5, 1024, 448, 512, 2, WS_WMIN, 2, I_MIN)
            XP(8, 256, 1536, 1536, 3, WS_WUQ, 2, I_UQ)
            XP(9, 128, 2048, 2048, 0, WS_WUKV, 2, I_UKV)
            XP(10, 1024, 1024, 1024, 0, WS_WMO, 2, I_SQ)
#undef XP
        }
        { const int* positions = (const int*)ap->in[1]; float* COS = (float*)(ws + WS_COS); float* SIN = (float*)(ws + WS_SIN);
          for (int idx = bx * 512 + tid; idx < MT * 32; idx += G * 512) { const int m = idx >> 5, i = idx & 31;
            const double ang = (double)positions[m] * ROPE_INVF[i]; const double rev = ang * 0.15915494309189535; const float fr = (float)(rev - __builtin_rint(rev));
            COS[idx] = __builtin_amdgcn_cosf(fr); SIN[idx] = __builtin_amdgcn_sinf(fr); } }
        { float* LB = (float*)(ws + WS_LB);
          for (int idx = bx * 512 + tid; idx < 2 * 2 * 1024; idx += G * 512) { const int c = idx & 1023, dir = (idx >> 10) & 1, j = idx >> 11, l = 2 * j + 1;
            const float* lbp = ap->in[12] + (size_t)dir * DEPTH * 1024 + c; float v[4], mx = -1e30f;
#pragma unroll
            for (int i = 0; i < 4; ++i) { v[i] = lbp[i * 1024]; mx = fmaxf(mx, v[i]); }
            float den = 0.f, num = 0.f;
#pragma unroll
            for (int i = 0; i < 4; ++i) { const float e = __expf(v[i] - mx); den += e; if (i >= 1 && i <= l) num += e; }
            LB[idx] = num / den; } }
        { const float* x_in = ap->in[0]; float* X = ap->out; bf16_t* HN = (bf16_t*)(ws + WS_HN); const float* gains = ap->in[2];
          for (int m = gw; m < MT; m += NGW) row_init(x_in + (size_t)m * DM, X + (size_t)m * DM, HN + (size_t)m * DM, gains, lane); }
    }
    gsync();

    for (int ph = 0; ph < 46; ++ph) {
        const int l = ph >= 35 ? 3 : (ph >= 23 ? 2 : (ph >= 12 ? 1 : 0)), s = ph - (l == 3 ? 35 : (l == 2 ? 23 : (l == 1 ? 12 : 0)));
        const bool hg = l & 1; const int j = l >> 1;
        const int op = hg ? OPS_H[s] : OPS_M[s];
        ArgsP ap = get_args(); unsigned char* ws = ap->ws; unsigned char* R = ws + WS_R;
        int G_ = gridDim.x, bx_ = blockIdx.x; asm volatile("" : "+s"(G_), "+s"(bx_));
        switch (op) {
        case OP_SW0: case OP_SW1: {
            const int half = op == OP_SW1;
            pg8::Gemm gm{(const bf16_t*)(ws + WS_HN), (const bf16_t*)(ws + WS_WFFI) + (size_t)(l * 2 + half) * (2 * DFF) * 1024, MT, 2 * DFF, 1024};
            pg8::StaticOrder S; S.init(MT, 2 * DFF, G_, bx_); EpiSwiglu E{(bf16_t*)(R + R_ACT)};
#ifndef NO_SW
            pg8::gemm_phase<EpiSwiglu, pg8::StaticOrder, true, true>(lds, gm, S, E);
#endif
        } break;
        case OP_FO0: case OP_FO1: case OP_MIN: case OP_MWO: case OP_HWO: {
            pg8::Gemm gm; EpiF32 E; float* Y = (float*)(ws + WS_Y);
            if (op == OP_FO0 || op == OP_FO1) { const int half = op == OP_FO1; gm = pg8::Gemm{(const bf16_t*)(R + R_ACT), (const bf16_t*)(ws + WS_WFFO) + (size_t)(l * 2 + half) * 1024 * DFF, MT, 1024, DFF}; E = EpiF32{Y, 1024}; }
            else if (op == OP_MIN) { gm = pg8::Gemm{(const bf16_t*)(ws + WS_HN), (const bf16_t*)(ws + WS_WMIN) + (size_t)j * 512 * 1024, MT, 512, 1024}; E = EpiF32{(float*)(R + R_C), 512}; }
            else if (op == OP_MWO) { gm = pg8::Gemm{(const bf16_t*)(R + R_O), (const bf16_t*)(ws + WS_WMO) + (size_t)j * 1024 * 1024, MT, 1024, 1024}; E = EpiF32{Y, 1024}; }
            else { gm = pg8::Gemm{(const bf16_t*)(R + R_HO), (const bf16_t*)(ws + WS_WHO) + (size_t)j * 1024 * 1024, MT, 1024, 1024}; E = EpiF32{Y, 1024}; }
            pg8::StaticOrder S; S.init(MT, gm.N, G_, bx_);
#ifndef NO_F32
            pg8::gemm_phase<EpiF32, pg8::StaticOrder, true, true>(lds, gm, S, E);
#endif
        } break;
        case OP_RPA: case OP_RPB: case OP_RPC: {
            const float* gains = ap->in[2]; const float* g = gains + (size_t)l * 6 * DM; float* Y = (float*)(ws + WS_Y); float* X = ap->out; bf16_t* HN = (bf16_t*)(ws + WS_HN);
            const int k = op == OP_RPA ? 1 : (op == OP_RPB ? 3 : 5); const float scale = op == OP_RPB ? 1.0f : 0.5f;
            const bool last = (op == OP_RPC) && (l == DEPTH - 1);
            const float* gn = op == OP_RPC ? gains + (size_t)(l + 1) * 6 * DM : g + (size_t)(k + 1) * DM;
            const int lane = LANE_;
            for (int m = bx_ * 8 + __builtin_amdgcn_readfirstlane(otid_() >> 6); m < MT; m += G_ * 8) row_post(Y + (size_t)m * DM, X + (size_t)m * DM, last ? (bf16_t*)nullptr : HN + (size_t)m * DM, scale, g + (size_t)k * DM, last ? g : gn, lane);
        } break;
        case OP_RMLA: {
            const float* qn = ap->in[6] + (size_t)j * QLR; const float* kvn = ap->in[7] + (size_t)j * KVLR; const float* COS = (const float*)(ws + WS_COS); const float* SIN = (const float*)(ws + WS_SIN);
            const int lane = LANE_;
            for (int m = bx_ * 8 + __builtin_amdgcn_readfirstlane(otid_() >> 6); m < MT; m += G_ * 8) row_mla((const float*)(R + R_C) + (size_t)m * 512, (bf16_t*)(R + R_CQ) + (size_t)m * 256, (bf16_t*)(R + R_CKV) + (size_t)m * 128, (bf16_t*)(R + R_KR) + (size_t)m * 64,
                                                         qn, kvn, COS + (size_t)m * 32, SIN + (size_t)m * 32, lane);
        } break;
        case OP_QKV: {
            { int Kq = 256; asm volatile("" : "+s"(Kq)); pg8::Gemm gm{(const bf16_t*)(R + R_CQ), (const bf16_t*)(ws + WS_WUQ) + (size_t)j * 1536 * 256, MT, 1536, Kq};
              pg8::StaticOrder S; S.init(MT, 1536, G_, bx_); EpiQ E{(bf16_t*)(R + R_QB), (const float*)(ws + WS_COS), (const float*)(ws + WS_SIN)};
#ifndef NO_Q
              pg8::gemm_phase<EpiQ, pg8::StaticOrder, true, true>(lds, gm, S, E);
#endif
            }
            __syncthreads();
            { int Kq = 128; asm volatile("" : "+s"(Kq)); pg8::Gemm gm{(const bf16_t*)(R + R_CKV), (const bf16_t*)(ws + WS_WUKV) + (size_t)j * 2048 * 128, MT, 2048, Kq};
              pg8::StaticOrder S; S.init(MT, 2048, G_, bx_); EpiKV E{(bf16_t*)(R + R_KN), (bf16_t*)(R + R_VB)};
#ifndef NO_KV
              pg8::gemm_phase<EpiKV, pg8::StaticOrder, true, true>(lds, gm, S, E);
#endif
            }
        } break;
        case OP_ATTN: {
#ifndef NO_ATTN
            const int G = G_, bx = bx_;
            const int vcu = (G % 8 == 0) ? (bx % 8) * (G / 8) + bx / 8 : bx;
            for (int uid = vcu; uid < BATCH * NH * (SEQ / 256); uid += G) {
                const int bh = uid >> 5, qb = uid & 31, b = bh >> 3, h = bh & 7;
                const size_t row0 = (size_t)b * SEQ;
                att::attn_unit((const att::bf16*)(R + R_QB) + (row0 + qb * 256) * 1536 + h * QKD, (const att::bf16*)(R + R_KN) + row0 * 1024 + h * 128,
                               (const att::bf16*)(R + R_KR) + row0 * 64, (const att::bf16*)(R + R_VB) + row0 * 1024 + h * 128,
                               (att::bf16*)(R + R_O) + (row0 + qb * 256) * 1024 + h * 128, SEQ, (char*)lds_raw);
            }
#endif
        } break;
        case OP_HIN: {
            pg8::Gemm gm{(const bf16_t*)(ws + WS_HN), (const bf16_t*)(ws + WS_WHIN) + (size_t)j * 5120 * 1024, MT, 5120, 1024};
            pg8::StaticOrder S; S.init(MT, 5120, G_, bx_);
            EpiHgrn E{(bf16_t*)(R + R_QH), (bf16_t*)(R + R_VH), (bf16_t*)(R + R_GH), (unsigned short*)(R + R_KF), (const float*)(ws + WS_LB) + (size_t)j * 2048};
#ifndef NO_HG
            pg8::gemm_phase<EpiHgrn, pg8::StaticOrder, true, true>(lds, gm, S, E);
#endif
        } break;
        case OP_SCAN: {
#ifndef NO_SCAN
            scan_phase(lds, (const bf16_t*)(R + R_QH), (const bf16_t*)(R + R_VH), (const unsigned short*)(R + R_KF), (bf16_t*)(ws + WS_Y), G_, bx_);
#endif
        } break;
        case OP_RHG: {
            const float* on = ap->in[13] + (size_t)j * DM; const bf16_t* Y = (const bf16_t*)(ws + WS_Y);
            const int lane = LANE_;
            for (int m = bx_ * 8 + __builtin_amdgcn_readfirstlane(otid_() >> 6); m < MT; m += G_ * 8) row_hgrn(Y + (size_t)m * DM, (const bf16_t*)(R + R_GH) + (size_t)m * DM, (bf16_t*)(R + R_HO) + (size_t)m * DM, on, lane);
        } break;
        default: break;
        }
        if (ph != 45) gsync();
#ifdef DBG_CHECKS
        { ArgsP ap2 = get_args(); dbg_after(l, op, ap2, ap2->ws, ap2->ws + WS_R, lds); gsync(); }
#endif
    }
#ifdef DBG_CHECKS
    gsync();
    if (blockIdx.x == 0 && threadIdx.x == 0) { ArgsP ap = get_args(); unsigned* DBG = (unsigned*)ap->ws; const float mx = __uint_as_float(atomicAdd(DBG + 20, 0u)), mean = atomicAdd((float*)(DBG + 21), 0.f); ap->out[1024 * 16] += 1e6f * mx; ap->out[1024 * 16 + 1] += 1e4f * mean; }
#endif
}

extern "C" void kernel_launch(void* const* d_in, const int* in_sizes, int n_in, void* d_out, int out_size, void* d_ws, size_t ws_size, hipStream_t stream) {
    static int grid = 0;
    if (grid == 0) {
        if (n_in != 15 || out_size != MT * DM || ws_size < WS_END) { fprintf(stderr, "kernel_launch: unexpected shapes: n_in %d out %d ws %zu (need %zu)\n", n_in, out_size, ws_size, (size_t)WS_END); grid = -1; return; }
        int dev = 0, cus = 0, per_cu = 0;
        (void)hipGetDevice(&dev); (void)hipDeviceGetAttribute(&cus, hipDeviceAttributeMultiprocessorCount, dev);
        if (hipFuncSetAttribute((const void*)mega_fwd, hipFuncAttributeMaxDynamicSharedMemorySize, LDS_BYTES) != hipSuccess) { fprintf(stderr, "kernel_launch: hipFuncSetAttribute failed\n"); grid = -1; return; }
        if (hipOccupancyMaxActiveBlocksPerMultiprocessor(&per_cu, (const void*)mega_fwd, 512, LDS_BYTES) != hipSuccess || per_cu < 1) { fprintf(stderr, "kernel_launch: occupancy query gave %d\n", per_cu); per_cu = 1; }
        (void)hipGetLastError();
        grid = cus * 1;
        fprintf(stderr, "kernel_launch: cus %d per_cu %d grid %d\n", cus, per_cu, grid);
    }
    if (grid < 0) return;
    Args a{};
    for (int i = 0; i < 15; ++i) a.in[i] = (const float*)d_in[i];
    a.out = (float*)d_out; a.ws = (unsigned char*)d_ws;
    void* args[] = {&a};
    hipError_t e = hipLaunchCooperativeKernel((const void*)mega_fwd, dim3(grid), dim3(512), args, LDS_BYTES, stream);
    if (e != hipSuccess) fprintf(stderr, "cooperative launch failed: %s (grid %d)\n", hipGetErrorString(e), grid);
}
```

```cpp
#include <hip/hip_runtime.h>
#include <hip/hip_cooperative_groups.h>
#include <hip/hip_bf16.h>
#include <hip/hip_fp16.h>
#include <cstdio>
#include <cstdint>
#include <cmath>
namespace cg = cooperative_groups;
namespace pg8 {
#define PG8_LAS __attribute__((address_space(3)))
typedef unsigned short bf16_t;
typedef short bf16x8 __attribute__((ext_vector_type(8)));
typedef float f32x4 __attribute__((ext_vector_type(4)));
typedef unsigned u32x4 __attribute__((ext_vector_type(4)));
constexpr int BM = 256, BK = 64, HALF = 128, HTB = HALF * BK * 2  , STAGE_BYTES = 8 * HTB, NXCD = 8, WGM = 8;

__host__ __device__ __forceinline__ int lds_byte(int r, int c) { const int st = (r >> 4) * 2 + (c >> 5), rr = r & 15, cc = c & 31, ob = rr * 64 + cc * 2; return st * 1024 + (ob ^ (((ob >> 9) & 1) << 5)); }
__host__ __device__ __forceinline__ void stage_rc(int b, int& R, int& C) { const int st = b / 1024, sb = b % 1024, swz = sb ^ (((sb >> 9) & 1) << 5); R = (st >> 1) * 16 + swz / 64; C = (st & 1) * 32 + (swz % 64) / 2; }
__host__ __device__ __forceinline__ int perm32(int rho) { const int n = rho >> 4, i = rho & 15; return 8 * (i >> 2) + 4 * n + (i & 3); }

struct Unit { int pm, pn; };
struct Gemm { const bf16_t* A; const bf16_t* Bt; int M, N, K; };

struct StaticOrder {
    int nM, nN, nwg, G, c;
    __host__ __device__ void init(int M, int N, int G_, int c_) { nM = M / BM; nN = N / BM; nwg = nM * nN; G = G_; c = c_; }
    __host__ __device__ bool next(int i, Unit& u) const {
        const long L = (long)i * G + c; if (L >= nwg) return false;
        int wgid = (int)L; { const int q = nwg / NXCD, r = nwg % NXCD, xcd = wgid % NXCD, off = wgid / NXCD; wgid = (xcd < r ? xcd * (q + 1) : r * (q + 1) + (xcd - r) * q) + off; }
        const int nig = WGM * nN, gid = wgid / nig, fm = gid * WGM, gsz = (nM - fm) < WGM ? (nM - fm) : WGM;
        u.pm = fm + ((wgid % nig) % gsz); u.pn = (wgid % nig) / gsz; return true;
    }
    __device__ __forceinline__ void a_ready(const Unit&) const {}
    __device__ __forceinline__ void done(const Unit&) const {}
};

__device__ __forceinline__ unsigned cvt_pk_bf16(float lo, float hi) { unsigned r; asm volatile("v_cvt_pk_bf16_f32 %0, %1, %2" : "=v"(r) : "v"(lo), "v"(hi)); return r; }
template <class Epi, class Sched, bool ALIGN_EPI = false, bool SP2 = false>
__device__ __forceinline__ void gemm_phase(PG8_LAS unsigned char* lds, const Gemm g, const Sched& S, const Epi& E) {
    int tid = threadIdx.x; asm volatile("" : "+v"(tid)); const int wid = __builtin_amdgcn_readfirstlane(tid >> 6), lane = tid & 63, wr = wid >> 2, wc = wid & 3, fr = lane & 15, fq = lane >> 4;
    const int K = g.K, nt = K / BK;
    unsigned voffA[2], voffB[2];
#pragma unroll
    for (int i = 0; i < 2; ++i) { int R, C; stage_rc(tid * 16 + i * 8192, R, C); const int Rb = Epi::PERM ? ((R & ~31) + perm32(R & 31)) : R;
        voffA[i] = (unsigned)(R * K + C) * 2u; voffB[i] = (unsigned)(Rb * K + C) * 2u; }
    const size_t kstep = (size_t)(BK * 2);
    const size_t hstep = (size_t)HALF * K * 2;
    const size_t tstep = 2 * hstep;
    const unsigned ldsw = (unsigned)wid * 1024u;
    const int aoff = lds_byte(wr * 64 + fr, fq * 8), boff = lds_byte(wc * 32 + fr, fq * 8);
#define PG8_SA(b, h) (((b) * 2 + (h)) * HTB)
#define PG8_SB(b, h) ((4 + (b) * 2 + (h)) * HTB)
#define PG8_STAGE(bufoff, gbase, voff) do { _Pragma("unroll") for (int _i = 0; _i < 2; ++_i) \
        __builtin_amdgcn_global_load_lds((const unsigned*)((const char*)(gbase) + (voff)[_i]), (PG8_LAS unsigned*)(lds + (bufoff) + ldsw + _i * 8192), 16, 0, 0); } while (0)
#define PG8_LDA(dst, b, h) do { _Pragma("unroll") for (int m = 0; m < 4; ++m) _Pragma("unroll") for (int k = 0; k < 2; ++k) dst[m][k] = *(const PG8_LAS bf16x8*)(lds + PG8_SA(b, h) + aoff + m * 2048 + k * 1024); } while (0)
#define PG8_LDB(dst, b, h) do { _Pragma("unroll") for (int n = 0; n < 2; ++n) _Pragma("unroll") for (int k = 0; k < 2; ++k) dst[n][k] = *(const PG8_LAS bf16x8*)(lds + PG8_SB(b, h) + boff + n * 2048 + k * 1024); } while (0)
#define PG8_MMA(ai, bj, At, Bt) do { __builtin_amdgcn_s_setprio(1); _Pragma("unroll") for (int m = 0; m < 4; ++m) _Pragma("unroll") for (int n = 0; n < 2; ++n) _Pragma("unroll") for (int k = 0; k < 2; ++k) \
        acc[ai][bj][m][n] = __builtin_amdgcn_mfma_f32_16x16x32_bf16(Bt[n][k], At[m][k], acc[ai][bj][m][n], 0, 0, 0); __builtin_amdgcn_s_setprio(0); } while (0)
#define PG8_WAIT_V(n) asm volatile("s_waitcnt vmcnt(" #n ")" ::: "memory")
#define PG8_WAIT_L(n) asm volatile("s_waitcnt lgkmcnt(" #n ")" ::: "memory")
#define PG8_BAR __builtin_amdgcn_s_barrier()
#define PG8_SCHED __builtin_amdgcn_sched_barrier(0)
    Unit cur, nxt; int ui = 0;
    if (!S.next(0, cur)) return;
    f32x4 acc[2][2][4][2];
#pragma unroll
    for (int a = 0; a < 2; ++a)
#pragma unroll
        for (int b = 0; b < 2; ++b)
#pragma unroll
            for (int m = 0; m < 4; ++m)
#pragma unroll
                for (int n = 0; n < 2; ++n) acc[a][b][m][n] = (f32x4){0.f, 0.f, 0.f, 0.f};
    bf16x8 At[4][2], B0[2][2], B1[2][2];
    const char* cA = (const char*)g.A + (size_t)cur.pm * tstep; const char* cB = (const char*)g.Bt + (size_t)cur.pn * tstep;
    S.a_ready(cur);
    if constexpr (SP2) {
        PG8_STAGE(PG8_SB(0, 0), cB, voffB); PG8_STAGE(PG8_SB(0, 1), cB + hstep, voffB); PG8_STAGE(PG8_SA(0, 0), cA, voffA); PG8_STAGE(PG8_SA(0, 1), cA + hstep, voffA);
        if (wr == 1) PG8_BAR;
        PG8_WAIT_V(2); PG8_BAR;
        PG8_STAGE(PG8_SB(1, 0), cB + kstep, voffB); PG8_STAGE(PG8_SA(1, 0), cA + kstep, voffA); PG8_STAGE(PG8_SB(1, 1), cB + hstep + kstep, voffB);
        PG8_WAIT_V(6); PG8_BAR;
    } else {
        PG8_STAGE(PG8_SB(0, 0), cB, voffB); PG8_STAGE(PG8_SA(0, 0), cA, voffA); PG8_STAGE(PG8_SB(0, 1), cB + hstep, voffB); PG8_STAGE(PG8_SA(0, 1), cA + hstep, voffA);
        if (wr == 1) PG8_BAR;
        PG8_WAIT_V(4); PG8_BAR;
        PG8_STAGE(PG8_SB(1, 0), cB + kstep, voffB); PG8_STAGE(PG8_SA(1, 0), cA + kstep, voffA); PG8_STAGE(PG8_SB(1, 1), cB + hstep + kstep, voffB);
        PG8_WAIT_V(6); PG8_BAR;
    }
    for (;;) {
        const bool has_next = S.next(ui + 1, nxt);
        const char* nA = has_next ? (const char*)g.A + (size_t)nxt.pm * tstep : cA; const char* nB = has_next ? (const char*)g.Bt + (size_t)nxt.pn * tstep : cB;
        for (int t = 0; t < nt; t += 2) {
            const bool last = (t == nt - 2);
            const char* a1 = cA + (size_t)(t + 1) * kstep;
            const char* a2 = last ? nA : cA + (size_t)(t + 2) * kstep; const char* b2 = last ? nB : cB + (size_t)(t + 2) * kstep;
            const char* a3 = a2 + kstep; const char* b3 = b2 + kstep;
            if (last && has_next) S.a_ready(nxt);
            if constexpr (SP2) {
            PG8_LDB(B0, 0, 0); PG8_LDB(B1, 0, 1); PG8_SCHED; PG8_LDA(At, 0, 0); PG8_STAGE(PG8_SA(1, 1), a1 + hstep, voffA);
            PG8_WAIT_V(8); PG8_WAIT_L(0); PG8_BAR; PG8_MMA(0, 0, At, B0); PG8_MMA(0, 1, At, B1); PG8_BAR; PG8_SCHED;
            PG8_LDA(At, 0, 1); PG8_STAGE(PG8_SB(0, 0), b2, voffB); PG8_STAGE(PG8_SB(0, 1), b2 + hstep, voffB); PG8_STAGE(PG8_SA(0, 0), a2, voffA);
            PG8_WAIT_V(8); PG8_WAIT_L(0); PG8_BAR; PG8_MMA(1, 0, At, B0); PG8_MMA(1, 1, At, B1); PG8_BAR; PG8_SCHED;
            PG8_LDB(B0, 1, 0); PG8_LDB(B1, 1, 1); PG8_SCHED; PG8_LDA(At, 1, 0); PG8_STAGE(PG8_SA(0, 1), a2 + hstep, voffA);
            PG8_WAIT_V(8); PG8_WAIT_L(0); PG8_BAR; PG8_MMA(0, 0, At, B0); PG8_MMA(0, 1, At, B1); PG8_BAR; PG8_SCHED;
            PG8_LDA(At, 1, 1); PG8_STAGE(PG8_SB(1, 0), b3, voffB); PG8_STAGE(PG8_SB(1, 1), b3 + hstep, voffB); PG8_STAGE(PG8_SA(1, 0), a3, voffA);
            PG8_WAIT_V(8); PG8_WAIT_L(0); PG8_BAR; PG8_MMA(1, 0, At, B0); PG8_MMA(1, 1, At, B1); PG8_BAR; PG8_SCHED;
            } else {
            PG8_LDB(B0, 0, 0); PG8_SCHED; PG8_LDA(At, 0, 0); PG8_STAGE(PG8_SA(1, 1), a1 + hstep, voffA);
            PG8_WAIT_L(8); PG8_BAR; PG8_WAIT_L(0); PG8_MMA(0, 0, At, B0); PG8_BAR; PG8_SCHED;
            PG8_LDB(B1, 0, 1); PG8_STAGE(PG8_SB(0, 0), b2, voffB);
            PG8_BAR; PG8_WAIT_L(0); PG8_MMA(0, 1, At, B1); PG8_BAR;
            PG8_LDA(At, 0, 1); PG8_STAGE(PG8_SA(0, 0), a2, voffA);
            PG8_BAR; PG8_WAIT_L(0); PG8_MMA(1, 0, At, B0); PG8_BAR; PG8_SCHED;
            PG8_STAGE(PG8_SB(0, 1), b2 + hstep, voffB);
            PG8_WAIT_V(6); PG8_BAR; PG8_MMA(1, 1, At, B1); PG8_BAR;
            PG8_LDB(B0, 1, 0); PG8_SCHED; PG8_LDA(At, 1, 0); PG8_STAGE(PG8_SA(0, 1), a2 + hstep, voffA);
            PG8_WAIT_L(8); PG8_BAR; PG8_WAIT_L(0); PG8_MMA(0, 0, At, B0); PG8_BAR; PG8_SCHED;
            PG8_LDB(B1, 1, 1); PG8_STAGE(PG8_SB(1, 0), b3, voffB);
            PG8_BAR; PG8_WAIT_L(0); PG8_MMA(0, 1, At, B1); PG8_BAR;
            PG8_LDA(At, 1, 1); PG8_STAGE(PG8_SA(1, 0), a3, voffA);
            PG8_BAR; PG8_WAIT_L(0); PG8_MMA(1, 0, At, B0); PG8_BAR; PG8_SCHED;
            PG8_STAGE(PG8_SB(1, 1), b3 + hstep, voffB);
            PG8_WAIT_V(6); PG8_BAR; PG8_MMA(1, 1, At, B1); PG8_BAR;
            }
        }
        if constexpr (ALIGN_EPI) { if (wr == 0) PG8_BAR; }
        if constexpr (!Epi::AFTER_DRAIN) { E(acc, cur, wr, wc, fr, fq); S.done(cur); }
        if (!has_next) break;
#pragma unroll
        for (int a = 0; a < 2; ++a)
#pragma unroll
            for (int b = 0; b < 2; ++b)
#pragma unroll
                for (int m = 0; m < 4; ++m)
#pragma unroll
                    for (int n = 0; n < 2; ++n) acc[a][b][m][n] = (f32x4){0.f, 0.f, 0.f, 0.f};
        cur = nxt; cA = nA; cB = nB; ++ui;
        if constexpr (ALIGN_EPI) { if (wr == 1) PG8_BAR; }
    }
    PG8_WAIT_V(0);
    if constexpr (!ALIGN_EPI) { if (wr == 0) PG8_BAR; }
    PG8_BAR;
    if constexpr (Epi::AFTER_DRAIN) { E.fused(acc, cur, wr, wc, fr, fq, lds, wid, lane); S.done(cur); }
#undef PG8_SA
#undef PG8_SB
#undef PG8_STAGE
#undef PG8_LDA
#undef PG8_LDB
#undef PG8_MMA
#undef PG8_WAIT_V
#undef PG8_WAIT_L
#undef PG8_BAR
#undef PG8_SCHED
}
}
#ifndef ATT_SDEPTH
#define ATT_SDEPTH 1
#endif
namespace att {
using bf16 = __hip_bfloat16;
constexpr int NW = 8, QBLK = 32, KVBLK = 64;
constexpr float SCALE = 0.07216878364870322f;
constexpr float THR = 8.f;
__device__ __forceinline__ int otid() { int t = threadIdx.x; asm volatile("" : "+v"(t)); return t; }
using bf16x8 = __attribute__((ext_vector_type(8))) short;
using s16x4  = __attribute__((ext_vector_type(4))) short;
using f32x16 = __attribute__((ext_vector_type(16))) float;
using f32x8  = __attribute__((ext_vector_type(8))) float;
using u32x4  = __attribute__((ext_vector_type(4))) unsigned;
#define KSWZ(row, colB) ((row) * 256 + ((colB) ^ (((row) & 7) << 4)))
#define SBAR() __builtin_amdgcn_sched_barrier(0)
__device__ __forceinline__ int crow(int r, int hi) { return (r & 3) + 8 * (r >> 2) + 4 * hi; }
__device__ __forceinline__ unsigned cvtpk(float lo, float hi) {
  unsigned r; asm volatile("v_cvt_pk_bf16_f32 %0, %1, %2" : "=v"(r) : "v"(lo), "v"(hi)); return r;
}
template <typename TIn> struct Stage;
template <> struct Stage<bf16>  { using T = bf16x8;
  __device__ static __forceinline__ T ld8(const bf16* p) { return *reinterpret_cast<const bf16x8*>(p); }
  __device__ static __forceinline__ bf16x8 tobf(T x) { return x; } };
template <> struct Stage<float> { using T = f32x8;
  __device__ static __forceinline__ T ld8(const float* p) { return *reinterpret_cast<const f32x8*>(p); }
  __device__ static __forceinline__ bf16x8 tobf(T x) {
    u32x4 w = {cvtpk(x[0], x[1]), cvtpk(x[2], x[3]), cvtpk(x[4], x[5]), cvtpk(x[6], x[7])}; return *reinterpret_cast<bf16x8*>(&w); } };

__device__ __forceinline__ void partialSM(f32x16& p0, f32x16& p1, float& m_reg, float& mn, float& alpha) {
  constexpr float C = SCALE * 1.4426950408889634f;
  float pmax = p0[0]; for (int r = 1; r < 16; ++r) pmax = fmaxf(pmax, p0[r]); for (int r = 0; r < 16; ++r) pmax = fmaxf(pmax, p1[r]);
  { auto rr = __builtin_amdgcn_permlane32_swap(__float_as_uint(pmax), __float_as_uint(pmax), false, false);
    pmax = fmaxf(__uint_as_float(rr[0]), __uint_as_float(rr[1])); }
  if (__builtin_expect(__all(pmax - m_reg <= THR / SCALE), 1)) { mn = m_reg; alpha = 1.f; }
  else { mn = fmaxf(m_reg, pmax); alpha = __builtin_amdgcn_exp2f((m_reg - mn) * C); m_reg = mn; }
  float mnC = -mn * C;
  for (int r = 0; r < 16; ++r) p0[r] = fmaf(p0[r], C, mnC); for (int r = 0; r < 16; ++r) p1[r] = fmaf(p1[r], C, mnC);
  for (int r = 0; r < 16; ++r) p0[r] = __builtin_amdgcn_exp2f(p0[r]);
}
__device__ __forceinline__ void finishSM(f32x16& p0, f32x16& p1, float alpha, float& l_reg, bf16x8& pa0, bf16x8& pa1, bf16x8& pa2, bf16x8& pa3) {
  for (int r = 0; r < 16; ++r) p1[r] = __builtin_amdgcn_exp2f(p1[r]);
  float ps = 0; for (int r = 0; r < 16; ++r) ps += p0[r]; for (int r = 0; r < 16; ++r) ps += p1[r];
  { auto rr = __builtin_amdgcn_permlane32_swap(__float_as_uint(ps), __float_as_uint(ps), false, false);
    ps = __uint_as_float(rr[0]) + __uint_as_float(rr[1]); }
  l_reg = l_reg * alpha + ps;
#define PK4(P, BASE, OUT) do { unsigned a0 = cvtpk(P[BASE + 0], P[BASE + 1]), a1 = cvtpk(P[BASE + 2], P[BASE + 3]);   \
    unsigned b0 = cvtpk(P[BASE + 4], P[BASE + 5]), b1 = cvtpk(P[BASE + 6], P[BASE + 7]);                              \
    auto r0 = __builtin_amdgcn_permlane32_swap(a0, b0, false, false); auto r1 = __builtin_amdgcn_permlane32_swap(a1, b1, false, false); \
    u32x4 w = {r0[0], r1[0], r0[1], r1[1]}; OUT = *reinterpret_cast<bf16x8*>(&w); } while (0)
  PK4(p0, 0, pa0); PK4(p0, 8, pa1); PK4(p1, 0, pa2); PK4(p1, 8, pa3);
#undef PK4
}
#define KSWZ2(row, colB) ((row) * 128 + ((colB) ^ (((row) & 7) << 4)))
__device__ __forceinline__ void qkt(f32x16& p0, f32x16& p1, const bf16* Ks, const bf16* KRs, const bf16x8* qr, const bf16x8* qrl, int r32, int hi) {
  p0 = f32x16{}; p1 = f32x16{};
#pragma unroll
  for (int d0 = 0; d0 < 8; ++d0) { int cb = (d0 * 16 + hi * 8) * 2;
    bf16x8 b0 = *reinterpret_cast<const bf16x8*>((const char*)Ks + KSWZ(r32, cb));
    bf16x8 b1 = *reinterpret_cast<const bf16x8*>((const char*)Ks + KSWZ(32 + r32, cb));
    p0 = __builtin_amdgcn_mfma_f32_32x32x16_bf16(b0, qr[d0], p0, 0, 0, 0);
    p1 = __builtin_amdgcn_mfma_f32_32x32x16_bf16(b1, qr[d0], p1, 0, 0, 0); }
#pragma unroll
  for (int d0 = 0; d0 < 4; ++d0) { int cb = (d0 * 16 + hi * 8) * 2;
    bf16x8 b0 = *reinterpret_cast<const bf16x8*>((const char*)KRs + KSWZ2(r32, cb));
    bf16x8 b1 = *reinterpret_cast<const bf16x8*>((const char*)KRs + KSWZ2(32 + r32, cb));
    const bf16x8 qv = qrl[d0 * 64];
    p0 = __builtin_amdgcn_mfma_f32_32x32x16_bf16(b0, qv, p0, 0, 0, 0);
    p1 = __builtin_amdgcn_mfma_f32_32x32x16_bf16(b1, qv, p1, 0, 0, 0); }
}
__device__ __forceinline__ int v_st(int k, int c) { const int kk = (k & ~0xC) | ((k & 4) << 1) | ((k & 8) >> 1); return ((kk >> 3) * 4 + (c >> 5)) * 512 + ((kk & 7) * 32 + (c & 31)) * 2; }
__device__ __forceinline__ int v_rd_base(int lane) { return ((lane & 3) << 3) | (((lane >> 2) & 3) << 6) | (((lane >> 4) & 1) << 5) | (((lane >> 5) & 1) << 8); }
constexpr int v_rd_off(int d0, int ks, int half) { return d0 * 512 + ks * 4096 + half * 2048; }
template <int OFF> __device__ __forceinline__ s16x4 tr_read(int vb) {
  s16x4 r; asm volatile("ds_read_b64_tr_b16 %0, %1 offset:%2" : "=&v"(r) : "v"(vb), "i"(OFF) : "memory"); return r;
}
template <int D0> __device__ __forceinline__ void pv_one(f32x16& od, int vb, bf16x8 pa0, bf16x8 pa1, bf16x8 pa2, bf16x8 pa3) {
  const s16x4 l0 = tr_read<v_rd_off(D0, 0, 0)>(vb), h0 = tr_read<v_rd_off(D0, 0, 1)>(vb), l1 = tr_read<v_rd_off(D0, 1, 0)>(vb), h1 = tr_read<v_rd_off(D0, 1, 1)>(vb);
  const s16x4 l2 = tr_read<v_rd_off(D0, 2, 0)>(vb), h2 = tr_read<v_rd_off(D0, 2, 1)>(vb), l3 = tr_read<v_rd_off(D0, 3, 0)>(vb), h3 = tr_read<v_rd_off(D0, 3, 1)>(vb);
  asm volatile("s_waitcnt lgkmcnt(0)" ::: "memory"); SBAR();
#define PK(L, H) (bf16x8){L[0], L[1], L[2], L[3], H[0], H[1], H[2], H[3]}
  od = __builtin_amdgcn_mfma_f32_32x32x16_bf16(pa0, PK(l0, h0), od, 0, 0, 0);
  od = __builtin_amdgcn_mfma_f32_32x32x16_bf16(pa1, PK(l1, h1), od, 0, 0, 0);
  od = __builtin_amdgcn_mfma_f32_32x32x16_bf16(pa2, PK(l2, h2), od, 0, 0, 0);
  od = __builtin_amdgcn_mfma_f32_32x32x16_bf16(pa3, PK(l3, h3), od, 0, 0, 0);
#undef PK
}
__device__ __forceinline__ void pv_d0(f32x16* o, int vb, bf16x8 pa0, bf16x8 pa1, bf16x8 pa2, bf16x8 pa3) {
  pv_one<0>(o[0], vb, pa0, pa1, pa2, pa3); pv_one<1>(o[1], vb, pa0, pa1, pa2, pa3); pv_one<2>(o[2], vb, pa0, pa1, pa2, pa3); pv_one<3>(o[3], vb, pa0, pa1, pa2, pa3);
}
constexpr int LDQ = 1536, LDK = 1024, LDV = 1024, LDKR = 64, LDO = 1024, SDEPTH = ATT_SDEPTH;
constexpr int SHM_V = KVBLK * 128 * 2, SHM_K = KVBLK * 128 * 2, SHM_KR = KVBLK * 64 * 2;
constexpr int SHM_QR = NW * 4 * 64 * 16;
constexpr int SHM_ATTN = 2 * SHM_V + 2 * SHM_K + 2 * SHM_KR + NW * 64 * 4 + SHM_QR;
__device__ __forceinline__ void attn_unit(const bf16* __restrict__ Qb, const bf16* __restrict__ Kh, const bf16* __restrict__ KRh, const bf16* __restrict__ Vh,
                                          bf16* __restrict__ Ob, int seq, char* lds) {
  using St = Stage<bf16>;
  const int tid = otid(), wid = tid >> 6, lane = tid & 63, r32 = lane & 31, hi = lane >> 5;
  bf16* V_lds = (bf16*)lds; bf16* K_lds = (bf16*)(lds + 2 * SHM_V); bf16* KR_lds = (bf16*)(lds + 2 * SHM_V + 2 * SHM_K);
  float* ws = (float*)(lds + 2 * SHM_V + 2 * SHM_K + 2 * SHM_KR) + wid * 64; float* li_l = ws; float* al_l = ws + 32;
  float m_reg = -1e30f, l_reg = 0; f32x16 o[4] = {}; bf16x8 qr[8];
  bf16x8* qrl = (bf16x8*)(lds + 2 * SHM_V + 2 * SHM_K + 2 * SHM_KR + NW * 64 * 4) + wid * 256 + lane;
  const bf16* Qw = Qb + (long)(wid * QBLK + r32) * LDQ + hi * 8;
#pragma unroll
  for (int d0 = 0; d0 < 8; ++d0) qr[d0] = St::ld8(Qw + d0 * 16);
#pragma unroll
  for (int d0 = 0; d0 < 4; ++d0) qrl[d0 * 64] = St::ld8(Qw + 128 + d0 * 16);
  const int sr = tid >> 4, sc = (tid & 15) * 8, vst0 = v_st(sr, sc), vst1 = v_st(32 + sr, sc);
  const int krr = tid >> 3, krc = (tid & 7) * 8;
  const int vb0 = (int)(uintptr_t)V_lds + v_rd_base(lane);
  struct { bf16x8 vs0, vs1, ks0, ks1, kr; } sr_[SDEPTH];
#define SLOAD(i, k0) do { sr_[i].vs0 = St::ld8(&Vh[(long)((k0) + sr) * LDV + sc]); sr_[i].vs1 = St::ld8(&Vh[(long)((k0) + 32 + sr) * LDV + sc]); \
    sr_[i].ks0 = St::ld8(&Kh[(long)((k0) + sr) * LDK + sc]); sr_[i].ks1 = St::ld8(&Kh[(long)((k0) + 32 + sr) * LDK + sc]); \
    sr_[i].kr = St::ld8(&KRh[(long)((k0) + krr) * LDKR + krc]); } while (0)
#define SWRITE(b, i) do { *(bf16x8*)((char*)V_lds + (b) * SHM_V + vst0) = sr_[i].vs0;          \
    *(bf16x8*)((char*)V_lds + (b) * SHM_V + vst1) = sr_[i].vs1; int kc = sc * 2;               \
    *(bf16x8*)((char*)K_lds + (b) * SHM_K + KSWZ(sr, kc)) = sr_[i].ks0;                       \
    *(bf16x8*)((char*)K_lds + (b) * SHM_K + KSWZ(32 + sr, kc)) = sr_[i].ks1;                  \
    *(bf16x8*)((char*)KR_lds + (b) * SHM_KR + KSWZ2(krr, krc * 2)) = sr_[i].kr; } while (0)
#define SWAIT() do { if constexpr (SDEPTH == 2) asm volatile("s_waitcnt vmcnt(5)" ::: "memory"); else asm volatile("s_waitcnt vmcnt(0)" ::: "memory"); } while (0)
#define RESC(a) do { if (__any((a) < 1.f)) { if (hi == 0) al_l[r32] = (a); asm volatile("s_waitcnt lgkmcnt(0)" ::: "memory"); \
    _Pragma("unroll") for (int d = 0; d < 4; ++d) _Pragma("unroll") for (int r = 0; r < 16; ++r) o[d][r] *= al_l[crow(r, hi)]; } } while (0)
  f32x16 pA0, pA1, pB0, pB1; float mnA, mnB, alA, alB; bf16x8 pa0, pa1, pa2, pa3; const int NT = seq / KVBLK;
  constexpr int SE = 0, SO = SDEPTH - 1;
  SLOAD(SE, 0); asm volatile("s_waitcnt vmcnt(0)" ::: "memory"); SWRITE(0, SE); __syncthreads();
  qkt(pA0, pA1, K_lds, KR_lds, qr, qrl, r32, hi); partialSM(pA0, pA1, m_reg, mnA, alA);
  SLOAD(SO, KVBLK); if constexpr (SDEPTH == 2) { if (2 < NT) SLOAD(SE, 2 * KVBLK); }
  SWAIT(); SWRITE(1, SO); __syncthreads();
  for (int j = 1; j + 1 < NT; j += 2) {
    SBAR(); qkt(pB0, pB1, (bf16*)((char*)K_lds + SHM_K), (bf16*)((char*)KR_lds + SHM_KR), qr, qrl, r32, hi);
    finishSM(pA0, pA1, alA, l_reg, pa0, pa1, pa2, pa3); SBAR();
    SLOAD(SO, (j + SDEPTH) * KVBLK); SBAR();
    pv_d0(o, vb0, pa0, pa1, pa2, pa3); partialSM(pB0, pB1, m_reg, mnB, alB);
    __syncthreads(); SWAIT(); SWRITE(0, SE);
    RESC(alB); __syncthreads();
    SBAR(); qkt(pA0, pA1, K_lds, KR_lds, qr, qrl, r32, hi);
    finishSM(pB0, pB1, alB, l_reg, pa0, pa1, pa2, pa3); SBAR();
    if (SDEPTH == 1 || j + 3 < NT) SLOAD(SE, (j + 1 + SDEPTH) * KVBLK); SBAR();
    pv_d0(o, vb0 + (int)SHM_V, pa0, pa1, pa2, pa3); partialSM(pA0, pA1, m_reg, mnA, alA);
    __syncthreads(); SWAIT(); SWRITE(1, SO);
    RESC(alA); __syncthreads();
  }
  SBAR(); qkt(pB0, pB1, (bf16*)((char*)K_lds + SHM_K), (bf16*)((char*)KR_lds + SHM_KR), qr, qrl, r32, hi);
  finishSM(pA0, pA1, alA, l_reg, pa0, pa1, pa2, pa3); SBAR();
  pv_d0(o, vb0, pa0, pa1, pa2, pa3); partialSM(pB0, pB1, m_reg, mnB, alB);
  __syncthreads(); RESC(alB);
  finishSM(pB0, pB1, alB, l_reg, pa0, pa1, pa2, pa3); SBAR();
  pv_d0(o, vb0 + (int)SHM_V, pa0, pa1, pa2, pa3);
  if (hi == 0) li_l[r32] = l_reg; asm volatile("s_waitcnt lgkmcnt(0)" ::: "memory");
  float rli[16];
#pragma unroll
  for (int r = 0; r < 16; ++r) rli[r] = __builtin_amdgcn_rcpf(li_l[crow(r, hi)]);
  bf16* Ow = Ob + (long)(wid * QBLK) * LDO;
#pragma unroll
  for (int r = 0; r < 16; ++r) { int orow = crow(r, hi);
#pragma unroll
    for (int d0 = 0; d0 < 4; ++d0) Ow[(long)orow * LDO + d0 * 32 + r32] = __float2bfloat16(o[d0][r] * rli[r]); }
  __syncthreads();
#undef SLOAD
#undef SWRITE
#undef SWAIT
#undef RESC
}
#undef SBAR
}
constexpr int BATCH = 4, SEQ = 8192, DM = 1024, DEPTH = 4, DFF = 2816, MT = BATCH * SEQ;
constexpr int NH = 8, QLR = 256, KVLR = 128, QKD = 192;
constexpr float EPS = 1e-6f;
constexpr size_t MiB = 1u << 20;
constexpr size_t WS_WFFI = 1 * MiB;
constexpr size_t WS_WFFO = 89 * MiB;
constexpr size_t WS_WHIN = 133 * MiB;
constexpr size_t WS_WHO  = 153 * MiB;
constexpr size_t WS_WMIN = 157 * MiB;
constexpr size_t WS_WUQ  = 159 * MiB;
constexpr size_t WS_WUKV = 161 * MiB;
constexpr size_t WS_WMO  = 162 * MiB;
constexpr size_t WS_COS  = 166 * MiB;
constexpr size_t WS_SIN  = 170 * MiB;
constexpr size_t WS_LB   = 174 * MiB;
constexpr size_t WS_HN   = 176 * MiB;
constexpr size_t WS_Y    = 240 * MiB;
constexpr size_t WS_R    = 368 * MiB;
constexpr size_t WS_END  = 704 * MiB;
constexpr size_t R_ACT = 0;
constexpr size_t R_C = 0, R_QB = 0, R_CQ = 96 * MiB, R_CKV = 112 * MiB, R_KR = 120 * MiB, R_KN = 124 * MiB, R_VB = 188 * MiB, R_O = 252 * MiB;
constexpr size_t R_QH = 0, R_VH = 64 * MiB, R_GH = 128 * MiB, R_KF = 192 * MiB, R_HO = 0;

constexpr int LDS_RING = 131072, LDS_BYTES = LDS_RING + 2048;
typedef unsigned short bf16_t;
typedef float f32x4 __attribute__((ext_vector_type(4)));
typedef float f32x2 __attribute__((ext_vector_type(2)));
typedef unsigned u32x4 __attribute__((ext_vector_type(4)));
typedef unsigned u32x2 __attribute__((ext_vector_type(2)));
typedef _Float16 h16x2 __attribute__((ext_vector_type(2)));
#define LAS __attribute__((address_space(3)))

__device__ __constant__ double ROPE_INVF[32] = {1.0, 0.7498942093324559, 0.5623413251903491, 0.4216965034285822, 0.31622776601683794, 0.23713737056616552, 0.1778279410038923, 0.1333521432163324, 0.1, 0.07498942093324558, 0.05623413251903491, 0.042169650342858224, 0.03162277660168379, 0.023713737056616554, 0.01778279410038923, 0.01333521432163324, 0.01, 0.007498942093324558, 0.005623413251903491, 0.004216965034285823, 0.0031622776601683794, 0.0023713737056616554, 0.0017782794100389228, 0.001333521432163324, 0.001, 0.0007498942093324559, 0.0005623413251903491, 0.00042169650342858224, 0.00031622776601683794, 0.00023713737056616554, 0.00017782794100389227, 0.0001333521432163324};

__device__ __forceinline__ unsigned pk2(float lo, float hi) { return pg8::cvt_pk_bf16(lo, hi); }
__device__ __forceinline__ float silu_f(float g) { return g * __builtin_amdgcn_rcpf(1.0f + __expf(-g)); }
__device__ __forceinline__ float wave_sum(float v) {
#pragma unroll
    for (int o = 1; o < 64; o <<= 1) v += __shfl_xor(v, o);
    return v;
}
__device__ __forceinline__ float half_sum(float v) {
#pragma unroll
    for (int o = 1; o < 32; o <<= 1) v += __shfl_xor(v, o);
    return v;
}

using pg8::Unit;
struct EpiSwiglu { static constexpr bool PERM = true, AFTER_DRAIN = false; bf16_t* O;
    __device__ __forceinline__ void operator()(const pg8::f32x4 (&acc)[2][2][4][2], const Unit& u, int wr, int wc, int fr, int fq) const {
        const int row0 = u.pm * 256 + wr * 64 + fr, col0 = u.pn * 128 + wc * 32 + 8 * fq;
#pragma unroll
        for (int ai = 0; ai < 2; ++ai)
#pragma unroll
            for (int m = 0; m < 4; ++m) { bf16_t* p = O + (size_t)(row0 + ai * 128 + m * 16) * DFF + col0;
                const pg8::f32x4 g0 = acc[ai][0][m][0], g1 = acc[ai][0][m][1], u0 = acc[ai][1][m][0], u1 = acc[ai][1][m][1];
                u32x4 w; w.x = pk2(silu_f(g0[0]) * u0[0], silu_f(g0[1]) * u0[1]); w.y = pk2(silu_f(g0[2]) * u0[2], silu_f(g0[3]) * u0[3]);
                w.z = pk2(silu_f(g1[0]) * u1[0], silu_f(g1[1]) * u1[1]); w.w = pk2(silu_f(g1[2]) * u1[2], silu_f(g1[3]) * u1[3]);
                *(u32x4*)p = w; }
    }
};
struct EpiF32 { static constexpr bool PERM = false, AFTER_DRAIN = false; float* O; int ldc;
    __device__ __forceinline__ void operator()(const pg8::f32x4 (&acc)[2][2][4][2], const Unit& u, int wr, int wc, int fr, int fq) const {
        const int row0 = u.pm * 256 + wr * 64 + fr, col0 = u.pn * 256 + wc * 32 + 4 * fq;
#pragma unroll
        for (int ai = 0; ai < 2; ++ai)
#pragma unroll
            for (int m = 0; m < 4; ++m) { float* p = O + (size_t)(row0 + ai * 128 + m * 16) * ldc + col0;
#pragma unroll
                for (int bj = 0; bj < 2; ++bj)
#pragma unroll
                    for (int n = 0; n < 2; ++n) *(pg8::f32x4*)(p + bj * 128 + n * 16) = acc[ai][bj][m][n]; }
    }
};
struct EpiQ { static constexpr bool PERM = true, AFTER_DRAIN = false; bf16_t* O; const float* cs; const float* sn;
    __device__ __forceinline__ void operator()(const pg8::f32x4 (&acc)[2][2][4][2], const Unit& u, int wr, int wc, int fr, int fq) const {
        const int row0 = u.pm * 256 + wr * 64 + fr;
#pragma unroll
        for (int bj = 0; bj < 2; ++bj) { const int col0 = u.pn * 256 + bj * 128 + wc * 32 + 8 * fq, d = col0 % QKD; const bool rot = d >= 128; const int i0 = (d - 128) >> 1;
#pragma unroll
            for (int ai = 0; ai < 2; ++ai)
#pragma unroll
                for (int m = 0; m < 4; ++m) { const int row = row0 + ai * 128 + m * 16; pg8::f32x4 v0 = acc[ai][bj][m][0], v1 = acc[ai][bj][m][1];
                    if (rot) { const pg8::f32x4 c = *(const pg8::f32x4*)(cs + (size_t)row * 32 + i0), s = *(const pg8::f32x4*)(sn + (size_t)row * 32 + i0);
                        pg8::f32x4 a, b; a[0] = v0[0] * c[0] - v0[1] * s[0]; a[1] = v0[0] * s[0] + v0[1] * c[0]; a[2] = v0[2] * c[1] - v0[3] * s[1]; a[3] = v0[2] * s[1] + v0[3] * c[1];
                        b[0] = v1[0] * c[2] - v1[1] * s[2]; b[1] = v1[0] * s[2] + v1[1] * c[2]; b[2] = v1[2] * c[3] - v1[3] * s[3]; b[3] = v1[2] * s[3] + v1[3] * c[3]; v0 = a; v1 = b; }
                    u32x4 w; w.x = pk2(v0[0], v0[1]); w.y = pk2(v0[2], v0[3]); w.z = pk2(v1[0], v1[1]); w.w = pk2(v1[2], v1[3]);
                    *(u32x4*)(O + (size_t)row * 1536 + col0) = w; } }
    }
};
struct EpiKV { static constexpr bool PERM = true, AFTER_DRAIN = false; bf16_t* Kn; bf16_t* Vb;
    __device__ __forceinline__ void operator()(const pg8::f32x4 (&acc)[2][2][4][2], const Unit& u, int wr, int wc, int fr, int fq) const {
        const int row0 = u.pm * 256 + wr * 64 + fr, col0 = u.pn * 128 + wc * 32 + 8 * fq;
#pragma unroll
        for (int bj = 0; bj < 2; ++bj) { bf16_t* base = bj ? Vb : Kn;
#pragma unroll
            for (int ai = 0; ai < 2; ++ai)
#pragma unroll
                for (int m = 0; m < 4; ++m) { const pg8::f32x4 v0 = acc[ai][bj][m][0], v1 = acc[ai][bj][m][1];
                    u32x4 w; w.x = pk2(v0[0], v0[1]); w.y = pk2(v0[2], v0[3]); w.z = pk2(v1[0], v1[1]); w.w = pk2(v1[2], v1[3]);
                    *(u32x4*)(base + (size_t)(row0 + ai * 128 + m * 16) * 1024 + col0) = w; } }
    }
};
__device__ __forceinline__ unsigned pkh2(float a, float b) { const h16x2 h = {(_Float16)a, (_Float16)b}; return __builtin_bit_cast(unsigned, h); }
__device__ __forceinline__ float kgate(float om, float z) { return om * __builtin_amdgcn_rcpf(1.0f + __expf(z)); }
struct EpiHgrn { static constexpr bool PERM = true, AFTER_DRAIN = false; bf16_t* Qh; bf16_t* Vh; bf16_t* Gh; unsigned short* KF; const float* lb;
    __device__ __forceinline__ void operator()(const pg8::f32x4 (&acc)[2][2][4][2], const Unit& u, int wr, int wc, int fr, int fq) const {
        const int row0 = u.pm * 256 + wr * 64 + fr, seg = u.pn >> 2;
#pragma unroll
        for (int bj = 0; bj < 2; ++bj) { const int cc = (u.pn & 3) * 256 + bj * 128 + wc * 32 + 8 * fq;
            if (seg == 1 || seg == 2) {
                const pg8::f32x4 om0 = 1.0f - *(const pg8::f32x4*)(lb + (seg - 1) * 1024 + cc), om1 = 1.0f - *(const pg8::f32x4*)(lb + (seg - 1) * 1024 + cc + 4);
                unsigned short* base = KF + (size_t)(seg - 1) * MT * 1024;
#pragma unroll
                for (int ai = 0; ai < 2; ++ai)
#pragma unroll
                    for (int m = 0; m < 4; ++m) { const size_t off = (size_t)(row0 + ai * 128 + m * 16) * 1024 + cc; const pg8::f32x4 v0 = acc[ai][bj][m][0], v1 = acc[ai][bj][m][1];
                        u32x4 w; w.x = pkh2(kgate(om0[0], v0[0]), kgate(om0[1], v0[1])); w.y = pkh2(kgate(om0[2], v0[2]), kgate(om0[3], v0[3]));
                        w.z = pkh2(kgate(om1[0], v1[0]), kgate(om1[1], v1[1])); w.w = pkh2(kgate(om1[2], v1[2]), kgate(om1[3], v1[3]));
                        *(u32x4*)(base + off) = w; }
            } else if (seg == 3) {
#pragma unroll
                for (int ai = 0; ai < 2; ++ai)
#pragma unroll
                    for (int m = 0; m < 4; ++m) { const size_t off = (size_t)(row0 + ai * 128 + m * 16) * 1024 + cc; const pg8::f32x4 v0 = acc[ai][bj][m][0], v1 = acc[ai][bj][m][1];
                        u32x4 w; w.x = pk2(v0[0], v0[1]); w.y = pk2(v0[2], v0[3]); w.z = pk2(v1[0], v1[1]); w.w = pk2(v1[2], v1[3]);
                        *(u32x4*)(Vh + off) = w; }
            } else { bf16_t* base = seg == 0 ? Qh : Gh;
#pragma unroll
                for (int ai = 0; ai < 2; ++ai)
#pragma unroll
                    for (int m = 0; m < 4; ++m) { const size_t off = (size_t)(row0 + ai * 128 + m * 16) * 1024 + cc; const pg8::f32x4 v0 = acc[ai][bj][m][0], v1 = acc[ai][bj][m][1];
                        u32x4 w; w.x = pk2(silu_f(v0[0]), silu_f(v0[1])); w.y = pk2(silu_f(v0[2]), silu_f(v0[3])); w.z = pk2(silu_f(v1[0]), silu_f(v1[1])); w.w = pk2(silu_f(v1[2]), silu_f(v1[3]));
                        *(u32x4*)(base + off) = w; } } }
    }
};

__device__ __forceinline__ int src_col(int mode, int n) {
    if (mode == 1) { const int t = n >> 8, j = n & 255; return j < 128 ? t * 128 + j : DFF + t * 128 + (j - 128); }
    if (mode == 2) { if (n < 384) return n; if (n >= 448) return -1; const int j = n - 384; return 384 + (j >> 1) + 32 * (j & 1); }
    if (mode == 3) { const int h = n / QKD, d = n % QKD; if (d < 128) return n; const int j = d - 128; return h * QKD + 128 + (j >> 1) + 32 * (j & 1); }
    return n;
}
__device__ __forceinline__ void xpose_item(const float* __restrict__ W, int K, int Nsrc, int Ndst, int mode, bf16_t* __restrict__ WT, LAS float* scr, int item, int lane) {
    const int nblk = Ndst / 32, kb = item / nblk, nb = item % nblk, k0 = 64 * kb, n0 = 32 * nb;
    const int sc = src_col(mode, n0 + (lane & 31));
#pragma unroll 8
    for (int i = 0; i < 32; ++i) { const int kk = 2 * i + (lane >> 5); scr[kk * 33 + (lane & 31)] = sc >= 0 ? W[(size_t)(k0 + kk) * Nsrc + sc] : 0.f; }
    asm volatile("s_waitcnt lgkmcnt(0)" ::: "memory");
    const int c = lane & 7;
#pragma unroll
    for (int j = 0; j < 4; ++j) { const int n = (lane >> 3) + 8 * j; const LAS float* s = scr + (8 * c) * 33 + n;
        u32x4 o; o.x = pk2(s[0 * 33], s[1 * 33]); o.y = pk2(s[2 * 33], s[3 * 33]); o.z = pk2(s[4 * 33], s[5 * 33]); o.w = pk2(s[6 * 33], s[7 * 33]);
        *(u32x4*)(WT + (size_t)(n0 + n) * K + k0 + 8 * c) = o; }
    asm volatile("s_waitcnt lgkmcnt(0)" ::: "memory");
}

__device__ __forceinline__ void row_init(const float* __restrict__ xin, float* __restrict__ X, bf16_t* __restrict__ HN, const float* __restrict__ g, int lane) {
    const f32x4* xr = (const f32x4*)xin + lane; f32x4 v[4]; float s = 0.f;
#pragma unroll
    for (int j = 0; j < 4; ++j) { v[j] = xr[64 * j]; s += (v[j][0] * v[j][0] + v[j][1] * v[j][1]) + (v[j][2] * v[j][2] + v[j][3] * v[j][3]); }
    const float r = rsqrtf(wave_sum(s) * (1.f / DM) + EPS);
#pragma unroll
    for (int j = 0; j < 4; ++j) { ((f32x4*)X + lane)[64 * j] = v[j]; const f32x4 gg = ((const f32x4*)g + lane)[64 * j];
        u32x2 w; w.x = pk2(v[j][0] * r * gg[0], v[j][1] * r * gg[1]); w.y = pk2(v[j][2] * r * gg[2], v[j][3] * r * gg[3]); ((u32x2*)HN + lane)[64 * j] = w; }
}
__device__ __forceinline__ void row_post(const float* __restrict__ Y, float* __restrict__ X, bf16_t* __restrict__ HN, float scale, const float* __restrict__ gp, const float* __restrict__ gn, int lane) {
    f32x4 y[4], x[4]; float s = 0.f;
#pragma unroll
    for (int j = 0; j < 4; ++j) { y[j] = ((const f32x4*)Y + lane)[64 * j]; x[j] = ((const f32x4*)X + lane)[64 * j]; s += (y[j][0] * y[j][0] + y[j][1] * y[j][1]) + (y[j][2] * y[j][2] + y[j][3] * y[j][3]); }
    const float r = rsqrtf(wave_sum(s) * (1.f / DM) + EPS) * scale; float s2 = 0.f;
#pragma unroll
    for (int j = 0; j < 4; ++j) { const f32x4 gg = ((const f32x4*)gp + lane)[64 * j]; x[j] = x[j] + y[j] * r * gg; ((f32x4*)X + lane)[64 * j] = x[j];
        s2 += (x[j][0] * x[j][0] + x[j][1] * x[j][1]) + (x[j][2] * x[j][2] + x[j][3] * x[j][3]); }
    if (HN) { const float r2 = rsqrtf(wave_sum(s2) * (1.f / DM) + EPS);
#pragma unroll
        for (int j = 0; j < 4; ++j) { const f32x4 gg = ((const f32x4*)gn + lane)[64 * j];
            u32x2 w; w.x = pk2(x[j][0] * r2 * gg[0], x[j][1] * r2 * gg[1]); w.y = pk2(x[j][2] * r2 * gg[2], x[j][3] * r2 * gg[3]); ((u32x2*)HN + lane)[64 * j] = w; } }
}
__device__ __forceinline__ void row_mla(const float* __restrict__ C, bf16_t* __restrict__ CQ, bf16_t* __restrict__ CKV, bf16_t* __restrict__ KR, const float* __restrict__ qn, const float* __restrict__ kvn,
                                        const float* __restrict__ cs, const float* __restrict__ sn, int lane) {
    const f32x4 a = ((const f32x4*)C)[2 * lane], b = ((const f32x4*)C)[2 * lane + 1];
    float s = (a[0] * a[0] + a[1] * a[1]) + (a[2] * a[2] + a[3] * a[3]) + (b[0] * b[0] + b[1] * b[1]) + (b[2] * b[2] + b[3] * b[3]);
#pragma unroll
    for (int o = 1; o < 16; o <<= 1) s += __shfl_xor(s, o);
    const float s16 = s, s32 = s16 + __shfl_xor(s16, 16);
    float v[8] = {a[0], a[1], a[2], a[3], b[0], b[1], b[2], b[3]};
    if (lane < 32) { const float r = rsqrtf(s32 * (1.f / QLR) + EPS); const f32x4 g0 = ((const f32x4*)qn)[2 * lane], g1 = ((const f32x4*)qn)[2 * lane + 1];
        u32x4 w; w.x = pk2(v[0] * r * g0[0], v[1] * r * g0[1]); w.y = pk2(v[2] * r * g0[2], v[3] * r * g0[3]); w.z = pk2(v[4] * r * g1[0], v[5] * r * g1[1]); w.w = pk2(v[6] * r * g1[2], v[7] * r * g1[3]);
        ((u32x4*)CQ)[lane] = w;
    } else if (lane < 48) { const int l = lane - 32; const float r = rsqrtf(s16 * (1.f / KVLR) + EPS); const f32x4 g0 = ((const f32x4*)kvn)[2 * l], g1 = ((const f32x4*)kvn)[2 * l + 1];
        u32x4 w; w.x = pk2(v[0] * r * g0[0], v[1] * r * g0[1]); w.y = pk2(v[2] * r * g0[2], v[3] * r * g0[3]); w.z = pk2(v[4] * r * g1[0], v[5] * r * g1[1]); w.w = pk2(v[6] * r * g1[2], v[7] * r * g1[3]);
        ((u32x4*)CKV)[l] = w;
    } else if (lane < 56) { const int l = lane - 48; const f32x4 c = ((const f32x4*)cs)[l], sv = ((const f32x4*)sn)[l];
        u32x4 w; w.x = pk2(v[0] * c[0] - v[1] * sv[0], v[0] * sv[0] + v[1] * c[0]); w.y = pk2(v[2] * c[1] - v[3] * sv[1], v[2] * sv[1] + v[3] * c[1]);
        w.z = pk2(v[4] * c[2] - v[5] * sv[2], v[4] * sv[2] + v[5] * c[2]); w.w = pk2(v[6] * c[3] - v[7] * sv[3], v[6] * sv[3] + v[7] * c[3]);
        ((u32x4*)KR)[l] = w; }
}
__device__ __forceinline__ void row_hgrn(const bf16_t* __restrict__ Oa, const bf16_t* __restrict__ Gh, bf16_t* __restrict__ HO, const float* __restrict__ on, int lane) {
#pragma unroll
    for (int j = 0; j < 4; ++j) { const u32x2 a = ((const u32x2*)Oa + lane)[64 * j], b = ((const u32x2*)(Oa + (size_t)MT * 1024) + lane)[64 * j];
        f32x4 o; o[0] = __uint_as_float(a.x << 16) + __uint_as_float(b.x << 16); o[1] = __uint_as_float(a.x & 0xffff0000u) + __uint_as_float(b.x & 0xffff0000u);
        o[2] = __uint_as_float(a.y << 16) + __uint_as_float(b.y << 16); o[3] = __uint_as_float(a.y & 0xffff0000u) + __uint_as_float(b.y & 0xffff0000u);
        const float s = half_sum((o[0] * o[0] + o[1] * o[1]) + (o[2] * o[2] + o[3] * o[3]));
        const float r = rsqrtf(s * (1.f / 128.f) + EPS); const f32x4 gg = ((const f32x4*)on + lane)[64 * j]; const u32x2 gb = ((const u32x2*)Gh + lane)[64 * j];
        const float g0 = __uint_as_float(gb.x << 16), g1 = __uint_as_float(gb.x & 0xffff0000u), g2 = __uint_as_float(gb.y << 16), g3 = __uint_as_float(gb.y & 0xffff0000u);
        u32x2 w; w.x = pk2(o[0] * r * gg[0] * g0, o[1] * r * gg[1] * g1); w.y = pk2(o[2] * r * gg[2] * g2, o[3] * r * gg[3] * g3); ((u32x2*)HO + lane)[64 * j] = w; }
}
__device__ __forceinline__ f32x2 h2f2_(unsigned u) { const h16x2 h = __builtin_bit_cast(h16x2, u); return (f32x2){(float)h[0], (float)h[1]}; }
__device__ __forceinline__ void scan_phase(LAS unsigned char* lds, const bf16_t* __restrict__ Qh, const bf16_t* __restrict__ Vh, const unsigned short* __restrict__ KF, bf16_t* __restrict__ OP, int G, int bx) {
    int tid = threadIdx.x; asm volatile("" : "+v"(tid)); const int wid = __builtin_amdgcn_readfirstlane(tid >> 6), lane = tid & 63;
    const int st = tid >> 4, sc8 = (tid & 15) * 8, sv = tid >> 3, vc4 = (tid & 7) * 4;
    constexpr int OFF_K = 16384, OFF_Q = 32768, OFF_V = 49152, OFF_P = 53248;
    for (int item = bx; item < 256; item += G) {
        const int dir = item & 1, dvq = (item >> 1) & 3, h = (item >> 3) & 7, b = item >> 6;
        const size_t kcol = h * 128 + sc8, vcol = h * 128 + dvq * 32 + vc4;
        const unsigned short* KFd = KF + (size_t)dir * MT * 1024; bf16_t* OPd = OP + (size_t)dir * MT * 1024;
        float S[8];
#pragma unroll
        for (int j = 0; j < 8; ++j) S[j] = 0.f;
        u32x4 rk, rq; u32x2 rv = {0u, 0u};
#define SC_GLOAD(blk) do { { const int tt = (blk) * 32 + st; const size_t m = (size_t)b * SEQ + (dir ? SEQ - 1 - tt : tt); \
        rk = *(const u32x4*)(KFd + m * 1024 + kcol); rq = *(const u32x4*)(Qh + m * 1024 + kcol); } \
        if (tid < 256) { const int tt = (blk) * 32 + sv; const size_t m = (size_t)b * SEQ + (dir ? SEQ - 1 - tt : tt); rv = *(const u32x2*)(Vh + m * 1024 + vcol); } } while (0)
#define SC_H2F(u_) h2f2_(u_)
#define SC_LWRITE() do { LAS unsigned char* B_ = lds + (st * 128 + sc8) * 4; \
        const f32x2 ka = SC_H2F(rk.x), kb = SC_H2F(rk.y), kc = SC_H2F(rk.z), kd = SC_H2F(rk.w); \
        const f32x4 k0_ = {ka[0], ka[1], kb[0], kb[1]}, k1_ = {kc[0], kc[1], kd[0], kd[1]}; \
        *(LAS f32x4*)(B_) = 1.0f - k0_; *(LAS f32x4*)(B_ + 16) = 1.0f - k1_; *(LAS f32x4*)(B_ + OFF_K) = k0_; *(LAS f32x4*)(B_ + OFF_K + 16) = k1_; \
        *(LAS f32x4*)(B_ + OFF_Q) = (f32x4){__uint_as_float(rq.x << 16), __uint_as_float(rq.x & 0xffff0000u), __uint_as_float(rq.y << 16), __uint_as_float(rq.y & 0xffff0000u)}; \
        *(LAS f32x4*)(B_ + OFF_Q + 16) = (f32x4){__uint_as_float(rq.z << 16), __uint_as_float(rq.z & 0xffff0000u), __uint_as_float(rq.w << 16), __uint_as_float(rq.w & 0xffff0000u)}; \
        if (tid < 256) *(LAS f32x4*)(lds + OFF_V + (sv * 32 + vc4) * 4) = (f32x4){__uint_as_float(rv.x << 16), __uint_as_float(rv.x & 0xffff0000u), __uint_as_float(rv.y << 16), __uint_as_float(rv.y & 0xffff0000u)}; } while (0)
        SC_GLOAD(0);
        const int sub = lane >> 5, dvl = lane & 31;
        const LAS unsigned char* Bc = lds + (16 * wid + 8 * sub) * 4;
        const LAS unsigned char* Vc = lds + OFF_V + dvl * 4;
        LAS float* P = (LAS float*)(lds + OFF_P) + (2 * wid + sub) * 1024 + dvl;
        for (int blk = 0; blk < SEQ / 32; ++blk) {
            SC_LWRITE();
            if (blk + 1 < SEQ / 32) SC_GLOAD(blk + 1);
            __syncthreads();
#pragma unroll 8
            for (int t = 0; t < 32; ++t) {
                const f32x4 f0 = *(const LAS f32x4*)(Bc + t * 512), f1 = *(const LAS f32x4*)(Bc + t * 512 + 16);
                const f32x4 k0 = *(const LAS f32x4*)(Bc + OFF_K + t * 512), k1 = *(const LAS f32x4*)(Bc + OFF_K + t * 512 + 16);
                const f32x4 q0 = *(const LAS f32x4*)(Bc + OFF_Q + t * 512), q1 = *(const LAS f32x4*)(Bc + OFF_Q + t * 512 + 16);
                const float vv = *(const LAS float*)(Vc + t * 128);
                float o = 0.f;
#pragma unroll
                for (int j = 0; j < 4; ++j) { S[j] = S[j] * f0[j] + k0[j] * vv; o += S[j] * q0[j]; }
#pragma unroll
                for (int j = 0; j < 4; ++j) { S[4 + j] = S[4 + j] * f1[j] + k1[j] * vv; o += S[4 + j] * q1[j]; }
                P[t * 32] = o;
            }
            __syncthreads();
            if (tid < 256) { const LAS float* Pr = (const LAS float*)(lds + OFF_P) + sv * 32 + vc4; f32x4 acc = *(const LAS f32x4*)Pr;
#pragma unroll
              for (int g = 1; g < 16; ++g) acc = acc + *(const LAS f32x4*)(Pr + g * 1024);
              const int tt = blk * 32 + sv; const size_t m = (size_t)b * SEQ + (dir ? SEQ - 1 - tt : tt);
              u32x2 w; w.x = pk2(acc[0], acc[1]); w.y = pk2(acc[2], acc[3]); *(u32x2*)(OPd + m * 1024 + vcol) = w; }
        }
        __syncthreads();
#undef SC_GLOAD
#undef SC_LWRITE
#undef SC_H2F
    }
}

enum Op { OP_SW0, OP_FO0, OP_RPA, OP_MIN, OP_RMLA, OP_QKV, OP_ATTN, OP_MWO, OP_RPB, OP_SW1, OP_FO1, OP_RPC, OP_HIN, OP_SCAN, OP_RHG, OP_HWO };
__device__ const unsigned char OPS_M[12] = {OP_SW0, OP_FO0, OP_RPA, OP_MIN, OP_RMLA, OP_QKV, OP_ATTN, OP_MWO, OP_RPB, OP_SW1, OP_FO1, OP_RPC};
__device__ const unsigned char OPS_H[11] = {OP_SW0, OP_FO0, OP_RPA, OP_HIN, OP_SCAN, OP_RHG, OP_HWO, OP_RPB, OP_SW1, OP_FO1, OP_RPC};

struct Args { const float* in[15]; float* out; unsigned char* ws; };
typedef const __attribute__((address_space(4))) Args* ArgsP;
__device__ __forceinline__ ArgsP get_args() { ArgsP p = (ArgsP)__builtin_amdgcn_kernarg_segment_ptr(); asm volatile("" : "+s"(p) :: "memory"); return p; }
#define GW_ ((int)blockIdx.x * 8 + __builtin_amdgcn_readfirstlane((int)threadIdx.x >> 6))
#define NGW_ ((int)gridDim.x * 8)
__device__ __forceinline__ int otid_() { int t = threadIdx.x; asm volatile("" : "+v"(t)); return t; }
#define LANE_ (otid_() & 63)

#ifdef DBG_CHECKS
__device__ __forceinline__ float bf2f(bf16_t v) { return __uint_as_float((unsigned)v << 16); }
__device__ __forceinline__ unsigned hash_u(unsigned x) { x ^= x >> 16; x *= 0x7feb352du; x ^= x >> 15; x *= 0x846ca68bu; x ^= x >> 16; return x; }
__device__ __forceinline__ void dbg_report(unsigned* DBG, int id, float got, float ref, float rtol, float atol) {
    const float err = fabsf(got - ref); const bool bad = !(err <= rtol * fabsf(ref) + atol);
    if (bad) atomicMax(DBG + id, 1u);
}
__device__ __forceinline__ int dbg_row(int sidx) { if (sidx == 0) return 0; if (sidx == 1) return MT - 1; if (sidx == 2) return SEQ - 1; if (sidx == 3) return SEQ; return (int)(hash_u(sidx * 2654435761u + 17u) % MT); }
#endif
#ifdef DBG_CHECKS
struct DbgCtx { const float* const* in; unsigned char* ws; unsigned char* R; unsigned* DBG; int bx, tid, lane, wave; };
__device__ __forceinline__ float dbg_dot_bf_w(const bf16_t* a, const float* W, int K, int ldw, int col) { float s = 0.f; for (int k = 0; k < K; ++k) s += bf2f(a[k]) * W[(size_t)k * ldw + col]; return s; }
template <class A>
__device__ __forceinline__ void dbg_after(int l, int op, A ap, unsigned char* ws, unsigned char* R, LAS unsigned char* lds) {
    unsigned* DBG = (unsigned*)(ws + 32768);
    const int bx = blockIdx.x, tid = otid_(), lane = tid & 63, wave = __builtin_amdgcn_readfirstlane(tid >> 6);
    const bf16_t* HN = (const bf16_t*)(ws + WS_HN); const float* Y = (const float*)(ws + WS_Y);
    if (false && l == 0 && op == OP_SW0 && bx < 32) { const int sid = bx * 512 + tid, m = dbg_row(sid), c = hash_u(sid * 3 + 1) % DFF; const float* W = ap->in[3];
        const float g = dbg_dot_bf_w(HN + (size_t)m * 1024, W, 1024, 2 * DFF, c), u = dbg_dot_bf_w(HN + (size_t)m * 1024, W, 1024, 2 * DFF, DFF + c);
        dbg_report(DBG, 1, bf2f(((const bf16_t*)(R + R_ACT))[(size_t)m * DFF + c]), g / (1.f + expf(-g)) * u, 0.015f, 0.004f); }
    if (false && l == 0 && op == OP_FO0 && bx < 32) { const int sid = bx * 512 + tid, m = dbg_row(sid), c = hash_u(sid * 3 + 2) % 1024;
        const float r = dbg_dot_bf_w((const bf16_t*)(R + R_ACT) + (size_t)m * DFF, ap->in[4], DFF, 1024, c);
        dbg_report(DBG, 2, Y[(size_t)m * 1024 + c], r, 0.015f, 0.004f); }
    if (false && l == 0 && op == OP_RPA && bx < 32) { const int sid = bx * 512 + tid, m = dbg_row(sid), c = hash_u(sid * 3 + 3) % 1024; const float* g = ap->in[2];
        float s = 0.f; for (int k = 0; k < 1024; ++k) { const float y = Y[(size_t)m * 1024 + k]; s += y * y; }
        const float xr = ap->in[0][(size_t)m * 1024 + c] + 0.5f * Y[(size_t)m * 1024 + c] * rsqrtf(s / 1024.f + EPS) * g[1024 + c];
        dbg_report(DBG, 2, ap->out[(size_t)m * 1024 + c], xr, 1e-3f, 1e-3f);
        float s2 = 0.f; for (int k = 0; k < 1024; ++k) { const float x = ap->out[(size_t)m * 1024 + k]; s2 += x * x; }
        dbg_report(DBG, 2, bf2f(HN[(size_t)m * 1024 + c]), ap->out[(size_t)m * 1024 + c] * rsqrtf(s2 / 1024.f + EPS) * g[2048 + c], 0.01f, 0.01f); }
    if (false && l == 0 && op == OP_MIN && bx < 32) { const int sid = bx * 512 + tid, m = dbg_row(sid), c = hash_u(sid * 3 + 4) % 512; const int sc = src_col(2, c);
        const float r = sc >= 0 ? dbg_dot_bf_w(HN + (size_t)m * 1024, ap->in[5], 1024, 448, sc) : 0.f;
        dbg_report(DBG, 3, ((const float*)(R + R_C))[(size_t)m * 512 + c], r, 0.015f, 0.01f); }
    if (false && l == 0 && op == OP_RMLA && bx < 32) { const int sid = bx * 512 + tid, m = dbg_row(sid), c = hash_u(sid * 3 + 5) % 448; const float* C = (const float*)(R + R_C) + (size_t)m * 512;
        if (c < 256) { float s = 0.f; for (int k = 0; k < 256; ++k) s += C[k] * C[k];
            dbg_report(DBG, 3, bf2f(((const bf16_t*)(R + R_CQ))[(size_t)m * 256 + c]), C[c] * rsqrtf(s / 256.f + EPS) * ap->in[6][c], 0.01f, 0.01f); }
        else if (c < 384) { float s = 0.f; for (int k = 256; k < 384; ++k) s += C[k] * C[k];
            dbg_report(DBG, 3, bf2f(((const bf16_t*)(R + R_CKV))[(size_t)m * 128 + c - 256]), C[c] * rsqrtf(s / 128.f + EPS) * ap->in[7][c - 256], 0.01f, 0.01f); }
        else { const int jj = c - 384, i = jj >> 1; const float ang = (float)((const int*)ap->in[1])[m] * powf(10000.f, -(float)i / 32.f); const float cs = cosf(ang), sn = sinf(ang);
            const float t1 = C[384 + 2 * i], t2 = C[384 + 2 * i + 1]; const float r = (jj & 1) ? t1 * sn + t2 * cs : t1 * cs - t2 * sn;
            dbg_report(DBG, 3, bf2f(((const bf16_t*)(R + R_KR))[(size_t)m * 64 + jj]), r, 0.02f, 0.05f); } }
    if (false && l == 0 && op == OP_QKV && bx < 32) { const int sid = bx * 512 + tid, m = dbg_row(sid); const bf16_t* CQ = (const bf16_t*)(R + R_CQ) + (size_t)m * 256; const bf16_t* CKV = (const bf16_t*)(R + R_CKV) + (size_t)m * 128;
        { const int c = hash_u(sid * 3 + 6) % 1536, h = c / QKD, d = c % QKD; float r;
          if (d < 128) r = dbg_dot_bf_w(CQ, ap->in[8], 256, 1536, c);
          else { const int jj = d - 128, i = jj >> 1; const float t1 = dbg_dot_bf_w(CQ, ap->in[8], 256, 1536, h * QKD + 128 + i), t2 = dbg_dot_bf_w(CQ, ap->in[8], 256, 1536, h * QKD + 160 + i);
              const float ang = (float)((const int*)ap->in[1])[m] * powf(10000.f, -(float)i / 32.f); const float cs = cosf(ang), sn = sinf(ang); r = (jj & 1) ? t1 * sn + t2 * cs : t1 * cs - t2 * sn; }
          dbg_report(DBG, 4, bf2f(((const bf16_t*)(R + R_QB))[(size_t)m * 1536 + c]), r, 0.015f, 0.015f); }
        { const int c = hash_u(sid * 3 + 7) % 2048, h = c >> 8, d = c & 255; const float r = dbg_dot_bf_w(CKV, ap->in[9], 128, 2048, c);
          const float got = d < 128 ? bf2f(((const bf16_t*)(R + R_KN))[(size_t)m * 1024 + h * 128 + d]) : bf2f(((const bf16_t*)(R + R_VB))[(size_t)m * 1024 + h * 128 + d - 128]);
          dbg_report(DBG, 5, got, r, 0.015f, 0.015f); } }
    if (l == 0 && op == OP_ATTN) { const int sid = bx * 8 + wave, m = dbg_row(sid), h = hash_u(sid * 5 + 1) & 7, dv = hash_u(sid * 5 + 2) & 127, b = m / SEQ;
        LAS float* qs = (LAS float*)lds + wave * 192; const bf16_t* Q = (const bf16_t*)(R + R_QB) + (size_t)m * 1536 + h * QKD;
        for (int d = lane; d < 192; d += 64) qs[d] = bf2f(Q[d]);
        asm volatile("s_waitcnt lgkmcnt(0)" ::: "memory");
        float mx = -1e30f, ls = 0.f, acc = 0.f;
        for (int kk = lane; kk < SEQ; kk += 64) { const size_t km = (size_t)b * SEQ + kk; const bf16_t* Kn = (const bf16_t*)(R + R_KN) + km * 1024 + h * 128; const bf16_t* Kr = (const bf16_t*)(R + R_KR) + km * 64;
            float s = 0.f; for (int d = 0; d < 128; ++d) s += qs[d] * bf2f(Kn[d]); for (int d = 0; d < 64; ++d) s += qs[128 + d] * bf2f(Kr[d]);
            s *= 0.07216878364870322f; const float v = bf2f(((const bf16_t*)(R + R_VB))[km * 1024 + h * 128 + dv]);
            const float mn = fmaxf(mx, s), al = expf(mx - mn), p = expf(s - mn); ls = ls * al + p; acc = acc * al + p * v; mx = mn; }
        float gm = mx;
        for (int o = 1; o < 64; o <<= 1) gm = fmaxf(gm, __shfl_xor(gm, o));
        const float sc = expf(mx - gm); const float L = wave_sum(ls * sc), Asum = wave_sum(acc * sc);
        if (lane == 0) { const float got = bf2f(((const bf16_t*)(R + R_O))[(size_t)m * 1024 + h * 128 + dv]), ref = Asum / L; atomicMax(DBG + 20, __float_as_uint(fabsf(got - ref))); atomicAdd((float*)(DBG + 21), fabsf(ref) * (1.f / 2048.f)); } }
    if (false && l == 1 && op == OP_HIN && bx < 32) { const int sid = bx * 512 + tid, m = dbg_row(sid), c5 = hash_u(sid * 3 + 8) % 5120, seg = c5 >> 10, c = c5 & 1023;
        const float u = dbg_dot_bf_w(HN + (size_t)m * 1024, ap->in[11], 1024, 5120, c5); float got, r;
        if (seg == 0) { got = bf2f(((const bf16_t*)(R + R_QH))[(size_t)m * 1024 + c]); r = u / (1.f + expf(-u)); }
        else if (seg == 3) { got = bf2f(((const bf16_t*)(R + R_VH))[(size_t)m * 1024 + c]); r = u; }
        else if (seg == 4) { got = bf2f(((const bf16_t*)(R + R_GH))[(size_t)m * 1024 + c]); r = u / (1.f + expf(-u)); }
        else { const int dir = seg - 1; const float* lbp = ap->in[12] + (size_t)dir * DEPTH * 1024 + c; const float e0 = expf(lbp[0]), e1 = expf(lbp[1024]), e2 = expf(lbp[2048]), e3 = expf(lbp[3072]);
            const float lb = e1 / (e0 + e1 + e2 + e3); const h16x2 hv = __builtin_bit_cast(h16x2, (unsigned)((const unsigned short*)(R + R_KF))[(size_t)dir * MT * 1024 + (size_t)m * 1024 + c]);
            got = (float)hv[0]; r = (1.f - lb) / (1.f + expf(u)); }
        dbg_report(DBG, 7, got, r, 0.015f, 0.006f); }
    if (false && l == 1 && op == OP_SCAN) { const int sid = bx * 8 + wave, h = hash_u(sid * 5 + 3) & 7, dv = hash_u(sid * 5 + 4) & 127, b = hash_u(sid * 5 + 5) & 3, toff = sid & 31, dir = 0;
        const bf16_t* Qh = (const bf16_t*)(R + R_QH); const bf16_t* Vh = (const bf16_t*)(R + R_VH); const unsigned short* KF = (const unsigned short*)(R + R_KF); const bf16_t* OPb = (const bf16_t*)(ws + WS_Y);
        float S0 = 0.f, S1 = 0.f; const int n = toff + 1; const int t = toff; const size_t m = (size_t)b * SEQ + t;
        for (int i = 0; i < n; ++i) { const int tt = i; const size_t mm = (size_t)b * SEQ + tt; const unsigned short* kp = KF + (size_t)dir * MT * 1024 + mm * 1024 + h * 128;
            const h16x2 ka = __builtin_bit_cast(h16x2, (unsigned)kp[lane]), kb = __builtin_bit_cast(h16x2, (unsigned)kp[lane + 64]); const float k0 = (float)ka[0], k1 = (float)kb[0];
            const float v = bf2f(Vh[mm * 1024 + h * 128 + dv]); S0 = S0 * (1.f - k0) + k0 * v; S1 = S1 * (1.f - k1) + k1 * v; }
        const bf16_t* q = Qh + m * 1024 + h * 128; const float tot = wave_sum(S0 * bf2f(q[lane]) + S1 * bf2f(q[lane + 64]));
        if (lane == 0) { const float got = bf2f(OPb[(size_t)dir * MT * 1024 + m * 1024 + h * 128 + dv]); const float re = fabsf(got - tot) / (fabsf(tot) + 0.05f);
            if (re > 0.05f) { atomicMin(DBG + 20, (unsigned)toff); atomicAdd(DBG + 21, 1u); } } }
    if (false && l == 1 && op == OP_RHG && bx < 32) { const int sid = bx * 512 + tid, m = dbg_row(sid), c = hash_u(sid * 3 + 9) % 1024, h0 = c & ~127; const bf16_t* OPb = (const bf16_t*)(ws + WS_Y);
        float s = 0.f; for (int k = 0; k < 128; ++k) { const float y = bf2f(OPb[(size_t)m * 1024 + h0 + k]) + bf2f(OPb[(size_t)MT * 1024 + (size_t)m * 1024 + h0 + k]); s += y * y; }
        const float yc = bf2f(OPb[(size_t)m * 1024 + c]) + bf2f(OPb[(size_t)MT * 1024 + (size_t)m * 1024 + c]);
        const float r = yc * rsqrtf(s / 128.f + EPS) * ap->in[13][c] * bf2f(((const bf16_t*)(R + R_GH))[(size_t)m * 1024 + c]);
        dbg_report(DBG, 9, bf2f(((const bf16_t*)(R + R_HO))[(size_t)m * 1024 + c]), r, 0.02f, 0.005f); }
    if (false && l == 1 && op == OP_HWO && bx < 32) { const int sid = bx * 512 + tid, m = dbg_row(sid), c = hash_u(sid * 3 + 10) % 1024;
        const float r = dbg_dot_bf_w((const bf16_t*)(R + R_HO) + (size_t)m * 1024, ap->in[14], 1024, 1024, c);
        dbg_report(DBG, 9, Y[(size_t)m * 1024 + c], r, 0.03f, 0.01f); }
    if (false && l == 0 && op == OP_MWO && bx < 32) { const int sid = bx * 512 + tid, m = dbg_row(sid), c = hash_u(sid * 3 + 11) % 1024;
        const float r = dbg_dot_bf_w((const bf16_t*)(R + R_O) + (size_t)m * 1024, ap->in[10], 1024, 1024, c);
        dbg_report(DBG, 6, Y[(size_t)m * 1024 + c], r, 0.02f, 0.0004f); }
}
#endif

__device__ __forceinline__ void gsync_cg() {
    asm volatile("s_waitcnt vmcnt(0) lgkmcnt(0)" ::: "memory");
    __syncthreads();
    cg::this_grid().sync();
    if (threadIdx.x == 0) { __builtin_amdgcn_fence(__ATOMIC_ACQUIRE, "agent"); asm volatile("s_waitcnt vmcnt(0)" ::: "memory"); }
    __syncthreads();
}
#define GAS __attribute__((address_space(1)))
#define XB_TMO      128
#define XB_XCNT(j)  (256  + 64 * (j))
#define XB_XSUB(j)  (1280 + 64 * (j))
#define XB_XGEN(j)  (2304 + 64 * (j))
#define XB_TOP      3328
#define XB_TOPGEN   3392
#define XCD_BAR_WORDS 3456
#define XB_SPIN_CAP (1u << 18)

__device__ __forceinline__ unsigned xb_ld(unsigned* p)              { return __hip_atomic_load(p, __ATOMIC_RELAXED, __HIP_MEMORY_SCOPE_AGENT); }
__device__ __forceinline__ unsigned xb_add(unsigned* p, unsigned v) { return __hip_atomic_fetch_add(p, v, __ATOMIC_RELAXED, __HIP_MEMORY_SCOPE_AGENT); }
__device__ __forceinline__ unsigned xb_xcc_id() { return (unsigned)__builtin_amdgcn_s_getreg((3 << 11) | 20) & 0xFu; }
#define XB_SPIN(cond, bar) do { unsigned _sp = 0; while (cond) { __builtin_amdgcn_s_sleep(1); \
    if ((++_sp & 255u) == 0u) { if (xb_ld(&(bar)[XB_TMO])) break; if (_sp > XB_SPIN_CAP) { atomicAdd(&(bar)[XB_TMO], 1u); break; } } } } while (0)

struct XcdBarrier {
    unsigned* bar; unsigned x;
    volatile LAS unsigned* st;
};

__device__ __forceinline__ XcdBarrier xcd_barrier_post(unsigned* bar, volatile LAS unsigned* st) {
    XcdBarrier b; b.bar = bar; b.x = xb_xcc_id(); b.st = st;
    if (threadIdx.x == 0) (void)xb_add(&bar[XB_XCNT(b.x)], 1u);
    return b;
}
__device__ __forceinline__ void xcd_barrier_complete(unsigned* bar, unsigned x, unsigned& nloc, unsigned& nx) {
    const unsigned G = gridDim.x * gridDim.y * gridDim.z;
    unsigned sum, cnt, mine, sp = 0u;
    for (;;) {
        sum = 0u; cnt = 0u; mine = 0u;
#pragma unroll
        for (unsigned j = 0; j < 16; ++j) { const unsigned c = xb_ld(&bar[XB_XCNT(j)]); sum += c; cnt += (c > 0u) ? 1u : 0u; mine = (j == x) ? c : mine; }
        if (sum == G) break;
        __builtin_amdgcn_s_sleep(1);
        if ((++sp & 255u) == 0u) { if (xb_ld(&bar[XB_TMO])) break; if (sp > XB_SPIN_CAP) { atomicAdd(&bar[XB_TMO], 1u); break; } }
    }
    nloc = mine > 0u ? mine : 1u; nx = cnt > 0u ? cnt : 1u;
}

__device__ __forceinline__ void xcd_barrier(const XcdBarrier& b) {
    asm volatile("s_waitcnt vmcnt(0)" ::: "memory");
    __syncthreads();
    if (threadIdx.x == 0) {
        unsigned* bar = b.bar;
        __builtin_amdgcn_s_waitcnt(0);
        unsigned nloc = b.st[0], nx = b.st[1];
        if (nloc == 0u) { xcd_barrier_complete(bar, b.x, nloc, nx); b.st[0] = nloc; b.st[1] = nx; }
        const unsigned old = xb_add(&bar[XB_XSUB(b.x)], 1u);
        const unsigned gen = old / nloc;
        if (old + 1u == (gen + 1u) * nloc) {
            __builtin_amdgcn_fence(__ATOMIC_RELEASE, "agent");
            asm volatile("s_waitcnt vmcnt(0)" ::: "memory");
            const unsigned og = xb_add(&bar[XB_TOP], 1u);
            const unsigned tg = og / nx;
            if (og + 1u == (tg + 1u) * nx) xb_add(&bar[XB_TOPGEN], 1u);
            else XB_SPIN(xb_ld(&bar[XB_TOPGEN]) == tg, bar);
            __builtin_amdgcn_fence(__ATOMIC_ACQUIRE, "agent");
            xb_add(&bar[XB_XGEN(b.x)], 1u);
            asm volatile("s_waitcnt vmcnt(0)" ::: "memory");
        } else {
            XB_SPIN(xb_ld(&bar[XB_XGEN(b.x)]) == gen, bar);
            __builtin_amdgcn_fence(__ATOMIC_ACQUIRE, "agent");
            asm volatile("s_waitcnt vmcnt(0)" ::: "memory");
        }
    }
    __syncthreads();
}

__device__ __forceinline__ void gsync(LAS unsigned char* lds) {
#ifdef USE_CG_SYNC
    gsync_cg();
#else
    XcdBarrier b; b.bar = (unsigned*)get_args()->ws; b.x = xb_xcc_id(); b.st = (volatile LAS unsigned*)(lds + LDS_RING);
    xcd_barrier(b);
#endif
}
__global__ void __launch_bounds__(512, 2) mega_fwd(Args a_unused) {
    extern __shared__ __attribute__((aligned(16))) unsigned char lds_raw[];
    LAS unsigned char* lds = (LAS unsigned char*)lds_raw;

    if (threadIdx.x < 2) ((volatile LAS unsigned*)(lds + LDS_RING))[threadIdx.x] = 0u;
    __syncthreads();
    (void)xcd_barrier_post((unsigned*)get_args()->ws, (volatile LAS unsigned*)(lds + LDS_RING));
    {
        ArgsP ap = get_args(); unsigned char* ws = ap->ws;
#ifdef DBG_CHECKS
        if (blockIdx.x == 0 && threadIdx.x < 32) atomicExch((unsigned*)ws + threadIdx.x, 0u);
#endif
        const int tid = threadIdx.x, lane = tid & 63, wave = __builtin_amdgcn_readfirstlane(tid >> 6), G = gridDim.x, bx = blockIdx.x, gw = bx * 8 + wave, NGW = G * 8;
        LAS float* scr = (LAS float*)(lds + wave * 16384);
        constexpr int I_FFI = 16 * 176, I_FFO = 44 * 32, I_HIN = 16 * 160, I_SQ = 16 * 32, I_MIN = 16 * 16, I_UQ = 4 * 48, I_UKV = 2 * 64;
        constexpr int NITEMS = 8 * I_FFI + 8 * I_FFO + 2 * I_HIN + 2 * I_SQ + 2 * I_MIN + 2 * I_UQ + 2 * I_UKV + 2 * I_SQ;
        for (int it = gw; it < NITEMS; it += NGW) {
            int r = it;
#define XP(IDX_, K_, NS_, ND_, MODE_, WSOFF_, NMAT_, IPM_) if (r < (NMAT_) * (IPM_)) { const int mat = r / (IPM_); \
            xpose_item(ap->in[IDX_] + (size_t)mat * (K_) * (NS_), K_, NS_, ND_, MODE_, (bf16_t*)(ws + (WSOFF_)) + (size_t)mat * (ND_) * (K_), scr, r % (IPM_), lane); continue; } r -= (NMAT_) * (IPM_);
            XP(3, 1024, 2 * DFF, 2 * DFF, 1, WS_WFFI, 8, I_FFI)
            XP(4, DFF, 1024, 1024, 0, WS_WFFO, 8, I_FFO)
            XP(11, 1024, 5120, 5120, 0, WS_WHIN, 2, I_HIN)
            XP(14, 1024, 1024, 1024, 0, WS_WHO, 2, I_SQ)
            XP(5, 1024, 448, 512, 2, WS_WMIN, 2, I_MIN)
            XP(8, 256, 1536, 1536, 3, WS_WUQ, 2, I_UQ)
            XP(9, 128, 2048, 2048, 0, WS_WUKV, 2, I_UKV)
            XP(10, 1024, 1024, 1024, 0, WS_WMO, 2, I_SQ)
#undef XP
        }
        { const int* positions = (const int*)ap->in[1]; float* COS = (float*)(ws + WS_COS); float* SIN = (float*)(ws + WS_SIN);
          for (int idx = bx * 512 + tid; idx < MT * 32; idx += G * 512) { const int m = idx >> 5, i = idx & 31;
            const double ang = (double)positions[m] * ROPE_INVF[i]; const double rev = ang * 0.15915494309189535; const float fr = (float)(rev - __builtin_rint(rev));
            COS[idx] = __builtin_amdgcn_cosf(fr); SIN[idx] = __builtin_amdgcn_sinf(fr); } }
        { float* LB = (float*)(ws + WS_LB);
          for (int idx = bx * 512 + tid; idx < 2 * 2 * 1024; idx += G * 512) { const int c = idx & 1023, dir = (idx >> 10) & 1, j = idx >> 11, l = 2 * j + 1;
            const float* lbp = ap->in[12] + (size_t)dir * DEPTH * 1024 + c; float v[4], mx = -1e30f;
#pragma unroll
            for (int i = 0; i < 4; ++i) { v[i] = lbp[i * 1024]; mx = fmaxf(mx, v[i]); }
            float den = 0.f, num = 0.f;
#pragma unroll
            for (int i = 0; i < 4; ++i) { const float e = __expf(v[i] - mx); den += e; if (i >= 1 && i <= l) num += e; }
            LB[idx] = num / den; } }
        { const float* x_in = ap->in[0]; float* X = ap->out; bf16_t* HN = (bf16_t*)(ws + WS_HN); const float* gains = ap->in[2];
          for (int m = gw; m < MT; m += NGW) row_init(x_in + (size_t)m * DM, X + (size_t)m * DM, HN + (size_t)m * DM, gains, lane); }
    }
    gsync_cg();

    for (int ph = 0; ph < 46; ++ph) {
        const int l = ph >= 35 ? 3 : (ph >= 23 ? 2 : (ph >= 12 ? 1 : 0)), s = ph - (l == 3 ? 35 : (l == 2 ? 23 : (l == 1 ? 12 : 0)));
        const bool hg = l & 1; const int j = l >> 1;
        const int op = hg ? OPS_H[s] : OPS_M[s];
        ArgsP ap = get_args(); unsigned char* ws = ap->ws; unsigned char* R = ws + WS_R;
        int G_ = gridDim.x, bx_ = blockIdx.x; asm volatile("" : "+s"(G_), "+s"(bx_));
        switch (op) {
        case OP_SW0: case OP_SW1: {
            const int half = op == OP_SW1;
            pg8::Gemm gm{(const bf16_t*)(ws + WS_HN), (const bf16_t*)(ws + WS_WFFI) + (size_t)(l * 2 + half) * (2 * DFF) * 1024, MT, 2 * DFF, 1024};
            pg8::StaticOrder S; S.init(MT, 2 * DFF, G_, bx_); EpiSwiglu E{(bf16_t*)(R + R_ACT)};
#ifndef NO_SW
            pg8::gemm_phase<EpiSwiglu, pg8::StaticOrder, true, true>(lds, gm, S, E);
#endif
        } break;
        case OP_FO0: case OP_FO1: case OP_MIN: case OP_MWO: case OP_HWO: {
            pg8::Gemm gm; EpiF32 E; float* Y = (float*)(ws + WS_Y);
            if (op == OP_FO0 || op == OP_FO1) { const int half = op == OP_FO1; gm = pg8::Gemm{(const bf16_t*)(R + R_ACT), (const bf16_t*)(ws + WS_WFFO) + (size_t)(l * 2 + half) * 1024 * DFF, MT, 1024, DFF}; E = EpiF32{Y, 1024}; }
            else if (op == OP_MIN) { gm = pg8::Gemm{(const bf16_t*)(ws + WS_HN), (const bf16_t*)(ws + WS_WMIN) + (size_t)j * 512 * 1024, MT, 512, 1024}; E = EpiF32{(float*)(R + R_C), 512}; }
            else if (op == OP_MWO) { gm = pg8::Gemm{(const bf16_t*)(R + R_O), (const bf16_t*)(ws + WS_WMO) + (size_t)j * 1024 * 1024, MT, 1024, 1024}; E = EpiF32{Y, 1024}; }
            else { gm = pg8::Gemm{(const bf16_t*)(R + R_HO), (const bf16_t*)(ws + WS_WHO) + (size_t)j * 1024 * 1024, MT, 1024, 1024}; E = EpiF32{Y, 1024}; }
            pg8::StaticOrder S; S.init(MT, gm.N, G_, bx_);
#ifndef NO_F32
            pg8::gemm_phase<EpiF32, pg8::StaticOrder, true, true>(lds, gm, S, E);
#endif
        } break;
        case OP_RPA: case OP_RPB: case OP_RPC: {
            const float* gains = ap->in[2]; const float* g = gains + (size_t)l * 6 * DM; float* Y = (float*)(ws + WS_Y); float* X = ap->out; bf16_t* HN = (bf16_t*)(ws + WS_HN);
            const int k = op == OP_RPA ? 1 : (op == OP_RPB ? 3 : 5); const float scale = op == OP_RPB ? 1.0f : 0.5f;
            const bool last = (op == OP_RPC) && (l == DEPTH - 1);
            const float* gn = op == OP_RPC ? gains + (size_t)(l + 1) * 6 * DM : g + (size_t)(k + 1) * DM;
            const int lane = LANE_;
            for (int m = bx_ * 8 + __builtin_amdgcn_readfirstlane(otid_() >> 6); m < MT; m += G_ * 8) row_post(Y + (size_t)m * DM, X + (size_t)m * DM, last ? (bf16_t*)nullptr : HN + (size_t)m * DM, scale, g + (size_t)k * DM, last ? g : gn, lane);
        } break;
        case OP_RMLA: {
            const float* qn = ap->in[6] + (size_t)j * QLR; const float* kvn = ap->in[7] + (size_t)j * KVLR; const float* COS = (const float*)(ws + WS_COS); const float* SIN = (const float*)(ws + WS_SIN);
            const int lane = LANE_;
            for (int m = bx_ * 8 + __builtin_amdgcn_readfirstlane(otid_() >> 6); m < MT; m += G_ * 8) row_mla((const float*)(R + R_C) + (size_t)m * 512, (bf16_t*)(R + R_CQ) + (size_t)m * 256, (bf16_t*)(R + R_CKV) + (size_t)m * 128, (bf16_t*)(R + R_KR) + (size_t)m * 64,
                                                         qn, kvn, COS + (size_t)m * 32, SIN + (size_t)m * 32, lane);
        } break;
        case OP_QKV: {
            { int Kq = 256; asm volatile("" : "+s"(Kq)); pg8::Gemm gm{(const bf16_t*)(R + R_CQ), (const bf16_t*)(ws + WS_WUQ) + (size_t)j * 1536 * 256, MT, 1536, Kq};
              pg8::StaticOrder S; S.init(MT, 1536, G_, bx_); EpiQ E{(bf16_t*)(R + R_QB), (const float*)(ws + WS_COS), (const float*)(ws + WS_SIN)};
#ifndef NO_Q
              pg8::gemm_phase<EpiQ, pg8::StaticOrder, true, true>(lds, gm, S, E);
#endif
            }
            __syncthreads();
            { int Kq = 128; asm volatile("" : "+s"(Kq)); pg8::Gemm gm{(const bf16_t*)(R + R_CKV), (const bf16_t*)(ws + WS_WUKV) + (size_t)j * 2048 * 128, MT, 2048, Kq};
              pg8::StaticOrder S; S.init(MT, 2048, G_, bx_); EpiKV E{(bf16_t*)(R + R_KN), (bf16_t*)(R + R_VB)};
#ifndef NO_KV
              pg8::gemm_phase<EpiKV, pg8::StaticOrder, true, true>(lds, gm, S, E);
#endif
            }
        } break;
        case OP_ATTN: {
#ifndef NO_ATTN
            const int G = G_, bx = bx_;

            const int vcu = (G % 8 == 0) ? (bx % 8) * (G / 8) + bx / 8 : bx;
#ifdef REP_ATTN
            for (int rep_ = 0; rep_ < 2; ++rep_)
#endif
            for (int uid = vcu; uid < BATCH * NH * (SEQ / 256); uid += G) {
                const int bh = uid >> 5, qb = uid & 31, b = bh >> 3, h = bh & 7;
                const size_t row0 = (size_t)b * SEQ;
                att::attn_unit((const att::bf16*)(R + R_QB) + (row0 + qb * 256) * 1536 + h * QKD, (const att::bf16*)(R + R_KN) + row0 * 1024 + h * 128,
                               (const att::bf16*)(R + R_KR) + row0 * 64, (const att::bf16*)(R + R_VB) + row0 * 1024 + h * 128,
                               (att::bf16*)(R + R_O) + (row0 + qb * 256) * 1024 + h * 128, SEQ, (char*)lds_raw);
            }
#endif
        } break;
        case OP_HIN: {
            pg8::Gemm gm{(const bf16_t*)(ws + WS_HN), (const bf16_t*)(ws + WS_WHIN) + (size_t)j * 5120 * 1024, MT, 5120, 1024};
            pg8::StaticOrder S; S.init(MT, 5120, G_, bx_);
            EpiHgrn E{(bf16_t*)(R + R_QH), (bf16_t*)(R + R_VH), (bf16_t*)(R + R_GH), (unsigned short*)(R + R_KF), (const float*)(ws + WS_LB) + (size_t)j * 2048};
#ifndef NO_HG
            pg8::gemm_phase<EpiHgrn, pg8::StaticOrder, true, true>(lds, gm, S, E);
#endif
        } break;
        case OP_SCAN: {
#ifndef NO_SCAN
#ifdef REP_SCAN
            scan_phase(lds, (const bf16_t*)(R + R_QH), (const bf16_t*)(R + R_VH), (const unsigned short*)(R + R_KF), (bf16_t*)(ws + WS_Y), G_, bx_); __syncthreads();
#endif
            scan_phase(lds, (const bf16_t*)(R + R_QH), (const bf16_t*)(R + R_VH), (const unsigned short*)(R + R_KF), (bf16_t*)(ws + WS_Y), G_, bx_);
#endif
        } break;
        case OP_RHG: {
            const float* on = ap->in[13] + (size_t)j * DM; const bf16_t* Y = (const bf16_t*)(ws + WS_Y);
            const int lane = LANE_;
            for (int m = bx_ * 8 + __builtin_amdgcn_readfirstlane(otid_() >> 6); m < MT; m += G_ * 8) row_hgrn(Y + (size_t)m * DM, (const bf16_t*)(R + R_GH) + (size_t)m * DM, (bf16_t*)(R + R_HO) + (size_t)m * DM, on, lane);
        } break;
        default: break;
        }
        if (ph != 45) gsync(lds);
#ifdef REP_SYNC
        gsync(lds);
#endif
#ifdef DBG_CHECKS
        { ArgsP ap2 = get_args(); dbg_after(l, op, ap2, ap2->ws, ap2->ws + WS_R, lds); gsync(lds); }
#endif
    }
#ifdef DBG_CHECKS
    gsync(lds);
    if (blockIdx.x == 0 && threadIdx.x == 0) { ArgsP ap = get_args(); unsigned* DBG = (unsigned*)ap->ws; const float mx = __uint_as_float(atomicAdd(DBG + 20, 0u)), mean = atomicAdd((float*)(DBG + 21), 0.f); ap->out[1024 * 16] += 1e6f * mx; ap->out[1024 * 16 + 1] += 1e4f * mean; }
#endif
}

extern "C" void kernel_launch(void* const* d_in, const int* in_sizes, int n_in, void* d_out, int out_size, void* d_ws, size_t ws_size, hipStream_t stream) {
    static int grid = 0;
    if (grid == 0) {
        if (n_in != 15 || out_size != MT * DM || ws_size < WS_END) { fprintf(stderr, "kernel_launch: unexpected shapes: n_in %d out %d ws %zu (need %zu)\n", n_in, out_size, ws_size, (size_t)WS_END); grid = -1; return; }
        int dev = 0, cus = 0, per_cu = 0;
        (void)hipGetDevice(&dev); (void)hipDeviceGetAttribute(&cus, hipDeviceAttributeMultiprocessorCount, dev);
        if (hipFuncSetAttribute((const void*)mega_fwd, hipFuncAttributeMaxDynamicSharedMemorySize, LDS_BYTES) != hipSuccess) { fprintf(stderr, "kernel_launch: hipFuncSetAttribute failed\n"); grid = -1; return; }
        if (hipOccupancyMaxActiveBlocksPerMultiprocessor(&per_cu, (const void*)mega_fwd, 512, LDS_BYTES) != hipSuccess || per_cu < 1) { fprintf(stderr, "kernel_launch: occupancy query gave %d\n", per_cu); per_cu = 1; }
        (void)hipGetLastError();
        grid = cus * 1;
        fprintf(stderr, "kernel_launch: cus %d per_cu %d grid %d\n", cus, per_cu, grid);
    }
    if (grid < 0) return;
    if (hipMemsetAsync(d_ws, 0, 65536, stream) != hipSuccess) { fprintf(stderr, "kernel_launch: memset failed\n"); return; }
    Args a{};
    for (int i = 0; i < 15; ++i) a.in[i] = (const float*)d_in[i];
    a.out = (float*)d_out; a.ws = (unsigned char*)d_ws;
    void* args[] = {&a};
    hipError_t e = hipLaunchCooperativeKernel((const void*)mega_fwd, dim3(grid), dim3(512), args, LDS_BYTES, stream);
    if (e != hipSuccess) fprintf(stderr, "cooperative launch failed: %s (grid %d)\n", hipGetErrorString(e), grid);
}
```

```cpp
#include <hip/hip_runtime.h>
#include <hip/hip_cooperative_groups.h>
#include <hip/hip_bf16.h>
#include <hip/hip_fp16.h>
#include <cstdio>
#include <cstdint>
#include <cmath>
namespace cg = cooperative_groups;
namespace pg8 {
#define PG8_LAS __attribute__((address_space(3)))
typedef unsigned short bf16_t;
typedef short bf16x8 __attribute__((ext_vector_type(8)));
typedef float f32x4 __attribute__((ext_vector_type(4)));
typedef unsigned u32x4 __attribute__((ext_vector_type(4)));
constexpr int BM = 256, BK = 64, HALF = 128, HTB = HALF * BK * 2  , STAGE_BYTES = 8 * HTB, NXCD = 8, WGM = 8;

__host__ __device__ __forceinline__ int lds_byte(int r, int c) { const int st = (r >> 4) * 2 + (c >> 5), rr = r & 15, cc = c & 31, ob = rr * 64 + cc * 2; return st * 1024 + (ob ^ (((ob >> 9) & 1) << 5)); }
__host__ __device__ __forceinline__ void stage_rc(int b, int& R, int& C) { const int st = b / 1024, sb = b % 1024, swz = sb ^ (((sb >> 9) & 1) << 5); R = (st >> 1) * 16 + swz / 64; C = (st & 1) * 32 + (swz % 64) / 2; }
__host__ __device__ __forceinline__ int perm32(int rho) { const int n = rho >> 4, i = rho & 15; return 8 * (i >> 2) + 4 * n + (i & 3); }

struct Unit { int pm, pn; };
struct Gemm { const bf16_t* A; const bf16_t* Bt; int M, N, K; };

struct StaticOrder {
    int nM, nN, nwg, G, c;
    __host__ __device__ void init(int M, int N, int G_, int c_) { nM = M / BM; nN = N / BM; nwg = nM * nN; G = G_; c = c_; }
    __host__ __device__ bool next(int i, Unit& u) const {
        const long L = (long)i * G + c; if (L >= nwg) return false;
        int wgid = (int)L; { const int q = nwg / NXCD, r = nwg % NXCD, xcd = wgid % NXCD, off = wgid / NXCD; wgid = (xcd < r ? xcd * (q + 1) : r * (q + 1) + (xcd - r) * q) + off; }
        const int nig = WGM * nN, gid = wgid / nig, fm = gid * WGM, gsz = (nM - fm) < WGM ? (nM - fm) : WGM;
        u.pm = fm + ((wgid % nig) % gsz); u.pn = (wgid % nig) / gsz; return true;
    }
    __device__ __forceinline__ void a_ready(const Unit&) const {}
    __device__ __forceinline__ void done(const Unit&) const {}
};

__device__ __forceinline__ unsigned cvt_pk_bf16(float lo, float hi) { unsigned r; asm volatile("v_cvt_pk_bf16_f32 %0, %1, %2" : "=v"(r) : "v"(lo), "v"(hi)); return r; }
template <class Epi, class Sched, bool ALIGN_EPI = false, bool SP2 = false>
__device__ __forceinline__ void gemm_phase(PG8_LAS unsigned char* lds, const Gemm g, const Sched& S, const Epi& E) {
    int tid = threadIdx.x; asm volatile("" : "+v"(tid)); const int wid = __builtin_amdgcn_readfirstlane(tid >> 6), lane = tid & 63, wr = wid >> 2, wc = wid & 3, fr = lane & 15, fq = lane >> 4;
    const int K = g.K, nt = K / BK;
    unsigned voffA[2], voffB[2];
#pragma unroll
    for (int i = 0; i < 2; ++i) { int R, C; stage_rc(tid * 16 + i * 8192, R, C); const int Rb = Epi::PERM ? ((R & ~31) + perm32(R & 31)) : R;
        voffA[i] = (unsigned)(R * K + C) * 2u; voffB[i] = (unsigned)(Rb * K + C) * 2u; }
    const size_t kstep = (size_t)(BK * 2);
    const size_t hstep = (size_t)HALF * K * 2;
    const size_t tstep = 2 * hstep;
    const unsigned ldsw = (unsigned)wid * 1024u;
    const int aoff = lds_byte(wr * 64 + fr, fq * 8), boff = lds_byte(wc * 32 + fr, fq * 8);
#define PG8_SA(b, h) (((b) * 2 + (h)) * HTB)
#define PG8_SB(b, h) ((4 + (b) * 2 + (h)) * HTB)
#define PG8_STAGE(bufoff, gbase, voff) do { _Pragma("unroll") for (int _i = 0; _i < 2; ++_i) \
        __builtin_amdgcn_global_load_lds((const unsigned*)((const char*)(gbase) + (voff)[_i]), (PG8_LAS unsigned*)(lds + (bufoff) + ldsw + _i * 8192), 16, 0, 0); } while (0)
#define PG8_LDA(dst, b, h) do { _Pragma("unroll") for (int m = 0; m < 4; ++m) _Pragma("unroll") for (int k = 0; k < 2; ++k) dst[m][k] = *(const PG8_LAS bf16x8*)(lds + PG8_SA(b, h) + aoff + m * 2048 + k * 1024); } while (0)
#define PG8_LDB(dst, b, h) do { _Pragma("unroll") for (int n = 0; n < 2; ++n) _Pragma("unroll") for (int k = 0; k < 2; ++k) dst[n][k] = *(const PG8_LAS bf16x8*)(lds + PG8_SB(b, h) + boff + n * 2048 + k * 1024); } while (0)
#define PG8_MMA(ai, bj, At, Bt) do { __builtin_amdgcn_s_setprio(1); _Pragma("unroll") for (int m = 0; m < 4; ++m) _Pragma("unroll") for (int n = 0; n < 2; ++n) _Pragma("unroll") for (int k = 0; k < 2; ++k) \
        acc[ai][bj][m][n] = __builtin_amdgcn_mfma_f32_16x16x32_bf16(Bt[n][k], At[m][k], acc[ai][bj][m][n], 0, 0, 0); __builtin_amdgcn_s_setprio(0); } while (0)
#define PG8_WAIT_V(n) asm volatile("s_waitcnt vmcnt(" #n ")" ::: "memory")
#define PG8_WAIT_L(n) asm volatile("s_waitcnt lgkmcnt(" #n ")" ::: "memory")
#define PG8_BAR __builtin_amdgcn_s_barrier()
#define PG8_SCHED __builtin_amdgcn_sched_barrier(0)
    Unit cur, nxt; int ui = 0;
    if (!S.next(0, cur)) return;
    f32x4 acc[2][2][4][2];
#pragma unroll
    for (int a = 0; a < 2; ++a)
#pragma unroll
        for (int b = 0; b < 2; ++b)
#pragma unroll
            for (int m = 0; m < 4; ++m)
#pragma unroll
                for (int n = 0; n < 2; ++n) acc[a][b][m][n] = (f32x4){0.f, 0.f, 0.f, 0.f};
    bf16x8 At[4][2], B0[2][2], B1[2][2];
    const char* cA = (const char*)g.A + (size_t)cur.pm * tstep; const char* cB = (const char*)g.Bt + (size_t)cur.pn * tstep;
    S.a_ready(cur);
    if constexpr (SP2) {
        PG8_STAGE(PG8_SB(0, 0), cB, voffB); PG8_STAGE(PG8_SB(0, 1), cB + hstep, voffB); PG8_STAGE(PG8_SA(0, 0), cA, voffA); PG8_STAGE(PG8_SA(0, 1), cA + hstep, voffA);
        if (wr == 1) PG8_BAR;
        PG8_WAIT_V(2); PG8_BAR;
        PG8_STAGE(PG8_SB(1, 0), cB + kstep, voffB); PG8_STAGE(PG8_SA(1, 0), cA + kstep, voffA); PG8_STAGE(PG8_SB(1, 1), cB + hstep + kstep, voffB);
        PG8_WAIT_V(6); PG8_BAR;
    } else {
        PG8_STAGE(PG8_SB(0, 0), cB, voffB); PG8_STAGE(PG8_SA(0, 0), cA, voffA); PG8_STAGE(PG8_SB(0, 1), cB + hstep, voffB); PG8_STAGE(PG8_SA(0, 1), cA + hstep, voffA);
        if (wr == 1) PG8_BAR;
        PG8_WAIT_V(4); PG8_BAR;
        PG8_STAGE(PG8_SB(1, 0), cB + kstep, voffB); PG8_STAGE(PG8_SA(1, 0), cA + kstep, voffA); PG8_STAGE(PG8_SB(1, 1), cB + hstep + kstep, voffB);
        PG8_WAIT_V(6); PG8_BAR;
    }
    for (;;) {
        const bool has_next = S.next(ui + 1, nxt);
        const char* nA = has_next ? (const char*)g.A + (size_t)nxt.pm * tstep : cA; const char* nB = has_next ? (const char*)g.Bt + (size_t)nxt.pn * tstep : cB;
        for (int t = 0; t < nt; t += 2) {
            const bool last = (t == nt - 2);
            const char* a1 = cA + (size_t)(t + 1) * kstep;
            const char* a2 = last ? nA : cA + (size_t)(t + 2) * kstep; const char* b2 = last ? nB : cB + (size_t)(t + 2) * kstep;
            const char* a3 = a2 + kstep; const char* b3 = b2 + kstep;
            if (last && has_next) S.a_ready(nxt);
            if constexpr (SP2) {
            PG8_LDB(B0, 0, 0); PG8_LDB(B1, 0, 1); PG8_SCHED; PG8_LDA(At, 0, 0); PG8_STAGE(PG8_SA(1, 1), a1 + hstep, voffA);
            PG8_WAIT_V(8); PG8_WAIT_L(0); PG8_BAR; PG8_MMA(0, 0, At, B0); PG8_MMA(0, 1, At, B1); PG8_BAR; PG8_SCHED;
            PG8_LDA(At, 0, 1); PG8_STAGE(PG8_SB(0, 0), b2, voffB); PG8_STAGE(PG8_SB(0, 1), b2 + hstep, voffB); PG8_STAGE(PG8_SA(0, 0), a2, voffA);
            PG8_WAIT_V(8); PG8_WAIT_L(0); PG8_BAR; PG8_MMA(1, 0, At, B0); PG8_MMA(1, 1, At, B1); PG8_BAR; PG8_SCHED;
            PG8_LDB(B0, 1, 0); PG8_LDB(B1, 1, 1); PG8_SCHED; PG8_LDA(At, 1, 0); PG8_STAGE(PG8_SA(0, 1), a2 + hstep, voffA);
            PG8_WAIT_V(8); PG8_WAIT_L(0); PG8_BAR; PG8_MMA(0, 0, At, B0); PG8_MMA(0, 1, At, B1); PG8_BAR; PG8_SCHED;
            PG8_LDA(At, 1, 1); PG8_STAGE(PG8_SB(1, 0), b3, voffB); PG8_STAGE(PG8_SB(1, 1), b3 + hstep, voffB); PG8_STAGE(PG8_SA(1, 0), a3, voffA);
            PG8_WAIT_V(8); PG8_WAIT_L(0); PG8_BAR; PG8_MMA(1, 0, At, B0); PG8_MMA(1, 1, At, B1); PG8_BAR; PG8_SCHED;
            } else {
            PG8_LDB(B0, 0, 0); PG8_SCHED; PG8_LDA(At, 0, 0); PG8_STAGE(PG8_SA(1, 1), a1 + hstep, voffA);
            PG8_WAIT_L(8); PG8_BAR; PG8_WAIT_L(0); PG8_MMA(0, 0, At, B0); PG8_BAR; PG8_SCHED;
            PG8_LDB(B1, 0, 1); PG8_STAGE(PG8_SB(0, 0), b2, voffB);
            PG8_BAR; PG8_WAIT_L(0); PG8_MMA(0, 1, At, B1); PG8_BAR;
            PG8_LDA(At, 0, 1); PG8_STAGE(PG8_SA(0, 0), a2, voffA);
            PG8_BAR; PG8_WAIT_L(0); PG8_MMA(1, 0, At, B0); PG8_BAR; PG8_SCHED;
            PG8_STAGE(PG8_SB(0, 1), b2 + hstep, voffB);
            PG8_WAIT_V(6); PG8_BAR; PG8_MMA(1, 1, At, B1); PG8_BAR;
            PG8_LDB(B0, 1, 0); PG8_SCHED; PG8_LDA(At, 1, 0); PG8_STAGE(PG8_SA(0, 1), a2 + hstep, voffA);
            PG8_WAIT_L(8); PG8_BAR; PG8_WAIT_L(0); PG8_MMA(0, 0, At, B0); PG8_BAR; PG8_SCHED;
            PG8_LDB(B1, 1, 1); PG8_STAGE(PG8_SB(1, 0), b3, voffB);
            PG8_BAR; PG8_WAIT_L(0); PG8_MMA(0, 1, At, B1); PG8_BAR;
            PG8_LDA(At, 1, 1); PG8_STAGE(PG8_SA(1, 0), a3, voffA);
            PG8_BAR; PG8_WAIT_L(0); PG8_MMA(1, 0, At, B0); PG8_BAR; PG8_SCHED;
            PG8_STAGE(PG8_SB(1, 1), b3 + hstep, voffB);
            PG8_WAIT_V(6); PG8_BAR; PG8_MMA(1, 1, At, B1); PG8_BAR;
            }
        }
        if constexpr (ALIGN_EPI) { if (wr == 0) PG8_BAR; }
        if constexpr (!Epi::AFTER_DRAIN) { E(acc, cur, wr, wc, fr, fq); S.done(cur); }
        if (!has_next) break;
#pragma unroll
        for (int a = 0; a < 2; ++a)
#pragma unroll
            for (int b = 0; b < 2; ++b)
#pragma unroll
                for (int m = 0; m < 4; ++m)
#pragma unroll
                    for (int n = 0; n < 2; ++n) acc[a][b][m][n] = (f32x4){0.f, 0.f, 0.f, 0.f};
        cur = nxt; cA = nA; cB = nB; ++ui;
        if constexpr (ALIGN_EPI) { if (wr == 1) PG8_BAR; }
    }
    PG8_WAIT_V(0);
    if constexpr (!ALIGN_EPI) { if (wr == 0) PG8_BAR; }
    PG8_BAR;
    if constexpr (Epi::AFTER_DRAIN) { E.fused(acc, cur, wr, wc, fr, fq, lds, wid, lane); S.done(cur); }
#undef PG8_SA
#undef PG8_SB
#undef PG8_STAGE
#undef PG8_LDA
#undef PG8_LDB
#undef PG8_MMA
#undef PG8_WAIT_V
#undef PG8_WAIT_L
#undef PG8_BAR
#undef PG8_SCHED
}
}
#ifndef ATT_SDEPTH
#define ATT_SDEPTH 1
#endif
namespace att {
using bf16 = __hip_bfloat16;
constexpr int NW = 8, QBLK = 32, KVBLK = 64;
constexpr float SCALE = 0.07216878364870322f;
constexpr float THR = 8.f;
__device__ __forceinline__ int otid() { int t = threadIdx.x; asm volatile("" : "+v"(t)); return t; }
using bf16x8 = __attribute__((ext_vector_type(8))) short;
using s16x4  = __attribute__((ext_vector_type(4))) short;
using f32x16 = __attribute__((ext_vector_type(16))) float;
using f32x8  = __attribute__((ext_vector_type(8))) float;
using u32x4  = __attribute__((ext_vector_type(4))) unsigned;
#define KSWZ(row, colB) ((row) * 256 + ((colB) ^ (((row) & 7) << 4)))
#define SBAR() __builtin_amdgcn_sched_barrier(0)
__device__ __forceinline__ int crow(int r, int hi) { return (r & 3) + 8 * (r >> 2) + 4 * hi; }
__device__ __forceinline__ unsigned cvtpk(float lo, float hi) {
  unsigned r; asm volatile("v_cvt_pk_bf16_f32 %0, %1, %2" : "=v"(r) : "v"(lo), "v"(hi)); return r;
}
template <typename TIn> struct Stage;
template <> struct Stage<bf16>  { using T = bf16x8;
  __device__ static __forceinline__ T ld8(const bf16* p) { return *reinterpret_cast<const bf16x8*>(p); }
  __device__ static __forceinline__ bf16x8 tobf(T x) { return x; } };
template <> struct Stage<float> { using T = f32x8;
  __device__ static __forceinline__ T ld8(const float* p) { return *reinterpret_cast<const f32x8*>(p); }
  __device__ static __forceinline__ bf16x8 tobf(T x) {
    u32x4 w = {cvtpk(x[0], x[1]), cvtpk(x[2], x[3]), cvtpk(x[4], x[5]), cvtpk(x[6], x[7])}; return *reinterpret_cast<bf16x8*>(&w); } };

__device__ __forceinline__ void partialSM(f32x16& p0, f32x16& p1, float& m_reg, float& mn, float& alpha) {
  constexpr float C = SCALE * 1.4426950408889634f;
  float pmax = p0[0]; for (int r = 1; r < 16; ++r) pmax = fmaxf(pmax, p0[r]); for (int r = 0; r < 16; ++r) pmax = fmaxf(pmax, p1[r]);
  { auto rr = __builtin_amdgcn_permlane32_swap(__float_as_uint(pmax), __float_as_uint(pmax), false, false);
    pmax = fmaxf(__uint_as_float(rr[0]), __uint_as_float(rr[1])); }
  if (__builtin_expect(__all(pmax - m_reg <= THR / SCALE), 1)) { mn = m_reg; alpha = 1.f; }
  else { mn = fmaxf(m_reg, pmax); alpha = __builtin_amdgcn_exp2f((m_reg - mn) * C); m_reg = mn; }
  float mnC = -mn * C;
  for (int r = 0; r < 16; ++r) p0[r] = fmaf(p0[r], C, mnC); for (int r = 0; r < 16; ++r) p1[r] = fmaf(p1[r], C, mnC);
  for (int r = 0; r < 16; ++r) p0[r] = __builtin_amdgcn_exp2f(p0[r]);
}
__device__ __forceinline__ void finishSM(f32x16& p0, f32x16& p1, float alpha, float& l_reg, bf16x8& pa0, bf16x8& pa1, bf16x8& pa2, bf16x8& pa3) {
  for (int r = 0; r < 16; ++r) p1[r] = __builtin_amdgcn_exp2f(p1[r]);
  float ps = 0; for (int r = 0; r < 16; ++r) ps += p0[r]; for (int r = 0; r < 16; ++r) ps += p1[r];
  { auto rr = __builtin_amdgcn_permlane32_swap(__float_as_uint(ps), __float_as_uint(ps), false, false);
    ps = __uint_as_float(rr[0]) + __uint_as_float(rr[1]); }
  l_reg = l_reg * alpha + ps;
#define PK4(P, BASE, OUT) do { unsigned a0 = cvtpk(P[BASE + 0], P[BASE + 1]), a1 = cvtpk(P[BASE + 2], P[BASE + 3]);   \
    unsigned b0 = cvtpk(P[BASE + 4], P[BASE + 5]), b1 = cvtpk(P[BASE + 6], P[BASE + 7]);                              \
    auto r0 = __builtin_amdgcn_permlane32_swap(a0, b0, false, false); auto r1 = __builtin_amdgcn_permlane32_swap(a1, b1, false, false); \
    u32x4 w = {r0[0], r1[0], r0[1], r1[1]}; OUT = *reinterpret_cast<bf16x8*>(&w); } while (0)
  PK4(p0, 0, pa0); PK4(p0, 8, pa1); PK4(p1, 0, pa2); PK4(p1, 8, pa3);
#undef PK4
}
#define KSWZ2(row, colB) ((row) * 128 + ((colB) ^ (((row) & 7) << 4)))
__device__ __forceinline__ void qkt(f32x16& p0, f32x16& p1, const bf16* Ks, const bf16* KRs, const bf16x8* qr, const bf16x8* qrl, int r32, int hi) {
  p0 = f32x16{}; p1 = f32x16{};
#pragma unroll
  for (int d0 = 0; d0 < 8; ++d0) { int cb = (d0 * 16 + hi * 8) * 2;
    bf16x8 b0 = *reinterpret_cast<const bf16x8*>((const char*)Ks + KSWZ(r32, cb));
    bf16x8 b1 = *reinterpret_cast<const bf16x8*>((const char*)Ks + KSWZ(32 + r32, cb));
    p0 = __builtin_amdgcn_mfma_f32_32x32x16_bf16(b0, qr[d0], p0, 0, 0, 0);
    p1 = __builtin_amdgcn_mfma_f32_32x32x16_bf16(b1, qr[d0], p1, 0, 0, 0); }
#pragma unroll
  for (int d0 = 0; d0 < 4; ++d0) { int cb = (d0 * 16 + hi * 8) * 2;
    bf16x8 b0 = *reinterpret_cast<const bf16x8*>((const char*)KRs + KSWZ2(r32, cb));
    bf16x8 b1 = *reinterpret_cast<const bf16x8*>((const char*)KRs + KSWZ2(32 + r32, cb));
    const bf16x8 qv = qrl[d0 * 64];
    p0 = __builtin_amdgcn_mfma_f32_32x32x16_bf16(b0, qv, p0, 0, 0, 0);
    p1 = __builtin_amdgcn_mfma_f32_32x32x16_bf16(b1, qv, p1, 0, 0, 0); }
}
__device__ __forceinline__ int v_st(int k, int c) { const int kk = (k & ~0xC) | ((k & 4) << 1) | ((k & 8) >> 1); return ((kk >> 3) * 4 + (c >> 5)) * 512 + ((kk & 7) * 32 + (c & 31)) * 2; }
__device__ __forceinline__ int v_rd_base(int lane) { return ((lane & 3) << 3) | (((lane >> 2) & 3) << 6) | (((lane >> 4) & 1) << 5) | (((lane >> 5) & 1) << 8); }
constexpr int v_rd_off(int d0, int ks, int half) { return d0 * 512 + ks * 4096 + half * 2048; }
template <int OFF> __device__ __forceinline__ s16x4 tr_read(int vb) {
  s16x4 r; asm volatile("ds_read_b64_tr_b16 %0, %1 offset:%2" : "=&v"(r) : "v"(vb), "i"(OFF) : "memory"); return r;
}
template <int D0> __device__ __forceinline__ void pv_one(f32x16& od, int vb, bf16x8 pa0, bf16x8 pa1, bf16x8 pa2, bf16x8 pa3) {
  const s16x4 l0 = tr_read<v_rd_off(D0, 0, 0)>(vb), h0 = tr_read<v_rd_off(D0, 0, 1)>(vb), l1 = tr_read<v_rd_off(D0, 1, 0)>(vb), h1 = tr_read<v_rd_off(D0, 1, 1)>(vb);
  const s16x4 l2 = tr_read<v_rd_off(D0, 2, 0)>(vb), h2 = tr_read<v_rd_off(D0, 2, 1)>(vb), l3 = tr_read<v_rd_off(D0, 3, 0)>(vb), h3 = tr_read<v_rd_off(D0, 3, 1)>(vb);
  asm volatile("s_waitcnt lgkmcnt(0)" ::: "memory"); SBAR();
#define PK(L, H) (bf16x8){L[0], L[1], L[2], L[3], H[0], H[1], H[2], H[3]}
  od = __builtin_amdgcn_mfma_f32_32x32x16_bf16(pa0, PK(l0, h0), od, 0, 0, 0);
  od = __builtin_amdgcn_mfma_f32_32x32x16_bf16(pa1, PK(l1, h1), od, 0, 0, 0);
  od = __builtin_amdgcn_mfma_f32_32x32x16_bf16(pa2, PK(l2, h2), od, 0, 0, 0);
  od = __builtin_amdgcn_mfma_f32_32x32x16_bf16(pa3, PK(l3, h3), od, 0, 0, 0);
#undef PK
}
__device__ __forceinline__ void pv_d0(f32x16* o, int vb, bf16x8 pa0, bf16x8 pa1, bf16x8 pa2, bf16x8 pa3) {
  pv_one<0>(o[0], vb, pa0, pa1, pa2, pa3); pv_one<1>(o[1], vb, pa0, pa1, pa2, pa3); pv_one<2>(o[2], vb, pa0, pa1, pa2, pa3); pv_one<3>(o[3], vb, pa0, pa1, pa2, pa3);
}
constexpr int LDQ = 1536, LDK = 1024, LDV = 1024, LDKR = 64, LDO = 1024, SDEPTH = ATT_SDEPTH;
constexpr int SHM_V = KVBLK * 128 * 2, SHM_K = KVBLK * 128 * 2, SHM_KR = KVBLK * 64 * 2;
constexpr int SHM_QR = NW * 4 * 64 * 16;
constexpr int SHM_ATTN = 2 * SHM_V + 2 * SHM_K + 2 * SHM_KR + NW * 64 * 4 + SHM_QR;
__device__ __forceinline__ void attn_unit(const bf16* __restrict__ Qb, const bf16* __restrict__ Kh, const bf16* __restrict__ KRh, const bf16* __restrict__ Vh,
                                          bf16* __restrict__ Ob, int seq, char* lds) {
  using St = Stage<bf16>;
  const int tid = otid(), wid = tid >> 6, lane = tid & 63, r32 = lane & 31, hi = lane >> 5;
  bf16* V_lds = (bf16*)lds; bf16* K_lds = (bf16*)(lds + 2 * SHM_V); bf16* KR_lds = (bf16*)(lds + 2 * SHM_V + 2 * SHM_K);
  float* ws = (float*)(lds + 2 * SHM_V + 2 * SHM_K + 2 * SHM_KR) + wid * 64; float* li_l = ws; float* al_l = ws + 32;
  float m_reg = -1e30f, l_reg = 0; f32x16 o[4] = {}; bf16x8 qr[8];
  bf16x8* qrl = (bf16x8*)(lds + 2 * SHM_V + 2 * SHM_K + 2 * SHM_KR + NW * 64 * 4) + wid * 256 + lane;
  const bf16* Qw = Qb + (long)(wid * QBLK + r32) * LDQ + hi * 8;
#pragma unroll
  for (int d0 = 0; d0 < 8; ++d0) qr[d0] = St::ld8(Qw + d0 * 16);
#pragma unroll
  for (int d0 = 0; d0 < 4; ++d0) qrl[d0 * 64] = St::ld8(Qw + 128 + d0 * 16);
  const int sr = tid >> 4, sc = (tid & 15) * 8, vst0 = v_st(sr, sc), vst1 = v_st(32 + sr, sc);
  const int krr = tid >> 3, krc = (tid & 7) * 8;
  const int vb0 = (int)(uintptr_t)V_lds + v_rd_base(lane);
  struct { bf16x8 vs0, vs1, ks0, ks1, kr; } sr_[SDEPTH];
#define SLOAD(i, k0) do { sr_[i].vs0 = St::ld8(&Vh[(long)((k0) + sr) * LDV + sc]); sr_[i].vs1 = St::ld8(&Vh[(long)((k0) + 32 + sr) * LDV + sc]); \
    sr_[i].ks0 = St::ld8(&Kh[(long)((k0) + sr) * LDK + sc]); sr_[i].ks1 = St::ld8(&Kh[(long)((k0) + 32 + sr) * LDK + sc]); \
    sr_[i].kr = St::ld8(&KRh[(long)((k0) + krr) * LDKR + krc]); } while (0)
#define SWRITE(b, i) do { *(bf16x8*)((char*)V_lds + (b) * SHM_V + vst0) = sr_[i].vs0;          \
    *(bf16x8*)((char*)V_lds + (b) * SHM_V + vst1) = sr_[i].vs1; int kc = sc * 2;               \
    *(bf16x8*)((char*)K_lds + (b) * SHM_K + KSWZ(sr, kc)) = sr_[i].ks0;                       \
    *(bf16x8*)((char*)K_lds + (b) * SHM_K + KSWZ(32 + sr, kc)) = sr_[i].ks1;                  \
    *(bf16x8*)((char*)KR_lds + (b) * SHM_KR + KSWZ2(krr, krc * 2)) = sr_[i].kr; } while (0)
#define SWAIT() do { if constexpr (SDEPTH == 2) asm volatile("s_waitcnt vmcnt(5)" ::: "memory"); else asm volatile("s_waitcnt vmcnt(0)" ::: "memory"); } while (0)
#define RESC(a) do { if (__any((a) < 1.f)) { if (hi == 0) al_l[r32] = (a); asm volatile("s_waitcnt lgkmcnt(0)" ::: "memory"); \
    _Pragma("unroll") for (int d = 0; d < 4; ++d) _Pragma("unroll") for (int r = 0; r < 16; ++r) o[d][r] *= al_l[crow(r, hi)]; } } while (0)
  f32x16 pA0, pA1, pB0, pB1; float mnA, mnB, alA, alB; bf16x8 pa0, pa1, pa2, pa3; const int NT = seq / KVBLK;
  constexpr int SE = 0, SO = SDEPTH - 1;
  SLOAD(SE, 0); asm volatile("s_waitcnt vmcnt(0)" ::: "memory"); SWRITE(0, SE); __syncthreads();
  qkt(pA0, pA1, K_lds, KR_lds, qr, qrl, r32, hi); partialSM(pA0, pA1, m_reg, mnA, alA);
  SLOAD(SO, KVBLK); if constexpr (SDEPTH == 2) { if (2 < NT) SLOAD(SE, 2 * KVBLK); }
  SWAIT(); SWRITE(1, SO); __syncthreads();
  for (int j = 1; j + 1 < NT; j += 2) {
    SBAR(); qkt(pB0, pB1, (bf16*)((char*)K_lds + SHM_K), (bf16*)((char*)KR_lds + SHM_KR), qr, qrl, r32, hi);
    finishSM(pA0, pA1, alA, l_reg, pa0, pa1, pa2, pa3); SBAR();
    SLOAD(SO, (j + SDEPTH) * KVBLK); SBAR();
    pv_d0(o, vb0, pa0, pa1, pa2, pa3); partialSM(pB0, pB1, m_reg, mnB, alB);
    __syncthreads(); SWAIT(); SWRITE(0, SE);
    RESC(alB); __syncthreads();
    SBAR(); qkt(pA0, pA1, K_lds, KR_lds, qr, qrl, r32, hi);
    finishSM(pB0, pB1, alB, l_reg, pa0, pa1, pa2, pa3); SBAR();
    if (SDEPTH == 1 || j + 3 < NT) SLOAD(SE, (j + 1 + SDEPTH) * KVBLK); SBAR();
    pv_d0(o, vb0 + (int)SHM_V, pa0, pa1, pa2, pa3); partialSM(pA0, pA1, m_reg, mnA, alA);
    __syncthreads(); SWAIT(); SWRITE(1, SO);
    RESC(alA); __syncthreads();
  }
  SBAR(); qkt(pB0, pB1, (bf16*)((char*)K_lds + SHM_K), (bf16*)((char*)KR_lds + SHM_KR), qr, qrl, r32, hi);
  finishSM(pA0, pA1, alA, l_reg, pa0, pa1, pa2, pa3); SBAR();
  pv_d0(o, vb0, pa0, pa1, pa2, pa3); partialSM(pB0, pB1, m_reg, mnB, alB);
  __syncthreads(); RESC(alB);
  finishSM(pB0, pB1, alB, l_reg, pa0, pa1, pa2, pa3); SBAR();
  pv_d0(o, vb0 + (int)SHM_V, pa0, pa1, pa2, pa3);
  if (hi == 0) li_l[r32] = l_reg; asm volatile("s_waitcnt lgkmcnt(0)" ::: "memory");
  float rli[16];
#pragma unroll
  for (int r = 0; r < 16; ++r) rli[r] = __builtin_amdgcn_rcpf(li_l[crow(r, hi)]);
  bf16* Ow = Ob + (long)(wid * QBLK) * LDO;
#pragma unroll
  for (int r = 0; r < 16; ++r) { int orow = crow(r, hi);
#pragma unroll
    for (int d0 = 0; d0 < 4; ++d0) Ow[(long)orow * LDO + d0 * 32 + r32] = __float2bfloat16(o[d0][r] * rli[r]); }
  __syncthreads();
#undef SLOAD
#undef SWRITE
#undef SWAIT
#undef RESC
}
#undef SBAR
}
constexpr int BATCH = 4, SEQ = 8192, DM = 1024, DEPTH = 4, DFF = 2816, MT = BATCH * SEQ;
constexpr int NH = 8, QLR = 256, KVLR = 128, QKD = 192;
constexpr float EPS = 1e-6f;
constexpr size_t MiB = 1u << 20;
constexpr size_t WS_WFFI = 1 * MiB;
constexpr size_t WS_WFFO = 89 * MiB;
constexpr size_t WS_WHIN = 133 * MiB;
constexpr size_t WS_WHO  = 153 * MiB;
constexpr size_t WS_WMIN = 157 * MiB;
constexpr size_t WS_WUQ  = 159 * MiB;
constexpr size_t WS_WUKV = 161 * MiB;
constexpr size_t WS_WMO  = 162 * MiB;
constexpr size_t WS_COS  = 166 * MiB;
constexpr size_t WS_SIN  = 170 * MiB;
constexpr size_t WS_LB   = 174 * MiB;
constexpr size_t WS_HN   = 176 * MiB;
constexpr size_t WS_Y    = 240 * MiB;
constexpr size_t WS_R    = 368 * MiB;
constexpr size_t WS_END  = 704 * MiB;
constexpr size_t R_ACT = 0;
constexpr size_t R_C = 0, R_QB = 0, R_CQ = 96 * MiB, R_CKV = 112 * MiB, R_KR = 120 * MiB, R_KN = 124 * MiB, R_VB = 188 * MiB, R_O = 252 * MiB;
constexpr size_t R_QH = 0, R_VH = 64 * MiB, R_GH = 128 * MiB, R_KF = 192 * MiB, R_HO = 0;

constexpr int LDS_RING = 131072, LDS_BYTES = LDS_RING + 2048;
typedef unsigned short bf16_t;
typedef float f32x4 __attribute__((ext_vector_type(4)));
typedef float f32x2 __attribute__((ext_vector_type(2)));
typedef unsigned u32x4 __attribute__((ext_vector_type(4)));
typedef unsigned u32x2 __attribute__((ext_vector_type(2)));
typedef _Float16 h16x2 __attribute__((ext_vector_type(2)));
#define LAS __attribute__((address_space(3)))

__device__ __constant__ double ROPE_INVF[32] = {1.0, 0.7498942093324559, 0.5623413251903491, 0.4216965034285822, 0.31622776601683794, 0.23713737056616552, 0.1778279410038923, 0.1333521432163324, 0.1, 0.07498942093324558, 0.05623413251903491, 0.042169650342858224, 0.03162277660168379, 0.023713737056616554, 0.01778279410038923, 0.01333521432163324, 0.01, 0.007498942093324558, 0.005623413251903491, 0.004216965034285823, 0.0031622776601683794, 0.0023713737056616554, 0.0017782794100389228, 0.001333521432163324, 0.001, 0.0007498942093324559, 0.0005623413251903491, 0.00042169650342858224, 0.00031622776601683794, 0.00023713737056616554, 0.00017782794100389227, 0.0001333521432163324};

__device__ __forceinline__ unsigned pk2(float lo, float hi) { return pg8::cvt_pk_bf16(lo, hi); }
__device__ __forceinline__ float silu_f(float g) { return g * __builtin_amdgcn_rcpf(1.0f + __expf(-g)); }
__device__ __forceinline__ float wave_sum(float v) {
#pragma unroll
    for (int o = 1; o < 64; o <<= 1) v += __shfl_xor(v, o);
    return v;
}
__device__ __forceinline__ float half_sum(float v) {
#pragma unroll
    for (int o = 1; o < 32; o <<= 1) v += __shfl_xor(v, o);
    return v;
}

using pg8::Unit;
struct EpiSwiglu { static constexpr bool PERM = true, AFTER_DRAIN = false; bf16_t* O;
    __device__ __forceinline__ void operator()(const pg8::f32x4 (&acc)[2][2][4][2], const Unit& u, int wr, int wc, int fr, int fq) const {
        const int row0 = u.pm * 256 + wr * 64 + fr, col0 = u.pn * 128 + wc * 32 + 8 * fq;
#pragma unroll
        for (int ai = 0; ai < 2; ++ai)
#pragma unroll
            for (int m = 0; m < 4; ++m) { bf16_t* p = O + (size_t)(row0 + ai * 128 + m * 16) * DFF + col0;
                const pg8::f32x4 g0 = acc[ai][0][m][0], g1 = acc[ai][0][m][1], u0 = acc[ai][1][m][0], u1 = acc[ai][1][m][1];
                u32x4 w; w.x = pk2(silu_f(g0[0]) * u0[0], silu_f(g0[1]) * u0[1]); w.y = pk2(silu_f(g0[2]) * u0[2], silu_f(g0[3]) * u0[3]);
                w.z = pk2(silu_f(g1[0]) * u1[0], silu_f(g1[1]) * u1[1]); w.w = pk2(silu_f(g1[2]) * u1[2], silu_f(g1[3]) * u1[3]);
                *(u32x4*)p = w; }
    }
};
struct EpiF32 { static constexpr bool PERM = false, AFTER_DRAIN = false; float* O; int ldc;
    __device__ __forceinline__ void operator()(const pg8::f32x4 (&acc)[2][2][4][2], const Unit& u, int wr, int wc, int fr, int fq) const {
        const int row0 = u.pm * 256 + wr * 64 + fr, col0 = u.pn * 256 + wc * 32 + 4 * fq;
#pragma unroll
        for (int ai = 0; ai < 2; ++ai)
#pragma unroll
            for (int m = 0; m < 4; ++m) { float* p = O + (size_t)(row0 + ai * 128 + m * 16) * ldc + col0;
#pragma unroll
                for (int bj = 0; bj < 2; ++bj)
#pragma unroll
                    for (int n = 0; n < 2; ++n) *(pg8::f32x4*)(p + bj * 128 + n * 16) = acc[ai][bj][m][n]; }
    }
};
struct EpiQ { static constexpr bool PERM = true, AFTER_DRAIN = false; bf16_t* O; const float* cs; const float* sn;
    __device__ __forceinline__ void operator()(const pg8::f32x4 (&acc)[2][2][4][2], const Unit& u, int wr, int wc, int fr, int fq) const {
        const int row0 = u.pm * 256 + wr * 64 + fr;
#pragma unroll
        for (int bj = 0; bj < 2; ++bj) { const int col0 = u.pn * 256 + bj * 128 + wc * 32 + 8 * fq, d = col0 % QKD; const bool rot = d >= 128; const int i0 = (d - 128) >> 1;
#pragma unroll
            for (int ai = 0; ai < 2; ++ai)
#pragma unroll
                for (int m = 0; m < 4; ++m) { const int row = row0 + ai * 128 + m * 16; pg8::f32x4 v0 = acc[ai][bj][m][0], v1 = acc[ai][bj][m][1];
                    if (rot) { const pg8::f32x4 c = *(const pg8::f32x4*)(cs + (size_t)row * 32 + i0), s = *(const pg8::f32x4*)(sn + (size_t)row * 32 + i0);
                        pg8::f32x4 a, b; a[0] = v0[0] * c[0] - v0[1] * s[0]; a[1] = v0[0] * s[0] + v0[1] * c[0]; a[2] = v0[2] * c[1] - v0[3] * s[1]; a[3] = v0[2] * s[1] + v0[3] * c[1];
                        b[0] = v1[0] * c[2] - v1[1] * s[2]; b[1] = v1[0] * s[2] + v1[1] * c[2]; b[2] = v1[2] * c[3] - v1[3] * s[3]; b[3] = v1[2] * s[3] + v1[3] * c[3]; v0 = a; v1 = b; }
                    u32x4 w; w.x = pk2(v0[0], v0[1]); w.y = pk2(v0[2], v0[3]); w.z = pk2(v1[0], v1[1]); w.w = pk2(v1[2], v1[3]);
                    *(u32x4*)(O + (size_t)row * 1536 + col0) = w; } }
    }
};
struct EpiKV { static constexpr bool PERM = true, AFTER_DRAIN = false; bf16_t* Kn; bf16_t* Vb;
    __device__ __forceinline__ void operator()(const pg8::f32x4 (&acc)[2][2][4][2], const Unit& u, int wr, int wc, int fr, int fq) const {
        const int row0 = u.pm * 256 + wr * 64 + fr, col0 = u.pn * 128 + wc * 32 + 8 * fq;
#pragma unroll
        for (int bj = 0; bj < 2; ++bj) { bf16_t* base = bj ? Vb : Kn;
#pragma unroll
            for (int ai = 0; ai < 2; ++ai)
#pragma unroll
                for (int m = 0; m < 4; ++m) { const pg8::f32x4 v0 = acc[ai][bj][m][0], v1 = acc[ai][bj][m][1];
                    u32x4 w; w.x = pk2(v0[0], v0[1]); w.y = pk2(v0[2], v0[3]); w.z = pk2(v1[0], v1[1]); w.w = pk2(v1[2], v1[3]);
                    *(u32x4*)(base + (size_t)(row0 + ai * 128 + m * 16) * 1024 + col0) = w; } }
    }
};
__device__ __forceinline__ unsigned pkh2(float a, float b) { const h16x2 h = {(_Float16)a, (_Float16)b}; return __builtin_bit_cast(unsigned, h); }
__device__ __forceinline__ float kgate(float om, float z) { return om * __builtin_amdgcn_rcpf(1.0f + __expf(z)); }
struct EpiHgrn { static constexpr bool PERM = true, AFTER_DRAIN = false; bf16_t* Qh; bf16_t* Vh; bf16_t* Gh; unsigned short* KF; const float* lb;
    __device__ __forceinline__ void operator()(const pg8::f32x4 (&acc)[2][2][4][2], const Unit& u, int wr, int wc, int fr, int fq) const {
        const int row0 = u.pm * 256 + wr * 64 + fr, seg = u.pn >> 2;
#pragma unroll
        for (int bj = 0; bj < 2; ++bj) { const int cc = (u.pn & 3) * 256 + bj * 128 + wc * 32 + 8 * fq;
            if (seg == 1 || seg == 2) {
                const pg8::f32x4 om0 = 1.0f - *(const pg8::f32x4*)(lb + (seg - 1) * 1024 + cc), om1 = 1.0f - *(const pg8::f32x4*)(lb + (seg - 1) * 1024 + cc + 4);
                unsigned short* base = KF + (size_t)(seg - 1) * MT * 1024;
#pragma unroll
                for (int ai = 0; ai < 2; ++ai)
#pragma unroll
                    for (int m = 0; m < 4; ++m) { const size_t off = (size_t)(row0 + ai * 128 + m * 16) * 1024 + cc; const pg8::f32x4 v0 = acc[ai][bj][m][0], v1 = acc[ai][bj][m][1];
                        u32x4 w; w.x = pkh2(kgate(om0[0], v0[0]), kgate(om0[1], v0[1])); w.y = pkh2(kgate(om0[2], v0[2]), kgate(om0[3], v0[3]));
                        w.z = pkh2(kgate(om1[0], v1[0]), kgate(om1[1], v1[1])); w.w = pkh2(kgate(om1[2], v1[2]), kgate(om1[3], v1[3]));
                        *(u32x4*)(base + off) = w; }
            } else if (seg == 3) {
#pragma unroll
                for (int ai = 0; ai < 2; ++ai)
#pragma unroll
                    for (int m = 0; m < 4; ++m) { const size_t off = (size_t)(row0 + ai * 128 + m * 16) * 1024 + cc; const pg8::f32x4 v0 = acc[ai][bj][m][0], v1 = acc[ai][bj][m][1];
                        u32x4 w; w.x = pk2(v0[0], v0[1]); w.y = pk2(v0[2], v0[3]); w.z = pk2(v1[0], v1[1]); w.w = pk2(v1[2], v1[3]);
                        *(u32x4*)(Vh + off) = w; }
            } else { bf16_t* base = seg == 0 ? Qh : Gh;
#pragma unroll
                for (int ai = 0; ai < 2; ++ai)
#pragma unroll
                    for (int m = 0; m < 4; ++m) { const size_t off = (size_t)(row0 + ai * 128 + m * 16) * 1024 + cc; const pg8::f32x4 v0 = acc[ai][bj][m][0], v1 = acc[ai][bj][m][1];
                        u32x4 w; w.x = pk2(silu_f(v0[0]), silu_f(v0[1])); w.y = pk2(silu_f(v0[2]), silu_f(v0[3])); w.z = pk2(silu_f(v1[0]), silu_f(v1[1])); w.w = pk2(silu_f(v1[2]), silu_f(v1[3]));
                        *(u32x4*)(base + off) = w; } } }
    }
};

__device__ __forceinline__ int src_col(int mode, int n) {
    if (mode == 1) { const int t = n >> 8, j = n & 255; return j < 128 ? t * 128 + j : DFF + t * 128 + (j - 128); }
    if (mode == 2) { if (n < 384) return n; if (n >= 448) return -1; const int j = n - 384; return 384 + (j >> 1) + 32 * (j & 1); }
    if (mode == 3) { const int h = n / QKD, d = n % QKD; if (d < 128) return n; const int j = d - 128; return h * QKD + 128 + (j >> 1) + 32 * (j & 1); }
    return n;
}
__device__ __forceinline__ void xpose_item(const float* __restrict__ W, int K, int Nsrc, int Ndst, int mode, bf16_t* __restrict__ WT, LAS float* scr, int item, int lane) {
    const int nblk = Ndst / 32, kb = item / nblk, nb = item % nblk, k0 = 64 * kb, n0 = 32 * nb;
    const int sc = src_col(mode, n0 + (lane & 31));
#pragma unroll 8
    for (int i = 0; i < 32; ++i) { const int kk = 2 * i + (lane >> 5); scr[kk * 33 + (lane & 31)] = sc >= 0 ? W[(size_t)(k0 + kk) * Nsrc + sc] : 0.f; }
    asm volatile("s_waitcnt lgkmcnt(0)" ::: "memory");
    const int c = lane & 7;
#pragma unroll
    for (int j = 0; j < 4; ++j) { const int n = (lane >> 3) + 8 * j; const LAS float* s = scr + (8 * c) * 33 + n;
        u32x4 o; o.x = pk2(s[0 * 33], s[1 * 33]); o.y = pk2(s[2 * 33], s[3 * 33]); o.z = pk2(s[4 * 33], s[5 * 33]); o.w = pk2(s[6 * 33], s[7 * 33]);
        *(u32x4*)(WT + (size_t)(n0 + n) * K + k0 + 8 * c) = o; }
    asm volatile("s_waitcnt lgkmcnt(0)" ::: "memory");
}

__device__ __forceinline__ void row_init(const float* __restrict__ xin, float* __restrict__ X, bf16_t* __restrict__ HN, const float* __restrict__ g, int lane) {
    const f32x4* xr = (const f32x4*)xin + lane; f32x4 v[4]; float s = 0.f;
#pragma unroll
    for (int j = 0; j < 4; ++j) { v[j] = xr[64 * j]; s += (v[j][0] * v[j][0] + v[j][1] * v[j][1]) + (v[j][2] * v[j][2] + v[j][3] * v[j][3]); }
    const float r = rsqrtf(wave_sum(s) * (1.f / DM) + EPS);
#pragma unroll
    for (int j = 0; j < 4; ++j) { ((f32x4*)X + lane)[64 * j] = v[j]; const f32x4 gg = ((const f32x4*)g + lane)[64 * j];
        u32x2 w; w.x = pk2(v[j][0] * r * gg[0], v[j][1] * r * gg[1]); w.y = pk2(v[j][2] * r * gg[2], v[j][3] * r * gg[3]); ((u32x2*)HN + lane)[64 * j] = w; }
}
__device__ __forceinline__ void row_post(const float* __restrict__ Y, float* __restrict__ X, bf16_t* __restrict__ HN, float scale, const float* __restrict__ gp, const float* __restrict__ gn, int lane) {
    f32x4 y[4], x[4]; float s = 0.f;
#pragma unroll
    for (int j = 0; j < 4; ++j) { y[j] = ((const f32x4*)Y + lane)[64 * j]; x[j] = ((const f32x4*)X + lane)[64 * j]; s += (y[j][0] * y[j][0] + y[j][1] * y[j][1]) + (y[j][2] * y[j][2] + y[j][3] * y[j][3]); }
    const float r = rsqrtf(wave_sum(s) * (1.f / DM) + EPS) * scale; float s2 = 0.f;
#pragma unroll
    for (int j = 0; j < 4; ++j) { const f32x4 gg = ((const f32x4*)gp + lane)[64 * j]; x[j] = x[j] + y[j] * r * gg; ((f32x4*)X + lane)[64 * j] = x[j];
        s2 += (x[j][0] * x[j][0] + x[j][1] * x[j][1]) + (x[j][2] * x[j][2] + x[j][3] * x[j][3]); }
    if (HN) { const float r2 = rsqrtf(wave_sum(s2) * (1.f / DM) + EPS);
#pragma unroll
        for (int j = 0; j < 4; ++j) { const f32x4 gg = ((const f32x4*)gn + lane)[64 * j];
            u32x2 w; w.x = pk2(x[j][0] * r2 * gg[0], x[j][1] * r2 * gg[1]); w.y = pk2(x[j][2] * r2 * gg[2], x[j][3] * r2 * gg[3]); ((u32x2*)HN + lane)[64 * j] = w; } }
}
__device__ __forceinline__ void row_mla(const float* __restrict__ C, bf16_t* __restrict__ CQ, bf16_t* __restrict__ CKV, bf16_t* __restrict__ KR, const float* __restrict__ qn, const float* __restrict__ kvn,
                                        const float* __restrict__ cs, const float* __restrict__ sn, int lane) {
    const f32x4 a = ((const f32x4*)C)[2 * lane], b = ((const f32x4*)C)[2 * lane + 1];
    float s = (a[0] * a[0] + a[1] * a[1]) + (a[2] * a[2] + a[3] * a[3]) + (b[0] * b[0] + b[1] * b[1]) + (b[2] * b[2] + b[3] * b[3]);
#pragma unroll
    for (int o = 1; o < 16; o <<= 1) s += __shfl_xor(s, o);
    const float s16 = s, s32 = s16 + __shfl_xor(s16, 16);
    float v[8] = {a[0], a[1], a[2], a[3], b[0], b[1], b[2], b[3]};
    if (lane < 32) { const float r = rsqrtf(s32 * (1.f / QLR) + EPS); const f32x4 g0 = ((const f32x4*)qn)[2 * lane], g1 = ((const f32x4*)qn)[2 * lane + 1];
        u32x4 w; w.x = pk2(v[0] * r * g0[0], v[1] * r * g0[1]); w.y = pk2(v[2] * r * g0[2], v[3] * r * g0[3]); w.z = pk2(v[4] * r * g1[0], v[5] * r * g1[1]); w.w = pk2(v[6] * r * g1[2], v[7] * r * g1[3]);
        ((u32x4*)CQ)[lane] = w;
    } else if (lane < 48) { const int l = lane - 32; const float r = rsqrtf(s16 * (1.f / KVLR) + EPS); const f32x4 g0 = ((const f32x4*)kvn)[2 * l], g1 = ((const f32x4*)kvn)[2 * l + 1];
        u32x4 w; w.x = pk2(v[0] * r * g0[0], v[1] * r * g0[1]); w.y = pk2(v[2] * r * g0[2], v[3] * r * g0[3]); w.z = pk2(v[4] * r * g1[0], v[5] * r * g1[1]); w.w = pk2(v[6] * r * g1[2], v[7] * r * g1[3]);
        ((u32x4*)CKV)[l] = w;
    } else if (lane < 56) { const int l = lane - 48; const f32x4 c = ((const f32x4*)cs)[l], sv = ((const f32x4*)sn)[l];
        u32x4 w; w.x = pk2(v[0] * c[0] - v[1] * sv[0], v[0] * sv[0] + v[1] * c[0]); w.y = pk2(v[2] * c[1] - v[3] * sv[1], v[2] * sv[1] + v[3] * c[1]);
        w.z = pk2(v[4] * c[2] - v[5] * sv[2], v[4] * sv[2] + v[5] * c[2]); w.w = pk2(v[6] * c[3] - v[7] * sv[3], v[6] * sv[3] + v[7] * c[3]);
        ((u32x4*)KR)[l] = w; }
}
__device__ __forceinline__ void row_hgrn(const bf16_t* __restrict__ Oa, const bf16_t* __restrict__ Gh, bf16_t* __restrict__ HO, const float* __restrict__ on, int lane) {
#pragma unroll
    for (int j = 0; j < 4; ++j) { const u32x2 a = ((const u32x2*)Oa + lane)[64 * j], b = ((const u32x2*)(Oa + (size_t)MT * 1024) + lane)[64 * j];
        f32x4 o; o[0] = __uint_as_float(a.x << 16) + __uint_as_float(b.x << 16); o[1] = __uint_as_float(a.x & 0xffff0000u) + __uint_as_float(b.x & 0xffff0000u);
        o[2] = __uint_as_float(a.y << 16) + __uint_as_float(b.y << 16); o[3] = __uint_as_float(a.y & 0xffff0000u) + __uint_as_float(b.y & 0xffff0000u);
        const float s = half_sum((o[0] * o[0] + o[1] * o[1]) + (o[2] * o[2] + o[3] * o[3]));
        const float r = rsqrtf(s * (1.f / 128.f) + EPS); const f32x4 gg = ((const f32x4*)on + lane)[64 * j]; const u32x2 gb = ((const u32x2*)Gh + lane)[64 * j];
        const float g0 = __uint_as_float(gb.x << 16), g1 = __uint_as_float(gb.x & 0xffff0000u), g2 = __uint_as_float(gb.y << 16), g3 = __uint_as_float(gb.y & 0xffff0000u);
        u32x2 w; w.x = pk2(o[0] * r * gg[0] * g0, o[1] * r * gg[1] * g1); w.y = pk2(o[2] * r * gg[2] * g2, o[3] * r * gg[3] * g3); ((u32x2*)HO + lane)[64 * j] = w; }
}
__device__ __forceinline__ f32x2 h2f2_(unsigned u) { const h16x2 h = __builtin_bit_cast(h16x2, u); return (f32x2){(float)h[0], (float)h[1]}; }
__device__ __forceinline__ void scan_phase(LAS unsigned char* lds, const bf16_t* __restrict__ Qh, const bf16_t* __restrict__ Vh, const unsigned short* __restrict__ KF, bf16_t* __restrict__ OP, int G, int bx) {
    int tid = threadIdx.x; asm volatile("" : "+v"(tid)); const int wid = __builtin_amdgcn_readfirstlane(tid >> 6), lane = tid & 63;
    const int st = tid >> 4, sc8 = (tid & 15) * 8, sv = tid >> 3, vc4 = (tid & 7) * 4;
    constexpr int OFF_K = 16384, OFF_Q = 32768, OFF_V = 49152, OFF_P = 53248;
    for (int item = bx; item < 256; item += G) {
        const int dir = item & 1, dvq = (item >> 1) & 3, h = (item >> 3) & 7, b = item >> 6;
        const size_t kcol = h * 128 + sc8, vcol = h * 128 + dvq * 32 + vc4;
        const unsigned short* KFd = KF + (size_t)dir * MT * 1024; bf16_t* OPd = OP + (size_t)dir * MT * 1024;
        u32x4 rk, rq; u32x2 rv = {0u, 0u};
#define SC_GLOAD(blk) do { { const int tt = (blk) * 32 + st; const size_t m = (size_t)b * SEQ + (dir ? SEQ - 1 - tt : tt); \
        rk = *(const u32x4*)(KFd + m * 1024 + kcol); rq = *(const u32x4*)(Qh + m * 1024 + kcol); } \
        if (tid < 256) { const int tt = (blk) * 32 + sv; const size_t m = (size_t)b * SEQ + (dir ? SEQ - 1 - tt : tt); rv = *(const u32x2*)(Vh + m * 1024 + vcol); } } while (0)
#define SC_H2F(u_) h2f2_(u_)
#define SC_LWRITE() do { LAS unsigned char* B_ = lds + (st * 128 + sc8) * 4; \
        const f32x2 ka = SC_H2F(rk.x), kb = SC_H2F(rk.y), kc = SC_H2F(rk.z), kd = SC_H2F(rk.w); \
        const f32x4 k0_ = {ka[0], ka[1], kb[0], kb[1]}, k1_ = {kc[0], kc[1], kd[0], kd[1]}; \
        *(LAS f32x4*)(B_ + OFF_K) = k0_; *(LAS f32x4*)(B_ + OFF_K + 16) = k1_; \
        *(LAS f32x4*)(B_ + OFF_Q) = (f32x4){__uint_as_float(rq.x << 16), __uint_as_float(rq.x & 0xffff0000u), __uint_as_float(rq.y << 16), __uint_as_float(rq.y & 0xffff0000u)}; \
        *(LAS f32x4*)(B_ + OFF_Q + 16) = (f32x4){__uint_as_float(rq.z << 16), __uint_as_float(rq.z & 0xffff0000u), __uint_as_float(rq.w << 16), __uint_as_float(rq.w & 0xffff0000u)}; \
        if (tid < 256) *(LAS f32x4*)(lds + OFF_V + (sv * 32 + vc4) * 4) = (f32x4){__uint_as_float(rv.x << 16), __uint_as_float(rv.x & 0xffff0000u), __uint_as_float(rv.y << 16), __uint_as_float(rv.y & 0xffff0000u)}; } while (0)
        SC_GLOAD(0);
        const int dksub = ((lane >> 3) & 1) | ((lane >> 5) << 1), dvp = (lane & 7) | (((lane >> 4) & 1) << 3);
        const LAS unsigned char* Bc = lds + (16 * wid + 4 * dksub) * 4;
        const LAS unsigned char* Vc = lds + OFF_V + dvp * 8;
        LAS unsigned char* Pw = lds + OFF_P + (wid * 4 + dksub) * 2048 + dvp * 4;
        f32x2 S2[4];
#pragma unroll
        for (int j = 0; j < 4; ++j) S2[j] = (f32x2){0.f, 0.f};
        for (int blk = 0; blk < SEQ / 32; ++blk) {
            SC_LWRITE();
            if (blk + 1 < SEQ / 32) SC_GLOAD(blk + 1);
            __syncthreads();
            f32x4 k4n = *(const LAS f32x4*)(Bc + OFF_K), q4n = *(const LAS f32x4*)(Bc + OFF_Q); f32x2 v2n = *(const LAS f32x2*)(Vc);
            f32x4 k4m = *(const LAS f32x4*)(Bc + OFF_K + 512), q4m = *(const LAS f32x4*)(Bc + OFF_Q + 512); f32x2 v2m = *(const LAS f32x2*)(Vc + 128);
#pragma unroll
            for (int t = 0; t < 32; ++t) {
                const f32x4 k4 = k4n, q4 = q4n; const f32x2 v2 = v2n;
                k4n = k4m; q4n = q4m; v2n = v2m;
                { const int tn = (t + 2) & 31;
                  k4m = *(const LAS f32x4*)(Bc + OFF_K + tn * 512); q4m = *(const LAS f32x4*)(Bc + OFF_Q + tn * 512); v2m = *(const LAS f32x2*)(Vc + tn * 128); }
                __builtin_amdgcn_sched_barrier(0);
#pragma unroll
                for (int j = 0; j < 4; ++j) S2[j] = S2[j] + (v2 - S2[j]) * k4[j];
                const f32x2 o2 = (S2[0] * q4[0] + S2[1] * q4[1]) + (S2[2] * q4[2] + S2[3] * q4[3]);
                *(LAS unsigned*)(Pw + t * 64) = pk2(o2[0], o2[1]);
            }
            __syncthreads();
            if (tid < 256) { const LAS unsigned char* Pr = lds + OFF_P + (sv * 32 + vc4) * 2; f32x4 acc = {0.f, 0.f, 0.f, 0.f};
#pragma unroll
              for (int g = 0; g < 32; ++g) { const u32x2 pv = *(const LAS u32x2*)(Pr + g * 2048);
                  acc[0] += __uint_as_float(pv.x << 16); acc[1] += __uint_as_float(pv.x & 0xffff0000u); acc[2] += __uint_as_float(pv.y << 16); acc[3] += __uint_as_float(pv.y & 0xffff0000u); }
              const int tt = blk * 32 + sv; const size_t m = (size_t)b * SEQ + (dir ? SEQ - 1 - tt : tt);
              u32x2 w; w.x = pk2(acc[0], acc[1]); w.y = pk2(acc[2], acc[3]); *(u32x2*)(OPd + m * 1024 + vcol) = w; }
        }
        __syncthreads();
#undef SC_GLOAD
#undef SC_LWRITE
#undef SC_H2F
    }
}

enum Op { OP_SW0, OP_FO0, OP_RPA, OP_MIN, OP_RMLA, OP_QKV, OP_ATTN, OP_MWO, OP_RPB, OP_SW1, OP_FO1, OP_RPC, OP_HIN, OP_SCAN, OP_RHG, OP_HWO };
__device__ const unsigned char OPS_M[12] = {OP_SW0, OP_FO0, OP_RPA, OP_MIN, OP_RMLA, OP_QKV, OP_ATTN, OP_MWO, OP_RPB, OP_SW1, OP_FO1, OP_RPC};
__device__ const unsigned char OPS_H[11] = {OP_SW0, OP_FO0, OP_RPA, OP_HIN, OP_SCAN, OP_RHG, OP_HWO, OP_RPB, OP_SW1, OP_FO1, OP_RPC};

struct Args { const float* in[15]; float* out; unsigned char* ws; };
typedef const __attribute__((address_space(4))) Args* ArgsP;
__device__ __forceinline__ ArgsP get_args() { ArgsP p = (ArgsP)__builtin_amdgcn_kernarg_segment_ptr(); asm volatile("" : "+s"(p) :: "memory"); return p; }
#define GW_ ((int)blockIdx.x * 8 + __builtin_amdgcn_readfirstlane((int)threadIdx.x >> 6))
#define NGW_ ((int)gridDim.x * 8)
__device__ __forceinline__ int otid_() { int t = threadIdx.x; asm volatile("" : "+v"(t)); return t; }
#define LANE_ (otid_() & 63)

#ifdef DBG_CHECKS
__device__ __forceinline__ float bf2f(bf16_t v) { return __uint_as_float((unsigned)v << 16); }
__device__ __forceinline__ unsigned hash_u(unsigned x) { x ^= x >> 16; x *= 0x7feb352du; x ^= x >> 15; x *= 0x846ca68bu; x ^= x >> 16; return x; }
__device__ __forceinline__ void dbg_report(unsigned* DBG, int id, float got, float ref, float rtol, float atol) {
    const float err = fabsf(got - ref); const bool bad = !(err <= rtol * fabsf(ref) + atol);
    if (bad) atomicMax(DBG + id, 1u);
}
__device__ __forceinline__ int dbg_row(int sidx) { if (sidx == 0) return 0; if (sidx == 1) return MT - 1; if (sidx == 2) return SEQ - 1; if (sidx == 3) return SEQ; return (int)(hash_u(sidx * 2654435761u + 17u) % MT); }
#endif
#ifdef DBG_CHECKS
struct DbgCtx { const float* const* in; unsigned char* ws; unsigned char* R; unsigned* DBG; int bx, tid, lane, wave; };
__device__ __forceinline__ float dbg_dot_bf_w(const bf16_t* a, const float* W, int K, int ldw, int col) { float s = 0.f; for (int k = 0; k < K; ++k) s += bf2f(a[k]) * W[(size_t)k * ldw + col]; return s; }
template <class A>
__device__ __forceinline__ void dbg_after(int l, int op, A ap, unsigned char* ws, unsigned char* R, LAS unsigned char* lds) {
    unsigned* DBG = (unsigned*)(ws + 32768);
    const int bx = blockIdx.x, tid = otid_(), lane = tid & 63, wave = __builtin_amdgcn_readfirstlane(tid >> 6);
    const bf16_t* HN = (const bf16_t*)(ws + WS_HN); const float* Y = (const float*)(ws + WS_Y);
    if (false && l == 0 && op == OP_SW0 && bx < 32) { const int sid = bx * 512 + tid, m = dbg_row(sid), c = hash_u(sid * 3 + 1) % DFF; const float* W = ap->in[3];
        const float g = dbg_dot_bf_w(HN + (size_t)m * 1024, W, 1024, 2 * DFF, c), u = dbg_dot_bf_w(HN + (size_t)m * 1024, W, 1024, 2 * DFF, DFF + c);
        dbg_report(DBG, 1, bf2f(((const bf16_t*)(R + R_ACT))[(size_t)m * DFF + c]), g / (1.f + expf(-g)) * u, 0.015f, 0.004f); }
    if (false && l == 0 && op == OP_FO0 && bx < 32) { const int sid = bx * 512 + tid, m = dbg_row(sid), c = hash_u(sid * 3 + 2) % 1024;
        const float r = dbg_dot_bf_w((const bf16_t*)(R + R_ACT) + (size_t)m * DFF, ap->in[4], DFF, 1024, c);
        dbg_report(DBG, 2, Y[(size_t)m * 1024 + c], r, 0.015f, 0.004f); }
    if (false && l == 0 && op == OP_RPA && bx < 32) { const int sid = bx * 512 + tid, m = dbg_row(sid), c = hash_u(sid * 3 + 3) % 1024; const float* g = ap->in[2];
        float s = 0.f; for (int k = 0; k < 1024; ++k) { const float y = Y[(size_t)m * 1024 + k]; s += y * y; }
        const float xr = ap->in[0][(size_t)m * 1024 + c] + 0.5f * Y[(size_t)m * 1024 + c] * rsqrtf(s / 1024.f + EPS) * g[1024 + c];
        dbg_report(DBG, 2, ap->out[(size_t)m * 1024 + c], xr, 1e-3f, 1e-3f);
        float s2 = 0.f; for (int k = 0; k < 1024; ++k) { const float x = ap->out[(size_t)m * 1024 + k]; s2 += x * x; }
        dbg_report(DBG, 2, bf2f(HN[(size_t)m * 1024 + c]), ap->out[(size_t)m * 1024 + c] * rsqrtf(s2 / 1024.f + EPS) * g[2048 + c], 0.01f, 0.01f); }
    if (false && l == 0 && op == OP_MIN && bx < 32) { const int sid = bx * 512 + tid, m = dbg_row(sid), c = hash_u(sid * 3 + 4) % 512; const int sc = src_col(2, c);
        const float r = sc >= 0 ? dbg_dot_bf_w(HN + (size_t)m * 1024, ap->in[5], 1024, 448, sc) : 0.f;
        dbg_report(DBG, 3, ((const float*)(R + R_C))[(size_t)m * 512 + c], r, 0.015f, 0.01f); }
    if (false && l == 0 && op == OP_RMLA && bx < 32) { const int sid = bx * 512 + tid, m = dbg_row(sid), c = hash_u(sid * 3 + 5) % 448; const float* C = (const float*)(R + R_C) + (size_t)m * 512;
        if (c < 256) { float s = 0.f; for (int k = 0; k < 256; ++k) s += C[k] * C[k];
            dbg_report(DBG, 3, bf2f(((const bf16_t*)(R + R_CQ))[(size_t)m * 256 + c]), C[c] * rsqrtf(s / 256.f + EPS) * ap->in[6][c], 0.01f, 0.01f); }
        else if (c < 384) { float s = 0.f; for (int k = 256; k < 384; ++k) s += C[k] * C[k];
            dbg_report(DBG, 3, bf2f(((const bf16_t*)(R + R_CKV))[(size_t)m * 128 + c - 256]), C[c] * rsqrtf(s / 128.f + EPS) * ap->in[7][c - 256], 0.01f, 0.01f); }
        else { const int jj = c - 384, i = jj >> 1; const float ang = (float)((const int*)ap->in[1])[m] * powf(10000.f, -(float)i / 32.f); const float cs = cosf(ang), sn = sinf(ang);
            const float t1 = C[384 + 2 * i], t2 = C[384 + 2 * i + 1]; const float r = (jj & 1) ? t1 * sn + t2 * cs : t1 * cs - t2 * sn;
            dbg_report(DBG, 3, bf2f(((const bf16_t*)(R + R_KR))[(size_t)m * 64 + jj]), r, 0.02f, 0.05f); } }
    if (false && l == 0 && op == OP_QKV && bx < 32) { const int sid = bx * 512 + tid, m = dbg_row(sid); const bf16_t* CQ = (const bf16_t*)(R + R_CQ) + (size_t)m * 256; const bf16_t* CKV = (const bf16_t*)(R + R_CKV) + (size_t)m * 128;
        { const int c = hash_u(sid * 3 + 6) % 1536, h = c / QKD, d = c % QKD; float r;
          if (d < 128) r = dbg_dot_bf_w(CQ, ap->in[8], 256, 1536, c);
          else { const int jj = d - 128, i = jj >> 1; const float t1 = dbg_dot_bf_w(CQ, ap->in[8], 256, 1536, h * QKD + 128 + i), t2 = dbg_dot_bf_w(CQ, ap->in[8], 256, 1536, h * QKD + 160 + i);
              const float ang = (float)((const int*)ap->in[1])[m] * powf(10000.f, -(float)i / 32.f); const float cs = cosf(ang), sn = sinf(ang); r = (jj & 1) ? t1 * sn + t2 * cs : t1 * cs - t2 * sn; }
          dbg_report(DBG, 4, bf2f(((const bf16_t*)(R + R_QB))[(size_t)m * 1536 + c]), r, 0.015f, 0.015f); }
        { const int c = hash_u(sid * 3 + 7) % 2048, h = c >> 8, d = c & 255; const float r = dbg_dot_bf_w(CKV, ap->in[9], 128, 2048, c);
          const float got = d < 128 ? bf2f(((const bf16_t*)(R + R_KN))[(size_t)m * 1024 + h * 128 + d]) : bf2f(((const bf16_t*)(R + R_VB))[(size_t)m * 1024 + h * 128 + d - 128]);
          dbg_report(DBG, 5, got, r, 0.015f, 0.015f); } }
    if (l == 0 && op == OP_ATTN) { const int sid = bx * 8 + wave, m = dbg_row(sid), h = hash_u(sid * 5 + 1) & 7, dv = hash_u(sid * 5 + 2) & 127, b = m / SEQ;
        LAS float* qs = (LAS float*)lds + wave * 192; const bf16_t* Q = (const bf16_t*)(R + R_QB) + (size_t)m * 1536 + h * QKD;
        for (int d = lane; d < 192; d += 64) qs[d] = bf2f(Q[d]);
        asm volatile("s_waitcnt lgkmcnt(0)" ::: "memory");
        float mx = -1e30f, ls = 0.f, acc = 0.f;
        for (int kk = lane; kk < SEQ; kk += 64) { const size_t km = (size_t)b * SEQ + kk; const bf16_t* Kn = (const bf16_t*)(R + R_KN) + km * 1024 + h * 128; const bf16_t* Kr = (const bf16_t*)(R + R_KR) + km * 64;
            float s = 0.f; for (int d = 0; d < 128; ++d) s += qs[d] * bf2f(Kn[d]); for (int d = 0; d < 64; ++d) s += qs[128 + d] * bf2f(Kr[d]);
            s *= 0.07216878364870322f; const float v = bf2f(((const bf16_t*)(R + R_VB))[km * 1024 + h * 128 + dv]);
            const float mn = fmaxf(mx, s), al = expf(mx - mn), p = expf(s - mn); ls = ls * al + p; acc = acc * al + p * v; mx = mn; }
        float gm = mx;
        for (int o = 1; o < 64; o <<= 1) gm = fmaxf(gm, __shfl_xor(gm, o));
        const float sc = expf(mx - gm); const float L = wave_sum(ls * sc), Asum = wave_sum(acc * sc);
        if (lane == 0) { const float got = bf2f(((const bf16_t*)(R + R_O))[(size_t)m * 1024 + h * 128 + dv]), ref = Asum / L; atomicMax(DBG + 20, __float_as_uint(fabsf(got - ref))); atomicAdd((float*)(DBG + 21), fabsf(ref) * (1.f / 2048.f)); } }
    if (false && l == 1 && op == OP_HIN && bx < 32) { const int sid = bx * 512 + tid, m = dbg_row(sid), c5 = hash_u(sid * 3 + 8) % 5120, seg = c5 >> 10, c = c5 & 1023;
        const float u = dbg_dot_bf_w(HN + (size_t)m * 1024, ap->in[11], 1024, 5120, c5); float got, r;
        if (seg == 0) { got = bf2f(((const bf16_t*)(R + R_QH))[(size_t)m * 1024 + c]); r = u / (1.f + expf(-u)); }
        else if (seg == 3) { got = bf2f(((const bf16_t*)(R + R_VH))[(size_t)m * 1024 + c]); r = u; }
        else if (seg == 4) { got = bf2f(((const bf16_t*)(R + R_GH))[(size_t)m * 1024 + c]); r = u / (1.f + expf(-u)); }
        else { const int dir = seg - 1; const float* lbp = ap->in[12] + (size_t)dir * DEPTH * 1024 + c; const float e0 = expf(lbp[0]), e1 = expf(lbp[1024]), e2 = expf(lbp[2048]), e3 = expf(lbp[3072]);
            const float lb = e1 / (e0 + e1 + e2 + e3); const h16x2 hv = __builtin_bit_cast(h16x2, (unsigned)((const unsigned short*)(R + R_KF))[(size_t)dir * MT * 1024 + (size_t)m * 1024 + c]);
            got = (float)hv[0]; r = (1.f - lb) / (1.f + expf(u)); }
        dbg_report(DBG, 7, got, r, 0.015f, 0.006f); }
    if (false && l == 1 && op == OP_SCAN) { const int sid = bx * 8 + wave, h = hash_u(sid * 5 + 3) & 7, dv = hash_u(sid * 5 + 4) & 127, b = hash_u(sid * 5 + 5) & 3, toff = sid & 31, dir = 0;
        const bf16_t* Qh = (const bf16_t*)(R + R_QH); const bf16_t* Vh = (const bf16_t*)(R + R_VH); const unsigned short* KF = (const unsigned short*)(R + R_KF); const bf16_t* OPb = (const bf16_t*)(ws + WS_Y);
        float S0 = 0.f, S1 = 0.f; const int n = toff + 1; const int t = toff; const size_t m = (size_t)b * SEQ + t;
        for (int i = 0; i < n; ++i) { const int tt = i; const size_t mm = (size_t)b * SEQ + tt; const unsigned short* kp = KF + (size_t)dir * MT * 1024 + mm * 1024 + h * 128;
            const h16x2 ka = __builtin_bit_cast(h16x2, (unsigned)kp[lane]), kb = __builtin_bit_cast(h16x2, (unsigned)kp[lane + 64]); const float k0 = (float)ka[0], k1 = (float)kb[0];
            const float v = bf2f(Vh[mm * 1024 + h * 128 + dv]); S0 = S0 * (1.f - k0) + k0 * v; S1 = S1 * (1.f - k1) + k1 * v; }
        const bf16_t* q = Qh + m * 1024 + h * 128; const float tot = wave_sum(S0 * bf2f(q[lane]) + S1 * bf2f(q[lane + 64]));
        if (lane == 0) { const float got = bf2f(OPb[(size_t)dir * MT * 1024 + m * 1024 + h * 128 + dv]); const float re = fabsf(got - tot) / (fabsf(tot) + 0.05f);
            if (re > 0.05f) { atomicMin(DBG + 20, (unsigned)toff); atomicAdd(DBG + 21, 1u); } } }
    if (false && l == 1 && op == OP_RHG && bx < 32) { const int sid = bx * 512 + tid, m = dbg_row(sid), c = hash_u(sid * 3 + 9) % 1024, h0 = c & ~127; const bf16_t* OPb = (const bf16_t*)(ws + WS_Y);
        float s = 0.f; for (int k = 0; k < 128; ++k) { const float y = bf2f(OPb[(size_t)m * 1024 + h0 + k]) + bf2f(OPb[(size_t)MT * 1024 + (size_t)m * 1024 + h0 + k]); s += y * y; }
        const float yc = bf2f(OPb[(size_t)m * 1024 + c]) + bf2f(OPb[(size_t)MT * 1024 + (size_t)m * 1024 + c]);
        const float r = yc * rsqrtf(s / 128.f + EPS) * ap->in[13][c] * bf2f(((const bf16_t*)(R + R_GH))[(size_t)m * 1024 + c]);
        dbg_report(DBG, 9, bf2f(((const bf16_t*)(R + R_HO))[(size_t)m * 1024 + c]), r, 0.02f, 0.005f); }
    if (false && l == 1 && op == OP_HWO && bx < 32) { const int sid = bx * 512 + tid, m = dbg_row(sid), c = hash_u(sid * 3 + 10) % 1024;
        const float r = dbg_dot_bf_w((const bf16_t*)(R + R_HO) + (size_t)m * 1024, ap->in[14], 1024, 1024, c);
        dbg_report(DBG, 9, Y[(size_t)m * 1024 + c], r, 0.03f, 0.01f); }
    if (false && l == 0 && op == OP_MWO && bx < 32) { const int sid = bx * 512 + tid, m = dbg_row(sid), c = hash_u(sid * 3 + 11) % 1024;
        const float r = dbg_dot_bf_w((const bf16_t*)(R + R_O) + (size_t)m * 1024, ap->in[10], 1024, 1024, c);
        dbg_report(DBG, 6, Y[(size_t)m * 1024 + c], r, 0.02f, 0.0004f); }
}
#endif

__device__ __forceinline__ void gsync_cg() {
    asm volatile("s_waitcnt vmcnt(0) lgkmcnt(0)" ::: "memory");
    __syncthreads();
    cg::this_grid().sync();
    if (threadIdx.x == 0) { __builtin_amdgcn_fence(__ATOMIC_ACQUIRE, "agent"); asm volatile("s_waitcnt vmcnt(0)" ::: "memory"); }
    __syncthreads();
}
#define GAS __attribute__((address_space(1)))
#define XB_TMO      128
#define XB_XCNT(j)  (256  + 64 * (j))
#define XB_XSUB(j)  (1280 + 64 * (j))
#define XB_XGEN(j)  (2304 + 64 * (j))
#define XB_TOP      3328
#define XB_TOPGEN   3392
#define XCD_BAR_WORDS 3456
#define XB_SPIN_CAP (1u << 18)

__device__ __forceinline__ unsigned xb_ld(unsigned* p)              { return __hip_atomic_load(p, __ATOMIC_RELAXED, __HIP_MEMORY_SCOPE_AGENT); }
__device__ __forceinline__ unsigned xb_add(unsigned* p, unsigned v) { return __hip_atomic_fetch_add(p, v, __ATOMIC_RELAXED, __HIP_MEMORY_SCOPE_AGENT); }
__device__ __forceinline__ unsigned xb_xcc_id() { return (unsigned)__builtin_amdgcn_s_getreg((3 << 11) | 20) & 0xFu; }
#define XB_SPIN(cond, bar) do { unsigned _sp = 0; while (cond) { __builtin_amdgcn_s_sleep(1); \
    if ((++_sp & 255u) == 0u) { if (xb_ld(&(bar)[XB_TMO])) break; if (_sp > XB_SPIN_CAP) { atomicAdd(&(bar)[XB_TMO], 1u); break; } } } } while (0)

struct XcdBarrier {
    unsigned* bar; unsigned x;
    volatile LAS unsigned* st;
};

__device__ __forceinline__ XcdBarrier xcd_barrier_post(unsigned* bar, volatile LAS unsigned* st) {
    XcdBarrier b; b.bar = bar; b.x = xb_xcc_id(); b.st = st;
    if (threadIdx.x == 0) (void)xb_add(&bar[XB_XCNT(b.x)], 1u);
    return b;
}
__device__ __forceinline__ void xcd_barrier_complete(unsigned* bar, unsigned x, unsigned& nloc, unsigned& nx) {
    const unsigned G = gridDim.x * gridDim.y * gridDim.z;
    unsigned sum, cnt, mine, sp = 0u;
    for (;;) {
        sum = 0u; cnt = 0u; mine = 0u;
#pragma unroll
        for (unsigned j = 0; j < 16; ++j) { const unsigned c = xb_ld(&bar[XB_XCNT(j)]); sum += c; cnt += (c > 0u) ? 1u : 0u; mine = (j == x) ? c : mine; }
        if (sum == G) break;
        __builtin_amdgcn_s_sleep(1);
        if ((++sp & 255u) == 0u) { if (xb_ld(&bar[XB_TMO])) break; if (sp > XB_SPIN_CAP) { atomicAdd(&bar[XB_TMO], 1u); break; } }
    }
    nloc = mine > 0u ? mine : 1u; nx = cnt > 0u ? cnt : 1u;
}

__device__ __forceinline__ void xcd_barrier(const XcdBarrier& b) {
    asm volatile("s_waitcnt vmcnt(0)" ::: "memory");
    __syncthreads();
    if (threadIdx.x == 0) {
        unsigned* bar = b.bar;
        __builtin_amdgcn_s_waitcnt(0);
        unsigned nloc = b.st[0], nx = b.st[1];
        if (nloc == 0u) { xcd_barrier_complete(bar, b.x, nloc, nx); b.st[0] = nloc; b.st[1] = nx; }
        const unsigned old = xb_add(&bar[XB_XSUB(b.x)], 1u);
        const unsigned gen = old / nloc;
        if (old + 1u == (gen + 1u) * nloc) {
            __builtin_amdgcn_fence(__ATOMIC_RELEASE, "agent");
            asm volatile("s_waitcnt vmcnt(0)" ::: "memory");
            const unsigned og = xb_add(&bar[XB_TOP], 1u);
            const unsigned tg = og / nx;
            if (og + 1u == (tg + 1u) * nx) xb_add(&bar[XB_TOPGEN], 1u);
            else XB_SPIN(xb_ld(&bar[XB_TOPGEN]) == tg, bar);
            __builtin_amdgcn_fence(__ATOMIC_ACQUIRE, "agent");
            xb_add(&bar[XB_XGEN(b.x)], 1u);
            asm volatile("s_waitcnt vmcnt(0)" ::: "memory");
        } else {
            XB_SPIN(xb_ld(&bar[XB_XGEN(b.x)]) == gen, bar);
            __builtin_amdgcn_fence(__ATOMIC_ACQUIRE, "agent");
            asm volatile("s_waitcnt vmcnt(0)" ::: "memory");
        }
    }
    __syncthreads();
}

__device__ __forceinline__ void gsync(LAS unsigned char* lds) {
#ifdef USE_CG_SYNC
    gsync_cg();
#else
    XcdBarrier b; b.bar = (unsigned*)get_args()->ws; b.x = xb_xcc_id(); b.st = (volatile LAS unsigned*)(lds + LDS_RING);
    xcd_barrier(b);
#endif
}
__global__ void __launch_bounds__(512, 2) mega_fwd(Args a_unused) {
    extern __shared__ __attribute__((aligned(16))) unsigned char lds_raw[];
    LAS unsigned char* lds = (LAS unsigned char*)lds_raw;

    if (threadIdx.x < 2) ((volatile LAS unsigned*)(lds + LDS_RING))[threadIdx.x] = 0u;
    __syncthreads();
    (void)xcd_barrier_post((unsigned*)get_args()->ws, (volatile LAS unsigned*)(lds + LDS_RING));
    {
        ArgsP ap = get_args(); unsigned char* ws = ap->ws;
#ifdef DBG_CHECKS
        if (blockIdx.x == 0 && threadIdx.x < 32) atomicExch((unsigned*)ws + threadIdx.x, 0u);
#endif
        const int tid = threadIdx.x, lane = tid & 63, wave = __builtin_amdgcn_readfirstlane(tid >> 6), G = gridDim.x, bx = blockIdx.x, gw = bx * 8 + wave, NGW = G * 8;
        LAS float* scr = (LAS float*)(lds + wave * 16384);
        constexpr int I_FFI = 16 * 176, I_FFO = 44 * 32, I_HIN = 16 * 160, I_SQ = 16 * 32, I_MIN = 16 * 16, I_UQ = 4 * 48, I_UKV = 2 * 64;
        constexpr int NITEMS = 8 * I_FFI + 8 * I_FFO + 2 * I_HIN + 2 * I_SQ + 2 * I_MIN + 2 * I_UQ + 2 * I_UKV + 2 * I_SQ;
        for (int it = gw; it < NITEMS; it += NGW) {
            int r = it;
#define XP(IDX_, K_, NS_, ND_, MODE_, WSOFF_, NMAT_, IPM_) if (r < (NMAT_) * (IPM_)) { const int mat = r / (IPM_); \
            xpose_item(ap->in[IDX_] + (size_t)mat * (K_) * (NS_), K_, NS_, ND_, MODE_, (bf16_t*)(ws + (WSOFF_)) + (size_t)mat * (ND_) * (K_), scr, r % (IPM_), lane); continue; } r -= (NMAT_) * (IPM_);
            XP(3, 1024, 2 * DFF, 2 * DFF, 1, WS_WFFI, 8, I_FFI)
            XP(4, DFF, 1024, 1024, 0, WS_WFFO, 8, I_FFO)
            XP(11, 1024, 5120, 5120, 0, WS_WHIN, 2, I_HIN)
            XP(14, 1024, 1024, 1024, 0, WS_WHO, 2, I_SQ)
            XP(5, 1024, 448, 512, 2, WS_WMIN, 2, I_MIN)
            XP(8, 256, 1536, 1536, 3, WS_WUQ, 2, I_UQ)
            XP(9, 128, 2048, 2048, 0, WS_WUKV, 2, I_UKV)
            XP(10, 1024, 1024, 1024, 0, WS_WMO, 2, I_SQ)
#undef XP
        }
        { const int* positions = (const int*)ap->in[1]; float* COS = (float*)(ws + WS_COS); float* SIN = (float*)(ws + WS_SIN);
          for (int idx = bx * 512 + tid; idx < MT * 32; idx += G * 512) { const int m = idx >> 5, i = idx & 31;
            const double ang = (double)positions[m] * ROPE_INVF[i]; const double rev = ang * 0.15915494309189535; const float fr = (float)(rev - __builtin_rint(rev));
            COS[idx] = __builtin_amdgcn_cosf(fr); SIN[idx] = __builtin_amdgcn_sinf(fr); } }
        { float* LB = (float*)(ws + WS_LB);
          for (int idx = bx * 512 + tid; idx < 2 * 2 * 1024; idx += G * 512) { const int c = idx & 1023, dir = (idx >> 10) & 1, j = idx >> 11, l = 2 * j + 1;
            const float* lbp = ap->in[12] + (size_t)dir * DEPTH * 1024 + c; float v[4], mx = -1e30f;
#pragma unroll
            for (int i = 0; i < 4; ++i) { v[i] = lbp[i * 1024]; mx = fmaxf(mx, v[i]); }
            float den = 0.f, num = 0.f;
#pragma unroll
            for (int i = 0; i < 4; ++i) { const float e = __expf(v[i] - mx); den += e; if (i >= 1 && i <= l) num += e; }
            LB[idx] = num / den; } }
        { const float* x_in = ap->in[0]; float* X = ap->out; bf16_t* HN = (bf16_t*)(ws + WS_HN); const float* gains = ap->in[2];
          for (int m = gw; m < MT; m += NGW) row_init(x_in + (size_t)m * DM, X + (size_t)m * DM, HN + (size_t)m * DM, gains, lane); }
    }
    gsync_cg();

    for (int ph = 0; ph < 46; ++ph) {
        const int l = ph >= 35 ? 3 : (ph >= 23 ? 2 : (ph >= 12 ? 1 : 0)), s = ph - (l == 3 ? 35 : (l == 2 ? 23 : (l == 1 ? 12 : 0)));
        const bool hg = l & 1; const int j = l >> 1;
        const int op = hg ? OPS_H[s] : OPS_M[s];
        ArgsP ap = get_args(); unsigned char* ws = ap->ws; unsigned char* R = ws + WS_R;
        int G_ = gridDim.x, bx_ = blockIdx.x; asm volatile("" : "+s"(G_), "+s"(bx_));
        switch (op) {
        case OP_SW0: case OP_SW1: {
            const int half = op == OP_SW1;
            pg8::Gemm gm{(const bf16_t*)(ws + WS_HN), (const bf16_t*)(ws + WS_WFFI) + (size_t)(l * 2 + half) * (2 * DFF) * 1024, MT, 2 * DFF, 1024};
            pg8::StaticOrder S; S.init(MT, 2 * DFF, G_, bx_); EpiSwiglu E{(bf16_t*)(R + R_ACT)};
#ifndef NO_SW
            pg8::gemm_phase<EpiSwiglu, pg8::StaticOrder, true, true>(lds, gm, S, E);
#endif
        } break;
        case OP_FO0: case OP_FO1: case OP_MIN: case OP_MWO: case OP_HWO: {
            pg8::Gemm gm; EpiF32 E; float* Y = (float*)(ws + WS_Y);
            if (op == OP_FO0 || op == OP_FO1) { const int half = op == OP_FO1; gm = pg8::Gemm{(const bf16_t*)(R + R_ACT), (const bf16_t*)(ws + WS_WFFO) + (size_t)(l * 2 + half) * 1024 * DFF, MT, 1024, DFF}; E = EpiF32{Y, 1024}; }
            else if (op == OP_MIN) { gm = pg8::Gemm{(const bf16_t*)(ws + WS_HN), (const bf16_t*)(ws + WS_WMIN) + (size_t)j * 512 * 1024, MT, 512, 1024}; E = EpiF32{(float*)(R + R_C), 512}; }
            else if (op == OP_MWO) { gm = pg8::Gemm{(const bf16_t*)(R + R_O), (const bf16_t*)(ws + WS_WMO) + (size_t)j * 1024 * 1024, MT, 1024, 1024}; E = EpiF32{Y, 1024}; }
            else { gm = pg8::Gemm{(const bf16_t*)(R + R_HO), (const bf16_t*)(ws + WS_WHO) + (size_t)j * 1024 * 1024, MT, 1024, 1024}; E = EpiF32{Y, 1024}; }
            pg8::StaticOrder S; S.init(MT, gm.N, G_, bx_);
#ifndef NO_F32
            pg8::gemm_phase<EpiF32, pg8::StaticOrder, true, true>(lds, gm, S, E);
#endif
        } break;
        case OP_RPA: case OP_RPB: case OP_RPC: {
            const float* gains = ap->in[2]; const float* g = gains + (size_t)l * 6 * DM; float* Y = (float*)(ws + WS_Y); float* X = ap->out; bf16_t* HN = (bf16_t*)(ws + WS_HN);
            const int k = op == OP_RPA ? 1 : (op == OP_RPB ? 3 : 5); const float scale = op == OP_RPB ? 1.0f : 0.5f;
            const bool last = (op == OP_RPC) && (l == DEPTH - 1);
            const float* gn = op == OP_RPC ? gains + (size_t)(l + 1) * 6 * DM : g + (size_t)(k + 1) * DM;
            const int lane = LANE_;
            for (int m = bx_ * 8 + __builtin_amdgcn_readfirstlane(otid_() >> 6); m < MT; m += G_ * 8) row_post(Y + (size_t)m * DM, X + (size_t)m * DM, last ? (bf16_t*)nullptr : HN + (size_t)m * DM, scale, g + (size_t)k * DM, last ? g : gn, lane);
        } break;
        case OP_RMLA: {
            const float* qn = ap->in[6] + (size_t)j * QLR; const float* kvn = ap->in[7] + (size_t)j * KVLR; const float* COS = (const float*)(ws + WS_COS); const float* SIN = (const float*)(ws + WS_SIN);
            const int lane = LANE_;
            for (int m = bx_ * 8 + __builtin_amdgcn_readfirstlane(otid_() >> 6); m < MT; m += G_ * 8) row_mla((const float*)(R + R_C) + (size_t)m * 512, (bf16_t*)(R + R_CQ) + (size_t)m * 256, (bf16_t*)(R + R_CKV) + (size_t)m * 128, (bf16_t*)(R + R_KR) + (size_t)m * 64,
                                                         qn, kvn, COS + (size_t)m * 32, SIN + (size_t)m * 32, lane);
        } break;
        case OP_QKV: {
            { int Kq = 256; asm volatile("" : "+s"(Kq)); pg8::Gemm gm{(const bf16_t*)(R + R_CQ), (const bf16_t*)(ws + WS_WUQ) + (size_t)j * 1536 * 256, MT, 1536, Kq};
              pg8::StaticOrder S; S.init(MT, 1536, G_, bx_); EpiQ E{(bf16_t*)(R + R_QB), (const float*)(ws + WS_COS), (const float*)(ws + WS_SIN)};
#ifndef NO_Q
              pg8::gemm_phase<EpiQ, pg8::StaticOrder, true, true>(lds, gm, S, E);
#endif
            }
            __syncthreads();
            { int Kq = 128; asm volatile("" : "+s"(Kq)); pg8::Gemm gm{(const bf16_t*)(R + R_CKV), (const bf16_t*)(ws + WS_WUKV) + (size_t)j * 2048 * 128, MT, 2048, Kq};
              pg8::StaticOrder S; S.init(MT, 2048, G_, bx_); EpiKV E{(bf16_t*)(R + R_KN), (bf16_t*)(R + R_VB)};
#ifndef NO_KV
              pg8::gemm_phase<EpiKV, pg8::StaticOrder, true, true>(lds, gm, S, E);
#endif
            }
        } break;
        case OP_ATTN: {
#ifndef NO_ATTN
            const int G = G_, bx = bx_;

            const int vcu = (G % 8 == 0) ? (bx % 8) * (G / 8) + bx / 8 : bx;
#ifdef REP_ATTN
            for (int rep_ = 0; rep_ < 2; ++rep_)
#endif
            for (int uid = vcu; uid < BATCH * NH * (SEQ / 256); uid += G) {
                const int bh = uid >> 5, qb = uid & 31, b = bh >> 3, h = bh & 7;
                const size_t row0 = (size_t)b * SEQ;
                att::attn_unit((const att::bf16*)(R + R_QB) + (row0 + qb * 256) * 1536 + h * QKD, (const att::bf16*)(R + R_KN) + row0 * 1024 + h * 128,
                               (const att::bf16*)(R + R_KR) + row0 * 64, (const att::bf16*)(R + R_VB) + row0 * 1024 + h * 128,
                               (att::bf16*)(R + R_O) + (row0 + qb * 256) * 1024 + h * 128, SEQ, (char*)lds_raw);
            }
#endif
        } break;
        case OP_HIN: {
            pg8::Gemm gm{(const bf16_t*)(ws + WS_HN), (const bf16_t*)(ws + WS_WHIN) + (size_t)j * 5120 * 1024, MT, 5120, 1024};
            pg8::StaticOrder S; S.init(MT, 5120, G_, bx_);
            EpiHgrn E{(bf16_t*)(R + R_QH), (bf16_t*)(R + R_VH), (bf16_t*)(R + R_GH), (unsigned short*)(R + R_KF), (const float*)(ws + WS_LB) + (size_t)j * 2048};
#ifndef NO_HG
            pg8::gemm_phase<EpiHgrn, pg8::StaticOrder, true, true>(lds, gm, S, E);
#endif
        } break;
        case OP_SCAN: {
#ifndef NO_SCAN
#ifdef REP_SCAN
            scan_phase(lds, (const bf16_t*)(R + R_QH), (const bf16_t*)(R + R_VH), (const unsigned short*)(R + R_KF), (bf16_t*)(ws + WS_Y), G_, bx_); __syncthreads();
#endif
            scan_phase(lds, (const bf16_t*)(R + R_QH), (const bf16_t*)(R + R_VH), (const unsigned short*)(R + R_KF), (bf16_t*)(ws + WS_Y), G_, bx_);
#endif
        } break;
        case OP_RHG: {
            const float* on = ap->in[13] + (size_t)j * DM; const bf16_t* Y = (const bf16_t*)(ws + WS_Y);
            const int lane = LANE_;
            for (int m = bx_ * 8 + __builtin_amdgcn_readfirstlane(otid_() >> 6); m < MT; m += G_ * 8) row_hgrn(Y + (size_t)m * DM, (const bf16_t*)(R + R_GH) + (size_t)m * DM, (bf16_t*)(R + R_HO) + (size_t)m * DM, on, lane);
        } break;
        default: break;
        }
        if (ph != 45) gsync(lds);
#ifdef REP_SYNC
        gsync(lds);
#endif
#ifdef DBG_CHECKS
        { ArgsP ap2 = get_args(); dbg_after(l, op, ap2, ap2->ws, ap2->ws + WS_R, lds); gsync(lds); }
#endif
    }
#ifdef DBG_CHECKS
    gsync(lds);
    if (blockIdx.x == 0 && threadIdx.x == 0) { ArgsP ap = get_args(); unsigned* DBG = (unsigned*)ap->ws; const float mx = __uint_as_float(atomicAdd(DBG + 20, 0u)), mean = atomicAdd((float*)(DBG + 21), 0.f); ap->out[1024 * 16] += 1e6f * mx; ap->out[1024 * 16 + 1] += 1e4f * mean; }
#endif
}

extern "C" void kernel_launch(void* const* d_in, const int* in_sizes, int n_in, void* d_out, int out_size, void* d_ws, size_t ws_size, hipStream_t stream) {
    static int grid = 0;
    if (grid == 0) {
        if (n_in != 15 || out_size != MT * DM || ws_size < WS_END) { fprintf(stderr, "kernel_launch: unexpected shapes: n_in %d out %d ws %zu (need %zu)\n", n_in, out_size, ws_size, (size_t)WS_END); grid = -1; return; }
        int dev = 0, cus = 0, per_cu = 0;
        (void)hipGetDevice(&dev); (void)hipDeviceGetAttribute(&cus, hipDeviceAttributeMultiprocessorCount, dev);
        if (hipFuncSetAttribute((const void*)mega_fwd, hipFuncAttributeMaxDynamicSharedMemorySize, LDS_BYTES) != hipSuccess) { fprintf(stderr, "kernel_launch: hipFuncSetAttribute failed\n"); grid = -1; return; }
        if (hipOccupancyMaxActiveBlocksPerMultiprocessor(&per_cu, (const void*)mega_fwd, 512, LDS_BYTES) != hipSuccess || per_cu < 1) { fprintf(stderr, "kernel_launch: occupancy query gave %d\n", per_cu); per_cu = 1; }
        (void)hipGetLastError();
        grid = cus * 1;
        fprintf(stderr, "kernel_launch: cus %d per_cu %d grid %d\n", cus, per_cu, grid);
    }
    if (grid < 0) return;
    if (hipMemsetAsync(d_ws, 0, 65536, stream) != hipSuccess) { fprintf(stderr, "kernel_launch: memset failed\n"); return; }
    Args a{};
    for (int i = 0; i < 15; ++i) a.in[i] = (const float*)d_in[i];
    a.out = (float*)d_out; a.ws = (unsigned char*)d_ws;
    void* args[] = {&a};
    hipError_t e = hipLaunchCooperativeKernel((const void*)mega_fwd, dim3(grid), dim3(512), args, LDS_BYTES, stream);
    if (e != hipSuccess) fprintf(stderr, "cooperative launch failed: %s (grid %d)\n", hipGetErrorString(e), grid);
}
```

```cpp
#include <hip/hip_runtime.h>
#include <hip/hip_cooperative_groups.h>
#include <hip/hip_bf16.h>
#include <hip/hip_fp16.h>
#include <cstdio>
#include <cstdint>
#include <cmath>
namespace cg = cooperative_groups;
namespace pg8 {
#define PG8_LAS __attribute__((address_space(3)))
typedef unsigned short bf16_t;
typedef short bf16x8 __attribute__((ext_vector_type(8)));
typedef float f32x4 __attribute__((ext_vector_type(4)));
typedef unsigned u32x4 __attribute__((ext_vector_type(4)));
constexpr int BM = 256, BK = 64, HALF = 128, HTB = HALF * BK * 2  , STAGE_BYTES = 8 * HTB, NXCD = 8, WGM = 8;

__host__ __device__ __forceinline__ int lds_byte(int r, int c) { const int st = (r >> 4) * 2 + (c >> 5), rr = r & 15, cc = c & 31, ob = rr * 64 + cc * 2; return st * 1024 + (ob ^ (((ob >> 9) & 1) << 5)); }
__host__ __device__ __forceinline__ void stage_rc(int b, int& R, int& C) { const int st = b / 1024, sb = b % 1024, swz = sb ^ (((sb >> 9) & 1) << 5); R = (st >> 1) * 16 + swz / 64; C = (st & 1) * 32 + (swz % 64) / 2; }
__host__ __device__ __forceinline__ int perm32(int rho) { const int n = rho >> 4, i = rho & 15; return 8 * (i >> 2) + 4 * n + (i & 3); }

struct Unit { int pm, pn; };
struct Gemm { const bf16_t* A; const bf16_t* Bt; int M, N, K; };

struct StaticOrder {
    int nM, nN, nwg, G, c;
    __host__ __device__ void init(int M, int N, int G_, int c_) { nM = M / BM; nN = N / BM; nwg = nM * nN; G = G_; c = c_; }
    __host__ __device__ bool next(int i, Unit& u) const {
        const long L = (long)i * G + c; if (L >= nwg) return false;
        int wgid = (int)L; { const int q = nwg / NXCD, r = nwg % NXCD, xcd = wgid % NXCD, off = wgid / NXCD; wgid = (xcd < r ? xcd * (q + 1) : r * (q + 1) + (xcd - r) * q) + off; }
        const int nig = WGM * nN, gid = wgid / nig, fm = gid * WGM, gsz = (nM - fm) < WGM ? (nM - fm) : WGM;
        u.pm = fm + ((wgid % nig) % gsz); u.pn = (wgid % nig) / gsz; return true;
    }
    __device__ __forceinline__ void a_ready(const Unit&) const {}
    __device__ __forceinline__ void done(const Unit&) const {}
};

__device__ __forceinline__ unsigned cvt_pk_bf16(float lo, float hi) { unsigned r; asm volatile("v_cvt_pk_bf16_f32 %0, %1, %2" : "=v"(r) : "v"(lo), "v"(hi)); return r; }
template <class Epi, class Sched, bool ALIGN_EPI = false, bool SP2 = false>
__device__ __forceinline__ void gemm_phase(PG8_LAS unsigned char* lds, const Gemm g, const Sched& S, const Epi& E) {
    int tid = threadIdx.x; asm volatile("" : "+v"(tid)); const int wid = __builtin_amdgcn_readfirstlane(tid >> 6), lane = tid & 63, wr = wid >> 2, wc = wid & 3, fr = lane & 15, fq = lane >> 4;
    const int K = g.K, nt = K / BK;
    unsigned voffA[2], voffB[2];
#pragma unroll
    for (int i = 0; i < 2; ++i) { int R, C; stage_rc(tid * 16 + i * 8192, R, C); const int Rb = Epi::PERM ? ((R & ~31) + perm32(R & 31)) : R;
        voffA[i] = (unsigned)(R * K + C) * 2u; voffB[i] = (unsigned)(Rb * K + C) * 2u; }
    const size_t kstep = (size_t)(BK * 2);
    const size_t hstep = (size_t)HALF * K * 2;
    const size_t tstep = 2 * hstep;
    const unsigned ldsw = (unsigned)wid * 1024u;
    const int aoff = lds_byte(wr * 64 + fr, fq * 8), boff = lds_byte(wc * 32 + fr, fq * 8);
#define PG8_SA(b, h) (((b) * 2 + (h)) * HTB)
#define PG8_SB(b, h) ((4 + (b) * 2 + (h)) * HTB)
#define PG8_STAGE(bufoff, gbase, voff) do { _Pragma("unroll") for (int _i = 0; _i < 2; ++_i) \
        __builtin_amdgcn_global_load_lds((const unsigned*)((const char*)(gbase) + (voff)[_i]), (PG8_LAS unsigned*)(lds + (bufoff) + ldsw + _i * 8192), 16, 0, 0); } while (0)
#define PG8_LDA(dst, b, h) do { _Pragma("unroll") for (int m = 0; m < 4; ++m) _Pragma("unroll") for (int k = 0; k < 2; ++k) dst[m][k] = *(const PG8_LAS bf16x8*)(lds + PG8_SA(b, h) + aoff + m * 2048 + k * 1024); } while (0)
#define PG8_LDB(dst, b, h) do { _Pragma("unroll") for (int n = 0; n < 2; ++n) _Pragma("unroll") for (int k = 0; k < 2; ++k) dst[n][k] = *(const PG8_LAS bf16x8*)(lds + PG8_SB(b, h) + boff + n * 2048 + k * 1024); } while (0)
#define PG8_MMA(ai, bj, At, Bt) do { __builtin_amdgcn_s_setprio(1); _Pragma("unroll") for (int m = 0; m < 4; ++m) _Pragma("unroll") for (int n = 0; n < 2; ++n) _Pragma("unroll") for (int k = 0; k < 2; ++k) \
        acc[ai][bj][m][n] = __builtin_amdgcn_mfma_f32_16x16x32_bf16(Bt[n][k], At[m][k], acc[ai][bj][m][n], 0, 0, 0); __builtin_amdgcn_s_setprio(0); } while (0)
#define PG8_WAIT_V(n) asm volatile("s_waitcnt vmcnt(" #n ")" ::: "memory")
#define PG8_WAIT_L(n) asm volatile("s_waitcnt lgkmcnt(" #n ")" ::: "memory")
#define PG8_BAR __builtin_amdgcn_s_barrier()
#define PG8_SCHED __builtin_amdgcn_sched_barrier(0)
    Unit cur, nxt; int ui = 0;
    if (!S.next(0, cur)) return;
    f32x4 acc[2][2][4][2];
#pragma unroll
    for (int a = 0; a < 2; ++a)
#pragma unroll
        for (int b = 0; b < 2; ++b)
#pragma unroll
            for (int m = 0; m < 4; ++m)
#pragma unroll
                for (int n = 0; n < 2; ++n) acc[a][b][m][n] = (f32x4){0.f, 0.f, 0.f, 0.f};
    bf16x8 At[4][2], B0[2][2], B1[2][2];
    const char* cA = (const char*)g.A + (size_t)cur.pm * tstep; const char* cB = (const char*)g.Bt + (size_t)cur.pn * tstep;
    S.a_ready(cur);
    if constexpr (SP2) {
        PG8_STAGE(PG8_SB(0, 0), cB, voffB); PG8_STAGE(PG8_SB(0, 1), cB + hstep, voffB); PG8_STAGE(PG8_SA(0, 0), cA, voffA); PG8_STAGE(PG8_SA(0, 1), cA + hstep, voffA);
        if (wr == 1) PG8_BAR;
        PG8_WAIT_V(2); PG8_BAR;
        PG8_STAGE(PG8_SB(1, 0), cB + kstep, voffB); PG8_STAGE(PG8_SA(1, 0), cA + kstep, voffA); PG8_STAGE(PG8_SB(1, 1), cB + hstep + kstep, voffB);
        PG8_WAIT_V(6); PG8_BAR;
    } else {
        PG8_STAGE(PG8_SB(0, 0), cB, voffB); PG8_STAGE(PG8_SA(0, 0), cA, voffA); PG8_STAGE(PG8_SB(0, 1), cB + hstep, voffB); PG8_STAGE(PG8_SA(0, 1), cA + hstep, voffA);
        if (wr == 1) PG8_BAR;
        PG8_WAIT_V(4); PG8_BAR;
        PG8_STAGE(PG8_SB(1, 0), cB + kstep, voffB); PG8_STAGE(PG8_SA(1, 0), cA + kstep, voffA); PG8_STAGE(PG8_SB(1, 1), cB + hstep + kstep, voffB);
        PG8_WAIT_V(6); PG8_BAR;
    }
    for (;;) {
        const bool has_next = S.next(ui + 1, nxt);
        const char* nA = has_next ? (const char*)g.A + (size_t)nxt.pm * tstep : cA; const char* nB = has_next ? (const char*)g.Bt + (size_t)nxt.pn * tstep : cB;
        for (int t = 0; t < nt; t += 2) {
            const bool last = (t == nt - 2);
            const char* a1 = cA + (size_t)(t + 1) * kstep;
            const char* a2 = last ? nA : cA + (size_t)(t + 2) * kstep; const char* b2 = last ? nB : cB + (size_t)(t + 2) * kstep;
            const char* a3 = a2 + kstep; const char* b3 = b2 + kstep;
            if (last && has_next) S.a_ready(nxt);
            if constexpr (SP2) {
            PG8_LDB(B0, 0, 0); PG8_LDB(B1, 0, 1); PG8_SCHED; PG8_LDA(At, 0, 0); PG8_STAGE(PG8_SA(1, 1), a1 + hstep, voffA);
            PG8_WAIT_V(8); PG8_WAIT_L(0); PG8_BAR; PG8_MMA(0, 0, At, B0); PG8_MMA(0, 1, At, B1); PG8_BAR; PG8_SCHED;
            PG8_LDA(At, 0, 1); PG8_STAGE(PG8_SB(0, 0), b2, voffB); PG8_STAGE(PG8_SB(0, 1), b2 + hstep, voffB); PG8_STAGE(PG8_SA(0, 0), a2, voffA);
            PG8_WAIT_V(8); PG8_WAIT_L(0); PG8_BAR; PG8_MMA(1, 0, At, B0); PG8_MMA(1, 1, At, B1); PG8_BAR; PG8_SCHED;
            PG8_LDB(B0, 1, 0); PG8_LDB(B1, 1, 1); PG8_SCHED; PG8_LDA(At, 1, 0); PG8_STAGE(PG8_SA(0, 1), a2 + hstep, voffA);
            PG8_WAIT_V(8); PG8_WAIT_L(0); PG8_BAR; PG8_MMA(0, 0, At, B0); PG8_MMA(0, 1, At, B1); PG8_BAR; PG8_SCHED;
            PG8_LDA(At, 1, 1); PG8_STAGE(PG8_SB(1, 0), b3, voffB); PG8_STAGE(PG8_SB(1, 1), b3 + hstep, voffB); PG8_STAGE(PG8_SA(1, 0), a3, voffA);
            PG8_WAIT_V(8); PG8_WAIT_L(0); PG8_BAR; PG8_MMA(1, 0, At, B0); PG8_MMA(1, 1, At, B1); PG8_BAR; PG8_SCHED;
            } else {
            PG8_LDB(B0, 0, 0); PG8_SCHED; PG8_LDA(At, 0, 0); PG8_STAGE(PG8_SA(1, 1), a1 + hstep, voffA);
            PG8_WAIT_L(8); PG8_BAR; PG8_WAIT_L(0); PG8_MMA(0, 0, At, B0); PG8_BAR; PG8_SCHED;
            PG8_LDB(B1, 0, 1); PG8_STAGE(PG8_SB(0, 0), b2, voffB);
            PG8_BAR; PG8_WAIT_L(0); PG8_MMA(0, 1, At, B1); PG8_BAR;
            PG8_LDA(At, 0, 1); PG8_STAGE(PG8_SA(0, 0), a2, voffA);
            PG8_BAR; PG8_WAIT_L(0); PG8_MMA(1, 0, At, B0); PG8_BAR; PG8_SCHED;
            PG8_STAGE(PG8_SB(0, 1), b2 + hstep, voffB);
            PG8_WAIT_V(6); PG8_BAR; PG8_MMA(1, 1, At, B1); PG8_BAR;
            PG8_LDB(B0, 1, 0); PG8_SCHED; PG8_LDA(At, 1, 0); PG8_STAGE(PG8_SA(0, 1), a2 + hstep, voffA);
            PG8_WAIT_L(8); PG8_BAR; PG8_WAIT_L(0); PG8_MMA(0, 0, At, B0); PG8_BAR; PG8_SCHED;
            PG8_LDB(B1, 1, 1); PG8_STAGE(PG8_SB(1, 0), b3, voffB);
            PG8_BAR; PG8_WAIT_L(0); PG8_MMA(0, 1, At, B1); PG8_BAR;
            PG8_LDA(At, 1, 1); PG8_STAGE(PG8_SA(1, 0), a3, voffA);
            PG8_BAR; PG8_WAIT_L(0); PG8_MMA(1, 0, At, B0); PG8_BAR; PG8_SCHED;
            PG8_STAGE(PG8_SB(1, 1), b3 + hstep, voffB);
            PG8_WAIT_V(6); PG8_BAR; PG8_MMA(1, 1, At, B1); PG8_BAR;
            }
        }
        if constexpr (ALIGN_EPI) { if (wr == 0) PG8_BAR; }
        if constexpr (!Epi::AFTER_DRAIN) { E(acc, cur, wr, wc, fr, fq); S.done(cur); }
        if (!has_next) break;
#pragma unroll
        for (int a = 0; a < 2; ++a)
#pragma unroll
            for (int b = 0; b < 2; ++b)
#pragma unroll
                for (int m = 0; m < 4; ++m)
#pragma unroll
                    for (int n = 0; n < 2; ++n) acc[a][b][m][n] = (f32x4){0.f, 0.f, 0.f, 0.f};
        cur = nxt; cA = nA; cB = nB; ++ui;
        if constexpr (ALIGN_EPI) { if (wr == 1) PG8_BAR; }
    }
    PG8_WAIT_V(0);
    if constexpr (!ALIGN_EPI) { if (wr == 0) PG8_BAR; }
    PG8_BAR;
    if constexpr (Epi::AFTER_DRAIN) { E.fused(acc, cur, wr, wc, fr, fq, lds, wid, lane); S.done(cur); }
#undef PG8_SA
#undef PG8_SB
#undef PG8_STAGE
#undef PG8_LDA
#undef PG8_LDB
#undef PG8_MMA
#undef PG8_WAIT_V
#undef PG8_WAIT_L
#undef PG8_BAR
#undef PG8_SCHED
}
}
#ifndef ATT_SDEPTH
#define ATT_SDEPTH 1
#endif
namespace att {
using bf16 = __hip_bfloat16;
constexpr int NW = 8, QBLK = 32, KVBLK = 64;
constexpr float SCALE = 0.07216878364870322f;
constexpr float THR = 8.f;
__device__ __forceinline__ int otid() { int t = threadIdx.x; asm volatile("" : "+v"(t)); return t; }
using bf16x8 = __attribute__((ext_vector_type(8))) short;
using s16x4  = __attribute__((ext_vector_type(4))) short;
using f32x16 = __attribute__((ext_vector_type(16))) float;
using f32x8  = __attribute__((ext_vector_type(8))) float;
using u32x4  = __attribute__((ext_vector_type(4))) unsigned;
#define KSWZ(row, colB) ((row) * 256 + ((colB) ^ (((row) & 7) << 4)))
#define SBAR() __builtin_amdgcn_sched_barrier(0)
__device__ __forceinline__ int crow(int r, int hi) { return (r & 3) + 8 * (r >> 2) + 4 * hi; }
__device__ __forceinline__ unsigned cvtpk(float lo, float hi) {
  unsigned r; asm volatile("v_cvt_pk_bf16_f32 %0, %1, %2" : "=v"(r) : "v"(lo), "v"(hi)); return r;
}
template <typename TIn> struct Stage;
template <> struct Stage<bf16>  { using T = bf16x8;
  __device__ static __forceinline__ T ld8(const bf16* p) { return *reinterpret_cast<const bf16x8*>(p); }
  __device__ static __forceinline__ bf16x8 tobf(T x) { return x; } };
template <> struct Stage<float> { using T = f32x8;
  __device__ static __forceinline__ T ld8(const float* p) { return *reinterpret_cast<const f32x8*>(p); }
  __device__ static __forceinline__ bf16x8 tobf(T x) {
    u32x4 w = {cvtpk(x[0], x[1]), cvtpk(x[2], x[3]), cvtpk(x[4], x[5]), cvtpk(x[6], x[7])}; return *reinterpret_cast<bf16x8*>(&w); } };

__device__ __forceinline__ void partialSM(f32x16& p0, f32x16& p1, float& m_reg, float& mn, float& alpha) {
  constexpr float C = SCALE * 1.4426950408889634f;
  float pmax = p0[0]; for (int r = 1; r < 16; ++r) pmax = fmaxf(pmax, p0[r]); for (int r = 0; r < 16; ++r) pmax = fmaxf(pmax, p1[r]);
  { auto rr = __builtin_amdgcn_permlane32_swap(__float_as_uint(pmax), __float_as_uint(pmax), false, false);
    pmax = fmaxf(__uint_as_float(rr[0]), __uint_as_float(rr[1])); }
  if (__builtin_expect(__all(pmax - m_reg <= THR / SCALE), 1)) { mn = m_reg; alpha = 1.f; }
  else { mn = fmaxf(m_reg, pmax); alpha = __builtin_amdgcn_exp2f((m_reg - mn) * C); m_reg = mn; }
  float mnC = -mn * C;
  for (int r = 0; r < 16; ++r) p0[r] = fmaf(p0[r], C, mnC); for (int r = 0; r < 16; ++r) p1[r] = fmaf(p1[r], C, mnC);
  for (int r = 0; r < 16; ++r) p0[r] = __builtin_amdgcn_exp2f(p0[r]);
}
__device__ __forceinline__ void finishSM(f32x16& p0, f32x16& p1, float alpha, float& l_reg, bf16x8& pa0, bf16x8& pa1, bf16x8& pa2, bf16x8& pa3) {
  for (int r = 0; r < 16; ++r) p1[r] = __builtin_amdgcn_exp2f(p1[r]);
  float ps = 0; for (int r = 0; r < 16; ++r) ps += p0[r]; for (int r = 0; r < 16; ++r) ps += p1[r];
  { auto rr = __builtin_amdgcn_permlane32_swap(__float_as_uint(ps), __float_as_uint(ps), false, false);
    ps = __uint_as_float(rr[0]) + __uint_as_float(rr[1]); }
  l_reg = l_reg * alpha + ps;
#define PK4(P, BASE, OUT) do { unsigned a0 = cvtpk(P[BASE + 0], P[BASE + 1]), a1 = cvtpk(P[BASE + 2], P[BASE + 3]);   \
    unsigned b0 = cvtpk(P[BASE + 4], P[BASE + 5]), b1 = cvtpk(P[BASE + 6], P[BASE + 7]);                              \
    auto r0 = __builtin_amdgcn_permlane32_swap(a0, b0, false, false); auto r1 = __builtin_amdgcn_permlane32_swap(a1, b1, false, false); \
    u32x4 w = {r0[0], r1[0], r0[1], r1[1]}; OUT = *reinterpret_cast<bf16x8*>(&w); } while (0)
  PK4(p0, 0, pa0); PK4(p0, 8, pa1); PK4(p1, 0, pa2); PK4(p1, 8, pa3);
#undef PK4
}
#define KSWZ2(row, colB) ((row) * 128 + ((colB) ^ (((row) & 7) << 4)))
__device__ __forceinline__ void qkt(f32x16& p0, f32x16& p1, const bf16* Ks, const bf16* KRs, const bf16x8* qr, const bf16x8* qrl, int r32, int hi) {
  p0 = f32x16{}; p1 = f32x16{};
#pragma unroll
  for (int d0 = 0; d0 < 8; ++d0) { int cb = (d0 * 16 + hi * 8) * 2;
    bf16x8 b0 = *reinterpret_cast<const bf16x8*>((const char*)Ks + KSWZ(r32, cb));
    bf16x8 b1 = *reinterpret_cast<const bf16x8*>((const char*)Ks + KSWZ(32 + r32, cb));
    p0 = __builtin_amdgcn_mfma_f32_32x32x16_bf16(b0, qr[d0], p0, 0, 0, 0);
    p1 = __builtin_amdgcn_mfma_f32_32x32x16_bf16(b1, qr[d0], p1, 0, 0, 0); }
#pragma unroll
  for (int d0 = 0; d0 < 4; ++d0) { int cb = (d0 * 16 + hi * 8) * 2;
    bf16x8 b0 = *reinterpret_cast<const bf16x8*>((const char*)KRs + KSWZ2(r32, cb));
    bf16x8 b1 = *reinterpret_cast<const bf16x8*>((const char*)KRs + KSWZ2(32 + r32, cb));
    const bf16x8 qv = qrl[d0 * 64];
    p0 = __builtin_amdgcn_mfma_f32_32x32x16_bf16(b0, qv, p0, 0, 0, 0);
    p1 = __builtin_amdgcn_mfma_f32_32x32x16_bf16(b1, qv, p1, 0, 0, 0); }
}
__device__ __forceinline__ int v_st(int k, int c) { const int kk = (k & ~0xC) | ((k & 4) << 1) | ((k & 8) >> 1); return ((kk >> 3) * 4 + (c >> 5)) * 512 + ((kk & 7) * 32 + (c & 31)) * 2; }
__device__ __forceinline__ int v_rd_base(int lane) { return ((lane & 3) << 3) | (((lane >> 2) & 3) << 6) | (((lane >> 4) & 1) << 5) | (((lane >> 5) & 1) << 8); }
constexpr int v_rd_off(int d0, int ks, int half) { return d0 * 512 + ks * 4096 + half * 2048; }
template <int OFF> __device__ __forceinline__ s16x4 tr_read(int vb) {
  s16x4 r; asm volatile("ds_read_b64_tr_b16 %0, %1 offset:%2" : "=&v"(r) : "v"(vb), "i"(OFF) : "memory"); return r;
}
template <int D0> __device__ __forceinline__ void pv_one(f32x16& od, int vb, bf16x8 pa0, bf16x8 pa1, bf16x8 pa2, bf16x8 pa3) {
  const s16x4 l0 = tr_read<v_rd_off(D0, 0, 0)>(vb), h0 = tr_read<v_rd_off(D0, 0, 1)>(vb), l1 = tr_read<v_rd_off(D0, 1, 0)>(vb), h1 = tr_read<v_rd_off(D0, 1, 1)>(vb);
  const s16x4 l2 = tr_read<v_rd_off(D0, 2, 0)>(vb), h2 = tr_read<v_rd_off(D0, 2, 1)>(vb), l3 = tr_read<v_rd_off(D0, 3, 0)>(vb), h3 = tr_read<v_rd_off(D0, 3, 1)>(vb);
  asm volatile("s_waitcnt lgkmcnt(0)" ::: "memory"); SBAR();
#define PK(L, H) (bf16x8){L[0], L[1], L[2], L[3], H[0], H[1], H[2], H[3]}
  od = __builtin_amdgcn_mfma_f32_32x32x16_bf16(pa0, PK(l0, h0), od, 0, 0, 0);
  od = __builtin_amdgcn_mfma_f32_32x32x16_bf16(pa1, PK(l1, h1), od, 0, 0, 0);
  od = __builtin_amdgcn_mfma_f32_32x32x16_bf16(pa2, PK(l2, h2), od, 0, 0, 0);
  od = __builtin_amdgcn_mfma_f32_32x32x16_bf16(pa3, PK(l3, h3), od, 0, 0, 0);
#undef PK
}
__device__ __forceinline__ void pv_d0(f32x16* o, int vb, bf16x8 pa0, bf16x8 pa1, bf16x8 pa2, bf16x8 pa3) {
  pv_one<0>(o[0], vb, pa0, pa1, pa2, pa3); pv_one<1>(o[1], vb, pa0, pa1, pa2, pa3); pv_one<2>(o[2], vb, pa0, pa1, pa2, pa3); pv_one<3>(o[3], vb, pa0, pa1, pa2, pa3);
}
constexpr int LDQ = 1536, LDK = 1024, LDV = 1024, LDKR = 64, LDO = 1024, SDEPTH = ATT_SDEPTH;
constexpr int SHM_V = KVBLK * 128 * 2, SHM_K = KVBLK * 128 * 2, SHM_KR = KVBLK * 64 * 2;
constexpr int SHM_QR = NW * 4 * 64 * 16;
constexpr int SHM_ATTN = 2 * SHM_V + 2 * SHM_K + 2 * SHM_KR + NW * 64 * 4 + SHM_QR;
__device__ __forceinline__ void attn_unit(const bf16* __restrict__ Qb, const bf16* __restrict__ Kh, const bf16* __restrict__ KRh, const bf16* __restrict__ Vh,
                                          bf16* __restrict__ Ob, int seq, char* lds) {
  using St = Stage<bf16>;
  const int tid = otid(), wid = tid >> 6, lane = tid & 63, r32 = lane & 31, hi = lane >> 5;
  bf16* V_lds = (bf16*)lds; bf16* K_lds = (bf16*)(lds + 2 * SHM_V); bf16* KR_lds = (bf16*)(lds + 2 * SHM_V + 2 * SHM_K);
  float* ws = (float*)(lds + 2 * SHM_V + 2 * SHM_K + 2 * SHM_KR) + wid * 64; float* li_l = ws; float* al_l = ws + 32;
  float m_reg = -1e30f, l_reg = 0; f32x16 o[4] = {}; bf16x8 qr[8];
  bf16x8* qrl = (bf16x8*)(lds + 2 * SHM_V + 2 * SHM_K + 2 * SHM_KR + NW * 64 * 4) + wid * 256 + lane;
  const bf16* Qw = Qb + (long)(wid * QBLK + r32) * LDQ + hi * 8;
#pragma unroll
  for (int d0 = 0; d0 < 8; ++d0) qr[d0] = St::ld8(Qw + d0 * 16);
#pragma unroll
  for (int d0 = 0; d0 < 4; ++d0) qrl[d0 * 64] = St::ld8(Qw + 128 + d0 * 16);
  const int sr = tid >> 4, sc = (tid & 15) * 8, vst0 = v_st(sr, sc), vst1 = v_st(32 + sr, sc);
  const int krr = tid >> 3, krc = (tid & 7) * 8;
  const int vb0 = (int)(uintptr_t)V_lds + v_rd_base(lane);
  struct { bf16x8 vs0, vs1, ks0, ks1, kr; } sr_[SDEPTH];
#define SLOAD(i, k0) do { sr_[i].vs0 = St::ld8(&Vh[(long)((k0) + sr) * LDV + sc]); sr_[i].vs1 = St::ld8(&Vh[(long)((k0) + 32 + sr) * LDV + sc]); \
    sr_[i].ks0 = St::ld8(&Kh[(long)((k0) + sr) * LDK + sc]); sr_[i].ks1 = St::ld8(&Kh[(long)((k0) + 32 + sr) * LDK + sc]); \
    sr_[i].kr = St::ld8(&KRh[(long)((k0) + krr) * LDKR + krc]); } while (0)
#define SWRITE(b, i) do { *(bf16x8*)((char*)V_lds + (b) * SHM_V + vst0) = sr_[i].vs0;          \
    *(bf16x8*)((char*)V_lds + (b) * SHM_V + vst1) = sr_[i].vs1; int kc = sc * 2;               \
    *(bf16x8*)((char*)K_lds + (b) * SHM_K + KSWZ(sr, kc)) = sr_[i].ks0;                       \
    *(bf16x8*)((char*)K_lds + (b) * SHM_K + KSWZ(32 + sr, kc)) = sr_[i].ks1;                  \
    *(bf16x8*)((char*)KR_lds + (b) * SHM_KR + KSWZ2(krr, krc * 2)) = sr_[i].kr; } while (0)
#define SWAIT() do { if constexpr (SDEPTH == 2) asm volatile("s_waitcnt vmcnt(5)" ::: "memory"); else asm volatile("s_waitcnt vmcnt(0)" ::: "memory"); } while (0)
#define RESC(a) do { if (__any((a) < 1.f)) { if (hi == 0) al_l[r32] = (a); asm volatile("s_waitcnt lgkmcnt(0)" ::: "memory"); \
    _Pragma("unroll") for (int d = 0; d < 4; ++d) _Pragma("unroll") for (int r = 0; r < 16; ++r) o[d][r] *= al_l[crow(r, hi)]; } } while (0)
  f32x16 pA0, pA1, pB0, pB1; float mnA, mnB, alA, alB; bf16x8 pa0, pa1, pa2, pa3; const int NT = seq / KVBLK;
  constexpr int SE = 0, SO = SDEPTH - 1;
  SLOAD(SE, 0); asm volatile("s_waitcnt vmcnt(0)" ::: "memory"); SWRITE(0, SE); __syncthreads();
  qkt(pA0, pA1, K_lds, KR_lds, qr, qrl, r32, hi); partialSM(pA0, pA1, m_reg, mnA, alA);
  SLOAD(SO, KVBLK); if constexpr (SDEPTH == 2) { if (2 < NT) SLOAD(SE, 2 * KVBLK); }
  SWAIT(); SWRITE(1, SO); __syncthreads();
  for (int j = 1; j + 1 < NT; j += 2) {
    SBAR(); qkt(pB0, pB1, (bf16*)((char*)K_lds + SHM_K), (bf16*)((char*)KR_lds + SHM_KR), qr, qrl, r32, hi);
    finishSM(pA0, pA1, alA, l_reg, pa0, pa1, pa2, pa3); SBAR();
    SLOAD(SO, (j + SDEPTH) * KVBLK); SBAR();
    pv_d0(o, vb0, pa0, pa1, pa2, pa3); partialSM(pB0, pB1, m_reg, mnB, alB);
    __syncthreads(); SWAIT(); SWRITE(0, SE);
    RESC(alB); __syncthreads();
    SBAR(); qkt(pA0, pA1, K_lds, KR_lds, qr, qrl, r32, hi);
    finishSM(pB0, pB1, alB, l_reg, pa0, pa1, pa2, pa3); SBAR();
    if (SDEPTH == 1 || j + 3 < NT) SLOAD(SE, (j + 1 + SDEPTH) * KVBLK); SBAR();
    pv_d0(o, vb0 + (int)SHM_V, pa0, pa1, pa2, pa3); partialSM(pA0, pA1, m_reg, mnA, alA);
    __syncthreads(); SWAIT(); SWRITE(1, SO);
    RESC(alA); __syncthreads();
  }
  SBAR(); qkt(pB0, pB1, (bf16*)((char*)K_lds + SHM_K), (bf16*)((char*)KR_lds + SHM_KR), qr, qrl, r32, hi);
  finishSM(pA0, pA1, alA, l_reg, pa0, pa1, pa2, pa3); SBAR();
  pv_d0(o, vb0, pa0, pa1, pa2, pa3); partialSM(pB0, pB1, m_reg, mnB, alB);
  __syncthreads(); RESC(alB);
  finishSM(pB0, pB1, alB, l_reg, pa0, pa1, pa2, pa3); SBAR();
  pv_d0(o, vb0 + (int)SHM_V, pa0, pa1, pa2, pa3);
  if (hi == 0) li_l[r32] = l_reg; asm volatile("s_waitcnt lgkmcnt(0)" ::: "memory");
  float rli[16];
#pragma unroll
  for (int r = 0; r < 16; ++r) rli[r] = __builtin_amdgcn_rcpf(li_l[crow(r, hi)]);
  bf16* Ow = Ob + (long)(wid * QBLK) * LDO;
#pragma unroll
  for (int r = 0; r < 16; ++r) { int orow = crow(r, hi);
#pragma unroll
    for (int d0 = 0; d0 < 4; ++d0) Ow[(long)orow * LDO + d0 * 32 + r32] = __float2bfloat16(o[d0][r] * rli[r]); }
  __syncthreads();
#undef SLOAD
#undef SWRITE
#undef SWAIT
#undef RESC
}
#undef SBAR
}
constexpr int BATCH = 4, SEQ = 8192, DM = 1024, DEPTH = 4, DFF = 2816, MT = BATCH * SEQ;
constexpr int NH = 8, QLR = 256, KVLR = 128, QKD = 192;
constexpr float EPS = 1e-6f;
constexpr size_t MiB = 1u << 20;
constexpr size_t WS_WFFI = 1 * MiB;
constexpr size_t WS_WFFO = 89 * MiB;
constexpr size_t WS_WHIN = 133 * MiB;
constexpr size_t WS_WHO  = 153 * MiB;
constexpr size_t WS_WMIN = 157 * MiB;
constexpr size_t WS_WUQ  = 159 * MiB;
constexpr size_t WS_WUKV = 161 * MiB;
constexpr size_t WS_WMO  = 162 * MiB;
constexpr size_t WS_COS  = 166 * MiB;
constexpr size_t WS_SIN  = 170 * MiB;
constexpr size_t WS_LB   = 174 * MiB;
constexpr size_t WS_HN   = 176 * MiB;
constexpr size_t WS_Y    = 240 * MiB;
constexpr size_t WS_R    = 368 * MiB;
constexpr size_t WS_END  = 704 * MiB;
constexpr size_t R_ACT = 0;
constexpr size_t R_C = 0, R_QB = 0, R_CQ = 96 * MiB, R_CKV = 112 * MiB, R_KR = 120 * MiB, R_KN = 124 * MiB, R_VB = 188 * MiB, R_O = 252 * MiB;
constexpr size_t R_QH = 0, R_VH = 64 * MiB, R_GH = 128 * MiB, R_KF = 192 * MiB, R_HO = 0;

constexpr int LDS_RING = 131072, LDS_BYTES = LDS_RING + 2048;
typedef unsigned short bf16_t;
typedef float f32x4 __attribute__((ext_vector_type(4)));
typedef float f32x2 __attribute__((ext_vector_type(2)));
typedef unsigned u32x4 __attribute__((ext_vector_type(4)));
typedef unsigned u32x2 __attribute__((ext_vector_type(2)));
typedef _Float16 h16x2 __attribute__((ext_vector_type(2)));
#define LAS __attribute__((address_space(3)))

__device__ __constant__ double ROPE_INVF[32] = {1.0, 0.7498942093324559, 0.5623413251903491, 0.4216965034285822, 0.31622776601683794, 0.23713737056616552, 0.1778279410038923, 0.1333521432163324, 0.1, 0.07498942093324558, 0.05623413251903491, 0.042169650342858224, 0.03162277660168379, 0.023713737056616554, 0.01778279410038923, 0.01333521432163324, 0.01, 0.007498942093324558, 0.005623413251903491, 0.004216965034285823, 0.0031622776601683794, 0.0023713737056616554, 0.0017782794100389228, 0.001333521432163324, 0.001, 0.0007498942093324559, 0.0005623413251903491, 0.00042169650342858224, 0.00031622776601683794, 0.00023713737056616554, 0.00017782794100389227, 0.0001333521432163324};

__device__ __forceinline__ unsigned pk2(float lo, float hi) { return pg8::cvt_pk_bf16(lo, hi); }
__device__ __forceinline__ float silu_f(float g) { return g * __builtin_amdgcn_rcpf(1.0f + __expf(-g)); }
__device__ __forceinline__ float wave_sum(float v) {
#pragma unroll
    for (int o = 1; o < 64; o <<= 1) v += __shfl_xor(v, o);
    return v;
}
__device__ __forceinline__ float half_sum(float v) {
#pragma unroll
    for (int o = 1; o < 32; o <<= 1) v += __shfl_xor(v, o);
    return v;
}

using pg8::Unit;
struct EpiSwiglu { static constexpr bool PERM = true, AFTER_DRAIN = false; bf16_t* O;
    __device__ __forceinline__ void operator()(const pg8::f32x4 (&acc)[2][2][4][2], const Unit& u, int wr, int wc, int fr, int fq) const {
        const int row0 = u.pm * 256 + wr * 64 + fr, col0 = u.pn * 128 + wc * 32 + 8 * fq;
#pragma unroll
        for (int ai = 0; ai < 2; ++ai)
#pragma unroll
            for (int m = 0; m < 4; ++m) { bf16_t* p = O + (size_t)(row0 + ai * 128 + m * 16) * DFF + col0;
                const pg8::f32x4 g0 = acc[ai][0][m][0], g1 = acc[ai][0][m][1], u0 = acc[ai][1][m][0], u1 = acc[ai][1][m][1];
                u32x4 w; w.x = pk2(silu_f(g0[0]) * u0[0], silu_f(g0[1]) * u0[1]); w.y = pk2(silu_f(g0[2]) * u0[2], silu_f(g0[3]) * u0[3]);
                w.z = pk2(silu_f(g1[0]) * u1[0], silu_f(g1[1]) * u1[1]); w.w = pk2(silu_f(g1[2]) * u1[2], silu_f(g1[3]) * u1[3]);
                *(u32x4*)p = w; }
    }
};
struct EpiF32 { static constexpr bool PERM = false, AFTER_DRAIN = false; float* O; int ldc;
    __device__ __forceinline__ void operator()(const pg8::f32x4 (&acc)[2][2][4][2], const Unit& u, int wr, int wc, int fr, int fq) const {
        const int row0 = u.pm * 256 + wr * 64 + fr, col0 = u.pn * 256 + wc * 32 + 4 * fq;
#pragma unroll
        for (int ai = 0; ai < 2; ++ai)
#pragma unroll
            for (int m = 0; m < 4; ++m) { float* p = O + (size_t)(row0 + ai * 128 + m * 16) * ldc + col0;
#pragma unroll
                for (int bj = 0; bj < 2; ++bj)
#pragma unroll
                    for (int n = 0; n < 2; ++n) *(pg8::f32x4*)(p + bj * 128 + n * 16) = acc[ai][bj][m][n]; }
    }
};
struct EpiQ { static constexpr bool PERM = true, AFTER_DRAIN = false; bf16_t* O; const float* cs; const float* sn;
    __device__ __forceinline__ void operator()(const pg8::f32x4 (&acc)[2][2][4][2], const Unit& u, int wr, int wc, int fr, int fq) const {
        const int row0 = u.pm * 256 + wr * 64 + fr;
#pragma unroll
        for (int bj = 0; bj < 2; ++bj) { const int col0 = u.pn * 256 + bj * 128 + wc * 32 + 8 * fq, d = col0 % QKD; const bool rot = d >= 128; const int i0 = (d - 128) >> 1;
#pragma unroll
            for (int ai = 0; ai < 2; ++ai)
#pragma unroll
                for (int m = 0; m < 4; ++m) { const int row = row0 + ai * 128 + m * 16; pg8::f32x4 v0 = acc[ai][bj][m][0], v1 = acc[ai][bj][m][1];
                    if (rot) { const pg8::f32x4 c = *(const pg8::f32x4*)(cs + (size_t)row * 32 + i0), s = *(const pg8::f32x4*)(sn + (size_t)row * 32 + i0);
                        pg8::f32x4 a, b; a[0] = v0[0] * c[0] - v0[1] * s[0]; a[1] = v0[0] * s[0] + v0[1] * c[0]; a[2] = v0[2] * c[1] - v0[3] * s[1]; a[3] = v0[2] * s[1] + v0[3] * c[1];
                        b[0] = v1[0] * c[2] - v1[1] * s[2]; b[1] = v1[0] * s[2] + v1[1] * c[2]; b[2] = v1[2] * c[3] - v1[3] * s[3]; b[3] = v1[2] * s[3] + v1[3] * c[3]; v0 = a; v1 = b; }
                    u32x4 w; w.x = pk2(v0[0], v0[1]); w.y = pk2(v0[2], v0[3]); w.z = pk2(v1[0], v1[1]); w.w = pk2(v1[2], v1[3]);
                    *(u32x4*)(O + (size_t)row * 1536 + col0) = w; } }
    }
};
struct EpiKV { static constexpr bool PERM = true, AFTER_DRAIN = false; bf16_t* Kn; bf16_t* Vb;
    __device__ __forceinline__ void operator()(const pg8::f32x4 (&acc)[2][2][4][2], const Unit& u, int wr, int wc, int fr, int fq) const {
        const int row0 = u.pm * 256 + wr * 64 + fr, col0 = u.pn * 128 + wc * 32 + 8 * fq;
#pragma unroll
        for (int bj = 0; bj < 2; ++bj) { bf16_t* base = bj ? Vb : Kn;
#pragma unroll
            for (int ai = 0; ai < 2; ++ai)
#pragma unroll
                for (int m = 0; m < 4; ++m) { const pg8::f32x4 v0 = acc[ai][bj][m][0], v1 = acc[ai][bj][m][1];
                    u32x4 w; w.x = pk2(v0[0], v0[1]); w.y = pk2(v0[2], v0[3]); w.z = pk2(v1[0], v1[1]); w.w = pk2(v1[2], v1[3]);
                    *(u32x4*)(base + (size_t)(row0 + ai * 128 + m * 16) * 1024 + col0) = w; } }
    }
};
__device__ __forceinline__ unsigned pkh2(float a, float b) { const h16x2 h = {(_Float16)a, (_Float16)b}; return __builtin_bit_cast(unsigned, h); }
__device__ __forceinline__ float kgate(float om, float z) { return om * __builtin_amdgcn_rcpf(1.0f + __expf(z)); }
struct EpiHgrn { static constexpr bool PERM = true, AFTER_DRAIN = false; bf16_t* Qh; bf16_t* Vh; bf16_t* Gh; unsigned short* KF; const float* lb;
    __device__ __forceinline__ void operator()(const pg8::f32x4 (&acc)[2][2][4][2], const Unit& u, int wr, int wc, int fr, int fq) const {
        const int row0 = u.pm * 256 + wr * 64 + fr, seg = u.pn >> 2;
#pragma unroll
        for (int bj = 0; bj < 2; ++bj) { const int cc = (u.pn & 3) * 256 + bj * 128 + wc * 32 + 8 * fq;
            if (seg == 1 || seg == 2) {
                const pg8::f32x4 om0 = 1.0f - *(const pg8::f32x4*)(lb + (seg - 1) * 1024 + cc), om1 = 1.0f - *(const pg8::f32x4*)(lb + (seg - 1) * 1024 + cc + 4);
                unsigned short* base = KF + (size_t)(seg - 1) * MT * 1024;
#pragma unroll
                for (int ai = 0; ai < 2; ++ai)
#pragma unroll
                    for (int m = 0; m < 4; ++m) { const size_t off = (size_t)(row0 + ai * 128 + m * 16) * 1024 + cc; const pg8::f32x4 v0 = acc[ai][bj][m][0], v1 = acc[ai][bj][m][1];
                        u32x4 w; w.x = pkh2(kgate(om0[0], v0[0]), kgate(om0[1], v0[1])); w.y = pkh2(kgate(om0[2], v0[2]), kgate(om0[3], v0[3]));
                        w.z = pkh2(kgate(om1[0], v1[0]), kgate(om1[1], v1[1])); w.w = pkh2(kgate(om1[2], v1[2]), kgate(om1[3], v1[3]));
                        *(u32x4*)(base + off) = w; }
            } else if (seg == 3) {
#pragma unroll
                for (int ai = 0; ai < 2; ++ai)
#pragma unroll
                    for (int m = 0; m < 4; ++m) { const size_t off = (size_t)(row0 + ai * 128 + m * 16) * 1024 + cc; const pg8::f32x4 v0 = acc[ai][bj][m][0], v1 = acc[ai][bj][m][1];
                        u32x4 w; w.x = pk2(v0[0], v0[1]); w.y = pk2(v0[2], v0[3]); w.z = pk2(v1[0], v1[1]); w.w = pk2(v1[2], v1[3]);
                        *(u32x4*)(Vh + off) = w; }
            } else { bf16_t* base = seg == 0 ? Qh : Gh;
#pragma unroll
                for (int ai = 0; ai < 2; ++ai)
#pragma unroll
                    for (int m = 0; m < 4; ++m) { const size_t off = (size_t)(row0 + ai * 128 + m * 16) * 1024 + cc; const pg8::f32x4 v0 = acc[ai][bj][m][0], v1 = acc[ai][bj][m][1];
                        u32x4 w; w.x = pk2(silu_f(v0[0]), silu_f(v0[1])); w.y = pk2(silu_f(v0[2]), silu_f(v0[3])); w.z = pk2(silu_f(v1[0]), silu_f(v1[1])); w.w = pk2(silu_f(v1[2]), silu_f(v1[3]));
                        *(u32x4*)(base + off) = w; } } }
    }
};

__device__ __forceinline__ int src_col(int mode, int n) {
    if (mode == 1) { const int t = n >> 8, j = n & 255; return j < 128 ? t * 128 + j : DFF + t * 128 + (j - 128); }
    if (mode == 2) { if (n < 384) return n; if (n >= 448) return -1; const int j = n - 384; return 384 + (j >> 1) + 32 * (j & 1); }
    if (mode == 3) { const int h = n / QKD, d = n % QKD; if (d < 128) return n; const int j = d - 128; return h * QKD + 128 + (j >> 1) + 32 * (j & 1); }
    return n;
}
__device__ __forceinline__ void xpose_item(const float* __restrict__ W, int K, int Nsrc, int Ndst, int mode, bf16_t* __restrict__ WT, LAS float* scr, int item, int lane) {
    const int nblk = Ndst / 32, kb = item / nblk, nb = item % nblk, k0 = 64 * kb, n0 = 32 * nb;
    const int sc = src_col(mode, n0 + (lane & 31));
#pragma unroll 8
    for (int i = 0; i < 32; ++i) { const int kk = 2 * i + (lane >> 5); scr[kk * 33 + (lane & 31)] = sc >= 0 ? W[(size_t)(k0 + kk) * Nsrc + sc] : 0.f; }
    asm volatile("s_waitcnt lgkmcnt(0)" ::: "memory");
    const int c = lane & 7;
#pragma unroll
    for (int j = 0; j < 4; ++j) { const int n = (lane >> 3) + 8 * j; const LAS float* s = scr + (8 * c) * 33 + n;
        u32x4 o; o.x = pk2(s[0 * 33], s[1 * 33]); o.y = pk2(s[2 * 33], s[3 * 33]); o.z = pk2(s[4 * 33], s[5 * 33]); o.w = pk2(s[6 * 33], s[7 * 33]);
        *(u32x4*)(WT + (size_t)(n0 + n) * K + k0 + 8 * c) = o; }
    asm volatile("s_waitcnt lgkmcnt(0)" ::: "memory");
}

__device__ __forceinline__ void row_init(const float* __restrict__ xin, float* __restrict__ X, bf16_t* __restrict__ HN, const float* __restrict__ g, int lane) {
    const f32x4* xr = (const f32x4*)xin + lane; f32x4 v[4]; float s = 0.f;
#pragma unroll
    for (int j = 0; j < 4; ++j) { v[j] = xr[64 * j]; s += (v[j][0] * v[j][0] + v[j][1] * v[j][1]) + (v[j][2] * v[j][2] + v[j][3] * v[j][3]); }
    const float r = rsqrtf(wave_sum(s) * (1.f / DM) + EPS);
#pragma unroll
    for (int j = 0; j < 4; ++j) { ((f32x4*)X + lane)[64 * j] = v[j]; const f32x4 gg = ((const f32x4*)g + lane)[64 * j];
        u32x2 w; w.x = pk2(v[j][0] * r * gg[0], v[j][1] * r * gg[1]); w.y = pk2(v[j][2] * r * gg[2], v[j][3] * r * gg[3]); ((u32x2*)HN + lane)[64 * j] = w; }
}
__device__ __forceinline__ void row_post(const float* __restrict__ Y, float* __restrict__ X, bf16_t* __restrict__ HN, float scale, const float* __restrict__ gp, const float* __restrict__ gn, int lane) {
    f32x4 y[4], x[4]; float s = 0.f;
#pragma unroll
    for (int j = 0; j < 4; ++j) { y[j] = ((const f32x4*)Y + lane)[64 * j]; x[j] = ((const f32x4*)X + lane)[64 * j]; s += (y[j][0] * y[j][0] + y[j][1] * y[j][1]) + (y[j][2] * y[j][2] + y[j][3] * y[j][3]); }
    const float r = rsqrtf(wave_sum(s) * (1.f / DM) + EPS) * scale; float s2 = 0.f;
#pragma unroll
    for (int j = 0; j < 4; ++j) { const f32x4 gg = ((const f32x4*)gp + lane)[64 * j]; x[j] = x[j] + y[j] * r * gg; ((f32x4*)X + lane)[64 * j] = x[j];
        s2 += (x[j][0] * x[j][0] + x[j][1] * x[j][1]) + (x[j][2] * x[j][2] + x[j][3] * x[j][3]); }
    if (HN) { const float r2 = rsqrtf(wave_sum(s2) * (1.f / DM) + EPS);
#pragma unroll
        for (int j = 0; j < 4; ++j) { const f32x4 gg = ((const f32x4*)gn + lane)[64 * j];
            u32x2 w; w.x = pk2(x[j][0] * r2 * gg[0], x[j][1] * r2 * gg[1]); w.y = pk2(x[j][2] * r2 * gg[2], x[j][3] * r2 * gg[3]); ((u32x2*)HN + lane)[64 * j] = w; } }
}
__device__ __forceinline__ void row_mla(const float* __restrict__ C, bf16_t* __restrict__ CQ, bf16_t* __restrict__ CKV, bf16_t* __restrict__ KR, const float* __restrict__ qn, const float* __restrict__ kvn,
                                        const float* __restrict__ cs, const float* __restrict__ sn, int lane) {
    const f32x4 a = ((const f32x4*)C)[2 * lane], b = ((const f32x4*)C)[2 * lane + 1];
    float s = (a[0] * a[0] + a[1] * a[1]) + (a[2] * a[2] + a[3] * a[3]) + (b[0] * b[0] + b[1] * b[1]) + (b[2] * b[2] + b[3] * b[3]);
#pragma unroll
    for (int o = 1; o < 16; o <<= 1) s += __shfl_xor(s, o);
    const float s16 = s, s32 = s16 + __shfl_xor(s16, 16);
    float v[8] = {a[0], a[1], a[2], a[3], b[0], b[1], b[2], b[3]};
    if (lane < 32) { const float r = rsqrtf(s32 * (1.f / QLR) + EPS); const f32x4 g0 = ((const f32x4*)qn)[2 * lane], g1 = ((const f32x4*)qn)[2 * lane + 1];
        u32x4 w; w.x = pk2(v[0] * r * g0[0], v[1] * r * g0[1]); w.y = pk2(v[2] * r * g0[2], v[3] * r * g0[3]); w.z = pk2(v[4] * r * g1[0], v[5] * r * g1[1]); w.w = pk2(v[6] * r * g1[2], v[7] * r * g1[3]);
        ((u32x4*)CQ)[lane] = w;
    } else if (lane < 48) { const int l = lane - 32; const float r = rsqrtf(s16 * (1.f / KVLR) + EPS); const f32x4 g0 = ((const f32x4*)kvn)[2 * l], g1 = ((const f32x4*)kvn)[2 * l + 1];
        u32x4 w; w.x = pk2(v[0] * r * g0[0], v[1] * r * g0[1]); w.y = pk2(v[2] * r * g0[2], v[3] * r * g0[3]); w.z = pk2(v[4] * r * g1[0], v[5] * r * g1[1]); w.w = pk2(v[6] * r * g1[2], v[7] * r * g1[3]);
        ((u32x4*)CKV)[l] = w;
    } else if (lane < 56) { const int l = lane - 48; const f32x4 c = ((const f32x4*)cs)[l], sv = ((const f32x4*)sn)[l];
        u32x4 w; w.x = pk2(v[0] * c[0] - v[1] * sv[0], v[0] * sv[0] + v[1] * c[0]); w.y = pk2(v[2] * c[1] - v[3] * sv[1], v[2] * sv[1] + v[3] * c[1]);
        w.z = pk2(v[4] * c[2] - v[5] * sv[2], v[4] * sv[2] + v[5] * c[2]); w.w = pk2(v[6] * c[3] - v[7] * sv[3], v[6] * sv[3] + v[7] * c[3]);
        ((u32x4*)KR)[l] = w; }
}
__device__ __forceinline__ void row_hgrn(const bf16_t* __restrict__ Oa, const bf16_t* __restrict__ Gh, bf16_t* __restrict__ HO, const float* __restrict__ on, int lane) {
#pragma unroll
    for (int j = 0; j < 4; ++j) { const u32x2 a = ((const u32x2*)Oa + lane)[64 * j], b = ((const u32x2*)(Oa + (size_t)MT * 1024) + lane)[64 * j];
        f32x4 o; o[0] = __uint_as_float(a.x << 16) + __uint_as_float(b.x << 16); o[1] = __uint_as_float(a.x & 0xffff0000u) + __uint_as_float(b.x & 0xffff0000u);
        o[2] = __uint_as_float(a.y << 16) + __uint_as_float(b.y << 16); o[3] = __uint_as_float(a.y & 0xffff0000u) + __uint_as_float(b.y & 0xffff0000u);
        const float s = half_sum((o[0] * o[0] + o[1] * o[1]) + (o[2] * o[2] + o[3] * o[3]));
        const float r = rsqrtf(s * (1.f / 128.f) + EPS); const f32x4 gg = ((const f32x4*)on + lane)[64 * j]; const u32x2 gb = ((const u32x2*)Gh + lane)[64 * j];
        const float g0 = __uint_as_float(gb.x << 16), g1 = __uint_as_float(gb.x & 0xffff0000u), g2 = __uint_as_float(gb.y << 16), g3 = __uint_as_float(gb.y & 0xffff0000u);
        u32x2 w; w.x = pk2(o[0] * r * gg[0] * g0, o[1] * r * gg[1] * g1); w.y = pk2(o[2] * r * gg[2] * g2, o[3] * r * gg[3] * g3); ((u32x2*)HO + lane)[64 * j] = w; }
}
__device__ __forceinline__ f32x2 h2f2_(unsigned u) { const h16x2 h = __builtin_bit_cast(h16x2, u); return (f32x2){(float)h[0], (float)h[1]}; }
__device__ __forceinline__ void scan_phase(LAS unsigned char* lds, const bf16_t* __restrict__ Qh, const bf16_t* __restrict__ Vh, const unsigned short* __restrict__ KF, bf16_t* __restrict__ OP, int G, int bx) {
    int tid = threadIdx.x; asm volatile("" : "+v"(tid)); const int wid = __builtin_amdgcn_readfirstlane(tid >> 6), lane = tid & 63;
    const int st = tid >> 4, sc8 = (tid & 15) * 8, sv = tid >> 3, vc4 = (tid & 7) * 4;
    constexpr int OFF_K = 16384, OFF_Q = 32768, OFF_V = 49152, OFF_P = 53248;
    for (int item = bx; item < 256; item += G) {
        const int dir = item & 1, dvq = (item >> 1) & 3, h = (item >> 3) & 7, b = item >> 6;
        const size_t kcol = h * 128 + sc8, vcol = h * 128 + dvq * 32 + vc4;
        const unsigned short* KFd = KF + (size_t)dir * MT * 1024; bf16_t* OPd = OP + (size_t)dir * MT * 1024;
        u32x4 rk, rq; u32x2 rv = {0u, 0u};
#define SC_GLOAD(blk) do { { const int tt = (blk) * 32 + st; const size_t m = (size_t)b * SEQ + (dir ? SEQ - 1 - tt : tt); \
        rk = *(const u32x4*)(KFd + m * 1024 + kcol); rq = *(const u32x4*)(Qh + m * 1024 + kcol); } \
        if (tid < 256) { const int tt = (blk) * 32 + sv; const size_t m = (size_t)b * SEQ + (dir ? SEQ - 1 - tt : tt); rv = *(const u32x2*)(Vh + m * 1024 + vcol); } } while (0)
#define SC_H2F(u_) h2f2_(u_)
#define SC_LWRITE() do { LAS unsigned char* B_ = lds + (st * 128 + sc8) * 4; \
        const f32x2 ka = SC_H2F(rk.x), kb = SC_H2F(rk.y), kc = SC_H2F(rk.z), kd = SC_H2F(rk.w); \
        const f32x4 k0_ = {ka[0], ka[1], kb[0], kb[1]}, k1_ = {kc[0], kc[1], kd[0], kd[1]}; \
        *(LAS f32x4*)(B_ + OFF_K) = k0_; *(LAS f32x4*)(B_ + OFF_K + 16) = k1_; \
        *(LAS f32x4*)(B_ + OFF_Q) = (f32x4){__uint_as_float(rq.x << 16), __uint_as_float(rq.x & 0xffff0000u), __uint_as_float(rq.y << 16), __uint_as_float(rq.y & 0xffff0000u)}; \
        *(LAS f32x4*)(B_ + OFF_Q + 16) = (f32x4){__uint_as_float(rq.z << 16), __uint_as_float(rq.z & 0xffff0000u), __uint_as_float(rq.w << 16), __uint_as_float(rq.w & 0xffff0000u)}; \
        if (tid < 256) *(LAS f32x4*)(lds + OFF_V + (sv * 32 + vc4) * 4) = (f32x4){__uint_as_float(rv.x << 16), __uint_as_float(rv.x & 0xffff0000u), __uint_as_float(rv.y << 16), __uint_as_float(rv.y & 0xffff0000u)}; } while (0)
        SC_GLOAD(0);
        const int dksub = ((lane >> 3) & 1) | ((lane >> 5) << 1), dvp = (lane & 7) | (((lane >> 4) & 1) << 3);
        const LAS unsigned char* Bc = lds + (16 * wid + 4 * dksub) * 4;
        const LAS unsigned char* Vc = lds + OFF_V + dvp * 8;
        LAS unsigned char* Pw = lds + OFF_P + (wid * 4 + dksub) * 2048 + dvp * 4;
        f32x2 S2[4];
#pragma unroll
        for (int j = 0; j < 4; ++j) S2[j] = (f32x2){0.f, 0.f};
        for (int blk = 0; blk < SEQ / 32; ++blk) {
            SC_LWRITE();
            if (blk + 1 < SEQ / 32) SC_GLOAD(blk + 1);
            __syncthreads();
            f32x4 k4n = *(const LAS f32x4*)(Bc + OFF_K), q4n = *(const LAS f32x4*)(Bc + OFF_Q); f32x2 v2n = *(const LAS f32x2*)(Vc);
            f32x4 k4m = *(const LAS f32x4*)(Bc + OFF_K + 512), q4m = *(const LAS f32x4*)(Bc + OFF_Q + 512); f32x2 v2m = *(const LAS f32x2*)(Vc + 128);
#pragma unroll
            for (int t = 0; t < 32; ++t) {
                const f32x4 k4 = k4n, q4 = q4n; const f32x2 v2 = v2n;
                k4n = k4m; q4n = q4m; v2n = v2m;
                { const int tn = (t + 2) & 31;
                  k4m = *(const LAS f32x4*)(Bc + OFF_K + tn * 512); q4m = *(const LAS f32x4*)(Bc + OFF_Q + tn * 512); v2m = *(const LAS f32x2*)(Vc + tn * 128); }
                __builtin_amdgcn_sched_barrier(0);
#pragma unroll
                for (int j = 0; j < 4; ++j) S2[j] = S2[j] + (v2 - S2[j]) * k4[j];
                const f32x2 o2 = (S2[0] * q4[0] + S2[1] * q4[1]) + (S2[2] * q4[2] + S2[3] * q4[3]);
                *(LAS unsigned*)(Pw + t * 64) = pk2(o2[0], o2[1]);
            }
            __syncthreads();
            if (tid < 256) { const LAS unsigned char* Pr = lds + OFF_P + (sv * 32 + vc4) * 2; f32x4 acc = {0.f, 0.f, 0.f, 0.f};
#pragma unroll
              for (int g = 0; g < 32; ++g) { const u32x2 pv = *(const LAS u32x2*)(Pr + g * 2048);
                  acc[0] += __uint_as_float(pv.x << 16); acc[1] += __uint_as_float(pv.x & 0xffff0000u); acc[2] += __uint_as_float(pv.y << 16); acc[3] += __uint_as_float(pv.y & 0xffff0000u); }
              const int tt = blk * 32 + sv; const size_t m = (size_t)b * SEQ + (dir ? SEQ - 1 - tt : tt);
              u32x2 w; w.x = pk2(acc[0], acc[1]); w.y = pk2(acc[2], acc[3]); *(u32x2*)(OPd + m * 1024 + vcol) = w; }
        }
        __syncthreads();
#undef SC_GLOAD
#undef SC_LWRITE
#undef SC_H2F
    }
}

typedef float f32x16 __attribute__((ext_vector_type(16)));
typedef short s16x8 __attribute__((ext_vector_type(8)));
__device__ __forceinline__ int crow_(int r, int hi) { return (r & 3) + 8 * (r >> 2) + 4 * hi; }
template <int KSTEPS>
__device__ __forceinline__ void mm_tile(f32x16& c, const LAS unsigned char* X, int xstride, const LAS unsigned char* Y, int ystride, int r32, int hi) {
#pragma unroll
    for (int i = 0; i < KSTEPS; ++i) { const s16x8 x = *(const LAS s16x8*)(X + r32 * xstride + (16 * i + 8 * hi) * 2), y = *(const LAS s16x8*)(Y + r32 * ystride + (16 * i + 8 * hi) * 2);
        c = __builtin_amdgcn_mfma_f32_32x32x16_bf16(x, y, c, 0, 0, 0); }
}
__device__ __forceinline__ void scan_phase_mfma(LAS unsigned char* lds, const bf16_t* __restrict__ Qh, const bf16_t* __restrict__ Vh, const unsigned short* __restrict__ KF, bf16_t* __restrict__ OP, int G, int bx) {
    int tid = threadIdx.x; asm volatile("" : "+v"(tid)); const int wid = __builtin_amdgcn_readfirstlane(tid >> 6), lane = tid & 63, r32 = lane & 31, hi = lane >> 5;
    const int st = tid >> 4, sc8 = (tid & 15) * 8, sv = tid >> 3, vc4 = (tid & 7) * 4;
    constexpr int SQ = 272, SV = 80;
    constexpr int O_LG = 0, O_QT = 16384, O_KT = O_QT + 32 * SQ, O_KTT = O_KT + 32 * SQ, O_VT = O_KTT + 128 * SV, O_AT = O_VT + 2 * 32 * SV, O_ST = O_AT + 32 * SV, O_G = O_ST + 32 * SQ;
    static_assert(O_G + 512 <= LDS_RING, "scan LDS map");
    for (int item = bx; item < 256; item += G) {
        const int dir = item & 1, dvq = (item >> 1) & 3, h = (item >> 3) & 7, b = item >> 6;
        const size_t kcol = h * 128 + sc8, vcol = h * 128 + dvq * 32 + vc4;
        const unsigned short* KFd = KF + (size_t)dir * MT * 1024; bf16_t* OPd = OP + (size_t)dir * MT * 1024;
        u32x4 rk, rq, nk, nq; u32x2 rv = {0u, 0u}, nv = {0u, 0u};
#define SM_GLOAD(K_, Q_, V_, blk) do { { const int tt = (blk) * 32 + st; const size_t m = (size_t)b * SEQ + (dir ? SEQ - 1 - tt : tt); \
        K_ = *(const u32x4*)(KFd + m * 1024 + kcol); Q_ = *(const u32x4*)(Qh + m * 1024 + kcol); } \
        if (tid < 256) { const int tt = (blk) * 32 + sv; const size_t m = (size_t)b * SEQ + (dir ? SEQ - 1 - tt : tt); V_ = *(const u32x2*)(Vh + m * 1024 + vcol); } } while (0)
        SM_GLOAD(rk, rq, rv, 0);
        f32x16 accS;
#pragma unroll
        for (int r = 0; r < 16; ++r) accS[r] = 0.f;
        for (int i = tid; i < 32 * SQ / 4; i += 512) ((LAS unsigned*)(lds + O_ST))[i] = 0u;
        for (int blk = 0; blk < SEQ / 32; ++blk) {
            const LAS unsigned char* VTc = lds + O_VT + (blk & 1) * 32 * SV;
            f32x4 k0, k1;
            { const f32x2 ka = h2f2_(rk.x), kb = h2f2_(rk.y), kc = h2f2_(rk.z), kd = h2f2_(rk.w); k0 = (f32x4){ka[0], ka[1], kb[0], kb[1]}; k1 = (f32x4){kc[0], kc[1], kd[0], kd[1]}; }
            { f32x4 a0, a1;
#pragma unroll
              for (int e = 0; e < 4; ++e) { a0[e] = __builtin_amdgcn_logf(1.0f - k0[e]); a1[e] = __builtin_amdgcn_logf(1.0f - k1[e]); }
              LAS unsigned char* L_ = lds + O_LG + (st * 128 + sc8) * 4; *(LAS f32x4*)(L_) = a0; *(LAS f32x4*)(L_ + 16) = a1; }
            if (tid < 256) { LAS unsigned char* V_ = lds + O_VT + (blk & 1) * 32 * SV + sv * 2;
                *(LAS unsigned short*)(V_ + (vc4 + 0) * SV) = (unsigned short)(rv.x & 0xffffu); *(LAS unsigned short*)(V_ + (vc4 + 1) * SV) = (unsigned short)(rv.x >> 16);
                *(LAS unsigned short*)(V_ + (vc4 + 2) * SV) = (unsigned short)(rv.y & 0xffffu); *(LAS unsigned short*)(V_ + (vc4 + 3) * SV) = (unsigned short)(rv.y >> 16); }
            if (blk + 1 < SEQ / 32) SM_GLOAD(nk, nq, nv, blk + 1);
            __syncthreads();
            if (tid < 128) { LAS float* col = (LAS float*)(lds + O_LG) + tid; float acc = 0.f;
#pragma unroll
                for (int t = 0; t < 32; ++t) { acc += col[t * 128]; col[t * 128] = acc; } }
            __syncthreads();
            { const LAS unsigned char* L_ = lds + O_LG + (st * 128 + sc8) * 4; const f32x4 b0 = *(const LAS f32x4*)(L_), b1 = *(const LAS f32x4*)(L_ + 16);
              float qv[8] = {__uint_as_float(rq.x << 16), __uint_as_float(rq.x & 0xffff0000u), __uint_as_float(rq.y << 16), __uint_as_float(rq.y & 0xffff0000u),
                             __uint_as_float(rq.z << 16), __uint_as_float(rq.z & 0xffff0000u), __uint_as_float(rq.w << 16), __uint_as_float(rq.w & 0xffff0000u)};
              float qs[8], ks[8];
#pragma unroll
              for (int e = 0; e < 4; ++e) { const float e0 = __builtin_amdgcn_exp2f(b0[e]), e1 = __builtin_amdgcn_exp2f(b1[e]);
                  qs[e] = qv[e] * e0; qs[4 + e] = qv[4 + e] * e1; ks[e] = k0[e] * __builtin_amdgcn_exp2f(-b0[e]); ks[4 + e] = k1[e] * __builtin_amdgcn_exp2f(-b1[e]);
                  if (st == 31) { ((LAS float*)(lds + O_G))[sc8 + e] = e0; ((LAS float*)(lds + O_G))[sc8 + 4 + e] = e1; } }
              u32x4 qw, kw; qw.x = pk2(qs[0], qs[1]); qw.y = pk2(qs[2], qs[3]); qw.z = pk2(qs[4], qs[5]); qw.w = pk2(qs[6], qs[7]);
              kw.x = pk2(ks[0], ks[1]); kw.y = pk2(ks[2], ks[3]); kw.z = pk2(ks[4], ks[5]); kw.w = pk2(ks[6], ks[7]);
              *(LAS u32x4*)(lds + O_QT + st * SQ + sc8 * 2) = qw; *(LAS u32x4*)(lds + O_KT + st * SQ + sc8 * 2) = kw;
              LAS unsigned char* T_ = lds + O_KTT + sc8 * SV + st * 2;
              *(LAS unsigned short*)(T_ + 0 * SV) = (unsigned short)(kw.x & 0xffffu); *(LAS unsigned short*)(T_ + 1 * SV) = (unsigned short)(kw.x >> 16);
              *(LAS unsigned short*)(T_ + 2 * SV) = (unsigned short)(kw.y & 0xffffu); *(LAS unsigned short*)(T_ + 3 * SV) = (unsigned short)(kw.y >> 16);
              *(LAS unsigned short*)(T_ + 4 * SV) = (unsigned short)(kw.z & 0xffffu); *(LAS unsigned short*)(T_ + 5 * SV) = (unsigned short)(kw.z >> 16);
              *(LAS unsigned short*)(T_ + 6 * SV) = (unsigned short)(kw.w & 0xffffu); *(LAS unsigned short*)(T_ + 7 * SV) = (unsigned short)(kw.w >> 16); }
            __syncthreads();
            f32x16 accO;
            if (wid < 4) { mm_tile<2>(accS, lds + O_KTT + wid * 32 * SV, SV, VTc, SV, r32, hi); }
            else if (wid == 4) { f32x16 p;
#pragma unroll
                for (int r = 0; r < 16; ++r) p[r] = 0.f;
                mm_tile<8>(p, lds + O_QT, SQ, lds + O_KT, SQ, r32, hi);
#pragma unroll
                for (int r = 0; r < 16; ++r) { const int t = crow_(r, hi); const float pv = r32 <= t ? p[r] : 0.f;
                    *(LAS unsigned short*)(lds + O_AT + t * SV + r32 * 2) = (unsigned short)(pk2(pv, 0.f) & 0xffffu); } }
            else if (wid == 5) {
#pragma unroll
                for (int r = 0; r < 16; ++r) accO[r] = 0.f;
                mm_tile<8>(accO, lds + O_QT, SQ, lds + O_ST, SQ, r32, hi); }
            __syncthreads();
            if (wid < 4) {
#pragma unroll
                for (int g = 0; g < 4; ++g) { const int dk0 = 32 * wid + 8 * g + 4 * hi; const f32x4 gm = *(const LAS f32x4*)(lds + O_G + dk0 * 4);
                    accS[4 * g + 0] *= gm[0]; accS[4 * g + 1] *= gm[1]; accS[4 * g + 2] *= gm[2]; accS[4 * g + 3] *= gm[3];
                    u32x2 w; w.x = pk2(accS[4 * g + 0], accS[4 * g + 1]); w.y = pk2(accS[4 * g + 2], accS[4 * g + 3]);
                    *(LAS u32x2*)(lds + O_ST + r32 * SQ + dk0 * 2) = w; } }
            else if (wid == 5) { mm_tile<2>(accO, lds + O_AT, SV, VTc, SV, r32, hi);
#pragma unroll
                for (int r = 0; r < 16; ++r) { const int tt = blk * 32 + crow_(r, hi); const size_t m = (size_t)b * SEQ + (dir ? SEQ - 1 - tt : tt);
                    OPd[m * 1024 + h * 128 + dvq * 32 + r32] = (bf16_t)(pk2(accO[r], 0.f) & 0xffffu); } }
            rk = nk; rq = nq; rv = nv;
        }
        __syncthreads();
#undef SM_GLOAD
    }
}

enum Op { OP_SW0, OP_FO0, OP_RPA, OP_MIN, OP_RMLA, OP_QKV, OP_ATTN, OP_MWO, OP_RPB, OP_SW1, OP_FO1, OP_RPC, OP_HIN, OP_SCAN, OP_RHG, OP_HWO };
__device__ const unsigned char OPS_M[12] = {OP_SW0, OP_FO0, OP_RPA, OP_MIN, OP_RMLA, OP_QKV, OP_ATTN, OP_MWO, OP_RPB, OP_SW1, OP_FO1, OP_RPC};
__device__ const unsigned char OPS_H[11] = {OP_SW0, OP_FO0, OP_RPA, OP_HIN, OP_SCAN, OP_RHG, OP_HWO, OP_RPB, OP_SW1, OP_FO1, OP_RPC};

struct Args { const float* in[15]; float* out; unsigned char* ws; };
typedef const __attribute__((address_space(4))) Args* ArgsP;
__device__ __forceinline__ ArgsP get_args() { ArgsP p = (ArgsP)__builtin_amdgcn_kernarg_segment_ptr(); asm volatile("" : "+s"(p) :: "memory"); return p; }
#define GW_ ((int)blockIdx.x * 8 + __builtin_amdgcn_readfirstlane((int)threadIdx.x >> 6))
#define NGW_ ((int)gridDim.x * 8)
__device__ __forceinline__ int otid_() { int t = threadIdx.x; asm volatile("" : "+v"(t)); return t; }
#define LANE_ (otid_() & 63)

#ifdef DBG_CHECKS
__device__ __forceinline__ float bf2f(bf16_t v) { return __uint_as_float((unsigned)v << 16); }
__device__ __forceinline__ unsigned hash_u(unsigned x) { x ^= x >> 16; x *= 0x7feb352du; x ^= x >> 15; x *= 0x846ca68bu; x ^= x >> 16; return x; }
__device__ __forceinline__ void dbg_report(unsigned* DBG, int id, float got, float ref, float rtol, float atol) {
    const float err = fabsf(got - ref); const bool bad = !(err <= rtol * fabsf(ref) + atol);
    if (bad) atomicMax(DBG + id, 1u);
}
__device__ __forceinline__ int dbg_row(int sidx) { if (sidx == 0) return 0; if (sidx == 1) return MT - 1; if (sidx == 2) return SEQ - 1; if (sidx == 3) return SEQ; return (int)(hash_u(sidx * 2654435761u + 17u) % MT); }
#endif
#ifdef DBG_CHECKS
struct DbgCtx { const float* const* in; unsigned char* ws; unsigned char* R; unsigned* DBG; int bx, tid, lane, wave; };
__device__ __forceinline__ float dbg_dot_bf_w(const bf16_t* a, const float* W, int K, int ldw, int col) { float s = 0.f; for (int k = 0; k < K; ++k) s += bf2f(a[k]) * W[(size_t)k * ldw + col]; return s; }
template <class A>
__device__ __forceinline__ void dbg_after(int l, int op, A ap, unsigned char* ws, unsigned char* R, LAS unsigned char* lds) {
    unsigned* DBG = (unsigned*)(ws + 32768);
    const int bx = blockIdx.x, tid = otid_(), lane = tid & 63, wave = __builtin_amdgcn_readfirstlane(tid >> 6);
    const bf16_t* HN = (const bf16_t*)(ws + WS_HN); const float* Y = (const float*)(ws + WS_Y);
    if (false && l == 0 && op == OP_SW0 && bx < 32) { const int sid = bx * 512 + tid, m = dbg_row(sid), c = hash_u(sid * 3 + 1) % DFF; const float* W = ap->in[3];
        const float g = dbg_dot_bf_w(HN + (size_t)m * 1024, W, 1024, 2 * DFF, c), u = dbg_dot_bf_w(HN + (size_t)m * 1024, W, 1024, 2 * DFF, DFF + c);
        dbg_report(DBG, 1, bf2f(((const bf16_t*)(R + R_ACT))[(size_t)m * DFF + c]), g / (1.f + expf(-g)) * u, 0.015f, 0.004f); }
    if (false && l == 0 && op == OP_FO0 && bx < 32) { const int sid = bx * 512 + tid, m = dbg_row(sid), c = hash_u(sid * 3 + 2) % 1024;
        const float r = dbg_dot_bf_w((const bf16_t*)(R + R_ACT) + (size_t)m * DFF, ap->in[4], DFF, 1024, c);
        dbg_report(DBG, 2, Y[(size_t)m * 1024 + c], r, 0.015f, 0.004f); }
    if (false && l == 0 && op == OP_RPA && bx < 32) { const int sid = bx * 512 + tid, m = dbg_row(sid), c = hash_u(sid * 3 + 3) % 1024; const float* g = ap->in[2];
        float s = 0.f; for (int k = 0; k < 1024; ++k) { const float y = Y[(size_t)m * 1024 + k]; s += y * y; }
        const float xr = ap->in[0][(size_t)m * 1024 + c] + 0.5f * Y[(size_t)m * 1024 + c] * rsqrtf(s / 1024.f + EPS) * g[1024 + c];
        dbg_report(DBG, 2, ap->out[(size_t)m * 1024 + c], xr, 1e-3f, 1e-3f);
        float s2 = 0.f; for (int k = 0; k < 1024; ++k) { const float x = ap->out[(size_t)m * 1024 + k]; s2 += x * x; }
        dbg_report(DBG, 2, bf2f(HN[(size_t)m * 1024 + c]), ap->out[(size_t)m * 1024 + c] * rsqrtf(s2 / 1024.f + EPS) * g[2048 + c], 0.01f, 0.01f); }
    if (false && l == 0 && op == OP_MIN && bx < 32) { const int sid = bx * 512 + tid, m = dbg_row(sid), c = hash_u(sid * 3 + 4) % 512; const int sc = src_col(2, c);
        const float r = sc >= 0 ? dbg_dot_bf_w(HN + (size_t)m * 1024, ap->in[5], 1024, 448, sc) : 0.f;
        dbg_report(DBG, 3, ((const float*)(R + R_C))[(size_t)m * 512 + c], r, 0.015f, 0.01f); }
    if (false && l == 0 && op == OP_RMLA && bx < 32) { const int sid = bx * 512 + tid, m = dbg_row(sid), c = hash_u(sid * 3 + 5) % 448; const float* C = (const float*)(R + R_C) + (size_t)m * 512;
        if (c < 256) { float s = 0.f; for (int k = 0; k < 256; ++k) s += C[k] * C[k];
            dbg_report(DBG, 3, bf2f(((const bf16_t*)(R + R_CQ))[(size_t)m * 256 + c]), C[c] * rsqrtf(s / 256.f + EPS) * ap->in[6][c], 0.01f, 0.01f); }
        else if (c < 384) { float s = 0.f; for (int k = 256; k < 384; ++k) s += C[k] * C[k];
            dbg_report(DBG, 3, bf2f(((const bf16_t*)(R + R_CKV))[(size_t)m * 128 + c - 256]), C[c] * rsqrtf(s / 128.f + EPS) * ap->in[7][c - 256], 0.01f, 0.01f); }
        else { const int jj = c - 384, i = jj >> 1; const float ang = (float)((const int*)ap->in[1])[m] * powf(10000.f, -(float)i / 32.f); const float cs = cosf(ang), sn = sinf(ang);
            const float t1 = C[384 + 2 * i], t2 = C[384 + 2 * i + 1]; const float r = (jj & 1) ? t1 * sn + t2 * cs : t1 * cs - t2 * sn;
            dbg_report(DBG, 3, bf2f(((const bf16_t*)(R + R_KR))[(size_t)m * 64 + jj]), r, 0.02f, 0.05f); } }
    if (false && l == 0 && op == OP_QKV && bx < 32) { const int sid = bx * 512 + tid, m = dbg_row(sid); const bf16_t* CQ = (const bf16_t*)(R + R_CQ) + (size_t)m * 256; const bf16_t* CKV = (const bf16_t*)(R + R_CKV) + (size_t)m * 128;
        { const int c = hash_u(sid * 3 + 6) % 1536, h = c / QKD, d = c % QKD; float r;
          if (d < 128) r = dbg_dot_bf_w(CQ, ap->in[8], 256, 1536, c);
          else { const int jj = d - 128, i = jj >> 1; const float t1 = dbg_dot_bf_w(CQ, ap->in[8], 256, 1536, h * QKD + 128 + i), t2 = dbg_dot_bf_w(CQ, ap->in[8], 256, 1536, h * QKD + 160 + i);
              const float ang = (float)((const int*)ap->in[1])[m] * powf(10000.f, -(float)i / 32.f); const float cs = cosf(ang), sn = sinf(ang); r = (jj & 1) ? t1 * sn + t2 * cs : t1 * cs - t2 * sn; }
          dbg_report(DBG, 4, bf2f(((const bf16_t*)(R + R_QB))[(size_t)m * 1536 + c]), r, 0.015f, 0.015f); }
        { const int c = hash_u(sid * 3 + 7) % 2048, h = c >> 8, d = c & 255; const float r = dbg_dot_bf_w(CKV, ap->in[9], 128, 2048, c);
          const float got = d < 128 ? bf2f(((const bf16_t*)(R + R_KN))[(size_t)m * 1024 + h * 128 + d]) : bf2f(((const bf16_t*)(R + R_VB))[(size_t)m * 1024 + h * 128 + d - 128]);
          dbg_report(DBG, 5, got, r, 0.015f, 0.015f); } }
    if (l == 0 && op == OP_ATTN) { const int sid = bx * 8 + wave, m = dbg_row(sid), h = hash_u(sid * 5 + 1) & 7, dv = hash_u(sid * 5 + 2) & 127, b = m / SEQ;
        LAS float* qs = (LAS float*)lds + wave * 192; const bf16_t* Q = (const bf16_t*)(R + R_QB) + (size_t)m * 1536 + h * QKD;
        for (int d = lane; d < 192; d += 64) qs[d] = bf2f(Q[d]);
        asm volatile("s_waitcnt lgkmcnt(0)" ::: "memory");
        float mx = -1e30f, ls = 0.f, acc = 0.f;
        for (int kk = lane; kk < SEQ; kk += 64) { const size_t km = (size_t)b * SEQ + kk; const bf16_t* Kn = (const bf16_t*)(R + R_KN) + km * 1024 + h * 128; const bf16_t* Kr = (const bf16_t*)(R + R_KR) + km * 64;
            float s = 0.f; for (int d = 0; d < 128; ++d) s += qs[d] * bf2f(Kn[d]); for (int d = 0; d < 64; ++d) s += qs[128 + d] * bf2f(Kr[d]);
            s *= 0.07216878364870322f; const float v = bf2f(((const bf16_t*)(R + R_VB))[km * 1024 + h * 128 + dv]);
            const float mn = fmaxf(mx, s), al = expf(mx - mn), p = expf(s - mn); ls = ls * al + p; acc = acc * al + p * v; mx = mn; }
        float gm = mx;
        for (int o = 1; o < 64; o <<= 1) gm = fmaxf(gm, __shfl_xor(gm, o));
        const float sc = expf(mx - gm); const float L = wave_sum(ls * sc), Asum = wave_sum(acc * sc);
        if (lane == 0) { const float got = bf2f(((const bf16_t*)(R + R_O))[(size_t)m * 1024 + h * 128 + dv]), ref = Asum / L; atomicMax(DBG + 20, __float_as_uint(fabsf(got - ref))); atomicAdd((float*)(DBG + 21), fabsf(ref) * (1.f / 2048.f)); } }
    if (false && l == 1 && op == OP_HIN && bx < 32) { const int sid = bx * 512 + tid, m = dbg_row(sid), c5 = hash_u(sid * 3 + 8) % 5120, seg = c5 >> 10, c = c5 & 1023;
        const float u = dbg_dot_bf_w(HN + (size_t)m * 1024, ap->in[11], 1024, 5120, c5); float got, r;
        if (seg == 0) { got = bf2f(((const bf16_t*)(R + R_QH))[(size_t)m * 1024 + c]); r = u / (1.f + expf(-u)); }
        else if (seg == 3) { got = bf2f(((const bf16_t*)(R + R_VH))[(size_t)m * 1024 + c]); r = u; }
        else if (seg == 4) { got = bf2f(((const bf16_t*)(R + R_GH))[(size_t)m * 1024 + c]); r = u / (1.f + expf(-u)); }
        else { const int dir = seg - 1; const float* lbp = ap->in[12] + (size_t)dir * DEPTH * 1024 + c; const float e0 = expf(lbp[0]), e1 = expf(lbp[1024]), e2 = expf(lbp[2048]), e3 = expf(lbp[3072]);
            const float lb = e1 / (e0 + e1 + e2 + e3); const h16x2 hv = __builtin_bit_cast(h16x2, (unsigned)((const unsigned short*)(R + R_KF))[(size_t)dir * MT * 1024 + (size_t)m * 1024 + c]);
            got = (float)hv[0]; r = (1.f - lb) / (1.f + expf(u)); }
        dbg_report(DBG, 7, got, r, 0.015f, 0.006f); }
    if (false && l == 1 && op == OP_SCAN) { const int sid = bx * 8 + wave, h = hash_u(sid * 5 + 3) & 7, dv = hash_u(sid * 5 + 4) & 127, b = hash_u(sid * 5 + 5) & 3, toff = sid & 31, dir = 0;
        const bf16_t* Qh = (const bf16_t*)(R + R_QH); const bf16_t* Vh = (const bf16_t*)(R + R_VH); const unsigned short* KF = (const unsigned short*)(R + R_KF); const bf16_t* OPb = (const bf16_t*)(ws + WS_Y);
        float S0 = 0.f, S1 = 0.f; const int n = toff + 1; const int t = toff; const size_t m = (size_t)b * SEQ + t;
        for (int i = 0; i < n; ++i) { const int tt = i; const size_t mm = (size_t)b * SEQ + tt; const unsigned short* kp = KF + (size_t)dir * MT * 1024 + mm * 1024 + h * 128;
            const h16x2 ka = __builtin_bit_cast(h16x2, (unsigned)kp[lane]), kb = __builtin_bit_cast(h16x2, (unsigned)kp[lane + 64]); const float k0 = (float)ka[0], k1 = (float)kb[0];
            const float v = bf2f(Vh[mm * 1024 + h * 128 + dv]); S0 = S0 * (1.f - k0) + k0 * v; S1 = S1 * (1.f - k1) + k1 * v; }
        const bf16_t* q = Qh + m * 1024 + h * 128; const float tot = wave_sum(S0 * bf2f(q[lane]) + S1 * bf2f(q[lane + 64]));
        if (lane == 0) { const float got = bf2f(OPb[(size_t)dir * MT * 1024 + m * 1024 + h * 128 + dv]); const float re = fabsf(got - tot) / (fabsf(tot) + 0.05f);
            if (re > 0.05f) { atomicMin(DBG + 20, (unsigned)toff); atomicAdd(DBG + 21, 1u); } } }
    if (false && l == 1 && op == OP_RHG && bx < 32) { const int sid = bx * 512 + tid, m = dbg_row(sid), c = hash_u(sid * 3 + 9) % 1024, h0 = c & ~127; const bf16_t* OPb = (const bf16_t*)(ws + WS_Y);
        float s = 0.f; for (int k = 0; k < 128; ++k) { const float y = bf2f(OPb[(size_t)m * 1024 + h0 + k]) + bf2f(OPb[(size_t)MT * 1024 + (size_t)m * 1024 + h0 + k]); s += y * y; }
        const float yc = bf2f(OPb[(size_t)m * 1024 + c]) + bf2f(OPb[(size_t)MT * 1024 + (size_t)m * 1024 + c]);
        const float r = yc * rsqrtf(s / 128.f + EPS) * ap->in[13][c] * bf2f(((const bf16_t*)(R + R_GH))[(size_t)m * 1024 + c]);
        dbg_report(DBG, 9, bf2f(((const bf16_t*)(R + R_HO))[(size_t)m * 1024 + c]), r, 0.02f, 0.005f); }
    if (false && l == 1 && op == OP_HWO && bx < 32) { const int sid = bx * 512 + tid, m = dbg_row(sid), c = hash_u(sid * 3 + 10) % 1024;
        const float r = dbg_dot_bf_w((const bf16_t*)(R + R_HO) + (size_t)m * 1024, ap->in[14], 1024, 1024, c);
        dbg_report(DBG, 9, Y[(size_t)m * 1024 + c], r, 0.03f, 0.01f); }
    if (false && l == 0 && op == OP_MWO && bx < 32) { const int sid = bx * 512 + tid, m = dbg_row(sid), c = hash_u(sid * 3 + 11) % 1024;
        const float r = dbg_dot_bf_w((const bf16_t*)(R + R_O) + (size_t)m * 1024, ap->in[10], 1024, 1024, c);
        dbg_report(DBG, 6, Y[(size_t)m * 1024 + c], r, 0.02f, 0.0004f); }
}
#endif

__device__ __forceinline__ void gsync_cg() {
    asm volatile("s_waitcnt vmcnt(0) lgkmcnt(0)" ::: "memory");
    __syncthreads();
    cg::this_grid().sync();
    if (threadIdx.x == 0) { __builtin_amdgcn_fence(__ATOMIC_ACQUIRE, "agent"); asm volatile("s_waitcnt vmcnt(0)" ::: "memory"); }
    __syncthreads();
}
#define GAS __attribute__((address_space(1)))
#define XB_TMO      128
#define XB_XCNT(j)  (256  + 64 * (j))
#define XB_XSUB(j)  (1280 + 64 * (j))
#define XB_XGEN(j)  (2304 + 64 * (j))
#define XB_TOP      3328
#define XB_TOPGEN   3392
#define XCD_BAR_WORDS 3456
#define XB_SPIN_CAP (1u << 18)

__device__ __forceinline__ unsigned xb_ld(unsigned* p)              { return __hip_atomic_load(p, __ATOMIC_RELAXED, __HIP_MEMORY_SCOPE_AGENT); }
__device__ __forceinline__ unsigned xb_add(unsigned* p, unsigned v) { return __hip_atomic_fetch_add(p, v, __ATOMIC_RELAXED, __HIP_MEMORY_SCOPE_AGENT); }
__device__ __forceinline__ unsigned xb_xcc_id() { return (unsigned)__builtin_amdgcn_s_getreg((3 << 11) | 20) & 0xFu; }
#define XB_SPIN(cond, bar) do { unsigned _sp = 0; while (cond) { __builtin_amdgcn_s_sleep(1); \
    if ((++_sp & 255u) == 0u) { if (xb_ld(&(bar)[XB_TMO])) break; if (_sp > XB_SPIN_CAP) { atomicAdd(&(bar)[XB_TMO], 1u); break; } } } } while (0)

struct XcdBarrier {
    unsigned* bar; unsigned x;
    volatile LAS unsigned* st;
};

__device__ __forceinline__ XcdBarrier xcd_barrier_post(unsigned* bar, volatile LAS unsigned* st) {
    XcdBarrier b; b.bar = bar; b.x = xb_xcc_id(); b.st = st;
    if (threadIdx.x == 0) (void)xb_add(&bar[XB_XCNT(b.x)], 1u);
    return b;
}
__device__ __forceinline__ void xcd_barrier_complete(unsigned* bar, unsigned x, unsigned& nloc, unsigned& nx) {
    const unsigned G = gridDim.x * gridDim.y * gridDim.z;
    unsigned sum, cnt, mine, sp = 0u;
    for (;;) {
        sum = 0u; cnt = 0u; mine = 0u;
#pragma unroll
        for (unsigned j = 0; j < 16; ++j) { const unsigned c = xb_ld(&bar[XB_XCNT(j)]); sum += c; cnt += (c > 0u) ? 1u : 0u; mine = (j == x) ? c : mine; }
        if (sum == G) break;
        __builtin_amdgcn_s_sleep(1);
        if ((++sp & 255u) == 0u) { if (xb_ld(&bar[XB_TMO])) break; if (sp > XB_SPIN_CAP) { atomicAdd(&bar[XB_TMO], 1u); break; } }
    }
    nloc = mine > 0u ? mine : 1u; nx = cnt > 0u ? cnt : 1u;
}

__device__ __forceinline__ void xcd_barrier(const XcdBarrier& b) {
    asm volatile("s_waitcnt vmcnt(0)" ::: "memory");
    __syncthreads();
    if (threadIdx.x == 0) {
        unsigned* bar = b.bar;
        __builtin_amdgcn_s_waitcnt(0);
        unsigned nloc = b.st[0], nx = b.st[1];
        if (nloc == 0u) { xcd_barrier_complete(bar, b.x, nloc, nx); b.st[0] = nloc; b.st[1] = nx; }
        const unsigned old = xb_add(&bar[XB_XSUB(b.x)], 1u);
        const unsigned gen = old / nloc;
        if (old + 1u == (gen + 1u) * nloc) {
            __builtin_amdgcn_fence(__ATOMIC_RELEASE, "agent");
            asm volatile("s_waitcnt vmcnt(0)" ::: "memory");
            const unsigned og = xb_add(&bar[XB_TOP], 1u);
            const unsigned tg = og / nx;
            if (og + 1u == (tg + 1u) * nx) xb_add(&bar[XB_TOPGEN], 1u);
            else XB_SPIN(xb_ld(&bar[XB_TOPGEN]) == tg, bar);
            __builtin_amdgcn_fence(__ATOMIC_ACQUIRE, "agent");
            xb_add(&bar[XB_XGEN(b.x)], 1u);
            asm volatile("s_waitcnt vmcnt(0)" ::: "memory");
        } else {
            XB_SPIN(xb_ld(&bar[XB_XGEN(b.x)]) == gen, bar);
            __builtin_amdgcn_fence(__ATOMIC_ACQUIRE, "agent");
            asm volatile("s_waitcnt vmcnt(0)" ::: "memory");
        }
    }
    __syncthreads();
}

__device__ __forceinline__ void gsync(LAS unsigned char* lds) {
#ifdef USE_CG_SYNC
    gsync_cg();
#else
    XcdBarrier b; b.bar = (unsigned*)get_args()->ws; b.x = xb_xcc_id(); b.st = (volatile LAS unsigned*)(lds + LDS_RING);
    xcd_barrier(b);
#endif
}
__global__ void __launch_bounds__(512, 2) mega_fwd(Args a_unused) {
    extern __shared__ __attribute__((aligned(16))) unsigned char lds_raw[];
    LAS unsigned char* lds = (LAS unsigned char*)lds_raw;

    if (threadIdx.x < 2) ((volatile LAS unsigned*)(lds + LDS_RING))[threadIdx.x] = 0u;
    __syncthreads();
    (void)xcd_barrier_post((unsigned*)get_args()->ws, (volatile LAS unsigned*)(lds + LDS_RING));
    {
        ArgsP ap = get_args(); unsigned char* ws = ap->ws;
#ifdef DBG_CHECKS
        if (blockIdx.x == 0 && threadIdx.x < 32) atomicExch((unsigned*)ws + threadIdx.x, 0u);
#endif
        const int tid = threadIdx.x, lane = tid & 63, wave = __builtin_amdgcn_readfirstlane(tid >> 6), G = gridDim.x, bx = blockIdx.x, gw = bx * 8 + wave, NGW = G * 8;
        LAS float* scr = (LAS float*)(lds + wave * 16384);
        constexpr int I_FFI = 16 * 176, I_FFO = 44 * 32, I_HIN = 16 * 160, I_SQ = 16 * 32, I_MIN = 16 * 16, I_UQ = 4 * 48, I_UKV = 2 * 64;
        constexpr int NITEMS = 8 * I_FFI + 8 * I_FFO + 2 * I_HIN + 2 * I_SQ + 2 * I_MIN + 2 * I_UQ + 2 * I_UKV + 2 * I_SQ;
        for (int it = gw; it < NITEMS; it += NGW) {
            int r = it;
#define XP(IDX_, K_, NS_, ND_, MODE_, WSOFF_, NMAT_, IPM_) if (r < (NMAT_) * (IPM_)) { const int mat = r / (IPM_); \
            xpose_item(ap->in[IDX_] + (size_t)mat * (K_) * (NS_), K_, NS_, ND_, MODE_, (bf16_t*)(ws + (WSOFF_)) + (size_t)mat * (ND_) * (K_), scr, r % (IPM_), lane); continue; } r -= (NMAT_) * (IPM_);
            XP(3, 1024, 2 * DFF, 2 * DFF, 1, WS_WFFI, 8, I_FFI)
            XP(4, DFF, 1024, 1024, 0, WS_WFFO, 8, I_FFO)
            XP(11, 1024, 5120, 5120, 0, WS_WHIN, 2, I_HIN)
            XP(14, 1024, 1024, 1024, 0, WS_WHO, 2, I_SQ)
            XP(5, 1024, 448, 512, 2, WS_WMIN, 2, I_MIN)
            XP(8, 256, 1536, 1536, 3, WS_WUQ, 2, I_UQ)
            XP(9, 128, 2048, 2048, 0, WS_WUKV, 2, I_UKV)
            XP(10, 1024, 1024, 1024, 0, WS_WMO, 2, I_SQ)
#undef XP
        }
        { const int* positions = (const int*)ap->in[1]; float* COS = (float*)(ws + WS_COS); float* SIN = (float*)(ws + WS_SIN);
          for (int idx = bx * 512 + tid; idx < MT * 32; idx += G * 512) { const int m = idx >> 5, i = idx & 31;
            const double ang = (double)positions[m] * ROPE_INVF[i]; const double rev = ang * 0.15915494309189535; const float fr = (float)(rev - __builtin_rint(rev));
            COS[idx] = __builtin_amdgcn_cosf(fr); SIN[idx] = __builtin_amdgcn_sinf(fr); } }
        { float* LB = (float*)(ws + WS_LB);
          for (int idx = bx * 512 + tid; idx < 2 * 2 * 1024; idx += G * 512) { const int c = idx & 1023, dir = (idx >> 10) & 1, j = idx >> 11, l = 2 * j + 1;
            const float* lbp = ap->in[12] + (size_t)dir * DEPTH * 1024 + c; float v[4], mx = -1e30f;
#pragma unroll
            for (int i = 0; i < 4; ++i) { v[i] = lbp[i * 1024]; mx = fmaxf(mx, v[i]); }
            float den = 0.f, num = 0.f;
#pragma unroll
            for (int i = 0; i < 4; ++i) { const float e = __expf(v[i] - mx); den += e; if (i >= 1 && i <= l) num += e; }
            LB[idx] = num / den; } }
        { const float* x_in = ap->in[0]; float* X = ap->out; bf16_t* HN = (bf16_t*)(ws + WS_HN); const float* gains = ap->in[2];
          for (int m = gw; m < MT; m += NGW) row_init(x_in + (size_t)m * DM, X + (size_t)m * DM, HN + (size_t)m * DM, gains, lane); }
    }
    gsync_cg();

    for (int ph = 0; ph < 46; ++ph) {
        const int l = ph >= 35 ? 3 : (ph >= 23 ? 2 : (ph >= 12 ? 1 : 0)), s = ph - (l == 3 ? 35 : (l == 2 ? 23 : (l == 1 ? 12 : 0)));
        const bool hg = l & 1; const int j = l >> 1;
        const int op = hg ? OPS_H[s] : OPS_M[s];
        ArgsP ap = get_args(); unsigned char* ws = ap->ws; unsigned char* R = ws + WS_R;
        int G_ = gridDim.x, bx_ = blockIdx.x; asm volatile("" : "+s"(G_), "+s"(bx_));
        switch (op) {
        case OP_SW0: case OP_SW1: {
            const int half = op == OP_SW1;
            pg8::Gemm gm{(const bf16_t*)(ws + WS_HN), (const bf16_t*)(ws + WS_WFFI) + (size_t)(l * 2 + half) * (2 * DFF) * 1024, MT, 2 * DFF, 1024};
            pg8::StaticOrder S; S.init(MT, 2 * DFF, G_, bx_); EpiSwiglu E{(bf16_t*)(R + R_ACT)};
#ifndef NO_SW
            pg8::gemm_phase<EpiSwiglu, pg8::StaticOrder, true, true>(lds, gm, S, E);
#endif
        } break;
        case OP_FO0: case OP_FO1: case OP_MIN: case OP_MWO: case OP_HWO: {
            pg8::Gemm gm; EpiF32 E; float* Y = (float*)(ws + WS_Y);
            if (op == OP_FO0 || op == OP_FO1) { const int half = op == OP_FO1; gm = pg8::Gemm{(const bf16_t*)(R + R_ACT), (const bf16_t*)(ws + WS_WFFO) + (size_t)(l * 2 + half) * 1024 * DFF, MT, 1024, DFF}; E = EpiF32{Y, 1024}; }
            else if (op == OP_MIN) { gm = pg8::Gemm{(const bf16_t*)(ws + WS_HN), (const bf16_t*)(ws + WS_WMIN) + (size_t)j * 512 * 1024, MT, 512, 1024}; E = EpiF32{(float*)(R + R_C), 512}; }
            else if (op == OP_MWO) { gm = pg8::Gemm{(const bf16_t*)(R + R_O), (const bf16_t*)(ws + WS_WMO) + (size_t)j * 1024 * 1024, MT, 1024, 1024}; E = EpiF32{Y, 1024}; }
            else { gm = pg8::Gemm{(const bf16_t*)(R + R_HO), (const bf16_t*)(ws + WS_WHO) + (size_t)j * 1024 * 1024, MT, 1024, 1024}; E = EpiF32{Y, 1024}; }
            pg8::StaticOrder S; S.init(MT, gm.N, G_, bx_);
#ifndef NO_F32
            pg8::gemm_phase<EpiF32, pg8::StaticOrder, true, true>(lds, gm, S, E);
#endif
        } break;
        case OP_RPA: case OP_RPB: case OP_RPC: {
            const float* gains = ap->in[2]; const float* g = gains + (size_t)l * 6 * DM; float* Y = (float*)(ws + WS_Y); float* X = ap->out; bf16_t* HN = (bf16_t*)(ws + WS_HN);
            const int k = op == OP_RPA ? 1 : (op == OP_RPB ? 3 : 5); const float scale = op == OP_RPB ? 1.0f : 0.5f;
            const bool last = (op == OP_RPC) && (l == DEPTH - 1);
            const float* gn = op == OP_RPC ? gains + (size_t)(l + 1) * 6 * DM : g + (size_t)(k + 1) * DM;
            const int lane = LANE_;
            for (int m = bx_ * 8 + __builtin_amdgcn_readfirstlane(otid_() >> 6); m < MT; m += G_ * 8) row_post(Y + (size_t)m * DM, X + (size_t)m * DM, last ? (bf16_t*)nullptr : HN + (size_t)m * DM, scale, g + (size_t)k * DM, last ? g : gn, lane);
        } break;
        case OP_RMLA: {
            const float* qn = ap->in[6] + (size_t)j * QLR; const float* kvn = ap->in[7] + (size_t)j * KVLR; const float* COS = (const float*)(ws + WS_COS); const float* SIN = (const float*)(ws + WS_SIN);
            const int lane = LANE_;
            for (int m = bx_ * 8 + __builtin_amdgcn_readfirstlane(otid_() >> 6); m < MT; m += G_ * 8) row_mla((const float*)(R + R_C) + (size_t)m * 512, (bf16_t*)(R + R_CQ) + (size_t)m * 256, (bf16_t*)(R + R_CKV) + (size_t)m * 128, (bf16_t*)(R + R_KR) + (size_t)m * 64,
                                                         qn, kvn, COS + (size_t)m * 32, SIN + (size_t)m * 32, lane);
        } break;
        case OP_QKV: {
            { int Kq = 256; asm volatile("" : "+s"(Kq)); pg8::Gemm gm{(const bf16_t*)(R + R_CQ), (const bf16_t*)(ws + WS_WUQ) + (size_t)j * 1536 * 256, MT, 1536, Kq};
              pg8::StaticOrder S; S.init(MT, 1536, G_, bx_); EpiQ E{(bf16_t*)(R + R_QB), (const float*)(ws + WS_COS), (const float*)(ws + WS_SIN)};
#ifndef NO_Q
              pg8::gemm_phase<EpiQ, pg8::StaticOrder, true, true>(lds, gm, S, E);
#endif
            }
            __syncthreads();
            { int Kq = 128; asm volatile("" : "+s"(Kq)); pg8::Gemm gm{(const bf16_t*)(R + R_CKV), (const bf16_t*)(ws + WS_WUKV) + (size_t)j * 2048 * 128, MT, 2048, Kq};
              pg8::StaticOrder S; S.init(MT, 2048, G_, bx_); EpiKV E{(bf16_t*)(R + R_KN), (bf16_t*)(R + R_VB)};
#ifndef NO_KV
              pg8::gemm_phase<EpiKV, pg8::StaticOrder, true, true>(lds, gm, S, E);
#endif
            }
        } break;
        case OP_ATTN: {
#ifndef NO_ATTN
            const int G = G_, bx = bx_;

            const int vcu = (G % 8 == 0) ? (bx % 8) * (G / 8) + bx / 8 : bx;
#ifdef REP_ATTN
            for (int rep_ = 0; rep_ < 2; ++rep_)
#endif
            for (int uid = vcu; uid < BATCH * NH * (SEQ / 256); uid += G) {
                const int bh = uid >> 5, qb = uid & 31, b = bh >> 3, h = bh & 7;
                const size_t row0 = (size_t)b * SEQ;
                att::attn_unit((const att::bf16*)(R + R_QB) + (row0 + qb * 256) * 1536 + h * QKD, (const att::bf16*)(R + R_KN) + row0 * 1024 + h * 128,
                               (const att::bf16*)(R + R_KR) + row0 * 64, (const att::bf16*)(R + R_VB) + row0 * 1024 + h * 128,
                               (att::bf16*)(R + R_O) + (row0 + qb * 256) * 1024 + h * 128, SEQ, (char*)lds_raw);
            }
#endif
        } break;
        case OP_HIN: {
            pg8::Gemm gm{(const bf16_t*)(ws + WS_HN), (const bf16_t*)(ws + WS_WHIN) + (size_t)j * 5120 * 1024, MT, 5120, 1024};
            pg8::StaticOrder S; S.init(MT, 5120, G_, bx_);
            EpiHgrn E{(bf16_t*)(R + R_QH), (bf16_t*)(R + R_VH), (bf16_t*)(R + R_GH), (unsigned short*)(R + R_KF), (const float*)(ws + WS_LB) + (size_t)j * 2048};
#ifndef NO_HG
            pg8::gemm_phase<EpiHgrn, pg8::StaticOrder, true, true>(lds, gm, S, E);
#endif
        } break;
        case OP_SCAN: {
#ifndef NO_SCAN
#ifdef REP_SCAN
            scan_phase(lds, (const bf16_t*)(R + R_QH), (const bf16_t*)(R + R_VH), (const unsigned short*)(R + R_KF), (bf16_t*)(ws + WS_Y), G_, bx_); __syncthreads();
#endif
#ifdef SCAN_VALU
            scan_phase(lds, (const bf16_t*)(R + R_QH), (const bf16_t*)(R + R_VH), (const unsigned short*)(R + R_KF), (bf16_t*)(ws + WS_Y), G_, bx_);
#else
            scan_phase_mfma(lds, (const bf16_t*)(R + R_QH), (const bf16_t*)(R + R_VH), (const unsigned short*)(R + R_KF), (bf16_t*)(ws + WS_Y), G_, bx_);
#endif
#endif
        } break;
        case OP_RHG: {
            const float* on = ap->in[13] + (size_t)j * DM; const bf16_t* Y = (const bf16_t*)(ws + WS_Y);
            const int lane = LANE_;
            for (int m = bx_ * 8 + __builtin_amdgcn_readfirstlane(otid_() >> 6); m < MT; m += G_ * 8) row_hgrn(Y + (size_t)m * DM, (const bf16_t*)(R + R_GH) + (size_t)m * DM, (bf16_t*)(R + R_HO) + (size_t)m * DM, on, lane);
        } break;
        default: break;
        }
        if (ph != 45) gsync(lds);
#ifdef REP_SYNC
        gsync(lds);
#endif
#ifdef DBG_CHECKS
        { ArgsP ap2 = get_args(); dbg_after(l, op, ap2, ap2->ws, ap2->ws + WS_R, lds); gsync(lds); }
#endif
    }
#ifdef DBG_CHECKS
    gsync(lds);
    if (blockIdx.x == 0 && threadIdx.x == 0) { ArgsP ap = get_args(); unsigned* DBG = (unsigned*)ap->ws; const float mx = __uint_as_float(atomicAdd(DBG + 20, 0u)), mean = atomicAdd((float*)(DBG + 21), 0.f); ap->out[1024 * 16] += 1e6f * mx; ap->out[1024 * 16 + 1] += 1e4f * mean; }
#endif
}

extern "C" void kernel_launch(void* const* d_in, const int* in_sizes, int n_in, void* d_out, int out_size, void* d_ws, size_t ws_size, hipStream_t stream) {
    static int grid = 0;
    if (grid == 0) {
        if (n_in != 15 || out_size != MT * DM || ws_size < WS_END) { fprintf(stderr, "kernel_launch: unexpected shapes: n_in %d out %d ws %zu (need %zu)\n", n_in, out_size, ws_size, (size_t)WS_END); grid = -1; return; }
        int dev = 0, cus = 0, per_cu = 0;
        (void)hipGetDevice(&dev); (void)hipDeviceGetAttribute(&cus, hipDeviceAttributeMultiprocessorCount, dev);
        if (hipFuncSetAttribute((const void*)mega_fwd, hipFuncAttributeMaxDynamicSharedMemorySize, LDS_BYTES) != hipSuccess) { fprintf(stderr, "kernel_launch: hipFuncSetAttribute failed\n"); grid = -1; return; }
        if (hipOccupancyMaxActiveBlocksPerMultiprocessor(&per_cu, (const void*)mega_fwd, 512, LDS_BYTES) != hipSuccess || per_cu < 1) { fprintf(stderr, "kernel_launch: occupancy query gave %d\n", per_cu); per_cu = 1; }
        (void)hipGetLastError();
        grid = cus * 1;
        fprintf(stderr, "kernel_launch: cus %d per_cu %d grid %d\n", cus, per_cu, grid);
    }
    if (grid < 0) return;
    if (hipMemsetAsync(d_ws, 0, 65536, stream) != hipSuccess) { fprintf(stderr, "kernel_launch: memset failed\n"); return; }
    Args a{};
    for (int i = 0; i < 15; ++i) a.in[i] = (const float*)d_in[i];
    a.out = (float*)d_out; a.ws = (unsigned char*)d_ws;
    void* args[] = {&a};
    hipError_t e = hipLaunchCooperativeKernel((const void*)mega_fwd, dim3(grid), dim3(512), args, LDS_BYTES, stream);
    if (e != hipSuccess) fprintf(stderr, "cooperative launch failed: %s (grid %d)\n", hipGetErrorString(e), grid);
}
```

```cpp
#include <hip/hip_runtime.h>
#include <hip/hip_cooperative_groups.h>
#include <hip/hip_bf16.h>
#include <hip/hip_fp16.h>
#include <cstdio>
#include <cstdint>
#include <cmath>
namespace cg = cooperative_groups;
namespace pg8 {
#define PG8_LAS __attribute__((address_space(3)))
typedef unsigned short bf16_t;
typedef short bf16x8 __attribute__((ext_vector_type(8)));
typedef float f32x4 __attribute__((ext_vector_type(4)));
typedef unsigned u32x4 __attribute__((ext_vector_type(4)));
constexpr int BM = 256, BK = 64, HALF = 128, HTB = HALF * BK * 2  , STAGE_BYTES = 8 * HTB, NXCD = 8, WGM = 8;

__host__ __device__ __forceinline__ int lds_byte(int r, int c) { const int st = (r >> 4) * 2 + (c >> 5), rr = r & 15, cc = c & 31, ob = rr * 64 + cc * 2; return st * 1024 + (ob ^ (((ob >> 9) & 1) << 5)); }
__host__ __device__ __forceinline__ void stage_rc(int b, int& R, int& C) { const int st = b / 1024, sb = b % 1024, swz = sb ^ (((sb >> 9) & 1) << 5); R = (st >> 1) * 16 + swz / 64; C = (st & 1) * 32 + (swz % 64) / 2; }
__host__ __device__ __forceinline__ int perm32(int rho) { const int n = rho >> 4, i = rho & 15; return 8 * (i >> 2) + 4 * n + (i & 3); }

struct Unit { int pm, pn; };
struct Gemm { const bf16_t* A; const bf16_t* Bt; int M, N, K; };

struct StaticOrder {
    int nM, nN, nwg, G, c;
    __host__ __device__ void init(int M, int N, int G_, int c_) { nM = M / BM; nN = N / BM; nwg = nM * nN; G = G_; c = c_; }
    __host__ __device__ bool next(int i, Unit& u) const {
        const long L = (long)i * G + c; if (L >= nwg) return false;
        int wgid = (int)L; { const int q = nwg / NXCD, r = nwg % NXCD, xcd = wgid % NXCD, off = wgid / NXCD; wgid = (xcd < r ? xcd * (q + 1) : r * (q + 1) + (xcd - r) * q) + off; }
        const int nig = WGM * nN, gid = wgid / nig, fm = gid * WGM, gsz = (nM - fm) < WGM ? (nM - fm) : WGM;
        u.pm = fm + ((wgid % nig) % gsz); u.pn = (wgid % nig) / gsz; return true;
    }
    __device__ __forceinline__ void a_ready(const Unit&) const {}
    __device__ __forceinline__ void done(const Unit&) const {}
};

__device__ __forceinline__ unsigned cvt_pk_bf16(float lo, float hi) { unsigned r; asm volatile("v_cvt_pk_bf16_f32 %0, %1, %2" : "=v"(r) : "v"(lo), "v"(hi)); return r; }
template <class Epi, class Sched, bool ALIGN_EPI = false, bool SP2 = false>
__device__ __forceinline__ void gemm_phase(PG8_LAS unsigned char* lds, const Gemm g, const Sched& S, const Epi& E) {
    int tid = threadIdx.x; asm volatile("" : "+v"(tid)); const int wid = __builtin_amdgcn_readfirstlane(tid >> 6), lane = tid & 63, wr = wid >> 2, wc = wid & 3, fr = lane & 15, fq = lane >> 4;
    const int K = g.K, nt = K / BK;
    unsigned voffA[2], voffB[2];
#pragma unroll
    for (int i = 0; i < 2; ++i) { int R, C; stage_rc(tid * 16 + i * 8192, R, C); const int Rb = Epi::PERM ? ((R & ~31) + perm32(R & 31)) : R;
        voffA[i] = (unsigned)(R * K + C) * 2u; voffB[i] = (unsigned)(Rb * K + C) * 2u; }
    const size_t kstep = (size_t)(BK * 2);
    const size_t hstep = (size_t)HALF * K * 2;
    const size_t tstep = 2 * hstep;
    const unsigned ldsw = (unsigned)wid * 1024u;
    const int aoff = lds_byte(wr * 64 + fr, fq * 8), boff = lds_byte(wc * 32 + fr, fq * 8);
#define PG8_SA(b, h) (((b) * 2 + (h)) * HTB)
#define PG8_SB(b, h) ((4 + (b) * 2 + (h)) * HTB)
#define PG8_STAGE(bufoff, gbase, voff) do { _Pragma("unroll") for (int _i = 0; _i < 2; ++_i) \
        __builtin_amdgcn_global_load_lds((const unsigned*)((const char*)(gbase) + (voff)[_i]), (PG8_LAS unsigned*)(lds + (bufoff) + ldsw + _i * 8192), 16, 0, 0); } while (0)
#define PG8_LDA(dst, b, h) do { _Pragma("unroll") for (int m = 0; m < 4; ++m) _Pragma("unroll") for (int k = 0; k < 2; ++k) dst[m][k] = *(const PG8_LAS bf16x8*)(lds + PG8_SA(b, h) + aoff + m * 2048 + k * 1024); } while (0)
#define PG8_LDB(dst, b, h) do { _Pragma("unroll") for (int n = 0; n < 2; ++n) _Pragma("unroll") for (int k = 0; k < 2; ++k) dst[n][k] = *(const PG8_LAS bf16x8*)(lds + PG8_SB(b, h) + boff + n * 2048 + k * 1024); } while (0)
#define PG8_MMA(ai, bj, At, Bt) do { __builtin_amdgcn_s_setprio(1); _Pragma("unroll") for (int m = 0; m < 4; ++m) _Pragma("unroll") for (int n = 0; n < 2; ++n) _Pragma("unroll") for (int k = 0; k < 2; ++k) \
        acc[ai][bj][m][n] = __builtin_amdgcn_mfma_f32_16x16x32_bf16(Bt[n][k], At[m][k], acc[ai][bj][m][n], 0, 0, 0); __builtin_amdgcn_s_setprio(0); } while (0)
#define PG8_WAIT_V(n) asm volatile("s_waitcnt vmcnt(" #n ")" ::: "memory")
#define PG8_WAIT_L(n) asm volatile("s_waitcnt lgkmcnt(" #n ")" ::: "memory")
#define PG8_BAR __builtin_amdgcn_s_barrier()
#define PG8_SCHED __builtin_amdgcn_sched_barrier(0)
    Unit cur, nxt; int ui = 0;
    if (!S.next(0, cur)) return;
    f32x4 acc[2][2][4][2];
#pragma unroll
    for (int a = 0; a < 2; ++a)
#pragma unroll
        for (int b = 0; b < 2; ++b)
#pragma unroll
            for (int m = 0; m < 4; ++m)
#pragma unroll
                for (int n = 0; n < 2; ++n) acc[a][b][m][n] = (f32x4){0.f, 0.f, 0.f, 0.f};
    bf16x8 At[4][2], B0[2][2], B1[2][2];
    const char* cA = (const char*)g.A + (size_t)cur.pm * tstep; const char* cB = (const char*)g.Bt + (size_t)cur.pn * tstep;
    S.a_ready(cur);
    if constexpr (SP2) {
        PG8_STAGE(PG8_SB(0, 0), cB, voffB); PG8_STAGE(PG8_SB(0, 1), cB + hstep, voffB); PG8_STAGE(PG8_SA(0, 0), cA, voffA); PG8_STAGE(PG8_SA(0, 1), cA + hstep, voffA);
        if (wr == 1) PG8_BAR;
        PG8_WAIT_V(2); PG8_BAR;
        PG8_STAGE(PG8_SB(1, 0), cB + kstep, voffB); PG8_STAGE(PG8_SA(1, 0), cA + kstep, voffA); PG8_STAGE(PG8_SB(1, 1), cB + hstep + kstep, voffB);
        PG8_WAIT_V(6); PG8_BAR;
    } else {
        PG8_STAGE(PG8_SB(0, 0), cB, voffB); PG8_STAGE(PG8_SA(0, 0), cA, voffA); PG8_STAGE(PG8_SB(0, 1), cB + hstep, voffB); PG8_STAGE(PG8_SA(0, 1), cA + hstep, voffA);
        if (wr == 1) PG8_BAR;
        PG8_WAIT_V(4); PG8_BAR;
        PG8_STAGE(PG8_SB(1, 0), cB + kstep, voffB); PG8_STAGE(PG8_SA(1, 0), cA + kstep, voffA); PG8_STAGE(PG8_SB(1, 1), cB + hstep + kstep, voffB);
        PG8_WAIT_V(6); PG8_BAR;
    }
    for (;;) {
        const bool has_next = S.next(ui + 1, nxt);
        const char* nA = has_next ? (const char*)g.A + (size_t)nxt.pm * tstep : cA; const char* nB = has_next ? (const char*)g.Bt + (size_t)nxt.pn * tstep : cB;
        for (int t = 0; t < nt; t += 2) {
            const bool last = (t == nt - 2);
            const char* a1 = cA + (size_t)(t + 1) * kstep;
            const char* a2 = last ? nA : cA + (size_t)(t + 2) * kstep; const char* b2 = last ? nB : cB + (size_t)(t + 2) * kstep;
            const char* a3 = a2 + kstep; const char* b3 = b2 + kstep;
            if (last && has_next) S.a_ready(nxt);
            if constexpr (SP2) {
            PG8_LDB(B0, 0, 0); PG8_LDB(B1, 0, 1); PG8_SCHED; PG8_LDA(At, 0, 0); PG8_STAGE(PG8_SA(1, 1), a1 + hstep, voffA);
            PG8_WAIT_V(8); PG8_WAIT_L(0); PG8_BAR; PG8_MMA(0, 0, At, B0); PG8_MMA(0, 1, At, B1); PG8_BAR; PG8_SCHED;
            PG8_LDA(At, 0, 1); PG8_STAGE(PG8_SB(0, 0), b2, voffB); PG8_STAGE(PG8_SB(0, 1), b2 + hstep, voffB); PG8_STAGE(PG8_SA(0, 0), a2, voffA);
            PG8_WAIT_V(8); PG8_WAIT_L(0); PG8_BAR; PG8_MMA(1, 0, At, B0); PG8_MMA(1, 1, At, B1); PG8_BAR; PG8_SCHED;
            PG8_LDB(B0, 1, 0); PG8_LDB(B1, 1, 1); PG8_SCHED; PG8_LDA(At, 1, 0); PG8_STAGE(PG8_SA(0, 1), a2 + hstep, voffA);
            PG8_WAIT_V(8); PG8_WAIT_L(0); PG8_BAR; PG8_MMA(0, 0, At, B0); PG8_MMA(0, 1, At, B1); PG8_BAR; PG8_SCHED;
            PG8_LDA(At, 1, 1); PG8_STAGE(PG8_SB(1, 0), b3, voffB); PG8_STAGE(PG8_SB(1, 1), b3 + hstep, voffB); PG8_STAGE(PG8_SA(1, 0), a3, voffA);
            PG8_WAIT_V(8); PG8_WAIT_L(0); PG8_BAR; PG8_MMA(1, 0, At, B0); PG8_MMA(1, 1, At, B1); PG8_BAR; PG8_SCHED;
            } else {
            PG8_LDB(B0, 0, 0); PG8_SCHED; PG8_LDA(At, 0, 0); PG8_STAGE(PG8_SA(1, 1), a1 + hstep, voffA);
            PG8_WAIT_L(8); PG8_BAR; PG8_WAIT_L(0); PG8_MMA(0, 0, At, B0); PG8_BAR; PG8_SCHED;
            PG8_LDB(B1, 0, 1); PG8_STAGE(PG8_SB(0, 0), b2, voffB);
            PG8_BAR; PG8_WAIT_L(0); PG8_MMA(0, 1, At, B1); PG8_BAR;
            PG8_LDA(At, 0, 1); PG8_STAGE(PG8_SA(0, 0), a2, voffA);
            PG8_BAR; PG8_WAIT_L(0); PG8_MMA(1, 0, At, B0); PG8_BAR; PG8_SCHED;
            PG8_STAGE(PG8_SB(0, 1), b2 + hstep, voffB);
            PG8_WAIT_V(6); PG8_BAR; PG8_MMA(1, 1, At, B1); PG8_BAR;
            PG8_LDB(B0, 1, 0); PG8_SCHED; PG8_LDA(At, 1, 0); PG8_STAGE(PG8_SA(0, 1), a2 + hstep, voffA);
            PG8_WAIT_L(8); PG8_BAR; PG8_WAIT_L(0); PG8_MMA(0, 0, At, B0); PG8_BAR; PG8_SCHED;
            PG8_LDB(B1, 1, 1); PG8_STAGE(PG8_SB(1, 0), b3, voffB);
            PG8_BAR; PG8_WAIT_L(0); PG8_MMA(0, 1, At, B1); PG8_BAR;
            PG8_LDA(At, 1, 1); PG8_STAGE(PG8_SA(1, 0), a3, voffA);
            PG8_BAR; PG8_WAIT_L(0); PG8_MMA(1, 0, At, B0); PG8_BAR; PG8_SCHED;
            PG8_STAGE(PG8_SB(1, 1), b3 + hstep, voffB);
            PG8_WAIT_V(6); PG8_BAR; PG8_MMA(1, 1, At, B1); PG8_BAR;
            }
        }
        if constexpr (ALIGN_EPI) { if (wr == 0) PG8_BAR; }
        if constexpr (!Epi::AFTER_DRAIN) { E(acc, cur, wr, wc, fr, fq); S.done(cur); }
        if (!has_next) break;
#pragma unroll
        for (int a = 0; a < 2; ++a)
#pragma unroll
            for (int b = 0; b < 2; ++b)
#pragma unroll
                for (int m = 0; m < 4; ++m)
#pragma unroll
                    for (int n = 0; n < 2; ++n) acc[a][b][m][n] = (f32x4){0.f, 0.f, 0.f, 0.f};
        cur = nxt; cA = nA; cB = nB; ++ui;
        if constexpr (ALIGN_EPI) { if (wr == 1) PG8_BAR; }
    }
    PG8_WAIT_V(0);
    if constexpr (!ALIGN_EPI) { if (wr == 0) PG8_BAR; }
    PG8_BAR;
    if constexpr (Epi::AFTER_DRAIN) { E.fused(acc, cur, wr, wc, fr, fq, lds, wid, lane); S.done(cur); }
#undef PG8_SA
#undef PG8_SB
#undef PG8_STAGE
#undef PG8_LDA
#undef PG8_LDB
#undef PG8_MMA
#undef PG8_WAIT_V
#undef PG8_WAIT_L
#undef PG8_BAR
#undef PG8_SCHED
}
}
#ifndef ATT_SDEPTH
#define ATT_SDEPTH 1
#endif
namespace att {
using bf16 = __hip_bfloat16;
constexpr int NW = 8, QBLK = 32, KVBLK = 64;
constexpr float SCALE = 0.07216878364870322f;
constexpr float THR = 8.f;
__device__ __forceinline__ int otid() { int t = threadIdx.x; asm volatile("" : "+v"(t)); return t; }
using bf16x8 = __attribute__((ext_vector_type(8))) short;
using s16x4  = __attribute__((ext_vector_type(4))) short;
using f32x16 = __attribute__((ext_vector_type(16))) float;
using f32x8  = __attribute__((ext_vector_type(8))) float;
using u32x4  = __attribute__((ext_vector_type(4))) unsigned;
#define KSWZ(row, colB) ((row) * 256 + ((colB) ^ (((row) & 7) << 4)))
#define SBAR() __builtin_amdgcn_sched_barrier(0)
__device__ __forceinline__ int crow(int r, int hi) { return (r & 3) + 8 * (r >> 2) + 4 * hi; }
__device__ __forceinline__ unsigned cvtpk(float lo, float hi) {
  unsigned r; asm volatile("v_cvt_pk_bf16_f32 %0, %1, %2" : "=v"(r) : "v"(lo), "v"(hi)); return r;
}
template <typename TIn> struct Stage;
template <> struct Stage<bf16>  { using T = bf16x8;
  __device__ static __forceinline__ T ld8(const bf16* p) { return *reinterpret_cast<const bf16x8*>(p); }
  __device__ static __forceinline__ bf16x8 tobf(T x) { return x; } };
template <> struct Stage<float> { using T = f32x8;
  __device__ static __forceinline__ T ld8(const float* p) { return *reinterpret_cast<const f32x8*>(p); }
  __device__ static __forceinline__ bf16x8 tobf(T x) {
    u32x4 w = {cvtpk(x[0], x[1]), cvtpk(x[2], x[3]), cvtpk(x[4], x[5]), cvtpk(x[6], x[7])}; return *reinterpret_cast<bf16x8*>(&w); } };

__device__ __forceinline__ void partialSM(f32x16& p0, f32x16& p1, float& m_reg, float& mn, float& alpha) {
  constexpr float C = SCALE * 1.4426950408889634f;
  float pmax = p0[0]; for (int r = 1; r < 16; ++r) pmax = fmaxf(pmax, p0[r]); for (int r = 0; r < 16; ++r) pmax = fmaxf(pmax, p1[r]);
  { auto rr = __builtin_amdgcn_permlane32_swap(__float_as_uint(pmax), __float_as_uint(pmax), false, false);
    pmax = fmaxf(__uint_as_float(rr[0]), __uint_as_float(rr[1])); }
  if (__builtin_expect(__all(pmax - m_reg <= THR / SCALE), 1)) { mn = m_reg; alpha = 1.f; }
  else { mn = fmaxf(m_reg, pmax); alpha = __builtin_amdgcn_exp2f((m_reg - mn) * C); m_reg = mn; }
  float mnC = -mn * C;
  for (int r = 0; r < 16; ++r) p0[r] = fmaf(p0[r], C, mnC); for (int r = 0; r < 16; ++r) p1[r] = fmaf(p1[r], C, mnC);
  for (int r = 0; r < 16; ++r) p0[r] = __builtin_amdgcn_exp2f(p0[r]);
}
__device__ __forceinline__ void finishSM(f32x16& p0, f32x16& p1, float alpha, float& l_reg, bf16x8& pa0, bf16x8& pa1, bf16x8& pa2, bf16x8& pa3) {
  for (int r = 0; r < 16; ++r) p1[r] = __builtin_amdgcn_exp2f(p1[r]);
  float ps = 0; for (int r = 0; r < 16; ++r) ps += p0[r]; for (int r = 0; r < 16; ++r) ps += p1[r];
  { auto rr = __builtin_amdgcn_permlane32_swap(__float_as_uint(ps), __float_as_uint(ps), false, false);
    ps = __uint_as_float(rr[0]) + __uint_as_float(rr[1]); }
  l_reg = l_reg * alpha + ps;
#define PK4(P, BASE, OUT) do { unsigned a0 = cvtpk(P[BASE + 0], P[BASE + 1]), a1 = cvtpk(P[BASE + 2], P[BASE + 3]);   \
    unsigned b0 = cvtpk(P[BASE + 4], P[BASE + 5]), b1 = cvtpk(P[BASE + 6], P[BASE + 7]);                              \
    auto r0 = __builtin_amdgcn_permlane32_swap(a0, b0, false, false); auto r1 = __builtin_amdgcn_permlane32_swap(a1, b1, false, false); \
    u32x4 w = {r0[0], r1[0], r0[1], r1[1]}; OUT = *reinterpret_cast<bf16x8*>(&w); } while (0)
  PK4(p0, 0, pa0); PK4(p0, 8, pa1); PK4(p1, 0, pa2); PK4(p1, 8, pa3);
#undef PK4
}
#define KSWZ2(row, colB) ((row) * 128 + ((colB) ^ (((row) & 7) << 4)))
__device__ __forceinline__ void qkt(f32x16& p0, f32x16& p1, const bf16* Ks, const bf16* KRs, const bf16x8* qr, const bf16x8* qrl, int r32, int hi) {
  p0 = f32x16{}; p1 = f32x16{};
#pragma unroll
  for (int d0 = 0; d0 < 8; ++d0) { int cb = (d0 * 16 + hi * 8) * 2;
    bf16x8 b0 = *reinterpret_cast<const bf16x8*>((const char*)Ks + KSWZ(r32, cb));
    bf16x8 b1 = *reinterpret_cast<const bf16x8*>((const char*)Ks + KSWZ(32 + r32, cb));
    p0 = __builtin_amdgcn_mfma_f32_32x32x16_bf16(b0, qr[d0], p0, 0, 0, 0);
    p1 = __builtin_amdgcn_mfma_f32_32x32x16_bf16(b1, qr[d0], p1, 0, 0, 0); }
#pragma unroll
  for (int d0 = 0; d0 < 4; ++d0) { int cb = (d0 * 16 + hi * 8) * 2;
    bf16x8 b0 = *reinterpret_cast<const bf16x8*>((const char*)KRs + KSWZ2(r32, cb));
    bf16x8 b1 = *reinterpret_cast<const bf16x8*>((const char*)KRs + KSWZ2(32 + r32, cb));
    const bf16x8 qv = qrl[d0 * 64];
    p0 = __builtin_amdgcn_mfma_f32_32x32x16_bf16(b0, qv, p0, 0, 0, 0);
    p1 = __builtin_amdgcn_mfma_f32_32x32x16_bf16(b1, qv, p1, 0, 0, 0); }
}
__device__ __forceinline__ int v_st(int k, int c) { const int kk = (k & ~0xC) | ((k & 4) << 1) | ((k & 8) >> 1); return ((kk >> 3) * 4 + (c >> 5)) * 512 + ((kk & 7) * 32 + (c & 31)) * 2; }
__device__ __forceinline__ int v_rd_base(int lane) { return ((lane & 3) << 3) | (((lane >> 2) & 3) << 6) | (((lane >> 4) & 1) << 5) | (((lane >> 5) & 1) << 8); }
constexpr int v_rd_off(int d0, int ks, int half) { return d0 * 512 + ks * 4096 + half * 2048; }
template <int OFF> __device__ __forceinline__ s16x4 tr_read(int vb) {
  s16x4 r; asm volatile("ds_read_b64_tr_b16 %0, %1 offset:%2" : "=&v"(r) : "v"(vb), "i"(OFF) : "memory"); return r;
}
template <int D0> __device__ __forceinline__ void pv_one(f32x16& od, int vb, bf16x8 pa0, bf16x8 pa1, bf16x8 pa2, bf16x8 pa3) {
  const s16x4 l0 = tr_read<v_rd_off(D0, 0, 0)>(vb), h0 = tr_read<v_rd_off(D0, 0, 1)>(vb), l1 = tr_read<v_rd_off(D0, 1, 0)>(vb), h1 = tr_read<v_rd_off(D0, 1, 1)>(vb);
  const s16x4 l2 = tr_read<v_rd_off(D0, 2, 0)>(vb), h2 = tr_read<v_rd_off(D0, 2, 1)>(vb), l3 = tr_read<v_rd_off(D0, 3, 0)>(vb), h3 = tr_read<v_rd_off(D0, 3, 1)>(vb);
  asm volatile("s_waitcnt lgkmcnt(0)" ::: "memory"); SBAR();
#define PK(L, H) (bf16x8){L[0], L[1], L[2], L[3], H[0], H[1], H[2], H[3]}
  od = __builtin_amdgcn_mfma_f32_32x32x16_bf16(pa0, PK(l0, h0), od, 0, 0, 0);
  od = __builtin_amdgcn_mfma_f32_32x32x16_bf16(pa1, PK(l1, h1), od, 0, 0, 0);
  od = __builtin_amdgcn_mfma_f32_32x32x16_bf16(pa2, PK(l2, h2), od, 0, 0, 0);
  od = __builtin_amdgcn_mfma_f32_32x32x16_bf16(pa3, PK(l3, h3), od, 0, 0, 0);
#undef PK
}
__device__ __forceinline__ void pv_d0(f32x16* o, int vb, bf16x8 pa0, bf16x8 pa1, bf16x8 pa2, bf16x8 pa3) {
  pv_one<0>(o[0], vb, pa0, pa1, pa2, pa3); pv_one<1>(o[1], vb, pa0, pa1, pa2, pa3); pv_one<2>(o[2], vb, pa0, pa1, pa2, pa3); pv_one<3>(o[3], vb, pa0, pa1, pa2, pa3);
}
constexpr int LDQ = 1536, LDK = 1024, LDV = 1024, LDKR = 64, LDO = 1024, SDEPTH = ATT_SDEPTH;
constexpr int SHM_V = KVBLK * 128 * 2, SHM_K = KVBLK * 128 * 2, SHM_KR = KVBLK * 64 * 2;
constexpr int SHM_QR = NW * 4 * 64 * 16;
constexpr int SHM_ATTN = 2 * SHM_V + 2 * SHM_K + 2 * SHM_KR + NW * 64 * 4 + SHM_QR;
__device__ __forceinline__ void attn_unit(const bf16* __restrict__ Qb, const bf16* __restrict__ Kh, const bf16* __restrict__ KRh, const bf16* __restrict__ Vh,
                                          bf16* __restrict__ Ob, int seq, char* lds) {
  using St = Stage<bf16>;
  const int tid = otid(), wid = tid >> 6, lane = tid & 63, r32 = lane & 31, hi = lane >> 5;
  bf16* V_lds = (bf16*)lds; bf16* K_lds = (bf16*)(lds + 2 * SHM_V); bf16* KR_lds = (bf16*)(lds + 2 * SHM_V + 2 * SHM_K);
  float* ws = (float*)(lds + 2 * SHM_V + 2 * SHM_K + 2 * SHM_KR) + wid * 64; float* li_l = ws; float* al_l = ws + 32;
  float m_reg = -1e30f, l_reg = 0; f32x16 o[4] = {}; bf16x8 qr[8];
  bf16x8* qrl = (bf16x8*)(lds + 2 * SHM_V + 2 * SHM_K + 2 * SHM_KR + NW * 64 * 4) + wid * 256 + lane;
  const bf16* Qw = Qb + (long)(wid * QBLK + r32) * LDQ + hi * 8;
#pragma unroll
  for (int d0 = 0; d0 < 8; ++d0) qr[d0] = St::ld8(Qw + d0 * 16);
#pragma unroll
  for (int d0 = 0; d0 < 4; ++d0) qrl[d0 * 64] = St::ld8(Qw + 128 + d0 * 16);
  const int sr = tid >> 4, sc = (tid & 15) * 8, vst0 = v_st(sr, sc), vst1 = v_st(32 + sr, sc);
  const int krr = tid >> 3, krc = (tid & 7) * 8;
  const int vb0 = (int)(uintptr_t)V_lds + v_rd_base(lane);
  struct { bf16x8 vs0, vs1, ks0, ks1, kr; } sr_[SDEPTH];
#define SLOAD(i, k0) do { sr_[i].vs0 = St::ld8(&Vh[(long)((k0) + sr) * LDV + sc]); sr_[i].vs1 = St::ld8(&Vh[(long)((k0) + 32 + sr) * LDV + sc]); \
    sr_[i].ks0 = St::ld8(&Kh[(long)((k0) + sr) * LDK + sc]); sr_[i].ks1 = St::ld8(&Kh[(long)((k0) + 32 + sr) * LDK + sc]); \
    sr_[i].kr = St::ld8(&KRh[(long)((k0) + krr) * LDKR + krc]); } while (0)
#define SWRITE(b, i) do { *(bf16x8*)((char*)V_lds + (b) * SHM_V + vst0) = sr_[i].vs0;          \
    *(bf16x8*)((char*)V_lds + (b) * SHM_V + vst1) = sr_[i].vs1; int kc = sc * 2;               \
    *(bf16x8*)((char*)K_lds + (b) * SHM_K + KSWZ(sr, kc)) = sr_[i].ks0;                       \
    *(bf16x8*)((char*)K_lds + (b) * SHM_K + KSWZ(32 + sr, kc)) = sr_[i].ks1;                  \
    *(bf16x8*)((char*)KR_lds + (b) * SHM_KR + KSWZ2(krr, krc * 2)) = sr_[i].kr; } while (0)
#define SWAIT() do { if constexpr (SDEPTH == 2) asm volatile("s_waitcnt vmcnt(5)" ::: "memory"); else asm volatile("s_waitcnt vmcnt(0)" ::: "memory"); } while (0)
#define RESC(a) do { if (__any((a) < 1.f)) { if (hi == 0) al_l[r32] = (a); asm volatile("s_waitcnt lgkmcnt(0)" ::: "memory"); \
    _Pragma("unroll") for (int d = 0; d < 4; ++d) _Pragma("unroll") for (int r = 0; r < 16; ++r) o[d][r] *= al_l[crow(r, hi)]; } } while (0)
  f32x16 pA0, pA1, pB0, pB1; float mnA, mnB, alA, alB; bf16x8 pa0, pa1, pa2, pa3; const int NT = seq / KVBLK;
  constexpr int SE = 0, SO = SDEPTH - 1;
  SLOAD(SE, 0); asm volatile("s_waitcnt vmcnt(0)" ::: "memory"); SWRITE(0, SE); __syncthreads();
  qkt(pA0, pA1, K_lds, KR_lds, qr, qrl, r32, hi); partialSM(pA0, pA1, m_reg, mnA, alA);
  SLOAD(SO, KVBLK); if constexpr (SDEPTH == 2) { if (2 < NT) SLOAD(SE, 2 * KVBLK); }
  SWAIT(); SWRITE(1, SO); __syncthreads();
  for (int j = 1; j + 1 < NT; j += 2) {
    SBAR(); qkt(pB0, pB1, (bf16*)((char*)K_lds + SHM_K), (bf16*)((char*)KR_lds + SHM_KR), qr, qrl, r32, hi);
    finishSM(pA0, pA1, alA, l_reg, pa0, pa1, pa2, pa3); SBAR();
    SLOAD(SO, (j + SDEPTH) * KVBLK); SBAR();
    pv_d0(o, vb0, pa0, pa1, pa2, pa3); partialSM(pB0, pB1, m_reg, mnB, alB);
    __syncthreads(); SWAIT(); SWRITE(0, SE);
    RESC(alB); __syncthreads();
    SBAR(); qkt(pA0, pA1, K_lds, KR_lds, qr, qrl, r32, hi);
    finishSM(pB0, pB1, alB, l_reg, pa0, pa1, pa2, pa3); SBAR();
    if (SDEPTH == 1 || j + 3 < NT) SLOAD(SE, (j + 1 + SDEPTH) * KVBLK); SBAR();
    pv_d0(o, vb0 + (int)SHM_V, pa0, pa1, pa2, pa3); partialSM(pA0, pA1, m_reg, mnA, alA);
    __syncthreads(); SWAIT(); SWRITE(1, SO);
    RESC(alA); __syncthreads();
  }
  SBAR(); qkt(pB0, pB1, (bf16*)((char*)K_lds + SHM_K), (bf16*)((char*)KR_lds + SHM_KR), qr, qrl, r32, hi);
  finishSM(pA0, pA1, alA, l_reg, pa0, pa1, pa2, pa3); SBAR();
  pv_d0(o, vb0, pa0, pa1, pa2, pa3); partialSM(pB0, pB1, m_reg, mnB, alB);
  __syncthreads(); RESC(alB);
  finishSM(pB0, pB1, alB, l_reg, pa0, pa1, pa2, pa3); SBAR();
  pv_d0(o, vb0 + (int)SHM_V, pa0, pa1, pa2, pa3);
  if (hi == 0) li_l[r32] = l_reg; asm volatile("s_waitcnt lgkmcnt(0)" ::: "memory");
  float rli[16];
#pragma unroll
  for (int r = 0; r < 16; ++r) rli[r] = __builtin_amdgcn_rcpf(li_l[crow(r, hi)]);
  bf16* Ow = Ob + (long)(wid * QBLK) * LDO;
#pragma unroll
  for (int r = 0; r < 16; ++r) { int orow = crow(r, hi);
#pragma unroll
    for (int d0 = 0; d0 < 4; ++d0) Ow[(long)orow * LDO + d0 * 32 + r32] = __float2bfloat16(o[d0][r] * rli[r]); }
  __syncthreads();
#undef SLOAD
#undef SWRITE
#undef SWAIT
#undef RESC
}
#undef SBAR
}
constexpr int BATCH = 4, SEQ = 8192, DM = 1024, DEPTH = 4, DFF = 2816, MT = BATCH * SEQ;
constexpr int NH = 8, QLR = 256, KVLR = 128, QKD = 192;
constexpr float EPS = 1e-6f;
constexpr size_t MiB = 1u << 20;
constexpr size_t WS_WFFI = 1 * MiB;
constexpr size_t WS_WFFO = 89 * MiB;
constexpr size_t WS_WHIN = 133 * MiB;
constexpr size_t WS_WHO  = 153 * MiB;
constexpr size_t WS_WMIN = 157 * MiB;
constexpr size_t WS_WUQ  = 159 * MiB;
constexpr size_t WS_WUKV = 161 * MiB;
constexpr size_t WS_WMO  = 162 * MiB;
constexpr size_t WS_COS  = 166 * MiB;
constexpr size_t WS_SIN  = 170 * MiB;
constexpr size_t WS_LB   = 174 * MiB;
constexpr size_t WS_HN   = 176 * MiB;
constexpr size_t WS_Y    = 240 * MiB;
constexpr size_t WS_YB   = 304 * MiB;
constexpr size_t WS_R    = 368 * MiB;
constexpr size_t WS_END  = 704 * MiB;
constexpr size_t R_ACT = 0;
constexpr size_t R_C = 0, R_QB = 0, R_CQ = 96 * MiB, R_CKV = 112 * MiB, R_KR = 120 * MiB, R_KN = 124 * MiB, R_VB = 188 * MiB, R_O = 252 * MiB;
constexpr size_t R_QH = 0, R_VH = 64 * MiB, R_GH = 128 * MiB, R_KF = 192 * MiB, R_HO = 0;

constexpr int LDS_RING = 131072, LDS_BYTES = LDS_RING + 2048;
typedef unsigned short bf16_t;
typedef float f32x4 __attribute__((ext_vector_type(4)));
typedef float f32x2 __attribute__((ext_vector_type(2)));
typedef unsigned u32x4 __attribute__((ext_vector_type(4)));
typedef unsigned u32x2 __attribute__((ext_vector_type(2)));
typedef _Float16 h16x2 __attribute__((ext_vector_type(2)));
#define LAS __attribute__((address_space(3)))

__device__ __constant__ double ROPE_INVF[32] = {1.0, 0.7498942093324559, 0.5623413251903491, 0.4216965034285822, 0.31622776601683794, 0.23713737056616552, 0.1778279410038923, 0.1333521432163324, 0.1, 0.07498942093324558, 0.05623413251903491, 0.042169650342858224, 0.03162277660168379, 0.023713737056616554, 0.01778279410038923, 0.01333521432163324, 0.01, 0.007498942093324558, 0.005623413251903491, 0.004216965034285823, 0.0031622776601683794, 0.0023713737056616554, 0.0017782794100389228, 0.001333521432163324, 0.001, 0.0007498942093324559, 0.0005623413251903491, 0.00042169650342858224, 0.00031622776601683794, 0.00023713737056616554, 0.00017782794100389227, 0.0001333521432163324};

__device__ __forceinline__ unsigned pk2(float lo, float hi) { return pg8::cvt_pk_bf16(lo, hi); }
__device__ __forceinline__ float silu_f(float g) { return g * __builtin_amdgcn_rcpf(1.0f + __expf(-g)); }
__device__ __forceinline__ float wave_sum(float v) {
#pragma unroll
    for (int o = 1; o < 64; o <<= 1) v += __shfl_xor(v, o);
    return v;
}
__device__ __forceinline__ float half_sum(float v) {
#pragma unroll
    for (int o = 1; o < 32; o <<= 1) v += __shfl_xor(v, o);
    return v;
}

using pg8::Unit;
struct EpiSwiglu { static constexpr bool PERM = true, AFTER_DRAIN = false; bf16_t* O;
    __device__ __forceinline__ void operator()(const pg8::f32x4 (&acc)[2][2][4][2], const Unit& u, int wr, int wc, int fr, int fq) const {
        const int row0 = u.pm * 256 + wr * 64 + fr, col0 = u.pn * 128 + wc * 32 + 8 * fq;
#pragma unroll
        for (int ai = 0; ai < 2; ++ai)
#pragma unroll
            for (int m = 0; m < 4; ++m) { bf16_t* p = O + (size_t)(row0 + ai * 128 + m * 16) * DFF + col0;
                const pg8::f32x4 g0 = acc[ai][0][m][0], g1 = acc[ai][0][m][1], u0 = acc[ai][1][m][0], u1 = acc[ai][1][m][1];
                u32x4 w; w.x = pk2(silu_f(g0[0]) * u0[0], silu_f(g0[1]) * u0[1]); w.y = pk2(silu_f(g0[2]) * u0[2], silu_f(g0[3]) * u0[3]);
                w.z = pk2(silu_f(g1[0]) * u1[0], silu_f(g1[1]) * u1[1]); w.w = pk2(silu_f(g1[2]) * u1[2], silu_f(g1[3]) * u1[3]);
                *(u32x4*)p = w; }
    }
};
struct EpiF32 { static constexpr bool PERM = false, AFTER_DRAIN = false; float* O; int ldc;
    __device__ __forceinline__ void operator()(const pg8::f32x4 (&acc)[2][2][4][2], const Unit& u, int wr, int wc, int fr, int fq) const {
        const int row0 = u.pm * 256 + wr * 64 + fr, col0 = u.pn * 256 + wc * 32 + 4 * fq;
#pragma unroll
        for (int ai = 0; ai < 2; ++ai)
#pragma unroll
            for (int m = 0; m < 4; ++m) { float* p = O + (size_t)(row0 + ai * 128 + m * 16) * ldc + col0;
#pragma unroll
                for (int bj = 0; bj < 2; ++bj)
#pragma unroll
                    for (int n = 0; n < 2; ++n) *(pg8::f32x4*)(p + bj * 128 + n * 16) = acc[ai][bj][m][n]; }
    }
};
struct EpiB16 { static constexpr bool PERM = true, AFTER_DRAIN = false; bf16_t* O; int ldc;
    __device__ __forceinline__ void operator()(const pg8::f32x4 (&acc)[2][2][4][2], const Unit& u, int wr, int wc, int fr, int fq) const {
        const int row0 = u.pm * 256 + wr * 64 + fr, col0 = u.pn * 256 + wc * 32 + 8 * fq;
#pragma unroll
        for (int ai = 0; ai < 2; ++ai)
#pragma unroll
            for (int m = 0; m < 4; ++m) { bf16_t* p = O + (size_t)(row0 + ai * 128 + m * 16) * ldc + col0;
#pragma unroll
                for (int bj = 0; bj < 2; ++bj) { const pg8::f32x4 v0 = acc[ai][bj][m][0], v1 = acc[ai][bj][m][1];
                    u32x4 w; w.x = pk2(v0[0], v0[1]); w.y = pk2(v0[2], v0[3]); w.z = pk2(v1[0], v1[1]); w.w = pk2(v1[2], v1[3]);
                    *(u32x4*)(p + bj * 128) = w; } }
    }
};
struct EpiQ { static constexpr bool PERM = true, AFTER_DRAIN = false; bf16_t* O; const float* cs; const float* sn;
    __device__ __forceinline__ void operator()(const pg8::f32x4 (&acc)[2][2][4][2], const Unit& u, int wr, int wc, int fr, int fq) const {
        const int row0 = u.pm * 256 + wr * 64 + fr;
#pragma unroll
        for (int bj = 0; bj < 2; ++bj) { const int col0 = u.pn * 256 + bj * 128 + wc * 32 + 8 * fq, d = col0 % QKD; const bool rot = d >= 128; const int i0 = (d - 128) >> 1;
#pragma unroll
            for (int ai = 0; ai < 2; ++ai)
#pragma unroll
                for (int m = 0; m < 4; ++m) { const int row = row0 + ai * 128 + m * 16; pg8::f32x4 v0 = acc[ai][bj][m][0], v1 = acc[ai][bj][m][1];
                    if (rot) { const pg8::f32x4 c = *(const pg8::f32x4*)(cs + (size_t)row * 32 + i0), s = *(const pg8::f32x4*)(sn + (size_t)row * 32 + i0);
                        pg8::f32x4 a, b; a[0] = v0[0] * c[0] - v0[1] * s[0]; a[1] = v0[0] * s[0] + v0[1] * c[0]; a[2] = v0[2] * c[1] - v0[3] * s[1]; a[3] = v0[2] * s[1] + v0[3] * c[1];
                        b[0] = v1[0] * c[2] - v1[1] * s[2]; b[1] = v1[0] * s[2] + v1[1] * c[2]; b[2] = v1[2] * c[3] - v1[3] * s[3]; b[3] = v1[2] * s[3] + v1[3] * c[3]; v0 = a; v1 = b; }
                    u32x4 w; w.x = pk2(v0[0], v0[1]); w.y = pk2(v0[2], v0[3]); w.z = pk2(v1[0], v1[1]); w.w = pk2(v1[2], v1[3]);
                    *(u32x4*)(O + (size_t)row * 1536 + col0) = w; } }
    }
};
struct EpiKV { static constexpr bool PERM = true, AFTER_DRAIN = false; bf16_t* Kn; bf16_t* Vb;
    __device__ __forceinline__ void operator()(const pg8::f32x4 (&acc)[2][2][4][2], const Unit& u, int wr, int wc, int fr, int fq) const {
        const int row0 = u.pm * 256 + wr * 64 + fr, col0 = u.pn * 128 + wc * 32 + 8 * fq;
#pragma unroll
        for (int bj = 0; bj < 2; ++bj) { bf16_t* base = bj ? Vb : Kn;
#pragma unroll
            for (int ai = 0; ai < 2; ++ai)
#pragma unroll
                for (int m = 0; m < 4; ++m) { const pg8::f32x4 v0 = acc[ai][bj][m][0], v1 = acc[ai][bj][m][1];
                    u32x4 w; w.x = pk2(v0[0], v0[1]); w.y = pk2(v0[2], v0[3]); w.z = pk2(v1[0], v1[1]); w.w = pk2(v1[2], v1[3]);
                    *(u32x4*)(base + (size_t)(row0 + ai * 128 + m * 16) * 1024 + col0) = w; } }
    }
};
__device__ __forceinline__ unsigned pkh2(float a, float b) { const h16x2 h = {(_Float16)a, (_Float16)b}; return __builtin_bit_cast(unsigned, h); }
__device__ __forceinline__ float kgate(float om, float z) { return om * __builtin_amdgcn_rcpf(1.0f + __expf(z)); }
struct EpiHgrn { static constexpr bool PERM = true, AFTER_DRAIN = false; bf16_t* Qh; bf16_t* Vh; bf16_t* Gh; unsigned short* KF; const float* lb;
    __device__ __forceinline__ void operator()(const pg8::f32x4 (&acc)[2][2][4][2], const Unit& u, int wr, int wc, int fr, int fq) const {
        const int row0 = u.pm * 256 + wr * 64 + fr, seg = u.pn >> 2;
#pragma unroll
        for (int bj = 0; bj < 2; ++bj) { const int cc = (u.pn & 3) * 256 + bj * 128 + wc * 32 + 8 * fq;
            if (seg == 1 || seg == 2) {
                const pg8::f32x4 om0 = 1.0f - *(const pg8::f32x4*)(lb + (seg - 1) * 1024 + cc), om1 = 1.0f - *(const pg8::f32x4*)(lb + (seg - 1) * 1024 + cc + 4);
                unsigned short* base = KF + (size_t)(seg - 1) * MT * 1024;
#pragma unroll
                for (int ai = 0; ai < 2; ++ai)
#pragma unroll
                    for (int m = 0; m < 4; ++m) { const size_t off = (size_t)(row0 + ai * 128 + m * 16) * 1024 + cc; const pg8::f32x4 v0 = acc[ai][bj][m][0], v1 = acc[ai][bj][m][1];
                        u32x4 w; w.x = pkh2(kgate(om0[0], v0[0]), kgate(om0[1], v0[1])); w.y = pkh2(kgate(om0[2], v0[2]), kgate(om0[3], v0[3]));
                        w.z = pkh2(kgate(om1[0], v1[0]), kgate(om1[1], v1[1])); w.w = pkh2(kgate(om1[2], v1[2]), kgate(om1[3], v1[3]));
                        *(u32x4*)(base + off) = w; }
            } else if (seg == 3) {
#pragma unroll
                for (int ai = 0; ai < 2; ++ai)
#pragma unroll
                    for (int m = 0; m < 4; ++m) { const size_t off = (size_t)(row0 + ai * 128 + m * 16) * 1024 + cc; const pg8::f32x4 v0 = acc[ai][bj][m][0], v1 = acc[ai][bj][m][1];
                        u32x4 w; w.x = pk2(v0[0], v0[1]); w.y = pk2(v0[2], v0[3]); w.z = pk2(v1[0], v1[1]); w.w = pk2(v1[2], v1[3]);
                        *(u32x4*)(Vh + off) = w; }
            } else { bf16_t* base = seg == 0 ? Qh : Gh;
#pragma unroll
                for (int ai = 0; ai < 2; ++ai)
#pragma unroll
                    for (int m = 0; m < 4; ++m) { const size_t off = (size_t)(row0 + ai * 128 + m * 16) * 1024 + cc; const pg8::f32x4 v0 = acc[ai][bj][m][0], v1 = acc[ai][bj][m][1];
                        u32x4 w; w.x = pk2(silu_f(v0[0]), silu_f(v0[1])); w.y = pk2(silu_f(v0[2]), silu_f(v0[3])); w.z = pk2(silu_f(v1[0]), silu_f(v1[1])); w.w = pk2(silu_f(v1[2]), silu_f(v1[3]));
                        *(u32x4*)(base + off) = w; } } }
    }
};

__device__ __forceinline__ int src_col(int mode, int n) {
    if (mode == 1) { const int t = n >> 8, j = n & 255; return j < 128 ? t * 128 + j : DFF + t * 128 + (j - 128); }
    if (mode == 2) { if (n < 384) return n; if (n >= 448) return -1; const int j = n - 384; return 384 + (j >> 1) + 32 * (j & 1); }
    if (mode == 3) { const int h = n / QKD, d = n % QKD; if (d < 128) return n; const int j = d - 128; return h * QKD + 128 + (j >> 1) + 32 * (j & 1); }
    return n;
}
__device__ __forceinline__ void xpose_item(const float* __restrict__ W, int K, int Nsrc, int Ndst, int mode, bf16_t* __restrict__ WT, LAS float* scr, int item, int lane) {
    const int nblk = Ndst / 32, kb = item / nblk, nb = item % nblk, k0 = 64 * kb, n0 = 32 * nb;
    const int sc = src_col(mode, n0 + (lane & 31));
#pragma unroll 8
    for (int i = 0; i < 32; ++i) { const int kk = 2 * i + (lane >> 5); scr[kk * 33 + (lane & 31)] = sc >= 0 ? W[(size_t)(k0 + kk) * Nsrc + sc] : 0.f; }
    asm volatile("s_waitcnt lgkmcnt(0)" ::: "memory");
    const int c = lane & 7;
#pragma unroll
    for (int j = 0; j < 4; ++j) { const int n = (lane >> 3) + 8 * j; const LAS float* s = scr + (8 * c) * 33 + n;
        u32x4 o; o.x = pk2(s[0 * 33], s[1 * 33]); o.y = pk2(s[2 * 33], s[3 * 33]); o.z = pk2(s[4 * 33], s[5 * 33]); o.w = pk2(s[6 * 33], s[7 * 33]);
        *(u32x4*)(WT + (size_t)(n0 + n) * K + k0 + 8 * c) = o; }
    asm volatile("s_waitcnt lgkmcnt(0)" ::: "memory");
}

__device__ __forceinline__ void row_init(const float* __restrict__ xin, float* __restrict__ X, bf16_t* __restrict__ HN, const float* __restrict__ g, int lane) {
    const f32x4* xr = (const f32x4*)xin + lane; f32x4 v[4]; float s = 0.f;
#pragma unroll
    for (int j = 0; j < 4; ++j) { v[j] = xr[64 * j]; s += (v[j][0] * v[j][0] + v[j][1] * v[j][1]) + (v[j][2] * v[j][2] + v[j][3] * v[j][3]); }
    const float r = rsqrtf(wave_sum(s) * (1.f / DM) + EPS);
#pragma unroll
    for (int j = 0; j < 4; ++j) { ((f32x4*)X + lane)[64 * j] = v[j]; const f32x4 gg = ((const f32x4*)g + lane)[64 * j];
        u32x2 w; w.x = pk2(v[j][0] * r * gg[0], v[j][1] * r * gg[1]); w.y = pk2(v[j][2] * r * gg[2], v[j][3] * r * gg[3]); ((u32x2*)HN + lane)[64 * j] = w; }
}
__device__ __forceinline__ void row_post(const bf16_t* __restrict__ Y, float* __restrict__ X, bf16_t* __restrict__ HN, float scale, const float* __restrict__ gp, const float* __restrict__ gn, int lane) {
    f32x4 y[4], x[4]; float s = 0.f;
#pragma unroll
    for (int j = 0; j < 4; ++j) { const u32x2 yb = ((const u32x2*)Y + lane)[64 * j]; y[j] = (f32x4){__uint_as_float(yb.x << 16), __uint_as_float(yb.x & 0xffff0000u), __uint_as_float(yb.y << 16), __uint_as_float(yb.y & 0xffff0000u)};
        x[j] = ((const f32x4*)X + lane)[64 * j]; s += (y[j][0] * y[j][0] + y[j][1] * y[j][1]) + (y[j][2] * y[j][2] + y[j][3] * y[j][3]); }
    const float r = rsqrtf(wave_sum(s) * (1.f / DM) + EPS) * scale; float s2 = 0.f;
#pragma unroll
    for (int j = 0; j < 4; ++j) { const f32x4 gg = ((const f32x4*)gp + lane)[64 * j]; x[j] = x[j] + y[j] * r * gg; ((f32x4*)X + lane)[64 * j] = x[j];
        s2 += (x[j][0] * x[j][0] + x[j][1] * x[j][1]) + (x[j][2] * x[j][2] + x[j][3] * x[j][3]); }
    if (HN) { const float r2 = rsqrtf(wave_sum(s2) * (1.f / DM) + EPS);
#pragma unroll
        for (int j = 0; j < 4; ++j) { const f32x4 gg = ((const f32x4*)gn + lane)[64 * j];
            u32x2 w; w.x = pk2(x[j][0] * r2 * gg[0], x[j][1] * r2 * gg[1]); w.y = pk2(x[j][2] * r2 * gg[2], x[j][3] * r2 * gg[3]); ((u32x2*)HN + lane)[64 * j] = w; } }
}
__device__ __forceinline__ void row_mla(const float* __restrict__ C, bf16_t* __restrict__ CQ, bf16_t* __restrict__ CKV, bf16_t* __restrict__ KR, const float* __restrict__ qn, const float* __restrict__ kvn,
                                        const float* __restrict__ cs, const float* __restrict__ sn, int lane) {
    const f32x4 a = ((const f32x4*)C)[2 * lane], b = ((const f32x4*)C)[2 * lane + 1];
    float s = (a[0] * a[0] + a[1] * a[1]) + (a[2] * a[2] + a[3] * a[3]) + (b[0] * b[0] + b[1] * b[1]) + (b[2] * b[2] + b[3] * b[3]);
#pragma unroll
    for (int o = 1; o < 16; o <<= 1) s += __shfl_xor(s, o);
    const float s16 = s, s32 = s16 + __shfl_xor(s16, 16);
    float v[8] = {a[0], a[1], a[2], a[3], b[0], b[1], b[2], b[3]};
    if (lane < 32) { const float r = rsqrtf(s32 * (1.f / QLR) + EPS); const f32x4 g0 = ((const f32x4*)qn)[2 * lane], g1 = ((const f32x4*)qn)[2 * lane + 1];
        u32x4 w; w.x = pk2(v[0] * r * g0[0], v[1] * r * g0[1]); w.y = pk2(v[2] * r * g0[2], v[3] * r * g0[3]); w.z = pk2(v[4] * r * g1[0], v[5] * r * g1[1]); w.w = pk2(v[6] * r * g1[2], v[7] * r * g1[3]);
        ((u32x4*)CQ)[lane] = w;
    } else if (lane < 48) { const int l = lane - 32; const float r = rsqrtf(s16 * (1.f / KVLR) + EPS); const f32x4 g0 = ((const f32x4*)kvn)[2 * l], g1 = ((const f32x4*)kvn)[2 * l + 1];
        u32x4 w; w.x = pk2(v[0] * r * g0[0], v[1] * r * g0[1]); w.y = pk2(v[2] * r * g0[2], v[3] * r * g0[3]); w.z = pk2(v[4] * r * g1[0], v[5] * r * g1[1]); w.w = pk2(v[6] * r * g1[2], v[7] * r * g1[3]);
        ((u32x4*)CKV)[l] = w;
    } else if (lane < 56) { const int l = lane - 48; const f32x4 c = ((const f32x4*)cs)[l], sv = ((const f32x4*)sn)[l];
        u32x4 w; w.x = pk2(v[0] * c[0] - v[1] * sv[0], v[0] * sv[0] + v[1] * c[0]); w.y = pk2(v[2] * c[1] - v[3] * sv[1], v[2] * sv[1] + v[3] * c[1]);
        w.z = pk2(v[4] * c[2] - v[5] * sv[2], v[4] * sv[2] + v[5] * c[2]); w.w = pk2(v[6] * c[3] - v[7] * sv[3], v[6] * sv[3] + v[7] * c[3]);
        ((u32x4*)KR)[l] = w; }
}
__device__ __forceinline__ void row_hgrn(const bf16_t* __restrict__ Oa, const bf16_t* __restrict__ Gh, bf16_t* __restrict__ HO, const float* __restrict__ on, int lane) {
#pragma unroll
    for (int j = 0; j < 4; ++j) { const u32x2 a = ((const u32x2*)Oa + lane)[64 * j], b = ((const u32x2*)(Oa + (size_t)MT * 1024) + lane)[64 * j];
        f32x4 o; o[0] = __uint_as_float(a.x << 16) + __uint_as_float(b.x << 16); o[1] = __uint_as_float(a.x & 0xffff0000u) + __uint_as_float(b.x & 0xffff0000u);
        o[2] = __uint_as_float(a.y << 16) + __uint_as_float(b.y << 16); o[3] = __uint_as_float(a.y & 0xffff0000u) + __uint_as_float(b.y & 0xffff0000u);
        const float s = half_sum((o[0] * o[0] + o[1] * o[1]) + (o[2] * o[2] + o[3] * o[3]));
        const float r = rsqrtf(s * (1.f / 128.f) + EPS); const f32x4 gg = ((const f32x4*)on + lane)[64 * j]; const u32x2 gb = ((const u32x2*)Gh + lane)[64 * j];
        const float g0 = __uint_as_float(gb.x << 16), g1 = __uint_as_float(gb.x & 0xffff0000u), g2 = __uint_as_float(gb.y << 16), g3 = __uint_as_float(gb.y & 0xffff0000u);
        u32x2 w; w.x = pk2(o[0] * r * gg[0] * g0, o[1] * r * gg[1] * g1); w.y = pk2(o[2] * r * gg[2] * g2, o[3] * r * gg[3] * g3); ((u32x2*)HO + lane)[64 * j] = w; }
}
__device__ __forceinline__ f32x2 h2f2_(unsigned u) { const h16x2 h = __builtin_bit_cast(h16x2, u); return (f32x2){(float)h[0], (float)h[1]}; }
__device__ __forceinline__ void scan_phase(LAS unsigned char* lds, const bf16_t* __restrict__ Qh, const bf16_t* __restrict__ Vh, const unsigned short* __restrict__ KF, bf16_t* __restrict__ OP, int G, int bx) {
    int tid = threadIdx.x; asm volatile("" : "+v"(tid)); const int wid = __builtin_amdgcn_readfirstlane(tid >> 6), lane = tid & 63;
    const int st = tid >> 4, sc8 = (tid & 15) * 8, sv = tid >> 3, vc4 = (tid & 7) * 4;
    constexpr int OFF_K = 16384, OFF_Q = 32768, OFF_V = 49152, OFF_P = 53248;
    for (int item = bx; item < 256; item += G) {
        const int dir = item & 1, dvq = (item >> 1) & 3, h = (item >> 3) & 7, b = item >> 6;
        const size_t kcol = h * 128 + sc8, vcol = h * 128 + dvq * 32 + vc4;
        const unsigned short* KFd = KF + (size_t)dir * MT * 1024; bf16_t* OPd = OP + (size_t)dir * MT * 1024;
        u32x4 rk, rq; u32x2 rv = {0u, 0u};
#define SC_GLOAD(blk) do { { const int tt = (blk) * 32 + st; const size_t m = (size_t)b * SEQ + (dir ? SEQ - 1 - tt : tt); \
        rk = *(const u32x4*)(KFd + m * 1024 + kcol); rq = *(const u32x4*)(Qh + m * 1024 + kcol); } \
        if (tid < 256) { const int tt = (blk) * 32 + sv; const size_t m = (size_t)b * SEQ + (dir ? SEQ - 1 - tt : tt); rv = *(const u32x2*)(Vh + m * 1024 + vcol); } } while (0)
#define SC_H2F(u_) h2f2_(u_)
#define SC_LWRITE() do { LAS unsigned char* B_ = lds + (st * 128 + sc8) * 4; \
        const f32x2 ka = SC_H2F(rk.x), kb = SC_H2F(rk.y), kc = SC_H2F(rk.z), kd = SC_H2F(rk.w); \
        const f32x4 k0_ = {ka[0], ka[1], kb[0], kb[1]}, k1_ = {kc[0], kc[1], kd[0], kd[1]}; \
        *(LAS f32x4*)(B_ + OFF_K) = k0_; *(LAS f32x4*)(B_ + OFF_K + 16) = k1_; \
        *(LAS f32x4*)(B_ + OFF_Q) = (f32x4){__uint_as_float(rq.x << 16), __uint_as_float(rq.x & 0xffff0000u), __uint_as_float(rq.y << 16), __uint_as_float(rq.y & 0xffff0000u)}; \
        *(LAS f32x4*)(B_ + OFF_Q + 16) = (f32x4){__uint_as_float(rq.z << 16), __uint_as_float(rq.z & 0xffff0000u), __uint_as_float(rq.w << 16), __uint_as_float(rq.w & 0xffff0000u)}; \
        if (tid < 256) *(LAS f32x4*)(lds + OFF_V + (sv * 32 + vc4) * 4) = (f32x4){__uint_as_float(rv.x << 16), __uint_as_float(rv.x & 0xffff0000u), __uint_as_float(rv.y << 16), __uint_as_float(rv.y & 0xffff0000u)}; } while (0)
        SC_GLOAD(0);
        const int dksub = ((lane >> 3) & 1) | ((lane >> 5) << 1), dvp = (lane & 7) | (((lane >> 4) & 1) << 3);
        const LAS unsigned char* Bc = lds + (16 * wid + 4 * dksub) * 4;
        const LAS unsigned char* Vc = lds + OFF_V + dvp * 8;
        LAS unsigned char* Pw = lds + OFF_P + (wid * 4 + dksub) * 2048 + dvp * 4;
        f32x2 S2[4];
#pragma unroll
        for (int j = 0; j < 4; ++j) S2[j] = (f32x2){0.f, 0.f};
        for (int blk = 0; blk < SEQ / 32; ++blk) {
            SC_LWRITE();
            if (blk + 1 < SEQ / 32) SC_GLOAD(blk + 1);
            __syncthreads();
            f32x4 k4n = *(const LAS f32x4*)(Bc + OFF_K), q4n = *(const LAS f32x4*)(Bc + OFF_Q); f32x2 v2n = *(const LAS f32x2*)(Vc);
            f32x4 k4m = *(const LAS f32x4*)(Bc + OFF_K + 512), q4m = *(const LAS f32x4*)(Bc + OFF_Q + 512); f32x2 v2m = *(const LAS f32x2*)(Vc + 128);
#pragma unroll
            for (int t = 0; t < 32; ++t) {
                const f32x4 k4 = k4n, q4 = q4n; const f32x2 v2 = v2n;
                k4n = k4m; q4n = q4m; v2n = v2m;
                { const int tn = (t + 2) & 31;
                  k4m = *(const LAS f32x4*)(Bc + OFF_K + tn * 512); q4m = *(const LAS f32x4*)(Bc + OFF_Q + tn * 512); v2m = *(const LAS f32x2*)(Vc + tn * 128); }
                __builtin_amdgcn_sched_barrier(0);
#pragma unroll
                for (int j = 0; j < 4; ++j) S2[j] = S2[j] + (v2 - S2[j]) * k4[j];
                const f32x2 o2 = (S2[0] * q4[0] + S2[1] * q4[1]) + (S2[2] * q4[2] + S2[3] * q4[3]);
                *(LAS unsigned*)(Pw + t * 64) = pk2(o2[0], o2[1]);
            }
            __syncthreads();
            if (tid < 256) { const LAS unsigned char* Pr = lds + OFF_P + (sv * 32 + vc4) * 2; f32x4 acc = {0.f, 0.f, 0.f, 0.f};
#pragma unroll
              for (int g = 0; g < 32; ++g) { const u32x2 pv = *(const LAS u32x2*)(Pr + g * 2048);
                  acc[0] += __uint_as_float(pv.x << 16); acc[1] += __uint_as_float(pv.x & 0xffff0000u); acc[2] += __uint_as_float(pv.y << 16); acc[3] += __uint_as_float(pv.y & 0xffff0000u); }
              const int tt = blk * 32 + sv; const size_t m = (size_t)b * SEQ + (dir ? SEQ - 1 - tt : tt);
              u32x2 w; w.x = pk2(acc[0], acc[1]); w.y = pk2(acc[2], acc[3]); *(u32x2*)(OPd + m * 1024 + vcol) = w; }
        }
        __syncthreads();
#undef SC_GLOAD
#undef SC_LWRITE
#undef SC_H2F
    }
}

typedef float f32x16 __attribute__((ext_vector_type(16)));
typedef short s16x8 __attribute__((ext_vector_type(8)));
__device__ __forceinline__ int crow_(int r, int hi) { return (r & 3) + 8 * (r >> 2) + 4 * hi; }
template <int KSTEPS>
__device__ __forceinline__ void mm_tile(f32x16& c, const LAS unsigned char* X, int xstride, const LAS unsigned char* Y, int ystride, int r32, int hi) {
#pragma unroll
    for (int i = 0; i < KSTEPS; ++i) { const s16x8 x = *(const LAS s16x8*)(X + r32 * xstride + (16 * i + 8 * hi) * 2), y = *(const LAS s16x8*)(Y + r32 * ystride + (16 * i + 8 * hi) * 2);
        c = __builtin_amdgcn_mfma_f32_32x32x16_bf16(x, y, c, 0, 0, 0); }
}
__device__ __forceinline__ void scan_phase_mfma(LAS unsigned char* lds, const bf16_t* __restrict__ Qh, const bf16_t* __restrict__ Vh, const unsigned short* __restrict__ KF, bf16_t* __restrict__ OP, int G, int bx) {
    int tid = threadIdx.x; asm volatile("" : "+v"(tid)); const int wid = __builtin_amdgcn_readfirstlane(tid >> 6), lane = tid & 63, r32 = lane & 31, hi = lane >> 5;
    const int st = tid >> 4, sc8 = (tid & 15) * 8, sv = tid >> 3, vc4 = (tid & 7) * 4;
    constexpr int SQ = 272, SV = 80;
    constexpr int O_LG = 0, O_QT = 16384, O_KT = O_QT + 32 * SQ, O_KTT = O_KT + 32 * SQ, O_VT = O_KTT + 128 * SV, O_AT = O_VT + 2 * 32 * SV, O_ST = O_AT + 32 * SV, O_G = O_ST + 32 * SQ;
    static_assert(O_G + 512 <= LDS_RING, "scan LDS map");
    for (int item = bx; item < 256; item += G) {
        const int dir = item & 1, dvq = (item >> 1) & 3, h = (item >> 3) & 7, b = item >> 6;
        const size_t kcol = h * 128 + sc8, vcol = h * 128 + dvq * 32 + vc4;
        const unsigned short* KFd = KF + (size_t)dir * MT * 1024; bf16_t* OPd = OP + (size_t)dir * MT * 1024;
        u32x4 rk, rq, nk, nq; u32x2 rv = {0u, 0u}, nv = {0u, 0u};
#define SM_GLOAD(K_, Q_, V_, blk) do { { const int tt = (blk) * 32 + st; const size_t m = (size_t)b * SEQ + (dir ? SEQ - 1 - tt : tt); \
        K_ = *(const u32x4*)(KFd + m * 1024 + kcol); Q_ = *(const u32x4*)(Qh + m * 1024 + kcol); } \
        if (tid < 256) { const int tt = (blk) * 32 + sv; const size_t m = (size_t)b * SEQ + (dir ? SEQ - 1 - tt : tt); V_ = *(const u32x2*)(Vh + m * 1024 + vcol); } } while (0)
        SM_GLOAD(rk, rq, rv, 0);
        f32x16 accS;
#pragma unroll
        for (int r = 0; r < 16; ++r) accS[r] = 0.f;
        for (int i = tid; i < 32 * SQ / 4; i += 512) ((LAS unsigned*)(lds + O_ST))[i] = 0u;
        for (int blk = 0; blk < SEQ / 32; ++blk) {
            const LAS unsigned char* VTc = lds + O_VT + (blk & 1) * 32 * SV;
            f32x4 k0, k1;
            { const f32x2 ka = h2f2_(rk.x), kb = h2f2_(rk.y), kc = h2f2_(rk.z), kd = h2f2_(rk.w); k0 = (f32x4){ka[0], ka[1], kb[0], kb[1]}; k1 = (f32x4){kc[0], kc[1], kd[0], kd[1]}; }
            { f32x4 a0, a1;
#pragma unroll
              for (int e = 0; e < 4; ++e) { a0[e] = __builtin_amdgcn_logf(1.0f - k0[e]); a1[e] = __builtin_amdgcn_logf(1.0f - k1[e]); }
              LAS unsigned char* L_ = lds + O_LG + (st * 128 + sc8) * 4; *(LAS f32x4*)(L_) = a0; *(LAS f32x4*)(L_ + 16) = a1; }
            if (tid < 256) { LAS unsigned char* V_ = lds + O_VT + (blk & 1) * 32 * SV + sv * 2;
                *(LAS unsigned short*)(V_ + (vc4 + 0) * SV) = (unsigned short)(rv.x & 0xffffu); *(LAS unsigned short*)(V_ + (vc4 + 1) * SV) = (unsigned short)(rv.x >> 16);
                *(LAS unsigned short*)(V_ + (vc4 + 2) * SV) = (unsigned short)(rv.y & 0xffffu); *(LAS unsigned short*)(V_ + (vc4 + 3) * SV) = (unsigned short)(rv.y >> 16); }
            if (blk + 1 < SEQ / 32) SM_GLOAD(nk, nq, nv, blk + 1);
            __syncthreads();
            { LAS float* col = (LAS float*)(lds + O_LG) + (tid & 127) + (tid >> 7) * 8 * 128; float acc = 0.f;
#pragma unroll
                for (int t = 0; t < 8; ++t) { acc += col[t * 128]; col[t * 128] = acc; } }
            __syncthreads();
            { const LAS unsigned char* L_ = lds + O_LG + (st * 128 + sc8) * 4; f32x4 b0 = *(const LAS f32x4*)(L_), b1 = *(const LAS f32x4*)(L_ + 16);
#pragma unroll
              for (int qd = 0; qd < 3; ++qd) { const LAS unsigned char* T_ = lds + O_LG + ((8 * qd + 7) * 128 + sc8) * 4; const float m_ = (st >> 3) > qd ? 1.f : 0.f;
                  b0 = b0 + *(const LAS f32x4*)(T_) * m_; b1 = b1 + *(const LAS f32x4*)(T_ + 16) * m_; }
              float qv[8] = {__uint_as_float(rq.x << 16), __uint_as_float(rq.x & 0xffff0000u), __uint_as_float(rq.y << 16), __uint_as_float(rq.y & 0xffff0000u),
                             __uint_as_float(rq.z << 16), __uint_as_float(rq.z & 0xffff0000u), __uint_as_float(rq.w << 16), __uint_as_float(rq.w & 0xffff0000u)};
              float qs[8], ks[8];
#pragma unroll
              for (int e = 0; e < 4; ++e) { const float e0 = __builtin_amdgcn_exp2f(b0[e]), e1 = __builtin_amdgcn_exp2f(b1[e]);
                  qs[e] = qv[e] * e0; qs[4 + e] = qv[4 + e] * e1; ks[e] = k0[e] * __builtin_amdgcn_exp2f(-b0[e]); ks[4 + e] = k1[e] * __builtin_amdgcn_exp2f(-b1[e]);
                  if (st == 31) { ((LAS float*)(lds + O_G))[sc8 + e] = e0; ((LAS float*)(lds + O_G))[sc8 + 4 + e] = e1; } }
              u32x4 qw, kw; qw.x = pk2(qs[0], qs[1]); qw.y = pk2(qs[2], qs[3]); qw.z = pk2(qs[4], qs[5]); qw.w = pk2(qs[6], qs[7]);
              kw.x = pk2(ks[0], ks[1]); kw.y = pk2(ks[2], ks[3]); kw.z = pk2(ks[4], ks[5]); kw.w = pk2(ks[6], ks[7]);
              *(LAS u32x4*)(lds + O_QT + st * SQ + sc8 * 2) = qw; *(LAS u32x4*)(lds + O_KT + st * SQ + sc8 * 2) = kw;
              LAS unsigned char* T_ = lds + O_KTT + sc8 * SV + st * 2;
              *(LAS unsigned short*)(T_ + 0 * SV) = (unsigned short)(kw.x & 0xffffu); *(LAS unsigned short*)(T_ + 1 * SV) = (unsigned short)(kw.x >> 16);
              *(LAS unsigned short*)(T_ + 2 * SV) = (unsigned short)(kw.y & 0xffffu); *(LAS unsigned short*)(T_ + 3 * SV) = (unsigned short)(kw.y >> 16);
              *(LAS unsigned short*)(T_ + 4 * SV) = (unsigned short)(kw.z & 0xffffu); *(LAS unsigned short*)(T_ + 5 * SV) = (unsigned short)(kw.z >> 16);
              *(LAS unsigned short*)(T_ + 6 * SV) = (unsigned short)(kw.w & 0xffffu); *(LAS unsigned short*)(T_ + 7 * SV) = (unsigned short)(kw.w >> 16); }
            __syncthreads();
            f32x16 accO;
            if (wid < 4) { mm_tile<2>(accS, lds + O_KTT + wid * 32 * SV, SV, VTc, SV, r32, hi); }
            else if (wid == 4) { f32x16 p;
#pragma unroll
                for (int r = 0; r < 16; ++r) p[r] = 0.f;
                mm_tile<8>(p, lds + O_QT, SQ, lds + O_KT, SQ, r32, hi);
#pragma unroll
                for (int r = 0; r < 16; ++r) { const int t = crow_(r, hi); const float pv = r32 <= t ? p[r] : 0.f;
                    *(LAS unsigned short*)(lds + O_AT + t * SV + r32 * 2) = (unsigned short)(pk2(pv, 0.f) & 0xffffu); } }
            else if (wid == 5) {
#pragma unroll
                for (int r = 0; r < 16; ++r) accO[r] = 0.f;
                mm_tile<8>(accO, lds + O_QT, SQ, lds + O_ST, SQ, r32, hi); }
            __syncthreads();
            if (wid < 4) {
#pragma unroll
                for (int g = 0; g < 4; ++g) { const int dk0 = 32 * wid + 8 * g + 4 * hi; const f32x4 gm = *(const LAS f32x4*)(lds + O_G + dk0 * 4);
                    accS[4 * g + 0] *= gm[0]; accS[4 * g + 1] *= gm[1]; accS[4 * g + 2] *= gm[2]; accS[4 * g + 3] *= gm[3];
                    u32x2 w; w.x = pk2(accS[4 * g + 0], accS[4 * g + 1]); w.y = pk2(accS[4 * g + 2], accS[4 * g + 3]);
                    *(LAS u32x2*)(lds + O_ST + r32 * SQ + dk0 * 2) = w; } }
            else if (wid == 5) { mm_tile<2>(accO, lds + O_AT, SV, VTc, SV, r32, hi);
#pragma unroll
                for (int r = 0; r < 16; ++r) { const int tt = blk * 32 + crow_(r, hi); const size_t m = (size_t)b * SEQ + (dir ? SEQ - 1 - tt : tt);
                    OPd[m * 1024 + h * 128 + dvq * 32 + r32] = (bf16_t)(pk2(accO[r], 0.f) & 0xffffu); } }
            rk = nk; rq = nq; rv = nv;
        }
        __syncthreads();
#undef SM_GLOAD
    }
}

enum Op { OP_SW0, OP_FO0, OP_RPA, OP_MIN, OP_RMLA, OP_QKV, OP_ATTN, OP_MWO, OP_RPB, OP_SW1, OP_FO1, OP_RPC, OP_HIN, OP_SCAN, OP_RHG, OP_HWO };
__device__ const unsigned char OPS_M[12] = {OP_SW0, OP_FO0, OP_RPA, OP_MIN, OP_RMLA, OP_QKV, OP_ATTN, OP_MWO, OP_RPB, OP_SW1, OP_FO1, OP_RPC};
__device__ const unsigned char OPS_H[11] = {OP_SW0, OP_FO0, OP_RPA, OP_HIN, OP_SCAN, OP_RHG, OP_HWO, OP_RPB, OP_SW1, OP_FO1, OP_RPC};

struct Args { const float* in[15]; float* out; unsigned char* ws; };
typedef const __attribute__((address_space(4))) Args* ArgsP;
__device__ __forceinline__ ArgsP get_args() { ArgsP p = (ArgsP)__builtin_amdgcn_kernarg_segment_ptr(); asm volatile("" : "+s"(p) :: "memory"); return p; }
#define GW_ ((int)blockIdx.x * 8 + __builtin_amdgcn_readfirstlane((int)threadIdx.x >> 6))
#define NGW_ ((int)gridDim.x * 8)
__device__ __forceinline__ int otid_() { int t = threadIdx.x; asm volatile("" : "+v"(t)); return t; }
#define LANE_ (otid_() & 63)

#ifdef DBG_CHECKS
__device__ __forceinline__ float bf2f(bf16_t v) { return __uint_as_float((unsigned)v << 16); }
__device__ __forceinline__ unsigned hash_u(unsigned x) { x ^= x >> 16; x *= 0x7feb352du; x ^= x >> 15; x *= 0x846ca68bu; x ^= x >> 16; return x; }
__device__ __forceinline__ void dbg_report(unsigned* DBG, int id, float got, float ref, float rtol, float atol) {
    const float err = fabsf(got - ref); const bool bad = !(err <= rtol * fabsf(ref) + atol);
    if (bad) atomicMax(DBG + id, 1u);
}
__device__ __forceinline__ int dbg_row(int sidx) { if (sidx == 0) return 0; if (sidx == 1) return MT - 1; if (sidx == 2) return SEQ - 1; if (sidx == 3) return SEQ; return (int)(hash_u(sidx * 2654435761u + 17u) % MT); }
#endif
#ifdef DBG_CHECKS
struct DbgCtx { const float* const* in; unsigned char* ws; unsigned char* R; unsigned* DBG; int bx, tid, lane, wave; };
__device__ __forceinline__ float dbg_dot_bf_w(const bf16_t* a, const float* W, int K, int ldw, int col) { float s = 0.f; for (int k = 0; k < K; ++k) s += bf2f(a[k]) * W[(size_t)k * ldw + col]; return s; }
template <class A>
__device__ __forceinline__ void dbg_after(int l, int op, A ap, unsigned char* ws, unsigned char* R, LAS unsigned char* lds) {
    unsigned* DBG = (unsigned*)(ws + 32768);
    const int bx = blockIdx.x, tid = otid_(), lane = tid & 63, wave = __builtin_amdgcn_readfirstlane(tid >> 6);
    const bf16_t* HN = (const bf16_t*)(ws + WS_HN); const float* Y = (const float*)(ws + WS_Y);
    if (false && l == 0 && op == OP_SW0 && bx < 32) { const int sid = bx * 512 + tid, m = dbg_row(sid), c = hash_u(sid * 3 + 1) % DFF; const float* W = ap->in[3];
        const float g = dbg_dot_bf_w(HN + (size_t)m * 1024, W, 1024, 2 * DFF, c), u = dbg_dot_bf_w(HN + (size_t)m * 1024, W, 1024, 2 * DFF, DFF + c);
        dbg_report(DBG, 1, bf2f(((const bf16_t*)(R + R_ACT))[(size_t)m * DFF + c]), g / (1.f + expf(-g)) * u, 0.015f, 0.004f); }
    if (false && l == 0 && op == OP_FO0 && bx < 32) { const int sid = bx * 512 + tid, m = dbg_row(sid), c = hash_u(sid * 3 + 2) % 1024;
        const float r = dbg_dot_bf_w((const bf16_t*)(R + R_ACT) + (size_t)m * DFF, ap->in[4], DFF, 1024, c);
        dbg_report(DBG, 2, Y[(size_t)m * 1024 + c], r, 0.015f, 0.004f); }
    if (false && l == 0 && op == OP_RPA && bx < 32) { const int sid = bx * 512 + tid, m = dbg_row(sid), c = hash_u(sid * 3 + 3) % 1024; const float* g = ap->in[2];
        float s = 0.f; for (int k = 0; k < 1024; ++k) { const float y = Y[(size_t)m * 1024 + k]; s += y * y; }
        const float xr = ap->in[0][(size_t)m * 1024 + c] + 0.5f * Y[(size_t)m * 1024 + c] * rsqrtf(s / 1024.f + EPS) * g[1024 + c];
        dbg_report(DBG, 2, ap->out[(size_t)m * 1024 + c], xr, 1e-3f, 1e-3f);
        float s2 = 0.f; for (int k = 0; k < 1024; ++k) { const float x = ap->out[(size_t)m * 1024 + k]; s2 += x * x; }
        dbg_report(DBG, 2, bf2f(HN[(size_t)m * 1024 + c]), ap->out[(size_t)m * 1024 + c] * rsqrtf(s2 / 1024.f + EPS) * g[2048 + c], 0.01f, 0.01f); }
    if (false && l == 0 && op == OP_MIN && bx < 32) { const int sid = bx * 512 + tid, m = dbg_row(sid), c = hash_u(sid * 3 + 4) % 512; const int sc = src_col(2, c);
        const float r = sc >= 0 ? dbg_dot_bf_w(HN + (size_t)m * 1024, ap->in[5], 1024, 448, sc) : 0.f;
        dbg_report(DBG, 3, ((const float*)(R + R_C))[(size_t)m * 512 + c], r, 0.015f, 0.01f); }
    if (false && l == 0 && op == OP_RMLA && bx < 32) { const int sid = bx * 512 + tid, m = dbg_row(sid), c = hash_u(sid * 3 + 5) % 448; const float* C = (const float*)(R + R_C) + (size_t)m * 512;
        if (c < 256) { float s = 0.f; for (int k = 0; k < 256; ++k) s += C[k] * C[k];
            dbg_report(DBG, 3, bf2f(((const bf16_t*)(R + R_CQ))[(size_t)m * 256 + c]), C[c] * rsqrtf(s / 256.f + EPS) * ap->in[6][c], 0.01f, 0.01f); }
        else if (c < 384) { float s = 0.f; for (int k = 256; k < 384; ++k) s += C[k] * C[k];
            dbg_report(DBG, 3, bf2f(((const bf16_t*)(R + R_CKV))[(size_t)m * 128 + c - 256]), C[c] * rsqrtf(s / 128.f + EPS) * ap->in[7][c - 256], 0.01f, 0.01f); }
        else { const int jj = c - 384, i = jj >> 1; const float ang = (float)((const int*)ap->in[1])[m] * powf(10000.f, -(float)i / 32.f); const float cs = cosf(ang), sn = sinf(ang);
            const float t1 = C[384 + 2 * i], t2 = C[384 + 2 * i + 1]; const float r = (jj & 1) ? t1 * sn + t2 * cs : t1 * cs - t2 * sn;
            dbg_report(DBG, 3, bf2f(((const bf16_t*)(R + R_KR))[(size_t)m * 64 + jj]), r, 0.02f, 0.05f); } }
    if (false && l == 0 && op == OP_QKV && bx < 32) { const int sid = bx * 512 + tid, m = dbg_row(sid); const bf16_t* CQ = (const bf16_t*)(R + R_CQ) + (size_t)m * 256; const bf16_t* CKV = (const bf16_t*)(R + R_CKV) + (size_t)m * 128;
        { const int c = hash_u(sid * 3 + 6) % 1536, h = c / QKD, d = c % QKD; float r;
          if (d < 128) r = dbg_dot_bf_w(CQ, ap->in[8], 256, 1536, c);
          else { const int jj = d - 128, i = jj >> 1; const float t1 = dbg_dot_bf_w(CQ, ap->in[8], 256, 1536, h * QKD + 128 + i), t2 = dbg_dot_bf_w(CQ, ap->in[8], 256, 1536, h * QKD + 160 + i);
              const float ang = (float)((const int*)ap->in[1])[m] * powf(10000.f, -(float)i / 32.f); const float cs = cosf(ang), sn = sinf(ang); r = (jj & 1) ? t1 * sn + t2 * cs : t1 * cs - t2 * sn; }
          dbg_report(DBG, 4, bf2f(((const bf16_t*)(R + R_QB))[(size_t)m * 1536 + c]), r, 0.015f, 0.015f); }
        { const int c = hash_u(sid * 3 + 7) % 2048, h = c >> 8, d = c & 255; const float r = dbg_dot_bf_w(CKV, ap->in[9], 128, 2048, c);
          const float got = d < 128 ? bf2f(((const bf16_t*)(R + R_KN))[(size_t)m * 1024 + h * 128 + d]) : bf2f(((const bf16_t*)(R + R_VB))[(size_t)m * 1024 + h * 128 + d - 128]);
          dbg_report(DBG, 5, got, r, 0.015f, 0.015f); } }
    if (l == 0 && op == OP_ATTN) { const int sid = bx * 8 + wave, m = dbg_row(sid), h = hash_u(sid * 5 + 1) & 7, dv = hash_u(sid * 5 + 2) & 127, b = m / SEQ;
        LAS float* qs = (LAS float*)lds + wave * 192; const bf16_t* Q = (const bf16_t*)(R + R_QB) + (size_t)m * 1536 + h * QKD;
        for (int d = lane; d < 192; d += 64) qs[d] = bf2f(Q[d]);
        asm volatile("s_waitcnt lgkmcnt(0)" ::: "memory");
        float mx = -1e30f, ls = 0.f, acc = 0.f;
        for (int kk = lane; kk < SEQ; kk += 64) { const size_t km = (size_t)b * SEQ + kk; const bf16_t* Kn = (const bf16_t*)(R + R_KN) + km * 1024 + h * 128; const bf16_t* Kr = (const bf16_t*)(R + R_KR) + km * 64;
            float s = 0.f; for (int d = 0; d < 128; ++d) s += qs[d] * bf2f(Kn[d]); for (int d = 0; d < 64; ++d) s += qs[128 + d] * bf2f(Kr[d]);
            s *= 0.07216878364870322f; const float v = bf2f(((const bf16_t*)(R + R_VB))[km * 1024 + h * 128 + dv]);
            const float mn = fmaxf(mx, s), al = expf(mx - mn), p = expf(s - mn); ls = ls * al + p; acc = acc * al + p * v; mx = mn; }
        float gm = mx;
        for (int o = 1; o < 64; o <<= 1) gm = fmaxf(gm, __shfl_xor(gm, o));
        const float sc = expf(mx - gm); const float L = wave_sum(ls * sc), Asum = wave_sum(acc * sc);
        if (lane == 0) { const float got = bf2f(((const bf16_t*)(R + R_O))[(size_t)m * 1024 + h * 128 + dv]), ref = Asum / L; atomicMax(DBG + 20, __float_as_uint(fabsf(got - ref))); atomicAdd((float*)(DBG + 21), fabsf(ref) * (1.f / 2048.f)); } }
    if (false && l == 1 && op == OP_HIN && bx < 32) { const int sid = bx * 512 + tid, m = dbg_row(sid), c5 = hash_u(sid * 3 + 8) % 5120, seg = c5 >> 10, c = c5 & 1023;
        const float u = dbg_dot_bf_w(HN + (size_t)m * 1024, ap->in[11], 1024, 5120, c5); float got, r;
        if (seg == 0) { got = bf2f(((const bf16_t*)(R + R_QH))[(size_t)m * 1024 + c]); r = u / (1.f + expf(-u)); }
        else if (seg == 3) { got = bf2f(((const bf16_t*)(R + R_VH))[(size_t)m * 1024 + c]); r = u; }
        else if (seg == 4) { got = bf2f(((const bf16_t*)(R + R_GH))[(size_t)m * 1024 + c]); r = u / (1.f + expf(-u)); }
        else { const int dir = seg - 1; const float* lbp = ap->in[12] + (size_t)dir * DEPTH * 1024 + c; const float e0 = expf(lbp[0]), e1 = expf(lbp[1024]), e2 = expf(lbp[2048]), e3 = expf(lbp[3072]);
            const float lb = e1 / (e0 + e1 + e2 + e3); const h16x2 hv = __builtin_bit_cast(h16x2, (unsigned)((const unsigned short*)(R + R_KF))[(size_t)dir * MT * 1024 + (size_t)m * 1024 + c]);
            got = (float)hv[0]; r = (1.f - lb) / (1.f + expf(u)); }
        dbg_report(DBG, 7, got, r, 0.015f, 0.006f); }
    if (false && l == 1 && op == OP_SCAN) { const int sid = bx * 8 + wave, h = hash_u(sid * 5 + 3) & 7, dv = hash_u(sid * 5 + 4) & 127, b = hash_u(sid * 5 + 5) & 3, toff = sid & 31, dir = 0;
        const bf16_t* Qh = (const bf16_t*)(R + R_QH); const bf16_t* Vh = (const bf16_t*)(R + R_VH); const unsigned short* KF = (const unsigned short*)(R + R_KF); const bf16_t* OPb = (const bf16_t*)(ws + WS_Y);
        float S0 = 0.f, S1 = 0.f; const int n = toff + 1; const int t = toff; const size_t m = (size_t)b * SEQ + t;
        for (int i = 0; i < n; ++i) { const int tt = i; const size_t mm = (size_t)b * SEQ + tt; const unsigned short* kp = KF + (size_t)dir * MT * 1024 + mm * 1024 + h * 128;
            const h16x2 ka = __builtin_bit_cast(h16x2, (unsigned)kp[lane]), kb = __builtin_bit_cast(h16x2, (unsigned)kp[lane + 64]); const float k0 = (float)ka[0], k1 = (float)kb[0];
            const float v = bf2f(Vh[mm * 1024 + h * 128 + dv]); S0 = S0 * (1.f - k0) + k0 * v; S1 = S1 * (1.f - k1) + k1 * v; }
        const bf16_t* q = Qh + m * 1024 + h * 128; const float tot = wave_sum(S0 * bf2f(q[lane]) + S1 * bf2f(q[lane + 64]));
        if (lane == 0) { const float got = bf2f(OPb[(size_t)dir * MT * 1024 + m * 1024 + h * 128 + dv]); const float re = fabsf(got - tot) / (fabsf(tot) + 0.05f);
            if (re > 0.05f) { atomicMin(DBG + 20, (unsigned)toff); atomicAdd(DBG + 21, 1u); } } }
    if (false && l == 1 && op == OP_RHG && bx < 32) { const int sid = bx * 512 + tid, m = dbg_row(sid), c = hash_u(sid * 3 + 9) % 1024, h0 = c & ~127; const bf16_t* OPb = (const bf16_t*)(ws + WS_Y);
        float s = 0.f; for (int k = 0; k < 128; ++k) { const float y = bf2f(OPb[(size_t)m * 1024 + h0 + k]) + bf2f(OPb[(size_t)MT * 1024 + (size_t)m * 1024 + h0 + k]); s += y * y; }
        const float yc = bf2f(OPb[(size_t)m * 1024 + c]) + bf2f(OPb[(size_t)MT * 1024 + (size_t)m * 1024 + c]);
        const float r = yc * rsqrtf(s / 128.f + EPS) * ap->in[13][c] * bf2f(((const bf16_t*)(R + R_GH))[(size_t)m * 1024 + c]);
        dbg_report(DBG, 9, bf2f(((const bf16_t*)(R + R_HO))[(size_t)m * 1024 + c]), r, 0.02f, 0.005f); }
    if (false && l == 1 && op == OP_HWO && bx < 32) { const int sid = bx * 512 + tid, m = dbg_row(sid), c = hash_u(sid * 3 + 10) % 1024;
        const float r = dbg_dot_bf_w((const bf16_t*)(R + R_HO) + (size_t)m * 1024, ap->in[14], 1024, 1024, c);
        dbg_report(DBG, 9, Y[(size_t)m * 1024 + c], r, 0.03f, 0.01f); }
    if (false && l == 0 && op == OP_MWO && bx < 32) { const int sid = bx * 512 + tid, m = dbg_row(sid), c = hash_u(sid * 3 + 11) % 1024;
        const float r = dbg_dot_bf_w((const bf16_t*)(R + R_O) + (size_t)m * 1024, ap->in[10], 1024, 1024, c);
        dbg_report(DBG, 6, Y[(size_t)m * 1024 + c], r, 0.02f, 0.0004f); }
}
#endif

__device__ __forceinline__ void gsync_cg() {
    asm volatile("s_waitcnt vmcnt(0) lgkmcnt(0)" ::: "memory");
    __syncthreads();
    cg::this_grid().sync();
    if (threadIdx.x == 0) { __builtin_amdgcn_fence(__ATOMIC_ACQUIRE, "agent"); asm volatile("s_waitcnt vmcnt(0)" ::: "memory"); }
    __syncthreads();
}
#define GAS __attribute__((address_space(1)))
#define XB_TMO      128
#define XB_XCNT(j)  (256  + 64 * (j))
#define XB_XSUB(j)  (1280 + 64 * (j))
#define XB_XGEN(j)  (2304 + 64 * (j))
#define XB_TOP      3328
#define XB_TOPGEN   3392
#define XCD_BAR_WORDS 3456
#define XB_SPIN_CAP (1u << 18)

__device__ __forceinline__ unsigned xb_ld(unsigned* p)              { return __hip_atomic_load(p, __ATOMIC_RELAXED, __HIP_MEMORY_SCOPE_AGENT); }
__device__ __forceinline__ unsigned xb_add(unsigned* p, unsigned v) { return __hip_atomic_fetch_add(p, v, __ATOMIC_RELAXED, __HIP_MEMORY_SCOPE_AGENT); }
__device__ __forceinline__ unsigned xb_xcc_id() { return (unsigned)__builtin_amdgcn_s_getreg((3 << 11) | 20) & 0xFu; }
#define XB_SPIN(cond, bar) do { unsigned _sp = 0; while (cond) { __builtin_amdgcn_s_sleep(1); \
    if ((++_sp & 255u) == 0u) { if (xb_ld(&(bar)[XB_TMO])) break; if (_sp > XB_SPIN_CAP) { atomicAdd(&(bar)[XB_TMO], 1u); break; } } } } while (0)

struct XcdBarrier {
    unsigned* bar; unsigned x;
    volatile LAS unsigned* st;
};

__device__ __forceinline__ XcdBarrier xcd_barrier_post(unsigned* bar, volatile LAS unsigned* st) {
    XcdBarrier b; b.bar = bar; b.x = xb_xcc_id(); b.st = st;
    if (threadIdx.x == 0) (void)xb_add(&bar[XB_XCNT(b.x)], 1u);
    return b;
}
__device__ __forceinline__ void xcd_barrier_complete(unsigned* bar, unsigned x, unsigned& nloc, unsigned& nx) {
    const unsigned G = gridDim.x * gridDim.y * gridDim.z;
    unsigned sum, cnt, mine, sp = 0u;
    for (;;) {
        sum = 0u; cnt = 0u; mine = 0u;
#pragma unroll
        for (unsigned j = 0; j < 16; ++j) { const unsigned c = xb_ld(&bar[XB_XCNT(j)]); sum += c; cnt += (c > 0u) ? 1u : 0u; mine = (j == x) ? c : mine; }
        if (sum == G) break;
        __builtin_amdgcn_s_sleep(1);
        if ((++sp & 255u) == 0u) { if (xb_ld(&bar[XB_TMO])) break; if (sp > XB_SPIN_CAP) { atomicAdd(&bar[XB_TMO], 1u); break; } }
    }
    nloc = mine > 0u ? mine : 1u; nx = cnt > 0u ? cnt : 1u;
}

__device__ __forceinline__ void xcd_barrier(const XcdBarrier& b) {
    asm volatile("s_waitcnt vmcnt(0)" ::: "memory");
    __syncthreads();
    if (threadIdx.x == 0) {
        unsigned* bar = b.bar;
        __builtin_amdgcn_s_waitcnt(0);
        unsigned nloc = b.st[0], nx = b.st[1];
        if (nloc == 0u) { xcd_barrier_complete(bar, b.x, nloc, nx); b.st[0] = nloc; b.st[1] = nx; }
        const unsigned old = xb_add(&bar[XB_XSUB(b.x)], 1u);
        const unsigned gen = old / nloc;
        if (old + 1u == (gen + 1u) * nloc) {
            __builtin_amdgcn_fence(__ATOMIC_RELEASE, "agent");
            asm volatile("s_waitcnt vmcnt(0)" ::: "memory");
            const unsigned og = xb_add(&bar[XB_TOP], 1u);
            const unsigned tg = og / nx;
            if (og + 1u == (tg + 1u) * nx) xb_add(&bar[XB_TOPGEN], 1u);
            else XB_SPIN(xb_ld(&bar[XB_TOPGEN]) == tg, bar);
            __builtin_amdgcn_fence(__ATOMIC_ACQUIRE, "agent");
            xb_add(&bar[XB_XGEN(b.x)], 1u);
            asm volatile("s_waitcnt vmcnt(0)" ::: "memory");
        } else {
            XB_SPIN(xb_ld(&bar[XB_XGEN(b.x)]) == gen, bar);
            __builtin_amdgcn_fence(__ATOMIC_ACQUIRE, "agent");
            asm volatile("s_waitcnt vmcnt(0)" ::: "memory");
        }
    }
    __syncthreads();
}

__device__ __forceinline__ void gsync(LAS unsigned char* lds) {
#ifdef USE_CG_SYNC
    gsync_cg();
#else
    XcdBarrier b; b.bar = (unsigned*)get_args()->ws; b.x = xb_xcc_id(); b.st = (volatile LAS unsigned*)(lds + LDS_RING);
    xcd_barrier(b);
#endif
}
__global__ void __launch_bounds__(512, 2) mega_fwd(Args a_unused) {
    extern __shared__ __attribute__((aligned(16))) unsigned char lds_raw[];
    LAS unsigned char* lds = (LAS unsigned char*)lds_raw;

    if (threadIdx.x < 2) ((volatile LAS unsigned*)(lds + LDS_RING))[threadIdx.x] = 0u;
    __syncthreads();
    (void)xcd_barrier_post((unsigned*)get_args()->ws, (volatile LAS unsigned*)(lds + LDS_RING));
    {
        ArgsP ap = get_args(); unsigned char* ws = ap->ws;
#ifdef DBG_CHECKS
        if (blockIdx.x == 0 && threadIdx.x < 32) atomicExch((unsigned*)ws + threadIdx.x, 0u);
#endif
        const int tid = threadIdx.x, lane = tid & 63, wave = __builtin_amdgcn_readfirstlane(tid >> 6), G = gridDim.x, bx = blockIdx.x, gw = bx * 8 + wave, NGW = G * 8;
        LAS float* scr = (LAS float*)(lds + wave * 16384);
        constexpr int I_FFI = 16 * 176, I_FFO = 44 * 32, I_HIN = 16 * 160, I_SQ = 16 * 32, I_MIN = 16 * 16, I_UQ = 4 * 48, I_UKV = 2 * 64;
        constexpr int NITEMS = 8 * I_FFI + 8 * I_FFO + 2 * I_HIN + 2 * I_SQ + 2 * I_MIN + 2 * I_UQ + 2 * I_UKV + 2 * I_SQ;
        for (int it = gw; it < NITEMS; it += NGW) {
            int r = it;
#define XP(IDX_, K_, NS_, ND_, MODE_, WSOFF_, NMAT_, IPM_) if (r < (NMAT_) * (IPM_)) { const int mat = r / (IPM_); \
            xpose_item(ap->in[IDX_] + (size_t)mat * (K_) * (NS_), K_, NS_, ND_, MODE_, (bf16_t*)(ws + (WSOFF_)) + (size_t)mat * (ND_) * (K_), scr, r % (IPM_), lane); continue; } r -= (NMAT_) * (IPM_);
            XP(3, 1024, 2 * DFF, 2 * DFF, 1, WS_WFFI, 8, I_FFI)
            XP(4, DFF, 1024, 1024, 0, WS_WFFO, 8, I_FFO)
            XP(11, 1024, 5120, 5120, 0, WS_WHIN, 2, I_HIN)
            XP(14, 1024, 1024, 1024, 0, WS_WHO, 2, I_SQ)
            XP(5, 1024, 448, 512, 2, WS_WMIN, 2, I_MIN)
            XP(8, 256, 1536, 1536, 3, WS_WUQ, 2, I_UQ)
            XP(9, 128, 2048, 2048, 0, WS_WUKV, 2, I_UKV)
            XP(10, 1024, 1024, 1024, 0, WS_WMO, 2, I_SQ)
#undef XP
        }
        { const int* positions = (const int*)ap->in[1]; float* COS = (float*)(ws + WS_COS); float* SIN = (float*)(ws + WS_SIN);
          for (int idx = bx * 512 + tid; idx < MT * 32; idx += G * 512) { const int m = idx >> 5, i = idx & 31;
            const double ang = (double)positions[m] * ROPE_INVF[i]; const double rev = ang * 0.15915494309189535; const float fr = (float)(rev - __builtin_rint(rev));
            COS[idx] = __builtin_amdgcn_cosf(fr); SIN[idx] = __builtin_amdgcn_sinf(fr); } }
        { float* LB = (float*)(ws + WS_LB);
          for (int idx = bx * 512 + tid; idx < 2 * 2 * 1024; idx += G * 512) { const int c = idx & 1023, dir = (idx >> 10) & 1, j = idx >> 11, l = 2 * j + 1;
            const float* lbp = ap->in[12] + (size_t)dir * DEPTH * 1024 + c; float v[4], mx = -1e30f;
#pragma unroll
            for (int i = 0; i < 4; ++i) { v[i] = lbp[i * 1024]; mx = fmaxf(mx, v[i]); }
            float den = 0.f, num = 0.f;
#pragma unroll
            for (int i = 0; i < 4; ++i) { const float e = __expf(v[i] - mx); den += e; if (i >= 1 && i <= l) num += e; }
            LB[idx] = num / den; } }
        { const float* x_in = ap->in[0]; float* X = ap->out; bf16_t* HN = (bf16_t*)(ws + WS_HN); const float* gains = ap->in[2];
          for (int m = gw; m < MT; m += NGW) row_init(x_in + (size_t)m * DM, X + (size_t)m * DM, HN + (size_t)m * DM, gains, lane); }
    }
    gsync_cg();

    for (int ph = 0; ph < 46; ++ph) {
        const int l = ph >= 35 ? 3 : (ph >= 23 ? 2 : (ph >= 12 ? 1 : 0)), s = ph - (l == 3 ? 35 : (l == 2 ? 23 : (l == 1 ? 12 : 0)));
        const bool hg = l & 1; const int j = l >> 1;
        const int op = hg ? OPS_H[s] : OPS_M[s];
        ArgsP ap = get_args(); unsigned char* ws = ap->ws; unsigned char* R = ws + WS_R;
        int G_ = gridDim.x, bx_ = blockIdx.x; asm volatile("" : "+s"(G_), "+s"(bx_));
        switch (op) {
        case OP_SW0: case OP_SW1: {
            const int half = op == OP_SW1;
            pg8::Gemm gm{(const bf16_t*)(ws + WS_HN), (const bf16_t*)(ws + WS_WFFI) + (size_t)(l * 2 + half) * (2 * DFF) * 1024, MT, 2 * DFF, 1024};
            pg8::StaticOrder S; S.init(MT, 2 * DFF, G_, bx_); EpiSwiglu E{(bf16_t*)(R + R_ACT)};
#ifndef NO_SW
            pg8::gemm_phase<EpiSwiglu, pg8::StaticOrder, true, true>(lds, gm, S, E);
#endif
        } break;
        case OP_MIN: {
            pg8::Gemm gm{(const bf16_t*)(ws + WS_HN), (const bf16_t*)(ws + WS_WMIN) + (size_t)j * 512 * 1024, MT, 512, 1024}; EpiF32 E{(float*)(R + R_C), 512};
            pg8::StaticOrder S; S.init(MT, 512, G_, bx_);
#ifndef NO_F32
            pg8::gemm_phase<EpiF32, pg8::StaticOrder, true, true>(lds, gm, S, E);
#endif
        } break;
        case OP_FO0: case OP_FO1: case OP_MWO: case OP_HWO: {
            pg8::Gemm gm; EpiB16 E{(bf16_t*)(ws + WS_YB), 1024};
            if (op == OP_FO0 || op == OP_FO1) { const int half = op == OP_FO1; gm = pg8::Gemm{(const bf16_t*)(R + R_ACT), (const bf16_t*)(ws + WS_WFFO) + (size_t)(l * 2 + half) * 1024 * DFF, MT, 1024, DFF}; }
            else if (op == OP_MWO) { gm = pg8::Gemm{(const bf16_t*)(R + R_O), (const bf16_t*)(ws + WS_WMO) + (size_t)j * 1024 * 1024, MT, 1024, 1024}; }
            else { gm = pg8::Gemm{(const bf16_t*)(R + R_HO), (const bf16_t*)(ws + WS_WHO) + (size_t)j * 1024 * 1024, MT, 1024, 1024}; }
            pg8::StaticOrder S; S.init(MT, 1024, G_, bx_);
            pg8::gemm_phase<EpiB16, pg8::StaticOrder, true, true>(lds, gm, S, E);
        } break;
        case OP_RPA: case OP_RPB: case OP_RPC: {
            const float* gains = ap->in[2]; const float* g = gains + (size_t)l * 6 * DM; const bf16_t* Y = (const bf16_t*)(ws + WS_YB); float* X = ap->out; bf16_t* HN = (bf16_t*)(ws + WS_HN);
            const int k = op == OP_RPA ? 1 : (op == OP_RPB ? 3 : 5); const float scale = op == OP_RPB ? 1.0f : 0.5f;
            const bool last = (op == OP_RPC) && (l == DEPTH - 1);
            const float* gn = op == OP_RPC ? gains + (size_t)(l + 1) * 6 * DM : g + (size_t)(k + 1) * DM;
            const int lane = LANE_;
            for (int m = bx_ * 8 + __builtin_amdgcn_readfirstlane(otid_() >> 6); m < MT; m += G_ * 8) row_post(Y + (size_t)m * DM, X + (size_t)m * DM, last ? (bf16_t*)nullptr : HN + (size_t)m * DM, scale, g + (size_t)k * DM, last ? g : gn, lane);
        } break;
        case OP_RMLA: {
            const float* qn = ap->in[6] + (size_t)j * QLR; const float* kvn = ap->in[7] + (size_t)j * KVLR; const float* COS = (const float*)(ws + WS_COS); const float* SIN = (const float*)(ws + WS_SIN);
            const int lane = LANE_;
            for (int m = bx_ * 8 + __builtin_amdgcn_readfirstlane(otid_() >> 6); m < MT; m += G_ * 8) row_mla((const float*)(R + R_C) + (size_t)m * 512, (bf16_t*)(R + R_CQ) + (size_t)m * 256, (bf16_t*)(R + R_CKV) + (size_t)m * 128, (bf16_t*)(R + R_KR) + (size_t)m * 64,
                                                         qn, kvn, COS + (size_t)m * 32, SIN + (size_t)m * 32, lane);
        } break;
        case OP_QKV: {
            { int Kq = 256; asm volatile("" : "+s"(Kq)); pg8::Gemm gm{(const bf16_t*)(R + R_CQ), (const bf16_t*)(ws + WS_WUQ) + (size_t)j * 1536 * 256, MT, 1536, Kq};
              pg8::StaticOrder S; S.init(MT, 1536, G_, bx_); EpiQ E{(bf16_t*)(R + R_QB), (const float*)(ws + WS_COS), (const float*)(ws + WS_SIN)};
#ifndef NO_Q
              pg8::gemm_phase<EpiQ, pg8::StaticOrder, true, true>(lds, gm, S, E);
#endif
            }
            __syncthreads();
            { int Kq = 128; asm volatile("" : "+s"(Kq)); pg8::Gemm gm{(const bf16_t*)(R + R_CKV), (const bf16_t*)(ws + WS_WUKV) + (size_t)j * 2048 * 128, MT, 2048, Kq};
              pg8::StaticOrder S; S.init(MT, 2048, G_, bx_); EpiKV E{(bf16_t*)(R + R_KN), (bf16_t*)(R + R_VB)};
#ifndef NO_KV
              pg8::gemm_phase<EpiKV, pg8::StaticOrder, true, true>(lds, gm, S, E);
#endif
            }
        } break;
        case OP_ATTN: {
#ifndef NO_ATTN
            const int G = G_, bx = bx_;

            const int vcu = (G % 8 == 0) ? (bx % 8) * (G / 8) + bx / 8 : bx;
#ifdef REP_ATTN
            for (int rep_ = 0; rep_ < 2; ++rep_)
#endif
            for (int uid = vcu; uid < BATCH * NH * (SEQ / 256); uid += G) {
                const int bh = uid >> 5, qb = uid & 31, b = bh >> 3, h = bh & 7;
                const size_t row0 = (size_t)b * SEQ;
                att::attn_unit((const att::bf16*)(R + R_QB) + (row0 + qb * 256) * 1536 + h * QKD, (const att::bf16*)(R + R_KN) + row0 * 1024 + h * 128,
                               (const att::bf16*)(R + R_KR) + row0 * 64, (const att::bf16*)(R + R_VB) + row0 * 1024 + h * 128,
                               (att::bf16*)(R + R_O) + (row0 + qb * 256) * 1024 + h * 128, SEQ, (char*)lds_raw);
            }
#endif
        } break;
        case OP_HIN: {
            pg8::Gemm gm{(const bf16_t*)(ws + WS_HN), (const bf16_t*)(ws + WS_WHIN) + (size_t)j * 5120 * 1024, MT, 5120, 1024};
            pg8::StaticOrder S; S.init(MT, 5120, G_, bx_);
            EpiHgrn E{(bf16_t*)(R + R_QH), (bf16_t*)(R + R_VH), (bf16_t*)(R + R_GH), (unsigned short*)(R + R_KF), (const float*)(ws + WS_LB) + (size_t)j * 2048};
#ifndef NO_HG
            pg8::gemm_phase<EpiHgrn, pg8::StaticOrder, true, true>(lds, gm, S, E);
#endif
        } break;
        case OP_SCAN: {
#ifndef NO_SCAN
#ifdef REP_SCAN
            scan_phase(lds, (const bf16_t*)(R + R_QH), (const bf16_t*)(R + R_VH), (const unsigned short*)(R + R_KF), (bf16_t*)(ws + WS_Y), G_, bx_); __syncthreads();
#endif
#ifdef SCAN_VALU
            scan_phase(lds, (const bf16_t*)(R + R_QH), (const bf16_t*)(R + R_VH), (const unsigned short*)(R + R_KF), (bf16_t*)(ws + WS_Y), G_, bx_);
#else
            scan_phase_mfma(lds, (const bf16_t*)(R + R_QH), (const bf16_t*)(R + R_VH), (const unsigned short*)(R + R_KF), (bf16_t*)(ws + WS_Y), G_, bx_);
#endif
#endif
        } break;
        case OP_RHG: {
            const float* on = ap->in[13] + (size_t)j * DM; const bf16_t* Y = (const bf16_t*)(ws + WS_Y);
            const int lane = LANE_;
            for (int m = bx_ * 8 + __builtin_amdgcn_readfirstlane(otid_() >> 6); m < MT; m += G_ * 8) row_hgrn(Y + (size_t)m * DM, (const bf16_t*)(R + R_GH) + (size_t)m * DM, (bf16_t*)(R + R_HO) + (size_t)m * DM, on, lane);
        } break;
        default: break;
        }
        if (ph != 45) gsync(lds);
#ifdef REP_SYNC
        gsync(lds);
#endif
#ifdef DBG_CHECKS
        { ArgsP ap2 = get_args(); dbg_after(l, op, ap2, ap2->ws, ap2->ws + WS_R, lds); gsync(lds); }
#endif
    }
#ifdef DBG_CHECKS
    gsync(lds);
    if (blockIdx.x == 0 && threadIdx.x == 0) { ArgsP ap = get_args(); unsigned* DBG = (unsigned*)ap->ws; const float mx = __uint_as_float(atomicAdd(DBG + 20, 0u)), mean = atomicAdd((float*)(DBG + 21), 0.f); ap->out[1024 * 16] += 1e6f * mx; ap->out[1024 * 16 + 1] += 1e4f * mean; }
#endif
}

extern "C" void kernel_launch(void* const* d_in, const int* in_sizes, int n_in, void* d_out, int out_size, void* d_ws, size_t ws_size, hipStream_t stream) {
    static int grid = 0;
    if (grid == 0) {
        if (n_in != 15 || out_size != MT * DM || ws_size < WS_END) { fprintf(stderr, "kernel_launch: unexpected shapes: n_in %d out %d ws %zu (need %zu)\n", n_in, out_size, ws_size, (size_t)WS_END); grid = -1; return; }
        int dev = 0, cus = 0, per_cu = 0;
        (void)hipGetDevice(&dev); (void)hipDeviceGetAttribute(&cus, hipDeviceAttributeMultiprocessorCount, dev);
        if (hipFuncSetAttribute((const void*)mega_fwd, hipFuncAttributeMaxDynamicSharedMemorySize, LDS_BYTES) != hipSuccess) { fprintf(stderr, "kernel_launch: hipFuncSetAttribute failed\n"); grid = -1; return; }
        if (hipOccupancyMaxActiveBlocksPerMultiprocessor(&per_cu, (const void*)mega_fwd, 512, LDS_BYTES) != hipSuccess || per_cu < 1) { fprintf(stderr, "kernel_launch: occupancy query gave %d\n", per_cu); per_cu = 1; }
        (void)hipGetLastError();
        grid = cus * 1;
        fprintf(stderr, "kernel_launch: cus %d per_cu %d grid %d\n", cus, per_cu, grid);
    }
    if (grid < 0) return;
    if (hipMemsetAsync(d_ws, 0, 65536, stream) != hipSuccess) { fprintf(stderr, "kernel_launch: memset failed\n"); return; }
    Args a{};
    for (int i = 0; i < 15; ++i) a.in[i] = (const float*)d_in[i];
    a.out = (float*)d_out; a.ws = (unsigned char*)d_ws;
    void* args[] = {&a};
    hipError_t e = hipLaunchCooperativeKernel((const void*)mega_fwd, dim3(grid), dim3(512), args, LDS_BYTES, stream);
    if (e != hipSuccess) fprintf(stderr, "cooperative launch failed: %s (grid %d)\n", hipGetErrorString(e), grid);
}
```

```cpp
#include <hip/hip_runtime.h>
#include <hip/hip_cooperative_groups.h>
#include <hip/hip_bf16.h>
#include <hip/hip_fp16.h>
#include <cstdio>
#include <cstdint>
#include <cmath>
namespace cg = cooperative_groups;
namespace pg8 {
#define PG8_LAS __attribute__((address_space(3)))
typedef unsigned short bf16_t;
typedef short bf16x8 __attribute__((ext_vector_type(8)));
typedef float f32x4 __attribute__((ext_vector_type(4)));
typedef unsigned u32x4 __attribute__((ext_vector_type(4)));
constexpr int BM = 256, BK = 64, HALF = 128, HTB = HALF * BK * 2  , STAGE_BYTES = 8 * HTB, NXCD = 8, WGM = 8;

__host__ __device__ __forceinline__ int lds_byte(int r, int c) { const int st = (r >> 4) * 2 + (c >> 5), rr = r & 15, cc = c & 31, ob = rr * 64 + cc * 2; return st * 1024 + (ob ^ (((ob >> 9) & 1) << 5)); }
__host__ __device__ __forceinline__ void stage_rc(int b, int& R, int& C) { const int st = b / 1024, sb = b % 1024, swz = sb ^ (((sb >> 9) & 1) << 5); R = (st >> 1) * 16 + swz / 64; C = (st & 1) * 32 + (swz % 64) / 2; }
__host__ __device__ __forceinline__ int perm32(int rho) { const int n = rho >> 4, i = rho & 15; return 8 * (i >> 2) + 4 * n + (i & 3); }

struct Unit { int pm, pn; };
struct Gemm { const bf16_t* A; const bf16_t* Bt; int M, N, K; };

struct StaticOrder {
    int nM, nN, nwg, G, c;
    __host__ __device__ void init(int M, int N, int G_, int c_) { nM = M / BM; nN = N / BM; nwg = nM * nN; G = G_; c = c_; }
    __host__ __device__ bool next(int i, Unit& u) const {
        const long L = (long)i * G + c; if (L >= nwg) return false;
        int wgid = (int)L; { const int q = nwg / NXCD, r = nwg % NXCD, xcd = wgid % NXCD, off = wgid / NXCD; wgid = (xcd < r ? xcd * (q + 1) : r * (q + 1) + (xcd - r) * q) + off; }
        const int nig = WGM * nN, gid = wgid / nig, fm = gid * WGM, gsz = (nM - fm) < WGM ? (nM - fm) : WGM;
        u.pm = fm + ((wgid % nig) % gsz); u.pn = (wgid % nig) / gsz; return true;
    }
    __device__ __forceinline__ void a_ready(const Unit&) const {}
    __device__ __forceinline__ void done(const Unit&) const {}
};

__device__ __forceinline__ unsigned cvt_pk_bf16(float lo, float hi) { unsigned r; asm volatile("v_cvt_pk_bf16_f32 %0, %1, %2" : "=v"(r) : "v"(lo), "v"(hi)); return r; }
template <class Epi, class Sched, bool ALIGN_EPI = false, bool SP2 = false>
__device__ __forceinline__ void gemm_phase(PG8_LAS unsigned char* lds, const Gemm g, const Sched& S, const Epi& E) {
    int tid = threadIdx.x; asm volatile("" : "+v"(tid)); const int wid = __builtin_amdgcn_readfirstlane(tid >> 6), lane = tid & 63, wr = wid >> 2, wc = wid & 3, fr = lane & 15, fq = lane >> 4;
    const int K = g.K, nt = K / BK;
    unsigned voffA[2], voffB[2];
#pragma unroll
    for (int i = 0; i < 2; ++i) { int R, C; stage_rc(tid * 16 + i * 8192, R, C); const int Rb = Epi::PERM ? ((R & ~31) + perm32(R & 31)) : R;
        voffA[i] = (unsigned)(R * K + C) * 2u; voffB[i] = (unsigned)(Rb * K + C) * 2u; }
    const size_t kstep = (size_t)(BK * 2);
    const size_t hstep = (size_t)HALF * K * 2;
    const size_t tstep = 2 * hstep;
    const unsigned ldsw = (unsigned)wid * 1024u;
    const int aoff = lds_byte(wr * 64 + fr, fq * 8), boff = lds_byte(wc * 32 + fr, fq * 8);
#define PG8_SA(b, h) (((b) * 2 + (h)) * HTB)
#define PG8_SB(b, h) ((4 + (b) * 2 + (h)) * HTB)
#define PG8_STAGE(bufoff, gbase, voff) do { _Pragma("unroll") for (int _i = 0; _i < 2; ++_i) \
        __builtin_amdgcn_global_load_lds((const unsigned*)((const char*)(gbase) + (voff)[_i]), (PG8_LAS unsigned*)(lds + (bufoff) + ldsw + _i * 8192), 16, 0, 0); } while (0)
#define PG8_LDA(dst, b, h) do { _Pragma("unroll") for (int m = 0; m < 4; ++m) _Pragma("unroll") for (int k = 0; k < 2; ++k) dst[m][k] = *(const PG8_LAS bf16x8*)(lds + PG8_SA(b, h) + aoff + m * 2048 + k * 1024); } while (0)
#define PG8_LDB(dst, b, h) do { _Pragma("unroll") for (int n = 0; n < 2; ++n) _Pragma("unroll") for (int k = 0; k < 2; ++k) dst[n][k] = *(const PG8_LAS bf16x8*)(lds + PG8_SB(b, h) + boff + n * 2048 + k * 1024); } while (0)
#define PG8_MMA(ai, bj, At, Bt) do { __builtin_amdgcn_s_setprio(1); _Pragma("unroll") for (int m = 0; m < 4; ++m) _Pragma("unroll") for (int n = 0; n < 2; ++n) _Pragma("unroll") for (int k = 0; k < 2; ++k) \
        acc[ai][bj][m][n] = __builtin_amdgcn_mfma_f32_16x16x32_bf16(Bt[n][k], At[m][k], acc[ai][bj][m][n], 0, 0, 0); __builtin_amdgcn_s_setprio(0); } while (0)
#define PG8_WAIT_V(n) asm volatile("s_waitcnt vmcnt(" #n ")" ::: "memory")
#define PG8_WAIT_L(n) asm volatile("s_waitcnt lgkmcnt(" #n ")" ::: "memory")
#define PG8_BAR __builtin_amdgcn_s_barrier()
#define PG8_SCHED __builtin_amdgcn_sched_barrier(0)
    Unit cur, nxt; int ui = 0;
    if (!S.next(0, cur)) return;
    f32x4 acc[2][2][4][2];
#pragma unroll
    for (int a = 0; a < 2; ++a)
#pragma unroll
        for (int b = 0; b < 2; ++b)
#pragma unroll
            for (int m = 0; m < 4; ++m)
#pragma unroll
                for (int n = 0; n < 2; ++n) acc[a][b][m][n] = (f32x4){0.f, 0.f, 0.f, 0.f};
    bf16x8 At[4][2], B0[2][2], B1[2][2];
    const char* cA = (const char*)g.A + (size_t)cur.pm * tstep; const char* cB = (const char*)g.Bt + (size_t)cur.pn * tstep;
    S.a_ready(cur);
    if constexpr (SP2) {
        PG8_STAGE(PG8_SB(0, 0), cB, voffB); PG8_STAGE(PG8_SB(0, 1), cB + hstep, voffB); PG8_STAGE(PG8_SA(0, 0), cA, voffA); PG8_STAGE(PG8_SA(0, 1), cA + hstep, voffA);
        if (wr == 1) PG8_BAR;
        PG8_WAIT_V(2); PG8_BAR;
        PG8_STAGE(PG8_SB(1, 0), cB + kstep, voffB); PG8_STAGE(PG8_SA(1, 0), cA + kstep, voffA); PG8_STAGE(PG8_SB(1, 1), cB + hstep + kstep, voffB);
        PG8_WAIT_V(6); PG8_BAR;
    } else {
        PG8_STAGE(PG8_SB(0, 0), cB, voffB); PG8_STAGE(PG8_SA(0, 0), cA, voffA); PG8_STAGE(PG8_SB(0, 1), cB + hstep, voffB); PG8_STAGE(PG8_SA(0, 1), cA + hstep, voffA);
        if (wr == 1) PG8_BAR;
        PG8_WAIT_V(4); PG8_BAR;
        PG8_STAGE(PG8_SB(1, 0), cB + kstep, voffB); PG8_STAGE(PG8_SA(1, 0), cA + kstep, voffA); PG8_STAGE(PG8_SB(1, 1), cB + hstep + kstep, voffB);
        PG8_WAIT_V(6); PG8_BAR;
    }
    for (;;) {
        const bool has_next = S.next(ui + 1, nxt);
        const char* nA = has_next ? (const char*)g.A + (size_t)nxt.pm * tstep : cA; const char* nB = has_next ? (const char*)g.Bt + (size_t)nxt.pn * tstep : cB;
        for (int t = 0; t < nt; t += 2) {
            const bool last = (t == nt - 2);
            const char* a1 = cA + (size_t)(t + 1) * kstep;
            const char* a2 = last ? nA : cA + (size_t)(t + 2) * kstep; const char* b2 = last ? nB : cB + (size_t)(t + 2) * kstep;
            const char* a3 = a2 + kstep; const char* b3 = b2 + kstep;
            if (last && has_next) S.a_ready(nxt);
            if constexpr (SP2) {
            PG8_LDB(B0, 0, 0); PG8_LDB(B1, 0, 1); PG8_SCHED; PG8_LDA(At, 0, 0); PG8_STAGE(PG8_SA(1, 1), a1 + hstep, voffA);
            PG8_WAIT_V(8); PG8_WAIT_L(0); PG8_BAR; PG8_MMA(0, 0, At, B0); PG8_MMA(0, 1, At, B1); PG8_BAR; PG8_SCHED;
            PG8_LDA(At, 0, 1); PG8_STAGE(PG8_SB(0, 0), b2, voffB); PG8_STAGE(PG8_SB(0, 1), b2 + hstep, voffB); PG8_STAGE(PG8_SA(0, 0), a2, voffA);
            PG8_WAIT_V(8); PG8_WAIT_L(0); PG8_BAR; PG8_MMA(1, 0, At, B0); PG8_MMA(1, 1, At, B1); PG8_BAR; PG8_SCHED;
            PG8_LDB(B0, 1, 0); PG8_LDB(B1, 1, 1); PG8_SCHED; PG8_LDA(At, 1, 0); PG8_STAGE(PG8_SA(0, 1), a2 + hstep, voffA);
            PG8_WAIT_V(8); PG8_WAIT_L(0); PG8_BAR; PG8_MMA(0, 0, At, B0); PG8_MMA(0, 1, At, B1); PG8_BAR; PG8_SCHED;
            PG8_LDA(At, 1, 1); PG8_STAGE(PG8_SB(1, 0), b3, voffB); PG8_STAGE(PG8_SB(1, 1), b3 + hstep, voffB); PG8_STAGE(PG8_SA(1, 0), a3, voffA);
            PG8_WAIT_V(8); PG8_WAIT_L(0); PG8_BAR; PG8_MMA(1, 0, At, B0); PG8_MMA(1, 1, At, B1); PG8_BAR; PG8_SCHED;
            } else {
            PG8_LDB(B0, 0, 0); PG8_SCHED; PG8_LDA(At, 0, 0); PG8_STAGE(PG8_SA(1, 1), a1 + hstep, voffA);
            PG8_WAIT_L(8); PG8_BAR; PG8_WAIT_L(0); PG8_MMA(0, 0, At, B0); PG8_BAR; PG8_SCHED;
            PG8_LDB(B1, 0, 1); PG8_STAGE(PG8_SB(0, 0), b2, voffB);
            PG8_BAR; PG8_WAIT_L(0); PG8_MMA(0, 1, At, B1); PG8_BAR;
            PG8_LDA(At, 0, 1); PG8_STAGE(PG8_SA(0, 0), a2, voffA);
            PG8_BAR; PG8_WAIT_L(0); PG8_MMA(1, 0, At, B0); PG8_BAR; PG8_SCHED;
            PG8_STAGE(PG8_SB(0, 1), b2 + hstep, voffB);
            PG8_WAIT_V(6); PG8_BAR; PG8_MMA(1, 1, At, B1); PG8_BAR;
            PG8_LDB(B0, 1, 0); PG8_SCHED; PG8_LDA(At, 1, 0); PG8_STAGE(PG8_SA(0, 1), a2 + hstep, voffA);
            PG8_WAIT_L(8); PG8_BAR; PG8_WAIT_L(0); PG8_MMA(0, 0, At, B0); PG8_BAR; PG8_SCHED;
            PG8_LDB(B1, 1, 1); PG8_STAGE(PG8_SB(1, 0), b3, voffB);
            PG8_BAR; PG8_WAIT_L(0); PG8_MMA(0, 1, At, B1); PG8_BAR;
            PG8_LDA(At, 1, 1); PG8_STAGE(PG8_SA(1, 0), a3, voffA);
            PG8_BAR; PG8_WAIT_L(0); PG8_MMA(1, 0, At, B0); PG8_BAR; PG8_SCHED;
            PG8_STAGE(PG8_SB(1, 1), b3 + hstep, voffB);
            PG8_WAIT_V(6); PG8_BAR; PG8_MMA(1, 1, At, B1); PG8_BAR;
            }
        }
        if constexpr (ALIGN_EPI) { if (wr == 0) PG8_BAR; }
        if constexpr (!Epi::AFTER_DRAIN) { E(acc, cur, wr, wc, fr, fq); S.done(cur); }
        if (!has_next) break;
#pragma unroll
        for (int a = 0; a < 2; ++a)
#pragma unroll
            for (int b = 0; b < 2; ++b)
#pragma unroll
                for (int m = 0; m < 4; ++m)
#pragma unroll
                    for (int n = 0; n < 2; ++n) acc[a][b][m][n] = (f32x4){0.f, 0.f, 0.f, 0.f};
        cur = nxt; cA = nA; cB = nB; ++ui;
        if constexpr (ALIGN_EPI) { if (wr == 1) PG8_BAR; }
    }
    PG8_WAIT_V(0);
    if constexpr (!ALIGN_EPI) { if (wr == 0) PG8_BAR; }
    PG8_BAR;
    if constexpr (Epi::AFTER_DRAIN) { E.fused(acc, cur, wr, wc, fr, fq, lds, wid, lane); S.done(cur); }
#undef PG8_SA
#undef PG8_SB
#undef PG8_STAGE
#undef PG8_LDA
#undef PG8_LDB
#undef PG8_MMA
#undef PG8_WAIT_V
#undef PG8_WAIT_L
#undef PG8_BAR
#undef PG8_SCHED
}
}
#ifndef ATT_SDEPTH
#define ATT_SDEPTH 1
#endif
namespace att {
using bf16 = __hip_bfloat16;
constexpr int NW = 8, QBLK = 32, KVBLK = 64;
constexpr float SCALE = 0.07216878364870322f;
constexpr float THR = 8.f;
__device__ __forceinline__ int otid() { int t = threadIdx.x; asm volatile("" : "+v"(t)); return t; }
using bf16x8 = __attribute__((ext_vector_type(8))) short;
using s16x4  = __attribute__((ext_vector_type(4))) short;
using f32x16 = __attribute__((ext_vector_type(16))) float;
using f32x8  = __attribute__((ext_vector_type(8))) float;
using u32x4  = __attribute__((ext_vector_type(4))) unsigned;
#define KSWZ(row, colB) ((row) * 256 + ((colB) ^ (((row) & 7) << 4)))
#define SBAR() __builtin_amdgcn_sched_barrier(0)
__device__ __forceinline__ int crow(int r, int hi) { return (r & 3) + 8 * (r >> 2) + 4 * hi; }
__device__ __forceinline__ unsigned cvtpk(float lo, float hi) {
  unsigned r; asm volatile("v_cvt_pk_bf16_f32 %0, %1, %2" : "=v"(r) : "v"(lo), "v"(hi)); return r;
}
template <typename TIn> struct Stage;
template <> struct Stage<bf16>  { using T = bf16x8;
  __device__ static __forceinline__ T ld8(const bf16* p) { return *reinterpret_cast<const bf16x8*>(p); }
  __device__ static __forceinline__ bf16x8 tobf(T x) { return x; } };
template <> struct Stage<float> { using T = f32x8;
  __device__ static __forceinline__ T ld8(const float* p) { return *reinterpret_cast<const f32x8*>(p); }
  __device__ static __forceinline__ bf16x8 tobf(T x) {
    u32x4 w = {cvtpk(x[0], x[1]), cvtpk(x[2], x[3]), cvtpk(x[4], x[5]), cvtpk(x[6], x[7])}; return *reinterpret_cast<bf16x8*>(&w); } };

__device__ __forceinline__ void partialSM(f32x16& p0, f32x16& p1, float& m_reg, float& mn, float& alpha) {
  constexpr float C = SCALE * 1.4426950408889634f;
  float pmax = p0[0]; for (int r = 1; r < 16; ++r) pmax = fmaxf(pmax, p0[r]); for (int r = 0; r < 16; ++r) pmax = fmaxf(pmax, p1[r]);
  { auto rr = __builtin_amdgcn_permlane32_swap(__float_as_uint(pmax), __float_as_uint(pmax), false, false);
    pmax = fmaxf(__uint_as_float(rr[0]), __uint_as_float(rr[1])); }
  if (__builtin_expect(__all(pmax - m_reg <= THR / SCALE), 1)) { mn = m_reg; alpha = 1.f; }
  else { mn = fmaxf(m_reg, pmax); alpha = __builtin_amdgcn_exp2f((m_reg - mn) * C); m_reg = mn; }
  float mnC = -mn * C;
  for (int r = 0; r < 16; ++r) p0[r] = fmaf(p0[r], C, mnC); for (int r = 0; r < 16; ++r) p1[r] = fmaf(p1[r], C, mnC);
  for (int r = 0; r < 16; ++r) p0[r] = __builtin_amdgcn_exp2f(p0[r]);
}
__device__ __forceinline__ void finishSM(f32x16& p0, f32x16& p1, float alpha, float& l_reg, bf16x8& pa0, bf16x8& pa1, bf16x8& pa2, bf16x8& pa3) {
  for (int r = 0; r < 16; ++r) p1[r] = __builtin_amdgcn_exp2f(p1[r]);
  float ps = 0; for (int r = 0; r < 16; ++r) ps += p0[r]; for (int r = 0; r < 16; ++r) ps += p1[r];
  { auto rr = __builtin_amdgcn_permlane32_swap(__float_as_uint(ps), __float_as_uint(ps), false, false);
    ps = __uint_as_float(rr[0]) + __uint_as_float(rr[1]); }
  l_reg = l_reg * alpha + ps;
#define PK4(P, BASE, OUT) do { unsigned a0 = cvtpk(P[BASE + 0], P[BASE + 1]), a1 = cvtpk(P[BASE + 2], P[BASE + 3]);   \
    unsigned b0 = cvtpk(P[BASE + 4], P[BASE + 5]), b1 = cvtpk(P[BASE + 6], P[BASE + 7]);                              \
    auto r0 = __builtin_amdgcn_permlane32_swap(a0, b0, false, false); auto r1 = __builtin_amdgcn_permlane32_swap(a1, b1, false, false); \
    u32x4 w = {r0[0], r1[0], r0[1], r1[1]}; OUT = *reinterpret_cast<bf16x8*>(&w); } while (0)
  PK4(p0, 0, pa0); PK4(p0, 8, pa1); PK4(p1, 0, pa2); PK4(p1, 8, pa3);
#undef PK4
}
#define KSWZ2(row, colB) ((row) * 128 + ((colB) ^ (((row) & 7) << 4)))
__device__ __forceinline__ void qkt(f32x16& p0, f32x16& p1, const bf16* Ks, const bf16* KRs, const bf16x8* qr, const bf16x8* qrl, int r32, int hi) {
  p0 = f32x16{}; p1 = f32x16{};
#pragma unroll
  for (int d0 = 0; d0 < 8; ++d0) { int cb = (d0 * 16 + hi * 8) * 2;
    bf16x8 b0 = *reinterpret_cast<const bf16x8*>((const char*)Ks + KSWZ(r32, cb));
    bf16x8 b1 = *reinterpret_cast<const bf16x8*>((const char*)Ks + KSWZ(32 + r32, cb));
    p0 = __builtin_amdgcn_mfma_f32_32x32x16_bf16(b0, qr[d0], p0, 0, 0, 0);
    p1 = __builtin_amdgcn_mfma_f32_32x32x16_bf16(b1, qr[d0], p1, 0, 0, 0); }
#pragma unroll
  for (int d0 = 0; d0 < 4; ++d0) { int cb = (d0 * 16 + hi * 8) * 2;
    bf16x8 b0 = *reinterpret_cast<const bf16x8*>((const char*)KRs + KSWZ2(r32, cb));
    bf16x8 b1 = *reinterpret_cast<const bf16x8*>((const char*)KRs + KSWZ2(32 + r32, cb));
    const bf16x8 qv = qrl[d0 * 64];
    p0 = __builtin_amdgcn_mfma_f32_32x32x16_bf16(b0, qv, p0, 0, 0, 0);
    p1 = __builtin_amdgcn_mfma_f32_32x32x16_bf16(b1, qv, p1, 0, 0, 0); }
}
__device__ __forceinline__ int v_st(int k, int c) { const int kk = (k & ~0xC) | ((k & 4) << 1) | ((k & 8) >> 1); return ((kk >> 3) * 4 + (c >> 5)) * 512 + ((kk & 7) * 32 + (c & 31)) * 2; }
__device__ __forceinline__ int v_rd_base(int lane) { return ((lane & 3) << 3) | (((lane >> 2) & 3) << 6) | (((lane >> 4) & 1) << 5) | (((lane >> 5) & 1) << 8); }
constexpr int v_rd_off(int d0, int ks, int half) { return d0 * 512 + ks * 4096 + half * 2048; }
template <int OFF> __device__ __forceinline__ s16x4 tr_read(int vb) {
  s16x4 r; asm volatile("ds_read_b64_tr_b16 %0, %1 offset:%2" : "=&v"(r) : "v"(vb), "i"(OFF) : "memory"); return r;
}
template <int D0> __device__ __forceinline__ void pv_one(f32x16& od, int vb, bf16x8 pa0, bf16x8 pa1, bf16x8 pa2, bf16x8 pa3) {
  const s16x4 l0 = tr_read<v_rd_off(D0, 0, 0)>(vb), h0 = tr_read<v_rd_off(D0, 0, 1)>(vb), l1 = tr_read<v_rd_off(D0, 1, 0)>(vb), h1 = tr_read<v_rd_off(D0, 1, 1)>(vb);
  const s16x4 l2 = tr_read<v_rd_off(D0, 2, 0)>(vb), h2 = tr_read<v_rd_off(D0, 2, 1)>(vb), l3 = tr_read<v_rd_off(D0, 3, 0)>(vb), h3 = tr_read<v_rd_off(D0, 3, 1)>(vb);
  asm volatile("s_waitcnt lgkmcnt(0)" ::: "memory"); SBAR();
#define PK(L, H) (bf16x8){L[0], L[1], L[2], L[3], H[0], H[1], H[2], H[3]}
  od = __builtin_amdgcn_mfma_f32_32x32x16_bf16(pa0, PK(l0, h0), od, 0, 0, 0);
  od = __builtin_amdgcn_mfma_f32_32x32x16_bf16(pa1, PK(l1, h1), od, 0, 0, 0);
  od = __builtin_amdgcn_mfma_f32_32x32x16_bf16(pa2, PK(l2, h2), od, 0, 0, 0);
  od = __builtin_amdgcn_mfma_f32_32x32x16_bf16(pa3, PK(l3, h3), od, 0, 0, 0);
#undef PK
}
__device__ __forceinline__ void pv_d0(f32x16* o, int vb, bf16x8 pa0, bf16x8 pa1, bf16x8 pa2, bf16x8 pa3) {
  pv_one<0>(o[0], vb, pa0, pa1, pa2, pa3); pv_one<1>(o[1], vb, pa0, pa1, pa2, pa3); pv_one<2>(o[2], vb, pa0, pa1, pa2, pa3); pv_one<3>(o[3], vb, pa0, pa1, pa2, pa3);
}
constexpr int LDQ = 1536, LDK = 1024, LDV = 1024, LDKR = 64, LDO = 1024, SDEPTH = ATT_SDEPTH;
constexpr int SHM_V = KVBLK * 128 * 2, SHM_K = KVBLK * 128 * 2, SHM_KR = KVBLK * 64 * 2;
constexpr int SHM_QR = NW * 4 * 64 * 16;
constexpr int SHM_ATTN = 2 * SHM_V + 2 * SHM_K + 2 * SHM_KR + NW * 64 * 4 + SHM_QR;
__device__ __forceinline__ void attn_unit(const bf16* __restrict__ Qb, const bf16* __restrict__ Kh, const bf16* __restrict__ KRh, const bf16* __restrict__ Vh,
                                          bf16* __restrict__ Ob, int seq, char* lds) {
  using St = Stage<bf16>;
  const int tid = otid(), wid = tid >> 6, lane = tid & 63, r32 = lane & 31, hi = lane >> 5;
  bf16* V_lds = (bf16*)lds; bf16* K_lds = (bf16*)(lds + 2 * SHM_V); bf16* KR_lds = (bf16*)(lds + 2 * SHM_V + 2 * SHM_K);
  float* ws = (float*)(lds + 2 * SHM_V + 2 * SHM_K + 2 * SHM_KR) + wid * 64; float* li_l = ws; float* al_l = ws + 32;
  float m_reg = -1e30f, l_reg = 0; f32x16 o[4] = {}; bf16x8 qr[8];
  bf16x8* qrl = (bf16x8*)(lds + 2 * SHM_V + 2 * SHM_K + 2 * SHM_KR + NW * 64 * 4) + wid * 256 + lane;
  const bf16* Qw = Qb + (long)(wid * QBLK + r32) * LDQ + hi * 8;
#pragma unroll
  for (int d0 = 0; d0 < 8; ++d0) qr[d0] = St::ld8(Qw + d0 * 16);
#pragma unroll
  for (int d0 = 0; d0 < 4; ++d0) qrl[d0 * 64] = St::ld8(Qw + 128 + d0 * 16);
  const int sr = tid >> 4, sc = (tid & 15) * 8, vst0 = v_st(sr, sc), vst1 = v_st(32 + sr, sc);
  const int krr = tid >> 3, krc = (tid & 7) * 8;
  const int vb0 = (int)(uintptr_t)V_lds + v_rd_base(lane);
  struct { bf16x8 vs0, vs1, ks0, ks1, kr; } sr_[SDEPTH];
#define SLOAD(i, k0) do { sr_[i].vs0 = St::ld8(&Vh[(long)((k0) + sr) * LDV + sc]); sr_[i].vs1 = St::ld8(&Vh[(long)((k0) + 32 + sr) * LDV + sc]); \
    sr_[i].ks0 = St::ld8(&Kh[(long)((k0) + sr) * LDK + sc]); sr_[i].ks1 = St::ld8(&Kh[(long)((k0) + 32 + sr) * LDK + sc]); \
    sr_[i].kr = St::ld8(&KRh[(long)((k0) + krr) * LDKR + krc]); } while (0)
#define SWRITE(b, i) do { *(bf16x8*)((char*)V_lds + (b) * SHM_V + vst0) = sr_[i].vs0;          \
    *(bf16x8*)((char*)V_lds + (b) * SHM_V + vst1) = sr_[i].vs1; int kc = sc * 2;               \
    *(bf16x8*)((char*)K_lds + (b) * SHM_K + KSWZ(sr, kc)) = sr_[i].ks0;                       \
    *(bf16x8*)((char*)K_lds + (b) * SHM_K + KSWZ(32 + sr, kc)) = sr_[i].ks1;                  \
    *(bf16x8*)((char*)KR_lds + (b) * SHM_KR + KSWZ2(krr, krc * 2)) = sr_[i].kr; } while (0)
#define SWAIT() do { if constexpr (SDEPTH == 2) asm volatile("s_waitcnt vmcnt(5)" ::: "memory"); else asm volatile("s_waitcnt vmcnt(0)" ::: "memory"); } while (0)
#define RESC(a) do { if (__any((a) < 1.f)) { if (hi == 0) al_l[r32] = (a); asm volatile("s_waitcnt lgkmcnt(0)" ::: "memory"); \
    _Pragma("unroll") for (int d = 0; d < 4; ++d) _Pragma("unroll") for (int r = 0; r < 16; ++r) o[d][r] *= al_l[crow(r, hi)]; } } while (0)
  f32x16 pA0, pA1, pB0, pB1; float mnA, mnB, alA, alB; bf16x8 pa0, pa1, pa2, pa3; const int NT = seq / KVBLK;
  constexpr int SE = 0, SO = SDEPTH - 1;
  SLOAD(SE, 0); asm volatile("s_waitcnt vmcnt(0)" ::: "memory"); SWRITE(0, SE); __syncthreads();
  qkt(pA0, pA1, K_lds, KR_lds, qr, qrl, r32, hi); partialSM(pA0, pA1, m_reg, mnA, alA);
  SLOAD(SO, KVBLK); if constexpr (SDEPTH == 2) { if (2 < NT) SLOAD(SE, 2 * KVBLK); }
  SWAIT(); SWRITE(1, SO); __syncthreads();
  for (int j = 1; j + 1 < NT; j += 2) {
    SBAR(); qkt(pB0, pB1, (bf16*)((char*)K_lds + SHM_K), (bf16*)((char*)KR_lds + SHM_KR), qr, qrl, r32, hi);
    finishSM(pA0, pA1, alA, l_reg, pa0, pa1, pa2, pa3); SBAR();
    SLOAD(SO, (j + SDEPTH) * KVBLK); SBAR();
    pv_d0(o, vb0, pa0, pa1, pa2, pa3); partialSM(pB0, pB1, m_reg, mnB, alB);
    __syncthreads(); SWAIT(); SWRITE(0, SE);
    RESC(alB); __syncthreads();
    SBAR(); qkt(pA0, pA1, K_lds, KR_lds, qr, qrl, r32, hi);
    finishSM(pB0, pB1, alB, l_reg, pa0, pa1, pa2, pa3); SBAR();
    if (SDEPTH == 1 || j + 3 < NT) SLOAD(SE, (j + 1 + SDEPTH) * KVBLK); SBAR();
    pv_d0(o, vb0 + (int)SHM_V, pa0, pa1, pa2, pa3); partialSM(pA0, pA1, m_reg, mnA, alA);
    __syncthreads(); SWAIT(); SWRITE(1, SO);
    RESC(alA); __syncthreads();
  }
  SBAR(); qkt(pB0, pB1, (bf16*)((char*)K_lds + SHM_K), (bf16*)((char*)KR_lds + SHM_KR), qr, qrl, r32, hi);
  finishSM(pA0, pA1, alA, l_reg, pa0, pa1, pa2, pa3); SBAR();
  pv_d0(o, vb0, pa0, pa1, pa2, pa3); partialSM(pB0, pB1, m_reg, mnB, alB);
  __syncthreads(); RESC(alB);
  finishSM(pB0, pB1, alB, l_reg, pa0, pa1, pa2, pa3); SBAR();
  pv_d0(o, vb0 + (int)SHM_V, pa0, pa1, pa2, pa3);
  if (hi == 0) li_l[r32] = l_reg; asm volatile("s_waitcnt lgkmcnt(0)" ::: "memory");
  float rli[16];
#pragma unroll
  for (int r = 0; r < 16; ++r) rli[r] = __builtin_amdgcn_rcpf(li_l[crow(r, hi)]);
  bf16* Ow = Ob + (long)(wid * QBLK) * LDO;
#pragma unroll
  for (int r = 0; r < 16; ++r) { int orow = crow(r, hi);
#pragma unroll
    for (int d0 = 0; d0 < 4; ++d0) Ow[(long)orow * LDO + d0 * 32 + r32] = __float2bfloat16(o[d0][r] * rli[r]); }
  __syncthreads();
#undef SLOAD
#undef SWRITE
#undef SWAIT
#undef RESC
}
#undef SBAR
}
constexpr int BATCH = 4, SEQ = 8192, DM = 1024, DEPTH = 4, DFF = 2816, MT = BATCH * SEQ;
constexpr int NH = 8, QLR = 256, KVLR = 128, QKD = 192;
constexpr float EPS = 1e-6f;
constexpr size_t MiB = 1u << 20;
constexpr size_t WS_WFFI = 1 * MiB;
constexpr size_t WS_WFFO = 89 * MiB;
constexpr size_t WS_WHIN = 133 * MiB;
constexpr size_t WS_WHO  = 153 * MiB;
constexpr size_t WS_WMIN = 157 * MiB;
constexpr size_t WS_WUQ  = 159 * MiB;
constexpr size_t WS_WUKV = 161 * MiB;
constexpr size_t WS_WMO  = 162 * MiB;
constexpr size_t WS_COS  = 166 * MiB;
constexpr size_t WS_SIN  = 170 * MiB;
constexpr size_t WS_LB   = 174 * MiB;
constexpr size_t WS_HN   = 176 * MiB;
constexpr size_t WS_Y    = 240 * MiB;
constexpr size_t WS_YB   = 304 * MiB;
constexpr size_t WS_R    = 368 * MiB;
constexpr size_t WS_END  = 704 * MiB;
constexpr size_t R_ACT = 0;
constexpr size_t R_C = 0, R_QB = 0, R_CQ = 96 * MiB, R_CKV = 112 * MiB, R_KR = 120 * MiB, R_KN = 124 * MiB, R_VB = 188 * MiB, R_O = 252 * MiB;
constexpr size_t R_QH = 0, R_VH = 64 * MiB, R_GH = 128 * MiB, R_KF = 192 * MiB, R_HO = 0;

constexpr int LDS_RING = 131072, LDS_BYTES = LDS_RING + 2048;
typedef unsigned short bf16_t;
typedef float f32x4 __attribute__((ext_vector_type(4)));
typedef float f32x2 __attribute__((ext_vector_type(2)));
typedef unsigned u32x4 __attribute__((ext_vector_type(4)));
typedef unsigned u32x2 __attribute__((ext_vector_type(2)));
typedef _Float16 h16x2 __attribute__((ext_vector_type(2)));
#define LAS __attribute__((address_space(3)))

__device__ __constant__ double ROPE_INVF[32] = {1.0, 0.7498942093324559, 0.5623413251903491, 0.4216965034285822, 0.31622776601683794, 0.23713737056616552, 0.1778279410038923, 0.1333521432163324, 0.1, 0.07498942093324558, 0.05623413251903491, 0.042169650342858224, 0.03162277660168379, 0.023713737056616554, 0.01778279410038923, 0.01333521432163324, 0.01, 0.007498942093324558, 0.005623413251903491, 0.004216965034285823, 0.0031622776601683794, 0.0023713737056616554, 0.0017782794100389228, 0.001333521432163324, 0.001, 0.0007498942093324559, 0.0005623413251903491, 0.00042169650342858224, 0.00031622776601683794, 0.00023713737056616554, 0.00017782794100389227, 0.0001333521432163324};

__device__ __forceinline__ unsigned pk2(float lo, float hi) { return pg8::cvt_pk_bf16(lo, hi); }
__device__ __forceinline__ float silu_f(float g) { return g * __builtin_amdgcn_rcpf(1.0f + __expf(-g)); }
__device__ __forceinline__ float wave_sum(float v) {
#pragma unroll
    for (int o = 1; o < 64; o <<= 1) v += __shfl_xor(v, o);
    return v;
}
__device__ __forceinline__ float half_sum(float v) {
#pragma unroll
    for (int o = 1; o < 32; o <<= 1) v += __shfl_xor(v, o);
    return v;
}

using pg8::Unit;
struct EpiSwiglu { static constexpr bool PERM = true, AFTER_DRAIN = false; bf16_t* O;
    __device__ __forceinline__ void operator()(const pg8::f32x4 (&acc)[2][2][4][2], const Unit& u, int wr, int wc, int fr, int fq) const {
        const int row0 = u.pm * 256 + wr * 64 + fr, col0 = u.pn * 128 + wc * 32 + 8 * fq;
#pragma unroll
        for (int ai = 0; ai < 2; ++ai)
#pragma unroll
            for (int m = 0; m < 4; ++m) { bf16_t* p = O + (size_t)(row0 + ai * 128 + m * 16) * DFF + col0;
                const pg8::f32x4 g0 = acc[ai][0][m][0], g1 = acc[ai][0][m][1], u0 = acc[ai][1][m][0], u1 = acc[ai][1][m][1];
                u32x4 w; w.x = pk2(silu_f(g0[0]) * u0[0], silu_f(g0[1]) * u0[1]); w.y = pk2(silu_f(g0[2]) * u0[2], silu_f(g0[3]) * u0[3]);
                w.z = pk2(silu_f(g1[0]) * u1[0], silu_f(g1[1]) * u1[1]); w.w = pk2(silu_f(g1[2]) * u1[2], silu_f(g1[3]) * u1[3]);
                *(u32x4*)p = w; }
    }
};
struct EpiF32 { static constexpr bool PERM = false, AFTER_DRAIN = false; float* O; int ldc;
    __device__ __forceinline__ void operator()(const pg8::f32x4 (&acc)[2][2][4][2], const Unit& u, int wr, int wc, int fr, int fq) const {
        const int row0 = u.pm * 256 + wr * 64 + fr, col0 = u.pn * 256 + wc * 32 + 4 * fq;
#pragma unroll
        for (int ai = 0; ai < 2; ++ai)
#pragma unroll
            for (int m = 0; m < 4; ++m) { float* p = O + (size_t)(row0 + ai * 128 + m * 16) * ldc + col0;
#pragma unroll
                for (int bj = 0; bj < 2; ++bj)
#pragma unroll
                    for (int n = 0; n < 2; ++n) *(pg8::f32x4*)(p + bj * 128 + n * 16) = acc[ai][bj][m][n]; }
    }
};
struct EpiB16 { static constexpr bool PERM = true, AFTER_DRAIN = false; bf16_t* O; int ldc;
    __device__ __forceinline__ void operator()(const pg8::f32x4 (&acc)[2][2][4][2], const Unit& u, int wr, int wc, int fr, int fq) const {
        const int row0 = u.pm * 256 + wr * 64 + fr, col0 = u.pn * 256 + wc * 32 + 8 * fq;
#pragma unroll
        for (int ai = 0; ai < 2; ++ai)
#pragma unroll
            for (int m = 0; m < 4; ++m) { bf16_t* p = O + (size_t)(row0 + ai * 128 + m * 16) * ldc + col0;
#pragma unroll
                for (int bj = 0; bj < 2; ++bj) { const pg8::f32x4 v0 = acc[ai][bj][m][0], v1 = acc[ai][bj][m][1];
                    u32x4 w; w.x = pk2(v0[0], v0[1]); w.y = pk2(v0[2], v0[3]); w.z = pk2(v1[0], v1[1]); w.w = pk2(v1[2], v1[3]);
                    *(u32x4*)(p + bj * 128) = w; } }
    }
};
struct EpiQ { static constexpr bool PERM = true, AFTER_DRAIN = false; bf16_t* O; const float* cs; const float* sn;
    __device__ __forceinline__ void operator()(const pg8::f32x4 (&acc)[2][2][4][2], const Unit& u, int wr, int wc, int fr, int fq) const {
        const int row0 = u.pm * 256 + wr * 64 + fr;
#pragma unroll
        for (int bj = 0; bj < 2; ++bj) { const int col0 = u.pn * 256 + bj * 128 + wc * 32 + 8 * fq, d = col0 % QKD; const bool rot = d >= 128; const int i0 = (d - 128) >> 1;
#pragma unroll
            for (int ai = 0; ai < 2; ++ai)
#pragma unroll
                for (int m = 0; m < 4; ++m) { const int row = row0 + ai * 128 + m * 16; pg8::f32x4 v0 = acc[ai][bj][m][0], v1 = acc[ai][bj][m][1];
                    if (rot) { const pg8::f32x4 c = *(const pg8::f32x4*)(cs + (size_t)row * 32 + i0), s = *(const pg8::f32x4*)(sn + (size_t)row * 32 + i0);
                        pg8::f32x4 a, b; a[0] = v0[0] * c[0] - v0[1] * s[0]; a[1] = v0[0] * s[0] + v0[1] * c[0]; a[2] = v0[2] * c[1] - v0[3] * s[1]; a[3] = v0[2] * s[1] + v0[3] * c[1];
                        b[0] = v1[0] * c[2] - v1[1] * s[2]; b[1] = v1[0] * s[2] + v1[1] * c[2]; b[2] = v1[2] * c[3] - v1[3] * s[3]; b[3] = v1[2] * s[3] + v1[3] * c[3]; v0 = a; v1 = b; }
                    u32x4 w; w.x = pk2(v0[0], v0[1]); w.y = pk2(v0[2], v0[3]); w.z = pk2(v1[0], v1[1]); w.w = pk2(v1[2], v1[3]);
                    *(u32x4*)(O + (size_t)row * 1536 + col0) = w; } }
    }
};
struct EpiKV { static constexpr bool PERM = true, AFTER_DRAIN = false; bf16_t* Kn; bf16_t* Vb;
    __device__ __forceinline__ void operator()(const pg8::f32x4 (&acc)[2][2][4][2], const Unit& u, int wr, int wc, int fr, int fq) const {
        const int row0 = u.pm * 256 + wr * 64 + fr, col0 = u.pn * 128 + wc * 32 + 8 * fq;
#pragma unroll
        for (int bj = 0; bj < 2; ++bj) { bf16_t* base = bj ? Vb : Kn;
#pragma unroll
            for (int ai = 0; ai < 2; ++ai)
#pragma unroll
                for (int m = 0; m < 4; ++m) { const pg8::f32x4 v0 = acc[ai][bj][m][0], v1 = acc[ai][bj][m][1];
                    u32x4 w; w.x = pk2(v0[0], v0[1]); w.y = pk2(v0[2], v0[3]); w.z = pk2(v1[0], v1[1]); w.w = pk2(v1[2], v1[3]);
                    *(u32x4*)(base + (size_t)(row0 + ai * 128 + m * 16) * 1024 + col0) = w; } }
    }
};
__device__ __forceinline__ unsigned pkh2(float a, float b) { const h16x2 h = {(_Float16)a, (_Float16)b}; return __builtin_bit_cast(unsigned, h); }
__device__ __forceinline__ float kgate(float om, float z) { return om * __builtin_amdgcn_rcpf(1.0f + __expf(z)); }
struct EpiHgrn { static constexpr bool PERM = true, AFTER_DRAIN = false; bf16_t* Qh; bf16_t* Vh; bf16_t* Gh; unsigned short* KF; const float* lb;
    __device__ __forceinline__ void operator()(const pg8::f32x4 (&acc)[2][2][4][2], const Unit& u, int wr, int wc, int fr, int fq) const {
        const int row0 = u.pm * 256 + wr * 64 + fr, seg = u.pn >> 2;
#pragma unroll
        for (int bj = 0; bj < 2; ++bj) { const int cc = (u.pn & 3) * 256 + bj * 128 + wc * 32 + 8 * fq;
            if (seg == 1 || seg == 2) {
                const pg8::f32x4 om0 = 1.0f - *(const pg8::f32x4*)(lb + (seg - 1) * 1024 + cc), om1 = 1.0f - *(const pg8::f32x4*)(lb + (seg - 1) * 1024 + cc + 4);
                unsigned short* base = KF + (size_t)(seg - 1) * MT * 1024;
#pragma unroll
                for (int ai = 0; ai < 2; ++ai)
#pragma unroll
                    for (int m = 0; m < 4; ++m) { const size_t off = (size_t)(row0 + ai * 128 + m * 16) * 1024 + cc; const pg8::f32x4 v0 = acc[ai][bj][m][0], v1 = acc[ai][bj][m][1];
                        u32x4 w; w.x = pkh2(kgate(om0[0], v0[0]), kgate(om0[1], v0[1])); w.y = pkh2(kgate(om0[2], v0[2]), kgate(om0[3], v0[3]));
                        w.z = pkh2(kgate(om1[0], v1[0]), kgate(om1[1], v1[1])); w.w = pkh2(kgate(om1[2], v1[2]), kgate(om1[3], v1[3]));
                        *(u32x4*)(base + off) = w; }
            } else if (seg == 3) {
#pragma unroll
                for (int ai = 0; ai < 2; ++ai)
#pragma unroll
                    for (int m = 0; m < 4; ++m) { const size_t off = (size_t)(row0 + ai * 128 + m * 16) * 1024 + cc; const pg8::f32x4 v0 = acc[ai][bj][m][0], v1 = acc[ai][bj][m][1];
                        u32x4 w; w.x = pk2(v0[0], v0[1]); w.y = pk2(v0[2], v0[3]); w.z = pk2(v1[0], v1[1]); w.w = pk2(v1[2], v1[3]);
                        *(u32x4*)(Vh + off) = w; }
            } else { bf16_t* base = seg == 0 ? Qh : Gh;
#pragma unroll
                for (int ai = 0; ai < 2; ++ai)
#pragma unroll
                    for (int m = 0; m < 4; ++m) { const size_t off = (size_t)(row0 + ai * 128 + m * 16) * 1024 + cc; const pg8::f32x4 v0 = acc[ai][bj][m][0], v1 = acc[ai][bj][m][1];
                        u32x4 w; w.x = pk2(silu_f(v0[0]), silu_f(v0[1])); w.y = pk2(silu_f(v0[2]), silu_f(v0[3])); w.z = pk2(silu_f(v1[0]), silu_f(v1[1])); w.w = pk2(silu_f(v1[2]), silu_f(v1[3]));
                        *(u32x4*)(base + off) = w; } } }
    }
};

__device__ __forceinline__ int src_col(int mode, int n) {
    if (mode == 1) { const int t = n >> 8, j = n & 255; return j < 128 ? t * 128 + j : DFF + t * 128 + (j - 128); }
    if (mode == 2) { if (n < 384) return n; if (n >= 448) return -1; const int j = n - 384; return 384 + (j >> 1) + 32 * (j & 1); }
    if (mode == 3) { const int h = n / QKD, d = n % QKD; if (d < 128) return n; const int j = d - 128; return h * QKD + 128 + (j >> 1) + 32 * (j & 1); }
    return n;
}
__device__ __forceinline__ void xpose_item(const float* __restrict__ W, int K, int Nsrc, int Ndst, int mode, bf16_t* __restrict__ WT, LAS float* scr, int item, int lane) {
    const int nblk = Ndst / 32, kb = item / nblk, nb = item % nblk, k0 = 64 * kb, n0 = 32 * nb;
    const int sc = src_col(mode, n0 + (lane & 31));
#pragma unroll 8
    for (int i = 0; i < 32; ++i) { const int kk = 2 * i + (lane >> 5); scr[kk * 33 + (lane & 31)] = sc >= 0 ? W[(size_t)(k0 + kk) * Nsrc + sc] : 0.f; }
    asm volatile("s_waitcnt lgkmcnt(0)" ::: "memory");
    const int c = lane & 7;
#pragma unroll
    for (int j = 0; j < 4; ++j) { const int n = (lane >> 3) + 8 * j; const LAS float* s = scr + (8 * c) * 33 + n;
        u32x4 o; o.x = pk2(s[0 * 33], s[1 * 33]); o.y = pk2(s[2 * 33], s[3 * 33]); o.z = pk2(s[4 * 33], s[5 * 33]); o.w = pk2(s[6 * 33], s[7 * 33]);
        *(u32x4*)(WT + (size_t)(n0 + n) * K + k0 + 8 * c) = o; }
    asm volatile("s_waitcnt lgkmcnt(0)" ::: "memory");
}

__device__ __forceinline__ void row_init(const float* __restrict__ xin, float* __restrict__ X, bf16_t* __restrict__ HN, const float* __restrict__ g, int lane) {
    const f32x4* xr = (const f32x4*)xin + lane; f32x4 v[4]; float s = 0.f;
#pragma unroll
    for (int j = 0; j < 4; ++j) { v[j] = xr[64 * j]; s += (v[j][0] * v[j][0] + v[j][1] * v[j][1]) + (v[j][2] * v[j][2] + v[j][3] * v[j][3]); }
    const float r = rsqrtf(wave_sum(s) * (1.f / DM) + EPS);
#pragma unroll
    for (int j = 0; j < 4; ++j) { ((f32x4*)X + lane)[64 * j] = v[j]; const f32x4 gg = ((const f32x4*)g + lane)[64 * j];
        u32x2 w; w.x = pk2(v[j][0] * r * gg[0], v[j][1] * r * gg[1]); w.y = pk2(v[j][2] * r * gg[2], v[j][3] * r * gg[3]); ((u32x2*)HN + lane)[64 * j] = w; }
}
__device__ __forceinline__ void row_post(const bf16_t* __restrict__ Y, float* __restrict__ X, bf16_t* __restrict__ HN, float scale, const float* __restrict__ gp, const float* __restrict__ gn, int lane) {
    f32x4 y[4], x[4]; float s = 0.f;
#pragma unroll
    for (int j = 0; j < 4; ++j) { const u32x2 yb = ((const u32x2*)Y + lane)[64 * j]; y[j] = (f32x4){__uint_as_float(yb.x << 16), __uint_as_float(yb.x & 0xffff0000u), __uint_as_float(yb.y << 16), __uint_as_float(yb.y & 0xffff0000u)};
        x[j] = ((const f32x4*)X + lane)[64 * j]; s += (y[j][0] * y[j][0] + y[j][1] * y[j][1]) + (y[j][2] * y[j][2] + y[j][3] * y[j][3]); }
    const float r = rsqrtf(wave_sum(s) * (1.f / DM) + EPS) * scale; float s2 = 0.f;
#pragma unroll
    for (int j = 0; j < 4; ++j) { const f32x4 gg = ((const f32x4*)gp + lane)[64 * j]; x[j] = x[j] + y[j] * r * gg; ((f32x4*)X + lane)[64 * j] = x[j];
        s2 += (x[j][0] * x[j][0] + x[j][1] * x[j][1]) + (x[j][2] * x[j][2] + x[j][3] * x[j][3]); }
    if (HN) { const float r2 = rsqrtf(wave_sum(s2) * (1.f / DM) + EPS);
#pragma unroll
        for (int j = 0; j < 4; ++j) { const f32x4 gg = ((const f32x4*)gn + lane)[64 * j];
            u32x2 w; w.x = pk2(x[j][0] * r2 * gg[0], x[j][1] * r2 * gg[1]); w.y = pk2(x[j][2] * r2 * gg[2], x[j][3] * r2 * gg[3]); ((u32x2*)HN + lane)[64 * j] = w; } }
}
__device__ __forceinline__ void row_mla(const float* __restrict__ C, bf16_t* __restrict__ CQ, bf16_t* __restrict__ CKV, bf16_t* __restrict__ KR, const float* __restrict__ qn, const float* __restrict__ kvn,
                                        const float* __restrict__ cs, const float* __restrict__ sn, int lane) {
    const f32x4 a = ((const f32x4*)C)[2 * lane], b = ((const f32x4*)C)[2 * lane + 1];
    float s = (a[0] * a[0] + a[1] * a[1]) + (a[2] * a[2] + a[3] * a[3]) + (b[0] * b[0] + b[1] * b[1]) + (b[2] * b[2] + b[3] * b[3]);
#pragma unroll
    for (int o = 1; o < 16; o <<= 1) s += __shfl_xor(s, o);
    const float s16 = s, s32 = s16 + __shfl_xor(s16, 16);
    float v[8] = {a[0], a[1], a[2], a[3], b[0], b[1], b[2], b[3]};
    if (lane < 32) { const float r = rsqrtf(s32 * (1.f / QLR) + EPS); const f32x4 g0 = ((const f32x4*)qn)[2 * lane], g1 = ((const f32x4*)qn)[2 * lane + 1];
        u32x4 w; w.x = pk2(v[0] * r * g0[0], v[1] * r * g0[1]); w.y = pk2(v[2] * r * g0[2], v[3] * r * g0[3]); w.z = pk2(v[4] * r * g1[0], v[5] * r * g1[1]); w.w = pk2(v[6] * r * g1[2], v[7] * r * g1[3]);
        ((u32x4*)CQ)[lane] = w;
    } else if (lane < 48) { const int l = lane - 32; const float r = rsqrtf(s16 * (1.f / KVLR) + EPS); const f32x4 g0 = ((const f32x4*)kvn)[2 * l], g1 = ((const f32x4*)kvn)[2 * l + 1];
        u32x4 w; w.x = pk2(v[0] * r * g0[0], v[1] * r * g0[1]); w.y = pk2(v[2] * r * g0[2], v[3] * r * g0[3]); w.z = pk2(v[4] * r * g1[0], v[5] * r * g1[1]); w.w = pk2(v[6] * r * g1[2], v[7] * r * g1[3]);
        ((u32x4*)CKV)[l] = w;
    } else if (lane < 56) { const int l = lane - 48; const f32x4 c = ((const f32x4*)cs)[l], sv = ((const f32x4*)sn)[l];
        u32x4 w; w.x = pk2(v[0] * c[0] - v[1] * sv[0], v[0] * sv[0] + v[1] * c[0]); w.y = pk2(v[2] * c[1] - v[3] * sv[1], v[2] * sv[1] + v[3] * c[1]);
        w.z = pk2(v[4] * c[2] - v[5] * sv[2], v[4] * sv[2] + v[5] * c[2]); w.w = pk2(v[6] * c[3] - v[7] * sv[3], v[6] * sv[3] + v[7] * c[3]);
        ((u32x4*)KR)[l] = w; }
}
__device__ __forceinline__ void row_hgrn(const bf16_t* __restrict__ Oa, const bf16_t* __restrict__ Gh, bf16_t* __restrict__ HO, const float* __restrict__ on, int lane) {
#pragma unroll
    for (int j = 0; j < 4; ++j) { const u32x2 a = ((const u32x2*)Oa + lane)[64 * j], b = ((const u32x2*)(Oa + (size_t)MT * 1024) + lane)[64 * j];
        f32x4 o; o[0] = __uint_as_float(a.x << 16) + __uint_as_float(b.x << 16); o[1] = __uint_as_float(a.x & 0xffff0000u) + __uint_as_float(b.x & 0xffff0000u);
        o[2] = __uint_as_float(a.y << 16) + __uint_as_float(b.y << 16); o[3] = __uint_as_float(a.y & 0xffff0000u) + __uint_as_float(b.y & 0xffff0000u);
        const float s = half_sum((o[0] * o[0] + o[1] * o[1]) + (o[2] * o[2] + o[3] * o[3]));
        const float r = rsqrtf(s * (1.f / 128.f) + EPS); const f32x4 gg = ((const f32x4*)on + lane)[64 * j]; const u32x2 gb = ((const u32x2*)Gh + lane)[64 * j];
        const float g0 = __uint_as_float(gb.x << 16), g1 = __uint_as_float(gb.x & 0xffff0000u), g2 = __uint_as_float(gb.y << 16), g3 = __uint_as_float(gb.y & 0xffff0000u);
        u32x2 w; w.x = pk2(o[0] * r * gg[0] * g0, o[1] * r * gg[1] * g1); w.y = pk2(o[2] * r * gg[2] * g2, o[3] * r * gg[3] * g3); ((u32x2*)HO + lane)[64 * j] = w; }
}
__device__ __forceinline__ f32x2 h2f2_(unsigned u) { const h16x2 h = __builtin_bit_cast(h16x2, u); return (f32x2){(float)h[0], (float)h[1]}; }
__device__ __forceinline__ void scan_phase(LAS unsigned char* lds, const bf16_t* __restrict__ Qh, const bf16_t* __restrict__ Vh, const unsigned short* __restrict__ KF, bf16_t* __restrict__ OP, int G, int bx) {
    int tid = threadIdx.x; asm volatile("" : "+v"(tid)); const int wid = __builtin_amdgcn_readfirstlane(tid >> 6), lane = tid & 63;
    const int st = tid >> 4, sc8 = (tid & 15) * 8, sv = tid >> 3, vc4 = (tid & 7) * 4;
    constexpr int OFF_K = 16384, OFF_Q = 32768, OFF_V = 49152, OFF_P = 53248;
    for (int item = bx; item < 256; item += G) {
        const int dir = item & 1, dvq = (item >> 1) & 3, h = (item >> 3) & 7, b = item >> 6;
        const size_t kcol = h * 128 + sc8, vcol = h * 128 + dvq * 32 + vc4;
        const unsigned short* KFd = KF + (size_t)dir * MT * 1024; bf16_t* OPd = OP + (size_t)dir * MT * 1024;
        u32x4 rk, rq; u32x2 rv = {0u, 0u};
#define SC_GLOAD(blk) do { { const int tt = (blk) * 32 + st; const size_t m = (size_t)b * SEQ + (dir ? SEQ - 1 - tt : tt); \
        rk = *(const u32x4*)(KFd + m * 1024 + kcol); rq = *(const u32x4*)(Qh + m * 1024 + kcol); } \
        if (tid < 256) { const int tt = (blk) * 32 + sv; const size_t m = (size_t)b * SEQ + (dir ? SEQ - 1 - tt : tt); rv = *(const u32x2*)(Vh + m * 1024 + vcol); } } while (0)
#define SC_H2F(u_) h2f2_(u_)
#define SC_LWRITE() do { LAS unsigned char* B_ = lds + (st * 128 + sc8) * 4; \
        const f32x2 ka = SC_H2F(rk.x), kb = SC_H2F(rk.y), kc = SC_H2F(rk.z), kd = SC_H2F(rk.w); \
        const f32x4 k0_ = {ka[0], ka[1], kb[0], kb[1]}, k1_ = {kc[0], kc[1], kd[0], kd[1]}; \
        *(LAS f32x4*)(B_ + OFF_K) = k0_; *(LAS f32x4*)(B_ + OFF_K + 16) = k1_; \
        *(LAS f32x4*)(B_ + OFF_Q) = (f32x4){__uint_as_float(rq.x << 16), __uint_as_float(rq.x & 0xffff0000u), __uint_as_float(rq.y << 16), __uint_as_float(rq.y & 0xffff0000u)}; \
        *(LAS f32x4*)(B_ + OFF_Q + 16) = (f32x4){__uint_as_float(rq.z << 16), __uint_as_float(rq.z & 0xffff0000u), __uint_as_float(rq.w << 16), __uint_as_float(rq.w & 0xffff0000u)}; \
        if (tid < 256) *(LAS f32x4*)(lds + OFF_V + (sv * 32 + vc4) * 4) = (f32x4){__uint_as_float(rv.x << 16), __uint_as_float(rv.x & 0xffff0000u), __uint_as_float(rv.y << 16), __uint_as_float(rv.y & 0xffff0000u)}; } while (0)
        SC_GLOAD(0);
        const int dksub = ((lane >> 3) & 1) | ((lane >> 5) << 1), dvp = (lane & 7) | (((lane >> 4) & 1) << 3);
        const LAS unsigned char* Bc = lds + (16 * wid + 4 * dksub) * 4;
        const LAS unsigned char* Vc = lds + OFF_V + dvp * 8;
        LAS unsigned char* Pw = lds + OFF_P + (wid * 4 + dksub) * 2048 + dvp * 4;
        f32x2 S2[4];
#pragma unroll
        for (int j = 0; j < 4; ++j) S2[j] = (f32x2){0.f, 0.f};
        for (int blk = 0; blk < SEQ / 32; ++blk) {
            SC_LWRITE();
            if (blk + 1 < SEQ / 32) SC_GLOAD(blk + 1);
            __syncthreads();
            f32x4 k4n = *(const LAS f32x4*)(Bc + OFF_K), q4n = *(const LAS f32x4*)(Bc + OFF_Q); f32x2 v2n = *(const LAS f32x2*)(Vc);
            f32x4 k4m = *(const LAS f32x4*)(Bc + OFF_K + 512), q4m = *(const LAS f32x4*)(Bc + OFF_Q + 512); f32x2 v2m = *(const LAS f32x2*)(Vc + 128);
#pragma unroll
            for (int t = 0; t < 32; ++t) {
                const f32x4 k4 = k4n, q4 = q4n; const f32x2 v2 = v2n;
                k4n = k4m; q4n = q4m; v2n = v2m;
                { const int tn = (t + 2) & 31;
                  k4m = *(const LAS f32x4*)(Bc + OFF_K + tn * 512); q4m = *(const LAS f32x4*)(Bc + OFF_Q + tn * 512); v2m = *(const LAS f32x2*)(Vc + tn * 128); }
                __builtin_amdgcn_sched_barrier(0);
#pragma unroll
                for (int j = 0; j < 4; ++j) S2[j] = S2[j] + (v2 - S2[j]) * k4[j];
                const f32x2 o2 = (S2[0] * q4[0] + S2[1] * q4[1]) + (S2[2] * q4[2] + S2[3] * q4[3]);
                *(LAS unsigned*)(Pw + t * 64) = pk2(o2[0], o2[1]);
            }
            __syncthreads();
            if (tid < 256) { const LAS unsigned char* Pr = lds + OFF_P + (sv * 32 + vc4) * 2; f32x4 acc = {0.f, 0.f, 0.f, 0.f};
#pragma unroll
              for (int g = 0; g < 32; ++g) { const u32x2 pv = *(const LAS u32x2*)(Pr + g * 2048);
                  acc[0] += __uint_as_float(pv.x << 16); acc[1] += __uint_as_float(pv.x & 0xffff0000u); acc[2] += __uint_as_float(pv.y << 16); acc[3] += __uint_as_float(pv.y & 0xffff0000u); }
              const int tt = blk * 32 + sv; const size_t m = (size_t)b * SEQ + (dir ? SEQ - 1 - tt : tt);
              u32x2 w; w.x = pk2(acc[0], acc[1]); w.y = pk2(acc[2], acc[3]); *(u32x2*)(OPd + m * 1024 + vcol) = w; }
        }
        __syncthreads();
#undef SC_GLOAD
#undef SC_LWRITE
#undef SC_H2F
    }
}

typedef float f32x16 __attribute__((ext_vector_type(16)));
typedef short s16x8 __attribute__((ext_vector_type(8)));
__device__ __forceinline__ int crow_(int r, int hi) { return (r & 3) + 8 * (r >> 2) + 4 * hi; }
template <int KSTEPS>
__device__ __forceinline__ void mm_tile(f32x16& c, const LAS unsigned char* X, int xstride, const LAS unsigned char* Y, int ystride, int r32, int hi) {
#pragma unroll
    for (int i = 0; i < KSTEPS; ++i) { const s16x8 x = *(const LAS s16x8*)(X + r32 * xstride + (16 * i + 8 * hi) * 2), y = *(const LAS s16x8*)(Y + r32 * ystride + (16 * i + 8 * hi) * 2);
        c = __builtin_amdgcn_mfma_f32_32x32x16_bf16(x, y, c, 0, 0, 0); }
}
__device__ __forceinline__ void scan_phase_mfma(LAS unsigned char* lds, const bf16_t* __restrict__ Qh, const bf16_t* __restrict__ Vh, const unsigned short* __restrict__ KF, bf16_t* __restrict__ OP, int G, int bx) {
    int tid = threadIdx.x; asm volatile("" : "+v"(tid)); const int wid = __builtin_amdgcn_readfirstlane(tid >> 6), lane = tid & 63, r32 = lane & 31, hi = lane >> 5;
    const bool grpA = wid < 4;
    const int st = (tid >> 3) & 31, sc16 = (tid & 7) * 16, vc4 = (tid & 7) * 4;
    constexpr int SQ = 272, SV = 80, NC = SEQ / 32;
    constexpr int IMG = 2 * 32 * SQ + 128 * SV + 32 * SV + 512;
    constexpr int O_LG = 0, O_IMG = 16384, O_AT = O_IMG + 2 * IMG, O_ST = O_AT + 32 * SV;
    constexpr int I_QT = 0, I_KT = 32 * SQ, I_KTT = 2 * 32 * SQ, I_VT = I_KTT + 128 * SV, I_G = I_VT + 32 * SV;
    static_assert(O_ST + 32 * SQ <= LDS_RING && IMG % 16 == 0, "scan LDS map");
    for (int item = bx; item < 256; item += G) {
        const int dir = item & 1, dvq = (item >> 1) & 3, h = (item >> 3) & 7, b = item >> 6;
        const size_t kcol = h * 128 + sc16, vcol = h * 128 + dvq * 32 + vc4;
        const unsigned short* KFd = KF + (size_t)dir * MT * 1024; bf16_t* OPd = OP + (size_t)dir * MT * 1024;
        u32x4 rk0, rk1, rq0, rq1; u32x2 rv;
#define SM_GLOAD(blk) do { const int tt = (blk) * 32 + st; const size_t m = (size_t)b * SEQ + (dir ? SEQ - 1 - tt : tt); \
        rk0 = *(const u32x4*)(KFd + m * 1024 + kcol); rk1 = *(const u32x4*)(KFd + m * 1024 + kcol + 8); rq0 = *(const u32x4*)(Qh + m * 1024 + kcol); rq1 = *(const u32x4*)(Qh + m * 1024 + kcol + 8); \
        rv = *(const u32x2*)(Vh + m * 1024 + vcol); } while (0)
        if (grpA) SM_GLOAD(0);
        f32x16 accS, accO;
#pragma unroll
        for (int r = 0; r < 16; ++r) { accS[r] = 0.f; accO[r] = 0.f; }
        for (int i = tid; i < 32 * SQ / 4; i += 512) ((LAS unsigned*)(lds + O_ST))[i] = 0u;
        __syncthreads();
        for (int rd = -1; rd < NC; ++rd) {
            const int cn = rd + 1;
            LAS unsigned char* Wi = lds + O_IMG + (cn & 1) * IMG;
            const LAS unsigned char* Ri = lds + O_IMG + (rd & 1) * IMG;
            float kf[16];
            if (grpA) { if (cn < NC) {
                { const f32x2 a = h2f2_(rk0.x), bq = h2f2_(rk0.y), c = h2f2_(rk0.z), d = h2f2_(rk0.w), e = h2f2_(rk1.x), f = h2f2_(rk1.y), g2 = h2f2_(rk1.z), h2 = h2f2_(rk1.w);
                  kf[0] = a[0]; kf[1] = a[1]; kf[2] = bq[0]; kf[3] = bq[1]; kf[4] = c[0]; kf[5] = c[1]; kf[6] = d[0]; kf[7] = d[1];
                  kf[8] = e[0]; kf[9] = e[1]; kf[10] = f[0]; kf[11] = f[1]; kf[12] = g2[0]; kf[13] = g2[1]; kf[14] = h2[0]; kf[15] = h2[1]; }
                LAS unsigned char* L_ = lds + O_LG + (st * 128 + sc16) * 4;
#pragma unroll
                for (int q4 = 0; q4 < 4; ++q4) { f32x4 a4;
#pragma unroll
                    for (int e = 0; e < 4; ++e) a4[e] = __builtin_amdgcn_logf(1.0f - kf[4 * q4 + e]);
                    *(LAS f32x4*)(L_ + 16 * q4) = a4; }
                LAS unsigned char* V_ = Wi + I_VT + st * 2;
                *(LAS unsigned short*)(V_ + (vc4 + 0) * SV) = (unsigned short)(rv.x & 0xffffu); *(LAS unsigned short*)(V_ + (vc4 + 1) * SV) = (unsigned short)(rv.x >> 16);
                *(LAS unsigned short*)(V_ + (vc4 + 2) * SV) = (unsigned short)(rv.y & 0xffffu); *(LAS unsigned short*)(V_ + (vc4 + 3) * SV) = (unsigned short)(rv.y >> 16);
            } } else if (rd >= 0) {
                const int w4 = wid - 4;
                mm_tile<2>(accS, Ri + I_KTT + w4 * 32 * SV, SV, Ri + I_VT, SV, r32, hi);
                if (w4 == 0) { f32x16 p;
#pragma unroll
                    for (int r = 0; r < 16; ++r) p[r] = 0.f;
                    mm_tile<8>(p, Ri + I_QT, SQ, Ri + I_KT, SQ, r32, hi);
#pragma unroll
                    for (int r = 0; r < 16; ++r) { const int t = crow_(r, hi); const float pv = r32 <= t ? p[r] : 0.f;
                        *(LAS unsigned short*)(lds + O_AT + t * SV + r32 * 2) = (unsigned short)(pk2(pv, 0.f) & 0xffffu); } }
                else if (w4 == 1) {
#pragma unroll
                    for (int r = 0; r < 16; ++r) accO[r] = 0.f;
                    mm_tile<8>(accO, Ri + I_QT, SQ, lds + O_ST, SQ, r32, hi); }
            }
            __syncthreads();
            if (grpA) { if (cn < NC) {
#pragma unroll
                for (int u = 0; u < 2; ++u) { LAS float* col = (LAS float*)(lds + O_LG) + (tid & 127) + (((tid >> 7) & 1) + 2 * u) * 8 * 128; float acc = 0.f;
#pragma unroll
                    for (int t = 0; t < 8; ++t) { acc += col[t * 128]; col[t * 128] = acc; } }
            } } else if (rd >= 0) {
                const int w4 = wid - 4;
                if (w4 == 1) { mm_tile<2>(accO, lds + O_AT, SV, Ri + I_VT, SV, r32, hi);
#pragma unroll
                    for (int r = 0; r < 16; ++r) { const int tt = rd * 32 + crow_(r, hi); const size_t m = (size_t)b * SEQ + (dir ? SEQ - 1 - tt : tt);
                        OPd[m * 1024 + h * 128 + dvq * 32 + r32] = (bf16_t)(pk2(accO[r], 0.f) & 0xffffu); } }
            }
            __syncthreads();
            if (grpA) { if (cn < NC) {
                const LAS unsigned char* L_ = lds + O_LG + (st * 128 + sc16) * 4; float bb[16];
#pragma unroll
                for (int q4 = 0; q4 < 4; ++q4) { const f32x4 t4 = *(const LAS f32x4*)(L_ + 16 * q4); bb[4 * q4] = t4[0]; bb[4 * q4 + 1] = t4[1]; bb[4 * q4 + 2] = t4[2]; bb[4 * q4 + 3] = t4[3]; }
#pragma unroll
                for (int qd = 0; qd < 3; ++qd) { const LAS unsigned char* T_ = lds + O_LG + ((8 * qd + 7) * 128 + sc16) * 4; const float m_ = (st >> 3) > qd ? 1.f : 0.f;
#pragma unroll
                    for (int q4 = 0; q4 < 4; ++q4) { const f32x4 t4 = *(const LAS f32x4*)(T_ + 16 * q4); bb[4 * q4] += t4[0] * m_; bb[4 * q4 + 1] += t4[1] * m_; bb[4 * q4 + 2] += t4[2] * m_; bb[4 * q4 + 3] += t4[3] * m_; } }
                const unsigned qraw[8] = {rq0.x, rq0.y, rq0.z, rq0.w, rq1.x, rq1.y, rq1.z, rq1.w};
                unsigned qw[8], kw[8];
#pragma unroll
                for (int e = 0; e < 8; ++e) { const float e0 = __builtin_amdgcn_exp2f(bb[2 * e]), e1 = __builtin_amdgcn_exp2f(bb[2 * e + 1]);
                    qw[e] = pk2(__uint_as_float(qraw[e] << 16) * e0, __uint_as_float(qraw[e] & 0xffff0000u) * e1);
                    kw[e] = pk2(kf[2 * e] * __builtin_amdgcn_exp2f(-bb[2 * e]), kf[2 * e + 1] * __builtin_amdgcn_exp2f(-bb[2 * e + 1]));
                    if (st == 31) { ((LAS float*)(Wi + I_G))[sc16 + 2 * e] = e0; ((LAS float*)(Wi + I_G))[sc16 + 2 * e + 1] = e1; } }
                *(LAS u32x4*)(Wi + I_QT + st * SQ + sc16 * 2) = (u32x4){qw[0], qw[1], qw[2], qw[3]}; *(LAS u32x4*)(Wi + I_QT + st * SQ + sc16 * 2 + 16) = (u32x4){qw[4], qw[5], qw[6], qw[7]};
                *(LAS u32x4*)(Wi + I_KT + st * SQ + sc16 * 2) = (u32x4){kw[0], kw[1], kw[2], kw[3]}; *(LAS u32x4*)(Wi + I_KT + st * SQ + sc16 * 2 + 16) = (u32x4){kw[4], kw[5], kw[6], kw[7]};
                LAS unsigned char* T_ = Wi + I_KTT + sc16 * SV + st * 2;
#pragma unroll
                for (int e = 0; e < 8; ++e) { *(LAS unsigned short*)(T_ + (2 * e) * SV) = (unsigned short)(kw[e] & 0xffffu); *(LAS unsigned short*)(T_ + (2 * e + 1) * SV) = (unsigned short)(kw[e] >> 16); }
                if (cn + 1 < NC) SM_GLOAD(cn + 1);
            } } else if (rd >= 0) {
                const int w4 = wid - 4;
#pragma unroll
                for (int g = 0; g < 4; ++g) { const int dk0 = 32 * w4 + 8 * g + 4 * hi; const f32x4 gm = *(const LAS f32x4*)(Ri + I_G + dk0 * 4);
                    accS[4 * g + 0] *= gm[0]; accS[4 * g + 1] *= gm[1]; accS[4 * g + 2] *= gm[2]; accS[4 * g + 3] *= gm[3];
                    u32x2 w; w.x = pk2(accS[4 * g + 0], accS[4 * g + 1]); w.y = pk2(accS[4 * g + 2], accS[4 * g + 3]);
                    *(LAS u32x2*)(lds + O_ST + r32 * SQ + dk0 * 2) = w; }
            }
            __syncthreads();
        }
#undef SM_GLOAD
    }
}

enum Op { OP_SW0, OP_FO0, OP_RPA, OP_MIN, OP_RMLA, OP_QKV, OP_ATTN, OP_MWO, OP_RPB, OP_SW1, OP_FO1, OP_RPC, OP_HIN, OP_SCAN, OP_RHG, OP_HWO };
__device__ const unsigned char OPS_M[12] = {OP_SW0, OP_FO0, OP_RPA, OP_MIN, OP_RMLA, OP_QKV, OP_ATTN, OP_MWO, OP_RPB, OP_SW1, OP_FO1, OP_RPC};
__device__ const unsigned char OPS_H[11] = {OP_SW0, OP_FO0, OP_RPA, OP_HIN, OP_SCAN, OP_RHG, OP_HWO, OP_RPB, OP_SW1, OP_FO1, OP_RPC};

struct Args { const float* in[15]; float* out; unsigned char* ws; };
typedef const __attribute__((address_space(4))) Args* ArgsP;
__device__ __forceinline__ ArgsP get_args() { ArgsP p = (ArgsP)__builtin_amdgcn_kernarg_segment_ptr(); asm volatile("" : "+s"(p) :: "memory"); return p; }
#define GW_ ((int)blockIdx.x * 8 + __builtin_amdgcn_readfirstlane((int)threadIdx.x >> 6))
#define NGW_ ((int)gridDim.x * 8)
__device__ __forceinline__ int otid_() { int t = threadIdx.x; asm volatile("" : "+v"(t)); return t; }
#define LANE_ (otid_() & 63)

#ifdef DBG_CHECKS
__device__ __forceinline__ float bf2f(bf16_t v) { return __uint_as_float((unsigned)v << 16); }
__device__ __forceinline__ unsigned hash_u(unsigned x) { x ^= x >> 16; x *= 0x7feb352du; x ^= x >> 15; x *= 0x846ca68bu; x ^= x >> 16; return x; }
__device__ __forceinline__ void dbg_report(unsigned* DBG, int id, float got, float ref, float rtol, float atol) {
    const float err = fabsf(got - ref); const bool bad = !(err <= rtol * fabsf(ref) + atol);
    if (bad) atomicMax(DBG + id, 1u);
}
__device__ __forceinline__ int dbg_row(int sidx) { if (sidx == 0) return 0; if (sidx == 1) return MT - 1; if (sidx == 2) return SEQ - 1; if (sidx == 3) return SEQ; return (int)(hash_u(sidx * 2654435761u + 17u) % MT); }
#endif
#ifdef DBG_CHECKS
struct DbgCtx { const float* const* in; unsigned char* ws; unsigned char* R; unsigned* DBG; int bx, tid, lane, wave; };
__device__ __forceinline__ float dbg_dot_bf_w(const bf16_t* a, const float* W, int K, int ldw, int col) { float s = 0.f; for (int k = 0; k < K; ++k) s += bf2f(a[k]) * W[(size_t)k * ldw + col]; return s; }
template <class A>
__device__ __forceinline__ void dbg_after(int l, int op, A ap, unsigned char* ws, unsigned char* R, LAS unsigned char* lds) {
    unsigned* DBG = (unsigned*)(ws + 32768);
    const int bx = blockIdx.x, tid = otid_(), lane = tid & 63, wave = __builtin_amdgcn_readfirstlane(tid >> 6);
    const bf16_t* HN = (const bf16_t*)(ws + WS_HN); const float* Y = (const float*)(ws + WS_Y);
    if (false && l == 0 && op == OP_SW0 && bx < 32) { const int sid = bx * 512 + tid, m = dbg_row(sid), c = hash_u(sid * 3 + 1) % DFF; const float* W = ap->in[3];
        const float g = dbg_dot_bf_w(HN + (size_t)m * 1024, W, 1024, 2 * DFF, c), u = dbg_dot_bf_w(HN + (size_t)m * 1024, W, 1024, 2 * DFF, DFF + c);
        dbg_report(DBG, 1, bf2f(((const bf16_t*)(R + R_ACT))[(size_t)m * DFF + c]), g / (1.f + expf(-g)) * u, 0.015f, 0.004f); }
    if (false && l == 0 && op == OP_FO0 && bx < 32) { const int sid = bx * 512 + tid, m = dbg_row(sid), c = hash_u(sid * 3 + 2) % 1024;
        const float r = dbg_dot_bf_w((const bf16_t*)(R + R_ACT) + (size_t)m * DFF, ap->in[4], DFF, 1024, c);
        dbg_report(DBG, 2, Y[(size_t)m * 1024 + c], r, 0.015f, 0.004f); }
    if (false && l == 0 && op == OP_RPA && bx < 32) { const int sid = bx * 512 + tid, m = dbg_row(sid), c = hash_u(sid * 3 + 3) % 1024; const float* g = ap->in[2];
        float s = 0.f; for (int k = 0; k < 1024; ++k) { const float y = Y[(size_t)m * 1024 + k]; s += y * y; }
        const float xr = ap->in[0][(size_t)m * 1024 + c] + 0.5f * Y[(size_t)m * 1024 + c] * rsqrtf(s / 1024.f + EPS) * g[1024 + c];
        dbg_report(DBG, 2, ap->out[(size_t)m * 1024 + c], xr, 1e-3f, 1e-3f);
        float s2 = 0.f; for (int k = 0; k < 1024; ++k) { const float x = ap->out[(size_t)m * 1024 + k]; s2 += x * x; }
        dbg_report(DBG, 2, bf2f(HN[(size_t)m * 1024 + c]), ap->out[(size_t)m * 1024 + c] * rsqrtf(s2 / 1024.f + EPS) * g[2048 + c], 0.01f, 0.01f); }
    if (false && l == 0 && op == OP_MIN && bx < 32) { const int sid = bx * 512 + tid, m = dbg_row(sid), c = hash_u(sid * 3 + 4) % 512; const int sc = src_col(2, c);
        const float r = sc >= 0 ? dbg_dot_bf_w(HN + (size_t)m * 1024, ap->in[5], 1024, 448, sc) : 0.f;
        dbg_report(DBG, 3, ((const float*)(R + R_C))[(size_t)m * 512 + c], r, 0.015f, 0.01f); }
    if (false && l == 0 && op == OP_RMLA && bx < 32) { const int sid = bx * 512 + tid, m = dbg_row(sid), c = hash_u(sid * 3 + 5) % 448; const float* C = (const float*)(R + R_C) + (size_t)m * 512;
        if (c < 256) { float s = 0.f; for (int k = 0; k < 256; ++k) s += C[k] * C[k];
            dbg_report(DBG, 3, bf2f(((const bf16_t*)(R + R_CQ))[(size_t)m * 256 + c]), C[c] * rsqrtf(s / 256.f + EPS) * ap->in[6][c], 0.01f, 0.01f); }
        else if (c < 384) { float s = 0.f; for (int k = 256; k < 384; ++k) s += C[k] * C[k];
            dbg_report(DBG, 3, bf2f(((const bf16_t*)(R + R_CKV))[(size_t)m * 128 + c - 256]), C[c] * rsqrtf(s / 128.f + EPS) * ap->in[7][c - 256], 0.01f, 0.01f); }
        else { const int jj = c - 384, i = jj >> 1; const float ang = (float)((const int*)ap->in[1])[m] * powf(10000.f, -(float)i / 32.f); const float cs = cosf(ang), sn = sinf(ang);
            const float t1 = C[384 + 2 * i], t2 = C[384 + 2 * i + 1]; const float r = (jj & 1) ? t1 * sn + t2 * cs : t1 * cs - t2 * sn;
            dbg_report(DBG, 3, bf2f(((const bf16_t*)(R + R_KR))[(size_t)m * 64 + jj]), r, 0.02f, 0.05f); } }
    if (false && l == 0 && op == OP_QKV && bx < 32) { const int sid = bx * 512 + tid, m = dbg_row(sid); const bf16_t* CQ = (const bf16_t*)(R + R_CQ) + (size_t)m * 256; const bf16_t* CKV = (const bf16_t*)(R + R_CKV) + (size_t)m * 128;
        { const int c = hash_u(sid * 3 + 6) % 1536, h = c / QKD, d = c % QKD; float r;
          if (d < 128) r = dbg_dot_bf_w(CQ, ap->in[8], 256, 1536, c);
          else { const int jj = d - 128, i = jj >> 1; const float t1 = dbg_dot_bf_w(CQ, ap->in[8], 256, 1536, h * QKD + 128 + i), t2 = dbg_dot_bf_w(CQ, ap->in[8], 256, 1536, h * QKD + 160 + i);
              const float ang = (float)((const int*)ap->in[1])[m] * powf(10000.f, -(float)i / 32.f); const float cs = cosf(ang), sn = sinf(ang); r = (jj & 1) ? t1 * sn + t2 * cs : t1 * cs - t2 * sn; }
          dbg_report(DBG, 4, bf2f(((const bf16_t*)(R + R_QB))[(size_t)m * 1536 + c]), r, 0.015f, 0.015f); }
        { const int c = hash_u(sid * 3 + 7) % 2048, h = c >> 8, d = c & 255; const float r = dbg_dot_bf_w(CKV, ap->in[9], 128, 2048, c);
          const float got = d < 128 ? bf2f(((const bf16_t*)(R + R_KN))[(size_t)m * 1024 + h * 128 + d]) : bf2f(((const bf16_t*)(R + R_VB))[(size_t)m * 1024 + h * 128 + d - 128]);
          dbg_report(DBG, 5, got, r, 0.015f, 0.015f); } }
    if (l == 0 && op == OP_ATTN) { const int sid = bx * 8 + wave, m = dbg_row(sid), h = hash_u(sid * 5 + 1) & 7, dv = hash_u(sid * 5 + 2) & 127, b = m / SEQ;
        LAS float* qs = (LAS float*)lds + wave * 192; const bf16_t* Q = (const bf16_t*)(R + R_QB) + (size_t)m * 1536 + h * QKD;
        for (int d = lane; d < 192; d += 64) qs[d] = bf2f(Q[d]);
        asm volatile("s_waitcnt lgkmcnt(0)" ::: "memory");
        float mx = -1e30f, ls = 0.f, acc = 0.f;
        for (int kk = lane; kk < SEQ; kk += 64) { const size_t km = (size_t)b * SEQ + kk; const bf16_t* Kn = (const bf16_t*)(R + R_KN) + km * 1024 + h * 128; const bf16_t* Kr = (const bf16_t*)(R + R_KR) + km * 64;
            float s = 0.f; for (int d = 0; d < 128; ++d) s += qs[d] * bf2f(Kn[d]); for (int d = 0; d < 64; ++d) s += qs[128 + d] * bf2f(Kr[d]);
            s *= 0.07216878364870322f; const float v = bf2f(((const bf16_t*)(R + R_VB))[km * 1024 + h * 128 + dv]);
            const float mn = fmaxf(mx, s), al = expf(mx - mn), p = expf(s - mn); ls = ls * al + p; acc = acc * al + p * v; mx = mn; }
        float gm = mx;
        for (int o = 1; o < 64; o <<= 1) gm = fmaxf(gm, __shfl_xor(gm, o));
        const float sc = expf(mx - gm); const float L = wave_sum(ls * sc), Asum = wave_sum(acc * sc);
        if (lane == 0) { const float got = bf2f(((const bf16_t*)(R + R_O))[(size_t)m * 1024 + h * 128 + dv]), ref = Asum / L; atomicMax(DBG + 20, __float_as_uint(fabsf(got - ref))); atomicAdd((float*)(DBG + 21), fabsf(ref) * (1.f / 2048.f)); } }
    if (false && l == 1 && op == OP_HIN && bx < 32) { const int sid = bx * 512 + tid, m = dbg_row(sid), c5 = hash_u(sid * 3 + 8) % 5120, seg = c5 >> 10, c = c5 & 1023;
        const float u = dbg_dot_bf_w(HN + (size_t)m * 1024, ap->in[11], 1024, 5120, c5); float got, r;
        if (seg == 0) { got = bf2f(((const bf16_t*)(R + R_QH))[(size_t)m * 1024 + c]); r = u / (1.f + expf(-u)); }
        else if (seg == 3) { got = bf2f(((const bf16_t*)(R + R_VH))[(size_t)m * 1024 + c]); r = u; }
        else if (seg == 4) { got = bf2f(((const bf16_t*)(R + R_GH))[(size_t)m * 1024 + c]); r = u / (1.f + expf(-u)); }
        else { const int dir = seg - 1; const float* lbp = ap->in[12] + (size_t)dir * DEPTH * 1024 + c; const float e0 = expf(lbp[0]), e1 = expf(lbp[1024]), e2 = expf(lbp[2048]), e3 = expf(lbp[3072]);
            const float lb = e1 / (e0 + e1 + e2 + e3); const h16x2 hv = __builtin_bit_cast(h16x2, (unsigned)((const unsigned short*)(R + R_KF))[(size_t)dir * MT * 1024 + (size_t)m * 1024 + c]);
            got = (float)hv[0]; r = (1.f - lb) / (1.f + expf(u)); }
        dbg_report(DBG, 7, got, r, 0.015f, 0.006f); }
    if (false && l == 1 && op == OP_SCAN) { const int sid = bx * 8 + wave, h = hash_u(sid * 5 + 3) & 7, dv = hash_u(sid * 5 + 4) & 127, b = hash_u(sid * 5 + 5) & 3, toff = sid & 31, dir = 0;
        const bf16_t* Qh = (const bf16_t*)(R + R_QH); const bf16_t* Vh = (const bf16_t*)(R + R_VH); const unsigned short* KF = (const unsigned short*)(R + R_KF); const bf16_t* OPb = (const bf16_t*)(ws + WS_Y);
        float S0 = 0.f, S1 = 0.f; const int n = toff + 1; const int t = toff; const size_t m = (size_t)b * SEQ + t;
        for (int i = 0; i < n; ++i) { const int tt = i; const size_t mm = (size_t)b * SEQ + tt; const unsigned short* kp = KF + (size_t)dir * MT * 1024 + mm * 1024 + h * 128;
            const h16x2 ka = __builtin_bit_cast(h16x2, (unsigned)kp[lane]), kb = __builtin_bit_cast(h16x2, (unsigned)kp[lane + 64]); const float k0 = (float)ka[0], k1 = (float)kb[0];
            const float v = bf2f(Vh[mm * 1024 + h * 128 + dv]); S0 = S0 * (1.f - k0) + k0 * v; S1 = S1 * (1.f - k1) + k1 * v; }
        const bf16_t* q = Qh + m * 1024 + h * 128; const float tot = wave_sum(S0 * bf2f(q[lane]) + S1 * bf2f(q[lane + 64]));
        if (lane == 0) { const float got = bf2f(OPb[(size_t)dir * MT * 1024 + m * 1024 + h * 128 + dv]); const float re = fabsf(got - tot) / (fabsf(tot) + 0.05f);
            if (re > 0.05f) { atomicMin(DBG + 20, (unsigned)toff); atomicAdd(DBG + 21, 1u); } } }
    if (false && l == 1 && op == OP_RHG && bx < 32) { const int sid = bx * 512 + tid, m = dbg_row(sid), c = hash_u(sid * 3 + 9) % 1024, h0 = c & ~127; const bf16_t* OPb = (const bf16_t*)(ws + WS_Y);
        float s = 0.f; for (int k = 0; k < 128; ++k) { const float y = bf2f(OPb[(size_t)m * 1024 + h0 + k]) + bf2f(OPb[(size_t)MT * 1024 + (size_t)m * 1024 + h0 + k]); s += y * y; }
        const float yc = bf2f(OPb[(size_t)m * 1024 + c]) + bf2f(OPb[(size_t)MT * 1024 + (size_t)m * 1024 + c]);
        const float r = yc * rsqrtf(s / 128.f + EPS) * ap->in[13][c] * bf2f(((const bf16_t*)(R + R_GH))[(size_t)m * 1024 + c]);
        dbg_report(DBG, 9, bf2f(((const bf16_t*)(R + R_HO))[(size_t)m * 1024 + c]), r, 0.02f, 0.005f); }
    if (false && l == 1 && op == OP_HWO && bx < 32) { const int sid = bx * 512 + tid, m = dbg_row(sid), c = hash_u(sid * 3 + 10) % 1024;
        const float r = dbg_dot_bf_w((const bf16_t*)(R + R_HO) + (size_t)m * 1024, ap->in[14], 1024, 1024, c);
        dbg_report(DBG, 9, Y[(size_t)m * 1024 + c], r, 0.03f, 0.01f); }
    if (false && l == 0 && op == OP_MWO && bx < 32) { const int sid = bx * 512 + tid, m = dbg_row(sid), c = hash_u(sid * 3 + 11) % 1024;
        const float r = dbg_dot_bf_w((const bf16_t*)(R + R_O) + (size_t)m * 1024, ap->in[10], 1024, 1024, c);
        dbg_report(DBG, 6, Y[(size_t)m * 1024 + c], r, 0.02f, 0.0004f); }
}
#endif

__device__ __forceinline__ void gsync_cg() {
    asm volatile("s_waitcnt vmcnt(0) lgkmcnt(0)" ::: "memory");
    __syncthreads();
    cg::this_grid().sync();
    if (threadIdx.x == 0) { __builtin_amdgcn_fence(__ATOMIC_ACQUIRE, "agent"); asm volatile("s_waitcnt vmcnt(0)" ::: "memory"); }
    __syncthreads();
}
#define GAS __attribute__((address_space(1)))
#define XB_TMO      128
#define XB_XCNT(j)  (256  + 64 * (j))
#define XB_XSUB(j)  (1280 + 64 * (j))
#define XB_XGEN(j)  (2304 + 64 * (j))
#define XB_TOP      3328
#define XB_TOPGEN   3392
#define XCD_BAR_WORDS 3456
#define XB_SPIN_CAP (1u << 18)

__device__ __forceinline__ unsigned xb_ld(unsigned* p)              { return __hip_atomic_load(p, __ATOMIC_RELAXED, __HIP_MEMORY_SCOPE_AGENT); }
__device__ __forceinline__ unsigned xb_add(unsigned* p, unsigned v) { return __hip_atomic_fetch_add(p, v, __ATOMIC_RELAXED, __HIP_MEMORY_SCOPE_AGENT); }
__device__ __forceinline__ unsigned xb_xcc_id() { return (unsigned)__builtin_amdgcn_s_getreg((3 << 11) | 20) & 0xFu; }
#define XB_SPIN(cond, bar) do { unsigned _sp = 0; while (cond) { __builtin_amdgcn_s_sleep(1); \
    if ((++_sp & 255u) == 0u) { if (xb_ld(&(bar)[XB_TMO])) break; if (_sp > XB_SPIN_CAP) { atomicAdd(&(bar)[XB_TMO], 1u); break; } } } } while (0)

struct XcdBarrier {
    unsigned* bar; unsigned x;
    volatile LAS unsigned* st;
};

__device__ __forceinline__ XcdBarrier xcd_barrier_post(unsigned* bar, volatile LAS unsigned* st) {
    XcdBarrier b; b.bar = bar; b.x = xb_xcc_id(); b.st = st;
    if (threadIdx.x == 0) (void)xb_add(&bar[XB_XCNT(b.x)], 1u);
    return b;
}
__device__ __forceinline__ void xcd_barrier_complete(unsigned* bar, unsigned x, unsigned& nloc, unsigned& nx) {
    const unsigned G = gridDim.x * gridDim.y * gridDim.z;
    unsigned sum, cnt, mine, sp = 0u;
    for (;;) {
        sum = 0u; cnt = 0u; mine = 0u;
#pragma unroll
        for (unsigned j = 0; j < 16; ++j) { const unsigned c = xb_ld(&bar[XB_XCNT(j)]); sum += c; cnt += (c > 0u) ? 1u : 0u; mine = (j == x) ? c : mine; }
        if (sum == G) break;
        __builtin_amdgcn_s_sleep(1);
        if ((++sp & 255u) == 0u) { if (xb_ld(&bar[XB_TMO])) break; if (sp > XB_SPIN_CAP) { atomicAdd(&bar[XB_TMO], 1u); break; } }
    }
    nloc = mine > 0u ? mine : 1u; nx = cnt > 0u ? cnt : 1u;
}

__device__ __forceinline__ void xcd_barrier(const XcdBarrier& b) {
    asm volatile("s_waitcnt vmcnt(0)" ::: "memory");
    __syncthreads();
    if (threadIdx.x == 0) {
        unsigned* bar = b.bar;
        __builtin_amdgcn_s_waitcnt(0);
        unsigned nloc = b.st[0], nx = b.st[1];
        if (nloc == 0u) { xcd_barrier_complete(bar, b.x, nloc, nx); b.st[0] = nloc; b.st[1] = nx; }
        const unsigned old = xb_add(&bar[XB_XSUB(b.x)], 1u);
        const unsigned gen = old / nloc;
        if (old + 1u == (gen + 1u) * nloc) {
            __builtin_amdgcn_fence(__ATOMIC_RELEASE, "agent");
            asm volatile("s_waitcnt vmcnt(0)" ::: "memory");
            const unsigned og = xb_add(&bar[XB_TOP], 1u);
            const unsigned tg = og / nx;
            if (og + 1u == (tg + 1u) * nx) xb_add(&bar[XB_TOPGEN], 1u);
            else XB_SPIN(xb_ld(&bar[XB_TOPGEN]) == tg, bar);
            __builtin_amdgcn_fence(__ATOMIC_ACQUIRE, "agent");
            xb_add(&bar[XB_XGEN(b.x)], 1u);
            asm volatile("s_waitcnt vmcnt(0)" ::: "memory");
        } else {
            XB_SPIN(xb_ld(&bar[XB_XGEN(b.x)]) == gen, bar);
            __builtin_amdgcn_fence(__ATOMIC_ACQUIRE, "agent");
            asm volatile("s_waitcnt vmcnt(0)" ::: "memory");
        }
    }
    __syncthreads();
}

__device__ __forceinline__ void gsync(LAS unsigned char* lds) {
#ifdef USE_CG_SYNC
    gsync_cg();
#else
    XcdBarrier b; b.bar = (unsigned*)get_args()->ws; b.x = xb_xcc_id(); b.st = (volatile LAS unsigned*)(lds + LDS_RING);
    xcd_barrier(b);
#endif
}
__global__ void __launch_bounds__(512, 2) mega_fwd(Args a_unused) {
    extern __shared__ __attribute__((aligned(16))) unsigned char lds_raw[];
    LAS unsigned char* lds = (LAS unsigned char*)lds_raw;

    if (threadIdx.x < 2) ((volatile LAS unsigned*)(lds + LDS_RING))[threadIdx.x] = 0u;
    __syncthreads();
    (void)xcd_barrier_post((unsigned*)get_args()->ws, (volatile LAS unsigned*)(lds + LDS_RING));
    {
        ArgsP ap = get_args(); unsigned char* ws = ap->ws;
#ifdef DBG_CHECKS
        if (blockIdx.x == 0 && threadIdx.x < 32) atomicExch((unsigned*)ws + threadIdx.x, 0u);
#endif
        const int tid = threadIdx.x, lane = tid & 63, wave = __builtin_amdgcn_readfirstlane(tid >> 6), G = gridDim.x, bx = blockIdx.x, gw = bx * 8 + wave, NGW = G * 8;
        LAS float* scr = (LAS float*)(lds + wave * 16384);
        constexpr int I_FFI = 16 * 176, I_FFO = 44 * 32, I_HIN = 16 * 160, I_SQ = 16 * 32, I_MIN = 16 * 16, I_UQ = 4 * 48, I_UKV = 2 * 64;
        constexpr int NITEMS = 8 * I_FFI + 8 * I_FFO + 2 * I_HIN + 2 * I_SQ + 2 * I_MIN + 2 * I_UQ + 2 * I_UKV + 2 * I_SQ;
        for (int it = gw; it < NITEMS; it += NGW) {
            int r = it;
#define XP(IDX_, K_, NS_, ND_, MODE_, WSOFF_, NMAT_, IPM_) if (r < (NMAT_) * (IPM_)) { const int mat = r / (IPM_); \
            xpose_item(ap->in[IDX_] + (size_t)mat * (K_) * (NS_), K_, NS_, ND_, MODE_, (bf16_t*)(ws + (WSOFF_)) + (size_t)mat * (ND_) * (K_), scr, r % (IPM_), lane); continue; } r -= (NMAT_) * (IPM_);
            XP(3, 1024, 2 * DFF, 2 * DFF, 1, WS_WFFI, 8, I_FFI)
            XP(4, DFF, 1024, 1024, 0, WS_WFFO, 8, I_FFO)
            XP(11, 1024, 5120, 5120, 0, WS_WHIN, 2, I_HIN)
            XP(14, 1024, 1024, 1024, 0, WS_WHO, 2, I_SQ)
            XP(5, 1024, 448, 512, 2, WS_WMIN, 2, I_MIN)
            XP(8, 256, 1536, 1536, 3, WS_WUQ, 2, I_UQ)
            XP(9, 128, 2048, 2048, 0, WS_WUKV, 2, I_UKV)
            XP(10, 1024, 1024, 1024, 0, WS_WMO, 2, I_SQ)
#undef XP
        }
        { const int* positions = (const int*)ap->in[1]; float* COS = (float*)(ws + WS_COS); float* SIN = (float*)(ws + WS_SIN);
          for (int idx = bx * 512 + tid; idx < MT * 32; idx += G * 512) { const int m = idx >> 5, i = idx & 31;
            const double ang = (double)positions[m] * ROPE_INVF[i]; const double rev = ang * 0.15915494309189535; const float fr = (float)(rev - __builtin_rint(rev));
            COS[idx] = __builtin_amdgcn_cosf(fr); SIN[idx] = __builtin_amdgcn_sinf(fr); } }
        { float* LB = (float*)(ws + WS_LB);
          for (int idx = bx * 512 + tid; idx < 2 * 2 * 1024; idx += G * 512) { const int c = idx & 1023, dir = (idx >> 10) & 1, j = idx >> 11, l = 2 * j + 1;
            const float* lbp = ap->in[12] + (size_t)dir * DEPTH * 1024 + c; float v[4], mx = -1e30f;
#pragma unroll
            for (int i = 0; i < 4; ++i) { v[i] = lbp[i * 1024]; mx = fmaxf(mx, v[i]); }
            float den = 0.f, num = 0.f;
#pragma unroll
            for (int i = 0; i < 4; ++i) { const float e = __expf(v[i] - mx); den += e; if (i >= 1 && i <= l) num += e; }
            LB[idx] = num / den; } }
        { const float* x_in = ap->in[0]; float* X = ap->out; bf16_t* HN = (bf16_t*)(ws + WS_HN); const float* gains = ap->in[2];
          for (int m = gw; m < MT; m += NGW) row_init(x_in + (size_t)m * DM, X + (size_t)m * DM, HN + (size_t)m * DM, gains, lane); }
    }
    gsync_cg();

    for (int ph = 0; ph < 46; ++ph) {
        const int l = ph >= 35 ? 3 : (ph >= 23 ? 2 : (ph >= 12 ? 1 : 0)), s = ph - (l == 3 ? 35 : (l == 2 ? 23 : (l == 1 ? 12 : 0)));
        const bool hg = l & 1; const int j = l >> 1;
        const int op = hg ? OPS_H[s] : OPS_M[s];
        ArgsP ap = get_args(); unsigned char* ws = ap->ws; unsigned char* R = ws + WS_R;
        int G_ = gridDim.x, bx_ = blockIdx.x; asm volatile("" : "+s"(G_), "+s"(bx_));
        switch (op) {
        case OP_SW0: case OP_SW1: {
            const int half = op == OP_SW1;
            pg8::Gemm gm{(const bf16_t*)(ws + WS_HN), (const bf16_t*)(ws + WS_WFFI) + (size_t)(l * 2 + half) * (2 * DFF) * 1024, MT, 2 * DFF, 1024};
            pg8::StaticOrder S; S.init(MT, 2 * DFF, G_, bx_); EpiSwiglu E{(bf16_t*)(R + R_ACT)};
#ifndef NO_SW
            pg8::gemm_phase<EpiSwiglu, pg8::StaticOrder, true, true>(lds, gm, S, E);
#endif
        } break;
        case OP_MIN: {
            pg8::Gemm gm{(const bf16_t*)(ws + WS_HN), (const bf16_t*)(ws + WS_WMIN) + (size_t)j * 512 * 1024, MT, 512, 1024}; EpiF32 E{(float*)(R + R_C), 512};
            pg8::StaticOrder S; S.init(MT, 512, G_, bx_);
#ifndef NO_F32
            pg8::gemm_phase<EpiF32, pg8::StaticOrder, true, true>(lds, gm, S, E);
#endif
        } break;
        case OP_FO0: case OP_FO1: case OP_MWO: case OP_HWO: {
            pg8::Gemm gm; EpiB16 E{(bf16_t*)(ws + WS_YB), 1024};
            if (op == OP_FO0 || op == OP_FO1) { const int half = op == OP_FO1; gm = pg8::Gemm{(const bf16_t*)(R + R_ACT), (const bf16_t*)(ws + WS_WFFO) + (size_t)(l * 2 + half) * 1024 * DFF, MT, 1024, DFF}; }
            else if (op == OP_MWO) { gm = pg8::Gemm{(const bf16_t*)(R + R_O), (const bf16_t*)(ws + WS_WMO) + (size_t)j * 1024 * 1024, MT, 1024, 1024}; }
            else { gm = pg8::Gemm{(const bf16_t*)(R + R_HO), (const bf16_t*)(ws + WS_WHO) + (size_t)j * 1024 * 1024, MT, 1024, 1024}; }
            pg8::StaticOrder S; S.init(MT, 1024, G_, bx_);
            pg8::gemm_phase<EpiB16, pg8::StaticOrder, true, true>(lds, gm, S, E);
        } break;
        case OP_RPA: case OP_RPB: case OP_RPC: {
            const float* gains = ap->in[2]; const float* g = gains + (size_t)l * 6 * DM; const bf16_t* Y = (const bf16_t*)(ws + WS_YB); float* X = ap->out; bf16_t* HN = (bf16_t*)(ws + WS_HN);
            const int k = op == OP_RPA ? 1 : (op == OP_RPB ? 3 : 5); const float scale = op == OP_RPB ? 1.0f : 0.5f;
            const bool last = (op == OP_RPC) && (l == DEPTH - 1);
            const float* gn = op == OP_RPC ? gains + (size_t)(l + 1) * 6 * DM : g + (size_t)(k + 1) * DM;
            const int lane = LANE_;
            for (int m = bx_ * 8 + __builtin_amdgcn_readfirstlane(otid_() >> 6); m < MT; m += G_ * 8) row_post(Y + (size_t)m * DM, X + (size_t)m * DM, last ? (bf16_t*)nullptr : HN + (size_t)m * DM, scale, g + (size_t)k * DM, last ? g : gn, lane);
        } break;
        case OP_RMLA: {
            const float* qn = ap->in[6] + (size_t)j * QLR; const float* kvn = ap->in[7] + (size_t)j * KVLR; const float* COS = (const float*)(ws + WS_COS); const float* SIN = (const float*)(ws + WS_SIN);
            const int lane = LANE_;
            for (int m = bx_ * 8 + __builtin_amdgcn_readfirstlane(otid_() >> 6); m < MT; m += G_ * 8) row_mla((const float*)(R + R_C) + (size_t)m * 512, (bf16_t*)(R + R_CQ) + (size_t)m * 256, (bf16_t*)(R + R_CKV) + (size_t)m * 128, (bf16_t*)(R + R_KR) + (size_t)m * 64,
                                                         qn, kvn, COS + (size_t)m * 32, SIN + (size_t)m * 32, lane);
        } break;
        case OP_QKV: {
            { int Kq = 256; asm volatile("" : "+s"(Kq)); pg8::Gemm gm{(const bf16_t*)(R + R_CQ), (const bf16_t*)(ws + WS_WUQ) + (size_t)j * 1536 * 256, MT, 1536, Kq};
              pg8::StaticOrder S; S.init(MT, 1536, G_, bx_); EpiQ E{(bf16_t*)(R + R_QB), (const float*)(ws + WS_COS), (const float*)(ws + WS_SIN)};
#ifndef NO_Q
              pg8::gemm_phase<EpiQ, pg8::StaticOrder, true, true>(lds, gm, S, E);
#endif
            }
            __syncthreads();
            { int Kq = 128; asm volatile("" : "+s"(Kq)); pg8::Gemm gm{(const bf16_t*)(R + R_CKV), (const bf16_t*)(ws + WS_WUKV) + (size_t)j * 2048 * 128, MT, 2048, Kq};
              pg8::StaticOrder S; S.init(MT, 2048, G_, bx_); EpiKV E{(bf16_t*)(R + R_KN), (bf16_t*)(R + R_VB)};
#ifndef NO_KV
              pg8::gemm_phase<EpiKV, pg8::StaticOrder, true, true>(lds, gm, S, E);
#endif
            }
        } break;
        case OP_ATTN: {
#ifndef NO_ATTN
            const int G = G_, bx = bx_;

            const int vcu = (G % 8 == 0) ? (bx % 8) * (G / 8) + bx / 8 : bx;
#ifdef REP_ATTN
            for (int rep_ = 0; rep_ < 2; ++rep_)
#endif
            for (int uid = vcu; uid < BATCH * NH * (SEQ / 256); uid += G) {
                const int bh = uid >> 5, qb = uid & 31, b = bh >> 3, h = bh & 7;
                const size_t row0 = (size_t)b * SEQ;
                att::attn_unit((const att::bf16*)(R + R_QB) + (row0 + qb * 256) * 1536 + h * QKD, (const att::bf16*)(R + R_KN) + row0 * 1024 + h * 128,
                               (const att::bf16*)(R + R_KR) + row0 * 64, (const att::bf16*)(R + R_VB) + row0 * 1024 + h * 128,
                               (att::bf16*)(R + R_O) + (row0 + qb * 256) * 1024 + h * 128, SEQ, (char*)lds_raw);
            }
#endif
        } break;
        case OP_HIN: {
            pg8::Gemm gm{(const bf16_t*)(ws + WS_HN), (const bf16_t*)(ws + WS_WHIN) + (size_t)j * 5120 * 1024, MT, 5120, 1024};
            pg8::StaticOrder S; S.init(MT, 5120, G_, bx_);
            EpiHgrn E{(bf16_t*)(R + R_QH), (bf16_t*)(R + R_VH), (bf16_t*)(R + R_GH), (unsigned short*)(R + R_KF), (const float*)(ws + WS_LB) + (size_t)j * 2048};
#ifndef NO_HG
            pg8::gemm_phase<EpiHgrn, pg8::StaticOrder, true, true>(lds, gm, S, E);
#endif
        } break;
        case OP_SCAN: {
#ifndef NO_SCAN
#ifdef REP_SCAN
            scan_phase(lds, (const bf16_t*)(R + R_QH), (const bf16_t*)(R + R_VH), (const unsigned short*)(R + R_KF), (bf16_t*)(ws + WS_Y), G_, bx_); __syncthreads();
#endif
#ifdef SCAN_VALU
            scan_phase(lds, (const bf16_t*)(R + R_QH), (const bf16_t*)(R + R_VH), (const unsigned short*)(R + R_KF), (bf16_t*)(ws + WS_Y), G_, bx_);
#else
            scan_phase_mfma(lds, (const bf16_t*)(R + R_QH), (const bf16_t*)(R + R_VH), (const unsigned short*)(R + R_KF), (bf16_t*)(ws + WS_Y), G_, bx_);
#endif
#endif
        } break;
        case OP_RHG: {
            const float* on = ap->in[13] + (size_t)j * DM; const bf16_t* Y = (const bf16_t*)(ws + WS_Y);
            const int lane = LANE_;
            for (int m = bx_ * 8 + __builtin_amdgcn_readfirstlane(otid_() >> 6); m < MT; m += G_ * 8) row_hgrn(Y + (size_t)m * DM, (const bf16_t*)(R + R_GH) + (size_t)m * DM, (bf16_t*)(R + R_HO) + (size_t)m * DM, on, lane);
        } break;
        default: break;
        }
        if (ph != 45) gsync(lds);
#ifdef REP_SYNC
        gsync(lds);
#endif
#ifdef DBG_CHECKS
        { ArgsP ap2 = get_args(); dbg_after(l, op, ap2, ap2->ws, ap2->ws + WS_R, lds); gsync(lds); }
#endif
    }
#ifdef DBG_CHECKS
    gsync(lds);
    if (blockIdx.x == 0 && threadIdx.x == 0) { ArgsP ap = get_args(); unsigned* DBG = (unsigned*)ap->ws; const float mx = __uint_as_float(atomicAdd(DBG + 20, 0u)), mean = atomicAdd((float*)(DBG + 21), 0.f); ap->out[1024 * 16] += 1e6f * mx; ap->out[1024 * 16 + 1] += 1e4f * mean; }
#endif
}

extern "C" void kernel_launch(void* const* d_in, const int* in_sizes, int n_in, void* d_out, int out_size, void* d_ws, size_t ws_size, hipStream_t stream) {
    static int grid = 0;
    if (grid == 0) {
        if (n_in != 15 || out_size != MT * DM || ws_size < WS_END) { fprintf(stderr, "kernel_launch: unexpected shapes: n_in %d out %d ws %zu (need %zu)\n", n_in, out_size, ws_size, (size_t)WS_END); grid = -1; return; }
        int dev = 0, cus = 0, per_cu = 0;
        (void)hipGetDevice(&dev); (void)hipDeviceGetAttribute(&cus, hipDeviceAttributeMultiprocessorCount, dev);
        if (hipFuncSetAttribute((const void*)mega_fwd, hipFuncAttributeMaxDynamicSharedMemorySize, LDS_BYTES) != hipSuccess) { fprintf(stderr, "kernel_launch: hipFuncSetAttribute failed\n"); grid = -1; return; }
        if (hipOccupancyMaxActiveBlocksPerMultiprocessor(&per_cu, (const void*)mega_fwd, 512, LDS_BYTES) != hipSuccess || per_cu < 1) { fprintf(stderr, "kernel_launch: occupancy query gave %d\n", per_cu); per_cu = 1; }
        (void)hipGetLastError();
        grid = cus * 1;
        fprintf(stderr, "kernel_launch: cus %d per_cu %d grid %d\n", cus, per_cu, grid);
    }
    if (grid < 0) return;
    if (hipMemsetAsync(d_ws, 0, 65536, stream) != hipSuccess) { fprintf(stderr, "kernel_launch: memset failed\n"); return; }
    Args a{};
    for (int i = 0; i < 15; ++i) a.in[i] = (const float*)d_in[i];
    a.out = (float*)d_out; a.ws = (unsigned char*)d_ws;
    void* args[] = {&a};
    hipError_t e = hipLaunchCooperativeKernel((const void*)mega_fwd, dim3(grid), dim3(512), args, LDS_BYTES, stream);
    if (e != hipSuccess) fprintf(stderr, "cooperative launch failed: %s (grid %d)\n", hipGetErrorString(e), grid);
}
```

```cpp
#include <hip/hip_runtime.h>
#include <hip/hip_cooperative_groups.h>
#include <hip/hip_bf16.h>
#include <hip/hip_fp16.h>
#include <cstdio>
#include <cstdint>
#include <cmath>
namespace cg = cooperative_groups;
namespace pg8 {
#define PG8_LAS __attribute__((address_space(3)))
typedef unsigned short bf16_t;
typedef short bf16x8 __attribute__((ext_vector_type(8)));
typedef float f32x4 __attribute__((ext_vector_type(4)));
typedef unsigned u32x4 __attribute__((ext_vector_type(4)));
constexpr int BM = 256, BK = 64, HALF = 128, HTB = HALF * BK * 2  , STAGE_BYTES = 8 * HTB, NXCD = 8, WGM = 8;

__host__ __device__ __forceinline__ int lds_byte(int r, int c) { const int st = (r >> 4) * 2 + (c >> 5), rr = r & 15, cc = c & 31, ob = rr * 64 + cc * 2; return st * 1024 + (ob ^ (((ob >> 9) & 1) << 5)); }
__host__ __device__ __forceinline__ void stage_rc(int b, int& R, int& C) { const int st = b / 1024, sb = b % 1024, swz = sb ^ (((sb >> 9) & 1) << 5); R = (st >> 1) * 16 + swz / 64; C = (st & 1) * 32 + (swz % 64) / 2; }
__host__ __device__ __forceinline__ int perm32(int rho) { const int n = rho >> 4, i = rho & 15; return 8 * (i >> 2) + 4 * n + (i & 3); }

struct Unit { int pm, pn; };
struct Gemm { const bf16_t* A; const bf16_t* Bt; int M, N, K; };

struct StaticOrder {
    int nM, nN, nwg, G, c;
    __host__ __device__ void init(int M, int N, int G_, int c_) { nM = M / BM; nN = N / BM; nwg = nM * nN; G = G_; c = c_; }
    __host__ __device__ bool next(int i, Unit& u) const {
        const long L = (long)i * G + c; if (L >= nwg) return false;
        int wgid = (int)L; { const int q = nwg / NXCD, r = nwg % NXCD, xcd = wgid % NXCD, off = wgid / NXCD; wgid = (xcd < r ? xcd * (q + 1) : r * (q + 1) + (xcd - r) * q) + off; }
        const int nig = WGM * nN, gid = wgid / nig, fm = gid * WGM, gsz = (nM - fm) < WGM ? (nM - fm) : WGM;
        u.pm = fm + ((wgid % nig) % gsz); u.pn = (wgid % nig) / gsz; return true;
    }
    __device__ __forceinline__ void a_ready(const Unit&) const {}
    __device__ __forceinline__ void done(const Unit&) const {}
};

__device__ __forceinline__ unsigned cvt_pk_bf16(float lo, float hi) { unsigned r; asm volatile("v_cvt_pk_bf16_f32 %0, %1, %2" : "=v"(r) : "v"(lo), "v"(hi)); return r; }
template <class Epi, class Sched, bool ALIGN_EPI = false, bool SP2 = false>
__device__ __forceinline__ void gemm_phase(PG8_LAS unsigned char* lds, const Gemm g, const Sched& S, const Epi& E) {
    int tid = threadIdx.x; asm volatile("" : "+v"(tid)); const int wid = __builtin_amdgcn_readfirstlane(tid >> 6), lane = tid & 63, wr = wid >> 2, wc = wid & 3, fr = lane & 15, fq = lane >> 4;
    const int K = g.K, nt = K / BK;
    unsigned voffA[2], voffB[2];
#pragma unroll
    for (int i = 0; i < 2; ++i) { int R, C; stage_rc(tid * 16 + i * 8192, R, C); const int Rb = Epi::PERM ? ((R & ~31) + perm32(R & 31)) : R;
        voffA[i] = (unsigned)(R * K + C) * 2u; voffB[i] = (unsigned)(Rb * K + C) * 2u; }
    const size_t kstep = (size_t)(BK * 2);
    const size_t hstep = (size_t)HALF * K * 2;
    const size_t tstep = 2 * hstep;
    const unsigned ldsw = (unsigned)wid * 1024u;
    const int aoff = lds_byte(wr * 64 + fr, fq * 8), boff = lds_byte(wc * 32 + fr, fq * 8);
#define PG8_SA(b, h) (((b) * 2 + (h)) * HTB)
#define PG8_SB(b, h) ((4 + (b) * 2 + (h)) * HTB)
#define PG8_STAGE(bufoff, gbase, voff) do { _Pragma("unroll") for (int _i = 0; _i < 2; ++_i) \
        __builtin_amdgcn_global_load_lds((const unsigned*)((const char*)(gbase) + (voff)[_i]), (PG8_LAS unsigned*)(lds + (bufoff) + ldsw + _i * 8192), 16, 0, 0); } while (0)
#define PG8_LDA(dst, b, h) do { _Pragma("unroll") for (int m = 0; m < 4; ++m) _Pragma("unroll") for (int k = 0; k < 2; ++k) dst[m][k] = *(const PG8_LAS bf16x8*)(lds + PG8_SA(b, h) + aoff + m * 2048 + k * 1024); } while (0)
#define PG8_LDB(dst, b, h) do { _Pragma("unroll") for (int n = 0; n < 2; ++n) _Pragma("unroll") for (int k = 0; k < 2; ++k) dst[n][k] = *(const PG8_LAS bf16x8*)(lds + PG8_SB(b, h) + boff + n * 2048 + k * 1024); } while (0)
#define PG8_MMA(ai, bj, At, Bt) do { __builtin_amdgcn_s_setprio(1); _Pragma("unroll") for (int m = 0; m < 4; ++m) _Pragma("unroll") for (int n = 0; n < 2; ++n) _Pragma("unroll") for (int k = 0; k < 2; ++k) \
        acc[ai][bj][m][n] = __builtin_amdgcn_mfma_f32_16x16x32_bf16(Bt[n][k], At[m][k], acc[ai][bj][m][n], 0, 0, 0); __builtin_amdgcn_s_setprio(0); } while (0)
#define PG8_WAIT_V(n) asm volatile("s_waitcnt vmcnt(" #n ")" ::: "memory")
#define PG8_WAIT_L(n) asm volatile("s_waitcnt lgkmcnt(" #n ")" ::: "memory")
#define PG8_BAR __builtin_amdgcn_s_barrier()
#define PG8_SCHED __builtin_amdgcn_sched_barrier(0)
    Unit cur, nxt; int ui = 0;
    if (!S.next(0, cur)) return;
    f32x4 acc[2][2][4][2];
#pragma unroll
    for (int a = 0; a < 2; ++a)
#pragma unroll
        for (int b = 0; b < 2; ++b)
#pragma unroll
            for (int m = 0; m < 4; ++m)
#pragma unroll
                for (int n = 0; n < 2; ++n) acc[a][b][m][n] = (f32x4){0.f, 0.f, 0.f, 0.f};
    bf16x8 At[4][2], B0[2][2], B1[2][2];
    const char* cA = (const char*)g.A + (size_t)cur.pm * tstep; const char* cB = (const char*)g.Bt + (size_t)cur.pn * tstep;
    S.a_ready(cur);
    if constexpr (SP2) {
        PG8_STAGE(PG8_SB(0, 0), cB, voffB); PG8_STAGE(PG8_SB(0, 1), cB + hstep, voffB); PG8_STAGE(PG8_SA(0, 0), cA, voffA); PG8_STAGE(PG8_SA(0, 1), cA + hstep, voffA);
        if (wr == 1) PG8_BAR;
        PG8_WAIT_V(2); PG8_BAR;
        PG8_STAGE(PG8_SB(1, 0), cB + kstep, voffB); PG8_STAGE(PG8_SA(1, 0), cA + kstep, voffA); PG8_STAGE(PG8_SB(1, 1), cB + hstep + kstep, voffB);
        PG8_WAIT_V(6); PG8_BAR;
    } else {
        PG8_STAGE(PG8_SB(0, 0), cB, voffB); PG8_STAGE(PG8_SA(0, 0), cA, voffA); PG8_STAGE(PG8_SB(0, 1), cB + hstep, voffB); PG8_STAGE(PG8_SA(0, 1), cA + hstep, voffA);
        if (wr == 1) PG8_BAR;
        PG8_WAIT_V(4); PG8_BAR;
        PG8_STAGE(PG8_SB(1, 0), cB + kstep, voffB); PG8_STAGE(PG8_SA(1, 0), cA + kstep, voffA); PG8_STAGE(PG8_SB(1, 1), cB + hstep + kstep, voffB);
        PG8_WAIT_V(6); PG8_BAR;
    }
    for (;;) {
        const bool has_next = S.next(ui + 1, nxt);
        const char* nA = has_next ? (const char*)g.A + (size_t)nxt.pm * tstep : cA; const char* nB = has_next ? (const char*)g.Bt + (size_t)nxt.pn * tstep : cB;
        for (int t = 0; t < nt; t += 2) {
            const bool last = (t == nt - 2);
            const char* a1 = cA + (size_t)(t + 1) * kstep;
            const char* a2 = last ? nA : cA + (size_t)(t + 2) * kstep; const char* b2 = last ? nB : cB + (size_t)(t + 2) * kstep;
            const char* a3 = a2 + kstep; const char* b3 = b2 + kstep;
            if (last && has_next) S.a_ready(nxt);
            if constexpr (SP2) {
            PG8_LDB(B0, 0, 0); PG8_LDB(B1, 0, 1); PG8_SCHED; PG8_LDA(At, 0, 0); PG8_STAGE(PG8_SA(1, 1), a1 + hstep, voffA);
            PG8_WAIT_V(8); PG8_WAIT_L(0); PG8_BAR; PG8_MMA(0, 0, At, B0); PG8_MMA(0, 1, At, B1); PG8_BAR; PG8_SCHED;
            PG8_LDA(At, 0, 1); PG8_STAGE(PG8_SB(0, 0), b2, voffB); PG8_STAGE(PG8_SB(0, 1), b2 + hstep, voffB); PG8_STAGE(PG8_SA(0, 0), a2, voffA);
            PG8_WAIT_V(8); PG8_WAIT_L(0); PG8_BAR; PG8_MMA(1, 0, At, B0); PG8_MMA(1, 1, At, B1); PG8_BAR; PG8_SCHED;
            PG8_LDB(B0, 1, 0); PG8_LDB(B1, 1, 1); PG8_SCHED; PG8_LDA(At, 1, 0); PG8_STAGE(PG8_SA(0, 1), a2 + hstep, voffA);
            PG8_WAIT_V(8); PG8_WAIT_L(0); PG8_BAR; PG8_MMA(0, 0, At, B0); PG8_MMA(0, 1, At, B1); PG8_BAR; PG8_SCHED;
            PG8_LDA(At, 1, 1); PG8_STAGE(PG8_SB(1, 0), b3, voffB); PG8_STAGE(PG8_SB(1, 1), b3 + hstep, voffB); PG8_STAGE(PG8_SA(1, 0), a3, voffA);
            PG8_WAIT_V(8); PG8_WAIT_L(0); PG8_BAR; PG8_MMA(1, 0, At, B0); PG8_MMA(1, 1, At, B1); PG8_BAR; PG8_SCHED;
            } else {
            PG8_LDB(B0, 0, 0); PG8_SCHED; PG8_LDA(At, 0, 0); PG8_STAGE(PG8_SA(1, 1), a1 + hstep, voffA);
            PG8_WAIT_L(8); PG8_BAR; PG8_WAIT_L(0); PG8_MMA(0, 0, At, B0); PG8_BAR; PG8_SCHED;
            PG8_LDB(B1, 0, 1); PG8_STAGE(PG8_SB(0, 0), b2, voffB);
            PG8_BAR; PG8_WAIT_L(0); PG8_MMA(0, 1, At, B1); PG8_BAR;
            PG8_LDA(At, 0, 1); PG8_STAGE(PG8_SA(0, 0), a2, voffA);
            PG8_BAR; PG8_WAIT_L(0); PG8_MMA(1, 0, At, B0); PG8_BAR; PG8_SCHED;
            PG8_STAGE(PG8_SB(0, 1), b2 + hstep, voffB);
            PG8_WAIT_V(6); PG8_BAR; PG8_MMA(1, 1, At, B1); PG8_BAR;
            PG8_LDB(B0, 1, 0); PG8_SCHED; PG8_LDA(At, 1, 0); PG8_STAGE(PG8_SA(0, 1), a2 + hstep, voffA);
            PG8_WAIT_L(8); PG8_BAR; PG8_WAIT_L(0); PG8_MMA(0, 0, At, B0); PG8_BAR; PG8_SCHED;
            PG8_LDB(B1, 1, 1); PG8_STAGE(PG8_SB(1, 0), b3, voffB);
            PG8_BAR; PG8_WAIT_L(0); PG8_MMA(0, 1, At, B1); PG8_BAR;
            PG8_LDA(At, 1, 1); PG8_STAGE(PG8_SA(1, 0), a3, voffA);
            PG8_BAR; PG8_WAIT_L(0); PG8_MMA(1, 0, At, B0); PG8_BAR; PG8_SCHED;
            PG8_STAGE(PG8_SB(1, 1), b3 + hstep, voffB);
            PG8_WAIT_V(6); PG8_BAR; PG8_MMA(1, 1, At, B1); PG8_BAR;
            }
        }
        if constexpr (ALIGN_EPI) { if (wr == 0) PG8_BAR; }
        if constexpr (!Epi::AFTER_DRAIN) { E(acc, cur, wr, wc, fr, fq); S.done(cur); }
        if (!has_next) break;
#pragma unroll
        for (int a = 0; a < 2; ++a)
#pragma unroll
            for (int b = 0; b < 2; ++b)
#pragma unroll
                for (int m = 0; m < 4; ++m)
#pragma unroll
                    for (int n = 0; n < 2; ++n) acc[a][b][m][n] = (f32x4){0.f, 0.f, 0.f, 0.f};
        cur = nxt; cA = nA; cB = nB; ++ui;
        if constexpr (ALIGN_EPI) { if (wr == 1) PG8_BAR; }
    }
    PG8_WAIT_V(0);
    if constexpr (!ALIGN_EPI) { if (wr == 0) PG8_BAR; }
    PG8_BAR;
    if constexpr (Epi::AFTER_DRAIN) { E.fused(acc, cur, wr, wc, fr, fq, lds, wid, lane); S.done(cur); }
#undef PG8_SA
#undef PG8_SB
#undef PG8_STAGE
#undef PG8_LDA
#undef PG8_LDB
#undef PG8_MMA
#undef PG8_WAIT_V
#undef PG8_WAIT_L
#undef PG8_BAR
#undef PG8_SCHED
}
}
#ifndef ATT_SDEPTH
#define ATT_SDEPTH 1
#endif
namespace att {
using bf16 = __hip_bfloat16;
constexpr int NW = 8, QBLK = 32, KVBLK = 64;
constexpr float SCALE = 0.07216878364870322f;
constexpr float THR = 8.f;
__device__ __forceinline__ int otid() { int t = threadIdx.x; asm volatile("" : "+v"(t)); return t; }
using bf16x8 = __attribute__((ext_vector_type(8))) short;
using s16x4  = __attribute__((ext_vector_type(4))) short;
using f32x16 = __attribute__((ext_vector_type(16))) float;
using f32x8  = __attribute__((ext_vector_type(8))) float;
using u32x4  = __attribute__((ext_vector_type(4))) unsigned;
#define KSWZ(row, colB) ((row) * 256 + ((colB) ^ (((row) & 7) << 4)))
#define SBAR() __builtin_amdgcn_sched_barrier(0)
__device__ __forceinline__ int crow(int r, int hi) { return (r & 3) + 8 * (r >> 2) + 4 * hi; }
__device__ __forceinline__ unsigned cvtpk(float lo, float hi) {
  unsigned r; asm volatile("v_cvt_pk_bf16_f32 %0, %1, %2" : "=v"(r) : "v"(lo), "v"(hi)); return r;
}
template <typename TIn> struct Stage;
template <> struct Stage<bf16>  { using T = bf16x8;
  __device__ static __forceinline__ T ld8(const bf16* p) { return *reinterpret_cast<const bf16x8*>(p); }
  __device__ static __forceinline__ bf16x8 tobf(T x) { return x; } };
template <> struct Stage<float> { using T = f32x8;
  __device__ static __forceinline__ T ld8(const float* p) { return *reinterpret_cast<const f32x8*>(p); }
  __device__ static __forceinline__ bf16x8 tobf(T x) {
    u32x4 w = {cvtpk(x[0], x[1]), cvtpk(x[2], x[3]), cvtpk(x[4], x[5]), cvtpk(x[6], x[7])}; return *reinterpret_cast<bf16x8*>(&w); } };

__device__ __forceinline__ void partialSM(f32x16& p0, f32x16& p1, float& m_reg, float& mn, float& alpha) {
  constexpr float C = SCALE * 1.4426950408889634f;
  float pmax = p0[0]; for (int r = 1; r < 16; ++r) pmax = fmaxf(pmax, p0[r]); for (int r = 0; r < 16; ++r) pmax = fmaxf(pmax, p1[r]);
  { auto rr = __builtin_amdgcn_permlane32_swap(__float_as_uint(pmax), __float_as_uint(pmax), false, false);
    pmax = fmaxf(__uint_as_float(rr[0]), __uint_as_float(rr[1])); }
  if (__builtin_expect(__all(pmax - m_reg <= THR / SCALE), 1)) { mn = m_reg; alpha = 1.f; }
  else { mn = fmaxf(m_reg, pmax); alpha = __builtin_amdgcn_exp2f((m_reg - mn) * C); m_reg = mn; }
  float mnC = -mn * C;
  for (int r = 0; r < 16; ++r) p0[r] = fmaf(p0[r], C, mnC); for (int r = 0; r < 16; ++r) p1[r] = fmaf(p1[r], C, mnC);
  for (int r = 0; r < 16; ++r) p0[r] = __builtin_amdgcn_exp2f(p0[r]);
}
__device__ __forceinline__ void finishSM(f32x16& p0, f32x16& p1, float alpha, float& l_reg, bf16x8& pa0, bf16x8& pa1, bf16x8& pa2, bf16x8& pa3) {
  for (int r = 0; r < 16; ++r) p1[r] = __builtin_amdgcn_exp2f(p1[r]);
  float ps = 0; for (int r = 0; r < 16; ++r) ps += p0[r]; for (int r = 0; r < 16; ++r) ps += p1[r];
  { auto rr = __builtin_amdgcn_permlane32_swap(__float_as_uint(ps), __float_as_uint(ps), false, false);
    ps = __uint_as_float(rr[0]) + __uint_as_float(rr[1]); }
  l_reg = l_reg * alpha + ps;
#define PK4(P, BASE, OUT) do { unsigned a0 = cvtpk(P[BASE + 0], P[BASE + 1]), a1 = cvtpk(P[BASE + 2], P[BASE + 3]);   \
    unsigned b0 = cvtpk(P[BASE + 4], P[BASE + 5]), b1 = cvtpk(P[BASE + 6], P[BASE + 7]);                              \
    auto r0 = __builtin_amdgcn_permlane32_swap(a0, b0, false, false); auto r1 = __builtin_amdgcn_permlane32_swap(a1, b1, false, false); \
    u32x4 w = {r0[0], r1[0], r0[1], r1[1]}; OUT = *reinterpret_cast<bf16x8*>(&w); } while (0)
  PK4(p0, 0, pa0); PK4(p0, 8, pa1); PK4(p1, 0, pa2); PK4(p1, 8, pa3);
#undef PK4
}
#define KSWZ2(row, colB) ((row) * 128 + ((colB) ^ (((row) & 7) << 4)))
__device__ __forceinline__ void qkt(f32x16& p0, f32x16& p1, const bf16* Ks, const bf16* KRs, const bf16x8* qr, const bf16x8* qrl, int r32, int hi) {
  p0 = f32x16{}; p1 = f32x16{};
#pragma unroll
  for (int d0 = 0; d0 < 8; ++d0) { int cb = (d0 * 16 + hi * 8) * 2;
    bf16x8 b0 = *reinterpret_cast<const bf16x8*>((const char*)Ks + KSWZ(r32, cb));
    bf16x8 b1 = *reinterpret_cast<const bf16x8*>((const char*)Ks + KSWZ(32 + r32, cb));
    p0 = __builtin_amdgcn_mfma_f32_32x32x16_bf16(b0, qr[d0], p0, 0, 0, 0);
    p1 = __builtin_amdgcn_mfma_f32_32x32x16_bf16(b1, qr[d0], p1, 0, 0, 0); }
#pragma unroll
  for (int d0 = 0; d0 < 4; ++d0) { int cb = (d0 * 16 + hi * 8) * 2;
    bf16x8 b0 = *reinterpret_cast<const bf16x8*>((const char*)KRs + KSWZ2(r32, cb));
    bf16x8 b1 = *reinterpret_cast<const bf16x8*>((const char*)KRs + KSWZ2(32 + r32, cb));
    const bf16x8 qv = qrl[d0 * 64];
    p0 = __builtin_amdgcn_mfma_f32_32x32x16_bf16(b0, qv, p0, 0, 0, 0);
    p1 = __builtin_amdgcn_mfma_f32_32x32x16_bf16(b1, qv, p1, 0, 0, 0); }
}
__device__ __forceinline__ int v_st(int k, int c) { const int kk = (k & ~0xC) | ((k & 4) << 1) | ((k & 8) >> 1); return ((kk >> 3) * 4 + (c >> 5)) * 512 + ((kk & 7) * 32 + (c & 31)) * 2; }
__device__ __forceinline__ int v_rd_base(int lane) { return ((lane & 3) << 3) | (((lane >> 2) & 3) << 6) | (((lane >> 4) & 1) << 5) | (((lane >> 5) & 1) << 8); }
constexpr int v_rd_off(int d0, int ks, int half) { return d0 * 512 + ks * 4096 + half * 2048; }
template <int OFF> __device__ __forceinline__ s16x4 tr_read(int vb) {
  s16x4 r; asm volatile("ds_read_b64_tr_b16 %0, %1 offset:%2" : "=&v"(r) : "v"(vb), "i"(OFF) : "memory"); return r;
}
template <int D0> __device__ __forceinline__ void pv_one(f32x16& od, int vb, bf16x8 pa0, bf16x8 pa1, bf16x8 pa2, bf16x8 pa3) {
  const s16x4 l0 = tr_read<v_rd_off(D0, 0, 0)>(vb), h0 = tr_read<v_rd_off(D0, 0, 1)>(vb), l1 = tr_read<v_rd_off(D0, 1, 0)>(vb), h1 = tr_read<v_rd_off(D0, 1, 1)>(vb);
  const s16x4 l2 = tr_read<v_rd_off(D0, 2, 0)>(vb), h2 = tr_read<v_rd_off(D0, 2, 1)>(vb), l3 = tr_read<v_rd_off(D0, 3, 0)>(vb), h3 = tr_read<v_rd_off(D0, 3, 1)>(vb);
  asm volatile("s_waitcnt lgkmcnt(0)" ::: "memory"); SBAR();
#define PK(L, H) (bf16x8){L[0], L[1], L[2], L[3], H[0], H[1], H[2], H[3]}
  od = __builtin_amdgcn_mfma_f32_32x32x16_bf16(pa0, PK(l0, h0), od, 0, 0, 0);
  od = __builtin_amdgcn_mfma_f32_32x32x16_bf16(pa1, PK(l1, h1), od, 0, 0, 0);
  od = __builtin_amdgcn_mfma_f32_32x32x16_bf16(pa2, PK(l2, h2), od, 0, 0, 0);
  od = __builtin_amdgcn_mfma_f32_32x32x16_bf16(pa3, PK(l3, h3), od, 0, 0, 0);
#undef PK
}
__device__ __forceinline__ void pv_d0(f32x16* o, int vb, bf16x8 pa0, bf16x8 pa1, bf16x8 pa2, bf16x8 pa3) {
  pv_one<0>(o[0], vb, pa0, pa1, pa2, pa3); pv_one<1>(o[1], vb, pa0, pa1, pa2, pa3); pv_one<2>(o[2], vb, pa0, pa1, pa2, pa3); pv_one<3>(o[3], vb, pa0, pa1, pa2, pa3);
}
constexpr int LDQ = 1536, LDK = 1024, LDV = 1024, LDKR = 64, LDO = 1024, SDEPTH = ATT_SDEPTH;
constexpr int SHM_V = KVBLK * 128 * 2, SHM_K = KVBLK * 128 * 2, SHM_KR = KVBLK * 64 * 2;
constexpr int SHM_QR = NW * 4 * 64 * 16;
constexpr int SHM_ATTN = 2 * SHM_V + 2 * SHM_K + 2 * SHM_KR + NW * 64 * 4 + SHM_QR;
__device__ __forceinline__ void attn_unit(const bf16* __restrict__ Qb, const bf16* __restrict__ Kh, const bf16* __restrict__ KRh, const bf16* __restrict__ Vh,
                                          bf16* __restrict__ Ob, int seq, char* lds) {
  using St = Stage<bf16>;
  const int tid = otid(), wid = tid >> 6, lane = tid & 63, r32 = lane & 31, hi = lane >> 5;
  bf16* V_lds = (bf16*)lds; bf16* K_lds = (bf16*)(lds + 2 * SHM_V); bf16* KR_lds = (bf16*)(lds + 2 * SHM_V + 2 * SHM_K);
  float* ws = (float*)(lds + 2 * SHM_V + 2 * SHM_K + 2 * SHM_KR) + wid * 64; float* li_l = ws; float* al_l = ws + 32;
  float m_reg = -1e30f, l_reg = 0; f32x16 o[4] = {}; bf16x8 qr[8];
  bf16x8* qrl = (bf16x8*)(lds + 2 * SHM_V + 2 * SHM_K + 2 * SHM_KR + NW * 64 * 4) + wid * 256 + lane;
  const bf16* Qw = Qb + (long)(wid * QBLK + r32) * LDQ + hi * 8;
#pragma unroll
  for (int d0 = 0; d0 < 8; ++d0) qr[d0] = St::ld8(Qw + d0 * 16);
#pragma unroll
  for (int d0 = 0; d0 < 4; ++d0) qrl[d0 * 64] = St::ld8(Qw + 128 + d0 * 16);
  const int sr = tid >> 4, sc = (tid & 15) * 8, vst0 = v_st(sr, sc), vst1 = v_st(32 + sr, sc);
  const int krr = tid >> 3, krc = (tid & 7) * 8;
  const int vb0 = (int)(uintptr_t)V_lds + v_rd_base(lane);
  struct { bf16x8 vs0, vs1, ks0, ks1, kr; } sr_[SDEPTH];
#define SLOAD(i, k0) do { sr_[i].vs0 = St::ld8(&Vh[(long)((k0) + sr) * LDV + sc]); sr_[i].vs1 = St::ld8(&Vh[(long)((k0) + 32 + sr) * LDV + sc]); \
    sr_[i].ks0 = St::ld8(&Kh[(long)((k0) + sr) * LDK + sc]); sr_[i].ks1 = St::ld8(&Kh[(long)((k0) + 32 + sr) * LDK + sc]); \
    sr_[i].kr = St::ld8(&KRh[(long)((k0) + krr) * LDKR + krc]); } while (0)
#define SWRITE(b, i) do { *(bf16x8*)((char*)V_lds + (b) * SHM_V + vst0) = sr_[i].vs0;          \
    *(bf16x8*)((char*)V_lds + (b) * SHM_V + vst1) = sr_[i].vs1; int kc = sc * 2;               \
    *(bf16x8*)((char*)K_lds + (b) * SHM_K + KSWZ(sr, kc)) = sr_[i].ks0;                       \
    *(bf16x8*)((char*)K_lds + (b) * SHM_K + KSWZ(32 + sr, kc)) = sr_[i].ks1;                  \
    *(bf16x8*)((char*)KR_lds + (b) * SHM_KR + KSWZ2(krr, krc * 2)) = sr_[i].kr; } while (0)
#define SWAIT() do { if constexpr (SDEPTH == 2) asm volatile("s_waitcnt vmcnt(5)" ::: "memory"); else asm volatile("s_waitcnt vmcnt(0)" ::: "memory"); } while (0)
#define RESC(a) do { if (__any((a) < 1.f)) { if (hi == 0) al_l[r32] = (a); asm volatile("s_waitcnt lgkmcnt(0)" ::: "memory"); \
    _Pragma("unroll") for (int d = 0; d < 4; ++d) _Pragma("unroll") for (int r = 0; r < 16; ++r) o[d][r] *= al_l[crow(r, hi)]; } } while (0)
  f32x16 pA0, pA1, pB0, pB1; float mnA, mnB, alA, alB; bf16x8 pa0, pa1, pa2, pa3; const int NT = seq / KVBLK;
  constexpr int SE = 0, SO = SDEPTH - 1;
  SLOAD(SE, 0); asm volatile("s_waitcnt vmcnt(0)" ::: "memory"); SWRITE(0, SE); __syncthreads();
  qkt(pA0, pA1, K_lds, KR_lds, qr, qrl, r32, hi); partialSM(pA0, pA1, m_reg, mnA, alA);
  SLOAD(SO, KVBLK); if constexpr (SDEPTH == 2) { if (2 < NT) SLOAD(SE, 2 * KVBLK); }
  SWAIT(); SWRITE(1, SO); __syncthreads();
  for (int j = 1; j + 1 < NT; j += 2) {
    SBAR(); qkt(pB0, pB1, (bf16*)((char*)K_lds + SHM_K), (bf16*)((char*)KR_lds + SHM_KR), qr, qrl, r32, hi);
    finishSM(pA0, pA1, alA, l_reg, pa0, pa1, pa2, pa3); SBAR();
    SLOAD(SO, (j + SDEPTH) * KVBLK); SBAR();
    pv_d0(o, vb0, pa0, pa1, pa2, pa3); partialSM(pB0, pB1, m_reg, mnB, alB);
    __syncthreads(); SWAIT(); SWRITE(0, SE);
    RESC(alB); __syncthreads();
    SBAR(); qkt(pA0, pA1, K_lds, KR_lds, qr, qrl, r32, hi);
    finishSM(pB0, pB1, alB, l_reg, pa0, pa1, pa2, pa3); SBAR();
    if (SDEPTH == 1 || j + 3 < NT) SLOAD(SE, (j + 1 + SDEPTH) * KVBLK); SBAR();
    pv_d0(o, vb0 + (int)SHM_V, pa0, pa1, pa2, pa3); partialSM(pA0, pA1, m_reg, mnA, alA);
    __syncthreads(); SWAIT(); SWRITE(1, SO);
    RESC(alA); __syncthreads();
  }
  SBAR(); qkt(pB0, pB1, (bf16*)((char*)K_lds + SHM_K), (bf16*)((char*)KR_lds + SHM_KR), qr, qrl, r32, hi);
  finishSM(pA0, pA1, alA, l_reg, pa0, pa1, pa2, pa3); SBAR();
  pv_d0(o, vb0, pa0, pa1, pa2, pa3); partialSM(pB0, pB1, m_reg, mnB, alB);
  __syncthreads(); RESC(alB);
  finishSM(pB0, pB1, alB, l_reg, pa0, pa1, pa2, pa3); SBAR();
  pv_d0(o, vb0 + (int)SHM_V, pa0, pa1, pa2, pa3);
  if (hi == 0) li_l[r32] = l_reg; asm volatile("s_waitcnt lgkmcnt(0)" ::: "memory");
  float rli[16];
#pragma unroll
  for (int r = 0; r < 16; ++r) rli[r] = __builtin_amdgcn_rcpf(li_l[crow(r, hi)]);
  bf16* Ow = Ob + (long)(wid * QBLK) * LDO;
#pragma unroll
  for (int r = 0; r < 16; ++r) { int orow = crow(r, hi);
#pragma unroll
    for (int d0 = 0; d0 < 4; ++d0) Ow[(long)orow * LDO + d0 * 32 + r32] = __float2bfloat16(o[d0][r] * rli[r]); }
  __syncthreads();
#undef SLOAD
#undef SWRITE
#undef SWAIT
#undef RESC
}
#undef SBAR
}
constexpr int BATCH = 4, SEQ = 8192, DM = 1024, DEPTH = 4, DFF = 2816, MT = BATCH * SEQ;
constexpr int NH = 8, QLR = 256, KVLR = 128, QKD = 192;
constexpr float EPS = 1e-6f;
constexpr size_t MiB = 1u << 20;
constexpr size_t WS_WFFI = 1 * MiB;
constexpr size_t WS_WFFO = 89 * MiB;
constexpr size_t WS_WHIN = 133 * MiB;
constexpr size_t WS_WHO  = 153 * MiB;
constexpr size_t WS_WMIN = 157 * MiB;
constexpr size_t WS_WUQ  = 159 * MiB;
constexpr size_t WS_WUKV = 161 * MiB;
constexpr size_t WS_WMO  = 162 * MiB;
constexpr size_t WS_COS  = 166 * MiB;
constexpr size_t WS_SIN  = 170 * MiB;
constexpr size_t WS_LB   = 174 * MiB;
constexpr size_t WS_HN   = 176 * MiB;
constexpr size_t WS_Y    = 240 * MiB;
constexpr size_t WS_YB   = 304 * MiB;
constexpr size_t WS_R    = 368 * MiB;
constexpr size_t WS_END  = 704 * MiB;
constexpr size_t R_ACT = 0;
constexpr size_t R_C = 0, R_QB = 0, R_CQ = 96 * MiB, R_CKV = 112 * MiB, R_KR = 120 * MiB, R_KN = 124 * MiB, R_VB = 188 * MiB, R_O = 252 * MiB;
constexpr size_t R_QH = 0, R_VH = 64 * MiB, R_GH = 128 * MiB, R_KF = 192 * MiB, R_HO = 0;

constexpr int LDS_RING = 131072, LDS_BYTES = LDS_RING + 2048;
typedef unsigned short bf16_t;
typedef float f32x4 __attribute__((ext_vector_type(4)));
typedef float f32x2 __attribute__((ext_vector_type(2)));
typedef unsigned u32x4 __attribute__((ext_vector_type(4)));
typedef unsigned u32x2 __attribute__((ext_vector_type(2)));
typedef _Float16 h16x2 __attribute__((ext_vector_type(2)));
#define LAS __attribute__((address_space(3)))

__device__ __constant__ double ROPE_INVF[32] = {1.0, 0.7498942093324559, 0.5623413251903491, 0.4216965034285822, 0.31622776601683794, 0.23713737056616552, 0.1778279410038923, 0.1333521432163324, 0.1, 0.07498942093324558, 0.05623413251903491, 0.042169650342858224, 0.03162277660168379, 0.023713737056616554, 0.01778279410038923, 0.01333521432163324, 0.01, 0.007498942093324558, 0.005623413251903491, 0.004216965034285823, 0.0031622776601683794, 0.0023713737056616554, 0.0017782794100389228, 0.001333521432163324, 0.001, 0.0007498942093324559, 0.0005623413251903491, 0.00042169650342858224, 0.00031622776601683794, 0.00023713737056616554, 0.00017782794100389227, 0.0001333521432163324};

__device__ __forceinline__ unsigned pk2(float lo, float hi) { return pg8::cvt_pk_bf16(lo, hi); }
__device__ __forceinline__ float silu_f(float g) { return g * __builtin_amdgcn_rcpf(1.0f + __expf(-g)); }
__device__ __forceinline__ float wave_sum(float v) {
#pragma unroll
    for (int o = 1; o < 64; o <<= 1) v += __shfl_xor(v, o);
    return v;
}
__device__ __forceinline__ float half_sum(float v) {
#pragma unroll
    for (int o = 1; o < 32; o <<= 1) v += __shfl_xor(v, o);
    return v;
}

using pg8::Unit;
struct EpiSwiglu { static constexpr bool PERM = true, AFTER_DRAIN = false; bf16_t* O;
    __device__ __forceinline__ void operator()(const pg8::f32x4 (&acc)[2][2][4][2], const Unit& u, int wr, int wc, int fr, int fq) const {
        const int row0 = u.pm * 256 + wr * 64 + fr, col0 = u.pn * 128 + wc * 32 + 8 * fq;
#pragma unroll
        for (int ai = 0; ai < 2; ++ai)
#pragma unroll
            for (int m = 0; m < 4; ++m) { bf16_t* p = O + (size_t)(row0 + ai * 128 + m * 16) * DFF + col0;
                const pg8::f32x4 g0 = acc[ai][0][m][0], g1 = acc[ai][0][m][1], u0 = acc[ai][1][m][0], u1 = acc[ai][1][m][1];
                u32x4 w; w.x = pk2(silu_f(g0[0]) * u0[0], silu_f(g0[1]) * u0[1]); w.y = pk2(silu_f(g0[2]) * u0[2], silu_f(g0[3]) * u0[3]);
                w.z = pk2(silu_f(g1[0]) * u1[0], silu_f(g1[1]) * u1[1]); w.w = pk2(silu_f(g1[2]) * u1[2], silu_f(g1[3]) * u1[3]);
                *(u32x4*)p = w; }
    }
};
struct EpiF32 { static constexpr bool PERM = false, AFTER_DRAIN = false; float* O; int ldc;
    __device__ __forceinline__ void operator()(const pg8::f32x4 (&acc)[2][2][4][2], const Unit& u, int wr, int wc, int fr, int fq) const {
        const int row0 = u.pm * 256 + wr * 64 + fr, col0 = u.pn * 256 + wc * 32 + 4 * fq;
#pragma unroll
        for (int ai = 0; ai < 2; ++ai)
#pragma unroll
            for (int m = 0; m < 4; ++m) { float* p = O + (size_t)(row0 + ai * 128 + m * 16) * ldc + col0;
#pragma unroll
                for (int bj = 0; bj < 2; ++bj)
#pragma unroll
                    for (int n = 0; n < 2; ++n) *(pg8::f32x4*)(p + bj * 128 + n * 16) = acc[ai][bj][m][n]; }
    }
};
struct EpiB16 { static constexpr bool PERM = true, AFTER_DRAIN = false; bf16_t* O; int ldc;
    __device__ __forceinline__ void operator()(const pg8::f32x4 (&acc)[2][2][4][2], const Unit& u, int wr, int wc, int fr, int fq) const {
        const int row0 = u.pm * 256 + wr * 64 + fr, col0 = u.pn * 256 + wc * 32 + 8 * fq;
#pragma unroll
        for (int ai = 0; ai < 2; ++ai)
#pragma unroll
            for (int m = 0; m < 4; ++m) { bf16_t* p = O + (size_t)(row0 + ai * 128 + m * 16) * ldc + col0;
#pragma unroll
                for (int bj = 0; bj < 2; ++bj) { const pg8::f32x4 v0 = acc[ai][bj][m][0], v1 = acc[ai][bj][m][1];
                    u32x4 w; w.x = pk2(v0[0], v0[1]); w.y = pk2(v0[2], v0[3]); w.z = pk2(v1[0], v1[1]); w.w = pk2(v1[2], v1[3]);
                    *(u32x4*)(p + bj * 128) = w; } }
    }
};
struct EpiQ { static constexpr bool PERM = true, AFTER_DRAIN = false; bf16_t* O; const float* cs; const float* sn;
    __device__ __forceinline__ void operator()(const pg8::f32x4 (&acc)[2][2][4][2], const Unit& u, int wr, int wc, int fr, int fq) const {
        const int row0 = u.pm * 256 + wr * 64 + fr;
#pragma unroll
        for (int bj = 0; bj < 2; ++bj) { const int col0 = u.pn * 256 + bj * 128 + wc * 32 + 8 * fq, d = col0 % QKD; const bool rot = d >= 128; const int i0 = (d - 128) >> 1;
#pragma unroll
            for (int ai = 0; ai < 2; ++ai)
#pragma unroll
                for (int m = 0; m < 4; ++m) { const int row = row0 + ai * 128 + m * 16; pg8::f32x4 v0 = acc[ai][bj][m][0], v1 = acc[ai][bj][m][1];
                    if (rot) { const pg8::f32x4 c = *(const pg8::f32x4*)(cs + (size_t)row * 32 + i0), s = *(const pg8::f32x4*)(sn + (size_t)row * 32 + i0);
                        pg8::f32x4 a, b; a[0] = v0[0] * c[0] - v0[1] * s[0]; a[1] = v0[0] * s[0] + v0[1] * c[0]; a[2] = v0[2] * c[1] - v0[3] * s[1]; a[3] = v0[2] * s[1] + v0[3] * c[1];
                        b[0] = v1[0] * c[2] - v1[1] * s[2]; b[1] = v1[0] * s[2] + v1[1] * c[2]; b[2] = v1[2] * c[3] - v1[3] * s[3]; b[3] = v1[2] * s[3] + v1[3] * c[3]; v0 = a; v1 = b; }
                    u32x4 w; w.x = pk2(v0[0], v0[1]); w.y = pk2(v0[2], v0[3]); w.z = pk2(v1[0], v1[1]); w.w = pk2(v1[2], v1[3]);
                    *(u32x4*)(O + (size_t)row * 1536 + col0) = w; } }
    }
};
struct EpiKV { static constexpr bool PERM = true, AFTER_DRAIN = false; bf16_t* Kn; bf16_t* Vb;
    __device__ __forceinline__ void operator()(const pg8::f32x4 (&acc)[2][2][4][2], const Unit& u, int wr, int wc, int fr, int fq) const {
        const int row0 = u.pm * 256 + wr * 64 + fr, col0 = u.pn * 128 + wc * 32 + 8 * fq;
#pragma unroll
        for (int bj = 0; bj < 2; ++bj) { bf16_t* base = bj ? Vb : Kn;
#pragma unroll
            for (int ai = 0; ai < 2; ++ai)
#pragma unroll
                for (int m = 0; m < 4; ++m) { const pg8::f32x4 v0 = acc[ai][bj][m][0], v1 = acc[ai][bj][m][1];
                    u32x4 w; w.x = pk2(v0[0], v0[1]); w.y = pk2(v0[2], v0[3]); w.z = pk2(v1[0], v1[1]); w.w = pk2(v1[2], v1[3]);
                    *(u32x4*)(base + (size_t)(row0 + ai * 128 + m * 16) * 1024 + col0) = w; } }
    }
};
__device__ __forceinline__ unsigned pkh2(float a, float b) { const h16x2 h = {(_Float16)a, (_Float16)b}; return __builtin_bit_cast(unsigned, h); }
__device__ __forceinline__ float kgate(float om, float z) { return om * __builtin_amdgcn_rcpf(1.0f + __expf(z)); }
struct EpiHgrn { static constexpr bool PERM = true, AFTER_DRAIN = false; bf16_t* Qh; bf16_t* Vh; bf16_t* Gh; unsigned short* KF; const float* lb;
    __device__ __forceinline__ void operator()(const pg8::f32x4 (&acc)[2][2][4][2], const Unit& u, int wr, int wc, int fr, int fq) const {
        const int row0 = u.pm * 256 + wr * 64 + fr, seg = u.pn >> 2;
#pragma unroll
        for (int bj = 0; bj < 2; ++bj) { const int cc = (u.pn & 3) * 256 + bj * 128 + wc * 32 + 8 * fq;
            if (seg == 1 || seg == 2) {
                const pg8::f32x4 om0 = 1.0f - *(const pg8::f32x4*)(lb + (seg - 1) * 1024 + cc), om1 = 1.0f - *(const pg8::f32x4*)(lb + (seg - 1) * 1024 + cc + 4);
                unsigned short* base = KF + (size_t)(seg - 1) * MT * 1024;
#pragma unroll
                for (int ai = 0; ai < 2; ++ai)
#pragma unroll
                    for (int m = 0; m < 4; ++m) { const size_t off = (size_t)(row0 + ai * 128 + m * 16) * 1024 + cc; const pg8::f32x4 v0 = acc[ai][bj][m][0], v1 = acc[ai][bj][m][1];
                        u32x4 w; w.x = pkh2(kgate(om0[0], v0[0]), kgate(om0[1], v0[1])); w.y = pkh2(kgate(om0[2], v0[2]), kgate(om0[3], v0[3]));
                        w.z = pkh2(kgate(om1[0], v1[0]), kgate(om1[1], v1[1])); w.w = pkh2(kgate(om1[2], v1[2]), kgate(om1[3], v1[3]));
                        *(u32x4*)(base + off) = w; }
            } else if (seg == 3) {
#pragma unroll
                for (int ai = 0; ai < 2; ++ai)
#pragma unroll
                    for (int m = 0; m < 4; ++m) { const size_t off = (size_t)(row0 + ai * 128 + m * 16) * 1024 + cc; const pg8::f32x4 v0 = acc[ai][bj][m][0], v1 = acc[ai][bj][m][1];
                        u32x4 w; w.x = pk2(v0[0], v0[1]); w.y = pk2(v0[2], v0[3]); w.z = pk2(v1[0], v1[1]); w.w = pk2(v1[2], v1[3]);
                        *(u32x4*)(Vh + off) = w; }
            } else { bf16_t* base = seg == 0 ? Qh : Gh;
#pragma unroll
                for (int ai = 0; ai < 2; ++ai)
#pragma unroll
                    for (int m = 0; m < 4; ++m) { const size_t off = (size_t)(row0 + ai * 128 + m * 16) * 1024 + cc; const pg8::f32x4 v0 = acc[ai][bj][m][0], v1 = acc[ai][bj][m][1];
                        u32x4 w; w.x = pk2(silu_f(v0[0]), silu_f(v0[1])); w.y = pk2(silu_f(v0[2]), silu_f(v0[3])); w.z = pk2(silu_f(v1[0]), silu_f(v1[1])); w.w = pk2(silu_f(v1[2]), silu_f(v1[3]));
                        *(u32x4*)(base + off) = w; } } }
    }
};

__device__ __forceinline__ int src_col(int mode, int n) {
    if (mode == 1) { const int t = n >> 8, j = n & 255; return j < 128 ? t * 128 + j : DFF + t * 128 + (j - 128); }
    if (mode == 2) { if (n < 384) return n; if (n >= 448) return -1; const int j = n - 384; return 384 + (j >> 1) + 32 * (j & 1); }
    if (mode == 3) { const int h = n / QKD, d = n % QKD; if (d < 128) return n; const int j = d - 128; return h * QKD + 128 + (j >> 1) + 32 * (j & 1); }
    return n;
}
__device__ __forceinline__ void xpose_item(const float* __restrict__ W, int K, int Nsrc, int Ndst, int mode, bf16_t* __restrict__ WT, LAS float* scr, int item, int lane) {
    const int nblk = Ndst / 32, kb = item / nblk, nb = item % nblk, k0 = 64 * kb, n0 = 32 * nb;
    if (mode <= 1) {
        const int sc0 = src_col(mode, n0) + (lane & 7) * 4;
#pragma unroll
        for (int i = 0; i < 8; ++i) { const int kk = 8 * i + (lane >> 3); const f32x4 v = *(const f32x4*)(W + (size_t)(k0 + kk) * Nsrc + sc0);
            LAS float* d = scr + kk * 33 + (lane & 7) * 4; d[0] = v[0]; d[1] = v[1]; d[2] = v[2]; d[3] = v[3]; }
    } else {
        const int sc = src_col(mode, n0 + (lane & 31));
#pragma unroll 8
        for (int i = 0; i < 32; ++i) { const int kk = 2 * i + (lane >> 5); scr[kk * 33 + (lane & 31)] = sc >= 0 ? W[(size_t)(k0 + kk) * Nsrc + sc] : 0.f; }
    }
    asm volatile("s_waitcnt lgkmcnt(0)" ::: "memory");
    const int c = lane & 7;
#pragma unroll
    for (int j = 0; j < 4; ++j) { const int n = (lane >> 3) + 8 * j; const LAS float* s = scr + (8 * c) * 33 + n;
        u32x4 o; o.x = pk2(s[0 * 33], s[1 * 33]); o.y = pk2(s[2 * 33], s[3 * 33]); o.z = pk2(s[4 * 33], s[5 * 33]); o.w = pk2(s[6 * 33], s[7 * 33]);
        *(u32x4*)(WT + (size_t)(n0 + n) * K + k0 + 8 * c) = o; }
    asm volatile("s_waitcnt lgkmcnt(0)" ::: "memory");
}

__device__ __forceinline__ void row_init(const float* __restrict__ xin, float* __restrict__ X, bf16_t* __restrict__ HN, const float* __restrict__ g, int lane) {
    const f32x4* xr = (const f32x4*)xin + lane; f32x4 v[4]; float s = 0.f;
#pragma unroll
    for (int j = 0; j < 4; ++j) { v[j] = xr[64 * j]; s += (v[j][0] * v[j][0] + v[j][1] * v[j][1]) + (v[j][2] * v[j][2] + v[j][3] * v[j][3]); }
    const float r = rsqrtf(wave_sum(s) * (1.f / DM) + EPS);
#pragma unroll
    for (int j = 0; j < 4; ++j) { ((f32x4*)X + lane)[64 * j] = v[j]; const f32x4 gg = ((const f32x4*)g + lane)[64 * j];
        u32x2 w; w.x = pk2(v[j][0] * r * gg[0], v[j][1] * r * gg[1]); w.y = pk2(v[j][2] * r * gg[2], v[j][3] * r * gg[3]); ((u32x2*)HN + lane)[64 * j] = w; }
}
__device__ __forceinline__ void row_post(const bf16_t* __restrict__ Y, float* __restrict__ X, bf16_t* __restrict__ HN, float scale, const float* __restrict__ gp, const float* __restrict__ gn, int lane) {
    f32x4 y[4], x[4]; float s = 0.f;
#pragma unroll
    for (int j = 0; j < 4; ++j) { const u32x2 yb = ((const u32x2*)Y + lane)[64 * j]; y[j] = (f32x4){__uint_as_float(yb.x << 16), __uint_as_float(yb.x & 0xffff0000u), __uint_as_float(yb.y << 16), __uint_as_float(yb.y & 0xffff0000u)};
        x[j] = ((const f32x4*)X + lane)[64 * j]; s += (y[j][0] * y[j][0] + y[j][1] * y[j][1]) + (y[j][2] * y[j][2] + y[j][3] * y[j][3]); }
    const float r = rsqrtf(wave_sum(s) * (1.f / DM) + EPS) * scale; float s2 = 0.f;
#pragma unroll
    for (int j = 0; j < 4; ++j) { const f32x4 gg = ((const f32x4*)gp + lane)[64 * j]; x[j] = x[j] + y[j] * r * gg; ((f32x4*)X + lane)[64 * j] = x[j];
        s2 += (x[j][0] * x[j][0] + x[j][1] * x[j][1]) + (x[j][2] * x[j][2] + x[j][3] * x[j][3]); }
    if (HN) { const float r2 = rsqrtf(wave_sum(s2) * (1.f / DM) + EPS);
#pragma unroll
        for (int j = 0; j < 4; ++j) { const f32x4 gg = ((const f32x4*)gn + lane)[64 * j];
            u32x2 w; w.x = pk2(x[j][0] * r2 * gg[0], x[j][1] * r2 * gg[1]); w.y = pk2(x[j][2] * r2 * gg[2], x[j][3] * r2 * gg[3]); ((u32x2*)HN + lane)[64 * j] = w; } }
}
__device__ __forceinline__ void row_mla(const float* __restrict__ C, bf16_t* __restrict__ CQ, bf16_t* __restrict__ CKV, bf16_t* __restrict__ KR, const float* __restrict__ qn, const float* __restrict__ kvn,
                                        const float* __restrict__ cs, const float* __restrict__ sn, int lane) {
    const f32x4 a = ((const f32x4*)C)[2 * lane], b = ((const f32x4*)C)[2 * lane + 1];
    float s = (a[0] * a[0] + a[1] * a[1]) + (a[2] * a[2] + a[3] * a[3]) + (b[0] * b[0] + b[1] * b[1]) + (b[2] * b[2] + b[3] * b[3]);
#pragma unroll
    for (int o = 1; o < 16; o <<= 1) s += __shfl_xor(s, o);
    const float s16 = s, s32 = s16 + __shfl_xor(s16, 16);
    float v[8] = {a[0], a[1], a[2], a[3], b[0], b[1], b[2], b[3]};
    if (lane < 32) { const float r = rsqrtf(s32 * (1.f / QLR) + EPS); const f32x4 g0 = ((const f32x4*)qn)[2 * lane], g1 = ((const f32x4*)qn)[2 * lane + 1];
        u32x4 w; w.x = pk2(v[0] * r * g0[0], v[1] * r * g0[1]); w.y = pk2(v[2] * r * g0[2], v[3] * r * g0[3]); w.z = pk2(v[4] * r * g1[0], v[5] * r * g1[1]); w.w = pk2(v[6] * r * g1[2], v[7] * r * g1[3]);
        ((u32x4*)CQ)[lane] = w;
    } else if (lane < 48) { const int l = lane - 32; const float r = rsqrtf(s16 * (1.f / KVLR) + EPS); const f32x4 g0 = ((const f32x4*)kvn)[2 * l], g1 = ((const f32x4*)kvn)[2 * l + 1];
        u32x4 w; w.x = pk2(v[0] * r * g0[0], v[1] * r * g0[1]); w.y = pk2(v[2] * r * g0[2], v[3] * r * g0[3]); w.z = pk2(v[4] * r * g1[0], v[5] * r * g1[1]); w.w = pk2(v[6] * r * g1[2], v[7] * r * g1[3]);
        ((u32x4*)CKV)[l] = w;
    } else if (lane < 56) { const int l = lane - 48; const f32x4 c = ((const f32x4*)cs)[l], sv = ((const f32x4*)sn)[l];
        u32x4 w; w.x = pk2(v[0] * c[0] - v[1] * sv[0], v[0] * sv[0] + v[1] * c[0]); w.y = pk2(v[2] * c[1] - v[3] * sv[1], v[2] * sv[1] + v[3] * c[1]);
        w.z = pk2(v[4] * c[2] - v[5] * sv[2], v[4] * sv[2] + v[5] * c[2]); w.w = pk2(v[6] * c[3] - v[7] * sv[3], v[6] * sv[3] + v[7] * c[3]);
        ((u32x4*)KR)[l] = w; }
}
__device__ __forceinline__ void row_hgrn(const bf16_t* __restrict__ Oa, const bf16_t* __restrict__ Gh, bf16_t* __restrict__ HO, const float* __restrict__ on, int lane) {
#pragma unroll
    for (int j = 0; j < 4; ++j) { const u32x2 a = ((const u32x2*)Oa + lane)[64 * j], b = ((const u32x2*)(Oa + (size_t)MT * 1024) + lane)[64 * j];
        f32x4 o; o[0] = __uint_as_float(a.x << 16) + __uint_as_float(b.x << 16); o[1] = __uint_as_float(a.x & 0xffff0000u) + __uint_as_float(b.x & 0xffff0000u);
        o[2] = __uint_as_float(a.y << 16) + __uint_as_float(b.y << 16); o[3] = __uint_as_float(a.y & 0xffff0000u) + __uint_as_float(b.y & 0xffff0000u);
        const float s = half_sum((o[0] * o[0] + o[1] * o[1]) + (o[2] * o[2] + o[3] * o[3]));
        const float r = rsqrtf(s * (1.f / 128.f) + EPS); const f32x4 gg = ((const f32x4*)on + lane)[64 * j]; const u32x2 gb = ((const u32x2*)Gh + lane)[64 * j];
        const float g0 = __uint_as_float(gb.x << 16), g1 = __uint_as_float(gb.x & 0xffff0000u), g2 = __uint_as_float(gb.y << 16), g3 = __uint_as_float(gb.y & 0xffff0000u);
        u32x2 w; w.x = pk2(o[0] * r * gg[0] * g0, o[1] * r * gg[1] * g1); w.y = pk2(o[2] * r * gg[2] * g2, o[3] * r * gg[3] * g3); ((u32x2*)HO + lane)[64 * j] = w; }
}
__device__ __forceinline__ f32x2 h2f2_(unsigned u) { const h16x2 h = __builtin_bit_cast(h16x2, u); return (f32x2){(float)h[0], (float)h[1]}; }
__device__ __forceinline__ void scan_phase(LAS unsigned char* lds, const bf16_t* __restrict__ Qh, const bf16_t* __restrict__ Vh, const unsigned short* __restrict__ KF, bf16_t* __restrict__ OP, int G, int bx) {
    int tid = threadIdx.x; asm volatile("" : "+v"(tid)); const int wid = __builtin_amdgcn_readfirstlane(tid >> 6), lane = tid & 63;
    const int st = tid >> 4, sc8 = (tid & 15) * 8, sv = tid >> 3, vc4 = (tid & 7) * 4;
    constexpr int OFF_K = 16384, OFF_Q = 32768, OFF_V = 49152, OFF_P = 53248;
    for (int item = bx; item < 256; item += G) {
        const int dir = item & 1, dvq = (item >> 1) & 3, h = (item >> 3) & 7, b = item >> 6;
        const size_t kcol = h * 128 + sc8, vcol = h * 128 + dvq * 32 + vc4;
        const unsigned short* KFd = KF + (size_t)dir * MT * 1024; bf16_t* OPd = OP + (size_t)dir * MT * 1024;
        u32x4 rk, rq; u32x2 rv = {0u, 0u};
#define SC_GLOAD(blk) do { { const int tt = (blk) * 32 + st; const size_t m = (size_t)b * SEQ + (dir ? SEQ - 1 - tt : tt); \
        rk = *(const u32x4*)(KFd + m * 1024 + kcol); rq = *(const u32x4*)(Qh + m * 1024 + kcol); } \
        if (tid < 256) { const int tt = (blk) * 32 + sv; const size_t m = (size_t)b * SEQ + (dir ? SEQ - 1 - tt : tt); rv = *(const u32x2*)(Vh + m * 1024 + vcol); } } while (0)
#define SC_H2F(u_) h2f2_(u_)
#define SC_LWRITE() do { LAS unsigned char* B_ = lds + (st * 128 + sc8) * 4; \
        const f32x2 ka = SC_H2F(rk.x), kb = SC_H2F(rk.y), kc = SC_H2F(rk.z), kd = SC_H2F(rk.w); \
        const f32x4 k0_ = {ka[0], ka[1], kb[0], kb[1]}, k1_ = {kc[0], kc[1], kd[0], kd[1]}; \
        *(LAS f32x4*)(B_ + OFF_K) = k0_; *(LAS f32x4*)(B_ + OFF_K + 16) = k1_; \
        *(LAS f32x4*)(B_ + OFF_Q) = (f32x4){__uint_as_float(rq.x << 16), __uint_as_float(rq.x & 0xffff0000u), __uint_as_float(rq.y << 16), __uint_as_float(rq.y & 0xffff0000u)}; \
        *(LAS f32x4*)(B_ + OFF_Q + 16) = (f32x4){__uint_as_float(rq.z << 16), __uint_as_float(rq.z & 0xffff0000u), __uint_as_float(rq.w << 16), __uint_as_float(rq.w & 0xffff0000u)}; \
        if (tid < 256) *(LAS f32x4*)(lds + OFF_V + (sv * 32 + vc4) * 4) = (f32x4){__uint_as_float(rv.x << 16), __uint_as_float(rv.x & 0xffff0000u), __uint_as_float(rv.y << 16), __uint_as_float(rv.y & 0xffff0000u)}; } while (0)
        SC_GLOAD(0);
        const int dksub = ((lane >> 3) & 1) | ((lane >> 5) << 1), dvp = (lane & 7) | (((lane >> 4) & 1) << 3);
        const LAS unsigned char* Bc = lds + (16 * wid + 4 * dksub) * 4;
        const LAS unsigned char* Vc = lds + OFF_V + dvp * 8;
        LAS unsigned char* Pw = lds + OFF_P + (wid * 4 + dksub) * 2048 + dvp * 4;
        f32x2 S2[4];
#pragma unroll
        for (int j = 0; j < 4; ++j) S2[j] = (f32x2){0.f, 0.f};
        for (int blk = 0; blk < SEQ / 32; ++blk) {
            SC_LWRITE();
            if (blk + 1 < SEQ / 32) SC_GLOAD(blk + 1);
            __syncthreads();
            f32x4 k4n = *(const LAS f32x4*)(Bc + OFF_K), q4n = *(const LAS f32x4*)(Bc + OFF_Q); f32x2 v2n = *(const LAS f32x2*)(Vc);
            f32x4 k4m = *(const LAS f32x4*)(Bc + OFF_K + 512), q4m = *(const LAS f32x4*)(Bc + OFF_Q + 512); f32x2 v2m = *(const LAS f32x2*)(Vc + 128);
#pragma unroll
            for (int t = 0; t < 32; ++t) {
                const f32x4 k4 = k4n, q4 = q4n; const f32x2 v2 = v2n;
                k4n = k4m; q4n = q4m; v2n = v2m;
                { const int tn = (t + 2) & 31;
                  k4m = *(const LAS f32x4*)(Bc + OFF_K + tn * 512); q4m = *(const LAS f32x4*)(Bc + OFF_Q + tn * 512); v2m = *(const LAS f32x2*)(Vc + tn * 128); }
                __builtin_amdgcn_sched_barrier(0);
#pragma unroll
                for (int j = 0; j < 4; ++j) S2[j] = S2[j] + (v2 - S2[j]) * k4[j];
                const f32x2 o2 = (S2[0] * q4[0] + S2[1] * q4[1]) + (S2[2] * q4[2] + S2[3] * q4[3]);
                *(LAS unsigned*)(Pw + t * 64) = pk2(o2[0], o2[1]);
            }
            __syncthreads();
            if (tid < 256) { const LAS unsigned char* Pr = lds + OFF_P + (sv * 32 + vc4) * 2; f32x4 acc = {0.f, 0.f, 0.f, 0.f};
#pragma unroll
              for (int g = 0; g < 32; ++g) { const u32x2 pv = *(const LAS u32x2*)(Pr + g * 2048);
                  acc[0] += __uint_as_float(pv.x << 16); acc[1] += __uint_as_float(pv.x & 0xffff0000u); acc[2] += __uint_as_float(pv.y << 16); acc[3] += __uint_as_float(pv.y & 0xffff0000u); }
              const int tt = blk * 32 + sv; const size_t m = (size_t)b * SEQ + (dir ? SEQ - 1 - tt : tt);
              u32x2 w; w.x = pk2(acc[0], acc[1]); w.y = pk2(acc[2], acc[3]); *(u32x2*)(OPd + m * 1024 + vcol) = w; }
        }
        __syncthreads();
#undef SC_GLOAD
#undef SC_LWRITE
#undef SC_H2F
    }
}

typedef float f32x16 __attribute__((ext_vector_type(16)));
typedef short s16x8 __attribute__((ext_vector_type(8)));
__device__ __forceinline__ int crow_(int r, int hi) { return (r & 3) + 8 * (r >> 2) + 4 * hi; }
template <int KSTEPS>
__device__ __forceinline__ void mm_tile(f32x16& c, const LAS unsigned char* X, int xstride, const LAS unsigned char* Y, int ystride, int r32, int hi) {
#pragma unroll
    for (int i = 0; i < KSTEPS; ++i) { const s16x8 x = *(const LAS s16x8*)(X + r32 * xstride + (16 * i + 8 * hi) * 2), y = *(const LAS s16x8*)(Y + r32 * ystride + (16 * i + 8 * hi) * 2);
        c = __builtin_amdgcn_mfma_f32_32x32x16_bf16(x, y, c, 0, 0, 0); }
}
__device__ __forceinline__ void scan_phase_mfma(LAS unsigned char* lds, const bf16_t* __restrict__ Qh, const bf16_t* __restrict__ Vh, const unsigned short* __restrict__ KF, bf16_t* __restrict__ OP, int G, int bx) {
    int tid = threadIdx.x; asm volatile("" : "+v"(tid)); const int wid = __builtin_amdgcn_readfirstlane(tid >> 6), lane = tid & 63, r32 = lane & 31, hi = lane >> 5;
    const bool grpA = wid < 4;
    const int st = (tid >> 3) & 31, sc16 = (tid & 7) * 16, vc4 = (tid & 7) * 4;
    constexpr int SQ = 272, SV = 80, NC = SEQ / 32;
    constexpr int IMG = 2 * 32 * SQ + 128 * SV + 32 * SV + 512;
    constexpr int O_LG = 0, O_IMG = 16384, O_AT = O_IMG + 2 * IMG, O_ST = O_AT + 32 * SV;
    constexpr int I_QT = 0, I_KT = 32 * SQ, I_KTT = 2 * 32 * SQ, I_VT = I_KTT + 128 * SV, I_G = I_VT + 32 * SV;
    static_assert(O_ST + 32 * SQ <= LDS_RING && IMG % 16 == 0, "scan LDS map");
    for (int item = bx; item < 256; item += G) {
        const int dir = item & 1, dvq = (item >> 1) & 3, h = (item >> 3) & 7, b = item >> 6;
        const size_t kcol = h * 128 + sc16, vcol = h * 128 + dvq * 32 + vc4;
        const unsigned short* KFd = KF + (size_t)dir * MT * 1024; bf16_t* OPd = OP + (size_t)dir * MT * 1024;
        u32x4 rk0, rk1, rq0, rq1; u32x2 rv;
#define SM_GLOAD(blk) do { const int tt = (blk) * 32 + st; const size_t m = (size_t)b * SEQ + (dir ? SEQ - 1 - tt : tt); \
        rk0 = *(const u32x4*)(KFd + m * 1024 + kcol); rk1 = *(const u32x4*)(KFd + m * 1024 + kcol + 8); rq0 = *(const u32x4*)(Qh + m * 1024 + kcol); rq1 = *(const u32x4*)(Qh + m * 1024 + kcol + 8); \
        rv = *(const u32x2*)(Vh + m * 1024 + vcol); } while (0)
        if (grpA) SM_GLOAD(0);
        f32x16 accS, accO;
#pragma unroll
        for (int r = 0; r < 16; ++r) { accS[r] = 0.f; accO[r] = 0.f; }
        for (int i = tid; i < 32 * SQ / 4; i += 512) ((LAS unsigned*)(lds + O_ST))[i] = 0u;
        __syncthreads();
        for (int rd = -1; rd < NC; ++rd) {
            const int cn = rd + 1;
            LAS unsigned char* Wi = lds + O_IMG + (cn & 1) * IMG;
            const LAS unsigned char* Ri = lds + O_IMG + (rd & 1) * IMG;
            float kf[16];
            if (grpA) { if (cn < NC) {
                { const f32x2 a = h2f2_(rk0.x), bq = h2f2_(rk0.y), c = h2f2_(rk0.z), d = h2f2_(rk0.w), e = h2f2_(rk1.x), f = h2f2_(rk1.y), g2 = h2f2_(rk1.z), h2 = h2f2_(rk1.w);
                  kf[0] = a[0]; kf[1] = a[1]; kf[2] = bq[0]; kf[3] = bq[1]; kf[4] = c[0]; kf[5] = c[1]; kf[6] = d[0]; kf[7] = d[1];
                  kf[8] = e[0]; kf[9] = e[1]; kf[10] = f[0]; kf[11] = f[1]; kf[12] = g2[0]; kf[13] = g2[1]; kf[14] = h2[0]; kf[15] = h2[1]; }
                LAS unsigned char* L_ = lds + O_LG + (st * 128 + sc16) * 4;
#pragma unroll
                for (int q4 = 0; q4 < 4; ++q4) { f32x4 a4;
#pragma unroll
                    for (int e = 0; e < 4; ++e) a4[e] = __builtin_amdgcn_logf(1.0f - kf[4 * q4 + e]);
                    *(LAS f32x4*)(L_ + 16 * q4) = a4; }
                LAS unsigned char* V_ = Wi + I_VT + st * 2;
                *(LAS unsigned short*)(V_ + (vc4 + 0) * SV) = (unsigned short)(rv.x & 0xffffu); *(LAS unsigned short*)(V_ + (vc4 + 1) * SV) = (unsigned short)(rv.x >> 16);
                *(LAS unsigned short*)(V_ + (vc4 + 2) * SV) = (unsigned short)(rv.y & 0xffffu); *(LAS unsigned short*)(V_ + (vc4 + 3) * SV) = (unsigned short)(rv.y >> 16);
            } } else if (rd >= 0) {
                const int w4 = wid - 4;
                mm_tile<2>(accS, Ri + I_KTT + w4 * 32 * SV, SV, Ri + I_VT, SV, r32, hi);
                if (w4 == 0) { f32x16 p;
#pragma unroll
                    for (int r = 0; r < 16; ++r) p[r] = 0.f;
                    mm_tile<8>(p, Ri + I_QT, SQ, Ri + I_KT, SQ, r32, hi);
#pragma unroll
                    for (int r = 0; r < 16; ++r) { const int t = crow_(r, hi); const float pv = r32 <= t ? p[r] : 0.f;
                        *(LAS unsigned short*)(lds + O_AT + t * SV + r32 * 2) = (unsigned short)(pk2(pv, 0.f) & 0xffffu); } }
                else if (w4 == 1) {
#pragma unroll
                    for (int r = 0; r < 16; ++r) accO[r] = 0.f;
                    mm_tile<8>(accO, Ri + I_QT, SQ, lds + O_ST, SQ, r32, hi); }
            }
            __syncthreads();
            if (grpA) { if (cn < NC) {
#pragma unroll
                for (int u = 0; u < 2; ++u) { LAS float* col = (LAS float*)(lds + O_LG) + (tid & 127) + (((tid >> 7) & 1) + 2 * u) * 8 * 128; float acc = 0.f;
#pragma unroll
                    for (int t = 0; t < 8; ++t) { acc += col[t * 128]; col[t * 128] = acc; } }
            } } else if (rd >= 0) {
                const int w4 = wid - 4;
                if (w4 == 1) { mm_tile<2>(accO, lds + O_AT, SV, Ri + I_VT, SV, r32, hi);
#pragma unroll
                    for (int r = 0; r < 16; ++r) { const int tt = rd * 32 + crow_(r, hi); const size_t m = (size_t)b * SEQ + (dir ? SEQ - 1 - tt : tt);
                        OPd[m * 1024 + h * 128 + dvq * 32 + r32] = (bf16_t)(pk2(accO[r], 0.f) & 0xffffu); } }
            }
            __syncthreads();
            if (grpA) { if (cn < NC) {
                const LAS unsigned char* L_ = lds + O_LG + (st * 128 + sc16) * 4; float bb[16];
#pragma unroll
                for (int q4 = 0; q4 < 4; ++q4) { const f32x4 t4 = *(const LAS f32x4*)(L_ + 16 * q4); bb[4 * q4] = t4[0]; bb[4 * q4 + 1] = t4[1]; bb[4 * q4 + 2] = t4[2]; bb[4 * q4 + 3] = t4[3]; }
#pragma unroll
                for (int qd = 0; qd < 3; ++qd) { const LAS unsigned char* T_ = lds + O_LG + ((8 * qd + 7) * 128 + sc16) * 4; const float m_ = (st >> 3) > qd ? 1.f : 0.f;
#pragma unroll
                    for (int q4 = 0; q4 < 4; ++q4) { const f32x4 t4 = *(const LAS f32x4*)(T_ + 16 * q4); bb[4 * q4] += t4[0] * m_; bb[4 * q4 + 1] += t4[1] * m_; bb[4 * q4 + 2] += t4[2] * m_; bb[4 * q4 + 3] += t4[3] * m_; } }
                const unsigned qraw[8] = {rq0.x, rq0.y, rq0.z, rq0.w, rq1.x, rq1.y, rq1.z, rq1.w};
                unsigned qw[8], kw[8];
#pragma unroll
                for (int e = 0; e < 8; ++e) { const float e0 = __builtin_amdgcn_exp2f(bb[2 * e]), e1 = __builtin_amdgcn_exp2f(bb[2 * e + 1]);
                    qw[e] = pk2(__uint_as_float(qraw[e] << 16) * e0, __uint_as_float(qraw[e] & 0xffff0000u) * e1);
                    kw[e] = pk2(kf[2 * e] * __builtin_amdgcn_exp2f(-bb[2 * e]), kf[2 * e + 1] * __builtin_amdgcn_exp2f(-bb[2 * e + 1]));
                    if (st == 31) { ((LAS float*)(Wi + I_G))[sc16 + 2 * e] = e0; ((LAS float*)(Wi + I_G))[sc16 + 2 * e + 1] = e1; } }
                *(LAS u32x4*)(Wi + I_QT + st * SQ + sc16 * 2) = (u32x4){qw[0], qw[1], qw[2], qw[3]}; *(LAS u32x4*)(Wi + I_QT + st * SQ + sc16 * 2 + 16) = (u32x4){qw[4], qw[5], qw[6], qw[7]};
                *(LAS u32x4*)(Wi + I_KT + st * SQ + sc16 * 2) = (u32x4){kw[0], kw[1], kw[2], kw[3]}; *(LAS u32x4*)(Wi + I_KT + st * SQ + sc16 * 2 + 16) = (u32x4){kw[4], kw[5], kw[6], kw[7]};
                LAS unsigned char* T_ = Wi + I_KTT + sc16 * SV + st * 2;
#pragma unroll
                for (int e = 0; e < 8; ++e) { *(LAS unsigned short*)(T_ + (2 * e) * SV) = (unsigned short)(kw[e] & 0xffffu); *(LAS unsigned short*)(T_ + (2 * e + 1) * SV) = (unsigned short)(kw[e] >> 16); }
                if (cn + 1 < NC) SM_GLOAD(cn + 1);
            } } else if (rd >= 0) {
                const int w4 = wid - 4;
#pragma unroll
                for (int g = 0; g < 4; ++g) { const int dk0 = 32 * w4 + 8 * g + 4 * hi; const f32x4 gm = *(const LAS f32x4*)(Ri + I_G + dk0 * 4);
                    accS[4 * g + 0] *= gm[0]; accS[4 * g + 1] *= gm[1]; accS[4 * g + 2] *= gm[2]; accS[4 * g + 3] *= gm[3];
                    u32x2 w; w.x = pk2(accS[4 * g + 0], accS[4 * g + 1]); w.y = pk2(accS[4 * g + 2], accS[4 * g + 3]);
                    *(LAS u32x2*)(lds + O_ST + r32 * SQ + dk0 * 2) = w; }
            }
            __syncthreads();
        }
#undef SM_GLOAD
    }
}

enum Op { OP_SW0, OP_FO0, OP_RPA, OP_MIN, OP_RMLA, OP_QKV, OP_ATTN, OP_MWO, OP_RPB, OP_SW1, OP_FO1, OP_RPC, OP_HIN, OP_SCAN, OP_RHG, OP_HWO };
__device__ const unsigned char OPS_M[12] = {OP_SW0, OP_FO0, OP_RPA, OP_MIN, OP_RMLA, OP_QKV, OP_ATTN, OP_MWO, OP_RPB, OP_SW1, OP_FO1, OP_RPC};
__device__ const unsigned char OPS_H[11] = {OP_SW0, OP_FO0, OP_RPA, OP_HIN, OP_SCAN, OP_RHG, OP_HWO, OP_RPB, OP_SW1, OP_FO1, OP_RPC};

struct Args { const float* in[15]; float* out; unsigned char* ws; };
typedef const __attribute__((address_space(4))) Args* ArgsP;
__device__ __forceinline__ ArgsP get_args() { ArgsP p = (ArgsP)__builtin_amdgcn_kernarg_segment_ptr(); asm volatile("" : "+s"(p) :: "memory"); return p; }
#define GW_ ((int)blockIdx.x * 8 + __builtin_amdgcn_readfirstlane((int)threadIdx.x >> 6))
#define NGW_ ((int)gridDim.x * 8)
__device__ __forceinline__ int otid_() { int t = threadIdx.x; asm volatile("" : "+v"(t)); return t; }
#define LANE_ (otid_() & 63)

#ifdef DBG_CHECKS
__device__ __forceinline__ float bf2f(bf16_t v) { return __uint_as_float((unsigned)v << 16); }
__device__ __forceinline__ unsigned hash_u(unsigned x) { x ^= x >> 16; x *= 0x7feb352du; x ^= x >> 15; x *= 0x846ca68bu; x ^= x >> 16; return x; }
__device__ __forceinline__ void dbg_report(unsigned* DBG, int id, float got, float ref, float rtol, float atol) {
    const float err = fabsf(got - ref); const bool bad = !(err <= rtol * fabsf(ref) + atol);
    if (bad) atomicMax(DBG + id, 1u);
}
__device__ __forceinline__ int dbg_row(int sidx) { if (sidx == 0) return 0; if (sidx == 1) return MT - 1; if (sidx == 2) return SEQ - 1; if (sidx == 3) return SEQ; return (int)(hash_u(sidx * 2654435761u + 17u) % MT); }
#endif
#ifdef DBG_CHECKS
struct DbgCtx { const float* const* in; unsigned char* ws; unsigned char* R; unsigned* DBG; int bx, tid, lane, wave; };
__device__ __forceinline__ float dbg_dot_bf_w(const bf16_t* a, const float* W, int K, int ldw, int col) { float s = 0.f; for (int k = 0; k < K; ++k) s += bf2f(a[k]) * W[(size_t)k * ldw + col]; return s; }
template <class A>
__device__ __forceinline__ void dbg_after(int l, int op, A ap, unsigned char* ws, unsigned char* R, LAS unsigned char* lds) {
    unsigned* DBG = (unsigned*)(ws + 32768);
    const int bx = blockIdx.x, tid = otid_(), lane = tid & 63, wave = __builtin_amdgcn_readfirstlane(tid >> 6);
    const bf16_t* HN = (const bf16_t*)(ws + WS_HN); const float* Y = (const float*)(ws + WS_Y);
    if (false && l == 0 && op == OP_SW0 && bx < 32) { const int sid = bx * 512 + tid, m = dbg_row(sid), c = hash_u(sid * 3 + 1) % DFF; const float* W = ap->in[3];
        const float g = dbg_dot_bf_w(HN + (size_t)m * 1024, W, 1024, 2 * DFF, c), u = dbg_dot_bf_w(HN + (size_t)m * 1024, W, 1024, 2 * DFF, DFF + c);
        dbg_report(DBG, 1, bf2f(((const bf16_t*)(R + R_ACT))[(size_t)m * DFF + c]), g / (1.f + expf(-g)) * u, 0.015f, 0.004f); }
    if (false && l == 0 && op == OP_FO0 && bx < 32) { const int sid = bx * 512 + tid, m = dbg_row(sid), c = hash_u(sid * 3 + 2) % 1024;
        const float r = dbg_dot_bf_w((const bf16_t*)(R + R_ACT) + (size_t)m * DFF, ap->in[4], DFF, 1024, c);
        dbg_report(DBG, 2, Y[(size_t)m * 1024 + c], r, 0.015f, 0.004f); }
    if (false && l == 0 && op == OP_RPA && bx < 32) { const int sid = bx * 512 + tid, m = dbg_row(sid), c = hash_u(sid * 3 + 3) % 1024; const float* g = ap->in[2];
        float s = 0.f; for (int k = 0; k < 1024; ++k) { const float y = Y[(size_t)m * 1024 + k]; s += y * y; }
        const float xr = ap->in[0][(size_t)m * 1024 + c] + 0.5f * Y[(size_t)m * 1024 + c] * rsqrtf(s / 1024.f + EPS) * g[1024 + c];
        dbg_report(DBG, 2, ap->out[(size_t)m * 1024 + c], xr, 1e-3f, 1e-3f);
        float s2 = 0.f; for (int k = 0; k < 1024; ++k) { const float x = ap->out[(size_t)m * 1024 + k]; s2 += x * x; }
        dbg_report(DBG, 2, bf2f(HN[(size_t)m * 1024 + c]), ap->out[(size_t)m * 1024 + c] * rsqrtf(s2 / 1024.f + EPS) * g[2048 + c], 0.01f, 0.01f); }
    if (false && l == 0 && op == OP_MIN && bx < 32) { const int sid = bx * 512 + tid, m = dbg_row(sid), c = hash_u(sid * 3 + 4) % 512; const int sc = src_col(2, c);
        const float r = sc >= 0 ? dbg_dot_bf_w(HN + (size_t)m * 1024, ap->in[5], 1024, 448, sc) : 0.f;
        dbg_report(DBG, 3, ((const float*)(R + R_C))[(size_t)m * 512 + c], r, 0.015f, 0.01f); }
    if (false && l == 0 && op == OP_RMLA && bx < 32) { const int sid = bx * 512 + tid, m = dbg_row(sid), c = hash_u(sid * 3 + 5) % 448; const float* C = (const float*)(R + R_C) + (size_t)m * 512;
        if (c < 256) { float s = 0.f; for (int k = 0; k < 256; ++k) s += C[k] * C[k];
            dbg_report(DBG, 3, bf2f(((const bf16_t*)(R + R_CQ))[(size_t)m * 256 + c]), C[c] * rsqrtf(s / 256.f + EPS) * ap->in[6][c], 0.01f, 0.01f); }
        else if (c < 384) { float s = 0.f; for (int k = 256; k < 384; ++k) s += C[k] * C[k];
            dbg_report(DBG, 3, bf2f(((const bf16_t*)(R + R_CKV))[(size_t)m * 128 + c - 256]), C[c] * rsqrtf(s / 128.f + EPS) * ap->in[7][c - 256], 0.01f, 0.01f); }
        else { const int jj = c - 384, i = jj >> 1; const float ang = (float)((const int*)ap->in[1])[m] * powf(10000.f, -(float)i / 32.f); const float cs = cosf(ang), sn = sinf(ang);
            const float t1 = C[384 + 2 * i], t2 = C[384 + 2 * i + 1]; const float r = (jj & 1) ? t1 * sn + t2 * cs : t1 * cs - t2 * sn;
            dbg_report(DBG, 3, bf2f(((const bf16_t*)(R + R_KR))[(size_t)m * 64 + jj]), r, 0.02f, 0.05f); } }
    if (false && l == 0 && op == OP_QKV && bx < 32) { const int sid = bx * 512 + tid, m = dbg_row(sid); const bf16_t* CQ = (const bf16_t*)(R + R_CQ) + (size_t)m * 256; const bf16_t* CKV = (const bf16_t*)(R + R_CKV) + (size_t)m * 128;
        { const int c = hash_u(sid * 3 + 6) % 1536, h = c / QKD, d = c % QKD; float r;
          if (d < 128) r = dbg_dot_bf_w(CQ, ap->in[8], 256, 1536, c);
          else { const int jj = d - 128, i = jj >> 1; const float t1 = dbg_dot_bf_w(CQ, ap->in[8], 256, 1536, h * QKD + 128 + i), t2 = dbg_dot_bf_w(CQ, ap->in[8], 256, 1536, h * QKD + 160 + i);
              const float ang = (float)((const int*)ap->in[1])[m] * powf(10000.f, -(float)i / 32.f); const float cs = cosf(ang), sn = sinf(ang); r = (jj & 1) ? t1 * sn + t2 * cs : t1 * cs - t2 * sn; }
          dbg_report(DBG, 4, bf2f(((const bf16_t*)(R + R_QB))[(size_t)m * 1536 + c]), r, 0.015f, 0.015f); }
        { const int c = hash_u(sid * 3 + 7) % 2048, h = c >> 8, d = c & 255; const float r = dbg_dot_bf_w(CKV, ap->in[9], 128, 2048, c);
          const float got = d < 128 ? bf2f(((const bf16_t*)(R + R_KN))[(size_t)m * 1024 + h * 128 + d]) : bf2f(((const bf16_t*)(R + R_VB))[(size_t)m * 1024 + h * 128 + d - 128]);
          dbg_report(DBG, 5, got, r, 0.015f, 0.015f); } }
    if (l == 0 && op == OP_ATTN) { const int sid = bx * 8 + wave, m = dbg_row(sid), h = hash_u(sid * 5 + 1) & 7, dv = hash_u(sid * 5 + 2) & 127, b = m / SEQ;
        LAS float* qs = (LAS float*)lds + wave * 192; const bf16_t* Q = (const bf16_t*)(R + R_QB) + (size_t)m * 1536 + h * QKD;
        for (int d = lane; d < 192; d += 64) qs[d] = bf2f(Q[d]);
        asm volatile("s_waitcnt lgkmcnt(0)" ::: "memory");
        float mx = -1e30f, ls = 0.f, acc = 0.f;
        for (int kk = lane; kk < SEQ; kk += 64) { const size_t km = (size_t)b * SEQ + kk; const bf16_t* Kn = (const bf16_t*)(R + R_KN) + km * 1024 + h * 128; const bf16_t* Kr = (const bf16_t*)(R + R_KR) + km * 64;
            float s = 0.f; for (int d = 0; d < 128; ++d) s += qs[d] * bf2f(Kn[d]); for (int d = 0; d < 64; ++d) s += qs[128 + d] * bf2f(Kr[d]);
            s *= 0.07216878364870322f; const float v = bf2f(((const bf16_t*)(R + R_VB))[km * 1024 + h * 128 + dv]);
            const float mn = fmaxf(mx, s), al = expf(mx - mn), p = expf(s - mn); ls = ls * al + p; acc = acc * al + p * v; mx = mn; }
        float gm = mx;
        for (int o = 1; o < 64; o <<= 1) gm = fmaxf(gm, __shfl_xor(gm, o));
        const float sc = expf(mx - gm); const float L = wave_sum(ls * sc), Asum = wave_sum(acc * sc);
        if (lane == 0) { const float got = bf2f(((const bf16_t*)(R + R_O))[(size_t)m * 1024 + h * 128 + dv]), ref = Asum / L; atomicMax(DBG + 20, __float_as_uint(fabsf(got - ref))); atomicAdd((float*)(DBG + 21), fabsf(ref) * (1.f / 2048.f)); } }
    if (false && l == 1 && op == OP_HIN && bx < 32) { const int sid = bx * 512 + tid, m = dbg_row(sid), c5 = hash_u(sid * 3 + 8) % 5120, seg = c5 >> 10, c = c5 & 1023;
        const float u = dbg_dot_bf_w(HN + (size_t)m * 1024, ap->in[11], 1024, 5120, c5); float got, r;
        if (seg == 0) { got = bf2f(((const bf16_t*)(R + R_QH))[(size_t)m * 1024 + c]); r = u / (1.f + expf(-u)); }
        else if (seg == 3) { got = bf2f(((const bf16_t*)(R + R_VH))[(size_t)m * 1024 + c]); r = u; }
        else if (seg == 4) { got = bf2f(((const bf16_t*)(R + R_GH))[(size_t)m * 1024 + c]); r = u / (1.f + expf(-u)); }
        else { const int dir = seg - 1; const float* lbp = ap->in[12] + (size_t)dir * DEPTH * 1024 + c; const float e0 = expf(lbp[0]), e1 = expf(lbp[1024]), e2 = expf(lbp[2048]), e3 = expf(lbp[3072]);
            const float lb = e1 / (e0 + e1 + e2 + e3); const h16x2 hv = __builtin_bit_cast(h16x2, (unsigned)((const unsigned short*)(R + R_KF))[(size_t)dir * MT * 1024 + (size_t)m * 1024 + c]);
            got = (float)hv[0]; r = (1.f - lb) / (1.f + expf(u)); }
        dbg_report(DBG, 7, got, r, 0.015f, 0.006f); }
    if (false && l == 1 && op == OP_SCAN) { const int sid = bx * 8 + wave, h = hash_u(sid * 5 + 3) & 7, dv = hash_u(sid * 5 + 4) & 127, b = hash_u(sid * 5 + 5) & 3, toff = sid & 31, dir = 0;
        const bf16_t* Qh = (const bf16_t*)(R + R_QH); const bf16_t* Vh = (const bf16_t*)(R + R_VH); const unsigned short* KF = (const unsigned short*)(R + R_KF); const bf16_t* OPb = (const bf16_t*)(ws + WS_Y);
        float S0 = 0.f, S1 = 0.f; const int n = toff + 1; const int t = toff; const size_t m = (size_t)b * SEQ + t;
        for (int i = 0; i < n; ++i) { const int tt = i; const size_t mm = (size_t)b * SEQ + tt; const unsigned short* kp = KF + (size_t)dir * MT * 1024 + mm * 1024 + h * 128;
            const h16x2 ka = __builtin_bit_cast(h16x2, (unsigned)kp[lane]), kb = __builtin_bit_cast(h16x2, (unsigned)kp[lane + 64]); const float k0 = (float)ka[0], k1 = (float)kb[0];
            const float v = bf2f(Vh[mm * 1024 + h * 128 + dv]); S0 = S0 * (1.f - k0) + k0 * v; S1 = S1 * (1.f - k1) + k1 * v; }
        const bf16_t* q = Qh + m * 1024 + h * 128; const float tot = wave_sum(S0 * bf2f(q[lane]) + S1 * bf2f(q[lane + 64]));
        if (lane == 0) { const float got = bf2f(OPb[(size_t)dir * MT * 1024 + m * 1024 + h * 128 + dv]); const float re = fabsf(got - tot) / (fabsf(tot) + 0.05f);
            if (re > 0.05f) { atomicMin(DBG + 20, (unsigned)toff); atomicAdd(DBG + 21, 1u); } } }
    if (false && l == 1 && op == OP_RHG && bx < 32) { const int sid = bx * 512 + tid, m = dbg_row(sid), c = hash_u(sid * 3 + 9) % 1024, h0 = c & ~127; const bf16_t* OPb = (const bf16_t*)(ws + WS_Y);
        float s = 0.f; for (int k = 0; k < 128; ++k) { const float y = bf2f(OPb[(size_t)m * 1024 + h0 + k]) + bf2f(OPb[(size_t)MT * 1024 + (size_t)m * 1024 + h0 + k]); s += y * y; }
        const float yc = bf2f(OPb[(size_t)m * 1024 + c]) + bf2f(OPb[(size_t)MT * 1024 + (size_t)m * 1024 + c]);
        const float r = yc * rsqrtf(s / 128.f + EPS) * ap->in[13][c] * bf2f(((const bf16_t*)(R + R_GH))[(size_t)m * 1024 + c]);
        dbg_report(DBG, 9, bf2f(((const bf16_t*)(R + R_HO))[(size_t)m * 1024 + c]), r, 0.02f, 0.005f); }
    if (false && l == 1 && op == OP_HWO && bx < 32) { const int sid = bx * 512 + tid, m = dbg_row(sid), c = hash_u(sid * 3 + 10) % 1024;
        const float r = dbg_dot_bf_w((const bf16_t*)(R + R_HO) + (size_t)m * 1024, ap->in[14], 1024, 1024, c);
        dbg_report(DBG, 9, Y[(size_t)m * 1024 + c], r, 0.03f, 0.01f); }
    if (false && l == 0 && op == OP_MWO && bx < 32) { const int sid = bx * 512 + tid, m = dbg_row(sid), c = hash_u(sid * 3 + 11) % 1024;
        const float r = dbg_dot_bf_w((const bf16_t*)(R + R_O) + (size_t)m * 1024, ap->in[10], 1024, 1024, c);
        dbg_report(DBG, 6, Y[(size_t)m * 1024 + c], r, 0.02f, 0.0004f); }
}
#endif

__device__ __forceinline__ void gsync_cg() {
    asm volatile("s_waitcnt vmcnt(0) lgkmcnt(0)" ::: "memory");
    __syncthreads();
    cg::this_grid().sync();
    if (threadIdx.x == 0) { __builtin_amdgcn_fence(__ATOMIC_ACQUIRE, "agent"); asm volatile("s_waitcnt vmcnt(0)" ::: "memory"); }
    __syncthreads();
}
#define GAS __attribute__((address_space(1)))
#define XB_TMO      128
#define XB_XCNT(j)  (256  + 64 * (j))
#define XB_XSUB(j)  (1280 + 64 * (j))
#define XB_XGEN(j)  (2304 + 64 * (j))
#define XB_TOP      3328
#define XB_TOPGEN   3392
#define XCD_BAR_WORDS 3456
#define XB_SPIN_CAP (1u << 18)

__device__ __forceinline__ unsigned xb_ld(unsigned* p)              { return __hip_atomic_load(p, __ATOMIC_RELAXED, __HIP_MEMORY_SCOPE_AGENT); }
__device__ __forceinline__ unsigned xb_add(unsigned* p, unsigned v) { return __hip_atomic_fetch_add(p, v, __ATOMIC_RELAXED, __HIP_MEMORY_SCOPE_AGENT); }
__device__ __forceinline__ unsigned xb_xcc_id() { return (unsigned)__builtin_amdgcn_s_getreg((3 << 11) | 20) & 0xFu; }
#define XB_SPIN(cond, bar) do { unsigned _sp = 0; while (cond) { __builtin_amdgcn_s_sleep(1); \
    if ((++_sp & 255u) == 0u) { if (xb_ld(&(bar)[XB_TMO])) break; if (_sp > XB_SPIN_CAP) { atomicAdd(&(bar)[XB_TMO], 1u); break; } } } } while (0)

struct XcdBarrier {
    unsigned* bar; unsigned x;
    volatile LAS unsigned* st;
};

__device__ __forceinline__ XcdBarrier xcd_barrier_post(unsigned* bar, volatile LAS unsigned* st) {
    XcdBarrier b; b.bar = bar; b.x = xb_xcc_id(); b.st = st;
    if (threadIdx.x == 0) (void)xb_add(&bar[XB_XCNT(b.x)], 1u);
    return b;
}
__device__ __forceinline__ void xcd_barrier_complete(unsigned* bar, unsigned x, unsigned& nloc, unsigned& nx) {
    const unsigned G = gridDim.x * gridDim.y * gridDim.z;
    unsigned sum, cnt, mine, sp = 0u;
    for (;;) {
        sum = 0u; cnt = 0u; mine = 0u;
#pragma unroll
        for (unsigned j = 0; j < 16; ++j) { const unsigned c = xb_ld(&bar[XB_XCNT(j)]); sum += c; cnt += (c > 0u) ? 1u : 0u; mine = (j == x) ? c : mine; }
        if (sum == G) break;
        __builtin_amdgcn_s_sleep(1);
        if ((++sp & 255u) == 0u) { if (xb_ld(&bar[XB_TMO])) break; if (sp > XB_SPIN_CAP) { atomicAdd(&bar[XB_TMO], 1u); break; } }
    }
    nloc = mine > 0u ? mine : 1u; nx = cnt > 0u ? cnt : 1u;
}

__device__ __forceinline__ void xcd_barrier(const XcdBarrier& b) {
    asm volatile("s_waitcnt vmcnt(0)" ::: "memory");
    __syncthreads();
    if (threadIdx.x == 0) {
        unsigned* bar = b.bar;
        __builtin_amdgcn_s_waitcnt(0);
        unsigned nloc = b.st[0], nx = b.st[1];
        if (nloc == 0u) { xcd_barrier_complete(bar, b.x, nloc, nx); b.st[0] = nloc; b.st[1] = nx; }
        const unsigned old = xb_add(&bar[XB_XSUB(b.x)], 1u);
        const unsigned gen = old / nloc;
        if (old + 1u == (gen + 1u) * nloc) {
            __builtin_amdgcn_fence(__ATOMIC_RELEASE, "agent");
            asm volatile("s_waitcnt vmcnt(0)" ::: "memory");
            const unsigned og = xb_add(&bar[XB_TOP], 1u);
            const unsigned tg = og / nx;
            if (og + 1u == (tg + 1u) * nx) xb_add(&bar[XB_TOPGEN], 1u);
            else XB_SPIN(xb_ld(&bar[XB_TOPGEN]) == tg, bar);
            __builtin_amdgcn_fence(__ATOMIC_ACQUIRE, "agent");
            xb_add(&bar[XB_XGEN(b.x)], 1u);
            asm volatile("s_waitcnt vmcnt(0)" ::: "memory");
        } else {
            XB_SPIN(xb_ld(&bar[XB_XGEN(b.x)]) == gen, bar);
            __builtin_amdgcn_fence(__ATOMIC_ACQUIRE, "agent");
            asm volatile("s_waitcnt vmcnt(0)" ::: "memory");
        }
    }
    __syncthreads();
}

__device__ __forceinline__ void gsync(LAS unsigned char* lds) {
#ifdef USE_CG_SYNC
    gsync_cg();
#else
    XcdBarrier b; b.bar = (unsigned*)get_args()->ws; b.x = xb_xcc_id(); b.st = (volatile LAS unsigned*)(lds + LDS_RING);
    xcd_barrier(b);
#endif
}
__global__ void __launch_bounds__(512, 2) mega_fwd(Args a_unused) {
    extern __shared__ __attribute__((aligned(16))) unsigned char lds_raw[];
    LAS unsigned char* lds = (LAS unsigned char*)lds_raw;

    if (threadIdx.x < 2) ((volatile LAS unsigned*)(lds + LDS_RING))[threadIdx.x] = 0u;
    __syncthreads();
    (void)xcd_barrier_post((unsigned*)get_args()->ws, (volatile LAS unsigned*)(lds + LDS_RING));
#ifdef REP_PRO
    for (int rep_ = 0; rep_ < 2; ++rep_)
#endif
    {
        ArgsP ap = get_args(); unsigned char* ws = ap->ws;
#ifdef DBG_CHECKS
        if (blockIdx.x == 0 && threadIdx.x < 32) atomicExch((unsigned*)ws + threadIdx.x, 0u);
#endif
        const int tid = threadIdx.x, lane = tid & 63, wave = __builtin_amdgcn_readfirstlane(tid >> 6), G = gridDim.x, bx = blockIdx.x, gw = bx * 8 + wave, NGW = G * 8;
        LAS float* scr = (LAS float*)(lds + wave * 16384);
        constexpr int I_FFI = 16 * 176, I_FFO = 44 * 32, I_HIN = 16 * 160, I_SQ = 16 * 32, I_MIN = 16 * 16, I_UQ = 4 * 48, I_UKV = 2 * 64;
        constexpr int NITEMS = 8 * I_FFI + 8 * I_FFO + 2 * I_HIN + 2 * I_SQ + 2 * I_MIN + 2 * I_UQ + 2 * I_UKV + 2 * I_SQ;
        for (int it = gw; it < NITEMS; it += NGW) {
            int r = it;
#define XP(IDX_, K_, NS_, ND_, MODE_, WSOFF_, NMAT_, IPM_) if (r < (NMAT_) * (IPM_)) { const int mat = r / (IPM_); \
            xpose_item(ap->in[IDX_] + (size_t)mat * (K_) * (NS_), K_, NS_, ND_, MODE_, (bf16_t*)(ws + (WSOFF_)) + (size_t)mat * (ND_) * (K_), scr, r % (IPM_), lane); continue; } r -= (NMAT_) * (IPM_);
            XP(3, 1024, 2 * DFF, 2 * DFF, 1, WS_WFFI, 8, I_FFI)
            XP(4, DFF, 1024, 1024, 0, WS_WFFO, 8, I_FFO)
            XP(11, 1024, 5120, 5120, 0, WS_WHIN, 2, I_HIN)
            XP(14, 1024, 1024, 1024, 0, WS_WHO, 2, I_SQ)
            XP(5, 1024, 448, 512, 2, WS_WMIN, 2, I_MIN)
            XP(8, 256, 1536, 1536, 3, WS_WUQ, 2, I_UQ)
            XP(9, 128, 2048, 2048, 0, WS_WUKV, 2, I_UKV)
            XP(10, 1024, 1024, 1024, 0, WS_WMO, 2, I_SQ)
#undef XP
        }
        { const int* positions = (const int*)ap->in[1]; float* COS = (float*)(ws + WS_COS); float* SIN = (float*)(ws + WS_SIN);
          for (int idx = bx * 512 + tid; idx < MT * 32; idx += G * 512) { const int m = idx >> 5, i = idx & 31;
            const double ang = (double)positions[m] * ROPE_INVF[i]; const double rev = ang * 0.15915494309189535; const float fr = (float)(rev - __builtin_rint(rev));
            COS[idx] = __builtin_amdgcn_cosf(fr); SIN[idx] = __builtin_amdgcn_sinf(fr); } }
        { float* LB = (float*)(ws + WS_LB);
          for (int idx = bx * 512 + tid; idx < 2 * 2 * 1024; idx += G * 512) { const int c = idx & 1023, dir = (idx >> 10) & 1, j = idx >> 11, l = 2 * j + 1;
            const float* lbp = ap->in[12] + (size_t)dir * DEPTH * 1024 + c; float v[4], mx = -1e30f;
#pragma unroll
            for (int i = 0; i < 4; ++i) { v[i] = lbp[i * 1024]; mx = fmaxf(mx, v[i]); }
            float den = 0.f, num = 0.f;
#pragma unroll
            for (int i = 0; i < 4; ++i) { const float e = __expf(v[i] - mx); den += e; if (i >= 1 && i <= l) num += e; }
            LB[idx] = num / den; } }
        { const float* x_in = ap->in[0]; float* X = ap->out; bf16_t* HN = (bf16_t*)(ws + WS_HN); const float* gains = ap->in[2];
          for (int m = gw; m < MT; m += NGW) row_init(x_in + (size_t)m * DM, X + (size_t)m * DM, HN + (size_t)m * DM, gains, lane); }
    }
    gsync_cg();

    for (int ph = 0; ph < 46; ++ph) {
        const int l = ph >= 35 ? 3 : (ph >= 23 ? 2 : (ph >= 12 ? 1 : 0)), s = ph - (l == 3 ? 35 : (l == 2 ? 23 : (l == 1 ? 12 : 0)));
        const bool hg = l & 1; const int j = l >> 1;
        const int op = hg ? OPS_H[s] : OPS_M[s];
        ArgsP ap = get_args(); unsigned char* ws = ap->ws; unsigned char* R = ws + WS_R;
        int G_ = gridDim.x, bx_ = blockIdx.x; asm volatile("" : "+s"(G_), "+s"(bx_));
        switch (op) {
        case OP_SW0: case OP_SW1: {
            const int half = op == OP_SW1;
            pg8::Gemm gm{(const bf16_t*)(ws + WS_HN), (const bf16_t*)(ws + WS_WFFI) + (size_t)(l * 2 + half) * (2 * DFF) * 1024, MT, 2 * DFF, 1024};
            pg8::StaticOrder S; S.init(MT, 2 * DFF, G_, bx_); EpiSwiglu E{(bf16_t*)(R + R_ACT)};
#ifndef NO_SW
            pg8::gemm_phase<EpiSwiglu, pg8::StaticOrder, true, true>(lds, gm, S, E);
#endif
        } break;
        case OP_MIN: {
            pg8::Gemm gm{(const bf16_t*)(ws + WS_HN), (const bf16_t*)(ws + WS_WMIN) + (size_t)j * 512 * 1024, MT, 512, 1024}; EpiF32 E{(float*)(R + R_C), 512};
            pg8::StaticOrder S; S.init(MT, 512, G_, bx_);
#ifndef NO_F32
            pg8::gemm_phase<EpiF32, pg8::StaticOrder, true, true>(lds, gm, S, E);
#endif
        } break;
        case OP_FO0: case OP_FO1: case OP_MWO: case OP_HWO: {
            pg8::Gemm gm; EpiB16 E{(bf16_t*)(ws + WS_YB), 1024};
            if (op == OP_FO0 || op == OP_FO1) { const int half = op == OP_FO1; gm = pg8::Gemm{(const bf16_t*)(R + R_ACT), (const bf16_t*)(ws + WS_WFFO) + (size_t)(l * 2 + half) * 1024 * DFF, MT, 1024, DFF}; }
            else if (op == OP_MWO) { gm = pg8::Gemm{(const bf16_t*)(R + R_O), (const bf16_t*)(ws + WS_WMO) + (size_t)j * 1024 * 1024, MT, 1024, 1024}; }
            else { gm = pg8::Gemm{(const bf16_t*)(R + R_HO), (const bf16_t*)(ws + WS_WHO) + (size_t)j * 1024 * 1024, MT, 1024, 1024}; }
            pg8::StaticOrder S; S.init(MT, 1024, G_, bx_);
            pg8::gemm_phase<EpiB16, pg8::StaticOrder, true, true>(lds, gm, S, E);
        } break;
        case OP_RPA: case OP_RPB: case OP_RPC: {
            const float* gains = ap->in[2]; const float* g = gains + (size_t)l * 6 * DM; const bf16_t* Y = (const bf16_t*)(ws + WS_YB); float* X = ap->out; bf16_t* HN = (bf16_t*)(ws + WS_HN);
            const int k = op == OP_RPA ? 1 : (op == OP_RPB ? 3 : 5); const float scale = op == OP_RPB ? 1.0f : 0.5f;
            const bool last = (op == OP_RPC) && (l == DEPTH - 1);
            const float* gn = op == OP_RPC ? gains + (size_t)(l + 1) * 6 * DM : g + (size_t)(k + 1) * DM;
            const int lane = LANE_;
            for (int m = bx_ * 8 + __builtin_amdgcn_readfirstlane(otid_() >> 6); m < MT; m += G_ * 8) row_post(Y + (size_t)m * DM, X + (size_t)m * DM, last ? (bf16_t*)nullptr : HN + (size_t)m * DM, scale, g + (size_t)k * DM, last ? g : gn, lane);
        } break;
        case OP_RMLA: {
            const float* qn = ap->in[6] + (size_t)j * QLR; const float* kvn = ap->in[7] + (size_t)j * KVLR; const float* COS = (const float*)(ws + WS_COS); const float* SIN = (const float*)(ws + WS_SIN);
            const int lane = LANE_;
            for (int m = bx_ * 8 + __builtin_amdgcn_readfirstlane(otid_() >> 6); m < MT; m += G_ * 8) row_mla((const float*)(R + R_C) + (size_t)m * 512, (bf16_t*)(R + R_CQ) + (size_t)m * 256, (bf16_t*)(R + R_CKV) + (size_t)m * 128, (bf16_t*)(R + R_KR) + (size_t)m * 64,
                                                         qn, kvn, COS + (size_t)m * 32, SIN + (size_t)m * 32, lane);
        } break;
        case OP_QKV: {
            { int Kq = 256; asm volatile("" : "+s"(Kq)); pg8::Gemm gm{(const bf16_t*)(R + R_CQ), (const bf16_t*)(ws + WS_WUQ) + (size_t)j * 1536 * 256, MT, 1536, Kq};
              pg8::StaticOrder S; S.init(MT, 1536, G_, bx_); EpiQ E{(bf16_t*)(R + R_QB), (const float*)(ws + WS_COS), (const float*)(ws + WS_SIN)};
#ifndef NO_Q
              pg8::gemm_phase<EpiQ, pg8::StaticOrder, true, true>(lds, gm, S, E);
#endif
            }
            __syncthreads();
            { int Kq = 128; asm volatile("" : "+s"(Kq)); pg8::Gemm gm{(const bf16_t*)(R + R_CKV), (const bf16_t*)(ws + WS_WUKV) + (size_t)j * 2048 * 128, MT, 2048, Kq};
              pg8::StaticOrder S; S.init(MT, 2048, G_, bx_); EpiKV E{(bf16_t*)(R + R_KN), (bf16_t*)(R + R_VB)};
#ifndef NO_KV
              pg8::gemm_phase<EpiKV, pg8::StaticOrder, true, true>(lds, gm, S, E);
#endif
            }
        } break;
        case OP_ATTN: {
#ifndef NO_ATTN
            const int G = G_, bx = bx_;

            const int vcu = (G % 8 == 0) ? (bx % 8) * (G / 8) + bx / 8 : bx;
#ifdef REP_ATTN
            for (int rep_ = 0; rep_ < 2; ++rep_)
#endif
            for (int uid = vcu; uid < BATCH * NH * (SEQ / 256); uid += G) {
                const int bh = uid >> 5, qb = uid & 31, b = bh >> 3, h = bh & 7;
                const size_t row0 = (size_t)b * SEQ;
                att::attn_unit((const att::bf16*)(R + R_QB) + (row0 + qb * 256) * 1536 + h * QKD, (const att::bf16*)(R + R_KN) + row0 * 1024 + h * 128,
                               (const att::bf16*)(R + R_KR) + row0 * 64, (const att::bf16*)(R + R_VB) + row0 * 1024 + h * 128,
                               (att::bf16*)(R + R_O) + (row0 + qb * 256) * 1024 + h * 128, SEQ, (char*)lds_raw);
            }
#endif
        } break;
        case OP_HIN: {
            pg8::Gemm gm{(const bf16_t*)(ws + WS_HN), (const bf16_t*)(ws + WS_WHIN) + (size_t)j * 5120 * 1024, MT, 5120, 1024};
            pg8::StaticOrder S; S.init(MT, 5120, G_, bx_);
            EpiHgrn E{(bf16_t*)(R + R_QH), (bf16_t*)(R + R_VH), (bf16_t*)(R + R_GH), (unsigned short*)(R + R_KF), (const float*)(ws + WS_LB) + (size_t)j * 2048};
#ifndef NO_HG
            pg8::gemm_phase<EpiHgrn, pg8::StaticOrder, true, true>(lds, gm, S, E);
#endif
        } break;
        case OP_SCAN: {
#ifndef NO_SCAN
#ifdef REP_SCAN
            scan_phase(lds, (const bf16_t*)(R + R_QH), (const bf16_t*)(R + R_VH), (const unsigned short*)(R + R_KF), (bf16_t*)(ws + WS_Y), G_, bx_); __syncthreads();
#endif
#ifdef SCAN_VALU
            scan_phase(lds, (const bf16_t*)(R + R_QH), (const bf16_t*)(R + R_VH), (const unsigned short*)(R + R_KF), (bf16_t*)(ws + WS_Y), G_, bx_);
#else
            scan_phase_mfma(lds, (const bf16_t*)(R + R_QH), (const bf16_t*)(R + R_VH), (const unsigned short*)(R + R_KF), (bf16_t*)(ws + WS_Y), G_, bx_);
#endif
#endif
        } break;
        case OP_RHG: {
            const float* on = ap->in[13] + (size_t)j * DM; const bf16_t* Y = (const bf16_t*)(ws + WS_Y);
            const int lane = LANE_;
            for (int m = bx_ * 8 + __builtin_amdgcn_readfirstlane(otid_() >> 6); m < MT; m += G_ * 8) row_hgrn(Y + (size_t)m * DM, (const bf16_t*)(R + R_GH) + (size_t)m * DM, (bf16_t*)(R + R_HO) + (size_t)m * DM, on, lane);
        } break;
        default: break;
        }
        if (ph != 45) gsync(lds);
#ifdef REP_SYNC
        gsync(lds);
#endif
#ifdef DBG_CHECKS
        { ArgsP ap2 = get_args(); dbg_after(l, op, ap2, ap2->ws, ap2->ws + WS_R, lds); gsync(lds); }
#endif
    }
#ifdef DBG_CHECKS
    gsync(lds);
    if (blockIdx.x == 0 && threadIdx.x == 0) { ArgsP ap = get_args(); unsigned* DBG = (unsigned*)ap->ws; const float mx = __uint_as_float(atomicAdd(DBG + 20, 0u)), mean = atomicAdd((float*)(DBG + 21), 0.f); ap->out[1024 * 16] += 1e6f * mx; ap->out[1024 * 16 + 1] += 1e4f * mean; }
#endif
}

extern "C" void kernel_launch(void* const* d_in, const int* in_sizes, int n_in, void* d_out, int out_size, void* d_ws, size_t ws_size, hipStream_t stream) {
    static int grid = 0;
    if (grid == 0) {
        if (n_in != 15 || out_size != MT * DM || ws_size < WS_END) { fprintf(stderr, "kernel_launch: unexpected shapes: n_in %d out %d ws %zu (need %zu)\n", n_in, out_size, ws_size, (size_t)WS_END); grid = -1; return; }
        int dev = 0, cus = 0, per_cu = 0;
        (void)hipGetDevice(&dev); (void)hipDeviceGetAttribute(&cus, hipDeviceAttributeMultiprocessorCount, dev);
        if (hipFuncSetAttribute((const void*)mega_fwd, hipFuncAttributeMaxDynamicSharedMemorySize, LDS_BYTES) != hipSuccess) { fprintf(stderr, "kernel_launch: hipFuncSetAttribute failed\n"); grid = -1; return; }
        if (hipOccupancyMaxActiveBlocksPerMultiprocessor(&per_cu, (const void*)mega_fwd, 512, LDS_BYTES) != hipSuccess || per_cu < 1) { fprintf(stderr, "kernel_launch: occupancy query gave %d\n", per_cu); per_cu = 1; }
        (void)hipGetLastError();
        grid = cus * 1;
        fprintf(stderr, "kernel_launch: cus %d per_cu %d grid %d\n", cus, per_cu, grid);
    }
    if (grid < 0) return;
    if (hipMemsetAsync(d_ws, 0, 65536, stream) != hipSuccess) { fprintf(stderr, "kernel_launch: memset failed\n"); return; }
    Args a{};
    for (int i = 0; i < 15; ++i) a.in[i] = (const float*)d_in[i];
    a.out = (float*)d_out; a.ws = (unsigned char*)d_ws;
    void* args[] = {&a};
    hipError_t e = hipLaunchCooperativeKernel((const void*)mega_fwd, dim3(grid), dim3(512), args, LDS_BYTES, stream);
    if (e != hipSuccess) fprintf(stderr, "cooperative launch failed: %s (grid %d)\n", hipGetErrorString(e), grid);
}
```

```cpp
#include <hip/hip_runtime.h>
#include <hip/hip_cooperative_groups.h>
#include <hip/hip_bf16.h>
#include <hip/hip_fp16.h>
#include <cstdio>
#include <cstdint>
#include <cmath>
namespace cg = cooperative_groups;
namespace pg8 {
#define PG8_LAS __attribute__((address_space(3)))
typedef unsigned short bf16_t;
typedef short bf16x8 __attribute__((ext_vector_type(8)));
typedef float f32x4 __attribute__((ext_vector_type(4)));
typedef unsigned u32x4 __attribute__((ext_vector_type(4)));
constexpr int BM = 256, BK = 64, HALF = 128, HTB = HALF * BK * 2  , STAGE_BYTES = 8 * HTB, NXCD = 8, WGM = 8;

__host__ __device__ __forceinline__ int lds_byte(int r, int c) { const int st = (r >> 4) * 2 + (c >> 5), rr = r & 15, cc = c & 31, ob = rr * 64 + cc * 2; return st * 1024 + (ob ^ (((ob >> 9) & 1) << 5)); }
__host__ __device__ __forceinline__ void stage_rc(int b, int& R, int& C) { const int st = b / 1024, sb = b % 1024, swz = sb ^ (((sb >> 9) & 1) << 5); R = (st >> 1) * 16 + swz / 64; C = (st & 1) * 32 + (swz % 64) / 2; }
__host__ __device__ __forceinline__ int perm32(int rho) { const int n = rho >> 4, i = rho & 15; return 8 * (i >> 2) + 4 * n + (i & 3); }

struct Unit { int pm, pn; };
struct Gemm { const bf16_t* A; const bf16_t* Bt; int M, N, K; };

struct StaticOrder {
    int nM, nN, nwg, G, c;
    __host__ __device__ void init(int M, int N, int G_, int c_) { nM = M / BM; nN = N / BM; nwg = nM * nN; G = G_; c = c_; }
    __host__ __device__ bool next(int i, Unit& u) const {
        const long L = (long)i * G + c; if (L >= nwg) return false;
        int wgid = (int)L; { const int q = nwg / NXCD, r = nwg % NXCD, xcd = wgid % NXCD, off = wgid / NXCD; wgid = (xcd < r ? xcd * (q + 1) : r * (q + 1) + (xcd - r) * q) + off; }
        const int nig = WGM * nN, gid = wgid / nig, fm = gid * WGM, gsz = (nM - fm) < WGM ? (nM - fm) : WGM;
        u.pm = fm + ((wgid % nig) % gsz); u.pn = (wgid % nig) / gsz; return true;
    }
    __device__ __forceinline__ void a_ready(const Unit&) const {}
    __device__ __forceinline__ void done(const Unit&) const {}
};

__device__ __forceinline__ unsigned cvt_pk_bf16(float lo, float hi) { unsigned r; asm volatile("v_cvt_pk_bf16_f32 %0, %1, %2" : "=v"(r) : "v"(lo), "v"(hi)); return r; }
template <class Epi, class Sched, bool ALIGN_EPI = false, bool SP2 = false>
__device__ __forceinline__ void gemm_phase(PG8_LAS unsigned char* lds, const Gemm g, const Sched& S, const Epi& E) {
    int tid = threadIdx.x; asm volatile("" : "+v"(tid)); const int wid = __builtin_amdgcn_readfirstlane(tid >> 6), lane = tid & 63, wr = wid >> 2, wc = wid & 3, fr = lane & 15, fq = lane >> 4;
    const int K = g.K, nt = K / BK;
    unsigned voffA[2], voffB[2];
#pragma unroll
    for (int i = 0; i < 2; ++i) { int R, C; stage_rc(tid * 16 + i * 8192, R, C); const int Rb = Epi::PERM ? ((R & ~31) + perm32(R & 31)) : R;
        voffA[i] = (unsigned)(R * K + C) * 2u; voffB[i] = (unsigned)(Rb * K + C) * 2u; }
    const size_t kstep = (size_t)(BK * 2);
    const size_t hstep = (size_t)HALF * K * 2;
    const size_t tstep = 2 * hstep;
    const unsigned ldsw = (unsigned)wid * 1024u;
    const int aoff = lds_byte(wr * 64 + fr, fq * 8), boff = lds_byte(wc * 32 + fr, fq * 8);
#define PG8_SA(b, h) (((b) * 2 + (h)) * HTB)
#define PG8_SB(b, h) ((4 + (b) * 2 + (h)) * HTB)
#define PG8_STAGE(bufoff, gbase, voff) do { _Pragma("unroll") for (int _i = 0; _i < 2; ++_i) \
        __builtin_amdgcn_global_load_lds((const unsigned*)((const char*)(gbase) + (voff)[_i]), (PG8_LAS unsigned*)(lds + (bufoff) + ldsw + _i * 8192), 16, 0, 0); } while (0)
#define PG8_LDA(dst, b, h) do { _Pragma("unroll") for (int m = 0; m < 4; ++m) _Pragma("unroll") for (int k = 0; k < 2; ++k) dst[m][k] = *(const PG8_LAS bf16x8*)(lds + PG8_SA(b, h) + aoff + m * 2048 + k * 1024); } while (0)
#define PG8_LDB(dst, b, h) do { _Pragma("unroll") for (int n = 0; n < 2; ++n) _Pragma("unroll") for (int k = 0; k < 2; ++k) dst[n][k] = *(const PG8_LAS bf16x8*)(lds + PG8_SB(b, h) + boff + n * 2048 + k * 1024); } while (0)
#define PG8_MMA(ai, bj, At, Bt) do { __builtin_amdgcn_s_setprio(1); _Pragma("unroll") for (int m = 0; m < 4; ++m) _Pragma("unroll") for (int n = 0; n < 2; ++n) _Pragma("unroll") for (int k = 0; k < 2; ++k) \
        acc[ai][bj][m][n] = __builtin_amdgcn_mfma_f32_16x16x32_bf16(Bt[n][k], At[m][k], acc[ai][bj][m][n], 0, 0, 0); __builtin_amdgcn_s_setprio(0); } while (0)
#define PG8_WAIT_V(n) asm volatile("s_waitcnt vmcnt(" #n ")" ::: "memory")
#define PG8_WAIT_L(n) asm volatile("s_waitcnt lgkmcnt(" #n ")" ::: "memory")
#define PG8_BAR __builtin_amdgcn_s_barrier()
#define PG8_SCHED __builtin_amdgcn_sched_barrier(0)
    Unit cur, nxt; int ui = 0;
    if (!S.next(0, cur)) return;
    f32x4 acc[2][2][4][2];
#pragma unroll
    for (int a = 0; a < 2; ++a)
#pragma unroll
        for (int b = 0; b < 2; ++b)
#pragma unroll
            for (int m = 0; m < 4; ++m)
#pragma unroll
                for (int n = 0; n < 2; ++n) acc[a][b][m][n] = (f32x4){0.f, 0.f, 0.f, 0.f};
    bf16x8 At[4][2], B0[2][2], B1[2][2];
    const char* cA = (const char*)g.A + (size_t)cur.pm * tstep; const char* cB = (const char*)g.Bt + (size_t)cur.pn * tstep;
    S.a_ready(cur);
    if constexpr (SP2) {
        PG8_STAGE(PG8_SB(0, 0), cB, voffB); PG8_STAGE(PG8_SB(0, 1), cB + hstep, voffB); PG8_STAGE(PG8_SA(0, 0), cA, voffA); PG8_STAGE(PG8_SA(0, 1), cA + hstep, voffA);
        if (wr == 1) PG8_BAR;
        PG8_WAIT_V(2); PG8_BAR;
        PG8_STAGE(PG8_SB(1, 0), cB + kstep, voffB); PG8_STAGE(PG8_SA(1, 0), cA + kstep, voffA); PG8_STAGE(PG8_SB(1, 1), cB + hstep + kstep, voffB);
        PG8_WAIT_V(6); PG8_BAR;
    } else {
        PG8_STAGE(PG8_SB(0, 0), cB, voffB); PG8_STAGE(PG8_SA(0, 0), cA, voffA); PG8_STAGE(PG8_SB(0, 1), cB + hstep, voffB); PG8_STAGE(PG8_SA(0, 1), cA + hstep, voffA);
        if (wr == 1) PG8_BAR;
        PG8_WAIT_V(4); PG8_BAR;
        PG8_STAGE(PG8_SB(1, 0), cB + kstep, voffB); PG8_STAGE(PG8_SA(1, 0), cA + kstep, voffA); PG8_STAGE(PG8_SB(1, 1), cB + hstep + kstep, voffB);
        PG8_WAIT_V(6); PG8_BAR;
    }
    for (;;) {
        const bool has_next = S.next(ui + 1, nxt);
        const char* nA = has_next ? (const char*)g.A + (size_t)nxt.pm * tstep : cA; const char* nB = has_next ? (const char*)g.Bt + (size_t)nxt.pn * tstep : cB;
        for (int t = 0; t < nt; t += 2) {
            const bool last = (t == nt - 2);
            const char* a1 = cA + (size_t)(t + 1) * kstep;
            const char* a2 = last ? nA : cA + (size_t)(t + 2) * kstep; const char* b2 = last ? nB : cB + (size_t)(t + 2) * kstep;
            const char* a3 = a2 + kstep; const char* b3 = b2 + kstep;
            if (last && has_next) S.a_ready(nxt);
            if constexpr (SP2) {
            PG8_LDB(B0, 0, 0); PG8_LDB(B1, 0, 1); PG8_SCHED; PG8_LDA(At, 0, 0); PG8_STAGE(PG8_SA(1, 1), a1 + hstep, voffA);
            PG8_WAIT_V(8); PG8_WAIT_L(0); PG8_BAR; PG8_MMA(0, 0, At, B0); PG8_MMA(0, 1, At, B1); PG8_BAR; PG8_SCHED;
            PG8_LDA(At, 0, 1); PG8_STAGE(PG8_SB(0, 0), b2, voffB); PG8_STAGE(PG8_SB(0, 1), b2 + hstep, voffB); PG8_STAGE(PG8_SA(0, 0), a2, voffA);
            PG8_WAIT_V(8); PG8_WAIT_L(0); PG8_BAR; PG8_MMA(1, 0, At, B0); PG8_MMA(1, 1, At, B1); PG8_BAR; PG8_SCHED;
            PG8_LDB(B0, 1, 0); PG8_LDB(B1, 1, 1); PG8_SCHED; PG8_LDA(At, 1, 0); PG8_STAGE(PG8_SA(0, 1), a2 + hstep, voffA);
            PG8_WAIT_V(8); PG8_WAIT_L(0); PG8_BAR; PG8_MMA(0, 0, At, B0); PG8_MMA(0, 1, At, B1); PG8_BAR; PG8_SCHED;
            PG8_LDA(At, 1, 1); PG8_STAGE(PG8_SB(1, 0), b3, voffB); PG8_STAGE(PG8_SB(1, 1), b3 + hstep, voffB); PG8_STAGE(PG8_SA(1, 0), a3, voffA);
            PG8_WAIT_V(8); PG8_WAIT_L(0); PG8_BAR; PG8_MMA(1, 0, At, B0); PG8_MMA(1, 1, At, B1); PG8_BAR; PG8_SCHED;
            } else {
            PG8_LDB(B0, 0, 0); PG8_SCHED; PG8_LDA(At, 0, 0); PG8_STAGE(PG8_SA(1, 1), a1 + hstep, voffA);
            PG8_WAIT_L(8); PG8_BAR; PG8_WAIT_L(0); PG8_MMA(0, 0, At, B0); PG8_BAR; PG8_SCHED;
            PG8_LDB(B1, 0, 1); PG8_STAGE(PG8_SB(0, 0), b2, voffB);
            PG8_BAR; PG8_WAIT_L(0); PG8_MMA(0, 1, At, B1); PG8_BAR;
            PG8_LDA(At, 0, 1); PG8_STAGE(PG8_SA(0, 0), a2, voffA);
            PG8_BAR; PG8_WAIT_L(0); PG8_MMA(1, 0, At, B0); PG8_BAR; PG8_SCHED;
            PG8_STAGE(PG8_SB(0, 1), b2 + hstep, voffB);
            PG8_WAIT_V(6); PG8_BAR; PG8_MMA(1, 1, At, B1); PG8_BAR;
            PG8_LDB(B0, 1, 0); PG8_SCHED; PG8_LDA(At, 1, 0); PG8_STAGE(PG8_SA(0, 1), a2 + hstep, voffA);
            PG8_WAIT_L(8); PG8_BAR; PG8_WAIT_L(0); PG8_MMA(0, 0, At, B0); PG8_BAR; PG8_SCHED;
            PG8_LDB(B1, 1, 1); PG8_STAGE(PG8_SB(1, 0), b3, voffB);
            PG8_BAR; PG8_WAIT_L(0); PG8_MMA(0, 1, At, B1); PG8_BAR;
            PG8_LDA(At, 1, 1); PG8_STAGE(PG8_SA(1, 0), a3, voffA);
            PG8_BAR; PG8_WAIT_L(0); PG8_MMA(1, 0, At, B0); PG8_BAR; PG8_SCHED;
            PG8_STAGE(PG8_SB(1, 1), b3 + hstep, voffB);
            PG8_WAIT_V(6); PG8_BAR; PG8_MMA(1, 1, At, B1); PG8_BAR;
            }
        }
        if constexpr (ALIGN_EPI) { if (wr == 0) PG8_BAR; }
        if constexpr (!Epi::AFTER_DRAIN) { E(acc, cur, wr, wc, fr, fq); S.done(cur); }
        if (!has_next) break;
#pragma unroll
        for (int a = 0; a < 2; ++a)
#pragma unroll
            for (int b = 0; b < 2; ++b)
#pragma unroll
                for (int m = 0; m < 4; ++m)
#pragma unroll
                    for (int n = 0; n < 2; ++n) acc[a][b][m][n] = (f32x4){0.f, 0.f, 0.f, 0.f};
        cur = nxt; cA = nA; cB = nB; ++ui;
        if constexpr (ALIGN_EPI) { if (wr == 1) PG8_BAR; }
    }
    PG8_WAIT_V(0);
    if constexpr (!ALIGN_EPI) { if (wr == 0) PG8_BAR; }
    PG8_BAR;
    if constexpr (Epi::AFTER_DRAIN) { E.fused(acc, cur, wr, wc, fr, fq, lds, wid, lane); S.done(cur); }
#undef PG8_SA
#undef PG8_SB
#undef PG8_STAGE
#undef PG8_LDA
#undef PG8_LDB
#undef PG8_MMA
#undef PG8_WAIT_V
#undef PG8_WAIT_L
#undef PG8_BAR
#undef PG8_SCHED
}
}
#ifndef ATT_SDEPTH
#define ATT_SDEPTH 1
#endif
namespace att {
using bf16 = __hip_bfloat16;
constexpr int NW = 8, QBLK = 32, KVBLK = 64;
constexpr float SCALE = 0.07216878364870322f;
constexpr float THR = 8.f;
__device__ __forceinline__ int otid() { int t = threadIdx.x; asm volatile("" : "+v"(t)); return t; }
using bf16x8 = __attribute__((ext_vector_type(8))) short;
using s16x4  = __attribute__((ext_vector_type(4))) short;
using f32x16 = __attribute__((ext_vector_type(16))) float;
using f32x8  = __attribute__((ext_vector_type(8))) float;
using u32x4  = __attribute__((ext_vector_type(4))) unsigned;
#define KSWZ(row, colB) ((row) * 256 + ((colB) ^ (((row) & 7) << 4)))
#define SBAR() __builtin_amdgcn_sched_barrier(0)
__device__ __forceinline__ int crow(int r, int hi) { return (r & 3) + 8 * (r >> 2) + 4 * hi; }
__device__ __forceinline__ unsigned cvtpk(float lo, float hi) {
  unsigned r; asm volatile("v_cvt_pk_bf16_f32 %0, %1, %2" : "=v"(r) : "v"(lo), "v"(hi)); return r;
}
template <typename TIn> struct Stage;
template <> struct Stage<bf16>  { using T = bf16x8;
  __device__ static __forceinline__ T ld8(const bf16* p) { return *reinterpret_cast<const bf16x8*>(p); }
  __device__ static __forceinline__ bf16x8 tobf(T x) { return x; } };
template <> struct Stage<float> { using T = f32x8;
  __device__ static __forceinline__ T ld8(const float* p) { return *reinterpret_cast<const f32x8*>(p); }
  __device__ static __forceinline__ bf16x8 tobf(T x) {
    u32x4 w = {cvtpk(x[0], x[1]), cvtpk(x[2], x[3]), cvtpk(x[4], x[5]), cvtpk(x[6], x[7])}; return *reinterpret_cast<bf16x8*>(&w); } };

__device__ __forceinline__ void partialSM(f32x16& p0, f32x16& p1, float& m_reg, float& mn, float& alpha) {
  constexpr float C = SCALE * 1.4426950408889634f;
  float pmax = p0[0]; for (int r = 1; r < 16; ++r) pmax = fmaxf(pmax, p0[r]); for (int r = 0; r < 16; ++r) pmax = fmaxf(pmax, p1[r]);
  { auto rr = __builtin_amdgcn_permlane32_swap(__float_as_uint(pmax), __float_as_uint(pmax), false, false);
    pmax = fmaxf(__uint_as_float(rr[0]), __uint_as_float(rr[1])); }
  if (__builtin_expect(__all(pmax - m_reg <= THR / SCALE), 1)) { mn = m_reg; alpha = 1.f; }
  else { mn = fmaxf(m_reg, pmax); alpha = __builtin_amdgcn_exp2f((m_reg - mn) * C); m_reg = mn; }
  float mnC = -mn * C;
  for (int r = 0; r < 16; ++r) p0[r] = fmaf(p0[r], C, mnC); for (int r = 0; r < 16; ++r) p1[r] = fmaf(p1[r], C, mnC);
  for (int r = 0; r < 16; ++r) p0[r] = __builtin_amdgcn_exp2f(p0[r]);
}
__device__ __forceinline__ void finishSM(f32x16& p0, f32x16& p1, float alpha, float& l_reg, bf16x8& pa0, bf16x8& pa1, bf16x8& pa2, bf16x8& pa3) {
  for (int r = 0; r < 16; ++r) p1[r] = __builtin_amdgcn_exp2f(p1[r]);
  float ps = 0; for (int r = 0; r < 16; ++r) ps += p0[r]; for (int r = 0; r < 16; ++r) ps += p1[r];
  { auto rr = __builtin_amdgcn_permlane32_swap(__float_as_uint(ps), __float_as_uint(ps), false, false);
    ps = __uint_as_float(rr[0]) + __uint_as_float(rr[1]); }
  l_reg = l_reg * alpha + ps;
#define PK4(P, BASE, OUT) do { unsigned a0 = cvtpk(P[BASE + 0], P[BASE + 1]), a1 = cvtpk(P[BASE + 2], P[BASE + 3]);   \
    unsigned b0 = cvtpk(P[BASE + 4], P[BASE + 5]), b1 = cvtpk(P[BASE + 6], P[BASE + 7]);                              \
    auto r0 = __builtin_amdgcn_permlane32_swap(a0, b0, false, false); auto r1 = __builtin_amdgcn_permlane32_swap(a1, b1, false, false); \
    u32x4 w = {r0[0], r1[0], r0[1], r1[1]}; OUT = *reinterpret_cast<bf16x8*>(&w); } while (0)
  PK4(p0, 0, pa0); PK4(p0, 8, pa1); PK4(p1, 0, pa2); PK4(p1, 8, pa3);
#undef PK4
}
#define KSWZ2(row, colB) ((row) * 128 + ((colB) ^ (((row) & 7) << 4)))
__device__ __forceinline__ void qkt(f32x16& p0, f32x16& p1, const bf16* Ks, const bf16* KRs, const bf16x8* qr, const bf16x8* qrl, int r32, int hi) {
  p0 = f32x16{}; p1 = f32x16{};
#pragma unroll
  for (int d0 = 0; d0 < 8; ++d0) { int cb = (d0 * 16 + hi * 8) * 2;
    bf16x8 b0 = *reinterpret_cast<const bf16x8*>((const char*)Ks + KSWZ(r32, cb));
    bf16x8 b1 = *reinterpret_cast<const bf16x8*>((const char*)Ks + KSWZ(32 + r32, cb));
    p0 = __builtin_amdgcn_mfma_f32_32x32x16_bf16(b0, qr[d0], p0, 0, 0, 0);
    p1 = __builtin_amdgcn_mfma_f32_32x32x16_bf16(b1, qr[d0], p1, 0, 0, 0); }
#pragma unroll
  for (int d0 = 0; d0 < 4; ++d0) { int cb = (d0 * 16 + hi * 8) * 2;
    bf16x8 b0 = *reinterpret_cast<const bf16x8*>((const char*)KRs + KSWZ2(r32, cb));
    bf16x8 b1 = *reinterpret_cast<const bf16x8*>((const char*)KRs + KSWZ2(32 + r32, cb));
    const bf16x8 qv = qrl[d0 * 64];
    p0 = __builtin_amdgcn_mfma_f32_32x32x16_bf16(b0, qv, p0, 0, 0, 0);
    p1 = __builtin_amdgcn_mfma_f32_32x32x16_bf16(b1, qv, p1, 0, 0, 0); }
}
__device__ __forceinline__ int v_st(int k, int c) { const int kk = (k & ~0xC) | ((k & 4) << 1) | ((k & 8) >> 1); return ((kk >> 3) * 4 + (c >> 5)) * 512 + ((kk & 7) * 32 + (c & 31)) * 2; }
__device__ __forceinline__ int v_rd_base(int lane) { return ((lane & 3) << 3) | (((lane >> 2) & 3) << 6) | (((lane >> 4) & 1) << 5) | (((lane >> 5) & 1) << 8); }
constexpr int v_rd_off(int d0, int ks, int half) { return d0 * 512 + ks * 4096 + half * 2048; }
template <int OFF> __device__ __forceinline__ s16x4 tr_read(int vb) {
  s16x4 r; asm volatile("ds_read_b64_tr_b16 %0, %1 offset:%2" : "=&v"(r) : "v"(vb), "i"(OFF) : "memory"); return r;
}
template <int D0> __device__ __forceinline__ void pv_one(f32x16& od, int vb, bf16x8 pa0, bf16x8 pa1, bf16x8 pa2, bf16x8 pa3) {
  const s16x4 l0 = tr_read<v_rd_off(D0, 0, 0)>(vb), h0 = tr_read<v_rd_off(D0, 0, 1)>(vb), l1 = tr_read<v_rd_off(D0, 1, 0)>(vb), h1 = tr_read<v_rd_off(D0, 1, 1)>(vb);
  const s16x4 l2 = tr_read<v_rd_off(D0, 2, 0)>(vb), h2 = tr_read<v_rd_off(D0, 2, 1)>(vb), l3 = tr_read<v_rd_off(D0, 3, 0)>(vb), h3 = tr_read<v_rd_off(D0, 3, 1)>(vb);
  asm volatile("s_waitcnt lgkmcnt(0)" ::: "memory"); SBAR();
#define PK(L, H) (bf16x8){L[0], L[1], L[2], L[3], H[0], H[1], H[2], H[3]}
  od = __builtin_amdgcn_mfma_f32_32x32x16_bf16(pa0, PK(l0, h0), od, 0, 0, 0);
  od = __builtin_amdgcn_mfma_f32_32x32x16_bf16(pa1, PK(l1, h1), od, 0, 0, 0);
  od = __builtin_amdgcn_mfma_f32_32x32x16_bf16(pa2, PK(l2, h2), od, 0, 0, 0);
  od = __builtin_amdgcn_mfma_f32_32x32x16_bf16(pa3, PK(l3, h3), od, 0, 0, 0);
#undef PK
}
__device__ __forceinline__ void pv_d0(f32x16* o, int vb, bf16x8 pa0, bf16x8 pa1, bf16x8 pa2, bf16x8 pa3) {
  pv_one<0>(o[0], vb, pa0, pa1, pa2, pa3); pv_one<1>(o[1], vb, pa0, pa1, pa2, pa3); pv_one<2>(o[2], vb, pa0, pa1, pa2, pa3); pv_one<3>(o[3], vb, pa0, pa1, pa2, pa3);
}
constexpr int LDQ = 1536, LDK = 1024, LDV = 1024, LDKR = 64, LDO = 1024, SDEPTH = ATT_SDEPTH;
constexpr int SHM_V = KVBLK * 128 * 2, SHM_K = KVBLK * 128 * 2, SHM_KR = KVBLK * 64 * 2;
constexpr int SHM_QR = NW * 4 * 64 * 16;
constexpr int SHM_ATTN = 2 * SHM_V + 2 * SHM_K + 2 * SHM_KR + NW * 64 * 4 + SHM_QR;
__device__ __forceinline__ void attn_unit(const bf16* __restrict__ Qb, const bf16* __restrict__ Kh, const bf16* __restrict__ KRh, const bf16* __restrict__ Vh,
                                          bf16* __restrict__ Ob, int seq, char* lds) {
  using St = Stage<bf16>;
  const int tid = otid(), wid = tid >> 6, lane = tid & 63, r32 = lane & 31, hi = lane >> 5;
  bf16* V_lds = (bf16*)lds; bf16* K_lds = (bf16*)(lds + 2 * SHM_V); bf16* KR_lds = (bf16*)(lds + 2 * SHM_V + 2 * SHM_K);
  float* ws = (float*)(lds + 2 * SHM_V + 2 * SHM_K + 2 * SHM_KR) + wid * 64; float* li_l = ws; float* al_l = ws + 32;
  float m_reg = -1e30f, l_reg = 0; f32x16 o[4] = {}; bf16x8 qr[8];
  bf16x8* qrl = (bf16x8*)(lds + 2 * SHM_V + 2 * SHM_K + 2 * SHM_KR + NW * 64 * 4) + wid * 256 + lane;
  const bf16* Qw = Qb + (long)(wid * QBLK + r32) * LDQ + hi * 8;
#pragma unroll
  for (int d0 = 0; d0 < 8; ++d0) qr[d0] = St::ld8(Qw + d0 * 16);
#pragma unroll
  for (int d0 = 0; d0 < 4; ++d0) qrl[d0 * 64] = St::ld8(Qw + 128 + d0 * 16);
  const int sr = tid >> 4, sc = (tid & 15) * 8, vst0 = v_st(sr, sc), vst1 = v_st(32 + sr, sc);
  const int krr = tid >> 3, krc = (tid & 7) * 8;
  const int vb0 = (int)(uintptr_t)V_lds + v_rd_base(lane);
  struct { bf16x8 vs0, vs1, ks0, ks1, kr; } sr_[SDEPTH];
#define SLOAD(i, k0) do { sr_[i].vs0 = St::ld8(&Vh[(long)((k0) + sr) * LDV + sc]); sr_[i].vs1 = St::ld8(&Vh[(long)((k0) + 32 + sr) * LDV + sc]); \
    sr_[i].ks0 = St::ld8(&Kh[(long)((k0) + sr) * LDK + sc]); sr_[i].ks1 = St::ld8(&Kh[(long)((k0) + 32 + sr) * LDK + sc]); \
    sr_[i].kr = St::ld8(&KRh[(long)((k0) + krr) * LDKR + krc]); } while (0)
#define SWRITE(b, i) do { *(bf16x8*)((char*)V_lds + (b) * SHM_V + vst0) = sr_[i].vs0;          \
    *(bf16x8*)((char*)V_lds + (b) * SHM_V + vst1) = sr_[i].vs1; int kc = sc * 2;               \
    *(bf16x8*)((char*)K_lds + (b) * SHM_K + KSWZ(sr, kc)) = sr_[i].ks0;                       \
    *(bf16x8*)((char*)K_lds + (b) * SHM_K + KSWZ(32 + sr, kc)) = sr_[i].ks1;                  \
    *(bf16x8*)((char*)KR_lds + (b) * SHM_KR + KSWZ2(krr, krc * 2)) = sr_[i].kr; } while (0)
#define SWAIT() do { if constexpr (SDEPTH == 2) asm volatile("s_waitcnt vmcnt(5)" ::: "memory"); else asm volatile("s_waitcnt vmcnt(0)" ::: "memory"); } while (0)
#define RESC(a) do { if (__any((a) < 1.f)) { if (hi == 0) al_l[r32] = (a); asm volatile("s_waitcnt lgkmcnt(0)" ::: "memory"); \
    _Pragma("unroll") for (int d = 0; d < 4; ++d) _Pragma("unroll") for (int r = 0; r < 16; ++r) o[d][r] *= al_l[crow(r, hi)]; } } while (0)
  f32x16 pA0, pA1, pB0, pB1; float mnA, mnB, alA, alB; bf16x8 pa0, pa1, pa2, pa3; const int NT = seq / KVBLK;
  constexpr int SE = 0, SO = SDEPTH - 1;
  SLOAD(SE, 0); asm volatile("s_waitcnt vmcnt(0)" ::: "memory"); SWRITE(0, SE); __syncthreads();
  qkt(pA0, pA1, K_lds, KR_lds, qr, qrl, r32, hi); partialSM(pA0, pA1, m_reg, mnA, alA);
  SLOAD(SO, KVBLK); if constexpr (SDEPTH == 2) { if (2 < NT) SLOAD(SE, 2 * KVBLK); }
  SWAIT(); SWRITE(1, SO); __syncthreads();
  for (int j = 1; j + 1 < NT; j += 2) {
    SBAR(); qkt(pB0, pB1, (bf16*)((char*)K_lds + SHM_K), (bf16*)((char*)KR_lds + SHM_KR), qr, qrl, r32, hi);
    finishSM(pA0, pA1, alA, l_reg, pa0, pa1, pa2, pa3); SBAR();
    SLOAD(SO, (j + SDEPTH) * KVBLK); SBAR();
    pv_d0(o, vb0, pa0, pa1, pa2, pa3); partialSM(pB0, pB1, m_reg, mnB, alB);
    __syncthreads(); SWAIT(); SWRITE(0, SE);
    RESC(alB); __syncthreads();
    SBAR(); qkt(pA0, pA1, K_lds, KR_lds, qr, qrl, r32, hi);
    finishSM(pB0, pB1, alB, l_reg, pa0, pa1, pa2, pa3); SBAR();
    if (SDEPTH == 1 || j + 3 < NT) SLOAD(SE, (j + 1 + SDEPTH) * KVBLK); SBAR();
    pv_d0(o, vb0 + (int)SHM_V, pa0, pa1, pa2, pa3); partialSM(pA0, pA1, m_reg, mnA, alA);
    __syncthreads(); SWAIT(); SWRITE(1, SO);
    RESC(alA); __syncthreads();
  }
  SBAR(); qkt(pB0, pB1, (bf16*)((char*)K_lds + SHM_K), (bf16*)((char*)KR_lds + SHM_KR), qr, qrl, r32, hi);
  finishSM(pA0, pA1, alA, l_reg, pa0, pa1, pa2, pa3); SBAR();
  pv_d0(o, vb0, pa0, pa1, pa2, pa3); partialSM(pB0, pB1, m_reg, mnB, alB);
  __syncthreads(); RESC(alB);
  finishSM(pB0, pB1, alB, l_reg, pa0, pa1, pa2, pa3); SBAR();
  pv_d0(o, vb0 + (int)SHM_V, pa0, pa1, pa2, pa3);
  if (hi == 0) li_l[r32] = l_reg; asm volatile("s_waitcnt lgkmcnt(0)" ::: "memory");
  float rli[16];
#pragma unroll
  for (int r = 0; r < 16; ++r) rli[r] = __builtin_amdgcn_rcpf(li_l[crow(r, hi)]);
  bf16* Ow = Ob + (long)(wid * QBLK) * LDO;
#pragma unroll
  for (int r = 0; r < 16; ++r) { int orow = crow(r, hi);
#pragma unroll
    for (int d0 = 0; d0 < 4; ++d0) Ow[(long)orow * LDO + d0 * 32 + r32] = __float2bfloat16(o[d0][r] * rli[r]); }
  __syncthreads();
#undef SLOAD
#undef SWRITE
#undef SWAIT
#undef RESC
}
#undef SBAR
}
constexpr int BATCH = 4, SEQ = 8192, DM = 1024, DEPTH = 4, DFF = 2816, MT = BATCH * SEQ;
constexpr int NH = 8, QLR = 256, KVLR = 128, QKD = 192;
constexpr float EPS = 1e-6f;
constexpr size_t MiB = 1u << 20;
constexpr size_t WS_WFFI = 1 * MiB;
constexpr size_t WS_WFFO = 89 * MiB;
constexpr size_t WS_WHIN = 133 * MiB;
constexpr size_t WS_WHO  = 153 * MiB;
constexpr size_t WS_WMIN = 157 * MiB;
constexpr size_t WS_WUQ  = 159 * MiB;
constexpr size_t WS_WUKV = 161 * MiB;
constexpr size_t WS_WMO  = 162 * MiB;
constexpr size_t WS_COS  = 166 * MiB;
constexpr size_t WS_SIN  = 170 * MiB;
constexpr size_t WS_LB   = 174 * MiB;
constexpr size_t WS_HN   = 176 * MiB;
constexpr size_t WS_Y    = 240 * MiB;
constexpr size_t WS_YB   = 304 * MiB;
constexpr size_t WS_R    = 368 * MiB;
constexpr size_t WS_END  = 704 * MiB;
constexpr size_t R_ACT = 0;
constexpr size_t R_C = 0, R_QB = 0, R_CQ = 96 * MiB, R_CKV = 112 * MiB, R_KR = 120 * MiB, R_KN = 124 * MiB, R_VB = 188 * MiB, R_O = 252 * MiB;
constexpr size_t R_QH = 0, R_VH = 64 * MiB, R_GH = 128 * MiB, R_KF = 192 * MiB, R_HO = 0;

constexpr int LDS_RING = 131072, LDS_BYTES = LDS_RING + 2048;
typedef unsigned short bf16_t;
typedef float f32x4 __attribute__((ext_vector_type(4)));
typedef float f32x2 __attribute__((ext_vector_type(2)));
typedef unsigned u32x4 __attribute__((ext_vector_type(4)));
typedef unsigned u32x2 __attribute__((ext_vector_type(2)));
typedef _Float16 h16x2 __attribute__((ext_vector_type(2)));
#define LAS __attribute__((address_space(3)))

__device__ __constant__ double ROPE_INVF[32] = {1.0, 0.7498942093324559, 0.5623413251903491, 0.4216965034285822, 0.31622776601683794, 0.23713737056616552, 0.1778279410038923, 0.1333521432163324, 0.1, 0.07498942093324558, 0.05623413251903491, 0.042169650342858224, 0.03162277660168379, 0.023713737056616554, 0.01778279410038923, 0.01333521432163324, 0.01, 0.007498942093324558, 0.005623413251903491, 0.004216965034285823, 0.0031622776601683794, 0.0023713737056616554, 0.0017782794100389228, 0.001333521432163324, 0.001, 0.0007498942093324559, 0.0005623413251903491, 0.00042169650342858224, 0.00031622776601683794, 0.00023713737056616554, 0.00017782794100389227, 0.0001333521432163324};

__device__ __forceinline__ unsigned pk2(float lo, float hi) { return pg8::cvt_pk_bf16(lo, hi); }
__device__ __forceinline__ float silu_f(float g) { return g * __builtin_amdgcn_rcpf(1.0f + __expf(-g)); }
__device__ __forceinline__ float wave_sum(float v) {
#pragma unroll
    for (int o = 1; o < 64; o <<= 1) v += __shfl_xor(v, o);
    return v;
}
__device__ __forceinline__ float half_sum(float v) {
#pragma unroll
    for (int o = 1; o < 32; o <<= 1) v += __shfl_xor(v, o);
    return v;
}

using pg8::Unit;
struct EpiSwiglu { static constexpr bool PERM = true, AFTER_DRAIN = false; bf16_t* O;
    __device__ __forceinline__ void operator()(const pg8::f32x4 (&acc)[2][2][4][2], const Unit& u, int wr, int wc, int fr, int fq) const {
        const int row0 = u.pm * 256 + wr * 64 + fr, col0 = u.pn * 128 + wc * 32 + 8 * fq;
#pragma unroll
        for (int ai = 0; ai < 2; ++ai)
#pragma unroll
            for (int m = 0; m < 4; ++m) { bf16_t* p = O + (size_t)(row0 + ai * 128 + m * 16) * DFF + col0;
                const pg8::f32x4 g0 = acc[ai][0][m][0], g1 = acc[ai][0][m][1], u0 = acc[ai][1][m][0], u1 = acc[ai][1][m][1];
                u32x4 w; w.x = pk2(silu_f(g0[0]) * u0[0], silu_f(g0[1]) * u0[1]); w.y = pk2(silu_f(g0[2]) * u0[2], silu_f(g0[3]) * u0[3]);
                w.z = pk2(silu_f(g1[0]) * u1[0], silu_f(g1[1]) * u1[1]); w.w = pk2(silu_f(g1[2]) * u1[2], silu_f(g1[3]) * u1[3]);
                *(u32x4*)p = w; }
    }
};
struct EpiF32 { static constexpr bool PERM = false, AFTER_DRAIN = false; float* O; int ldc;
    __device__ __forceinline__ void operator()(const pg8::f32x4 (&acc)[2][2][4][2], const Unit& u, int wr, int wc, int fr, int fq) const {
        const int row0 = u.pm * 256 + wr * 64 + fr, col0 = u.pn * 256 + wc * 32 + 4 * fq;
#pragma unroll
        for (int ai = 0; ai < 2; ++ai)
#pragma unroll
            for (int m = 0; m < 4; ++m) { float* p = O + (size_t)(row0 + ai * 128 + m * 16) * ldc + col0;
#pragma unroll
                for (int bj = 0; bj < 2; ++bj)
#pragma unroll
                    for (int n = 0; n < 2; ++n) *(pg8::f32x4*)(p + bj * 128 + n * 16) = acc[ai][bj][m][n]; }
    }
};
struct EpiB16 { static constexpr bool PERM = true, AFTER_DRAIN = false; bf16_t* O; int ldc;
    __device__ __forceinline__ void operator()(const pg8::f32x4 (&acc)[2][2][4][2], const Unit& u, int wr, int wc, int fr, int fq) const {
        const int row0 = u.pm * 256 + wr * 64 + fr, col0 = u.pn * 256 + wc * 32 + 8 * fq;
#pragma unroll
        for (int ai = 0; ai < 2; ++ai)
#pragma unroll
            for (int m = 0; m < 4; ++m) { bf16_t* p = O + (size_t)(row0 + ai * 128 + m * 16) * ldc + col0;
#pragma unroll
                for (int bj = 0; bj < 2; ++bj) { const pg8::f32x4 v0 = acc[ai][bj][m][0], v1 = acc[ai][bj][m][1];
                    u32x4 w; w.x = pk2(v0[0], v0[1]); w.y = pk2(v0[2], v0[3]); w.z = pk2(v1[0], v1[1]); w.w = pk2(v1[2], v1[3]);
                    *(u32x4*)(p + bj * 128) = w; } }
    }
};
struct EpiQ { static constexpr bool PERM = true, AFTER_DRAIN = false; bf16_t* O; const float* cs; const float* sn;
    __device__ __forceinline__ void operator()(const pg8::f32x4 (&acc)[2][2][4][2], const Unit& u, int wr, int wc, int fr, int fq) const {
        const int row0 = u.pm * 256 + wr * 64 + fr;
#pragma unroll
        for (int bj = 0; bj < 2; ++bj) { const int col0 = u.pn * 256 + bj * 128 + wc * 32 + 8 * fq, d = col0 % QKD; const bool rot = d >= 128; const int i0 = (d - 128) >> 1;
#pragma unroll
            for (int ai = 0; ai < 2; ++ai)
#pragma unroll
                for (int m = 0; m < 4; ++m) { const int row = row0 + ai * 128 + m * 16; pg8::f32x4 v0 = acc[ai][bj][m][0], v1 = acc[ai][bj][m][1];
                    if (rot) { const pg8::f32x4 c = *(const pg8::f32x4*)(cs + (size_t)row * 32 + i0), s = *(const pg8::f32x4*)(sn + (size_t)row * 32 + i0);
                        pg8::f32x4 a, b; a[0] = v0[0] * c[0] - v0[1] * s[0]; a[1] = v0[0] * s[0] + v0[1] * c[0]; a[2] = v0[2] * c[1] - v0[3] * s[1]; a[3] = v0[2] * s[1] + v0[3] * c[1];
                        b[0] = v1[0] * c[2] - v1[1] * s[2]; b[1] = v1[0] * s[2] + v1[1] * c[2]; b[2] = v1[2] * c[3] - v1[3] * s[3]; b[3] = v1[2] * s[3] + v1[3] * c[3]; v0 = a; v1 = b; }
                    u32x4 w; w.x = pk2(v0[0], v0[1]); w.y = pk2(v0[2], v0[3]); w.z = pk2(v1[0], v1[1]); w.w = pk2(v1[2], v1[3]);
                    *(u32x4*)(O + (size_t)row * 1536 + col0) = w; } }
    }
};
struct EpiKV { static constexpr bool PERM = true, AFTER_DRAIN = false; bf16_t* Kn; bf16_t* Vb;
    __device__ __forceinline__ void operator()(const pg8::f32x4 (&acc)[2][2][4][2], const Unit& u, int wr, int wc, int fr, int fq) const {
        const int row0 = u.pm * 256 + wr * 64 + fr, col0 = u.pn * 128 + wc * 32 + 8 * fq;
#pragma unroll
        for (int bj = 0; bj < 2; ++bj) { bf16_t* base = bj ? Vb : Kn;
#pragma unroll
            for (int ai = 0; ai < 2; ++ai)
#pragma unroll
                for (int m = 0; m < 4; ++m) { const pg8::f32x4 v0 = acc[ai][bj][m][0], v1 = acc[ai][bj][m][1];
                    u32x4 w; w.x = pk2(v0[0], v0[1]); w.y = pk2(v0[2], v0[3]); w.z = pk2(v1[0], v1[1]); w.w = pk2(v1[2], v1[3]);
                    *(u32x4*)(base + (size_t)(row0 + ai * 128 + m * 16) * 1024 + col0) = w; } }
    }
};
__device__ __forceinline__ unsigned pkh2(float a, float b) { const h16x2 h = {(_Float16)a, (_Float16)b}; return __builtin_bit_cast(unsigned, h); }
__device__ __forceinline__ float kgate(float om, float z) { return om * __builtin_amdgcn_rcpf(1.0f + __expf(z)); }
struct EpiHgrn { static constexpr bool PERM = true, AFTER_DRAIN = false; bf16_t* Qh; bf16_t* Vh; bf16_t* Gh; unsigned short* KF; const float* lb;
    __device__ __forceinline__ void operator()(const pg8::f32x4 (&acc)[2][2][4][2], const Unit& u, int wr, int wc, int fr, int fq) const {
        const int row0 = u.pm * 256 + wr * 64 + fr, seg = u.pn >> 2;
#pragma unroll
        for (int bj = 0; bj < 2; ++bj) { const int cc = (u.pn & 3) * 256 + bj * 128 + wc * 32 + 8 * fq;
            if (seg == 1 || seg == 2) {
                const pg8::f32x4 om0 = 1.0f - *(const pg8::f32x4*)(lb + (seg - 1) * 1024 + cc), om1 = 1.0f - *(const pg8::f32x4*)(lb + (seg - 1) * 1024 + cc + 4);
                unsigned short* base = KF + (size_t)(seg - 1) * MT * 1024;
#pragma unroll
                for (int ai = 0; ai < 2; ++ai)
#pragma unroll
                    for (int m = 0; m < 4; ++m) { const size_t off = (size_t)(row0 + ai * 128 + m * 16) * 1024 + cc; const pg8::f32x4 v0 = acc[ai][bj][m][0], v1 = acc[ai][bj][m][1];
                        u32x4 w; w.x = pkh2(kgate(om0[0], v0[0]), kgate(om0[1], v0[1])); w.y = pkh2(kgate(om0[2], v0[2]), kgate(om0[3], v0[3]));
                        w.z = pkh2(kgate(om1[0], v1[0]), kgate(om1[1], v1[1])); w.w = pkh2(kgate(om1[2], v1[2]), kgate(om1[3], v1[3]));
                        *(u32x4*)(base + off) = w; }
            } else if (seg == 3) {
#pragma unroll
                for (int ai = 0; ai < 2; ++ai)
#pragma unroll
                    for (int m = 0; m < 4; ++m) { const size_t off = (size_t)(row0 + ai * 128 + m * 16) * 1024 + cc; const pg8::f32x4 v0 = acc[ai][bj][m][0], v1 = acc[ai][bj][m][1];
                        u32x4 w; w.x = pk2(v0[0], v0[1]); w.y = pk2(v0[2], v0[3]); w.z = pk2(v1[0], v1[1]); w.w = pk2(v1[2], v1[3]);
                        *(u32x4*)(Vh + off) = w; }
            } else { bf16_t* base = seg == 0 ? Qh : Gh;
#pragma unroll
                for (int ai = 0; ai < 2; ++ai)
#pragma unroll
                    for (int m = 0; m < 4; ++m) { const size_t off = (size_t)(row0 + ai * 128 + m * 16) * 1024 + cc; const pg8::f32x4 v0 = acc[ai][bj][m][0], v1 = acc[ai][bj][m][1];
                        u32x4 w; w.x = pk2(silu_f(v0[0]), silu_f(v0[1])); w.y = pk2(silu_f(v0[2]), silu_f(v0[3])); w.z = pk2(silu_f(v1[0]), silu_f(v1[1])); w.w = pk2(silu_f(v1[2]), silu_f(v1[3]));
                        *(u32x4*)(base + off) = w; } } }
    }
};

__device__ __forceinline__ int src_col(int mode, int n) {
    if (mode == 1) { const int t = n >> 8, j = n & 255; return j < 128 ? t * 128 + j : DFF + t * 128 + (j - 128); }
    if (mode == 2) { if (n < 384) return n; if (n >= 448) return -1; const int j = n - 384; return 384 + (j >> 1) + 32 * (j & 1); }
    if (mode == 3) { const int h = n / QKD, d = n % QKD; if (d < 128) return n; const int j = d - 128; return h * QKD + 128 + (j >> 1) + 32 * (j & 1); }
    return n;
}
__device__ __forceinline__ void xpose_item(const float* __restrict__ W, int K, int Nsrc, int Ndst, int mode, bf16_t* __restrict__ WT, LAS float* scr, int item, int lane) {
    const int nblk = Ndst / 32, kb = item / nblk, nb = item % nblk, k0 = 64 * kb, n0 = 32 * nb;
    if (mode <= 1) {
        const int sc0 = src_col(mode, n0) + (lane & 7) * 4;
#pragma unroll
        for (int i = 0; i < 8; ++i) { const int kk = 8 * i + (lane >> 3); const f32x4 v = *(const f32x4*)(W + (size_t)(k0 + kk) * Nsrc + sc0);
            LAS float* d = scr + kk * 33 + (lane & 7) * 4; d[0] = v[0]; d[1] = v[1]; d[2] = v[2]; d[3] = v[3]; }
    } else {
        const int sc = src_col(mode, n0 + (lane & 31));
#pragma unroll 8
        for (int i = 0; i < 32; ++i) { const int kk = 2 * i + (lane >> 5); scr[kk * 33 + (lane & 31)] = sc >= 0 ? W[(size_t)(k0 + kk) * Nsrc + sc] : 0.f; }
    }
    asm volatile("s_waitcnt lgkmcnt(0)" ::: "memory");
    const int c = lane & 7;
#pragma unroll
    for (int j = 0; j < 4; ++j) { const int n = (lane >> 3) + 8 * j; const LAS float* s = scr + (8 * c) * 33 + n;
        u32x4 o; o.x = pk2(s[0 * 33], s[1 * 33]); o.y = pk2(s[2 * 33], s[3 * 33]); o.z = pk2(s[4 * 33], s[5 * 33]); o.w = pk2(s[6 * 33], s[7 * 33]);
        *(u32x4*)(WT + (size_t)(n0 + n) * K + k0 + 8 * c) = o; }
    asm volatile("s_waitcnt lgkmcnt(0)" ::: "memory");
}

__device__ __forceinline__ void row_init(const float* __restrict__ xin, float* __restrict__ X, bf16_t* __restrict__ HN, const float* __restrict__ g, int lane) {
    const f32x4* xr = (const f32x4*)xin + lane; f32x4 v[4]; float s = 0.f;
#pragma unroll
    for (int j = 0; j < 4; ++j) { v[j] = xr[64 * j]; s += (v[j][0] * v[j][0] + v[j][1] * v[j][1]) + (v[j][2] * v[j][2] + v[j][3] * v[j][3]); }
    const float r = rsqrtf(wave_sum(s) * (1.f / DM) + EPS);
#pragma unroll
    for (int j = 0; j < 4; ++j) { ((f32x4*)X + lane)[64 * j] = v[j]; const f32x4 gg = ((const f32x4*)g + lane)[64 * j];
        u32x2 w; w.x = pk2(v[j][0] * r * gg[0], v[j][1] * r * gg[1]); w.y = pk2(v[j][2] * r * gg[2], v[j][3] * r * gg[3]); ((u32x2*)HN + lane)[64 * j] = w; }
}
__device__ __forceinline__ void row_post(const bf16_t* __restrict__ Y, float* __restrict__ X, bf16_t* __restrict__ HN, float scale, const float* __restrict__ gp, const float* __restrict__ gn, int lane) {
    f32x4 y[4], x[4]; float s = 0.f;
#pragma unroll
    for (int j = 0; j < 4; ++j) { const u32x2 yb = ((const u32x2*)Y + lane)[64 * j]; y[j] = (f32x4){__uint_as_float(yb.x << 16), __uint_as_float(yb.x & 0xffff0000u), __uint_as_float(yb.y << 16), __uint_as_float(yb.y & 0xffff0000u)};
        x[j] = ((const f32x4*)X + lane)[64 * j]; s += (y[j][0] * y[j][0] + y[j][1] * y[j][1]) + (y[j][2] * y[j][2] + y[j][3] * y[j][3]); }
    const float r = rsqrtf(wave_sum(s) * (1.f / DM) + EPS) * scale; float s2 = 0.f;
#pragma unroll
    for (int j = 0; j < 4; ++j) { const f32x4 gg = ((const f32x4*)gp + lane)[64 * j]; x[j] = x[j] + y[j] * r * gg; ((f32x4*)X + lane)[64 * j] = x[j];
        s2 += (x[j][0] * x[j][0] + x[j][1] * x[j][1]) + (x[j][2] * x[j][2] + x[j][3] * x[j][3]); }
    if (HN) { const float r2 = rsqrtf(wave_sum(s2) * (1.f / DM) + EPS);
#pragma unroll
        for (int j = 0; j < 4; ++j) { const f32x4 gg = ((const f32x4*)gn + lane)[64 * j];
            u32x2 w; w.x = pk2(x[j][0] * r2 * gg[0], x[j][1] * r2 * gg[1]); w.y = pk2(x[j][2] * r2 * gg[2], x[j][3] * r2 * gg[3]); ((u32x2*)HN + lane)[64 * j] = w; } }
}
__device__ __forceinline__ void row_mla(const float* __restrict__ C, bf16_t* __restrict__ CQ, bf16_t* __restrict__ CKV, bf16_t* __restrict__ KR, const float* __restrict__ qn, const float* __restrict__ kvn,
                                        const float* __restrict__ cs, const float* __restrict__ sn, int lane) {
    const f32x4 a = ((const f32x4*)C)[2 * lane], b = ((const f32x4*)C)[2 * lane + 1];
    float s = (a[0] * a[0] + a[1] * a[1]) + (a[2] * a[2] + a[3] * a[3]) + (b[0] * b[0] + b[1] * b[1]) + (b[2] * b[2] + b[3] * b[3]);
#pragma unroll
    for (int o = 1; o < 16; o <<= 1) s += __shfl_xor(s, o);
    const float s16 = s, s32 = s16 + __shfl_xor(s16, 16);
    float v[8] = {a[0], a[1], a[2], a[3], b[0], b[1], b[2], b[3]};
    if (lane < 32) { const float r = rsqrtf(s32 * (1.f / QLR) + EPS); const f32x4 g0 = ((const f32x4*)qn)[2 * lane], g1 = ((const f32x4*)qn)[2 * lane + 1];
        u32x4 w; w.x = pk2(v[0] * r * g0[0], v[1] * r * g0[1]); w.y = pk2(v[2] * r * g0[2], v[3] * r * g0[3]); w.z = pk2(v[4] * r * g1[0], v[5] * r * g1[1]); w.w = pk2(v[6] * r * g1[2], v[7] * r * g1[3]);
        ((u32x4*)CQ)[lane] = w;
    } else if (lane < 48) { const int l = lane - 32; const float r = rsqrtf(s16 * (1.f / KVLR) + EPS); const f32x4 g0 = ((const f32x4*)kvn)[2 * l], g1 = ((const f32x4*)kvn)[2 * l + 1];
        u32x4 w; w.x = pk2(v[0] * r * g0[0], v[1] * r * g0[1]); w.y = pk2(v[2] * r * g0[2], v[3] * r * g0[3]); w.z = pk2(v[4] * r * g1[0], v[5] * r * g1[1]); w.w = pk2(v[6] * r * g1[2], v[7] * r * g1[3]);
        ((u32x4*)CKV)[l] = w;
    } else if (lane < 56) { const int l = lane - 48; const f32x4 c = ((const f32x4*)cs)[l], sv = ((const f32x4*)sn)[l];
        u32x4 w; w.x = pk2(v[0] * c[0] - v[1] * sv[0], v[0] * sv[0] + v[1] * c[0]); w.y = pk2(v[2] * c[1] - v[3] * sv[1], v[2] * sv[1] + v[3] * c[1]);
        w.z = pk2(v[4] * c[2] - v[5] * sv[2], v[4] * sv[2] + v[5] * c[2]); w.w = pk2(v[6] * c[3] - v[7] * sv[3], v[6] * sv[3] + v[7] * c[3]);
        ((u32x4*)KR)[l] = w; }
}
__device__ __forceinline__ void row_hgrn(const bf16_t* __restrict__ Oa, const bf16_t* __restrict__ Gh, bf16_t* __restrict__ HO, const float* __restrict__ on, int lane) {
#pragma unroll
    for (int j = 0; j < 4; ++j) { const u32x2 a = ((const u32x2*)Oa + lane)[64 * j], b = ((const u32x2*)(Oa + (size_t)MT * 1024) + lane)[64 * j];
        f32x4 o; o[0] = __uint_as_float(a.x << 16) + __uint_as_float(b.x << 16); o[1] = __uint_as_float(a.x & 0xffff0000u) + __uint_as_float(b.x & 0xffff0000u);
        o[2] = __uint_as_float(a.y << 16) + __uint_as_float(b.y << 16); o[3] = __uint_as_float(a.y & 0xffff0000u) + __uint_as_float(b.y & 0xffff0000u);
        const float s = half_sum((o[0] * o[0] + o[1] * o[1]) + (o[2] * o[2] + o[3] * o[3]));
        const float r = rsqrtf(s * (1.f / 128.f) + EPS); const f32x4 gg = ((const f32x4*)on + lane)[64 * j]; const u32x2 gb = ((const u32x2*)Gh + lane)[64 * j];
        const float g0 = __uint_as_float(gb.x << 16), g1 = __uint_as_float(gb.x & 0xffff0000u), g2 = __uint_as_float(gb.y << 16), g3 = __uint_as_float(gb.y & 0xffff0000u);
        u32x2 w; w.x = pk2(o[0] * r * gg[0] * g0, o[1] * r * gg[1] * g1); w.y = pk2(o[2] * r * gg[2] * g2, o[3] * r * gg[3] * g3); ((u32x2*)HO + lane)[64 * j] = w; }
}
__device__ __forceinline__ f32x2 h2f2_(unsigned u) { const h16x2 h = __builtin_bit_cast(h16x2, u); return (f32x2){(float)h[0], (float)h[1]}; }
__device__ __forceinline__ void scan_phase(LAS unsigned char* lds, const bf16_t* __restrict__ Qh, const bf16_t* __restrict__ Vh, const unsigned short* __restrict__ KF, bf16_t* __restrict__ OP, int G, int bx) {
    int tid = threadIdx.x; asm volatile("" : "+v"(tid)); const int wid = __builtin_amdgcn_readfirstlane(tid >> 6), lane = tid & 63;
    const int st = tid >> 4, sc8 = (tid & 15) * 8, sv = tid >> 3, vc4 = (tid & 7) * 4;
    constexpr int OFF_K = 16384, OFF_Q = 32768, OFF_V = 49152, OFF_P = 53248;
    for (int item = bx; item < 256; item += G) {
        const int dir = item & 1, dvq = (item >> 1) & 3, h = (item >> 3) & 7, b = item >> 6;
        const size_t kcol = h * 128 + sc8, vcol = h * 128 + dvq * 32 + vc4;
        const unsigned short* KFd = KF + (size_t)dir * MT * 1024; bf16_t* OPd = OP + (size_t)dir * MT * 1024;
        u32x4 rk, rq; u32x2 rv = {0u, 0u};
#define SC_GLOAD(blk) do { { const int tt = (blk) * 32 + st; const size_t m = (size_t)b * SEQ + (dir ? SEQ - 1 - tt : tt); \
        rk = *(const u32x4*)(KFd + m * 1024 + kcol); rq = *(const u32x4*)(Qh + m * 1024 + kcol); } \
        if (tid < 256) { const int tt = (blk) * 32 + sv; const size_t m = (size_t)b * SEQ + (dir ? SEQ - 1 - tt : tt); rv = *(const u32x2*)(Vh + m * 1024 + vcol); } } while (0)
#define SC_H2F(u_) h2f2_(u_)
#define SC_LWRITE() do { LAS unsigned char* B_ = lds + (st * 128 + sc8) * 4; \
        const f32x2 ka = SC_H2F(rk.x), kb = SC_H2F(rk.y), kc = SC_H2F(rk.z), kd = SC_H2F(rk.w); \
        const f32x4 k0_ = {ka[0], ka[1], kb[0], kb[1]}, k1_ = {kc[0], kc[1], kd[0], kd[1]}; \
        *(LAS f32x4*)(B_ + OFF_K) = k0_; *(LAS f32x4*)(B_ + OFF_K + 16) = k1_; \
        *(LAS f32x4*)(B_ + OFF_Q) = (f32x4){__uint_as_float(rq.x << 16), __uint_as_float(rq.x & 0xffff0000u), __uint_as_float(rq.y << 16), __uint_as_float(rq.y & 0xffff0000u)}; \
        *(LAS f32x4*)(B_ + OFF_Q + 16) = (f32x4){__uint_as_float(rq.z << 16), __uint_as_float(rq.z & 0xffff0000u), __uint_as_float(rq.w << 16), __uint_as_float(rq.w & 0xffff0000u)}; \
        if (tid < 256) *(LAS f32x4*)(lds + OFF_V + (sv * 32 + vc4) * 4) = (f32x4){__uint_as_float(rv.x << 16), __uint_as_float(rv.x & 0xffff0000u), __uint_as_float(rv.y << 16), __uint_as_float(rv.y & 0xffff0000u)}; } while (0)
        SC_GLOAD(0);
        const int dksub = ((lane >> 3) & 1) | ((lane >> 5) << 1), dvp = (lane & 7) | (((lane >> 4) & 1) << 3);
        const LAS unsigned char* Bc = lds + (16 * wid + 4 * dksub) * 4;
        const LAS unsigned char* Vc = lds + OFF_V + dvp * 8;
        LAS unsigned char* Pw = lds + OFF_P + (wid * 4 + dksub) * 2048 + dvp * 4;
        f32x2 S2[4];
#pragma unroll
        for (int j = 0; j < 4; ++j) S2[j] = (f32x2){0.f, 0.f};
        for (int blk = 0; blk < SEQ / 32; ++blk) {
            SC_LWRITE();
            if (blk + 1 < SEQ / 32) SC_GLOAD(blk + 1);
            __syncthreads();
            f32x4 k4n = *(const LAS f32x4*)(Bc + OFF_K), q4n = *(const LAS f32x4*)(Bc + OFF_Q); f32x2 v2n = *(const LAS f32x2*)(Vc);
            f32x4 k4m = *(const LAS f32x4*)(Bc + OFF_K + 512), q4m = *(const LAS f32x4*)(Bc + OFF_Q + 512); f32x2 v2m = *(const LAS f32x2*)(Vc + 128);
#pragma unroll
            for (int t = 0; t < 32; ++t) {
                const f32x4 k4 = k4n, q4 = q4n; const f32x2 v2 = v2n;
                k4n = k4m; q4n = q4m; v2n = v2m;
                { const int tn = (t + 2) & 31;
                  k4m = *(const LAS f32x4*)(Bc + OFF_K + tn * 512); q4m = *(const LAS f32x4*)(Bc + OFF_Q + tn * 512); v2m = *(const LAS f32x2*)(Vc + tn * 128); }
                __builtin_amdgcn_sched_barrier(0);
#pragma unroll
                for (int j = 0; j < 4; ++j) S2[j] = S2[j] + (v2 - S2[j]) * k4[j];
                const f32x2 o2 = (S2[0] * q4[0] + S2[1] * q4[1]) + (S2[2] * q4[2] + S2[3] * q4[3]);
                *(LAS unsigned*)(Pw + t * 64) = pk2(o2[0], o2[1]);
            }
            __syncthreads();
            if (tid < 256) { const LAS unsigned char* Pr = lds + OFF_P + (sv * 32 + vc4) * 2; f32x4 acc = {0.f, 0.f, 0.f, 0.f};
#pragma unroll
              for (int g = 0; g < 32; ++g) { const u32x2 pv = *(const LAS u32x2*)(Pr + g * 2048);
                  acc[0] += __uint_as_float(pv.x << 16); acc[1] += __uint_as_float(pv.x & 0xffff0000u); acc[2] += __uint_as_float(pv.y << 16); acc[3] += __uint_as_float(pv.y & 0xffff0000u); }
              const int tt = blk * 32 + sv; const size_t m = (size_t)b * SEQ + (dir ? SEQ - 1 - tt : tt);
              u32x2 w; w.x = pk2(acc[0], acc[1]); w.y = pk2(acc[2], acc[3]); *(u32x2*)(OPd + m * 1024 + vcol) = w; }
        }
        __syncthreads();
#undef SC_GLOAD
#undef SC_LWRITE
#undef SC_H2F
    }
}

typedef float f32x16 __attribute__((ext_vector_type(16)));
typedef short s16x8 __attribute__((ext_vector_type(8)));
__device__ __forceinline__ int crow_(int r, int hi) { return (r & 3) + 8 * (r >> 2) + 4 * hi; }
template <int KSTEPS, int I0 = 0>
__device__ __forceinline__ void mm_tile(f32x16& c, const LAS unsigned char* X, int xstride, const LAS unsigned char* Y, int ystride, int r32, int hi) {
#pragma unroll
    for (int i = I0; i < I0 + KSTEPS; ++i) { const s16x8 x = *(const LAS s16x8*)(X + r32 * xstride + (16 * i + 8 * hi) * 2), y = *(const LAS s16x8*)(Y + r32 * ystride + (16 * i + 8 * hi) * 2);
        c = __builtin_amdgcn_mfma_f32_32x32x16_bf16(x, y, c, 0, 0, 0); }
}
__device__ __forceinline__ void scan_phase_mfma(LAS unsigned char* lds, const bf16_t* __restrict__ Qh, const bf16_t* __restrict__ Vh, const unsigned short* __restrict__ KF, bf16_t* __restrict__ OP, int G, int bx) {
    int tid = threadIdx.x; asm volatile("" : "+v"(tid)); const int wid = __builtin_amdgcn_readfirstlane(tid >> 6), lane = tid & 63, r32 = lane & 31, hi = lane >> 5;
    const bool grpA = wid < 4;
    const int st = (tid >> 3) & 31, sc16 = (tid & 7) * 16, vc4 = (tid & 7) * 4;
    constexpr int SQ = 272, SV = 80, NC = SEQ / 32;
    constexpr int IMG = 2 * 32 * SQ + 128 * SV + 32 * SV + 512;
    constexpr int O_LG = 0, O_IMG = 16384, O_AT = O_IMG + 2 * IMG, O_ST = O_AT + 32 * SV;
    constexpr int I_QT = 0, I_KT = 32 * SQ, I_KTT = 2 * 32 * SQ, I_VT = I_KTT + 128 * SV, I_G = I_VT + 32 * SV;
    static_assert(O_ST + 32 * SQ <= LDS_RING && IMG % 16 == 0, "scan LDS map");
    for (int item = bx; item < 256; item += G) {
        const int dir = item & 1, dvq = (item >> 1) & 3, h = (item >> 3) & 7, b = item >> 6;
        const size_t kcol = h * 128 + sc16, vcol = h * 128 + dvq * 32 + vc4;
        const unsigned short* KFd = KF + (size_t)dir * MT * 1024; bf16_t* OPd = OP + (size_t)dir * MT * 1024;
        u32x4 rk0, rk1, rq0, rq1; u32x2 rv;
#define SM_GLOAD(blk) do { const int tt = (blk) * 32 + st; const size_t m = (size_t)b * SEQ + (dir ? SEQ - 1 - tt : tt); \
        rk0 = *(const u32x4*)(KFd + m * 1024 + kcol); rk1 = *(const u32x4*)(KFd + m * 1024 + kcol + 8); rq0 = *(const u32x4*)(Qh + m * 1024 + kcol); rq1 = *(const u32x4*)(Qh + m * 1024 + kcol + 8); \
        rv = *(const u32x2*)(Vh + m * 1024 + vcol); } while (0)
        if (grpA) SM_GLOAD(0);
        f32x16 accS, accO;
#pragma unroll
        for (int r = 0; r < 16; ++r) { accS[r] = 0.f; accO[r] = 0.f; }
        for (int i = tid; i < 32 * SQ / 4; i += 512) ((LAS unsigned*)(lds + O_ST))[i] = 0u;
        __syncthreads();
        for (int rd = -1; rd < NC; ++rd) {
            const int cn = rd + 1;
            LAS unsigned char* Wi = lds + O_IMG + (cn & 1) * IMG;
            const LAS unsigned char* Ri = lds + O_IMG + (rd & 1) * IMG;
            float kf[16];
            if (grpA) { if (cn < NC) {
                { const f32x2 a = h2f2_(rk0.x), bq = h2f2_(rk0.y), c = h2f2_(rk0.z), d = h2f2_(rk0.w), e = h2f2_(rk1.x), f = h2f2_(rk1.y), g2 = h2f2_(rk1.z), h2 = h2f2_(rk1.w);
                  kf[0] = a[0]; kf[1] = a[1]; kf[2] = bq[0]; kf[3] = bq[1]; kf[4] = c[0]; kf[5] = c[1]; kf[6] = d[0]; kf[7] = d[1];
                  kf[8] = e[0]; kf[9] = e[1]; kf[10] = f[0]; kf[11] = f[1]; kf[12] = g2[0]; kf[13] = g2[1]; kf[14] = h2[0]; kf[15] = h2[1]; }
                LAS unsigned char* L_ = lds + O_LG + (st * 128 + sc16) * 4;
#pragma unroll
                for (int q4 = 0; q4 < 4; ++q4) { f32x4 a4;
#pragma unroll
                    for (int e = 0; e < 4; ++e) a4[e] = __builtin_amdgcn_logf(1.0f - kf[4 * q4 + e]);
                    *(LAS f32x4*)(L_ + 16 * q4) = a4; }
                LAS unsigned char* V_ = Wi + I_VT + st * 2;
                *(LAS unsigned short*)(V_ + (vc4 + 0) * SV) = (unsigned short)(rv.x & 0xffffu); *(LAS unsigned short*)(V_ + (vc4 + 1) * SV) = (unsigned short)(rv.x >> 16);
                *(LAS unsigned short*)(V_ + (vc4 + 2) * SV) = (unsigned short)(rv.y & 0xffffu); *(LAS unsigned short*)(V_ + (vc4 + 3) * SV) = (unsigned short)(rv.y >> 16);
            } } else if (rd >= 0) {
                const int w4 = wid - 4;
                mm_tile<2>(accS, Ri + I_KTT + w4 * 32 * SV, SV, Ri + I_VT, SV, r32, hi);
                if (w4 == 0) { f32x16 pa, pb;
#pragma unroll
                    for (int r = 0; r < 16; ++r) { pa[r] = 0.f; pb[r] = 0.f; }
                    mm_tile<4, 0>(pa, Ri + I_KT, SQ, Ri + I_QT, SQ, r32, hi); mm_tile<4, 4>(pb, Ri + I_KT, SQ, Ri + I_QT, SQ, r32, hi);
#pragma unroll
                    for (int g = 0; g < 4; ++g) { const int s0 = 8 * g + 4 * hi; float v4[4];
#pragma unroll
                        for (int e = 0; e < 4; ++e) v4[e] = (s0 + e) <= r32 ? pa[4 * g + e] + pb[4 * g + e] : 0.f;
                        u32x2 w; w.x = pk2(v4[0], v4[1]); w.y = pk2(v4[2], v4[3]); *(LAS u32x2*)(lds + O_AT + r32 * SV + s0 * 2) = w; } }
                else if (w4 == 1) { f32x16 ob;
#pragma unroll
                    for (int r = 0; r < 16; ++r) { accO[r] = 0.f; ob[r] = 0.f; }
                    mm_tile<4, 0>(accO, lds + O_ST, SQ, Ri + I_QT, SQ, r32, hi); mm_tile<4, 4>(ob, lds + O_ST, SQ, Ri + I_QT, SQ, r32, hi);
#pragma unroll
                    for (int r = 0; r < 16; ++r) accO[r] += ob[r]; }
            }
            __syncthreads();
            if (grpA) { if (cn < NC) {
#pragma unroll
                for (int u = 0; u < 2; ++u) { LAS float* col = (LAS float*)(lds + O_LG) + (tid & 127) + (((tid >> 7) & 1) + 2 * u) * 8 * 128; float acc = 0.f;
#pragma unroll
                    for (int t = 0; t < 8; ++t) { acc += col[t * 128]; col[t * 128] = acc; } }
            } } else if (rd >= 0) {
                const int w4 = wid - 4;
                if (w4 == 1) { mm_tile<2>(accO, Ri + I_VT, SV, lds + O_AT, SV, r32, hi);
                    asm volatile("s_nop 15\n\ts_nop 7" : "+v"(accO));
                    const int tt = rd * 32 + r32; const size_t m = (size_t)b * SEQ + (dir ? SEQ - 1 - tt : tt); bf16_t* orow = OPd + m * 1024 + h * 128 + dvq * 32;
#pragma unroll
                    for (int g = 0; g < 4; ++g) { u32x2 w; w.x = pk2(accO[4 * g + 0], accO[4 * g + 1]); w.y = pk2(accO[4 * g + 2], accO[4 * g + 3]); *(u32x2*)(orow + 8 * g + 4 * hi) = w; } }
            }
            __syncthreads();
            if (grpA) { if (cn < NC)
#ifdef REP_A3
            for (int rep_ = 0; rep_ < 2; ++rep_)
#endif
            {
                const LAS unsigned char* L_ = lds + O_LG + (st * 128 + sc16) * 4; float bb[16];
#pragma unroll
                for (int q4 = 0; q4 < 4; ++q4) { const f32x4 t4 = *(const LAS f32x4*)(L_ + 16 * q4); bb[4 * q4] = t4[0]; bb[4 * q4 + 1] = t4[1]; bb[4 * q4 + 2] = t4[2]; bb[4 * q4 + 3] = t4[3]; }
#pragma unroll
                for (int qd = 0; qd < 3; ++qd) { const LAS unsigned char* T_ = lds + O_LG + ((8 * qd + 7) * 128 + sc16) * 4; const float m_ = (st >> 3) > qd ? 1.f : 0.f;
#pragma unroll
                    for (int q4 = 0; q4 < 4; ++q4) { const f32x4 t4 = *(const LAS f32x4*)(T_ + 16 * q4); bb[4 * q4] += t4[0] * m_; bb[4 * q4 + 1] += t4[1] * m_; bb[4 * q4 + 2] += t4[2] * m_; bb[4 * q4 + 3] += t4[3] * m_; } }
                const unsigned qraw[8] = {rq0.x, rq0.y, rq0.z, rq0.w, rq1.x, rq1.y, rq1.z, rq1.w};
                unsigned qw[8], kw[8];
#pragma unroll
                for (int e = 0; e < 8; ++e) { const float e0 = __builtin_amdgcn_exp2f(bb[2 * e]), e1 = __builtin_amdgcn_exp2f(bb[2 * e + 1]);
                    qw[e] = pk2(__uint_as_float(qraw[e] << 16) * e0, __uint_as_float(qraw[e] & 0xffff0000u) * e1);
                    kw[e] = pk2(kf[2 * e] * __builtin_amdgcn_exp2f(-bb[2 * e]), kf[2 * e + 1] * __builtin_amdgcn_exp2f(-bb[2 * e + 1]));
                    if (st == 31) { ((LAS float*)(Wi + I_G))[sc16 + 2 * e] = e0; ((LAS float*)(Wi + I_G))[sc16 + 2 * e + 1] = e1; } }
                *(LAS u32x4*)(Wi + I_QT + st * SQ + sc16 * 2) = (u32x4){qw[0], qw[1], qw[2], qw[3]}; *(LAS u32x4*)(Wi + I_QT + st * SQ + sc16 * 2 + 16) = (u32x4){qw[4], qw[5], qw[6], qw[7]};
                *(LAS u32x4*)(Wi + I_KT + st * SQ + sc16 * 2) = (u32x4){kw[0], kw[1], kw[2], kw[3]}; *(LAS u32x4*)(Wi + I_KT + st * SQ + sc16 * 2 + 16) = (u32x4){kw[4], kw[5], kw[6], kw[7]};
                LAS unsigned char* T_ = Wi + I_KTT + sc16 * SV + st * 2;
#pragma unroll
                for (int e = 0; e < 8; ++e) { *(LAS unsigned short*)(T_ + (2 * e) * SV) = (unsigned short)(kw[e] & 0xffffu); *(LAS unsigned short*)(T_ + (2 * e + 1) * SV) = (unsigned short)(kw[e] >> 16); }
                if (cn + 1 < NC) SM_GLOAD(cn + 1);
            } } else if (rd >= 0) {
                const int w4 = wid - 4;
#pragma unroll
                for (int g = 0; g < 4; ++g) { const int dk0 = 32 * w4 + 8 * g + 4 * hi; const f32x4 gm = *(const LAS f32x4*)(Ri + I_G + dk0 * 4);
                    accS[4 * g + 0] *= gm[0]; accS[4 * g + 1] *= gm[1]; accS[4 * g + 2] *= gm[2]; accS[4 * g + 3] *= gm[3];
                    u32x2 w; w.x = pk2(accS[4 * g + 0], accS[4 * g + 1]); w.y = pk2(accS[4 * g + 2], accS[4 * g + 3]);
                    *(LAS u32x2*)(lds + O_ST + r32 * SQ + dk0 * 2) = w; }
            }
            __syncthreads();
        }
#undef SM_GLOAD
    }
}

enum Op { OP_SW0, OP_FO0, OP_RPA, OP_MIN, OP_RMLA, OP_QKV, OP_ATTN, OP_MWO, OP_RPB, OP_SW1, OP_FO1, OP_RPC, OP_HIN, OP_SCAN, OP_RHG, OP_HWO };
__device__ const unsigned char OPS_M[12] = {OP_SW0, OP_FO0, OP_RPA, OP_MIN, OP_RMLA, OP_QKV, OP_ATTN, OP_MWO, OP_RPB, OP_SW1, OP_FO1, OP_RPC};
__device__ const unsigned char OPS_H[11] = {OP_SW0, OP_FO0, OP_RPA, OP_HIN, OP_SCAN, OP_RHG, OP_HWO, OP_RPB, OP_SW1, OP_FO1, OP_RPC};

struct Args { const float* in[15]; float* out; unsigned char* ws; };
typedef const __attribute__((address_space(4))) Args* ArgsP;
__device__ __forceinline__ ArgsP get_args() { ArgsP p = (ArgsP)__builtin_amdgcn_kernarg_segment_ptr(); asm volatile("" : "+s"(p) :: "memory"); return p; }
#define GW_ ((int)blockIdx.x * 8 + __builtin_amdgcn_readfirstlane((int)threadIdx.x >> 6))
#define NGW_ ((int)gridDim.x * 8)
__device__ __forceinline__ int otid_() { int t = threadIdx.x; asm volatile("" : "+v"(t)); return t; }
#define LANE_ (otid_() & 63)

#ifdef DBG_CHECKS
__device__ __forceinline__ float bf2f(bf16_t v) { return __uint_as_float((unsigned)v << 16); }
__device__ __forceinline__ unsigned hash_u(unsigned x) { x ^= x >> 16; x *= 0x7feb352du; x ^= x >> 15; x *= 0x846ca68bu; x ^= x >> 16; return x; }
__device__ __forceinline__ void dbg_report(unsigned* DBG, int id, float got, float ref, float rtol, float atol) {
    const float err = fabsf(got - ref); const bool bad = !(err <= rtol * fabsf(ref) + atol);
    if (bad) atomicMax(DBG + id, 1u);
}
__device__ __forceinline__ int dbg_row(int sidx) { if (sidx == 0) return 0; if (sidx == 1) return MT - 1; if (sidx == 2) return SEQ - 1; if (sidx == 3) return SEQ; return (int)(hash_u(sidx * 2654435761u + 17u) % MT); }
#endif
#ifdef DBG_CHECKS
struct DbgCtx { const float* const* in; unsigned char* ws; unsigned char* R; unsigned* DBG; int bx, tid, lane, wave; };
__device__ __forceinline__ float dbg_dot_bf_w(const bf16_t* a, const float* W, int K, int ldw, int col) { float s = 0.f; for (int k = 0; k < K; ++k) s += bf2f(a[k]) * W[(size_t)k * ldw + col]; return s; }
template <class A>
__device__ __forceinline__ void dbg_after(int l, int op, A ap, unsigned char* ws, unsigned char* R, LAS unsigned char* lds) {
    unsigned* DBG = (unsigned*)(ws + 32768);
    const int bx = blockIdx.x, tid = otid_(), lane = tid & 63, wave = __builtin_amdgcn_readfirstlane(tid >> 6);
    const bf16_t* HN = (const bf16_t*)(ws + WS_HN); const float* Y = (const float*)(ws + WS_Y);
    if (false && l == 0 && op == OP_SW0 && bx < 32) { const int sid = bx * 512 + tid, m = dbg_row(sid), c = hash_u(sid * 3 + 1) % DFF; const float* W = ap->in[3];
        const float g = dbg_dot_bf_w(HN + (size_t)m * 1024, W, 1024, 2 * DFF, c), u = dbg_dot_bf_w(HN + (size_t)m * 1024, W, 1024, 2 * DFF, DFF + c);
        dbg_report(DBG, 1, bf2f(((const bf16_t*)(R + R_ACT))[(size_t)m * DFF + c]), g / (1.f + expf(-g)) * u, 0.015f, 0.004f); }
    if (false && l == 0 && op == OP_FO0 && bx < 32) { const int sid = bx * 512 + tid, m = dbg_row(sid), c = hash_u(sid * 3 + 2) % 1024;
        const float r = dbg_dot_bf_w((const bf16_t*)(R + R_ACT) + (size_t)m * DFF, ap->in[4], DFF, 1024, c);
        dbg_report(DBG, 2, Y[(size_t)m * 1024 + c], r, 0.015f, 0.004f); }
    if (false && l == 0 && op == OP_RPA && bx < 32) { const int sid = bx * 512 + tid, m = dbg_row(sid), c = hash_u(sid * 3 + 3) % 1024; const float* g = ap->in[2];
        float s = 0.f; for (int k = 0; k < 1024; ++k) { const float y = Y[(size_t)m * 1024 + k]; s += y * y; }
        const float xr = ap->in[0][(size_t)m * 1024 + c] + 0.5f * Y[(size_t)m * 1024 + c] * rsqrtf(s / 1024.f + EPS) * g[1024 + c];
        dbg_report(DBG, 2, ap->out[(size_t)m * 1024 + c], xr, 1e-3f, 1e-3f);
        float s2 = 0.f; for (int k = 0; k < 1024; ++k) { const float x = ap->out[(size_t)m * 1024 + k]; s2 += x * x; }
        dbg_report(DBG, 2, bf2f(HN[(size_t)m * 1024 + c]), ap->out[(size_t)m * 1024 + c] * rsqrtf(s2 / 1024.f + EPS) * g[2048 + c], 0.01f, 0.01f); }
    if (false && l == 0 && op == OP_MIN && bx < 32) { const int sid = bx * 512 + tid, m = dbg_row(sid), c = hash_u(sid * 3 + 4) % 512; const int sc = src_col(2, c);
        const float r = sc >= 0 ? dbg_dot_bf_w(HN + (size_t)m * 1024, ap->in[5], 1024, 448, sc) : 0.f;
        dbg_report(DBG, 3, ((const float*)(R + R_C))[(size_t)m * 512 + c], r, 0.015f, 0.01f); }
    if (false && l == 0 && op == OP_RMLA && bx < 32) { const int sid = bx * 512 + tid, m = dbg_row(sid), c = hash_u(sid * 3 + 5) % 448; const float* C = (const float*)(R + R_C) + (size_t)m * 512;
        if (c < 256) { float s = 0.f; for (int k = 0; k < 256; ++k) s += C[k] * C[k];
            dbg_report(DBG, 3, bf2f(((const bf16_t*)(R + R_CQ))[(size_t)m * 256 + c]), C[c] * rsqrtf(s / 256.f + EPS) * ap->in[6][c], 0.01f, 0.01f); }
        else if (c < 384) { float s = 0.f; for (int k = 256; k < 384; ++k) s += C[k] * C[k];
            dbg_report(DBG, 3, bf2f(((const bf16_t*)(R + R_CKV))[(size_t)m * 128 + c - 256]), C[c] * rsqrtf(s / 128.f + EPS) * ap->in[7][c - 256], 0.01f, 0.01f); }
        else { const int jj = c - 384, i = jj >> 1; const float ang = (float)((const int*)ap->in[1])[m] * powf(10000.f, -(float)i / 32.f); const float cs = cosf(ang), sn = sinf(ang);
            const float t1 = C[384 + 2 * i], t2 = C[384 + 2 * i + 1]; const float r = (jj & 1) ? t1 * sn + t2 * cs : t1 * cs - t2 * sn;
            dbg_report(DBG, 3, bf2f(((const bf16_t*)(R + R_KR))[(size_t)m * 64 + jj]), r, 0.02f, 0.05f); } }
    if (false && l == 0 && op == OP_QKV && bx < 32) { const int sid = bx * 512 + tid, m = dbg_row(sid); const bf16_t* CQ = (const bf16_t*)(R + R_CQ) + (size_t)m * 256; const bf16_t* CKV = (const bf16_t*)(R + R_CKV) + (size_t)m * 128;
        { const int c = hash_u(sid * 3 + 6) % 1536, h = c / QKD, d = c % QKD; float r;
          if (d < 128) r = dbg_dot_bf_w(CQ, ap->in[8], 256, 1536, c);
          else { const int jj = d - 128, i = jj >> 1; const float t1 = dbg_dot_bf_w(CQ, ap->in[8], 256, 1536, h * QKD + 128 + i), t2 = dbg_dot_bf_w(CQ, ap->in[8], 256, 1536, h * QKD + 160 + i);
              const float ang = (float)((const int*)ap->in[1])[m] * powf(10000.f, -(float)i / 32.f); const float cs = cosf(ang), sn = sinf(ang); r = (jj & 1) ? t1 * sn + t2 * cs : t1 * cs - t2 * sn; }
          dbg_report(DBG, 4, bf2f(((const bf16_t*)(R + R_QB))[(size_t)m * 1536 + c]), r, 0.015f, 0.015f); }
        { const int c = hash_u(sid * 3 + 7) % 2048, h = c >> 8, d = c & 255; const float r = dbg_dot_bf_w(CKV, ap->in[9], 128, 2048, c);
          const float got = d < 128 ? bf2f(((const bf16_t*)(R + R_KN))[(size_t)m * 1024 + h * 128 + d]) : bf2f(((const bf16_t*)(R + R_VB))[(size_t)m * 1024 + h * 128 + d - 128]);
          dbg_report(DBG, 5, got, r, 0.015f, 0.015f); } }
    if (l == 0 && op == OP_ATTN) { const int sid = bx * 8 + wave, m = dbg_row(sid), h = hash_u(sid * 5 + 1) & 7, dv = hash_u(sid * 5 + 2) & 127, b = m / SEQ;
        LAS float* qs = (LAS float*)lds + wave * 192; const bf16_t* Q = (const bf16_t*)(R + R_QB) + (size_t)m * 1536 + h * QKD;
        for (int d = lane; d < 192; d += 64) qs[d] = bf2f(Q[d]);
        asm volatile("s_waitcnt lgkmcnt(0)" ::: "memory");
        float mx = -1e30f, ls = 0.f, acc = 0.f;
        for (int kk = lane; kk < SEQ; kk += 64) { const size_t km = (size_t)b * SEQ + kk; const bf16_t* Kn = (const bf16_t*)(R + R_KN) + km * 1024 + h * 128; const bf16_t* Kr = (const bf16_t*)(R + R_KR) + km * 64;
            float s = 0.f; for (int d = 0; d < 128; ++d) s += qs[d] * bf2f(Kn[d]); for (int d = 0; d < 64; ++d) s += qs[128 + d] * bf2f(Kr[d]);
            s *= 0.07216878364870322f; const float v = bf2f(((const bf16_t*)(R + R_VB))[km * 1024 + h * 128 + dv]);
            const float mn = fmaxf(mx, s), al = expf(mx - mn), p = expf(s - mn); ls = ls * al + p; acc = acc * al + p * v; mx = mn; }
        float gm = mx;
        for (int o = 1; o < 64; o <<= 1) gm = fmaxf(gm, __shfl_xor(gm, o));
        const float sc = expf(mx - gm); const float L = wave_sum(ls * sc), Asum = wave_sum(acc * sc);
        if (lane == 0) { const float got = bf2f(((const bf16_t*)(R + R_O))[(size_t)m * 1024 + h * 128 + dv]), ref = Asum / L; atomicMax(DBG + 20, __float_as_uint(fabsf(got - ref))); atomicAdd((float*)(DBG + 21), fabsf(ref) * (1.f / 2048.f)); } }
    if (false && l == 1 && op == OP_HIN && bx < 32) { const int sid = bx * 512 + tid, m = dbg_row(sid), c5 = hash_u(sid * 3 + 8) % 5120, seg = c5 >> 10, c = c5 & 1023;
        const float u = dbg_dot_bf_w(HN + (size_t)m * 1024, ap->in[11], 1024, 5120, c5); float got, r;
        if (seg == 0) { got = bf2f(((const bf16_t*)(R + R_QH))[(size_t)m * 1024 + c]); r = u / (1.f + expf(-u)); }
        else if (seg == 3) { got = bf2f(((const bf16_t*)(R + R_VH))[(size_t)m * 1024 + c]); r = u; }
        else if (seg == 4) { got = bf2f(((const bf16_t*)(R + R_GH))[(size_t)m * 1024 + c]); r = u / (1.f + expf(-u)); }
        else { const int dir = seg - 1; const float* lbp = ap->in[12] + (size_t)dir * DEPTH * 1024 + c; const float e0 = expf(lbp[0]), e1 = expf(lbp[1024]), e2 = expf(lbp[2048]), e3 = expf(lbp[3072]);
            const float lb = e1 / (e0 + e1 + e2 + e3); const h16x2 hv = __builtin_bit_cast(h16x2, (unsigned)((const unsigned short*)(R + R_KF))[(size_t)dir * MT * 1024 + (size_t)m * 1024 + c]);
            got = (float)hv[0]; r = (1.f - lb) / (1.f + expf(u)); }
        dbg_report(DBG, 7, got, r, 0.015f, 0.006f); }
    if (false && l == 1 && op == OP_SCAN) { const int sid = bx * 8 + wave, h = hash_u(sid * 5 + 3) & 7, dv = hash_u(sid * 5 + 4) & 127, b = hash_u(sid * 5 + 5) & 3, toff = sid & 31, dir = 0;
        const bf16_t* Qh = (const bf16_t*)(R + R_QH); const bf16_t* Vh = (const bf16_t*)(R + R_VH); const unsigned short* KF = (const unsigned short*)(R + R_KF); const bf16_t* OPb = (const bf16_t*)(ws + WS_Y);
        float S0 = 0.f, S1 = 0.f; const int n = toff + 1; const int t = toff; const size_t m = (size_t)b * SEQ + t;
        for (int i = 0; i < n; ++i) { const int tt = i; const size_t mm = (size_t)b * SEQ + tt; const unsigned short* kp = KF + (size_t)dir * MT * 1024 + mm * 1024 + h * 128;
            const h16x2 ka = __builtin_bit_cast(h16x2, (unsigned)kp[lane]), kb = __builtin_bit_cast(h16x2, (unsigned)kp[lane + 64]); const float k0 = (float)ka[0], k1 = (float)kb[0];
            const float v = bf2f(Vh[mm * 1024 + h * 128 + dv]); S0 = S0 * (1.f - k0) + k0 * v; S1 = S1 * (1.f - k1) + k1 * v; }
        const bf16_t* q = Qh + m * 1024 + h * 128; const float tot = wave_sum(S0 * bf2f(q[lane]) + S1 * bf2f(q[lane + 64]));
        if (lane == 0) { const float got = bf2f(OPb[(size_t)dir * MT * 1024 + m * 1024 + h * 128 + dv]); const float re = fabsf(got - tot) / (fabsf(tot) + 0.05f);
            if (re > 0.05f) { atomicMin(DBG + 20, (unsigned)toff); atomicAdd(DBG + 21, 1u); } } }
    if (false && l == 1 && op == OP_RHG && bx < 32) { const int sid = bx * 512 + tid, m = dbg_row(sid), c = hash_u(sid * 3 + 9) % 1024, h0 = c & ~127; const bf16_t* OPb = (const bf16_t*)(ws + WS_Y);
        float s = 0.f; for (int k = 0; k < 128; ++k) { const float y = bf2f(OPb[(size_t)m * 1024 + h0 + k]) + bf2f(OPb[(size_t)MT * 1024 + (size_t)m * 1024 + h0 + k]); s += y * y; }
        const float yc = bf2f(OPb[(size_t)m * 1024 + c]) + bf2f(OPb[(size_t)MT * 1024 + (size_t)m * 1024 + c]);
        const float r = yc * rsqrtf(s / 128.f + EPS) * ap->in[13][c] * bf2f(((const bf16_t*)(R + R_GH))[(size_t)m * 1024 + c]);
        dbg_report(DBG, 9, bf2f(((const bf16_t*)(R + R_HO))[(size_t)m * 1024 + c]), r, 0.02f, 0.005f); }
    if (false && l == 1 && op == OP_HWO && bx < 32) { const int sid = bx * 512 + tid, m = dbg_row(sid), c = hash_u(sid * 3 + 10) % 1024;
        const float r = dbg_dot_bf_w((const bf16_t*)(R + R_HO) + (size_t)m * 1024, ap->in[14], 1024, 1024, c);
        dbg_report(DBG, 9, Y[(size_t)m * 1024 + c], r, 0.03f, 0.01f); }
    if (false && l == 0 && op == OP_MWO && bx < 32) { const int sid = bx * 512 + tid, m = dbg_row(sid), c = hash_u(sid * 3 + 11) % 1024;
        const float r = dbg_dot_bf_w((const bf16_t*)(R + R_O) + (size_t)m * 1024, ap->in[10], 1024, 1024, c);
        dbg_report(DBG, 6, Y[(size_t)m * 1024 + c], r, 0.02f, 0.0004f); }
}
#endif

__device__ __forceinline__ void gsync_cg() {
    asm volatile("s_waitcnt vmcnt(0) lgkmcnt(0)" ::: "memory");
    __syncthreads();
    cg::this_grid().sync();
    if (threadIdx.x == 0) { __builtin_amdgcn_fence(__ATOMIC_ACQUIRE, "agent"); asm volatile("s_waitcnt vmcnt(0)" ::: "memory"); }
    __syncthreads();
}
#define GAS __attribute__((address_space(1)))
#define XB_TMO      128
#define XB_XCNT(j)  (256  + 64 * (j))
#define XB_XSUB(j)  (1280 + 64 * (j))
#define XB_XGEN(j)  (2304 + 64 * (j))
#define XB_TOP      3328
#define XB_TOPGEN   3392
#define XCD_BAR_WORDS 3456
#define XB_SPIN_CAP (1u << 18)

__device__ __forceinline__ unsigned xb_ld(unsigned* p)              { return __hip_atomic_load(p, __ATOMIC_RELAXED, __HIP_MEMORY_SCOPE_AGENT); }
__device__ __forceinline__ unsigned xb_add(unsigned* p, unsigned v) { return __hip_atomic_fetch_add(p, v, __ATOMIC_RELAXED, __HIP_MEMORY_SCOPE_AGENT); }
__device__ __forceinline__ unsigned xb_xcc_id() { return (unsigned)__builtin_amdgcn_s_getreg((3 << 11) | 20) & 0xFu; }
#define XB_SPIN(cond, bar) do { unsigned _sp = 0; while (cond) { __builtin_amdgcn_s_sleep(1); \
    if ((++_sp & 255u) == 0u) { if (xb_ld(&(bar)[XB_TMO])) break; if (_sp > XB_SPIN_CAP) { atomicAdd(&(bar)[XB_TMO], 1u); break; } } } } while (0)

struct XcdBarrier {
    unsigned* bar; unsigned x;
    volatile LAS unsigned* st;
};

__device__ __forceinline__ XcdBarrier xcd_barrier_post(unsigned* bar, volatile LAS unsigned* st) {
    XcdBarrier b; b.bar = bar; b.x = xb_xcc_id(); b.st = st;
    if (threadIdx.x == 0) (void)xb_add(&bar[XB_XCNT(b.x)], 1u);
    return b;
}
__device__ __forceinline__ void xcd_barrier_complete(unsigned* bar, unsigned x, unsigned& nloc, unsigned& nx) {
    const unsigned G = gridDim.x * gridDim.y * gridDim.z;
    unsigned sum, cnt, mine, sp = 0u;
    for (;;) {
        sum = 0u; cnt = 0u; mine = 0u;
#pragma unroll
        for (unsigned j = 0; j < 16; ++j) { const unsigned c = xb_ld(&bar[XB_XCNT(j)]); sum += c; cnt += (c > 0u) ? 1u : 0u; mine = (j == x) ? c : mine; }
        if (sum == G) break;
        __builtin_amdgcn_s_sleep(1);
        if ((++sp & 255u) == 0u) { if (xb_ld(&bar[XB_TMO])) break; if (sp > XB_SPIN_CAP) { atomicAdd(&bar[XB_TMO], 1u); break; } }
    }
    nloc = mine > 0u ? mine : 1u; nx = cnt > 0u ? cnt : 1u;
}

__device__ __forceinline__ void xcd_barrier(const XcdBarrier& b) {
    asm volatile("s_waitcnt vmcnt(0)" ::: "memory");
    __syncthreads();
    if (threadIdx.x == 0) {
        unsigned* bar = b.bar;
        __builtin_amdgcn_s_waitcnt(0);
        unsigned nloc = b.st[0], nx = b.st[1];
        if (nloc == 0u) { xcd_barrier_complete(bar, b.x, nloc, nx); b.st[0] = nloc; b.st[1] = nx; }
        const unsigned old = xb_add(&bar[XB_XSUB(b.x)], 1u);
        const unsigned gen = old / nloc;
        if (old + 1u == (gen + 1u) * nloc) {
            __builtin_amdgcn_fence(__ATOMIC_RELEASE, "agent");
            asm volatile("s_waitcnt vmcnt(0)" ::: "memory");
            const unsigned og = xb_add(&bar[XB_TOP], 1u);
            const unsigned tg = og / nx;
            if (og + 1u == (tg + 1u) * nx) xb_add(&bar[XB_TOPGEN], 1u);
            else XB_SPIN(xb_ld(&bar[XB_TOPGEN]) == tg, bar);
            __builtin_amdgcn_fence(__ATOMIC_ACQUIRE, "agent");
            xb_add(&bar[XB_XGEN(b.x)], 1u);
            asm volatile("s_waitcnt vmcnt(0)" ::: "memory");
        } else {
            XB_SPIN(xb_ld(&bar[XB_XGEN(b.x)]) == gen, bar);
            __builtin_amdgcn_fence(__ATOMIC_ACQUIRE, "agent");
            asm volatile("s_waitcnt vmcnt(0)" ::: "memory");
        }
    }
    __syncthreads();
}

__device__ __forceinline__ void gsync(LAS unsigned char* lds) {
#ifdef USE_CG_SYNC
    gsync_cg();
#else
    XcdBarrier b; b.bar = (unsigned*)get_args()->ws; b.x = xb_xcc_id(); b.st = (volatile LAS unsigned*)(lds + LDS_RING);
    xcd_barrier(b);
#endif
}
__global__ void __launch_bounds__(512, 2) mega_fwd(Args a_unused) {
    extern __shared__ __attribute__((aligned(16))) unsigned char lds_raw[];
    LAS unsigned char* lds = (LAS unsigned char*)lds_raw;

    if (threadIdx.x < 2) ((volatile LAS unsigned*)(lds + LDS_RING))[threadIdx.x] = 0u;
    __syncthreads();
    (void)xcd_barrier_post((unsigned*)get_args()->ws, (volatile LAS unsigned*)(lds + LDS_RING));
#ifdef REP_PRO
    for (int rep_ = 0; rep_ < 2; ++rep_)
#endif
    {
        ArgsP ap = get_args(); unsigned char* ws = ap->ws;
#ifdef DBG_CHECKS
        if (blockIdx.x == 0 && threadIdx.x < 32) atomicExch((unsigned*)ws + threadIdx.x, 0u);
#endif
        const int tid = threadIdx.x, lane = tid & 63, wave = __builtin_amdgcn_readfirstlane(tid >> 6), G = gridDim.x, bx = blockIdx.x, gw = bx * 8 + wave, NGW = G * 8;
        LAS float* scr = (LAS float*)(lds + wave * 16384);
        constexpr int I_FFI = 16 * 176, I_FFO = 44 * 32, I_HIN = 16 * 160, I_SQ = 16 * 32, I_MIN = 16 * 16, I_UQ = 4 * 48, I_UKV = 2 * 64;
        constexpr int NITEMS = 8 * I_FFI + 8 * I_FFO + 2 * I_HIN + 2 * I_SQ + 2 * I_MIN + 2 * I_UQ + 2 * I_UKV + 2 * I_SQ;
        for (int it = gw; it < NITEMS; it += NGW) {
            int r = it;
#define XP(IDX_, K_, NS_, ND_, MODE_, WSOFF_, NMAT_, IPM_) if (r < (NMAT_) * (IPM_)) { const int mat = r / (IPM_); \
            xpose_item(ap->in[IDX_] + (size_t)mat * (K_) * (NS_), K_, NS_, ND_, MODE_, (bf16_t*)(ws + (WSOFF_)) + (size_t)mat * (ND_) * (K_), scr, r % (IPM_), lane); continue; } r -= (NMAT_) * (IPM_);
            XP(3, 1024, 2 * DFF, 2 * DFF, 1, WS_WFFI, 8, I_FFI)
            XP(4, DFF, 1024, 1024, 0, WS_WFFO, 8, I_FFO)
            XP(11, 1024, 5120, 5120, 0, WS_WHIN, 2, I_HIN)
            XP(14, 1024, 1024, 1024, 0, WS_WHO, 2, I_SQ)
            XP(5, 1024, 448, 512, 2, WS_WMIN, 2, I_MIN)
            XP(8, 256, 1536, 1536, 3, WS_WUQ, 2, I_UQ)
            XP(9, 128, 2048, 2048, 0, WS_WUKV, 2, I_UKV)
            XP(10, 1024, 1024, 1024, 0, WS_WMO, 2, I_SQ)
#undef XP
        }
        { const int* positions = (const int*)ap->in[1]; float* COS = (float*)(ws + WS_COS); float* SIN = (float*)(ws + WS_SIN);
          for (int idx = bx * 512 + tid; idx < MT * 32; idx += G * 512) { const int m = idx >> 5, i = idx & 31;
            const double ang = (double)positions[m] * ROPE_INVF[i]; const double rev = ang * 0.15915494309189535; const float fr = (float)(rev - __builtin_rint(rev));
            COS[idx] = __builtin_amdgcn_cosf(fr); SIN[idx] = __builtin_amdgcn_sinf(fr); } }
        { float* LB = (float*)(ws + WS_LB);
          for (int idx = bx * 512 + tid; idx < 2 * 2 * 1024; idx += G * 512) { const int c = idx & 1023, dir = (idx >> 10) & 1, j = idx >> 11, l = 2 * j + 1;
            const float* lbp = ap->in[12] + (size_t)dir * DEPTH * 1024 + c; float v[4], mx = -1e30f;
#pragma unroll
            for (int i = 0; i < 4; ++i) { v[i] = lbp[i * 1024]; mx = fmaxf(mx, v[i]); }
            float den = 0.f, num = 0.f;
#pragma unroll
            for (int i = 0; i < 4; ++i) { const float e = __expf(v[i] - mx); den += e; if (i >= 1 && i <= l) num += e; }
            LB[idx] = num / den; } }
        { const float* x_in = ap->in[0]; float* X = ap->out; bf16_t* HN = (bf16_t*)(ws + WS_HN); const float* gains = ap->in[2];
          for (int m = gw; m < MT; m += NGW) row_init(x_in + (size_t)m * DM, X + (size_t)m * DM, HN + (size_t)m * DM, gains, lane); }
    }
    gsync_cg();

    for (int ph = 0; ph < 46; ++ph) {
        const int l = ph >= 35 ? 3 : (ph >= 23 ? 2 : (ph >= 12 ? 1 : 0)), s = ph - (l == 3 ? 35 : (l == 2 ? 23 : (l == 1 ? 12 : 0)));
        const bool hg = l & 1; const int j = l >> 1;
        const int op = hg ? OPS_H[s] : OPS_M[s];
        ArgsP ap = get_args(); unsigned char* ws = ap->ws; unsigned char* R = ws + WS_R;
        int G_ = gridDim.x, bx_ = blockIdx.x; asm volatile("" : "+s"(G_), "+s"(bx_));
        switch (op) {
        case OP_SW0: case OP_SW1: {
            const int half = op == OP_SW1;
            pg8::Gemm gm{(const bf16_t*)(ws + WS_HN), (const bf16_t*)(ws + WS_WFFI) + (size_t)(l * 2 + half) * (2 * DFF) * 1024, MT, 2 * DFF, 1024};
            pg8::StaticOrder S; S.init(MT, 2 * DFF, G_, bx_); EpiSwiglu E{(bf16_t*)(R + R_ACT)};
#ifndef NO_SW
            pg8::gemm_phase<EpiSwiglu, pg8::StaticOrder, true, true>(lds, gm, S, E);
#endif
        } break;
        case OP_MIN: {
            pg8::Gemm gm{(const bf16_t*)(ws + WS_HN), (const bf16_t*)(ws + WS_WMIN) + (size_t)j * 512 * 1024, MT, 512, 1024}; EpiF32 E{(float*)(R + R_C), 512};
            pg8::StaticOrder S; S.init(MT, 512, G_, bx_);
#ifndef NO_F32
            pg8::gemm_phase<EpiF32, pg8::StaticOrder, true, true>(lds, gm, S, E);
#endif
        } break;
        case OP_FO0: case OP_FO1: case OP_MWO: case OP_HWO: {
            pg8::Gemm gm; EpiB16 E{(bf16_t*)(ws + WS_YB), 1024};
            if (op == OP_FO0 || op == OP_FO1) { const int half = op == OP_FO1; gm = pg8::Gemm{(const bf16_t*)(R + R_ACT), (const bf16_t*)(ws + WS_WFFO) + (size_t)(l * 2 + half) * 1024 * DFF, MT, 1024, DFF}; }
            else if (op == OP_MWO) { gm = pg8::Gemm{(const bf16_t*)(R + R_O), (const bf16_t*)(ws + WS_WMO) + (size_t)j * 1024 * 1024, MT, 1024, 1024}; }
            else { gm = pg8::Gemm{(const bf16_t*)(R + R_HO), (const bf16_t*)(ws + WS_WHO) + (size_t)j * 1024 * 1024, MT, 1024, 1024}; }
            pg8::StaticOrder S; S.init(MT, 1024, G_, bx_);
            pg8::gemm_phase<EpiB16, pg8::StaticOrder, true, true>(lds, gm, S, E);
        } break;
        case OP_RPA: case OP_RPB: case OP_RPC: {
            const float* gains = ap->in[2]; const float* g = gains + (size_t)l * 6 * DM; const bf16_t* Y = (const bf16_t*)(ws + WS_YB); float* X = ap->out; bf16_t* HN = (bf16_t*)(ws + WS_HN);
            const int k = op == OP_RPA ? 1 : (op == OP_RPB ? 3 : 5); const float scale = op == OP_RPB ? 1.0f : 0.5f;
            const bool last = (op == OP_RPC) && (l == DEPTH - 1);
            const float* gn = op == OP_RPC ? gains + (size_t)(l + 1) * 6 * DM : g + (size_t)(k + 1) * DM;
            const int lane = LANE_;
            for (int m = bx_ * 8 + __builtin_amdgcn_readfirstlane(otid_() >> 6); m < MT; m += G_ * 8) row_post(Y + (size_t)m * DM, X + (size_t)m * DM, last ? (bf16_t*)nullptr : HN + (size_t)m * DM, scale, g + (size_t)k * DM, last ? g : gn, lane);
        } break;
        case OP_RMLA: {
            const float* qn = ap->in[6] + (size_t)j * QLR; const float* kvn = ap->in[7] + (size_t)j * KVLR; const float* COS = (const float*)(ws + WS_COS); const float* SIN = (const float*)(ws + WS_SIN);
            const int lane = LANE_;
            for (int m = bx_ * 8 + __builtin_amdgcn_readfirstlane(otid_() >> 6); m < MT; m += G_ * 8) row_mla((const float*)(R + R_C) + (size_t)m * 512, (bf16_t*)(R + R_CQ) + (size_t)m * 256, (bf16_t*)(R + R_CKV) + (size_t)m * 128, (bf16_t*)(R + R_KR) + (size_t)m * 64,
                                                         qn, kvn, COS + (size_t)m * 32, SIN + (size_t)m * 32, lane);
        } break;
        case OP_QKV: {
            { int Kq = 256; asm volatile("" : "+s"(Kq)); pg8::Gemm gm{(const bf16_t*)(R + R_CQ), (const bf16_t*)(ws + WS_WUQ) + (size_t)j * 1536 * 256, MT, 1536, Kq};
              pg8::StaticOrder S; S.init(MT, 1536, G_, bx_); EpiQ E{(bf16_t*)(R + R_QB), (const float*)(ws + WS_COS), (const float*)(ws + WS_SIN)};
#ifndef NO_Q
              pg8::gemm_phase<EpiQ, pg8::StaticOrder, true, true>(lds, gm, S, E);
#endif
            }
            __syncthreads();
            { int Kq = 128; asm volatile("" : "+s"(Kq)); pg8::Gemm gm{(const bf16_t*)(R + R_CKV), (const bf16_t*)(ws + WS_WUKV) + (size_t)j * 2048 * 128, MT, 2048, Kq};
              pg8::StaticOrder S; S.init(MT, 2048, G_, bx_); EpiKV E{(bf16_t*)(R + R_KN), (bf16_t*)(R + R_VB)};
#ifndef NO_KV
              pg8::gemm_phase<EpiKV, pg8::StaticOrder, true, true>(lds, gm, S, E);
#endif
            }
        } break;
        case OP_ATTN: {
#ifndef NO_ATTN
            const int G = G_, bx = bx_;

            const int vcu = (G % 8 == 0) ? (bx % 8) * (G / 8) + bx / 8 : bx;
#ifdef REP_ATTN
            for (int rep_ = 0; rep_ < 2; ++rep_)
#endif
            for (int uid = vcu; uid < BATCH * NH * (SEQ / 256); uid += G) {
                const int bh = uid >> 5, qb = uid & 31, b = bh >> 3, h = bh & 7;
                const size_t row0 = (size_t)b * SEQ;
                att::attn_unit((const att::bf16*)(R + R_QB) + (row0 + qb * 256) * 1536 + h * QKD, (const att::bf16*)(R + R_KN) + row0 * 1024 + h * 128,
                               (const att::bf16*)(R + R_KR) + row0 * 64, (const att::bf16*)(R + R_VB) + row0 * 1024 + h * 128,
                               (att::bf16*)(R + R_O) + (row0 + qb * 256) * 1024 + h * 128, SEQ, (char*)lds_raw);
            }
#endif
        } break;
        case OP_HIN: {
            pg8::Gemm gm{(const bf16_t*)(ws + WS_HN), (const bf16_t*)(ws + WS_WHIN) + (size_t)j * 5120 * 1024, MT, 5120, 1024};
            pg8::StaticOrder S; S.init(MT, 5120, G_, bx_);
            EpiHgrn E{(bf16_t*)(R + R_QH), (bf16_t*)(R + R_VH), (bf16_t*)(R + R_GH), (unsigned short*)(R + R_KF), (const float*)(ws + WS_LB) + (size_t)j * 2048};
#ifndef NO_HG
            pg8::gemm_phase<EpiHgrn, pg8::StaticOrder, true, true>(lds, gm, S, E);
#endif
        } break;
        case OP_SCAN: {
#ifndef NO_SCAN
#ifdef REP_SCAN
            scan_phase(lds, (const bf16_t*)(R + R_QH), (const bf16_t*)(R + R_VH), (const unsigned short*)(R + R_KF), (bf16_t*)(ws + WS_Y), G_, bx_); __syncthreads();
#endif
#ifdef SCAN_VALU
            scan_phase(lds, (const bf16_t*)(R + R_QH), (const bf16_t*)(R + R_VH), (const unsigned short*)(R + R_KF), (bf16_t*)(ws + WS_Y), G_, bx_);
#else
            scan_phase_mfma(lds, (const bf16_t*)(R + R_QH), (const bf16_t*)(R + R_VH), (const unsigned short*)(R + R_KF), (bf16_t*)(ws + WS_Y), G_, bx_);
#endif
#endif
        } break;
        case OP_RHG: {
            const float* on = ap->in[13] + (size_t)j * DM; const bf16_t* Y = (const bf16_t*)(ws + WS_Y);
            const int lane = LANE_;
            for (int m = bx_ * 8 + __builtin_amdgcn_readfirstlane(otid_() >> 6); m < MT; m += G_ * 8) row_hgrn(Y + (size_t)m * DM, (const bf16_t*)(R + R_GH) + (size_t)m * DM, (bf16_t*)(R + R_HO) + (size_t)m * DM, on, lane);
        } break;
        default: break;
        }
        if (ph != 45) gsync(lds);
#ifdef REP_SYNC
        gsync(lds);
#endif
#ifdef DBG_CHECKS
        { ArgsP ap2 = get_args(); dbg_after(l, op, ap2, ap2->ws, ap2->ws + WS_R, lds); gsync(lds); }
#endif
    }
#ifdef DBG_CHECKS
    gsync(lds);
    if (blockIdx.x == 0 && threadIdx.x == 0) { ArgsP ap = get_args(); unsigned* DBG = (unsigned*)ap->ws; const float mx = __uint_as_float(atomicAdd(DBG + 20, 0u)), mean = atomicAdd((float*)(DBG + 21), 0.f); ap->out[1024 * 16] += 1e6f * mx; ap->out[1024 * 16 + 1] += 1e4f * mean; }
#endif
}

extern "C" void kernel_launch(void* const* d_in, const int* in_sizes, int n_in, void* d_out, int out_size, void* d_ws, size_t ws_size, hipStream_t stream) {
    static int grid = 0;
    if (grid == 0) {
        if (n_in != 15 || out_size != MT * DM || ws_size < WS_END) { fprintf(stderr, "kernel_launch: unexpected shapes: n_in %d out %d ws %zu (need %zu)\n", n_in, out_size, ws_size, (size_t)WS_END); grid = -1; return; }
        int dev = 0, cus = 0, per_cu = 0;
        (void)hipGetDevice(&dev); (void)hipDeviceGetAttribute(&cus, hipDeviceAttributeMultiprocessorCount, dev);
        if (hipFuncSetAttribute((const void*)mega_fwd, hipFuncAttributeMaxDynamicSharedMemorySize, LDS_BYTES) != hipSuccess) { fprintf(stderr, "kernel_launch: hipFuncSetAttribute failed\n"); grid = -1; return; }
        if (hipOccupancyMaxActiveBlocksPerMultiprocessor(&per_cu, (const void*)mega_fwd, 512, LDS_BYTES) != hipSuccess || per_cu < 1) { fprintf(stderr, "kernel_launch: occupancy query gave %d\n", per_cu); per_cu = 1; }
        (void)hipGetLastError();
        grid = cus * 1;
        fprintf(stderr, "kernel_launch: cus %d per_cu %d grid %d\n", cus, per_cu, grid);
    }
    if (grid < 0) return;
    if (hipMemsetAsync(d_ws, 0, 65536, stream) != hipSuccess) { fprintf(stderr, "kernel_launch: memset failed\n"); return; }
    Args a{};
    for (int i = 0; i < 15; ++i) a.in[i] = (const float*)d_in[i];
    a.out = (float*)d_out; a.ws = (unsigned char*)d_ws;
    void* args[] = {&a};
    hipError_t e = hipLaunchCooperativeKernel((const void*)mega_fwd, dim3(grid), dim3(512), args, LDS_BYTES, stream);
    if (e != hipSuccess) fprintf(stderr, "cooperative launch failed: %s (grid %d)\n", hipGetErrorString(e), grid);
}
```

```cpp
#include <hip/hip_runtime.h>
#include <hip/hip_cooperative_groups.h>
#include <hip/hip_bf16.h>
#include <hip/hip_fp16.h>
#include <cstdio>
#include <cstdint>
#include <cmath>
namespace cg = cooperative_groups;
namespace pg8 {
#define PG8_LAS __attribute__((address_space(3)))
typedef unsigned short bf16_t;
typedef short bf16x8 __attribute__((ext_vector_type(8)));
typedef float f32x4 __attribute__((ext_vector_type(4)));
typedef unsigned u32x4 __attribute__((ext_vector_type(4)));
constexpr int BM = 256, BK = 64, HALF = 128, HTB = HALF * BK * 2  , STAGE_BYTES = 8 * HTB, NXCD = 8, WGM = 8;

__host__ __device__ __forceinline__ int lds_byte(int r, int c) { const int st = (r >> 4) * 2 + (c >> 5), rr = r & 15, cc = c & 31, ob = rr * 64 + cc * 2; return st * 1024 + (ob ^ (((ob >> 9) & 1) << 5)); }
__host__ __device__ __forceinline__ void stage_rc(int b, int& R, int& C) { const int st = b / 1024, sb = b % 1024, swz = sb ^ (((sb >> 9) & 1) << 5); R = (st >> 1) * 16 + swz / 64; C = (st & 1) * 32 + (swz % 64) / 2; }
__host__ __device__ __forceinline__ int perm32(int rho) { const int n = rho >> 4, i = rho & 15; return 8 * (i >> 2) + 4 * n + (i & 3); }

struct Unit { int pm, pn; };
struct Gemm { const bf16_t* A; const bf16_t* Bt; int M, N, K; };

struct StaticOrder {
    int nM, nN, nwg, G, c;
    __host__ __device__ void init(int M, int N, int G_, int c_) { nM = M / BM; nN = N / BM; nwg = nM * nN; G = G_; c = c_; }
    __host__ __device__ bool next(int i, Unit& u) const {
        const long L = (long)i * G + c; if (L >= nwg) return false;
        int wgid = (int)L; { const int q = nwg / NXCD, r = nwg % NXCD, xcd = wgid % NXCD, off = wgid / NXCD; wgid = (xcd < r ? xcd * (q + 1) : r * (q + 1) + (xcd - r) * q) + off; }
        const int nig = WGM * nN, gid = wgid / nig, fm = gid * WGM, gsz = (nM - fm) < WGM ? (nM - fm) : WGM;
        u.pm = fm + ((wgid % nig) % gsz); u.pn = (wgid % nig) / gsz; return true;
    }
    __device__ __forceinline__ void a_ready(const Unit&) const {}
    __device__ __forceinline__ void done(const Unit&) const {}
};

__device__ __forceinline__ unsigned cvt_pk_bf16(float lo, float hi) { unsigned r; asm volatile("v_cvt_pk_bf16_f32 %0, %1, %2" : "=v"(r) : "v"(lo), "v"(hi)); return r; }
template <class Epi, class Sched, bool ALIGN_EPI = false, bool SP2 = false>
__device__ __forceinline__ void gemm_phase(PG8_LAS unsigned char* lds, const Gemm g, const Sched& S, const Epi& E) {
    int tid = threadIdx.x; asm volatile("" : "+v"(tid)); const int wid = __builtin_amdgcn_readfirstlane(tid >> 6), lane = tid & 63, wr = wid >> 2, wc = wid & 3, fr = lane & 15, fq = lane >> 4;
    const int K = g.K, nt = K / BK;
    unsigned voffA[2], voffB[2];
#pragma unroll
    for (int i = 0; i < 2; ++i) { int R, C; stage_rc(tid * 16 + i * 8192, R, C); const int Rb = Epi::PERM ? ((R & ~31) + perm32(R & 31)) : R;
        voffA[i] = (unsigned)(R * K + C) * 2u; voffB[i] = (unsigned)(Rb * K + C) * 2u; }
    const size_t kstep = (size_t)(BK * 2);
    const size_t hstep = (size_t)HALF * K * 2;
    const size_t tstep = 2 * hstep;
    const unsigned ldsw = (unsigned)wid * 1024u;
    const int aoff = lds_byte(wr * 64 + fr, fq * 8), boff = lds_byte(wc * 32 + fr, fq * 8);
#define PG8_SA(b, h) (((b) * 2 + (h)) * HTB)
#define PG8_SB(b, h) ((4 + (b) * 2 + (h)) * HTB)
#define PG8_STAGE(bufoff, gbase, voff) do { _Pragma("unroll") for (int _i = 0; _i < 2; ++_i) \
        __builtin_amdgcn_global_load_lds((const unsigned*)((const char*)(gbase) + (voff)[_i]), (PG8_LAS unsigned*)(lds + (bufoff) + ldsw + _i * 8192), 16, 0, 0); } while (0)
#define PG8_LDA(dst, b, h) do { _Pragma("unroll") for (int m = 0; m < 4; ++m) _Pragma("unroll") for (int k = 0; k < 2; ++k) dst[m][k] = *(const PG8_LAS bf16x8*)(lds + PG8_SA(b, h) + aoff + m * 2048 + k * 1024); } while (0)
#define PG8_LDB(dst, b, h) do { _Pragma("unroll") for (int n = 0; n < 2; ++n) _Pragma("unroll") for (int k = 0; k < 2; ++k) dst[n][k] = *(const PG8_LAS bf16x8*)(lds + PG8_SB(b, h) + boff + n * 2048 + k * 1024); } while (0)
#define PG8_MMA(ai, bj, At, Bt) do { __builtin_amdgcn_s_setprio(1); _Pragma("unroll") for (int m = 0; m < 4; ++m) _Pragma("unroll") for (int n = 0; n < 2; ++n) _Pragma("unroll") for (int k = 0; k < 2; ++k) \
        acc[ai][bj][m][n] = __builtin_amdgcn_mfma_f32_16x16x32_bf16(Bt[n][k], At[m][k], acc[ai][bj][m][n], 0, 0, 0); __builtin_amdgcn_s_setprio(0); } while (0)
#define PG8_WAIT_V(n) asm volatile("s_waitcnt vmcnt(" #n ")" ::: "memory")
#define PG8_WAIT_L(n) asm volatile("s_waitcnt lgkmcnt(" #n ")" ::: "memory")
#define PG8_BAR __builtin_amdgcn_s_barrier()
#define PG8_SCHED __builtin_amdgcn_sched_barrier(0)
    Unit cur, nxt; int ui = 0;
    if (!S.next(0, cur)) return;
    f32x4 acc[2][2][4][2];
#pragma unroll
    for (int a = 0; a < 2; ++a)
#pragma unroll
        for (int b = 0; b < 2; ++b)
#pragma unroll
            for (int m = 0; m < 4; ++m)
#pragma unroll
                for (int n = 0; n < 2; ++n) acc[a][b][m][n] = (f32x4){0.f, 0.f, 0.f, 0.f};
    bf16x8 At[4][2], B0[2][2], B1[2][2];
    const char* cA = (const char*)g.A + (size_t)cur.pm * tstep; const char* cB = (const char*)g.Bt + (size_t)cur.pn * tstep;
    S.a_ready(cur);
    if constexpr (SP2) {
        PG8_STAGE(PG8_SB(0, 0), cB, voffB); PG8_STAGE(PG8_SB(0, 1), cB + hstep, voffB); PG8_STAGE(PG8_SA(0, 0), cA, voffA); PG8_STAGE(PG8_SA(0, 1), cA + hstep, voffA);
        if (wr == 1) PG8_BAR;
        PG8_WAIT_V(2); PG8_BAR;
        PG8_STAGE(PG8_SB(1, 0), cB + kstep, voffB); PG8_STAGE(PG8_SA(1, 0), cA + kstep, voffA); PG8_STAGE(PG8_SB(1, 1), cB + hstep + kstep, voffB);
        PG8_WAIT_V(6); PG8_BAR;
    } else {
        PG8_STAGE(PG8_SB(0, 0), cB, voffB); PG8_STAGE(PG8_SA(0, 0), cA, voffA); PG8_STAGE(PG8_SB(0, 1), cB + hstep, voffB); PG8_STAGE(PG8_SA(0, 1), cA + hstep, voffA);
        if (wr == 1) PG8_BAR;
        PG8_WAIT_V(4); PG8_BAR;
        PG8_STAGE(PG8_SB(1, 0), cB + kstep, voffB); PG8_STAGE(PG8_SA(1, 0), cA + kstep, voffA); PG8_STAGE(PG8_SB(1, 1), cB + hstep + kstep, voffB);
        PG8_WAIT_V(6); PG8_BAR;
    }
    for (;;) {
        const bool has_next = S.next(ui + 1, nxt);
        const char* nA = has_next ? (const char*)g.A + (size_t)nxt.pm * tstep : cA; const char* nB = has_next ? (const char*)g.Bt + (size_t)nxt.pn * tstep : cB;
        for (int t = 0; t < nt; t += 2) {
            const bool last = (t == nt - 2);
            const char* a1 = cA + (size_t)(t + 1) * kstep;
            const char* a2 = last ? nA : cA + (size_t)(t + 2) * kstep; const char* b2 = last ? nB : cB + (size_t)(t + 2) * kstep;
            const char* a3 = a2 + kstep; const char* b3 = b2 + kstep;
            if (last && has_next) S.a_ready(nxt);
            if constexpr (SP2) {
            PG8_LDB(B0, 0, 0); PG8_LDB(B1, 0, 1); PG8_SCHED; PG8_LDA(At, 0, 0); PG8_STAGE(PG8_SA(1, 1), a1 + hstep, voffA);
            PG8_WAIT_V(8); PG8_WAIT_L(0); PG8_BAR; PG8_MMA(0, 0, At, B0); PG8_MMA(0, 1, At, B1); PG8_BAR; PG8_SCHED;
            PG8_LDA(At, 0, 1); PG8_STAGE(PG8_SB(0, 0), b2, voffB); PG8_STAGE(PG8_SB(0, 1), b2 + hstep, voffB); PG8_STAGE(PG8_SA(0, 0), a2, voffA);
            PG8_WAIT_V(8); PG8_WAIT_L(0); PG8_BAR; PG8_MMA(1, 0, At, B0); PG8_MMA(1, 1, At, B1); PG8_BAR; PG8_SCHED;
            PG8_LDB(B0, 1, 0); PG8_LDB(B1, 1, 1); PG8_SCHED; PG8_LDA(At, 1, 0); PG8_STAGE(PG8_SA(0, 1), a2 + hstep, voffA);
            PG8_WAIT_V(8); PG8_WAIT_L(0); PG8_BAR; PG8_MMA(0, 0, At, B0); PG8_MMA(0, 1, At, B1); PG8_BAR; PG8_SCHED;
            PG8_LDA(At, 1, 1); PG8_STAGE(PG8_SB(1, 0), b3, voffB); PG8_STAGE(PG8_SB(1, 1), b3 + hstep, voffB); PG8_STAGE(PG8_SA(1, 0), a3, voffA);
            PG8_WAIT_V(8); PG8_WAIT_L(0); PG8_BAR; PG8_MMA(1, 0, At, B0); PG8_MMA(1, 1, At, B1); PG8_BAR; PG8_SCHED;
            } else {
            PG8_LDB(B0, 0, 0); PG8_SCHED; PG8_LDA(At, 0, 0); PG8_STAGE(PG8_SA(1, 1), a1 + hstep, voffA);
            PG8_WAIT_L(8); PG8_BAR; PG8_WAIT_L(0); PG8_MMA(0, 0, At, B0); PG8_BAR; PG8_SCHED;
            PG8_LDB(B1, 0, 1); PG8_STAGE(PG8_SB(0, 0), b2, voffB);
            PG8_BAR; PG8_WAIT_L(0); PG8_MMA(0, 1, At, B1); PG8_BAR;
            PG8_LDA(At, 0, 1); PG8_STAGE(PG8_SA(0, 0), a2, voffA);
            PG8_BAR; PG8_WAIT_L(0); PG8_MMA(1, 0, At, B0); PG8_BAR; PG8_SCHED;
            PG8_STAGE(PG8_SB(0, 1), b2 + hstep, voffB);
            PG8_WAIT_V(6); PG8_BAR; PG8_MMA(1, 1, At, B1); PG8_BAR;
            PG8_LDB(B0, 1, 0); PG8_SCHED; PG8_LDA(At, 1, 0); PG8_STAGE(PG8_SA(0, 1), a2 + hstep, voffA);
            PG8_WAIT_L(8); PG8_BAR; PG8_WAIT_L(0); PG8_MMA(0, 0, At, B0); PG8_BAR; PG8_SCHED;
            PG8_LDB(B1, 1, 1); PG8_STAGE(PG8_SB(1, 0), b3, voffB);
            PG8_BAR; PG8_WAIT_L(0); PG8_MMA(0, 1, At, B1); PG8_BAR;
            PG8_LDA(At, 1, 1); PG8_STAGE(PG8_SA(1, 0), a3, voffA);
            PG8_BAR; PG8_WAIT_L(0); PG8_MMA(1, 0, At, B0); PG8_BAR; PG8_SCHED;
            PG8_STAGE(PG8_SB(1, 1), b3 + hstep, voffB);
            PG8_WAIT_V(6); PG8_BAR; PG8_MMA(1, 1, At, B1); PG8_BAR;
            }
        }
        if constexpr (ALIGN_EPI) { if (wr == 0) PG8_BAR; }
        if constexpr (!Epi::AFTER_DRAIN) { E(acc, cur, wr, wc, fr, fq); S.done(cur); }
        if (!has_next) break;
#pragma unroll
        for (int a = 0; a < 2; ++a)
#pragma unroll
            for (int b = 0; b < 2; ++b)
#pragma unroll
                for (int m = 0; m < 4; ++m)
#pragma unroll
                    for (int n = 0; n < 2; ++n) acc[a][b][m][n] = (f32x4){0.f, 0.f, 0.f, 0.f};
        cur = nxt; cA = nA; cB = nB; ++ui;
        if constexpr (ALIGN_EPI) { if (wr == 1) PG8_BAR; }
    }
    PG8_WAIT_V(0);
    if constexpr (!ALIGN_EPI) { if (wr == 0) PG8_BAR; }
    PG8_BAR;
    if constexpr (Epi::AFTER_DRAIN) { E.fused(acc, cur, wr, wc, fr, fq, lds, wid, lane); S.done(cur); }
#undef PG8_SA
#undef PG8_SB
#undef PG8_STAGE
#undef PG8_LDA
#undef PG8_LDB
#undef PG8_MMA
#undef PG8_WAIT_V
#undef PG8_WAIT_L
#undef PG8_BAR
#undef PG8_SCHED
}
}
#ifndef ATT_SDEPTH
#define ATT_SDEPTH 1
#endif
namespace att {
using bf16 = __hip_bfloat16;
constexpr int NW = 8, QBLK = 32, KVBLK = 64;
constexpr float SCALE = 0.07216878364870322f;
constexpr float THR = 8.f;
__device__ __forceinline__ int otid() { int t = threadIdx.x; asm volatile("" : "+v"(t)); return t; }
using bf16x8 = __attribute__((ext_vector_type(8))) short;
using s16x4  = __attribute__((ext_vector_type(4))) short;
using f32x16 = __attribute__((ext_vector_type(16))) float;
using f32x8  = __attribute__((ext_vector_type(8))) float;
using u32x4  = __attribute__((ext_vector_type(4))) unsigned;
#define KSWZ(row, colB) ((row) * 256 + ((colB) ^ (((row) & 7) << 4)))
#define SBAR() __builtin_amdgcn_sched_barrier(0)
__device__ __forceinline__ int crow(int r, int hi) { return (r & 3) + 8 * (r >> 2) + 4 * hi; }
__device__ __forceinline__ unsigned cvtpk(float lo, float hi) {
  unsigned r; asm volatile("v_cvt_pk_bf16_f32 %0, %1, %2" : "=v"(r) : "v"(lo), "v"(hi)); return r;
}
template <typename TIn> struct Stage;
template <> struct Stage<bf16>  { using T = bf16x8;
  __device__ static __forceinline__ T ld8(const bf16* p) { return *reinterpret_cast<const bf16x8*>(p); }
  __device__ static __forceinline__ bf16x8 tobf(T x) { return x; } };
template <> struct Stage<float> { using T = f32x8;
  __device__ static __forceinline__ T ld8(const float* p) { return *reinterpret_cast<const f32x8*>(p); }
  __device__ static __forceinline__ bf16x8 tobf(T x) {
    u32x4 w = {cvtpk(x[0], x[1]), cvtpk(x[2], x[3]), cvtpk(x[4], x[5]), cvtpk(x[6], x[7])}; return *reinterpret_cast<bf16x8*>(&w); } };

__device__ __forceinline__ void partialSM(f32x16& p0, f32x16& p1, float& m_reg, float& mn, float& alpha) {
  constexpr float C = SCALE * 1.4426950408889634f;
  float pmax = p0[0]; for (int r = 1; r < 16; ++r) pmax = fmaxf(pmax, p0[r]); for (int r = 0; r < 16; ++r) pmax = fmaxf(pmax, p1[r]);
  { auto rr = __builtin_amdgcn_permlane32_swap(__float_as_uint(pmax), __float_as_uint(pmax), false, false);
    pmax = fmaxf(__uint_as_float(rr[0]), __uint_as_float(rr[1])); }
  if (__builtin_expect(__all(pmax - m_reg <= THR / SCALE), 1)) { mn = m_reg; alpha = 1.f; }
  else { mn = fmaxf(m_reg, pmax); alpha = __builtin_amdgcn_exp2f((m_reg - mn) * C); m_reg = mn; }
  float mnC = -mn * C;
  for (int r = 0; r < 16; ++r) p0[r] = fmaf(p0[r], C, mnC); for (int r = 0; r < 16; ++r) p1[r] = fmaf(p1[r], C, mnC);
  for (int r = 0; r < 16; ++r) p0[r] = __builtin_amdgcn_exp2f(p0[r]);
}
__device__ __forceinline__ void finishSM(f32x16& p0, f32x16& p1, float alpha, float& l_reg, bf16x8& pa0, bf16x8& pa1, bf16x8& pa2, bf16x8& pa3) {
  for (int r = 0; r < 16; ++r) p1[r] = __builtin_amdgcn_exp2f(p1[r]);
  float ps = 0; for (int r = 0; r < 16; ++r) ps += p0[r]; for (int r = 0; r < 16; ++r) ps += p1[r];
  { auto rr = __builtin_amdgcn_permlane32_swap(__float_as_uint(ps), __float_as_uint(ps), false, false);
    ps = __uint_as_float(rr[0]) + __uint_as_float(rr[1]); }
  l_reg = l_reg * alpha + ps;
#define PK4(P, BASE, OUT) do { unsigned a0 = cvtpk(P[BASE + 0], P[BASE + 1]), a1 = cvtpk(P[BASE + 2], P[BASE + 3]);   \
    unsigned b0 = cvtpk(P[BASE + 4], P[BASE + 5]), b1 = cvtpk(P[BASE + 6], P[BASE + 7]);                              \
    auto r0 = __builtin_amdgcn_permlane32_swap(a0, b0, false, false); auto r1 = __builtin_amdgcn_permlane32_swap(a1, b1, false, false); \
    u32x4 w = {r0[0], r1[0], r0[1], r1[1]}; OUT = *reinterpret_cast<bf16x8*>(&w); } while (0)
  PK4(p0, 0, pa0); PK4(p0, 8, pa1); PK4(p1, 0, pa2); PK4(p1, 8, pa3);
#undef PK4
}
#define KSWZ2(row, colB) ((row) * 128 + ((colB) ^ (((row) & 7) << 4)))
__device__ __forceinline__ void qkt(f32x16& p0, f32x16& p1, const bf16* Ks, const bf16* KRs, const bf16x8* qr, const bf16x8* qrl, int r32, int hi) {
  p0 = f32x16{}; p1 = f32x16{};
#pragma unroll
  for (int d0 = 0; d0 < 8; ++d0) { int cb = (d0 * 16 + hi * 8) * 2;
    bf16x8 b0 = *reinterpret_cast<const bf16x8*>((const char*)Ks + KSWZ(r32, cb));
    bf16x8 b1 = *reinterpret_cast<const bf16x8*>((const char*)Ks + KSWZ(32 + r32, cb));
    p0 = __builtin_amdgcn_mfma_f32_32x32x16_bf16(b0, qr[d0], p0, 0, 0, 0);
    p1 = __builtin_amdgcn_mfma_f32_32x32x16_bf16(b1, qr[d0], p1, 0, 0, 0); }
#pragma unroll
  for (int d0 = 0; d0 < 4; ++d0) { int cb = (d0 * 16 + hi * 8) * 2;
    bf16x8 b0 = *reinterpret_cast<const bf16x8*>((const char*)KRs + KSWZ2(r32, cb));
    bf16x8 b1 = *reinterpret_cast<const bf16x8*>((const char*)KRs + KSWZ2(32 + r32, cb));
    const bf16x8 qv = qrl[d0 * 64];
    p0 = __builtin_amdgcn_mfma_f32_32x32x16_bf16(b0, qv, p0, 0, 0, 0);
    p1 = __builtin_amdgcn_mfma_f32_32x32x16_bf16(b1, qv, p1, 0, 0, 0); }
}
__device__ __forceinline__ int v_st(int k, int c) { const int kk = (k & ~0xC) | ((k & 4) << 1) | ((k & 8) >> 1); return ((kk >> 3) * 4 + (c >> 5)) * 512 + ((kk & 7) * 32 + (c & 31)) * 2; }
__device__ __forceinline__ int v_rd_base(int lane) { return ((lane & 3) << 3) | (((lane >> 2) & 3) << 6) | (((lane >> 4) & 1) << 5) | (((lane >> 5) & 1) << 8); }
constexpr int v_rd_off(int d0, int ks, int half) { return d0 * 512 + ks * 4096 + half * 2048; }
template <int OFF> __device__ __forceinline__ s16x4 tr_read(int vb) {
  s16x4 r; asm volatile("ds_read_b64_tr_b16 %0, %1 offset:%2" : "=&v"(r) : "v"(vb), "i"(OFF) : "memory"); return r;
}
template <int D0> __device__ __forceinline__ void pv_one(f32x16& od, int vb, bf16x8 pa0, bf16x8 pa1, bf16x8 pa2, bf16x8 pa3) {
  const s16x4 l0 = tr_read<v_rd_off(D0, 0, 0)>(vb), h0 = tr_read<v_rd_off(D0, 0, 1)>(vb), l1 = tr_read<v_rd_off(D0, 1, 0)>(vb), h1 = tr_read<v_rd_off(D0, 1, 1)>(vb);
  const s16x4 l2 = tr_read<v_rd_off(D0, 2, 0)>(vb), h2 = tr_read<v_rd_off(D0, 2, 1)>(vb), l3 = tr_read<v_rd_off(D0, 3, 0)>(vb), h3 = tr_read<v_rd_off(D0, 3, 1)>(vb);
  asm volatile("s_waitcnt lgkmcnt(0)" ::: "memory"); SBAR();
#define PK(L, H) (bf16x8){L[0], L[1], L[2], L[3], H[0], H[1], H[2], H[3]}
  od = __builtin_amdgcn_mfma_f32_32x32x16_bf16(pa0, PK(l0, h0), od, 0, 0, 0);
  od = __builtin_amdgcn_mfma_f32_32x32x16_bf16(pa1, PK(l1, h1), od, 0, 0, 0);
  od = __builtin_amdgcn_mfma_f32_32x32x16_bf16(pa2, PK(l2, h2), od, 0, 0, 0);
  od = __builtin_amdgcn_mfma_f32_32x32x16_bf16(pa3, PK(l3, h3), od, 0, 0, 0);
#undef PK
}
__device__ __forceinline__ void pv_d0(f32x16* o, int vb, bf16x8 pa0, bf16x8 pa1, bf16x8 pa2, bf16x8 pa3) {
  pv_one<0>(o[0], vb, pa0, pa1, pa2, pa3); pv_one<1>(o[1], vb, pa0, pa1, pa2, pa3); pv_one<2>(o[2], vb, pa0, pa1, pa2, pa3); pv_one<3>(o[3], vb, pa0, pa1, pa2, pa3);
}
constexpr int LDQ = 1536, LDK = 1024, LDV = 1024, LDKR = 64, LDO = 1024, SDEPTH = ATT_SDEPTH;
constexpr int SHM_V = KVBLK * 128 * 2, SHM_K = KVBLK * 128 * 2, SHM_KR = KVBLK * 64 * 2;
constexpr int SHM_QR = NW * 4 * 64 * 16;
constexpr int SHM_ATTN = 2 * SHM_V + 2 * SHM_K + 2 * SHM_KR + NW * 64 * 4 + SHM_QR;
__device__ __forceinline__ void attn_unit(const bf16* __restrict__ Qb, const bf16* __restrict__ Kh, const bf16* __restrict__ KRh, const bf16* __restrict__ Vh,
                                          bf16* __restrict__ Ob, int seq, char* lds) {
  using St = Stage<bf16>;
  const int tid = otid(), wid = tid >> 6, lane = tid & 63, r32 = lane & 31, hi = lane >> 5;
  bf16* V_lds = (bf16*)lds; bf16* K_lds = (bf16*)(lds + 2 * SHM_V); bf16* KR_lds = (bf16*)(lds + 2 * SHM_V + 2 * SHM_K);
  float* ws = (float*)(lds + 2 * SHM_V + 2 * SHM_K + 2 * SHM_KR) + wid * 64; float* li_l = ws; float* al_l = ws + 32;
  float m_reg = -1e30f, l_reg = 0; f32x16 o[4] = {}; bf16x8 qr[8];
  bf16x8* qrl = (bf16x8*)(lds + 2 * SHM_V + 2 * SHM_K + 2 * SHM_KR + NW * 64 * 4) + wid * 256 + lane;
  const bf16* Qw = Qb + (long)(wid * QBLK + r32) * LDQ + hi * 8;
#pragma unroll
  for (int d0 = 0; d0 < 8; ++d0) qr[d0] = St::ld8(Qw + d0 * 16);
#pragma unroll
  for (int d0 = 0; d0 < 4; ++d0) qrl[d0 * 64] = St::ld8(Qw + 128 + d0 * 16);
  const int sr = tid >> 4, sc = (tid & 15) * 8, vst0 = v_st(sr, sc), vst1 = v_st(32 + sr, sc);
  const int krr = tid >> 3, krc = (tid & 7) * 8;
  const int vb0 = (int)(uintptr_t)V_lds + v_rd_base(lane);
  struct { bf16x8 vs0, vs1, ks0, ks1, kr; } sr_[SDEPTH];
#define SLOAD(i, k0) do { sr_[i].vs0 = St::ld8(&Vh[(long)((k0) + sr) * LDV + sc]); sr_[i].vs1 = St::ld8(&Vh[(long)((k0) + 32 + sr) * LDV + sc]); \
    sr_[i].ks0 = St::ld8(&Kh[(long)((k0) + sr) * LDK + sc]); sr_[i].ks1 = St::ld8(&Kh[(long)((k0) + 32 + sr) * LDK + sc]); \
    sr_[i].kr = St::ld8(&KRh[(long)((k0) + krr) * LDKR + krc]); } while (0)
#define SWRITE(b, i) do { *(bf16x8*)((char*)V_lds + (b) * SHM_V + vst0) = sr_[i].vs0;          \
    *(bf16x8*)((char*)V_lds + (b) * SHM_V + vst1) = sr_[i].vs1; int kc = sc * 2;               \
    *(bf16x8*)((char*)K_lds + (b) * SHM_K + KSWZ(sr, kc)) = sr_[i].ks0;                       \
    *(bf16x8*)((char*)K_lds + (b) * SHM_K + KSWZ(32 + sr, kc)) = sr_[i].ks1;                  \
    *(bf16x8*)((char*)KR_lds + (b) * SHM_KR + KSWZ2(krr, krc * 2)) = sr_[i].kr; } while (0)
#define SWAIT() do { if constexpr (SDEPTH == 2) asm volatile("s_waitcnt vmcnt(5)" ::: "memory"); else asm volatile("s_waitcnt vmcnt(0)" ::: "memory"); } while (0)
#define RESC(a) do { if (__any((a) < 1.f)) { if (hi == 0) al_l[r32] = (a); asm volatile("s_waitcnt lgkmcnt(0)" ::: "memory"); \
    _Pragma("unroll") for (int d = 0; d < 4; ++d) _Pragma("unroll") for (int r = 0; r < 16; ++r) o[d][r] *= al_l[crow(r, hi)]; } } while (0)
  f32x16 pA0, pA1, pB0, pB1; float mnA, mnB, alA, alB; bf16x8 pa0, pa1, pa2, pa3; const int NT = seq / KVBLK;
  constexpr int SE = 0, SO = SDEPTH - 1;
  SLOAD(SE, 0); asm volatile("s_waitcnt vmcnt(0)" ::: "memory"); SWRITE(0, SE); __syncthreads();
  qkt(pA0, pA1, K_lds, KR_lds, qr, qrl, r32, hi); partialSM(pA0, pA1, m_reg, mnA, alA);
  SLOAD(SO, KVBLK); if constexpr (SDEPTH == 2) { if (2 < NT) SLOAD(SE, 2 * KVBLK); }
  SWAIT(); SWRITE(1, SO); __syncthreads();
  for (int j = 1; j + 1 < NT; j += 2) {
    SBAR(); qkt(pB0, pB1, (bf16*)((char*)K_lds + SHM_K), (bf16*)((char*)KR_lds + SHM_KR), qr, qrl, r32, hi);
    finishSM(pA0, pA1, alA, l_reg, pa0, pa1, pa2, pa3); SBAR();
    SLOAD(SO, (j + SDEPTH) * KVBLK); SBAR();
    pv_d0(o, vb0, pa0, pa1, pa2, pa3); partialSM(pB0, pB1, m_reg, mnB, alB);
    __syncthreads(); SWAIT(); SWRITE(0, SE);
    RESC(alB); __syncthreads();
    SBAR(); qkt(pA0, pA1, K_lds, KR_lds, qr, qrl, r32, hi);
    finishSM(pB0, pB1, alB, l_reg, pa0, pa1, pa2, pa3); SBAR();
    if (SDEPTH == 1 || j + 3 < NT) SLOAD(SE, (j + 1 + SDEPTH) * KVBLK); SBAR();
    pv_d0(o, vb0 + (int)SHM_V, pa0, pa1, pa2, pa3); partialSM(pA0, pA1, m_reg, mnA, alA);
    __syncthreads(); SWAIT(); SWRITE(1, SO);
    RESC(alA); __syncthreads();
  }
  SBAR(); qkt(pB0, pB1, (bf16*)((char*)K_lds + SHM_K), (bf16*)((char*)KR_lds + SHM_KR), qr, qrl, r32, hi);
  finishSM(pA0, pA1, alA, l_reg, pa0, pa1, pa2, pa3); SBAR();
  pv_d0(o, vb0, pa0, pa1, pa2, pa3); partialSM(pB0, pB1, m_reg, mnB, alB);
  __syncthreads(); RESC(alB);
  finishSM(pB0, pB1, alB, l_reg, pa0, pa1, pa2, pa3); SBAR();
  pv_d0(o, vb0 + (int)SHM_V, pa0, pa1, pa2, pa3);
  if (hi == 0) li_l[r32] = l_reg; asm volatile("s_waitcnt lgkmcnt(0)" ::: "memory");
  float rli[16];
#pragma unroll
  for (int r = 0; r < 16; ++r) rli[r] = __builtin_amdgcn_rcpf(li_l[crow(r, hi)]);
  bf16* Ow = Ob + (long)(wid * QBLK) * LDO;
#pragma unroll
  for (int r = 0; r < 16; ++r) { int orow = crow(r, hi);
#pragma unroll
    for (int d0 = 0; d0 < 4; ++d0) Ow[(long)orow * LDO + d0 * 32 + r32] = __float2bfloat16(o[d0][r] * rli[r]); }
  __syncthreads();
#undef SLOAD
#undef SWRITE
#undef SWAIT
#undef RESC
}
#undef SBAR
}
constexpr int BATCH = 4, SEQ = 8192, DM = 1024, DEPTH = 4, DFF = 2816, MT = BATCH * SEQ;
constexpr int NH = 8, QLR = 256, KVLR = 128, QKD = 192;
constexpr float EPS = 1e-6f;
constexpr size_t MiB = 1u << 20;
constexpr size_t WS_WFFI = 1 * MiB;
constexpr size_t WS_WFFO = 89 * MiB;
constexpr size_t WS_WHIN = 133 * MiB;
constexpr size_t WS_WHO  = 153 * MiB;
constexpr size_t WS_WMIN = 157 * MiB;
constexpr size_t WS_WUQ  = 159 * MiB;
constexpr size_t WS_WUKV = 161 * MiB;
constexpr size_t WS_WMO  = 162 * MiB;
constexpr size_t WS_COS  = 166 * MiB;
constexpr size_t WS_SIN  = 170 * MiB;
constexpr size_t WS_LB   = 174 * MiB;
constexpr size_t WS_HN   = 176 * MiB;
constexpr size_t WS_Y    = 240 * MiB;
constexpr size_t WS_YB   = 304 * MiB;
constexpr size_t WS_R    = 368 * MiB;
constexpr size_t WS_END  = 704 * MiB;
constexpr size_t R_ACT = 0;
constexpr size_t R_C = 0, R_QB = 0, R_CQ = 96 * MiB, R_CKV = 112 * MiB, R_KR = 120 * MiB, R_KN = 124 * MiB, R_VB = 188 * MiB, R_O = 252 * MiB;
constexpr size_t R_QH = 0, R_VH = 64 * MiB, R_GH = 128 * MiB, R_KF = 192 * MiB, R_HO = 0;

constexpr int LDS_RING = 131072, LDS_BYTES = LDS_RING + 2048;
typedef unsigned short bf16_t;
typedef float f32x4 __attribute__((ext_vector_type(4)));
typedef float f32x2 __attribute__((ext_vector_type(2)));
typedef unsigned u32x4 __attribute__((ext_vector_type(4)));
typedef unsigned u32x2 __attribute__((ext_vector_type(2)));
typedef _Float16 h16x2 __attribute__((ext_vector_type(2)));
#define LAS __attribute__((address_space(3)))

__device__ __constant__ double ROPE_INVF[32] = {1.0, 0.7498942093324559, 0.5623413251903491, 0.4216965034285822, 0.31622776601683794, 0.23713737056616552, 0.1778279410038923, 0.1333521432163324, 0.1, 0.07498942093324558, 0.05623413251903491, 0.042169650342858224, 0.03162277660168379, 0.023713737056616554, 0.01778279410038923, 0.01333521432163324, 0.01, 0.007498942093324558, 0.005623413251903491, 0.004216965034285823, 0.0031622776601683794, 0.0023713737056616554, 0.0017782794100389228, 0.001333521432163324, 0.001, 0.0007498942093324559, 0.0005623413251903491, 0.00042169650342858224, 0.00031622776601683794, 0.00023713737056616554, 0.00017782794100389227, 0.0001333521432163324};

__device__ __forceinline__ unsigned pk2(float lo, float hi) { return pg8::cvt_pk_bf16(lo, hi); }
__device__ __forceinline__ float silu_f(float g) { return g * __builtin_amdgcn_rcpf(1.0f + __expf(-g)); }
__device__ __forceinline__ float wave_sum(float v) {
#pragma unroll
    for (int o = 1; o < 64; o <<= 1) v += __shfl_xor(v, o);
    return v;
}
__device__ __forceinline__ float half_sum(float v) {
#pragma unroll
    for (int o = 1; o < 32; o <<= 1) v += __shfl_xor(v, o);
    return v;
}

using pg8::Unit;
struct EpiSwiglu { static constexpr bool PERM = true, AFTER_DRAIN = false; bf16_t* O;
    __device__ __forceinline__ void operator()(const pg8::f32x4 (&acc)[2][2][4][2], const Unit& u, int wr, int wc, int fr, int fq) const {
        const int row0 = u.pm * 256 + wr * 64 + fr, col0 = u.pn * 128 + wc * 32 + 8 * fq;
#pragma unroll
        for (int ai = 0; ai < 2; ++ai)
#pragma unroll
            for (int m = 0; m < 4; ++m) { bf16_t* p = O + (size_t)(row0 + ai * 128 + m * 16) * DFF + col0;
                const pg8::f32x4 g0 = acc[ai][0][m][0], g1 = acc[ai][0][m][1], u0 = acc[ai][1][m][0], u1 = acc[ai][1][m][1];
                u32x4 w; w.x = pk2(silu_f(g0[0]) * u0[0], silu_f(g0[1]) * u0[1]); w.y = pk2(silu_f(g0[2]) * u0[2], silu_f(g0[3]) * u0[3]);
                w.z = pk2(silu_f(g1[0]) * u1[0], silu_f(g1[1]) * u1[1]); w.w = pk2(silu_f(g1[2]) * u1[2], silu_f(g1[3]) * u1[3]);
                *(u32x4*)p = w; }
    }
};
struct EpiF32 { static constexpr bool PERM = false, AFTER_DRAIN = false; float* O; int ldc;
    __device__ __forceinline__ void operator()(const pg8::f32x4 (&acc)[2][2][4][2], const Unit& u, int wr, int wc, int fr, int fq) const {
        const int row0 = u.pm * 256 + wr * 64 + fr, col0 = u.pn * 256 + wc * 32 + 4 * fq;
#pragma unroll
        for (int ai = 0; ai < 2; ++ai)
#pragma unroll
            for (int m = 0; m < 4; ++m) { float* p = O + (size_t)(row0 + ai * 128 + m * 16) * ldc + col0;
#pragma unroll
                for (int bj = 0; bj < 2; ++bj)
#pragma unroll
                    for (int n = 0; n < 2; ++n) *(pg8::f32x4*)(p + bj * 128 + n * 16) = acc[ai][bj][m][n]; }
    }
};
struct EpiB16 { static constexpr bool PERM = true, AFTER_DRAIN = false; bf16_t* O; int ldc;
    __device__ __forceinline__ void operator()(const pg8::f32x4 (&acc)[2][2][4][2], const Unit& u, int wr, int wc, int fr, int fq) const {
        const int row0 = u.pm * 256 + wr * 64 + fr, col0 = u.pn * 256 + wc * 32 + 8 * fq;
#pragma unroll
        for (int ai = 0; ai < 2; ++ai)
#pragma unroll
            for (int m = 0; m < 4; ++m) { bf16_t* p = O + (size_t)(row0 + ai * 128 + m * 16) * ldc + col0;
#pragma unroll
                for (int bj = 0; bj < 2; ++bj) { const pg8::f32x4 v0 = acc[ai][bj][m][0], v1 = acc[ai][bj][m][1];
                    u32x4 w; w.x = pk2(v0[0], v0[1]); w.y = pk2(v0[2], v0[3]); w.z = pk2(v1[0], v1[1]); w.w = pk2(v1[2], v1[3]);
                    *(u32x4*)(p + bj * 128) = w; } }
    }
};
struct EpiQ { static constexpr bool PERM = true, AFTER_DRAIN = false; bf16_t* O; const float* cs; const float* sn;
    __device__ __forceinline__ void operator()(const pg8::f32x4 (&acc)[2][2][4][2], const Unit& u, int wr, int wc, int fr, int fq) const {
        const int row0 = u.pm * 256 + wr * 64 + fr;
#pragma unroll
        for (int bj = 0; bj < 2; ++bj) { const int col0 = u.pn * 256 + bj * 128 + wc * 32 + 8 * fq, d = col0 % QKD; const bool rot = d >= 128; const int i0 = (d - 128) >> 1;
#pragma unroll
            for (int ai = 0; ai < 2; ++ai)
#pragma unroll
                for (int m = 0; m < 4; ++m) { const int row = row0 + ai * 128 + m * 16; pg8::f32x4 v0 = acc[ai][bj][m][0], v1 = acc[ai][bj][m][1];
                    if (rot) { const pg8::f32x4 c = *(const pg8::f32x4*)(cs + (size_t)row * 32 + i0), s = *(const pg8::f32x4*)(sn + (size_t)row * 32 + i0);
                        pg8::f32x4 a, b; a[0] = v0[0] * c[0] - v0[1] * s[0]; a[1] = v0[0] * s[0] + v0[1] * c[0]; a[2] = v0[2] * c[1] - v0[3] * s[1]; a[3] = v0[2] * s[1] + v0[3] * c[1];
                        b[0] = v1[0] * c[2] - v1[1] * s[2]; b[1] = v1[0] * s[2] + v1[1] * c[2]; b[2] = v1[2] * c[3] - v1[3] * s[3]; b[3] = v1[2] * s[3] + v1[3] * c[3]; v0 = a; v1 = b; }
                    u32x4 w; w.x = pk2(v0[0], v0[1]); w.y = pk2(v0[2], v0[3]); w.z = pk2(v1[0], v1[1]); w.w = pk2(v1[2], v1[3]);
                    *(u32x4*)(O + (size_t)row * 1536 + col0) = w; } }
    }
};
struct EpiKV { static constexpr bool PERM = true, AFTER_DRAIN = false; bf16_t* Kn; bf16_t* Vb;
    __device__ __forceinline__ void operator()(const pg8::f32x4 (&acc)[2][2][4][2], const Unit& u, int wr, int wc, int fr, int fq) const {
        const int row0 = u.pm * 256 + wr * 64 + fr, col0 = u.pn * 128 + wc * 32 + 8 * fq;
#pragma unroll
        for (int bj = 0; bj < 2; ++bj) { bf16_t* base = bj ? Vb : Kn;
#pragma unroll
            for (int ai = 0; ai < 2; ++ai)
#pragma unroll
                for (int m = 0; m < 4; ++m) { const pg8::f32x4 v0 = acc[ai][bj][m][0], v1 = acc[ai][bj][m][1];
                    u32x4 w; w.x = pk2(v0[0], v0[1]); w.y = pk2(v0[2], v0[3]); w.z = pk2(v1[0], v1[1]); w.w = pk2(v1[2], v1[3]);
                    *(u32x4*)(base + (size_t)(row0 + ai * 128 + m * 16) * 1024 + col0) = w; } }
    }
};
__device__ __forceinline__ unsigned pkh2(float a, float b) { const h16x2 h = {(_Float16)a, (_Float16)b}; return __builtin_bit_cast(unsigned, h); }
__device__ __forceinline__ float kgate(float om, float z) { return om * __builtin_amdgcn_rcpf(1.0f + __expf(z)); }
struct EpiHgrn { static constexpr bool PERM = true, AFTER_DRAIN = false; bf16_t* Qh; bf16_t* Vh; bf16_t* Gh; unsigned short* KF; const float* lb;
    __device__ __forceinline__ void operator()(const pg8::f32x4 (&acc)[2][2][4][2], const Unit& u, int wr, int wc, int fr, int fq) const {
        const int row0 = u.pm * 256 + wr * 64 + fr, seg = u.pn >> 2;
#pragma unroll
        for (int bj = 0; bj < 2; ++bj) { const int cc = (u.pn & 3) * 256 + bj * 128 + wc * 32 + 8 * fq;
            if (seg == 1 || seg == 2) {
                const pg8::f32x4 om0 = 1.0f - *(const pg8::f32x4*)(lb + (seg - 1) * 1024 + cc), om1 = 1.0f - *(const pg8::f32x4*)(lb + (seg - 1) * 1024 + cc + 4);
                unsigned short* base = KF + (size_t)(seg - 1) * MT * 1024;
#pragma unroll
                for (int ai = 0; ai < 2; ++ai)
#pragma unroll
                    for (int m = 0; m < 4; ++m) { const size_t off = (size_t)(row0 + ai * 128 + m * 16) * 1024 + cc; const pg8::f32x4 v0 = acc[ai][bj][m][0], v1 = acc[ai][bj][m][1];
                        u32x4 w; w.x = pkh2(kgate(om0[0], v0[0]), kgate(om0[1], v0[1])); w.y = pkh2(kgate(om0[2], v0[2]), kgate(om0[3], v0[3]));
                        w.z = pkh2(kgate(om1[0], v1[0]), kgate(om1[1], v1[1])); w.w = pkh2(kgate(om1[2], v1[2]), kgate(om1[3], v1[3]));
                        *(u32x4*)(base + off) = w; }
            } else if (seg == 3) {
#pragma unroll
                for (int ai = 0; ai < 2; ++ai)
#pragma unroll
                    for (int m = 0; m < 4; ++m) { const size_t off = (size_t)(row0 + ai * 128 + m * 16) * 1024 + cc; const pg8::f32x4 v0 = acc[ai][bj][m][0], v1 = acc[ai][bj][m][1];
                        u32x4 w; w.x = pk2(v0[0], v0[1]); w.y = pk2(v0[2], v0[3]); w.z = pk2(v1[0], v1[1]); w.w = pk2(v1[2], v1[3]);
                        *(u32x4*)(Vh + off) = w; }
            } else { bf16_t* base = seg == 0 ? Qh : Gh;
#pragma unroll
                for (int ai = 0; ai < 2; ++ai)
#pragma unroll
                    for (int m = 0; m < 4; ++m) { const size_t off = (size_t)(row0 + ai * 128 + m * 16) * 1024 + cc; const pg8::f32x4 v0 = acc[ai][bj][m][0], v1 = acc[ai][bj][m][1];
                        u32x4 w; w.x = pk2(silu_f(v0[0]), silu_f(v0[1])); w.y = pk2(silu_f(v0[2]), silu_f(v0[3])); w.z = pk2(silu_f(v1[0]), silu_f(v1[1])); w.w = pk2(silu_f(v1[2]), silu_f(v1[3]));
                        *(u32x4*)(base + off) = w; } } }
    }
};

__device__ __forceinline__ int src_col(int mode, int n) {
    if (mode == 1) { const int t = n >> 8, j = n & 255; return j < 128 ? t * 128 + j : DFF + t * 128 + (j - 128); }
    if (mode == 2) { if (n < 384) return n; if (n >= 448) return -1; const int j = n - 384; return 384 + (j >> 1) + 32 * (j & 1); }
    if (mode == 3) { const int h = n / QKD, d = n % QKD; if (d < 128) return n; const int j = d - 128; return h * QKD + 128 + (j >> 1) + 32 * (j & 1); }
    return n;
}
__device__ __forceinline__ void xpose_item(const float* __restrict__ W, int K, int Nsrc, int Ndst, int mode, bf16_t* __restrict__ WT, LAS float* scr, int item, int lane) {
    const int nblk = Ndst / 32, kb = item / nblk, nb = item % nblk, k0 = 64 * kb, n0 = 32 * nb;
    if (mode <= 1) {
        const int sc0 = src_col(mode, n0) + (lane & 7) * 4;
#pragma unroll
        for (int i = 0; i < 8; ++i) { const int kk = 8 * i + (lane >> 3); const f32x4 v = *(const f32x4*)(W + (size_t)(k0 + kk) * Nsrc + sc0);
            LAS float* d = scr + kk * 33 + (lane & 7) * 4; d[0] = v[0]; d[1] = v[1]; d[2] = v[2]; d[3] = v[3]; }
    } else {
        const int sc = src_col(mode, n0 + (lane & 31));
#pragma unroll 8
        for (int i = 0; i < 32; ++i) { const int kk = 2 * i + (lane >> 5); scr[kk * 33 + (lane & 31)] = sc >= 0 ? W[(size_t)(k0 + kk) * Nsrc + sc] : 0.f; }
    }
    asm volatile("s_waitcnt lgkmcnt(0)" ::: "memory");
    const int c = lane & 7;
#pragma unroll
    for (int j = 0; j < 4; ++j) { const int n = (lane >> 3) + 8 * j; const LAS float* s = scr + (8 * c) * 33 + n;
        u32x4 o; o.x = pk2(s[0 * 33], s[1 * 33]); o.y = pk2(s[2 * 33], s[3 * 33]); o.z = pk2(s[4 * 33], s[5 * 33]); o.w = pk2(s[6 * 33], s[7 * 33]);
        *(u32x4*)(WT + (size_t)(n0 + n) * K + k0 + 8 * c) = o; }
    asm volatile("s_waitcnt lgkmcnt(0)" ::: "memory");
}

__device__ __forceinline__ void row_init(const float* __restrict__ xin, float* __restrict__ X, bf16_t* __restrict__ HN, const float* __restrict__ g, int lane) {
    const f32x4* xr = (const f32x4*)xin + lane; f32x4 v[4]; float s = 0.f;
#pragma unroll
    for (int j = 0; j < 4; ++j) { v[j] = xr[64 * j]; s += (v[j][0] * v[j][0] + v[j][1] * v[j][1]) + (v[j][2] * v[j][2] + v[j][3] * v[j][3]); }
    const float r = rsqrtf(wave_sum(s) * (1.f / DM) + EPS);
#pragma unroll
    for (int j = 0; j < 4; ++j) { ((f32x4*)X + lane)[64 * j] = v[j]; const f32x4 gg = ((const f32x4*)g + lane)[64 * j];
        u32x2 w; w.x = pk2(v[j][0] * r * gg[0], v[j][1] * r * gg[1]); w.y = pk2(v[j][2] * r * gg[2], v[j][3] * r * gg[3]); ((u32x2*)HN + lane)[64 * j] = w; }
}
__device__ __forceinline__ void row_post(const bf16_t* __restrict__ Y, float* __restrict__ X, bf16_t* __restrict__ HN, float scale, const float* __restrict__ gp, const float* __restrict__ gn, int lane) {
    f32x4 y[4], x[4]; float s = 0.f;
#pragma unroll
    for (int j = 0; j < 4; ++j) { const u32x2 yb = ((const u32x2*)Y + lane)[64 * j]; y[j] = (f32x4){__uint_as_float(yb.x << 16), __uint_as_float(yb.x & 0xffff0000u), __uint_as_float(yb.y << 16), __uint_as_float(yb.y & 0xffff0000u)};
        x[j] = ((const f32x4*)X + lane)[64 * j]; s += (y[j][0] * y[j][0] + y[j][1] * y[j][1]) + (y[j][2] * y[j][2] + y[j][3] * y[j][3]); }
    const float r = rsqrtf(wave_sum(s) * (1.f / DM) + EPS) * scale; float s2 = 0.f;
#pragma unroll
    for (int j = 0; j < 4; ++j) { const f32x4 gg = ((const f32x4*)gp + lane)[64 * j]; x[j] = x[j] + y[j] * r * gg; ((f32x4*)X + lane)[64 * j] = x[j];
        s2 += (x[j][0] * x[j][0] + x[j][1] * x[j][1]) + (x[j][2] * x[j][2] + x[j][3] * x[j][3]); }
    if (HN) { const float r2 = rsqrtf(wave_sum(s2) * (1.f / DM) + EPS);
#pragma unroll
        for (int j = 0; j < 4; ++j) { const f32x4 gg = ((const f32x4*)gn + lane)[64 * j];
            u32x2 w; w.x = pk2(x[j][0] * r2 * gg[0], x[j][1] * r2 * gg[1]); w.y = pk2(x[j][2] * r2 * gg[2], x[j][3] * r2 * gg[3]); ((u32x2*)HN + lane)[64 * j] = w; } }
}
template <int NR>
__device__ __forceinline__ void row_post_n(const bf16_t* __restrict__ Y, float* __restrict__ X, bf16_t* __restrict__ HN, size_t row_stride, float scale, const float* __restrict__ gp, const float* __restrict__ gn, int lane) {
    f32x4 y[NR][4], x[NR][4]; float s[NR];
#pragma unroll
    for (int i = 0; i < NR; ++i) {
#pragma unroll
        for (int j = 0; j < 4; ++j) { const u32x2 yb = ((const u32x2*)(Y + i * row_stride) + lane)[64 * j];
            y[i][j] = (f32x4){__uint_as_float(yb.x << 16), __uint_as_float(yb.x & 0xffff0000u), __uint_as_float(yb.y << 16), __uint_as_float(yb.y & 0xffff0000u)};
            x[i][j] = ((const f32x4*)(X + i * row_stride) + lane)[64 * j]; } }
    f32x4 gpv[4];
#pragma unroll
    for (int j = 0; j < 4; ++j) gpv[j] = ((const f32x4*)gp + lane)[64 * j];
#pragma unroll
    for (int i = 0; i < NR; ++i) { float a = 0.f;
#pragma unroll
        for (int j = 0; j < 4; ++j) a += (y[i][j][0] * y[i][j][0] + y[i][j][1] * y[i][j][1]) + (y[i][j][2] * y[i][j][2] + y[i][j][3] * y[i][j][3]);
        s[i] = a; }
#pragma unroll
    for (int o = 1; o < 64; o <<= 1) {
#pragma unroll
        for (int i = 0; i < NR; ++i) s[i] += __shfl_xor(s[i], o); }
    float s2[NR];
#pragma unroll
    for (int i = 0; i < NR; ++i) { const float r = rsqrtf(s[i] * (1.f / DM) + EPS) * scale; float a = 0.f;
#pragma unroll
        for (int j = 0; j < 4; ++j) { x[i][j] = x[i][j] + y[i][j] * r * gpv[j]; ((f32x4*)(X + i * row_stride) + lane)[64 * j] = x[i][j];
            a += (x[i][j][0] * x[i][j][0] + x[i][j][1] * x[i][j][1]) + (x[i][j][2] * x[i][j][2] + x[i][j][3] * x[i][j][3]); }
        s2[i] = a; }
    if (HN) {
#pragma unroll
        for (int j = 0; j < 4; ++j) gpv[j] = ((const f32x4*)gn + lane)[64 * j];
#pragma unroll
        for (int o = 1; o < 64; o <<= 1) {
#pragma unroll
            for (int i = 0; i < NR; ++i) s2[i] += __shfl_xor(s2[i], o); }
#pragma unroll
        for (int i = 0; i < NR; ++i) { const float r2 = rsqrtf(s2[i] * (1.f / DM) + EPS);
#pragma unroll
            for (int j = 0; j < 4; ++j) { u32x2 w; w.x = pk2(x[i][j][0] * r2 * gpv[j][0], x[i][j][1] * r2 * gpv[j][1]); w.y = pk2(x[i][j][2] * r2 * gpv[j][2], x[i][j][3] * r2 * gpv[j][3]);
                ((u32x2*)(HN + i * row_stride) + lane)[64 * j] = w; } } }
}
__device__ __forceinline__ void row_mla(const float* __restrict__ C, bf16_t* __restrict__ CQ, bf16_t* __restrict__ CKV, bf16_t* __restrict__ KR, const float* __restrict__ qn, const float* __restrict__ kvn,
                                        const float* __restrict__ cs, const float* __restrict__ sn, int lane) {
    const f32x4 a = ((const f32x4*)C)[2 * lane], b = ((const f32x4*)C)[2 * lane + 1];
    float s = (a[0] * a[0] + a[1] * a[1]) + (a[2] * a[2] + a[3] * a[3]) + (b[0] * b[0] + b[1] * b[1]) + (b[2] * b[2] + b[3] * b[3]);
#pragma unroll
    for (int o = 1; o < 16; o <<= 1) s += __shfl_xor(s, o);
    const float s16 = s, s32 = s16 + __shfl_xor(s16, 16);
    float v[8] = {a[0], a[1], a[2], a[3], b[0], b[1], b[2], b[3]};
    if (lane < 32) { const float r = rsqrtf(s32 * (1.f / QLR) + EPS); const f32x4 g0 = ((const f32x4*)qn)[2 * lane], g1 = ((const f32x4*)qn)[2 * lane + 1];
        u32x4 w; w.x = pk2(v[0] * r * g0[0], v[1] * r * g0[1]); w.y = pk2(v[2] * r * g0[2], v[3] * r * g0[3]); w.z = pk2(v[4] * r * g1[0], v[5] * r * g1[1]); w.w = pk2(v[6] * r * g1[2], v[7] * r * g1[3]);
        ((u32x4*)CQ)[lane] = w;
    } else if (lane < 48) { const int l = lane - 32; const float r = rsqrtf(s16 * (1.f / KVLR) + EPS); const f32x4 g0 = ((const f32x4*)kvn)[2 * l], g1 = ((const f32x4*)kvn)[2 * l + 1];
        u32x4 w; w.x = pk2(v[0] * r * g0[0], v[1] * r * g0[1]); w.y = pk2(v[2] * r * g0[2], v[3] * r * g0[3]); w.z = pk2(v[4] * r * g1[0], v[5] * r * g1[1]); w.w = pk2(v[6] * r * g1[2], v[7] * r * g1[3]);
        ((u32x4*)CKV)[l] = w;
    } else if (lane < 56) { const int l = lane - 48; const f32x4 c = ((const f32x4*)cs)[l], sv = ((const f32x4*)sn)[l];
        u32x4 w; w.x = pk2(v[0] * c[0] - v[1] * sv[0], v[0] * sv[0] + v[1] * c[0]); w.y = pk2(v[2] * c[1] - v[3] * sv[1], v[2] * sv[1] + v[3] * c[1]);
        w.z = pk2(v[4] * c[2] - v[5] * sv[2], v[4] * sv[2] + v[5] * c[2]); w.w = pk2(v[6] * c[3] - v[7] * sv[3], v[6] * sv[3] + v[7] * c[3]);
        ((u32x4*)KR)[l] = w; }
}
__device__ __forceinline__ void row_hgrn(const bf16_t* __restrict__ Oa, const bf16_t* __restrict__ Gh, bf16_t* __restrict__ HO, const float* __restrict__ on, int lane) {
#pragma unroll
    for (int j = 0; j < 4; ++j) { const u32x2 a = ((const u32x2*)Oa + lane)[64 * j], b = ((const u32x2*)(Oa + (size_t)MT * 1024) + lane)[64 * j];
        f32x4 o; o[0] = __uint_as_float(a.x << 16) + __uint_as_float(b.x << 16); o[1] = __uint_as_float(a.x & 0xffff0000u) + __uint_as_float(b.x & 0xffff0000u);
        o[2] = __uint_as_float(a.y << 16) + __uint_as_float(b.y << 16); o[3] = __uint_as_float(a.y & 0xffff0000u) + __uint_as_float(b.y & 0xffff0000u);
        const float s = half_sum((o[0] * o[0] + o[1] * o[1]) + (o[2] * o[2] + o[3] * o[3]));
        const float r = rsqrtf(s * (1.f / 128.f) + EPS); const f32x4 gg = ((const f32x4*)on + lane)[64 * j]; const u32x2 gb = ((const u32x2*)Gh + lane)[64 * j];
        const float g0 = __uint_as_float(gb.x << 16), g1 = __uint_as_float(gb.x & 0xffff0000u), g2 = __uint_as_float(gb.y << 16), g3 = __uint_as_float(gb.y & 0xffff0000u);
        u32x2 w; w.x = pk2(o[0] * r * gg[0] * g0, o[1] * r * gg[1] * g1); w.y = pk2(o[2] * r * gg[2] * g2, o[3] * r * gg[3] * g3); ((u32x2*)HO + lane)[64 * j] = w; }
}
__device__ __forceinline__ f32x2 h2f2_(unsigned u) { const h16x2 h = __builtin_bit_cast(h16x2, u); return (f32x2){(float)h[0], (float)h[1]}; }
__device__ __forceinline__ void scan_phase(LAS unsigned char* lds, const bf16_t* __restrict__ Qh, const bf16_t* __restrict__ Vh, const unsigned short* __restrict__ KF, bf16_t* __restrict__ OP, int G, int bx) {
    int tid = threadIdx.x; asm volatile("" : "+v"(tid)); const int wid = __builtin_amdgcn_readfirstlane(tid >> 6), lane = tid & 63;
    const int st = tid >> 4, sc8 = (tid & 15) * 8, sv = tid >> 3, vc4 = (tid & 7) * 4;
    constexpr int OFF_K = 16384, OFF_Q = 32768, OFF_V = 49152, OFF_P = 53248;
    for (int item = bx; item < 256; item += G) {
        const int dir = item & 1, dvq = (item >> 1) & 3, h = (item >> 3) & 7, b = item >> 6;
        const size_t kcol = h * 128 + sc8, vcol = h * 128 + dvq * 32 + vc4;
        const unsigned short* KFd = KF + (size_t)dir * MT * 1024; bf16_t* OPd = OP + (size_t)dir * MT * 1024;
        u32x4 rk, rq; u32x2 rv = {0u, 0u};
#define SC_GLOAD(blk) do { { const int tt = (blk) * 32 + st; const size_t m = (size_t)b * SEQ + (dir ? SEQ - 1 - tt : tt); \
        rk = *(const u32x4*)(KFd + m * 1024 + kcol); rq = *(const u32x4*)(Qh + m * 1024 + kcol); } \
        if (tid < 256) { const int tt = (blk) * 32 + sv; const size_t m = (size_t)b * SEQ + (dir ? SEQ - 1 - tt : tt); rv = *(const u32x2*)(Vh + m * 1024 + vcol); } } while (0)
#define SC_H2F(u_) h2f2_(u_)
#define SC_LWRITE() do { LAS unsigned char* B_ = lds + (st * 128 + sc8) * 4; \
        const f32x2 ka = SC_H2F(rk.x), kb = SC_H2F(rk.y), kc = SC_H2F(rk.z), kd = SC_H2F(rk.w); \
        const f32x4 k0_ = {ka[0], ka[1], kb[0], kb[1]}, k1_ = {kc[0], kc[1], kd[0], kd[1]}; \
        *(LAS f32x4*)(B_ + OFF_K) = k0_; *(LAS f32x4*)(B_ + OFF_K + 16) = k1_; \
        *(LAS f32x4*)(B_ + OFF_Q) = (f32x4){__uint_as_float(rq.x << 16), __uint_as_float(rq.x & 0xffff0000u), __uint_as_float(rq.y << 16), __uint_as_float(rq.y & 0xffff0000u)}; \
        *(LAS f32x4*)(B_ + OFF_Q + 16) = (f32x4){__uint_as_float(rq.z << 16), __uint_as_float(rq.z & 0xffff0000u), __uint_as_float(rq.w << 16), __uint_as_float(rq.w & 0xffff0000u)}; \
        if (tid < 256) *(LAS f32x4*)(lds + OFF_V + (sv * 32 + vc4) * 4) = (f32x4){__uint_as_float(rv.x << 16), __uint_as_float(rv.x & 0xffff0000u), __uint_as_float(rv.y << 16), __uint_as_float(rv.y & 0xffff0000u)}; } while (0)
        SC_GLOAD(0);
        const int dksub = ((lane >> 3) & 1) | ((lane >> 5) << 1), dvp = (lane & 7) | (((lane >> 4) & 1) << 3);
        const LAS unsigned char* Bc = lds + (16 * wid + 4 * dksub) * 4;
        const LAS unsigned char* Vc = lds + OFF_V + dvp * 8;
        LAS unsigned char* Pw = lds + OFF_P + (wid * 4 + dksub) * 2048 + dvp * 4;
        f32x2 S2[4];
#pragma unroll
        for (int j = 0; j < 4; ++j) S2[j] = (f32x2){0.f, 0.f};
        for (int blk = 0; blk < SEQ / 32; ++blk) {
            SC_LWRITE();
            if (blk + 1 < SEQ / 32) SC_GLOAD(blk + 1);
            __syncthreads();
            f32x4 k4n = *(const LAS f32x4*)(Bc + OFF_K), q4n = *(const LAS f32x4*)(Bc + OFF_Q); f32x2 v2n = *(const LAS f32x2*)(Vc);
            f32x4 k4m = *(const LAS f32x4*)(Bc + OFF_K + 512), q4m = *(const LAS f32x4*)(Bc + OFF_Q + 512); f32x2 v2m = *(const LAS f32x2*)(Vc + 128);
#pragma unroll
            for (int t = 0; t < 32; ++t) {
                const f32x4 k4 = k4n, q4 = q4n; const f32x2 v2 = v2n;
                k4n = k4m; q4n = q4m; v2n = v2m;
                { const int tn = (t + 2) & 31;
                  k4m = *(const LAS f32x4*)(Bc + OFF_K + tn * 512); q4m = *(const LAS f32x4*)(Bc + OFF_Q + tn * 512); v2m = *(const LAS f32x2*)(Vc + tn * 128); }
                __builtin_amdgcn_sched_barrier(0);
#pragma unroll
                for (int j = 0; j < 4; ++j) S2[j] = S2[j] + (v2 - S2[j]) * k4[j];
                const f32x2 o2 = (S2[0] * q4[0] + S2[1] * q4[1]) + (S2[2] * q4[2] + S2[3] * q4[3]);
                *(LAS unsigned*)(Pw + t * 64) = pk2(o2[0], o2[1]);
            }
            __syncthreads();
            if (tid < 256) { const LAS unsigned char* Pr = lds + OFF_P + (sv * 32 + vc4) * 2; f32x4 acc = {0.f, 0.f, 0.f, 0.f};
#pragma unroll
              for (int g = 0; g < 32; ++g) { const u32x2 pv = *(const LAS u32x2*)(Pr + g * 2048);
                  acc[0] += __uint_as_float(pv.x << 16); acc[1] += __uint_as_float(pv.x & 0xffff0000u); acc[2] += __uint_as_float(pv.y << 16); acc[3] += __uint_as_float(pv.y & 0xffff0000u); }
              const int tt = blk * 32 + sv; const size_t m = (size_t)b * SEQ + (dir ? SEQ - 1 - tt : tt);
              u32x2 w; w.x = pk2(acc[0], acc[1]); w.y = pk2(acc[2], acc[3]); *(u32x2*)(OPd + m * 1024 + vcol) = w; }
        }
        __syncthreads();
#undef SC_GLOAD
#undef SC_LWRITE
#undef SC_H2F
    }
}

typedef float f32x16 __attribute__((ext_vector_type(16)));
typedef short s16x8 __attribute__((ext_vector_type(8)));
__device__ __forceinline__ int crow_(int r, int hi) { return (r & 3) + 8 * (r >> 2) + 4 * hi; }
template <int KSTEPS, int I0 = 0>
__device__ __forceinline__ void mm_tile(f32x16& c, const LAS unsigned char* X, int xstride, const LAS unsigned char* Y, int ystride, int r32, int hi) {
#pragma unroll
    for (int i = I0; i < I0 + KSTEPS; ++i) { const s16x8 x = *(const LAS s16x8*)(X + r32 * xstride + (16 * i + 8 * hi) * 2), y = *(const LAS s16x8*)(Y + r32 * ystride + (16 * i + 8 * hi) * 2);
        c = __builtin_amdgcn_mfma_f32_32x32x16_bf16(x, y, c, 0, 0, 0); }
}
__device__ __forceinline__ void scan_phase_mfma(LAS unsigned char* lds, const bf16_t* __restrict__ Qh, const bf16_t* __restrict__ Vh, const unsigned short* __restrict__ KF, bf16_t* __restrict__ OP, int G, int bx) {
    int tid = threadIdx.x; asm volatile("" : "+v"(tid)); const int wid = __builtin_amdgcn_readfirstlane(tid >> 6), lane = tid & 63, r32 = lane & 31, hi = lane >> 5;
    const bool grpA = wid < 4;
    const int st = (tid >> 3) & 31, sc16 = (tid & 7) * 16, vc4 = (tid & 7) * 4;
    constexpr int SQ = 272, SV = 80, NC = SEQ / 32;
    constexpr int IMG = 2 * 32 * SQ + 128 * SV + 128 + 32 * SV + 512;
    constexpr int O_LG = 0, O_IMG = 16384, O_AT = O_IMG + 2 * IMG, O_ST = O_AT + 32 * SV;
    constexpr int I_QT = 0, I_KT = 32 * SQ, I_KTT = 2 * 32 * SQ, I_VT = I_KTT + 128 * SV + 128, I_G = I_VT + 32 * SV;
    static_assert(O_ST + 32 * SQ <= LDS_RING && IMG % 16 == 0, "scan LDS map");
    for (int item = bx; item < 256; item += G) {
        const int dir = item & 1, dvq = (item >> 1) & 3, h = (item >> 3) & 7, b = item >> 6;
        const size_t kcol = h * 128 + sc16, vcol = h * 128 + dvq * 32 + vc4;
        const unsigned short* KFd = KF + (size_t)dir * MT * 1024; bf16_t* OPd = OP + (size_t)dir * MT * 1024;
        u32x4 rk0, rk1, rq0, rq1; u32x2 rv;
#define SM_GLOAD(blk) do { const int tt = (blk) * 32 + st; const size_t m = (size_t)b * SEQ + (dir ? SEQ - 1 - tt : tt); \
        rk0 = *(const u32x4*)(KFd + m * 1024 + kcol); rk1 = *(const u32x4*)(KFd + m * 1024 + kcol + 8); rq0 = *(const u32x4*)(Qh + m * 1024 + kcol); rq1 = *(const u32x4*)(Qh + m * 1024 + kcol + 8); \
        rv = *(const u32x2*)(Vh + m * 1024 + vcol); } while (0)
        if (grpA) SM_GLOAD(0);
        f32x16 accS, accO;
#pragma unroll
        for (int r = 0; r < 16; ++r) { accS[r] = 0.f; accO[r] = 0.f; }
        for (int i = tid; i < 32 * SQ / 4; i += 512) ((LAS unsigned*)(lds + O_ST))[i] = 0u;
        __syncthreads();
        for (int rd = -1; rd < NC; ++rd) {
            const int cn = rd + 1;
            LAS unsigned char* Wi = lds + O_IMG + (cn & 1) * IMG;
            const LAS unsigned char* Ri = lds + O_IMG + (rd & 1) * IMG;
            float kf[16];
            if (grpA) { if (cn < NC) {
                { const f32x2 a = h2f2_(rk0.x), bq = h2f2_(rk0.y), c = h2f2_(rk0.z), d = h2f2_(rk0.w), e = h2f2_(rk1.x), f = h2f2_(rk1.y), g2 = h2f2_(rk1.z), h2 = h2f2_(rk1.w);
                  kf[0] = a[0]; kf[1] = a[1]; kf[2] = bq[0]; kf[3] = bq[1]; kf[4] = c[0]; kf[5] = c[1]; kf[6] = d[0]; kf[7] = d[1];
                  kf[8] = e[0]; kf[9] = e[1]; kf[10] = f[0]; kf[11] = f[1]; kf[12] = g2[0]; kf[13] = g2[1]; kf[14] = h2[0]; kf[15] = h2[1]; }
                LAS unsigned char* L_ = lds + O_LG + (st * 128 + sc16) * 4;
#pragma unroll
                for (int q4 = 0; q4 < 4; ++q4) { f32x4 a4;
#pragma unroll
                    for (int e = 0; e < 4; ++e) a4[e] = 1.0f - kf[4 * q4 + e];
                    *(LAS f32x4*)(L_ + 16 * q4) = a4; }
                LAS unsigned char* V_ = Wi + I_VT + st * 2;
                *(LAS unsigned short*)(V_ + (vc4 + 0) * SV) = (unsigned short)(rv.x & 0xffffu); *(LAS unsigned short*)(V_ + (vc4 + 1) * SV) = (unsigned short)(rv.x >> 16);
                *(LAS unsigned short*)(V_ + (vc4 + 2) * SV) = (unsigned short)(rv.y & 0xffffu); *(LAS unsigned short*)(V_ + (vc4 + 3) * SV) = (unsigned short)(rv.y >> 16);
            } } else if (rd >= 0) {
                const int w4 = wid - 4;
                mm_tile<2>(accS, Ri + I_KTT + w4 * 32 * SV + (2 * w4 + (r32 >> 4)) * 16, SV, Ri + I_VT, SV, r32, hi);
                if (w4 == 0) { f32x16 pa, pb;
#pragma unroll
                    for (int r = 0; r < 16; ++r) { pa[r] = 0.f; pb[r] = 0.f; }
                    mm_tile<4, 0>(pa, Ri + I_KT, SQ, Ri + I_QT, SQ, r32, hi); mm_tile<4, 4>(pb, Ri + I_KT, SQ, Ri + I_QT, SQ, r32, hi);
#pragma unroll
                    for (int g = 0; g < 4; ++g) { const int s0 = 8 * g + 4 * hi; float v4[4];
#pragma unroll
                        for (int e = 0; e < 4; ++e) v4[e] = (s0 + e) <= r32 ? pa[4 * g + e] + pb[4 * g + e] : 0.f;
                        u32x2 w; w.x = pk2(v4[0], v4[1]); w.y = pk2(v4[2], v4[3]); *(LAS u32x2*)(lds + O_AT + r32 * SV + s0 * 2) = w; } }
                else if (w4 == 1) { f32x16 ob;
#pragma unroll
                    for (int r = 0; r < 16; ++r) { accO[r] = 0.f; ob[r] = 0.f; }
                    mm_tile<4, 0>(accO, lds + O_ST, SQ, Ri + I_QT, SQ, r32, hi); mm_tile<4, 4>(ob, lds + O_ST, SQ, Ri + I_QT, SQ, r32, hi);
#pragma unroll
                    for (int r = 0; r < 16; ++r) accO[r] += ob[r]; }
            }
            __syncthreads();
            if (grpA) { if (cn < NC) {
#pragma unroll
                for (int u = 0; u < 2; ++u) { LAS float* col = (LAS float*)(lds + O_LG) + (tid & 127) + (((tid >> 7) & 1) + 2 * u) * 8 * 128; float acc = 1.f;
#pragma unroll
                    for (int t = 0; t < 8; ++t) { acc *= col[t * 128]; col[t * 128] = acc; } }
            } } else if (rd >= 0) {
                const int w4 = wid - 4;
                if (w4 == 1) { mm_tile<2>(accO, Ri + I_VT, SV, lds + O_AT, SV, r32, hi);
                    asm volatile("s_nop 15\n\ts_nop 7" : "+v"(accO));
                    const int tt = rd * 32 + r32; const size_t m = (size_t)b * SEQ + (dir ? SEQ - 1 - tt : tt); bf16_t* orow = OPd + m * 1024 + h * 128 + dvq * 32;
#pragma unroll
                    for (int g = 0; g < 4; ++g) { u32x2 w; w.x = pk2(accO[4 * g + 0], accO[4 * g + 1]); w.y = pk2(accO[4 * g + 2], accO[4 * g + 3]); *(u32x2*)(orow + 8 * g + 4 * hi) = w; } }
            }
            __syncthreads();
            if (grpA) { if (cn < NC)
#ifdef REP_A3
            for (int rep_ = 0; rep_ < 2; ++rep_)
#endif
            {
                const LAS unsigned char* L_ = lds + O_LG + (st * 128 + sc16) * 4; float bb[16];
#pragma unroll
                for (int q4 = 0; q4 < 4; ++q4) { const f32x4 t4 = *(const LAS f32x4*)(L_ + 16 * q4); bb[4 * q4] = t4[0]; bb[4 * q4 + 1] = t4[1]; bb[4 * q4 + 2] = t4[2]; bb[4 * q4 + 3] = t4[3]; }
#pragma unroll
                for (int qd = 0; qd < 3; ++qd) { const LAS unsigned char* T_ = lds + O_LG + ((8 * qd + 7) * 128 + sc16) * 4; const bool on = (st >> 3) > qd;
#pragma unroll
                    for (int q4 = 0; q4 < 4; ++q4) { const f32x4 t4 = *(const LAS f32x4*)(T_ + 16 * q4);
                        bb[4 * q4] *= on ? t4[0] : 1.f; bb[4 * q4 + 1] *= on ? t4[1] : 1.f; bb[4 * q4 + 2] *= on ? t4[2] : 1.f; bb[4 * q4 + 3] *= on ? t4[3] : 1.f; } }
                const unsigned qraw[8] = {rq0.x, rq0.y, rq0.z, rq0.w, rq1.x, rq1.y, rq1.z, rq1.w};
                unsigned qw[8], kw[8];
#pragma unroll
                for (int e = 0; e < 8; ++e) { const float e0 = bb[2 * e], e1 = bb[2 * e + 1];
                    qw[e] = pk2(__uint_as_float(qraw[e] << 16) * e0, __uint_as_float(qraw[e] & 0xffff0000u) * e1);
                    kw[e] = pk2(kf[2 * e] * __builtin_amdgcn_rcpf(e0), kf[2 * e + 1] * __builtin_amdgcn_rcpf(e1));
                    if (st == 31) { ((LAS float*)(Wi + I_G))[sc16 + 2 * e] = e0; ((LAS float*)(Wi + I_G))[sc16 + 2 * e + 1] = e1; } }
                *(LAS u32x4*)(Wi + I_QT + st * SQ + sc16 * 2) = (u32x4){qw[0], qw[1], qw[2], qw[3]}; *(LAS u32x4*)(Wi + I_QT + st * SQ + sc16 * 2 + 16) = (u32x4){qw[4], qw[5], qw[6], qw[7]};
                *(LAS u32x4*)(Wi + I_KT + st * SQ + sc16 * 2) = (u32x4){kw[0], kw[1], kw[2], kw[3]}; *(LAS u32x4*)(Wi + I_KT + st * SQ + sc16 * 2 + 16) = (u32x4){kw[4], kw[5], kw[6], kw[7]};
                LAS unsigned char* T_ = Wi + I_KTT + sc16 * SV + (sc16 >> 4) * 16 + st * 2;
#pragma unroll
                for (int e = 0; e < 8; ++e) { *(LAS unsigned short*)(T_ + (2 * e) * SV) = (unsigned short)(kw[e] & 0xffffu); *(LAS unsigned short*)(T_ + (2 * e + 1) * SV) = (unsigned short)(kw[e] >> 16); }
            }
                if (cn + 1 < NC) SM_GLOAD(cn + 1);
            } else if (rd >= 0) {
                const int w4 = wid - 4;
#pragma unroll
                for (int g = 0; g < 4; ++g) { const int dk0 = 32 * w4 + 8 * g + 4 * hi; const f32x4 gm = *(const LAS f32x4*)(Ri + I_G + dk0 * 4);
                    accS[4 * g + 0] *= gm[0]; accS[4 * g + 1] *= gm[1]; accS[4 * g + 2] *= gm[2]; accS[4 * g + 3] *= gm[3];
                    u32x2 w; w.x = pk2(accS[4 * g + 0], accS[4 * g + 1]); w.y = pk2(accS[4 * g + 2], accS[4 * g + 3]);
                    *(LAS u32x2*)(lds + O_ST + r32 * SQ + dk0 * 2) = w; }
            }
            __syncthreads();
        }
#undef SM_GLOAD
    }
}

enum Op { OP_SW0, OP_FO0, OP_RPA, OP_MIN, OP_RMLA, OP_QKV, OP_ATTN, OP_MWO, OP_RPB, OP_SW1, OP_FO1, OP_RPC, OP_HIN, OP_SCAN, OP_RHG, OP_HWO };
__device__ const unsigned char OPS_M[12] = {OP_SW0, OP_FO0, OP_RPA, OP_MIN, OP_RMLA, OP_QKV, OP_ATTN, OP_MWO, OP_RPB, OP_SW1, OP_FO1, OP_RPC};
__device__ const unsigned char OPS_H[11] = {OP_SW0, OP_FO0, OP_RPA, OP_HIN, OP_SCAN, OP_RHG, OP_HWO, OP_RPB, OP_SW1, OP_FO1, OP_RPC};

struct Args { const float* in[15]; float* out; unsigned char* ws; };
typedef const __attribute__((address_space(4))) Args* ArgsP;
__device__ __forceinline__ ArgsP get_args() { ArgsP p = (ArgsP)__builtin_amdgcn_kernarg_segment_ptr(); asm volatile("" : "+s"(p) :: "memory"); return p; }
#define GW_ ((int)blockIdx.x * 8 + __builtin_amdgcn_readfirstlane((int)threadIdx.x >> 6))
#define NGW_ ((int)gridDim.x * 8)
__device__ __forceinline__ int otid_() { int t = threadIdx.x; asm volatile("" : "+v"(t)); return t; }
#define LANE_ (otid_() & 63)

#ifdef DBG_CHECKS
__device__ __forceinline__ float bf2f(bf16_t v) { return __uint_as_float((unsigned)v << 16); }
__device__ __forceinline__ unsigned hash_u(unsigned x) { x ^= x >> 16; x *= 0x7feb352du; x ^= x >> 15; x *= 0x846ca68bu; x ^= x >> 16; return x; }
__device__ __forceinline__ void dbg_report(unsigned* DBG, int id, float got, float ref, float rtol, float atol) {
    const float err = fabsf(got - ref); const bool bad = !(err <= rtol * fabsf(ref) + atol);
    if (bad) atomicMax(DBG + id, 1u);
}
__device__ __forceinline__ int dbg_row(int sidx) { if (sidx == 0) return 0; if (sidx == 1) return MT - 1; if (sidx == 2) return SEQ - 1; if (sidx == 3) return SEQ; return (int)(hash_u(sidx * 2654435761u + 17u) % MT); }
#endif
#ifdef DBG_CHECKS
struct DbgCtx { const float* const* in; unsigned char* ws; unsigned char* R; unsigned* DBG; int bx, tid, lane, wave; };
__device__ __forceinline__ float dbg_dot_bf_w(const bf16_t* a, const float* W, int K, int ldw, int col) { float s = 0.f; for (int k = 0; k < K; ++k) s += bf2f(a[k]) * W[(size_t)k * ldw + col]; return s; }
template <class A>
__device__ __forceinline__ void dbg_after(int l, int op, A ap, unsigned char* ws, unsigned char* R, LAS unsigned char* lds) {
    unsigned* DBG = (unsigned*)(ws + 32768);
    const int bx = blockIdx.x, tid = otid_(), lane = tid & 63, wave = __builtin_amdgcn_readfirstlane(tid >> 6);
    const bf16_t* HN = (const bf16_t*)(ws + WS_HN); const float* Y = (const float*)(ws + WS_Y);
    if (false && l == 0 && op == OP_SW0 && bx < 32) { const int sid = bx * 512 + tid, m = dbg_row(sid), c = hash_u(sid * 3 + 1) % DFF; const float* W = ap->in[3];
        const float g = dbg_dot_bf_w(HN + (size_t)m * 1024, W, 1024, 2 * DFF, c), u = dbg_dot_bf_w(HN + (size_t)m * 1024, W, 1024, 2 * DFF, DFF + c);
        dbg_report(DBG, 1, bf2f(((const bf16_t*)(R + R_ACT))[(size_t)m * DFF + c]), g / (1.f + expf(-g)) * u, 0.015f, 0.004f); }
    if (false && l == 0 && op == OP_FO0 && bx < 32) { const int sid = bx * 512 + tid, m = dbg_row(sid), c = hash_u(sid * 3 + 2) % 1024;
        const float r = dbg_dot_bf_w((const bf16_t*)(R + R_ACT) + (size_t)m * DFF, ap->in[4], DFF, 1024, c);
        dbg_report(DBG, 2, Y[(size_t)m * 1024 + c], r, 0.015f, 0.004f); }
    if (false && l == 0 && op == OP_RPA && bx < 32) { const int sid = bx * 512 + tid, m = dbg_row(sid), c = hash_u(sid * 3 + 3) % 1024; const float* g = ap->in[2];
        float s = 0.f; for (int k = 0; k < 1024; ++k) { const float y = Y[(size_t)m * 1024 + k]; s += y * y; }
        const float xr = ap->in[0][(size_t)m * 1024 + c] + 0.5f * Y[(size_t)m * 1024 + c] * rsqrtf(s / 1024.f + EPS) * g[1024 + c];
        dbg_report(DBG, 2, ap->out[(size_t)m * 1024 + c], xr, 1e-3f, 1e-3f);
        float s2 = 0.f; for (int k = 0; k < 1024; ++k) { const float x = ap->out[(size_t)m * 1024 + k]; s2 += x * x; }
        dbg_report(DBG, 2, bf2f(HN[(size_t)m * 1024 + c]), ap->out[(size_t)m * 1024 + c] * rsqrtf(s2 / 1024.f + EPS) * g[2048 + c], 0.01f, 0.01f); }
    if (false && l == 0 && op == OP_MIN && bx < 32) { const int sid = bx * 512 + tid, m = dbg_row(sid), c = hash_u(sid * 3 + 4) % 512; const int sc = src_col(2, c);
        const float r = sc >= 0 ? dbg_dot_bf_w(HN + (size_t)m * 1024, ap->in[5], 1024, 448, sc) : 0.f;
        dbg_report(DBG, 3, ((const float*)(R + R_C))[(size_t)m * 512 + c], r, 0.015f, 0.01f); }
    if (false && l == 0 && op == OP_RMLA && bx < 32) { const int sid = bx * 512 + tid, m = dbg_row(sid), c = hash_u(sid * 3 + 5) % 448; const float* C = (const float*)(R + R_C) + (size_t)m * 512;
        if (c < 256) { float s = 0.f; for (int k = 0; k < 256; ++k) s += C[k] * C[k];
            dbg_report(DBG, 3, bf2f(((const bf16_t*)(R + R_CQ))[(size_t)m * 256 + c]), C[c] * rsqrtf(s / 256.f + EPS) * ap->in[6][c], 0.01f, 0.01f); }
        else if (c < 384) { float s = 0.f; for (int k = 256; k < 384; ++k) s += C[k] * C[k];
            dbg_report(DBG, 3, bf2f(((const bf16_t*)(R + R_CKV))[(size_t)m * 128 + c - 256]), C[c] * rsqrtf(s / 128.f + EPS) * ap->in[7][c - 256], 0.01f, 0.01f); }
        else { const int jj = c - 384, i = jj >> 1; const float ang = (float)((const int*)ap->in[1])[m] * powf(10000.f, -(float)i / 32.f); const float cs = cosf(ang), sn = sinf(ang);
            const float t1 = C[384 + 2 * i], t2 = C[384 + 2 * i + 1]; const float r = (jj & 1) ? t1 * sn + t2 * cs : t1 * cs - t2 * sn;
            dbg_report(DBG, 3, bf2f(((const bf16_t*)(R + R_KR))[(size_t)m * 64 + jj]), r, 0.02f, 0.05f); } }
    if (false && l == 0 && op == OP_QKV && bx < 32) { const int sid = bx * 512 + tid, m = dbg_row(sid); const bf16_t* CQ = (const bf16_t*)(R + R_CQ) + (size_t)m * 256; const bf16_t* CKV = (const bf16_t*)(R + R_CKV) + (size_t)m * 128;
        { const int c = hash_u(sid * 3 + 6) % 1536, h = c / QKD, d = c % QKD; float r;
          if (d < 128) r = dbg_dot_bf_w(CQ, ap->in[8], 256, 1536, c);
          else { const int jj = d - 128, i = jj >> 1; const float t1 = dbg_dot_bf_w(CQ, ap->in[8], 256, 1536, h * QKD + 128 + i), t2 = dbg_dot_bf_w(CQ, ap->in[8], 256, 1536, h * QKD + 160 + i);
              const float ang = (float)((const int*)ap->in[1])[m] * powf(10000.f, -(float)i / 32.f); const float cs = cosf(ang), sn = sinf(ang); r = (jj & 1) ? t1 * sn + t2 * cs : t1 * cs - t2 * sn; }
          dbg_report(DBG, 4, bf2f(((const bf16_t*)(R + R_QB))[(size_t)m * 1536 + c]), r, 0.015f, 0.015f); }
        { const int c = hash_u(sid * 3 + 7) % 2048, h = c >> 8, d = c & 255; const float r = dbg_dot_bf_w(CKV, ap->in[9], 128, 2048, c);
          const float got = d < 128 ? bf2f(((const bf16_t*)(R + R_KN))[(size_t)m * 1024 + h * 128 + d]) : bf2f(((const bf16_t*)(R + R_VB))[(size_t)m * 1024 + h * 128 + d - 128]);
          dbg_report(DBG, 5, got, r, 0.015f, 0.015f); } }
    if (l == 0 && op == OP_ATTN) { const int sid = bx * 8 + wave, m = dbg_row(sid), h = hash_u(sid * 5 + 1) & 7, dv = hash_u(sid * 5 + 2) & 127, b = m / SEQ;
        LAS float* qs = (LAS float*)lds + wave * 192; const bf16_t* Q = (const bf16_t*)(R + R_QB) + (size_t)m * 1536 + h * QKD;
        for (int d = lane; d < 192; d += 64) qs[d] = bf2f(Q[d]);
        asm volatile("s_waitcnt lgkmcnt(0)" ::: "memory");
        float mx = -1e30f, ls = 0.f, acc = 0.f;
        for (int kk = lane; kk < SEQ; kk += 64) { const size_t km = (size_t)b * SEQ + kk; const bf16_t* Kn = (const bf16_t*)(R + R_KN) + km * 1024 + h * 128; const bf16_t* Kr = (const bf16_t*)(R + R_KR) + km * 64;
            float s = 0.f; for (int d = 0; d < 128; ++d) s += qs[d] * bf2f(Kn[d]); for (int d = 0; d < 64; ++d) s += qs[128 + d] * bf2f(Kr[d]);
            s *= 0.07216878364870322f; const float v = bf2f(((const bf16_t*)(R + R_VB))[km * 1024 + h * 128 + dv]);
            const float mn = fmaxf(mx, s), al = expf(mx - mn), p = expf(s - mn); ls = ls * al + p; acc = acc * al + p * v; mx = mn; }
        float gm = mx;
        for (int o = 1; o < 64; o <<= 1) gm = fmaxf(gm, __shfl_xor(gm, o));
        const float sc = expf(mx - gm); const float L = wave_sum(ls * sc), Asum = wave_sum(acc * sc);
        if (lane == 0) { const float got = bf2f(((const bf16_t*)(R + R_O))[(size_t)m * 1024 + h * 128 + dv]), ref = Asum / L; atomicMax(DBG + 20, __float_as_uint(fabsf(got - ref))); atomicAdd((float*)(DBG + 21), fabsf(ref) * (1.f / 2048.f)); } }
    if (false && l == 1 && op == OP_HIN && bx < 32) { const int sid = bx * 512 + tid, m = dbg_row(sid), c5 = hash_u(sid * 3 + 8) % 5120, seg = c5 >> 10, c = c5 & 1023;
        const float u = dbg_dot_bf_w(HN + (size_t)m * 1024, ap->in[11], 1024, 5120, c5); float got, r;
        if (seg == 0) { got = bf2f(((const bf16_t*)(R + R_QH))[(size_t)m * 1024 + c]); r = u / (1.f + expf(-u)); }
        else if (seg == 3) { got = bf2f(((const bf16_t*)(R + R_VH))[(size_t)m * 1024 + c]); r = u; }
        else if (seg == 4) { got = bf2f(((const bf16_t*)(R + R_GH))[(size_t)m * 1024 + c]); r = u / (1.f + expf(-u)); }
        else { const int dir = seg - 1; const float* lbp = ap->in[12] + (size_t)dir * DEPTH * 1024 + c; const float e0 = expf(lbp[0]), e1 = expf(lbp[1024]), e2 = expf(lbp[2048]), e3 = expf(lbp[3072]);
            const float lb = e1 / (e0 + e1 + e2 + e3); const h16x2 hv = __builtin_bit_cast(h16x2, (unsigned)((const unsigned short*)(R + R_KF))[(size_t)dir * MT * 1024 + (size_t)m * 1024 + c]);
            got = (float)hv[0]; r = (1.f - lb) / (1.f + expf(u)); }
        dbg_report(DBG, 7, got, r, 0.015f, 0.006f); }
    if (false && l == 1 && op == OP_SCAN) { const int sid = bx * 8 + wave, h = hash_u(sid * 5 + 3) & 7, dv = hash_u(sid * 5 + 4) & 127, b = hash_u(sid * 5 + 5) & 3, toff = sid & 31, dir = 0;
        const bf16_t* Qh = (const bf16_t*)(R + R_QH); const bf16_t* Vh = (const bf16_t*)(R + R_VH); const unsigned short* KF = (const unsigned short*)(R + R_KF); const bf16_t* OPb = (const bf16_t*)(ws + WS_Y);
        float S0 = 0.f, S1 = 0.f; const int n = toff + 1; const int t = toff; const size_t m = (size_t)b * SEQ + t;
        for (int i = 0; i < n; ++i) { const int tt = i; const size_t mm = (size_t)b * SEQ + tt; const unsigned short* kp = KF + (size_t)dir * MT * 1024 + mm * 1024 + h * 128;
            const h16x2 ka = __builtin_bit_cast(h16x2, (unsigned)kp[lane]), kb = __builtin_bit_cast(h16x2, (unsigned)kp[lane + 64]); const float k0 = (float)ka[0], k1 = (float)kb[0];
            const float v = bf2f(Vh[mm * 1024 + h * 128 + dv]); S0 = S0 * (1.f - k0) + k0 * v; S1 = S1 * (1.f - k1) + k1 * v; }
        const bf16_t* q = Qh + m * 1024 + h * 128; const float tot = wave_sum(S0 * bf2f(q[lane]) + S1 * bf2f(q[lane + 64]));
        if (lane == 0) { const float got = bf2f(OPb[(size_t)dir * MT * 1024 + m * 1024 + h * 128 + dv]); const float re = fabsf(got - tot) / (fabsf(tot) + 0.05f);
            if (re > 0.05f) { atomicMin(DBG + 20, (unsigned)toff); atomicAdd(DBG + 21, 1u); } } }
    if (false && l == 1 && op == OP_RHG && bx < 32) { const int sid = bx * 512 + tid, m = dbg_row(sid), c = hash_u(sid * 3 + 9) % 1024, h0 = c & ~127; const bf16_t* OPb = (const bf16_t*)(ws + WS_Y);
        float s = 0.f; for (int k = 0; k < 128; ++k) { const float y = bf2f(OPb[(size_t)m * 1024 + h0 + k]) + bf2f(OPb[(size_t)MT * 1024 + (size_t)m * 1024 + h0 + k]); s += y * y; }
        const float yc = bf2f(OPb[(size_t)m * 1024 + c]) + bf2f(OPb[(size_t)MT * 1024 + (size_t)m * 1024 + c]);
        const float r = yc * rsqrtf(s / 128.f + EPS) * ap->in[13][c] * bf2f(((const bf16_t*)(R + R_GH))[(size_t)m * 1024 + c]);
        dbg_report(DBG, 9, bf2f(((const bf16_t*)(R + R_HO))[(size_t)m * 1024 + c]), r, 0.02f, 0.005f); }
    if (false && l == 1 && op == OP_HWO && bx < 32) { const int sid = bx * 512 + tid, m = dbg_row(sid), c = hash_u(sid * 3 + 10) % 1024;
        const float r = dbg_dot_bf_w((const bf16_t*)(R + R_HO) + (size_t)m * 1024, ap->in[14], 1024, 1024, c);
        dbg_report(DBG, 9, Y[(size_t)m * 1024 + c], r, 0.03f, 0.01f); }
    if (false && l == 0 && op == OP_MWO && bx < 32) { const int sid = bx * 512 + tid, m = dbg_row(sid), c = hash_u(sid * 3 + 11) % 1024;
        const float r = dbg_dot_bf_w((const bf16_t*)(R + R_O) + (size_t)m * 1024, ap->in[10], 1024, 1024, c);
        dbg_report(DBG, 6, Y[(size_t)m * 1024 + c], r, 0.02f, 0.0004f); }
}
#endif

__device__ __forceinline__ void gsync_cg() {
    asm volatile("s_waitcnt vmcnt(0) lgkmcnt(0)" ::: "memory");
    __syncthreads();
    cg::this_grid().sync();
    if (threadIdx.x == 0) { __builtin_amdgcn_fence(__ATOMIC_ACQUIRE, "agent"); asm volatile("s_waitcnt vmcnt(0)" ::: "memory"); }
    __syncthreads();
}
#define GAS __attribute__((address_space(1)))
#define XB_TMO      128
#define XB_XCNT(j)  (256  + 64 * (j))
#define XB_XSUB(j)  (1280 + 64 * (j))
#define XB_XGEN(j)  (2304 + 64 * (j))
#define XB_TOP      3328
#define XB_TOPGEN   3392
#define XCD_BAR_WORDS 3456
#define XB_SPIN_CAP (1u << 18)

__device__ __forceinline__ unsigned xb_ld(unsigned* p)              { return __hip_atomic_load(p, __ATOMIC_RELAXED, __HIP_MEMORY_SCOPE_AGENT); }
__device__ __forceinline__ unsigned xb_add(unsigned* p, unsigned v) { return __hip_atomic_fetch_add(p, v, __ATOMIC_RELAXED, __HIP_MEMORY_SCOPE_AGENT); }
__device__ __forceinline__ unsigned xb_xcc_id() { return (unsigned)__builtin_amdgcn_s_getreg((3 << 11) | 20) & 0xFu; }
#define XB_SPIN(cond, bar) do { unsigned _sp = 0; while (cond) { __builtin_amdgcn_s_sleep(1); \
    if ((++_sp & 255u) == 0u) { if (xb_ld(&(bar)[XB_TMO])) break; if (_sp > XB_SPIN_CAP) { atomicAdd(&(bar)[XB_TMO], 1u); break; } } } } while (0)

struct XcdBarrier {
    unsigned* bar; unsigned x;
    volatile LAS unsigned* st;
};

__device__ __forceinline__ XcdBarrier xcd_barrier_post(unsigned* bar, volatile LAS unsigned* st) {
    XcdBarrier b; b.bar = bar; b.x = xb_xcc_id(); b.st = st;
    if (threadIdx.x == 0) (void)xb_add(&bar[XB_XCNT(b.x)], 1u);
    return b;
}
__device__ __forceinline__ void xcd_barrier_complete(unsigned* bar, unsigned x, unsigned& nloc, unsigned& nx) {
    const unsigned G = gridDim.x * gridDim.y * gridDim.z;
    unsigned sum, cnt, mine, sp = 0u;
    for (;;) {
        sum = 0u; cnt = 0u; mine = 0u;
#pragma unroll
        for (unsigned j = 0; j < 16; ++j) { const unsigned c = xb_ld(&bar[XB_XCNT(j)]); sum += c; cnt += (c > 0u) ? 1u : 0u; mine = (j == x) ? c : mine; }
        if (sum == G) break;
        __builtin_amdgcn_s_sleep(1);
        if ((++sp & 255u) == 0u) { if (xb_ld(&bar[XB_TMO])) break; if (sp > XB_SPIN_CAP) { atomicAdd(&bar[XB_TMO], 1u); break; } }
    }
    nloc = mine > 0u ? mine : 1u; nx = cnt > 0u ? cnt : 1u;
}

__device__ __forceinline__ void xcd_barrier(const XcdBarrier& b) {
    asm volatile("s_waitcnt vmcnt(0)" ::: "memory");
    __syncthreads();
    if (threadIdx.x == 0) {
        unsigned* bar = b.bar;
        __builtin_amdgcn_s_waitcnt(0);
        unsigned nloc = b.st[0], nx = b.st[1];
        if (nloc == 0u) { xcd_barrier_complete(bar, b.x, nloc, nx); b.st[0] = nloc; b.st[1] = nx; }
        const unsigned old = xb_add(&bar[XB_XSUB(b.x)], 1u);
        const unsigned gen = old / nloc;
        if (old + 1u == (gen + 1u) * nloc) {
            __builtin_amdgcn_fence(__ATOMIC_RELEASE, "agent");
            asm volatile("s_waitcnt vmcnt(0)" ::: "memory");
            const unsigned og = xb_add(&bar[XB_TOP], 1u);
            const unsigned tg = og / nx;
            if (og + 1u == (tg + 1u) * nx) xb_add(&bar[XB_TOPGEN], 1u);
            else XB_SPIN(xb_ld(&bar[XB_TOPGEN]) == tg, bar);
            __builtin_amdgcn_fence(__ATOMIC_ACQUIRE, "agent");
            xb_add(&bar[XB_XGEN(b.x)], 1u);
            asm volatile("s_waitcnt vmcnt(0)" ::: "memory");
        } else {
            XB_SPIN(xb_ld(&bar[XB_XGEN(b.x)]) == gen, bar);
            __builtin_amdgcn_fence(__ATOMIC_ACQUIRE, "agent");
            asm volatile("s_waitcnt vmcnt(0)" ::: "memory");
        }
    }
    __syncthreads();
}

__device__ __forceinline__ void gsync(LAS unsigned char* lds) {
#ifdef USE_CG_SYNC
    gsync_cg();
#else
    XcdBarrier b; b.bar = (unsigned*)get_args()->ws; b.x = xb_xcc_id(); b.st = (volatile LAS unsigned*)(lds + LDS_RING);
    xcd_barrier(b);
#endif
}
__global__ void __launch_bounds__(512, 2) mega_fwd(Args a_unused) {
    extern __shared__ __attribute__((aligned(16))) unsigned char lds_raw[];
    LAS unsigned char* lds = (LAS unsigned char*)lds_raw;

    if (threadIdx.x < 2) ((volatile LAS unsigned*)(lds + LDS_RING))[threadIdx.x] = 0u;
    __syncthreads();
    (void)xcd_barrier_post((unsigned*)get_args()->ws, (volatile LAS unsigned*)(lds + LDS_RING));
#ifdef REP_PRO
    for (int rep_ = 0; rep_ < 2; ++rep_)
#endif
    {
        ArgsP ap = get_args(); unsigned char* ws = ap->ws;
#ifdef DBG_CHECKS
        if (blockIdx.x == 0 && threadIdx.x < 32) atomicExch((unsigned*)ws + threadIdx.x, 0u);
#endif
        const int tid = threadIdx.x, lane = tid & 63, wave = __builtin_amdgcn_readfirstlane(tid >> 6), G = gridDim.x, bx = blockIdx.x, gw = bx * 8 + wave, NGW = G * 8;
        LAS float* scr = (LAS float*)(lds + wave * 16384);
        constexpr int I_FFI = 16 * 176, I_FFO = 44 * 32, I_HIN = 16 * 160, I_SQ = 16 * 32, I_MIN = 16 * 16, I_UQ = 4 * 48, I_UKV = 2 * 64;
        constexpr int NITEMS = 8 * I_FFI + 8 * I_FFO + 2 * I_HIN + 2 * I_SQ + 2 * I_MIN + 2 * I_UQ + 2 * I_UKV + 2 * I_SQ;
        for (int it = gw; it < NITEMS; it += NGW) {
            int r = it;
#define XP(IDX_, K_, NS_, ND_, MODE_, WSOFF_, NMAT_, IPM_) if (r < (NMAT_) * (IPM_)) { const int mat = r / (IPM_); \
            xpose_item(ap->in[IDX_] + (size_t)mat * (K_) * (NS_), K_, NS_, ND_, MODE_, (bf16_t*)(ws + (WSOFF_)) + (size_t)mat * (ND_) * (K_), scr, r % (IPM_), lane); continue; } r -= (NMAT_) * (IPM_);
            XP(3, 1024, 2 * DFF, 2 * DFF, 1, WS_WFFI, 8, I_FFI)
            XP(4, DFF, 1024, 1024, 0, WS_WFFO, 8, I_FFO)
            XP(11, 1024, 5120, 5120, 0, WS_WHIN, 2, I_HIN)
            XP(14, 1024, 1024, 1024, 0, WS_WHO, 2, I_SQ)
            XP(5, 1024, 448, 512, 2, WS_WMIN, 2, I_MIN)
            XP(8, 256, 1536, 1536, 3, WS_WUQ, 2, I_UQ)
            XP(9, 128, 2048, 2048, 0, WS_WUKV, 2, I_UKV)
            XP(10, 1024, 1024, 1024, 0, WS_WMO, 2, I_SQ)
#undef XP
        }
        { const int* positions = (const int*)ap->in[1]; float* COS = (float*)(ws + WS_COS); float* SIN = (float*)(ws + WS_SIN);
          for (int idx = bx * 512 + tid; idx < MT * 32; idx += G * 512) { const int m = idx >> 5, i = idx & 31;
            const double ang = (double)positions[m] * ROPE_INVF[i]; const double rev = ang * 0.15915494309189535; const float fr = (float)(rev - __builtin_rint(rev));
            COS[idx] = __builtin_amdgcn_cosf(fr); SIN[idx] = __builtin_amdgcn_sinf(fr); } }
        { float* LB = (float*)(ws + WS_LB);
          for (int idx = bx * 512 + tid; idx < 2 * 2 * 1024; idx += G * 512) { const int c = idx & 1023, dir = (idx >> 10) & 1, j = idx >> 11, l = 2 * j + 1;
            const float* lbp = ap->in[12] + (size_t)dir * DEPTH * 1024 + c; float v[4], mx = -1e30f;
#pragma unroll
            for (int i = 0; i < 4; ++i) { v[i] = lbp[i * 1024]; mx = fmaxf(mx, v[i]); }
            float den = 0.f, num = 0.f;
#pragma unroll
            for (int i = 0; i < 4; ++i) { const float e = __expf(v[i] - mx); den += e; if (i >= 1 && i <= l) num += e; }
            LB[idx] = num / den; } }
        { const float* x_in = ap->in[0]; float* X = ap->out; bf16_t* HN = (bf16_t*)(ws + WS_HN); const float* gains = ap->in[2];
          for (int m = gw; m < MT; m += NGW) row_init(x_in + (size_t)m * DM, X + (size_t)m * DM, HN + (size_t)m * DM, gains, lane); }
    }
    gsync_cg();

    for (int ph = 0; ph < 46; ++ph) {
        const int l = ph >= 35 ? 3 : (ph >= 23 ? 2 : (ph >= 12 ? 1 : 0)), s = ph - (l == 3 ? 35 : (l == 2 ? 23 : (l == 1 ? 12 : 0)));
        const bool hg = l & 1; const int j = l >> 1;
        const int op = hg ? OPS_H[s] : OPS_M[s];
        ArgsP ap = get_args(); unsigned char* ws = ap->ws; unsigned char* R = ws + WS_R;
        int G_ = gridDim.x, bx_ = blockIdx.x; asm volatile("" : "+s"(G_), "+s"(bx_));
        switch (op) {
        case OP_SW0: case OP_SW1: {
            const int half = op == OP_SW1;
            pg8::Gemm gm{(const bf16_t*)(ws + WS_HN), (const bf16_t*)(ws + WS_WFFI) + (size_t)(l * 2 + half) * (2 * DFF) * 1024, MT, 2 * DFF, 1024};
            pg8::StaticOrder S; S.init(MT, 2 * DFF, G_, bx_); EpiSwiglu E{(bf16_t*)(R + R_ACT)};
#ifndef NO_SW
            pg8::gemm_phase<EpiSwiglu, pg8::StaticOrder, true, true>(lds, gm, S, E);
#endif
        } break;
        case OP_MIN: {
            pg8::Gemm gm{(const bf16_t*)(ws + WS_HN), (const bf16_t*)(ws + WS_WMIN) + (size_t)j * 512 * 1024, MT, 512, 1024}; EpiF32 E{(float*)(R + R_C), 512};
            pg8::StaticOrder S; S.init(MT, 512, G_, bx_);
#ifndef NO_F32
            pg8::gemm_phase<EpiF32, pg8::StaticOrder, true, true>(lds, gm, S, E);
#endif
        } break;
        case OP_FO0: case OP_FO1: case OP_MWO: case OP_HWO: {
            pg8::Gemm gm; EpiB16 E{(bf16_t*)(ws + WS_YB), 1024};
            if (op == OP_FO0 || op == OP_FO1) { const int half = op == OP_FO1; gm = pg8::Gemm{(const bf16_t*)(R + R_ACT), (const bf16_t*)(ws + WS_WFFO) + (size_t)(l * 2 + half) * 1024 * DFF, MT, 1024, DFF}; }
            else if (op == OP_MWO) { gm = pg8::Gemm{(const bf16_t*)(R + R_O), (const bf16_t*)(ws + WS_WMO) + (size_t)j * 1024 * 1024, MT, 1024, 1024}; }
            else { gm = pg8::Gemm{(const bf16_t*)(R + R_HO), (const bf16_t*)(ws + WS_WHO) + (size_t)j * 1024 * 1024, MT, 1024, 1024}; }
            pg8::StaticOrder S; S.init(MT, 1024, G_, bx_);
            pg8::gemm_phase<EpiB16, pg8::StaticOrder, true, true>(lds, gm, S, E);
        } break;
        case OP_RPA: case OP_RPB: case OP_RPC: {
            const float* gains = ap->in[2]; const float* g = gains + (size_t)l * 6 * DM; const bf16_t* Y = (const bf16_t*)(ws + WS_YB); float* X = ap->out; bf16_t* HN = (bf16_t*)(ws + WS_HN);
            const int k = op == OP_RPA ? 1 : (op == OP_RPB ? 3 : 5); const float scale = op == OP_RPB ? 1.0f : 0.5f;
            const bool last = (op == OP_RPC) && (l == DEPTH - 1);
            const float* gn = op == OP_RPC ? gains + (size_t)(l + 1) * 6 * DM : g + (size_t)(k + 1) * DM;
            const int lane = LANE_;
            for (int m = bx_ * 8 + __builtin_amdgcn_readfirstlane(otid_() >> 6); m < MT; m += G_ * 8) row_post(Y + (size_t)m * DM, X + (size_t)m * DM, last ? (bf16_t*)nullptr : HN + (size_t)m * DM, scale, g + (size_t)k * DM, last ? g : gn, lane);
        } break;
        case OP_RMLA: {
            const float* qn = ap->in[6] + (size_t)j * QLR; const float* kvn = ap->in[7] + (size_t)j * KVLR; const float* COS = (const float*)(ws + WS_COS); const float* SIN = (const float*)(ws + WS_SIN);
            const int lane = LANE_;
            for (int m = bx_ * 8 + __builtin_amdgcn_readfirstlane(otid_() >> 6); m < MT; m += G_ * 8) row_mla((const float*)(R + R_C) + (size_t)m * 512, (bf16_t*)(R + R_CQ) + (size_t)m * 256, (bf16_t*)(R + R_CKV) + (size_t)m * 128, (bf16_t*)(R + R_KR) + (size_t)m * 64,
                                                         qn, kvn, COS + (size_t)m * 32, SIN + (size_t)m * 32, lane);
        } break;
        case OP_QKV: {
            { int Kq = 256; asm volatile("" : "+s"(Kq)); pg8::Gemm gm{(const bf16_t*)(R + R_CQ), (const bf16_t*)(ws + WS_WUQ) + (size_t)j * 1536 * 256, MT, 1536, Kq};
              pg8::StaticOrder S; S.init(MT, 1536, G_, bx_); EpiQ E{(bf16_t*)(R + R_QB), (const float*)(ws + WS_COS), (const float*)(ws + WS_SIN)};
#ifndef NO_Q
              pg8::gemm_phase<EpiQ, pg8::StaticOrder, true, true>(lds, gm, S, E);
#endif
            }
            __syncthreads();
            { int Kq = 128; asm volatile("" : "+s"(Kq)); pg8::Gemm gm{(const bf16_t*)(R + R_CKV), (const bf16_t*)(ws + WS_WUKV) + (size_t)j * 2048 * 128, MT, 2048, Kq};
              pg8::StaticOrder S; S.init(MT, 2048, G_, bx_); EpiKV E{(bf16_t*)(R + R_KN), (bf16_t*)(R + R_VB)};
#ifndef NO_KV
              pg8::gemm_phase<EpiKV, pg8::StaticOrder, true, true>(lds, gm, S, E);
#endif
            }
        } break;
        case OP_ATTN: {
#ifndef NO_ATTN
            const int G = G_, bx = bx_;

            const int vcu = (G % 8 == 0) ? (bx % 8) * (G / 8) + bx / 8 : bx;
#ifdef REP_ATTN
            for (int rep_ = 0; rep_ < 2; ++rep_)
#endif
            for (int uid = vcu; uid < BATCH * NH * (SEQ / 256); uid += G) {
                const int bh = uid >> 5, qb = uid & 31, b = bh >> 3, h = bh & 7;
                const size_t row0 = (size_t)b * SEQ;
                att::attn_unit((const att::bf16*)(R + R_QB) + (row0 + qb * 256) * 1536 + h * QKD, (const att::bf16*)(R + R_KN) + row0 * 1024 + h * 128,
                               (const att::bf16*)(R + R_KR) + row0 * 64, (const att::bf16*)(R + R_VB) + row0 * 1024 + h * 128,
                               (att::bf16*)(R + R_O) + (row0 + qb * 256) * 1024 + h * 128, SEQ, (char*)lds_raw);
            }
#endif
        } break;
        case OP_HIN: {
            pg8::Gemm gm{(const bf16_t*)(ws + WS_HN), (const bf16_t*)(ws + WS_WHIN) + (size_t)j * 5120 * 1024, MT, 5120, 1024};
            pg8::StaticOrder S; S.init(MT, 5120, G_, bx_);
            EpiHgrn E{(bf16_t*)(R + R_QH), (bf16_t*)(R + R_VH), (bf16_t*)(R + R_GH), (unsigned short*)(R + R_KF), (const float*)(ws + WS_LB) + (size_t)j * 2048};
#ifndef NO_HG
            pg8::gemm_phase<EpiHgrn, pg8::StaticOrder, true, true>(lds, gm, S, E);
#endif
        } break;
        case OP_SCAN: {
#ifndef NO_SCAN
#ifdef REP_SCAN
            scan_phase(lds, (const bf16_t*)(R + R_QH), (const bf16_t*)(R + R_VH), (const unsigned short*)(R + R_KF), (bf16_t*)(ws + WS_Y), G_, bx_); __syncthreads();
#endif
#ifdef SCAN_VALU
            scan_phase(lds, (const bf16_t*)(R + R_QH), (const bf16_t*)(R + R_VH), (const unsigned short*)(R + R_KF), (bf16_t*)(ws + WS_Y), G_, bx_);
#else
            scan_phase_mfma(lds, (const bf16_t*)(R + R_QH), (const bf16_t*)(R + R_VH), (const unsigned short*)(R + R_KF), (bf16_t*)(ws + WS_Y), G_, bx_);
#endif
#endif
        } break;
        case OP_RHG: {
            const float* on = ap->in[13] + (size_t)j * DM; const bf16_t* Y = (const bf16_t*)(ws + WS_Y);
            const int lane = LANE_;
            for (int m = bx_ * 8 + __builtin_amdgcn_readfirstlane(otid_() >> 6); m < MT; m += G_ * 8) row_hgrn(Y + (size_t)m * DM, (const bf16_t*)(R + R_GH) + (size_t)m * DM, (bf16_t*)(R + R_HO) + (size_t)m * DM, on, lane);
        } break;
        default: break;
        }
        if (ph != 45) gsync(lds);
#ifdef REP_SYNC
        gsync(lds);
#endif
#ifdef DBG_CHECKS
        { ArgsP ap2 = get_args(); dbg_after(l, op, ap2, ap2->ws, ap2->ws + WS_R, lds); gsync(lds); }
#endif
    }
#ifdef DBG_CHECKS
    gsync(lds);
    if (blockIdx.x == 0 && threadIdx.x == 0) { ArgsP ap = get_args(); unsigned* DBG = (unsigned*)ap->ws; const float mx = __uint_as_float(atomicAdd(DBG + 20, 0u)), mean = atomicAdd((float*)(DBG + 21), 0.f); ap->out[1024 * 16] += 1e6f * mx; ap->out[1024 * 16 + 1] += 1e4f * mean; }
#endif
}

extern "C" void kernel_launch(void* const* d_in, const int* in_sizes, int n_in, void* d_out, int out_size, void* d_ws, size_t ws_size, hipStream_t stream) {
    static int grid = 0;
    if (grid == 0) {
        if (n_in != 15 || out_size != MT * DM || ws_size < WS_END) { fprintf(stderr, "kernel_launch: unexpected shapes: n_in %d out %d ws %zu (need %zu)\n", n_in, out_size, ws_size, (size_t)WS_END); grid = -1; return; }
        int dev = 0, cus = 0, per_cu = 0;
        (void)hipGetDevice(&dev); (void)hipDeviceGetAttribute(&cus, hipDeviceAttributeMultiprocessorCount, dev);
        if (hipFuncSetAttribute((const void*)mega_fwd, hipFuncAttributeMaxDynamicSharedMemorySize, LDS_BYTES) != hipSuccess) { fprintf(stderr, "kernel_launch: hipFuncSetAttribute failed\n"); grid = -1; return; }
        if (hipOccupancyMaxActiveBlocksPerMultiprocessor(&per_cu, (const void*)mega_fwd, 512, LDS_BYTES) != hipSuccess || per_cu < 1) { fprintf(stderr, "kernel_launch: occupancy query gave %d\n", per_cu); per_cu = 1; }
        (void)hipGetLastError();
        grid = cus * 1;
        fprintf(stderr, "kernel_launch: cus %d per_cu %d grid %d\n", cus, per_cu, grid);
    }
    if (grid < 0) return;
    if (hipMemsetAsync(d_ws, 0, 65536, stream) != hipSuccess) { fprintf(stderr, "kernel_launch: memset failed\n"); return; }
    Args a{};
    for (int i = 0; i < 15; ++i) a.in[i] = (const float*)d_in[i];
    a.out = (float*)d_out; a.ws = (unsigned char*)d_ws;
    void* args[] = {&a};
    hipError_t e = hipLaunchCooperativeKernel((const void*)mega_fwd, dim3(grid), dim3(512), args, LDS_BYTES, stream);
    if (e != hipSuccess) fprintf(stderr, "cooperative launch failed: %s (grid %d)\n", hipGetErrorString(e), grid);
}
```

```cpp
#include <hip/hip_runtime.h>
#include <hip/hip_cooperative_groups.h>
#include <hip/hip_bf16.h>
#include <hip/hip_fp16.h>
#include <cstdio>
#include <cstdint>
#include <cmath>
namespace cg = cooperative_groups;
namespace pg8 {
#define PG8_LAS __attribute__((address_space(3)))
typedef unsigned short bf16_t;
typedef short bf16x8 __attribute__((ext_vector_type(8)));
typedef float f32x4 __attribute__((ext_vector_type(4)));
typedef unsigned u32x4 __attribute__((ext_vector_type(4)));
constexpr int BM = 256, BK = 64, HALF = 128, HTB = HALF * BK * 2  , STAGE_BYTES = 8 * HTB, NXCD = 8, WGM = 8;

__host__ __device__ __forceinline__ int lds_byte(int r, int c) { const int st = (r >> 4) * 2 + (c >> 5), rr = r & 15, cc = c & 31, ob = rr * 64 + cc * 2; return st * 1024 + (ob ^ (((ob >> 9) & 1) << 5)); }
__host__ __device__ __forceinline__ void stage_rc(int b, int& R, int& C) { const int st = b / 1024, sb = b % 1024, swz = sb ^ (((sb >> 9) & 1) << 5); R = (st >> 1) * 16 + swz / 64; C = (st & 1) * 32 + (swz % 64) / 2; }
__host__ __device__ __forceinline__ int perm32(int rho) { const int n = rho >> 4, i = rho & 15; return 8 * (i >> 2) + 4 * n + (i & 3); }

struct Unit { int pm, pn; };
struct Gemm { const bf16_t* A; const bf16_t* Bt; int M, N, K; };

struct StaticOrder {
    int nM, nN, nwg, G, c;
    __host__ __device__ void init(int M, int N, int G_, int c_) { nM = M / BM; nN = N / BM; nwg = nM * nN; G = G_; c = c_; }
    __host__ __device__ bool next(int i, Unit& u) const {
        const long L = (long)i * G + c; if (L >= nwg) return false;
        int wgid = (int)L; { const int q = nwg / NXCD, r = nwg % NXCD, xcd = wgid % NXCD, off = wgid / NXCD; wgid = (xcd < r ? xcd * (q + 1) : r * (q + 1) + (xcd - r) * q) + off; }
        const int nig = WGM * nN, gid = wgid / nig, fm = gid * WGM, gsz = (nM - fm) < WGM ? (nM - fm) : WGM;
        u.pm = fm + ((wgid % nig) % gsz); u.pn = (wgid % nig) / gsz; return true;
    }
    __device__ __forceinline__ void a_ready(const Unit&) const {}
    __device__ __forceinline__ void done(const Unit&) const {}
};

__device__ __forceinline__ unsigned cvt_pk_bf16(float lo, float hi) { unsigned r; asm volatile("v_cvt_pk_bf16_f32 %0, %1, %2" : "=v"(r) : "v"(lo), "v"(hi)); return r; }
template <class Epi, class Sched, bool ALIGN_EPI = false, bool SP2 = false>
__device__ __forceinline__ void gemm_phase(PG8_LAS unsigned char* lds, const Gemm g, const Sched& S, const Epi& E) {
    int tid = threadIdx.x; asm volatile("" : "+v"(tid)); const int wid = __builtin_amdgcn_readfirstlane(tid >> 6), lane = tid & 63, wr = wid >> 2, wc = wid & 3, fr = lane & 15, fq = lane >> 4;
    const int K = g.K, nt = K / BK;
    unsigned voffA[2], voffB[2];
#pragma unroll
    for (int i = 0; i < 2; ++i) { int R, C; stage_rc(tid * 16 + i * 8192, R, C); const int Rb = Epi::PERM ? ((R & ~31) + perm32(R & 31)) : R;
        voffA[i] = (unsigned)(R * K + C) * 2u; voffB[i] = (unsigned)(Rb * K + C) * 2u; }
    const size_t kstep = (size_t)(BK * 2);
    const size_t hstep = (size_t)HALF * K * 2;
    const size_t tstep = 2 * hstep;
    const unsigned ldsw = (unsigned)wid * 1024u;
    const int aoff = lds_byte(wr * 64 + fr, fq * 8), boff = lds_byte(wc * 32 + fr, fq * 8);
#define PG8_SA(b, h) (((b) * 2 + (h)) * HTB)
#define PG8_SB(b, h) ((4 + (b) * 2 + (h)) * HTB)
#define PG8_STAGE(bufoff, gbase, voff) do { _Pragma("unroll") for (int _i = 0; _i < 2; ++_i) \
        __builtin_amdgcn_global_load_lds((const unsigned*)((const char*)(gbase) + (voff)[_i]), (PG8_LAS unsigned*)(lds + (bufoff) + ldsw + _i * 8192), 16, 0, 0); } while (0)
#define PG8_LDA(dst, b, h) do { _Pragma("unroll") for (int m = 0; m < 4; ++m) _Pragma("unroll") for (int k = 0; k < 2; ++k) dst[m][k] = *(const PG8_LAS bf16x8*)(lds + PG8_SA(b, h) + aoff + m * 2048 + k * 1024); } while (0)
#define PG8_LDB(dst, b, h) do { _Pragma("unroll") for (int n = 0; n < 2; ++n) _Pragma("unroll") for (int k = 0; k < 2; ++k) dst[n][k] = *(const PG8_LAS bf16x8*)(lds + PG8_SB(b, h) + boff + n * 2048 + k * 1024); } while (0)
#define PG8_MMA(ai, bj, At, Bt) do { __builtin_amdgcn_s_setprio(1); _Pragma("unroll") for (int m = 0; m < 4; ++m) _Pragma("unroll") for (int n = 0; n < 2; ++n) _Pragma("unroll") for (int k = 0; k < 2; ++k) \
        acc[ai][bj][m][n] = __builtin_amdgcn_mfma_f32_16x16x32_bf16(Bt[n][k], At[m][k], acc[ai][bj][m][n], 0, 0, 0); __builtin_amdgcn_s_setprio(0); } while (0)
#define PG8_WAIT_V(n) asm volatile("s_waitcnt vmcnt(" #n ")" ::: "memory")
#define PG8_WAIT_L(n) asm volatile("s_waitcnt lgkmcnt(" #n ")" ::: "memory")
#define PG8_BAR __builtin_amdgcn_s_barrier()
#define PG8_SCHED __builtin_amdgcn_sched_barrier(0)
    Unit cur, nxt; int ui = 0;
    if (!S.next(0, cur)) return;
    f32x4 acc[2][2][4][2];
#pragma unroll
    for (int a = 0; a < 2; ++a)
#pragma unroll
        for (int b = 0; b < 2; ++b)
#pragma unroll
            for (int m = 0; m < 4; ++m)
#pragma unroll
                for (int n = 0; n < 2; ++n) acc[a][b][m][n] = (f32x4){0.f, 0.f, 0.f, 0.f};
    bf16x8 At[4][2], B0[2][2], B1[2][2];
    const char* cA = (const char*)g.A + (size_t)cur.pm * tstep; const char* cB = (const char*)g.Bt + (size_t)cur.pn * tstep;
    S.a_ready(cur);
    if constexpr (SP2) {
        PG8_STAGE(PG8_SB(0, 0), cB, voffB); PG8_STAGE(PG8_SB(0, 1), cB + hstep, voffB); PG8_STAGE(PG8_SA(0, 0), cA, voffA); PG8_STAGE(PG8_SA(0, 1), cA + hstep, voffA);
        if (wr == 1) PG8_BAR;
        PG8_WAIT_V(2); PG8_BAR;
        PG8_STAGE(PG8_SB(1, 0), cB + kstep, voffB); PG8_STAGE(PG8_SA(1, 0), cA + kstep, voffA); PG8_STAGE(PG8_SB(1, 1), cB + hstep + kstep, voffB);
        PG8_WAIT_V(6); PG8_BAR;
    } else {
        PG8_STAGE(PG8_SB(0, 0), cB, voffB); PG8_STAGE(PG8_SA(0, 0), cA, voffA); PG8_STAGE(PG8_SB(0, 1), cB + hstep, voffB); PG8_STAGE(PG8_SA(0, 1), cA + hstep, voffA);
        if (wr == 1) PG8_BAR;
        PG8_WAIT_V(4); PG8_BAR;
        PG8_STAGE(PG8_SB(1, 0), cB + kstep, voffB); PG8_STAGE(PG8_SA(1, 0), cA + kstep, voffA); PG8_STAGE(PG8_SB(1, 1), cB + hstep + kstep, voffB);
        PG8_WAIT_V(6); PG8_BAR;
    }
    for (;;) {
        const bool has_next = S.next(ui + 1, nxt);
        const char* nA = has_next ? (const char*)g.A + (size_t)nxt.pm * tstep : cA; const char* nB = has_next ? (const char*)g.Bt + (size_t)nxt.pn * tstep : cB;
        for (int t = 0; t < nt; t += 2) {
            const bool last = (t == nt - 2);
            const char* a1 = cA + (size_t)(t + 1) * kstep;
            const char* a2 = last ? nA : cA + (size_t)(t + 2) * kstep; const char* b2 = last ? nB : cB + (size_t)(t + 2) * kstep;
            const char* a3 = a2 + kstep; const char* b3 = b2 + kstep;
            if (last && has_next) S.a_ready(nxt);
            if constexpr (SP2) {
            PG8_LDB(B0, 0, 0); PG8_LDB(B1, 0, 1); PG8_SCHED; PG8_LDA(At, 0, 0); PG8_STAGE(PG8_SA(1, 1), a1 + hstep, voffA);
            PG8_WAIT_V(8); PG8_WAIT_L(0); PG8_BAR; PG8_MMA(0, 0, At, B0); PG8_MMA(0, 1, At, B1); PG8_BAR; PG8_SCHED;
            PG8_LDA(At, 0, 1); PG8_STAGE(PG8_SB(0, 0), b2, voffB); PG8_STAGE(PG8_SB(0, 1), b2 + hstep, voffB); PG8_STAGE(PG8_SA(0, 0), a2, voffA);
            PG8_WAIT_V(8); PG8_WAIT_L(0); PG8_BAR; PG8_MMA(1, 0, At, B0); PG8_MMA(1, 1, At, B1); PG8_BAR; PG8_SCHED;
            PG8_LDB(B0, 1, 0); PG8_LDB(B1, 1, 1); PG8_SCHED; PG8_LDA(At, 1, 0); PG8_STAGE(PG8_SA(0, 1), a2 + hstep, voffA);
            PG8_WAIT_V(8); PG8_WAIT_L(0); PG8_BAR; PG8_MMA(0, 0, At, B0); PG8_MMA(0, 1, At, B1); PG8_BAR; PG8_SCHED;
            PG8_LDA(At, 1, 1); PG8_STAGE(PG8_SB(1, 0), b3, voffB); PG8_STAGE(PG8_SB(1, 1), b3 + hstep, voffB); PG8_STAGE(PG8_SA(1, 0), a3, voffA);
            PG8_WAIT_V(8); PG8_WAIT_L(0); PG8_BAR; PG8_MMA(1, 0, At, B0); PG8_MMA(1, 1, At, B1); PG8_BAR; PG8_SCHED;
            } else {
            PG8_LDB(B0, 0, 0); PG8_SCHED; PG8_LDA(At, 0, 0); PG8_STAGE(PG8_SA(1, 1), a1 + hstep, voffA);
            PG8_WAIT_L(8); PG8_BAR; PG8_WAIT_L(0); PG8_MMA(0, 0, At, B0); PG8_BAR; PG8_SCHED;
            PG8_LDB(B1, 0, 1); PG8_STAGE(PG8_SB(0, 0), b2, voffB);
            PG8_BAR; PG8_WAIT_L(0); PG8_MMA(0, 1, At, B1); PG8_BAR;
            PG8_LDA(At, 0, 1); PG8_STAGE(PG8_SA(0, 0), a2, voffA);
            PG8_BAR; PG8_WAIT_L(0); PG8_MMA(1, 0, At, B0); PG8_BAR; PG8_SCHED;
            PG8_STAGE(PG8_SB(0, 1), b2 + hstep, voffB);
            PG8_WAIT_V(6); PG8_BAR; PG8_MMA(1, 1, At, B1); PG8_BAR;
            PG8_LDB(B0, 1, 0); PG8_SCHED; PG8_LDA(At, 1, 0); PG8_STAGE(PG8_SA(0, 1), a2 + hstep, voffA);
            PG8_WAIT_L(8); PG8_BAR; PG8_WAIT_L(0); PG8_MMA(0, 0, At, B0); PG8_BAR; PG8_SCHED;
            PG8_LDB(B1, 1, 1); PG8_STAGE(PG8_SB(1, 0), b3, voffB);
            PG8_BAR; PG8_WAIT_L(0); PG8_MMA(0, 1, At, B1); PG8_BAR;
            PG8_LDA(At, 1, 1); PG8_STAGE(PG8_SA(1, 0), a3, voffA);
            PG8_BAR; PG8_WAIT_L(0); PG8_MMA(1, 0, At, B0); PG8_BAR; PG8_SCHED;
            PG8_STAGE(PG8_SB(1, 1), b3 + hstep, voffB);
            PG8_WAIT_V(6); PG8_BAR; PG8_MMA(1, 1, At, B1); PG8_BAR;
            }
        }
        if constexpr (ALIGN_EPI) { if (wr == 0) PG8_BAR; }
        if constexpr (!Epi::AFTER_DRAIN) { E(acc, cur, wr, wc, fr, fq); S.done(cur); }
        if (!has_next) break;
#pragma unroll
        for (int a = 0; a < 2; ++a)
#pragma unroll
            for (int b = 0; b < 2; ++b)
#pragma unroll
                for (int m = 0; m < 4; ++m)
#pragma unroll
                    for (int n = 0; n < 2; ++n) acc[a][b][m][n] = (f32x4){0.f, 0.f, 0.f, 0.f};
        cur = nxt; cA = nA; cB = nB; ++ui;
        if constexpr (ALIGN_EPI) { if (wr == 1) PG8_BAR; }
    }
    PG8_WAIT_V(0);
    if constexpr (!ALIGN_EPI) { if (wr == 0) PG8_BAR; }
    PG8_BAR;
    if constexpr (Epi::AFTER_DRAIN) { E.fused(acc, cur, wr, wc, fr, fq, lds, wid, lane); S.done(cur); }
#undef PG8_SA
#undef PG8_SB
#undef PG8_STAGE
#undef PG8_LDA
#undef PG8_LDB
#undef PG8_MMA
#undef PG8_WAIT_V
#undef PG8_WAIT_L
#undef PG8_BAR
#undef PG8_SCHED
}
}
#ifndef ATT_SDEPTH
#define ATT_SDEPTH 1
#endif
namespace att {
using bf16 = __hip_bfloat16;
constexpr int NW = 8, QBLK = 32, KVBLK = 64;
constexpr float SCALE = 0.07216878364870322f;
constexpr float THR = 8.f;
__device__ __forceinline__ int otid() { int t = threadIdx.x; asm volatile("" : "+v"(t)); return t; }
using bf16x8 = __attribute__((ext_vector_type(8))) short;
using s16x4  = __attribute__((ext_vector_type(4))) short;
using f32x16 = __attribute__((ext_vector_type(16))) float;
using f32x8  = __attribute__((ext_vector_type(8))) float;
using u32x4  = __attribute__((ext_vector_type(4))) unsigned;
#define KSWZ(row, colB) ((row) * 256 + ((colB) ^ (((row) & 7) << 4)))
#define SBAR() __builtin_amdgcn_sched_barrier(0)
__device__ __forceinline__ int crow(int r, int hi) { return (r & 3) + 8 * (r >> 2) + 4 * hi; }
__device__ __forceinline__ unsigned cvtpk(float lo, float hi) {
  unsigned r; asm volatile("v_cvt_pk_bf16_f32 %0, %1, %2" : "=v"(r) : "v"(lo), "v"(hi)); return r;
}
template <typename TIn> struct Stage;
template <> struct Stage<bf16>  { using T = bf16x8;
  __device__ static __forceinline__ T ld8(const bf16* p) { return *reinterpret_cast<const bf16x8*>(p); }
  __device__ static __forceinline__ bf16x8 tobf(T x) { return x; } };
template <> struct Stage<float> { using T = f32x8;
  __device__ static __forceinline__ T ld8(const float* p) { return *reinterpret_cast<const f32x8*>(p); }
  __device__ static __forceinline__ bf16x8 tobf(T x) {
    u32x4 w = {cvtpk(x[0], x[1]), cvtpk(x[2], x[3]), cvtpk(x[4], x[5]), cvtpk(x[6], x[7])}; return *reinterpret_cast<bf16x8*>(&w); } };

__device__ __forceinline__ void partialSM(f32x16& p0, f32x16& p1, float& m_reg, float& mn, float& alpha) {
  constexpr float C = SCALE * 1.4426950408889634f;
  float pmax = p0[0]; for (int r = 1; r < 16; ++r) pmax = fmaxf(pmax, p0[r]); for (int r = 0; r < 16; ++r) pmax = fmaxf(pmax, p1[r]);
  { auto rr = __builtin_amdgcn_permlane32_swap(__float_as_uint(pmax), __float_as_uint(pmax), false, false);
    pmax = fmaxf(__uint_as_float(rr[0]), __uint_as_float(rr[1])); }
  if (__builtin_expect(__all(pmax - m_reg <= THR / SCALE), 1)) { mn = m_reg; alpha = 1.f; }
  else { mn = fmaxf(m_reg, pmax); alpha = __builtin_amdgcn_exp2f((m_reg - mn) * C); m_reg = mn; }
  float mnC = -mn * C;
  for (int r = 0; r < 16; ++r) p0[r] = fmaf(p0[r], C, mnC); for (int r = 0; r < 16; ++r) p1[r] = fmaf(p1[r], C, mnC);
  for (int r = 0; r < 16; ++r) p0[r] = __builtin_amdgcn_exp2f(p0[r]);
}
__device__ __forceinline__ void finishSM(f32x16& p0, f32x16& p1, float alpha, float& l_reg, bf16x8& pa0, bf16x8& pa1, bf16x8& pa2, bf16x8& pa3) {
  for (int r = 0; r < 16; ++r) p1[r] = __builtin_amdgcn_exp2f(p1[r]);
  float ps = 0; for (int r = 0; r < 16; ++r) ps += p0[r]; for (int r = 0; r < 16; ++r) ps += p1[r];
  { auto rr = __builtin_amdgcn_permlane32_swap(__float_as_uint(ps), __float_as_uint(ps), false, false);
    ps = __uint_as_float(rr[0]) + __uint_as_float(rr[1]); }
  l_reg = l_reg * alpha + ps;
#define PK4(P, BASE, OUT) do { unsigned a0 = cvtpk(P[BASE + 0], P[BASE + 1]), a1 = cvtpk(P[BASE + 2], P[BASE + 3]);   \
    unsigned b0 = cvtpk(P[BASE + 4], P[BASE + 5]), b1 = cvtpk(P[BASE + 6], P[BASE + 7]);                              \
    auto r0 = __builtin_amdgcn_permlane32_swap(a0, b0, false, false); auto r1 = __builtin_amdgcn_permlane32_swap(a1, b1, false, false); \
    u32x4 w = {r0[0], r1[0], r0[1], r1[1]}; OUT = *reinterpret_cast<bf16x8*>(&w); } while (0)
  PK4(p0, 0, pa0); PK4(p0, 8, pa1); PK4(p1, 0, pa2); PK4(p1, 8, pa3);
#undef PK4
}
#define KSWZ2(row, colB) ((row) * 128 + ((colB) ^ (((row) & 7) << 4)))
__device__ __forceinline__ void qkt(f32x16& p0, f32x16& p1, const bf16* Ks, const bf16* KRs, const bf16x8* qr, const bf16x8* qrl, int r32, int hi) {
  p0 = f32x16{}; p1 = f32x16{};
#pragma unroll
  for (int d0 = 0; d0 < 8; ++d0) { int cb = (d0 * 16 + hi * 8) * 2;
    bf16x8 b0 = *reinterpret_cast<const bf16x8*>((const char*)Ks + KSWZ(r32, cb));
    bf16x8 b1 = *reinterpret_cast<const bf16x8*>((const char*)Ks + KSWZ(32 + r32, cb));
    p0 = __builtin_amdgcn_mfma_f32_32x32x16_bf16(b0, qr[d0], p0, 0, 0, 0);
    p1 = __builtin_amdgcn_mfma_f32_32x32x16_bf16(b1, qr[d0], p1, 0, 0, 0); }
#pragma unroll
  for (int d0 = 0; d0 < 4; ++d0) { int cb = (d0 * 16 + hi * 8) * 2;
    bf16x8 b0 = *reinterpret_cast<const bf16x8*>((const char*)KRs + KSWZ2(r32, cb));
    bf16x8 b1 = *reinterpret_cast<const bf16x8*>((const char*)KRs + KSWZ2(32 + r32, cb));
    const bf16x8 qv = qrl[d0 * 64];
    p0 = __builtin_amdgcn_mfma_f32_32x32x16_bf16(b0, qv, p0, 0, 0, 0);
    p1 = __builtin_amdgcn_mfma_f32_32x32x16_bf16(b1, qv, p1, 0, 0, 0); }
}
__device__ __forceinline__ int v_st(int k, int c) { const int kk = (k & ~0xC) | ((k & 4) << 1) | ((k & 8) >> 1); return ((kk >> 3) * 4 + (c >> 5)) * 512 + ((kk & 7) * 32 + (c & 31)) * 2; }
__device__ __forceinline__ int v_rd_base(int lane) { return ((lane & 3) << 3) | (((lane >> 2) & 3) << 6) | (((lane >> 4) & 1) << 5) | (((lane >> 5) & 1) << 8); }
constexpr int v_rd_off(int d0, int ks, int half) { return d0 * 512 + ks * 4096 + half * 2048; }
template <int OFF> __device__ __forceinline__ s16x4 tr_read(int vb) {
  s16x4 r; asm volatile("ds_read_b64_tr_b16 %0, %1 offset:%2" : "=&v"(r) : "v"(vb), "i"(OFF) : "memory"); return r;
}
template <int D0> __device__ __forceinline__ void pv_one(f32x16& od, int vb, bf16x8 pa0, bf16x8 pa1, bf16x8 pa2, bf16x8 pa3) {
  const s16x4 l0 = tr_read<v_rd_off(D0, 0, 0)>(vb), h0 = tr_read<v_rd_off(D0, 0, 1)>(vb), l1 = tr_read<v_rd_off(D0, 1, 0)>(vb), h1 = tr_read<v_rd_off(D0, 1, 1)>(vb);
  const s16x4 l2 = tr_read<v_rd_off(D0, 2, 0)>(vb), h2 = tr_read<v_rd_off(D0, 2, 1)>(vb), l3 = tr_read<v_rd_off(D0, 3, 0)>(vb), h3 = tr_read<v_rd_off(D0, 3, 1)>(vb);
  asm volatile("s_waitcnt lgkmcnt(0)" ::: "memory"); SBAR();
#define PK(L, H) (bf16x8){L[0], L[1], L[2], L[3], H[0], H[1], H[2], H[3]}
  od = __builtin_amdgcn_mfma_f32_32x32x16_bf16(pa0, PK(l0, h0), od, 0, 0, 0);
  od = __builtin_amdgcn_mfma_f32_32x32x16_bf16(pa1, PK(l1, h1), od, 0, 0, 0);
  od = __builtin_amdgcn_mfma_f32_32x32x16_bf16(pa2, PK(l2, h2), od, 0, 0, 0);
  od = __builtin_amdgcn_mfma_f32_32x32x16_bf16(pa3, PK(l3, h3), od, 0, 0, 0);
#undef PK
}
__device__ __forceinline__ void pv_d0(f32x16* o, int vb, bf16x8 pa0, bf16x8 pa1, bf16x8 pa2, bf16x8 pa3) {
  pv_one<0>(o[0], vb, pa0, pa1, pa2, pa3); pv_one<1>(o[1], vb, pa0, pa1, pa2, pa3); pv_one<2>(o[2], vb, pa0, pa1, pa2, pa3); pv_one<3>(o[3], vb, pa0, pa1, pa2, pa3);
}
constexpr int LDQ = 1536, LDK = 1024, LDV = 1024, LDKR = 64, LDO = 1024, SDEPTH = ATT_SDEPTH;
constexpr int SHM_V = KVBLK * 128 * 2, SHM_K = KVBLK * 128 * 2, SHM_KR = KVBLK * 64 * 2;
constexpr int SHM_QR = NW * 4 * 64 * 16;
constexpr int SHM_ATTN = 2 * SHM_V + 2 * SHM_K + 2 * SHM_KR + NW * 64 * 4 + SHM_QR;
__device__ __forceinline__ void attn_unit(const bf16* __restrict__ Qb, const bf16* __restrict__ Kh, const bf16* __restrict__ KRh, const bf16* __restrict__ Vh,
                                          bf16* __restrict__ Ob, int seq, char* lds) {
  using St = Stage<bf16>;
  const int tid = otid(), wid = tid >> 6, lane = tid & 63, r32 = lane & 31, hi = lane >> 5;
  bf16* V_lds = (bf16*)lds; bf16* K_lds = (bf16*)(lds + 2 * SHM_V); bf16* KR_lds = (bf16*)(lds + 2 * SHM_V + 2 * SHM_K);
  float* ws = (float*)(lds + 2 * SHM_V + 2 * SHM_K + 2 * SHM_KR) + wid * 64; float* li_l = ws; float* al_l = ws + 32;
  float m_reg = -1e30f, l_reg = 0; f32x16 o[4] = {}; bf16x8 qr[8];
  bf16x8* qrl = (bf16x8*)(lds + 2 * SHM_V + 2 * SHM_K + 2 * SHM_KR + NW * 64 * 4) + wid * 256 + lane;
  const bf16* Qw = Qb + (long)(wid * QBLK + r32) * LDQ + hi * 8;
#pragma unroll
  for (int d0 = 0; d0 < 8; ++d0) qr[d0] = St::ld8(Qw + d0 * 16);
#pragma unroll
  for (int d0 = 0; d0 < 4; ++d0) qrl[d0 * 64] = St::ld8(Qw + 128 + d0 * 16);
  const int sr = tid >> 4, sc = (tid & 15) * 8, vst0 = v_st(sr, sc), vst1 = v_st(32 + sr, sc);
  const int krr = tid >> 3, krc = (tid & 7) * 8;
  const int vb0 = (int)(uintptr_t)V_lds + v_rd_base(lane);
  struct { bf16x8 vs0, vs1, ks0, ks1, kr; } sr_[SDEPTH];
#define SLOAD(i, k0) do { sr_[i].vs0 = St::ld8(&Vh[(long)((k0) + sr) * LDV + sc]); sr_[i].vs1 = St::ld8(&Vh[(long)((k0) + 32 + sr) * LDV + sc]); \
    sr_[i].ks0 = St::ld8(&Kh[(long)((k0) + sr) * LDK + sc]); sr_[i].ks1 = St::ld8(&Kh[(long)((k0) + 32 + sr) * LDK + sc]); \
    sr_[i].kr = St::ld8(&KRh[(long)((k0) + krr) * LDKR + krc]); } while (0)
#define SWRITE(b, i) do { *(bf16x8*)((char*)V_lds + (b) * SHM_V + vst0) = sr_[i].vs0;          \
    *(bf16x8*)((char*)V_lds + (b) * SHM_V + vst1) = sr_[i].vs1; int kc = sc * 2;               \
    *(bf16x8*)((char*)K_lds + (b) * SHM_K + KSWZ(sr, kc)) = sr_[i].ks0;                       \
    *(bf16x8*)((char*)K_lds + (b) * SHM_K + KSWZ(32 + sr, kc)) = sr_[i].ks1;                  \
    *(bf16x8*)((char*)KR_lds + (b) * SHM_KR + KSWZ2(krr, krc * 2)) = sr_[i].kr; } while (0)
#define SWAIT() do { if constexpr (SDEPTH == 2) asm volatile("s_waitcnt vmcnt(5)" ::: "memory"); else asm volatile("s_waitcnt vmcnt(0)" ::: "memory"); } while (0)
#define RESC(a) do { if (__any((a) < 1.f)) { if (hi == 0) al_l[r32] = (a); asm volatile("s_waitcnt lgkmcnt(0)" ::: "memory"); \
    _Pragma("unroll") for (int d = 0; d < 4; ++d) _Pragma("unroll") for (int r = 0; r < 16; ++r) o[d][r] *= al_l[crow(r, hi)]; } } while (0)
  f32x16 pA0, pA1, pB0, pB1; float mnA, mnB, alA, alB; bf16x8 pa0, pa1, pa2, pa3; const int NT = seq / KVBLK;
  constexpr int SE = 0, SO = SDEPTH - 1;
  SLOAD(SE, 0); asm volatile("s_waitcnt vmcnt(0)" ::: "memory"); SWRITE(0, SE); __syncthreads();
  qkt(pA0, pA1, K_lds, KR_lds, qr, qrl, r32, hi); partialSM(pA0, pA1, m_reg, mnA, alA);
  SLOAD(SO, KVBLK); if constexpr (SDEPTH == 2) { if (2 < NT) SLOAD(SE, 2 * KVBLK); }
  SWAIT(); SWRITE(1, SO); __syncthreads();
  for (int j = 1; j + 1 < NT; j += 2) {
    SBAR(); qkt(pB0, pB1, (bf16*)((char*)K_lds + SHM_K), (bf16*)((char*)KR_lds + SHM_KR), qr, qrl, r32, hi);
    finishSM(pA0, pA1, alA, l_reg, pa0, pa1, pa2, pa3); SBAR();
    SLOAD(SO, (j + SDEPTH) * KVBLK); SBAR();
    pv_d0(o, vb0, pa0, pa1, pa2, pa3); partialSM(pB0, pB1, m_reg, mnB, alB);
    __syncthreads(); SWAIT(); SWRITE(0, SE);
    RESC(alB); __syncthreads();
    SBAR(); qkt(pA0, pA1, K_lds, KR_lds, qr, qrl, r32, hi);
    finishSM(pB0, pB1, alB, l_reg, pa0, pa1, pa2, pa3); SBAR();
    if (SDEPTH == 1 || j + 3 < NT) SLOAD(SE, (j + 1 + SDEPTH) * KVBLK); SBAR();
    pv_d0(o, vb0 + (int)SHM_V, pa0, pa1, pa2, pa3); partialSM(pA0, pA1, m_reg, mnA, alA);
    __syncthreads(); SWAIT(); SWRITE(1, SO);
    RESC(alA); __syncthreads();
  }
  SBAR(); qkt(pB0, pB1, (bf16*)((char*)K_lds + SHM_K), (bf16*)((char*)KR_lds + SHM_KR), qr, qrl, r32, hi);
  finishSM(pA0, pA1, alA, l_reg, pa0, pa1, pa2, pa3); SBAR();
  pv_d0(o, vb0, pa0, pa1, pa2, pa3); partialSM(pB0, pB1, m_reg, mnB, alB);
  __syncthreads(); RESC(alB);
  finishSM(pB0, pB1, alB, l_reg, pa0, pa1, pa2, pa3); SBAR();
  pv_d0(o, vb0 + (int)SHM_V, pa0, pa1, pa2, pa3);
  if (hi == 0) li_l[r32] = l_reg; asm volatile("s_waitcnt lgkmcnt(0)" ::: "memory");
  float rli[16];
#pragma unroll
  for (int r = 0; r < 16; ++r) rli[r] = __builtin_amdgcn_rcpf(li_l[crow(r, hi)]);
  bf16* Ow = Ob + (long)(wid * QBLK) * LDO;
#pragma unroll
  for (int r = 0; r < 16; ++r) { int orow = crow(r, hi);
#pragma unroll
    for (int d0 = 0; d0 < 4; ++d0) Ow[(long)orow * LDO + d0 * 32 + r32] = __float2bfloat16(o[d0][r] * rli[r]); }
  __syncthreads();
#undef SLOAD
#undef SWRITE
#undef SWAIT
#undef RESC
}
#undef SBAR
}
constexpr int BATCH = 4, SEQ = 8192, DM = 1024, DEPTH = 4, DFF = 2816, MT = BATCH * SEQ;
constexpr int NH = 8, QLR = 256, KVLR = 128, QKD = 192;
constexpr float EPS = 1e-6f;
constexpr size_t MiB = 1u << 20;
constexpr size_t WS_WFFI = 1 * MiB;
constexpr size_t WS_WFFO = 89 * MiB;
constexpr size_t WS_WHIN = 133 * MiB;
constexpr size_t WS_WHO  = 153 * MiB;
constexpr size_t WS_WMIN = 157 * MiB;
constexpr size_t WS_WUQ  = 159 * MiB;
constexpr size_t WS_WUKV = 161 * MiB;
constexpr size_t WS_WMO  = 162 * MiB;
constexpr size_t WS_COS  = 166 * MiB;
constexpr size_t WS_SIN  = 170 * MiB;
constexpr size_t WS_LB   = 174 * MiB;
constexpr size_t WS_HN   = 176 * MiB;
constexpr size_t WS_Y    = 240 * MiB;
constexpr size_t WS_YB   = 304 * MiB;
constexpr size_t WS_R    = 368 * MiB;
constexpr size_t WS_END  = 704 * MiB;
constexpr size_t R_ACT = 0;
constexpr size_t R_C = 0, R_QB = 0, R_CQ = 96 * MiB, R_CKV = 112 * MiB, R_KR = 120 * MiB, R_KN = 124 * MiB, R_VB = 188 * MiB, R_O = 252 * MiB;
constexpr size_t R_QH = 0, R_VH = 64 * MiB, R_GH = 128 * MiB, R_KF = 192 * MiB, R_HO = 0;

constexpr int LDS_RING = 131072, LDS_BYTES = LDS_RING + 2048;
typedef unsigned short bf16_t;
typedef float f32x4 __attribute__((ext_vector_type(4)));
typedef float f32x2 __attribute__((ext_vector_type(2)));
typedef unsigned u32x4 __attribute__((ext_vector_type(4)));
typedef unsigned u32x2 __attribute__((ext_vector_type(2)));
typedef _Float16 h16x2 __attribute__((ext_vector_type(2)));
#define LAS __attribute__((address_space(3)))

__device__ __constant__ double ROPE_INVF[32] = {1.0, 0.7498942093324559, 0.5623413251903491, 0.4216965034285822, 0.31622776601683794, 0.23713737056616552, 0.1778279410038923, 0.1333521432163324, 0.1, 0.07498942093324558, 0.05623413251903491, 0.042169650342858224, 0.03162277660168379, 0.023713737056616554, 0.01778279410038923, 0.01333521432163324, 0.01, 0.007498942093324558, 0.005623413251903491, 0.004216965034285823, 0.0031622776601683794, 0.0023713737056616554, 0.0017782794100389228, 0.001333521432163324, 0.001, 0.0007498942093324559, 0.0005623413251903491, 0.00042169650342858224, 0.00031622776601683794, 0.00023713737056616554, 0.00017782794100389227, 0.0001333521432163324};

__device__ __forceinline__ unsigned pk2(float lo, float hi) { return pg8::cvt_pk_bf16(lo, hi); }
__device__ __forceinline__ float silu_f(float g) { return g * __builtin_amdgcn_rcpf(1.0f + __expf(-g)); }
__device__ __forceinline__ float wave_sum(float v) {
#pragma unroll
    for (int o = 1; o < 64; o <<= 1) v += __shfl_xor(v, o);
    return v;
}
__device__ __forceinline__ float half_sum(float v) {
#pragma unroll
    for (int o = 1; o < 32; o <<= 1) v += __shfl_xor(v, o);
    return v;
}

using pg8::Unit;
struct EpiSwiglu { static constexpr bool PERM = true, AFTER_DRAIN = false; bf16_t* O;
    __device__ __forceinline__ void operator()(const pg8::f32x4 (&acc)[2][2][4][2], const Unit& u, int wr, int wc, int fr, int fq) const {
        const int row0 = u.pm * 256 + wr * 64 + fr, col0 = u.pn * 128 + wc * 32 + 8 * fq;
#pragma unroll
        for (int ai = 0; ai < 2; ++ai)
#pragma unroll
            for (int m = 0; m < 4; ++m) { bf16_t* p = O + (size_t)(row0 + ai * 128 + m * 16) * DFF + col0;
                const pg8::f32x4 g0 = acc[ai][0][m][0], g1 = acc[ai][0][m][1], u0 = acc[ai][1][m][0], u1 = acc[ai][1][m][1];
                u32x4 w; w.x = pk2(silu_f(g0[0]) * u0[0], silu_f(g0[1]) * u0[1]); w.y = pk2(silu_f(g0[2]) * u0[2], silu_f(g0[3]) * u0[3]);
                w.z = pk2(silu_f(g1[0]) * u1[0], silu_f(g1[1]) * u1[1]); w.w = pk2(silu_f(g1[2]) * u1[2], silu_f(g1[3]) * u1[3]);
                *(u32x4*)p = w; }
    }
};
struct EpiF32 { static constexpr bool PERM = false, AFTER_DRAIN = false; float* O; int ldc;
    __device__ __forceinline__ void operator()(const pg8::f32x4 (&acc)[2][2][4][2], const Unit& u, int wr, int wc, int fr, int fq) const {
        const int row0 = u.pm * 256 + wr * 64 + fr, col0 = u.pn * 256 + wc * 32 + 4 * fq;
#pragma unroll
        for (int ai = 0; ai < 2; ++ai)
#pragma unroll
            for (int m = 0; m < 4; ++m) { float* p = O + (size_t)(row0 + ai * 128 + m * 16) * ldc + col0;
#pragma unroll
                for (int bj = 0; bj < 2; ++bj)
#pragma unroll
                    for (int n = 0; n < 2; ++n) *(pg8::f32x4*)(p + bj * 128 + n * 16) = acc[ai][bj][m][n]; }
    }
};
struct EpiB16 { static constexpr bool PERM = true, AFTER_DRAIN = false; bf16_t* O; int ldc;
    __device__ __forceinline__ void operator()(const pg8::f32x4 (&acc)[2][2][4][2], const Unit& u, int wr, int wc, int fr, int fq) const {
        const int row0 = u.pm * 256 + wr * 64 + fr, col0 = u.pn * 256 + wc * 32 + 8 * fq;
#pragma unroll
        for (int ai = 0; ai < 2; ++ai)
#pragma unroll
            for (int m = 0; m < 4; ++m) { bf16_t* p = O + (size_t)(row0 + ai * 128 + m * 16) * ldc + col0;
#pragma unroll
                for (int bj = 0; bj < 2; ++bj) { const pg8::f32x4 v0 = acc[ai][bj][m][0], v1 = acc[ai][bj][m][1];
                    u32x4 w; w.x = pk2(v0[0], v0[1]); w.y = pk2(v0[2], v0[3]); w.z = pk2(v1[0], v1[1]); w.w = pk2(v1[2], v1[3]);
                    *(u32x4*)(p + bj * 128) = w; } }
    }
};
struct EpiQ { static constexpr bool PERM = true, AFTER_DRAIN = false; bf16_t* O; const float* cs; const float* sn;
    __device__ __forceinline__ void operator()(const pg8::f32x4 (&acc)[2][2][4][2], const Unit& u, int wr, int wc, int fr, int fq) const {
        const int row0 = u.pm * 256 + wr * 64 + fr;
#pragma unroll
        for (int bj = 0; bj < 2; ++bj) { const int col0 = u.pn * 256 + bj * 128 + wc * 32 + 8 * fq, d = col0 % QKD; const bool rot = d >= 128; const int i0 = (d - 128) >> 1;
#pragma unroll
            for (int ai = 0; ai < 2; ++ai)
#pragma unroll
                for (int m = 0; m < 4; ++m) { const int row = row0 + ai * 128 + m * 16; pg8::f32x4 v0 = acc[ai][bj][m][0], v1 = acc[ai][bj][m][1];
                    if (rot) { const pg8::f32x4 c = *(const pg8::f32x4*)(cs + (size_t)row * 32 + i0), s = *(const pg8::f32x4*)(sn + (size_t)row * 32 + i0);
                        pg8::f32x4 a, b; a[0] = v0[0] * c[0] - v0[1] * s[0]; a[1] = v0[0] * s[0] + v0[1] * c[0]; a[2] = v0[2] * c[1] - v0[3] * s[1]; a[3] = v0[2] * s[1] + v0[3] * c[1];
                        b[0] = v1[0] * c[2] - v1[1] * s[2]; b[1] = v1[0] * s[2] + v1[1] * c[2]; b[2] = v1[2] * c[3] - v1[3] * s[3]; b[3] = v1[2] * s[3] + v1[3] * c[3]; v0 = a; v1 = b; }
                    u32x4 w; w.x = pk2(v0[0], v0[1]); w.y = pk2(v0[2], v0[3]); w.z = pk2(v1[0], v1[1]); w.w = pk2(v1[2], v1[3]);
                    *(u32x4*)(O + (size_t)row * 1536 + col0) = w; } }
    }
};
struct EpiKV { static constexpr bool PERM = true, AFTER_DRAIN = false; bf16_t* Kn; bf16_t* Vb;
    __device__ __forceinline__ void operator()(const pg8::f32x4 (&acc)[2][2][4][2], const Unit& u, int wr, int wc, int fr, int fq) const {
        const int row0 = u.pm * 256 + wr * 64 + fr, col0 = u.pn * 128 + wc * 32 + 8 * fq;
#pragma unroll
        for (int bj = 0; bj < 2; ++bj) { bf16_t* base = bj ? Vb : Kn;
#pragma unroll
            for (int ai = 0; ai < 2; ++ai)
#pragma unroll
                for (int m = 0; m < 4; ++m) { const pg8::f32x4 v0 = acc[ai][bj][m][0], v1 = acc[ai][bj][m][1];
                    u32x4 w; w.x = pk2(v0[0], v0[1]); w.y = pk2(v0[2], v0[3]); w.z = pk2(v1[0], v1[1]); w.w = pk2(v1[2], v1[3]);
                    *(u32x4*)(base + (size_t)(row0 + ai * 128 + m * 16) * 1024 + col0) = w; } }
    }
};
__device__ __forceinline__ unsigned pkh2(float a, float b) { const h16x2 h = {(_Float16)a, (_Float16)b}; return __builtin_bit_cast(unsigned, h); }
__device__ __forceinline__ float kgate(float om, float z) { return om * __builtin_amdgcn_rcpf(1.0f + __expf(z)); }
struct EpiHgrn { static constexpr bool PERM = true, AFTER_DRAIN = false; bf16_t* Qh; bf16_t* Vh; bf16_t* Gh; unsigned short* KF; const float* lb;
    __device__ __forceinline__ void operator()(const pg8::f32x4 (&acc)[2][2][4][2], const Unit& u, int wr, int wc, int fr, int fq) const {
        const int row0 = u.pm * 256 + wr * 64 + fr, seg = u.pn >> 2;
#pragma unroll
        for (int bj = 0; bj < 2; ++bj) { const int cc = (u.pn & 3) * 256 + bj * 128 + wc * 32 + 8 * fq;
            if (seg == 1 || seg == 2) {
                const pg8::f32x4 om0 = 1.0f - *(const pg8::f32x4*)(lb + (seg - 1) * 1024 + cc), om1 = 1.0f - *(const pg8::f32x4*)(lb + (seg - 1) * 1024 + cc + 4);
                unsigned short* base = KF + (size_t)(seg - 1) * MT * 1024;
#pragma unroll
                for (int ai = 0; ai < 2; ++ai)
#pragma unroll
                    for (int m = 0; m < 4; ++m) { const size_t off = (size_t)(row0 + ai * 128 + m * 16) * 1024 + cc; const pg8::f32x4 v0 = acc[ai][bj][m][0], v1 = acc[ai][bj][m][1];
                        u32x4 w; w.x = pkh2(kgate(om0[0], v0[0]), kgate(om0[1], v0[1])); w.y = pkh2(kgate(om0[2], v0[2]), kgate(om0[3], v0[3]));
                        w.z = pkh2(kgate(om1[0], v1[0]), kgate(om1[1], v1[1])); w.w = pkh2(kgate(om1[2], v1[2]), kgate(om1[3], v1[3]));
                        *(u32x4*)(base + off) = w; }
            } else if (seg == 3) {
#pragma unroll
                for (int ai = 0; ai < 2; ++ai)
#pragma unroll
                    for (int m = 0; m < 4; ++m) { const size_t off = (size_t)(row0 + ai * 128 + m * 16) * 1024 + cc; const pg8::f32x4 v0 = acc[ai][bj][m][0], v1 = acc[ai][bj][m][1];
                        u32x4 w; w.x = pk2(v0[0], v0[1]); w.y = pk2(v0[2], v0[3]); w.z = pk2(v1[0], v1[1]); w.w = pk2(v1[2], v1[3]);
                        *(u32x4*)(Vh + off) = w; }
            } else { bf16_t* base = seg == 0 ? Qh : Gh;
#pragma unroll
                for (int ai = 0; ai < 2; ++ai)
#pragma unroll
                    for (int m = 0; m < 4; ++m) { const size_t off = (size_t)(row0 + ai * 128 + m * 16) * 1024 + cc; const pg8::f32x4 v0 = acc[ai][bj][m][0], v1 = acc[ai][bj][m][1];
                        u32x4 w; w.x = pk2(silu_f(v0[0]), silu_f(v0[1])); w.y = pk2(silu_f(v0[2]), silu_f(v0[3])); w.z = pk2(silu_f(v1[0]), silu_f(v1[1])); w.w = pk2(silu_f(v1[2]), silu_f(v1[3]));
                        *(u32x4*)(base + off) = w; } } }
    }
};

__device__ __forceinline__ int src_col(int mode, int n) {
    if (mode == 1) { const int t = n >> 8, j = n & 255; return j < 128 ? t * 128 + j : DFF + t * 128 + (j - 128); }
    if (mode == 2) { if (n < 384) return n; if (n >= 448) return -1; const int j = n - 384; return 384 + (j >> 1) + 32 * (j & 1); }
    if (mode == 3) { const int h = n / QKD, d = n % QKD; if (d < 128) return n; const int j = d - 128; return h * QKD + 128 + (j >> 1) + 32 * (j & 1); }
    return n;
}
__device__ __forceinline__ void xpose_item(const float* __restrict__ W, int K, int Nsrc, int Ndst, int mode, bf16_t* __restrict__ WT, LAS float* scr, int item, int lane) {
    const int nblk = Ndst / 32, kb = item / nblk, nb = item % nblk, k0 = 64 * kb, n0 = 32 * nb;
    if (mode <= 1) {
        const int sc0 = src_col(mode, n0) + (lane & 7) * 4;
#pragma unroll
        for (int i = 0; i < 8; ++i) { const int kk = 8 * i + (lane >> 3); const f32x4 v = *(const f32x4*)(W + (size_t)(k0 + kk) * Nsrc + sc0);
            LAS float* d = scr + kk * 33 + (lane & 7) * 4; d[0] = v[0]; d[1] = v[1]; d[2] = v[2]; d[3] = v[3]; }
    } else {
        const int sc = src_col(mode, n0 + (lane & 31));
#pragma unroll 8
        for (int i = 0; i < 32; ++i) { const int kk = 2 * i + (lane >> 5); scr[kk * 33 + (lane & 31)] = sc >= 0 ? W[(size_t)(k0 + kk) * Nsrc + sc] : 0.f; }
    }
    asm volatile("s_waitcnt lgkmcnt(0)" ::: "memory");
    const int c = lane & 7;
#pragma unroll
    for (int j = 0; j < 4; ++j) { const int n = (lane >> 3) + 8 * j; const LAS float* s = scr + (8 * c) * 33 + n;
        u32x4 o; o.x = pk2(s[0 * 33], s[1 * 33]); o.y = pk2(s[2 * 33], s[3 * 33]); o.z = pk2(s[4 * 33], s[5 * 33]); o.w = pk2(s[6 * 33], s[7 * 33]);
        *(u32x4*)(WT + (size_t)(n0 + n) * K + k0 + 8 * c) = o; }
    asm volatile("s_waitcnt lgkmcnt(0)" ::: "memory");
}

__device__ __forceinline__ void row_init(const float* __restrict__ xin, float* __restrict__ X, bf16_t* __restrict__ HN, const float* __restrict__ g, int lane) {
    const f32x4* xr = (const f32x4*)xin + lane; f32x4 v[4]; float s = 0.f;
#pragma unroll
    for (int j = 0; j < 4; ++j) { v[j] = xr[64 * j]; s += (v[j][0] * v[j][0] + v[j][1] * v[j][1]) + (v[j][2] * v[j][2] + v[j][3] * v[j][3]); }
    const float r = rsqrtf(wave_sum(s) * (1.f / DM) + EPS);
#pragma unroll
    for (int j = 0; j < 4; ++j) { ((f32x4*)X + lane)[64 * j] = v[j]; const f32x4 gg = ((const f32x4*)g + lane)[64 * j];
        u32x2 w; w.x = pk2(v[j][0] * r * gg[0], v[j][1] * r * gg[1]); w.y = pk2(v[j][2] * r * gg[2], v[j][3] * r * gg[3]); ((u32x2*)HN + lane)[64 * j] = w; }
}
__device__ __forceinline__ void row_post(const bf16_t* __restrict__ Y, float* __restrict__ X, bf16_t* __restrict__ HN, float scale, const float* __restrict__ gp, const float* __restrict__ gn, int lane) {
    f32x4 y[4], x[4]; float s = 0.f;
#pragma unroll
    for (int j = 0; j < 4; ++j) { const u32x2 yb = ((const u32x2*)Y + lane)[64 * j]; y[j] = (f32x4){__uint_as_float(yb.x << 16), __uint_as_float(yb.x & 0xffff0000u), __uint_as_float(yb.y << 16), __uint_as_float(yb.y & 0xffff0000u)};
        x[j] = ((const f32x4*)X + lane)[64 * j]; s += (y[j][0] * y[j][0] + y[j][1] * y[j][1]) + (y[j][2] * y[j][2] + y[j][3] * y[j][3]); }
    const float r = rsqrtf(wave_sum(s) * (1.f / DM) + EPS) * scale; float s2 = 0.f;
#pragma unroll
    for (int j = 0; j < 4; ++j) { const f32x4 gg = ((const f32x4*)gp + lane)[64 * j]; x[j] = x[j] + y[j] * r * gg; ((f32x4*)X + lane)[64 * j] = x[j];
        s2 += (x[j][0] * x[j][0] + x[j][1] * x[j][1]) + (x[j][2] * x[j][2] + x[j][3] * x[j][3]); }
    if (HN) { const float r2 = rsqrtf(wave_sum(s2) * (1.f / DM) + EPS);
#pragma unroll
        for (int j = 0; j < 4; ++j) { const f32x4 gg = ((const f32x4*)gn + lane)[64 * j];
            u32x2 w; w.x = pk2(x[j][0] * r2 * gg[0], x[j][1] * r2 * gg[1]); w.y = pk2(x[j][2] * r2 * gg[2], x[j][3] * r2 * gg[3]); ((u32x2*)HN + lane)[64 * j] = w; } }
}
template <int NR>
__device__ __forceinline__ void row_post_n(const bf16_t* __restrict__ Y, float* __restrict__ X, bf16_t* __restrict__ HN, size_t row_stride, float scale, const float* __restrict__ gp, const float* __restrict__ gn, int lane) {
    f32x4 y[NR][4], x[NR][4]; float s[NR];
#pragma unroll
    for (int i = 0; i < NR; ++i) {
#pragma unroll
        for (int j = 0; j < 4; ++j) { const u32x2 yb = ((const u32x2*)(Y + i * row_stride) + lane)[64 * j];
            y[i][j] = (f32x4){__uint_as_float(yb.x << 16), __uint_as_float(yb.x & 0xffff0000u), __uint_as_float(yb.y << 16), __uint_as_float(yb.y & 0xffff0000u)};
            x[i][j] = ((const f32x4*)(X + i * row_stride) + lane)[64 * j]; } }
    f32x4 gpv[4];
#pragma unroll
    for (int j = 0; j < 4; ++j) gpv[j] = ((const f32x4*)gp + lane)[64 * j];
#pragma unroll
    for (int i = 0; i < NR; ++i) { float a = 0.f;
#pragma unroll
        for (int j = 0; j < 4; ++j) a += (y[i][j][0] * y[i][j][0] + y[i][j][1] * y[i][j][1]) + (y[i][j][2] * y[i][j][2] + y[i][j][3] * y[i][j][3]);
        s[i] = a; }
#pragma unroll
    for (int o = 1; o < 64; o <<= 1) {
#pragma unroll
        for (int i = 0; i < NR; ++i) s[i] += __shfl_xor(s[i], o); }
    float s2[NR];
#pragma unroll
    for (int i = 0; i < NR; ++i) { const float r = rsqrtf(s[i] * (1.f / DM) + EPS) * scale; float a = 0.f;
#pragma unroll
        for (int j = 0; j < 4; ++j) { x[i][j] = x[i][j] + y[i][j] * r * gpv[j]; ((f32x4*)(X + i * row_stride) + lane)[64 * j] = x[i][j];
            a += (x[i][j][0] * x[i][j][0] + x[i][j][1] * x[i][j][1]) + (x[i][j][2] * x[i][j][2] + x[i][j][3] * x[i][j][3]); }
        s2[i] = a; }
    if (HN) {
#pragma unroll
        for (int j = 0; j < 4; ++j) gpv[j] = ((const f32x4*)gn + lane)[64 * j];
#pragma unroll
        for (int o = 1; o < 64; o <<= 1) {
#pragma unroll
            for (int i = 0; i < NR; ++i) s2[i] += __shfl_xor(s2[i], o); }
#pragma unroll
        for (int i = 0; i < NR; ++i) { const float r2 = rsqrtf(s2[i] * (1.f / DM) + EPS);
#pragma unroll
            for (int j = 0; j < 4; ++j) { u32x2 w; w.x = pk2(x[i][j][0] * r2 * gpv[j][0], x[i][j][1] * r2 * gpv[j][1]); w.y = pk2(x[i][j][2] * r2 * gpv[j][2], x[i][j][3] * r2 * gpv[j][3]);
                ((u32x2*)(HN + i * row_stride) + lane)[64 * j] = w; } } }
}
__device__ __forceinline__ void row_mla(const float* __restrict__ C, bf16_t* __restrict__ CQ, bf16_t* __restrict__ CKV, bf16_t* __restrict__ KR, const float* __restrict__ qn, const float* __restrict__ kvn,
                                        const float* __restrict__ cs, const float* __restrict__ sn, int lane) {
    const f32x4 a = ((const f32x4*)C)[2 * lane], b = ((const f32x4*)C)[2 * lane + 1];
    float s = (a[0] * a[0] + a[1] * a[1]) + (a[2] * a[2] + a[3] * a[3]) + (b[0] * b[0] + b[1] * b[1]) + (b[2] * b[2] + b[3] * b[3]);
#pragma unroll
    for (int o = 1; o < 16; o <<= 1) s += __shfl_xor(s, o);
    const float s16 = s, s32 = s16 + __shfl_xor(s16, 16);
    float v[8] = {a[0], a[1], a[2], a[3], b[0], b[1], b[2], b[3]};
    if (lane < 32) { const float r = rsqrtf(s32 * (1.f / QLR) + EPS); const f32x4 g0 = ((const f32x4*)qn)[2 * lane], g1 = ((const f32x4*)qn)[2 * lane + 1];
        u32x4 w; w.x = pk2(v[0] * r * g0[0], v[1] * r * g0[1]); w.y = pk2(v[2] * r * g0[2], v[3] * r * g0[3]); w.z = pk2(v[4] * r * g1[0], v[5] * r * g1[1]); w.w = pk2(v[6] * r * g1[2], v[7] * r * g1[3]);
        ((u32x4*)CQ)[lane] = w;
    } else if (lane < 48) { const int l = lane - 32; const float r = rsqrtf(s16 * (1.f / KVLR) + EPS); const f32x4 g0 = ((const f32x4*)kvn)[2 * l], g1 = ((const f32x4*)kvn)[2 * l + 1];
        u32x4 w; w.x = pk2(v[0] * r * g0[0], v[1] * r * g0[1]); w.y = pk2(v[2] * r * g0[2], v[3] * r * g0[3]); w.z = pk2(v[4] * r * g1[0], v[5] * r * g1[1]); w.w = pk2(v[6] * r * g1[2], v[7] * r * g1[3]);
        ((u32x4*)CKV)[l] = w;
    } else if (lane < 56) { const int l = lane - 48; const f32x4 c = ((const f32x4*)cs)[l], sv = ((const f32x4*)sn)[l];
        u32x4 w; w.x = pk2(v[0] * c[0] - v[1] * sv[0], v[0] * sv[0] + v[1] * c[0]); w.y = pk2(v[2] * c[1] - v[3] * sv[1], v[2] * sv[1] + v[3] * c[1]);
        w.z = pk2(v[4] * c[2] - v[5] * sv[2], v[4] * sv[2] + v[5] * c[2]); w.w = pk2(v[6] * c[3] - v[7] * sv[3], v[6] * sv[3] + v[7] * c[3]);
        ((u32x4*)KR)[l] = w; }
}
__device__ __forceinline__ void row_hgrn(const bf16_t* __restrict__ Oa, const bf16_t* __restrict__ Gh, bf16_t* __restrict__ HO, const float* __restrict__ on, int lane) {
#pragma unroll
    for (int j = 0; j < 4; ++j) { const u32x2 a = ((const u32x2*)Oa + lane)[64 * j], b = ((const u32x2*)(Oa + (size_t)MT * 1024) + lane)[64 * j];
        f32x4 o; o[0] = __uint_as_float(a.x << 16) + __uint_as_float(b.x << 16); o[1] = __uint_as_float(a.x & 0xffff0000u) + __uint_as_float(b.x & 0xffff0000u);
        o[2] = __uint_as_float(a.y << 16) + __uint_as_float(b.y << 16); o[3] = __uint_as_float(a.y & 0xffff0000u) + __uint_as_float(b.y & 0xffff0000u);
        const float s = half_sum((o[0] * o[0] + o[1] * o[1]) + (o[2] * o[2] + o[3] * o[3]));
        const float r = rsqrtf(s * (1.f / 128.f) + EPS); const f32x4 gg = ((const f32x4*)on + lane)[64 * j]; const u32x2 gb = ((const u32x2*)Gh + lane)[64 * j];
        const float g0 = __uint_as_float(gb.x << 16), g1 = __uint_as_float(gb.x & 0xffff0000u), g2 = __uint_as_float(gb.y << 16), g3 = __uint_as_float(gb.y & 0xffff0000u);
        u32x2 w; w.x = pk2(o[0] * r * gg[0] * g0, o[1] * r * gg[1] * g1); w.y = pk2(o[2] * r * gg[2] * g2, o[3] * r * gg[3] * g3); ((u32x2*)HO + lane)[64 * j] = w; }
}
__device__ __forceinline__ f32x2 h2f2_(unsigned u) { const h16x2 h = __builtin_bit_cast(h16x2, u); return (f32x2){(float)h[0], (float)h[1]}; }
__device__ __forceinline__ void scan_phase(LAS unsigned char* lds, const bf16_t* __restrict__ Qh, const bf16_t* __restrict__ Vh, const unsigned short* __restrict__ KF, bf16_t* __restrict__ OP, int G, int bx) {
    int tid = threadIdx.x; asm volatile("" : "+v"(tid)); const int wid = __builtin_amdgcn_readfirstlane(tid >> 6), lane = tid & 63;
    const int st = tid >> 4, sc8 = (tid & 15) * 8, sv = tid >> 3, vc4 = (tid & 7) * 4;
    constexpr int OFF_K = 16384, OFF_Q = 32768, OFF_V = 49152, OFF_P = 53248;
    for (int item = bx; item < 256; item += G) {
        const int dir = item & 1, dvq = (item >> 1) & 3, h = (item >> 3) & 7, b = item >> 6;
        const size_t kcol = h * 128 + sc8, vcol = h * 128 + dvq * 32 + vc4;
        const unsigned short* KFd = KF + (size_t)dir * MT * 1024; bf16_t* OPd = OP + (size_t)dir * MT * 1024;
        u32x4 rk, rq; u32x2 rv = {0u, 0u};
#define SC_GLOAD(blk) do { { const int tt = (blk) * 32 + st; const size_t m = (size_t)b * SEQ + (dir ? SEQ - 1 - tt : tt); \
        rk = *(const u32x4*)(KFd + m * 1024 + kcol); rq = *(const u32x4*)(Qh + m * 1024 + kcol); } \
        if (tid < 256) { const int tt = (blk) * 32 + sv; const size_t m = (size_t)b * SEQ + (dir ? SEQ - 1 - tt : tt); rv = *(const u32x2*)(Vh + m * 1024 + vcol); } } while (0)
#define SC_H2F(u_) h2f2_(u_)
#define SC_LWRITE() do { LAS unsigned char* B_ = lds + (st * 128 + sc8) * 4; \
        const f32x2 ka = SC_H2F(rk.x), kb = SC_H2F(rk.y), kc = SC_H2F(rk.z), kd = SC_H2F(rk.w); \
        const f32x4 k0_ = {ka[0], ka[1], kb[0], kb[1]}, k1_ = {kc[0], kc[1], kd[0], kd[1]}; \
        *(LAS f32x4*)(B_ + OFF_K) = k0_; *(LAS f32x4*)(B_ + OFF_K + 16) = k1_; \
        *(LAS f32x4*)(B_ + OFF_Q) = (f32x4){__uint_as_float(rq.x << 16), __uint_as_float(rq.x & 0xffff0000u), __uint_as_float(rq.y << 16), __uint_as_float(rq.y & 0xffff0000u)}; \
        *(LAS f32x4*)(B_ + OFF_Q + 16) = (f32x4){__uint_as_float(rq.z << 16), __uint_as_float(rq.z & 0xffff0000u), __uint_as_float(rq.w << 16), __uint_as_float(rq.w & 0xffff0000u)}; \
        if (tid < 256) *(LAS f32x4*)(lds + OFF_V + (sv * 32 + vc4) * 4) = (f32x4){__uint_as_float(rv.x << 16), __uint_as_float(rv.x & 0xffff0000u), __uint_as_float(rv.y << 16), __uint_as_float(rv.y & 0xffff0000u)}; } while (0)
        SC_GLOAD(0);
        const int dksub = ((lane >> 3) & 1) | ((lane >> 5) << 1), dvp = (lane & 7) | (((lane >> 4) & 1) << 3);
        const LAS unsigned char* Bc = lds + (16 * wid + 4 * dksub) * 4;
        const LAS unsigned char* Vc = lds + OFF_V + dvp * 8;
        LAS unsigned char* Pw = lds + OFF_P + (wid * 4 + dksub) * 2048 + dvp * 4;
        f32x2 S2[4];
#pragma unroll
        for (int j = 0; j < 4; ++j) S2[j] = (f32x2){0.f, 0.f};
        for (int blk = 0; blk < SEQ / 32; ++blk) {
            SC_LWRITE();
            if (blk + 1 < SEQ / 32) SC_GLOAD(blk + 1);
            __syncthreads();
            f32x4 k4n = *(const LAS f32x4*)(Bc + OFF_K), q4n = *(const LAS f32x4*)(Bc + OFF_Q); f32x2 v2n = *(const LAS f32x2*)(Vc);
            f32x4 k4m = *(const LAS f32x4*)(Bc + OFF_K + 512), q4m = *(const LAS f32x4*)(Bc + OFF_Q + 512); f32x2 v2m = *(const LAS f32x2*)(Vc + 128);
#pragma unroll
            for (int t = 0; t < 32; ++t) {
                const f32x4 k4 = k4n, q4 = q4n; const f32x2 v2 = v2n;
                k4n = k4m; q4n = q4m; v2n = v2m;
                { const int tn = (t + 2) & 31;
                  k4m = *(const LAS f32x4*)(Bc + OFF_K + tn * 512); q4m = *(const LAS f32x4*)(Bc + OFF_Q + tn * 512); v2m = *(const LAS f32x2*)(Vc + tn * 128); }
                __builtin_amdgcn_sched_barrier(0);
#pragma unroll
                for (int j = 0; j < 4; ++j) S2[j] = S2[j] + (v2 - S2[j]) * k4[j];
                const f32x2 o2 = (S2[0] * q4[0] + S2[1] * q4[1]) + (S2[2] * q4[2] + S2[3] * q4[3]);
                *(LAS unsigned*)(Pw + t * 64) = pk2(o2[0], o2[1]);
            }
            __syncthreads();
            if (tid < 256) { const LAS unsigned char* Pr = lds + OFF_P + (sv * 32 + vc4) * 2; f32x4 acc = {0.f, 0.f, 0.f, 0.f};
#pragma unroll
              for (int g = 0; g < 32; ++g) { const u32x2 pv = *(const LAS u32x2*)(Pr + g * 2048);
                  acc[0] += __uint_as_float(pv.x << 16); acc[1] += __uint_as_float(pv.x & 0xffff0000u); acc[2] += __uint_as_float(pv.y << 16); acc[3] += __uint_as_float(pv.y & 0xffff0000u); }
              const int tt = blk * 32 + sv; const size_t m = (size_t)b * SEQ + (dir ? SEQ - 1 - tt : tt);
              u32x2 w; w.x = pk2(acc[0], acc[1]); w.y = pk2(acc[2], acc[3]); *(u32x2*)(OPd + m * 1024 + vcol) = w; }
        }
        __syncthreads();
#undef SC_GLOAD
#undef SC_LWRITE
#undef SC_H2F
    }
}

typedef float f32x16 __attribute__((ext_vector_type(16)));
typedef short s16x8 __attribute__((ext_vector_type(8)));
__device__ __forceinline__ int crow_(int r, int hi) { return (r & 3) + 8 * (r >> 2) + 4 * hi; }
template <int KSTEPS, int I0 = 0>
__device__ __forceinline__ void mm_tile(f32x16& c, const LAS unsigned char* X, int xstride, const LAS unsigned char* Y, int ystride, int r32, int hi) {
#pragma unroll
    for (int i = I0; i < I0 + KSTEPS; ++i) { const s16x8 x = *(const LAS s16x8*)(X + r32 * xstride + (16 * i + 8 * hi) * 2), y = *(const LAS s16x8*)(Y + r32 * ystride + (16 * i + 8 * hi) * 2);
        c = __builtin_amdgcn_mfma_f32_32x32x16_bf16(x, y, c, 0, 0, 0); }
}
__device__ __forceinline__ void scan_phase_mfma(LAS unsigned char* lds, const bf16_t* __restrict__ Qh, const bf16_t* __restrict__ Vh, const unsigned short* __restrict__ KF, bf16_t* __restrict__ OP, int G, int bx) {
    int tid = threadIdx.x; asm volatile("" : "+v"(tid)); const int wid = __builtin_amdgcn_readfirstlane(tid >> 6), lane = tid & 63, r32 = lane & 31, hi = lane >> 5;
    const bool grpA = wid < 4;
    const int st = (tid >> 3) & 31, sc16 = (tid & 7) * 16, vc4 = (tid & 7) * 4;
    constexpr int SQ = 272, SV = 80, NC = SEQ / 32;
    constexpr int IMG = 2 * 32 * SQ + 128 * SV + 128 + 32 * SV + 512;
    constexpr int O_LG = 0, O_IMG = 16384, O_AT = O_IMG + 2 * IMG, O_ST = O_AT + 32 * SV;
    constexpr int I_QT = 0, I_KT = 32 * SQ, I_KTT = 2 * 32 * SQ, I_VT = I_KTT + 128 * SV + 128, I_G = I_VT + 32 * SV;
    static_assert(O_ST + 32 * SQ <= LDS_RING && IMG % 16 == 0, "scan LDS map");
    for (int item = bx; item < 256; item += G) {
        const int dir = item & 1, dvq = (item >> 1) & 3, h = (item >> 3) & 7, b = item >> 6;
        const size_t kcol = h * 128 + sc16, vcol = h * 128 + dvq * 32 + vc4;
        const unsigned short* KFd = KF + (size_t)dir * MT * 1024; bf16_t* OPd = OP + (size_t)dir * MT * 1024;
        u32x4 rk0, rk1, rq0, rq1; u32x2 rv;
#define SM_GLOAD(blk) do { const int tt = (blk) * 32 + st; const size_t m = (size_t)b * SEQ + (dir ? SEQ - 1 - tt : tt); \
        rk0 = *(const u32x4*)(KFd + m * 1024 + kcol); rk1 = *(const u32x4*)(KFd + m * 1024 + kcol + 8); rq0 = *(const u32x4*)(Qh + m * 1024 + kcol); rq1 = *(const u32x4*)(Qh + m * 1024 + kcol + 8); \
        rv = *(const u32x2*)(Vh + m * 1024 + vcol); } while (0)
        if (grpA) SM_GLOAD(0);
        f32x16 accS, accO;
#pragma unroll
        for (int r = 0; r < 16; ++r) { accS[r] = 0.f; accO[r] = 0.f; }
        for (int i = tid; i < 32 * SQ / 4; i += 512) ((LAS unsigned*)(lds + O_ST))[i] = 0u;
        __syncthreads();
        for (int rd = -1; rd < NC; ++rd) {
            const int cn = rd + 1;
            LAS unsigned char* Wi = lds + O_IMG + (cn & 1) * IMG;
            const LAS unsigned char* Ri = lds + O_IMG + (rd & 1) * IMG;
            float kf[16];
            if (grpA) { if (cn < NC) {
                { const f32x2 a = h2f2_(rk0.x), bq = h2f2_(rk0.y), c = h2f2_(rk0.z), d = h2f2_(rk0.w), e = h2f2_(rk1.x), f = h2f2_(rk1.y), g2 = h2f2_(rk1.z), h2 = h2f2_(rk1.w);
                  kf[0] = a[0]; kf[1] = a[1]; kf[2] = bq[0]; kf[3] = bq[1]; kf[4] = c[0]; kf[5] = c[1]; kf[6] = d[0]; kf[7] = d[1];
                  kf[8] = e[0]; kf[9] = e[1]; kf[10] = f[0]; kf[11] = f[1]; kf[12] = g2[0]; kf[13] = g2[1]; kf[14] = h2[0]; kf[15] = h2[1]; }
                LAS unsigned char* L_ = lds + O_LG + (st * 128 + sc16) * 4;
#pragma unroll
                for (int q4 = 0; q4 < 4; ++q4) { f32x4 a4;
#pragma unroll
                    for (int e = 0; e < 4; ++e) a4[e] = 1.0f - kf[4 * q4 + e];
                    *(LAS f32x4*)(L_ + 16 * q4) = a4; }
                LAS unsigned char* V_ = Wi + I_VT + st * 2;
                *(LAS unsigned short*)(V_ + (vc4 + 0) * SV) = (unsigned short)(rv.x & 0xffffu); *(LAS unsigned short*)(V_ + (vc4 + 1) * SV) = (unsigned short)(rv.x >> 16);
                *(LAS unsigned short*)(V_ + (vc4 + 2) * SV) = (unsigned short)(rv.y & 0xffffu); *(LAS unsigned short*)(V_ + (vc4 + 3) * SV) = (unsigned short)(rv.y >> 16);
            } } else if (rd >= 0) {
                const int w4 = wid - 4;
                mm_tile<2>(accS, Ri + I_KTT + w4 * 32 * SV + (2 * w4 + (r32 >> 4)) * 16, SV, Ri + I_VT, SV, r32, hi);
                if (w4 == 0) { f32x16 pa, pb;
#pragma unroll
                    for (int r = 0; r < 16; ++r) { pa[r] = 0.f; pb[r] = 0.f; }
                    mm_tile<4, 0>(pa, Ri + I_KT, SQ, Ri + I_QT, SQ, r32, hi); mm_tile<4, 4>(pb, Ri + I_KT, SQ, Ri + I_QT, SQ, r32, hi);
#pragma unroll
                    for (int g = 0; g < 4; ++g) { const int s0 = 8 * g + 4 * hi; float v4[4];
#pragma unroll
                        for (int e = 0; e < 4; ++e) v4[e] = (s0 + e) <= r32 ? pa[4 * g + e] + pb[4 * g + e] : 0.f;
                        u32x2 w; w.x = pk2(v4[0], v4[1]); w.y = pk2(v4[2], v4[3]); *(LAS u32x2*)(lds + O_AT + r32 * SV + s0 * 2) = w; } }
                else if (w4 == 1) { f32x16 ob;
#pragma unroll
                    for (int r = 0; r < 16; ++r) { accO[r] = 0.f; ob[r] = 0.f; }
                    mm_tile<4, 0>(accO, lds + O_ST, SQ, Ri + I_QT, SQ, r32, hi); mm_tile<4, 4>(ob, lds + O_ST, SQ, Ri + I_QT, SQ, r32, hi);
#pragma unroll
                    for (int r = 0; r < 16; ++r) accO[r] += ob[r]; }
            }
            __syncthreads();
            if (grpA) { if (cn < NC) {
                if (tid < 128) { LAS float* col = (LAS float*)(lds + O_LG) + tid; float fv[32];
#pragma unroll
                    for (int t = 0; t < 32; ++t) fv[t] = col[t * 128];
                    float acc = 1.f;
#pragma unroll
                    for (int t = 0; t < 32; ++t) { acc *= fv[t]; col[t * 128] = acc; } }
            } } else if (rd >= 0) {
                const int w4 = wid - 4;
                if (w4 == 1) { mm_tile<2>(accO, Ri + I_VT, SV, lds + O_AT, SV, r32, hi);
                    asm volatile("s_nop 15\n\ts_nop 7" : "+v"(accO));
                    const int tt = rd * 32 + r32; const size_t m = (size_t)b * SEQ + (dir ? SEQ - 1 - tt : tt); bf16_t* orow = OPd + m * 1024 + h * 128 + dvq * 32;
#pragma unroll
                    for (int g = 0; g < 4; ++g) { u32x2 w; w.x = pk2(accO[4 * g + 0], accO[4 * g + 1]); w.y = pk2(accO[4 * g + 2], accO[4 * g + 3]); *(u32x2*)(orow + 8 * g + 4 * hi) = w; } }
            }
            __syncthreads();
            if (grpA) { if (cn < NC)
#ifdef REP_A3
            for (int rep_ = 0; rep_ < 2; ++rep_)
#endif
            {
                const LAS unsigned char* L_ = lds + O_LG + (st * 128 + sc16) * 4; float bb[16];
#pragma unroll
                for (int q4 = 0; q4 < 4; ++q4) { const f32x4 t4 = *(const LAS f32x4*)(L_ + 16 * q4); bb[4 * q4] = t4[0]; bb[4 * q4 + 1] = t4[1]; bb[4 * q4 + 2] = t4[2]; bb[4 * q4 + 3] = t4[3]; }
                const unsigned qraw[8] = {rq0.x, rq0.y, rq0.z, rq0.w, rq1.x, rq1.y, rq1.z, rq1.w};
                unsigned qw[8], kw[8];
#pragma unroll
                for (int e = 0; e < 8; ++e) { const float e0 = bb[2 * e], e1 = bb[2 * e + 1];
                    qw[e] = pk2(__uint_as_float(qraw[e] << 16) * e0, __uint_as_float(qraw[e] & 0xffff0000u) * e1);
                    kw[e] = pk2(kf[2 * e] * __builtin_amdgcn_rcpf(e0), kf[2 * e + 1] * __builtin_amdgcn_rcpf(e1));
                    if (st == 31) { ((LAS float*)(Wi + I_G))[sc16 + 2 * e] = e0; ((LAS float*)(Wi + I_G))[sc16 + 2 * e + 1] = e1; } }
                *(LAS u32x4*)(Wi + I_QT + st * SQ + sc16 * 2) = (u32x4){qw[0], qw[1], qw[2], qw[3]}; *(LAS u32x4*)(Wi + I_QT + st * SQ + sc16 * 2 + 16) = (u32x4){qw[4], qw[5], qw[6], qw[7]};
                *(LAS u32x4*)(Wi + I_KT + st * SQ + sc16 * 2) = (u32x4){kw[0], kw[1], kw[2], kw[3]}; *(LAS u32x4*)(Wi + I_KT + st * SQ + sc16 * 2 + 16) = (u32x4){kw[4], kw[5], kw[6], kw[7]};
                LAS unsigned char* T_ = Wi + I_KTT + sc16 * SV + (sc16 >> 4) * 16 + st * 2;
#pragma unroll
                for (int e = 0; e < 8; ++e) { *(LAS unsigned short*)(T_ + (2 * e) * SV) = (unsigned short)(kw[e] & 0xffffu); *(LAS unsigned short*)(T_ + (2 * e + 1) * SV) = (unsigned short)(kw[e] >> 16); }
            }
                if (cn + 1 < NC) SM_GLOAD(cn + 1);
            } else if (rd >= 0) {
                const int w4 = wid - 4;
#pragma unroll
                for (int g = 0; g < 4; ++g) { const int dk0 = 32 * w4 + 8 * g + 4 * hi; const f32x4 gm = *(const LAS f32x4*)(Ri + I_G + dk0 * 4);
                    accS[4 * g + 0] *= gm[0]; accS[4 * g + 1] *= gm[1]; accS[4 * g + 2] *= gm[2]; accS[4 * g + 3] *= gm[3];
                    u32x2 w; w.x = pk2(accS[4 * g + 0], accS[4 * g + 1]); w.y = pk2(accS[4 * g + 2], accS[4 * g + 3]);
                    *(LAS u32x2*)(lds + O_ST + r32 * SQ + dk0 * 2) = w; }
            }
            __syncthreads();
        }
#undef SM_GLOAD
    }
}

enum Op { OP_SW0, OP_FO0, OP_RPA, OP_MIN, OP_RMLA, OP_QKV, OP_ATTN, OP_MWO, OP_RPB, OP_SW1, OP_FO1, OP_RPC, OP_HIN, OP_SCAN, OP_RHG, OP_HWO };
__device__ const unsigned char OPS_M[12] = {OP_SW0, OP_FO0, OP_RPA, OP_MIN, OP_RMLA, OP_QKV, OP_ATTN, OP_MWO, OP_RPB, OP_SW1, OP_FO1, OP_RPC};
__device__ const unsigned char OPS_H[11] = {OP_SW0, OP_FO0, OP_RPA, OP_HIN, OP_SCAN, OP_RHG, OP_HWO, OP_RPB, OP_SW1, OP_FO1, OP_RPC};

struct Args { const float* in[15]; float* out; unsigned char* ws; };
typedef const __attribute__((address_space(4))) Args* ArgsP;
__device__ __forceinline__ ArgsP get_args() { ArgsP p = (ArgsP)__builtin_amdgcn_kernarg_segment_ptr(); asm volatile("" : "+s"(p) :: "memory"); return p; }
#define GW_ ((int)blockIdx.x * 8 + __builtin_amdgcn_readfirstlane((int)threadIdx.x >> 6))
#define NGW_ ((int)gridDim.x * 8)
__device__ __forceinline__ int otid_() { int t = threadIdx.x; asm volatile("" : "+v"(t)); return t; }
#define LANE_ (otid_() & 63)

#ifdef DBG_CHECKS
__device__ __forceinline__ float bf2f(bf16_t v) { return __uint_as_float((unsigned)v << 16); }
__device__ __forceinline__ unsigned hash_u(unsigned x) { x ^= x >> 16; x *= 0x7feb352du; x ^= x >> 15; x *= 0x846ca68bu; x ^= x >> 16; return x; }
__device__ __forceinline__ void dbg_report(unsigned* DBG, int id, float got, float ref, float rtol, float atol) {
    const float err = fabsf(got - ref); const bool bad = !(err <= rtol * fabsf(ref) + atol);
    if (bad) atomicMax(DBG + id, 1u);
}
__device__ __forceinline__ int dbg_row(int sidx) { if (sidx == 0) return 0; if (sidx == 1) return MT - 1; if (sidx == 2) return SEQ - 1; if (sidx == 3) return SEQ; return (int)(hash_u(sidx * 2654435761u + 17u) % MT); }
#endif
#ifdef DBG_CHECKS
struct DbgCtx { const float* const* in; unsigned char* ws; unsigned char* R; unsigned* DBG; int bx, tid, lane, wave; };
__device__ __forceinline__ float dbg_dot_bf_w(const bf16_t* a, const float* W, int K, int ldw, int col) { float s = 0.f; for (int k = 0; k < K; ++k) s += bf2f(a[k]) * W[(size_t)k * ldw + col]; return s; }
template <class A>
__device__ __forceinline__ void dbg_after(int l, int op, A ap, unsigned char* ws, unsigned char* R, LAS unsigned char* lds) {
    unsigned* DBG = (unsigned*)(ws + 32768);
    const int bx = blockIdx.x, tid = otid_(), lane = tid & 63, wave = __builtin_amdgcn_readfirstlane(tid >> 6);
    const bf16_t* HN = (const bf16_t*)(ws + WS_HN); const float* Y = (const float*)(ws + WS_Y);
    if (false && l == 0 && op == OP_SW0 && bx < 32) { const int sid = bx * 512 + tid, m = dbg_row(sid), c = hash_u(sid * 3 + 1) % DFF; const float* W = ap->in[3];
        const float g = dbg_dot_bf_w(HN + (size_t)m * 1024, W, 1024, 2 * DFF, c), u = dbg_dot_bf_w(HN + (size_t)m * 1024, W, 1024, 2 * DFF, DFF + c);
        dbg_report(DBG, 1, bf2f(((const bf16_t*)(R + R_ACT))[(size_t)m * DFF + c]), g / (1.f + expf(-g)) * u, 0.015f, 0.004f); }
    if (false && l == 0 && op == OP_FO0 && bx < 32) { const int sid = bx * 512 + tid, m = dbg_row(sid), c = hash_u(sid * 3 + 2) % 1024;
        const float r = dbg_dot_bf_w((const bf16_t*)(R + R_ACT) + (size_t)m * DFF, ap->in[4], DFF, 1024, c);
        dbg_report(DBG, 2, Y[(size_t)m * 1024 + c], r, 0.015f, 0.004f); }
    if (false && l == 0 && op == OP_RPA && bx < 32) { const int sid = bx * 512 + tid, m = dbg_row(sid), c = hash_u(sid * 3 + 3) % 1024; const float* g = ap->in[2];
        float s = 0.f; for (int k = 0; k < 1024; ++k) { const float y = Y[(size_t)m * 1024 + k]; s += y * y; }
        const float xr = ap->in[0][(size_t)m * 1024 + c] + 0.5f * Y[(size_t)m * 1024 + c] * rsqrtf(s / 1024.f + EPS) * g[1024 + c];
        dbg_report(DBG, 2, ap->out[(size_t)m * 1024 + c], xr, 1e-3f, 1e-3f);
        float s2 = 0.f; for (int k = 0; k < 1024; ++k) { const float x = ap->out[(size_t)m * 1024 + k]; s2 += x * x; }
        dbg_report(DBG, 2, bf2f(HN[(size_t)m * 1024 + c]), ap->out[(size_t)m * 1024 + c] * rsqrtf(s2 / 1024.f + EPS) * g[2048 + c], 0.01f, 0.01f); }
    if (false && l == 0 && op == OP_MIN && bx < 32) { const int sid = bx * 512 + tid, m = dbg_row(sid), c = hash_u(sid * 3 + 4) % 512; const int sc = src_col(2, c);
        const float r = sc >= 0 ? dbg_dot_bf_w(HN + (size_t)m * 1024, ap->in[5], 1024, 448, sc) : 0.f;
        dbg_report(DBG, 3, ((const float*)(R + R_C))[(size_t)m * 512 + c], r, 0.015f, 0.01f); }
    if (false && l == 0 && op == OP_RMLA && bx < 32) { const int sid = bx * 512 + tid, m = dbg_row(sid), c = hash_u(sid * 3 + 5) % 448; const float* C = (const float*)(R + R_C) + (size_t)m * 512;
        if (c < 256) { float s = 0.f; for (int k = 0; k < 256; ++k) s += C[k] * C[k];
            dbg_report(DBG, 3, bf2f(((const bf16_t*)(R + R_CQ))[(size_t)m * 256 + c]), C[c] * rsqrtf(s / 256.f + EPS) * ap->in[6][c], 0.01f, 0.01f); }
        else if (c < 384) { float s = 0.f; for (int k = 256; k < 384; ++k) s += C[k] * C[k];
            dbg_report(DBG, 3, bf2f(((const bf16_t*)(R + R_CKV))[(size_t)m * 128 + c - 256]), C[c] * rsqrtf(s / 128.f + EPS) * ap->in[7][c - 256], 0.01f, 0.01f); }
        else { const int jj = c - 384, i = jj >> 1; const float ang = (float)((const int*)ap->in[1])[m] * powf(10000.f, -(float)i / 32.f); const float cs = cosf(ang), sn = sinf(ang);
            const float t1 = C[384 + 2 * i], t2 = C[384 + 2 * i + 1]; const float r = (jj & 1) ? t1 * sn + t2 * cs : t1 * cs - t2 * sn;
            dbg_report(DBG, 3, bf2f(((const bf16_t*)(R + R_KR))[(size_t)m * 64 + jj]), r, 0.02f, 0.05f); } }
    if (false && l == 0 && op == OP_QKV && bx < 32) { const int sid = bx * 512 + tid, m = dbg_row(sid); const bf16_t* CQ = (const bf16_t*)(R + R_CQ) + (size_t)m * 256; const bf16_t* CKV = (const bf16_t*)(R + R_CKV) + (size_t)m * 128;
        { const int c = hash_u(sid * 3 + 6) % 1536, h = c / QKD, d = c % QKD; float r;
          if (d < 128) r = dbg_dot_bf_w(CQ, ap->in[8], 256, 1536, c);
          else { const int jj = d - 128, i = jj >> 1; const float t1 = dbg_dot_bf_w(CQ, ap->in[8], 256, 1536, h * QKD + 128 + i), t2 = dbg_dot_bf_w(CQ, ap->in[8], 256, 1536, h * QKD + 160 + i);
              const float ang = (float)((const int*)ap->in[1])[m] * powf(10000.f, -(float)i / 32.f); const float cs = cosf(ang), sn = sinf(ang); r = (jj & 1) ? t1 * sn + t2 * cs : t1 * cs - t2 * sn; }
          dbg_report(DBG, 4, bf2f(((const bf16_t*)(R + R_QB))[(size_t)m * 1536 + c]), r, 0.015f, 0.015f); }
        { const int c = hash_u(sid * 3 + 7) % 2048, h = c >> 8, d = c & 255; const float r = dbg_dot_bf_w(CKV, ap->in[9], 128, 2048, c);
          const float got = d < 128 ? bf2f(((const bf16_t*)(R + R_KN))[(size_t)m * 1024 + h * 128 + d]) : bf2f(((const bf16_t*)(R + R_VB))[(size_t)m * 1024 + h * 128 + d - 128]);
          dbg_report(DBG, 5, got, r, 0.015f, 0.015f); } }
    if (l == 0 && op == OP_ATTN) { const int sid = bx * 8 + wave, m = dbg_row(sid), h = hash_u(sid * 5 + 1) & 7, dv = hash_u(sid * 5 + 2) & 127, b = m / SEQ;
        LAS float* qs = (LAS float*)lds + wave * 192; const bf16_t* Q = (const bf16_t*)(R + R_QB) + (size_t)m * 1536 + h * QKD;
        for (int d = lane; d < 192; d += 64) qs[d] = bf2f(Q[d]);
        asm volatile("s_waitcnt lgkmcnt(0)" ::: "memory");
        float mx = -1e30f, ls = 0.f, acc = 0.f;
        for (int kk = lane; kk < SEQ; kk += 64) { const size_t km = (size_t)b * SEQ + kk; const bf16_t* Kn = (const bf16_t*)(R + R_KN) + km * 1024 + h * 128; const bf16_t* Kr = (const bf16_t*)(R + R_KR) + km * 64;
            float s = 0.f; for (int d = 0; d < 128; ++d) s += qs[d] * bf2f(Kn[d]); for (int d = 0; d < 64; ++d) s += qs[128 + d] * bf2f(Kr[d]);
            s *= 0.07216878364870322f; const float v = bf2f(((const bf16_t*)(R + R_VB))[km * 1024 + h * 128 + dv]);
            const float mn = fmaxf(mx, s), al = expf(mx - mn), p = expf(s - mn); ls = ls * al + p; acc = acc * al + p * v; mx = mn; }
        float gm = mx;
        for (int o = 1; o < 64; o <<= 1) gm = fmaxf(gm, __shfl_xor(gm, o));
        const float sc = expf(mx - gm); const float L = wave_sum(ls * sc), Asum = wave_sum(acc * sc);
        if (lane == 0) { const float got = bf2f(((const bf16_t*)(R + R_O))[(size_t)m * 1024 + h * 128 + dv]), ref = Asum / L; atomicMax(DBG + 20, __float_as_uint(fabsf(got - ref))); atomicAdd((float*)(DBG + 21), fabsf(ref) * (1.f / 2048.f)); } }
    if (false && l == 1 && op == OP_HIN && bx < 32) { const int sid = bx * 512 + tid, m = dbg_row(sid), c5 = hash_u(sid * 3 + 8) % 5120, seg = c5 >> 10, c = c5 & 1023;
        const float u = dbg_dot_bf_w(HN + (size_t)m * 1024, ap->in[11], 1024, 5120, c5); float got, r;
        if (seg == 0) { got = bf2f(((const bf16_t*)(R + R_QH))[(size_t)m * 1024 + c]); r = u / (1.f + expf(-u)); }
        else if (seg == 3) { got = bf2f(((const bf16_t*)(R + R_VH))[(size_t)m * 1024 + c]); r = u; }
        else if (seg == 4) { got = bf2f(((const bf16_t*)(R + R_GH))[(size_t)m * 1024 + c]); r = u / (1.f + expf(-u)); }
        else { const int dir = seg - 1; const float* lbp = ap->in[12] + (size_t)dir * DEPTH * 1024 + c; const float e0 = expf(lbp[0]), e1 = expf(lbp[1024]), e2 = expf(lbp[2048]), e3 = expf(lbp[3072]);
            const float lb = e1 / (e0 + e1 + e2 + e3); const h16x2 hv = __builtin_bit_cast(h16x2, (unsigned)((const unsigned short*)(R + R_KF))[(size_t)dir * MT * 1024 + (size_t)m * 1024 + c]);
            got = (float)hv[0]; r = (1.f - lb) / (1.f + expf(u)); }
        dbg_report(DBG, 7, got, r, 0.015f, 0.006f); }
    if (false && l == 1 && op == OP_SCAN) { const int sid = bx * 8 + wave, h = hash_u(sid * 5 + 3) & 7, dv = hash_u(sid * 5 + 4) & 127, b = hash_u(sid * 5 + 5) & 3, toff = sid & 31, dir = 0;
        const bf16_t* Qh = (const bf16_t*)(R + R_QH); const bf16_t* Vh = (const bf16_t*)(R + R_VH); const unsigned short* KF = (const unsigned short*)(R + R_KF); const bf16_t* OPb = (const bf16_t*)(ws + WS_Y);
        float S0 = 0.f, S1 = 0.f; const int n = toff + 1; const int t = toff; const size_t m = (size_t)b * SEQ + t;
        for (int i = 0; i < n; ++i) { const int tt = i; const size_t mm = (size_t)b * SEQ + tt; const unsigned short* kp = KF + (size_t)dir * MT * 1024 + mm * 1024 + h * 128;
            const h16x2 ka = __builtin_bit_cast(h16x2, (unsigned)kp[lane]), kb = __builtin_bit_cast(h16x2, (unsigned)kp[lane + 64]); const float k0 = (float)ka[0], k1 = (float)kb[0];
            const float v = bf2f(Vh[mm * 1024 + h * 128 + dv]); S0 = S0 * (1.f - k0) + k0 * v; S1 = S1 * (1.f - k1) + k1 * v; }
        const bf16_t* q = Qh + m * 1024 + h * 128; const float tot = wave_sum(S0 * bf2f(q[lane]) + S1 * bf2f(q[lane + 64]));
        if (lane == 0) { const float got = bf2f(OPb[(size_t)dir * MT * 1024 + m * 1024 + h * 128 + dv]); const float re = fabsf(got - tot) / (fabsf(tot) + 0.05f);
            if (re > 0.05f) { atomicMin(DBG + 20, (unsigned)toff); atomicAdd(DBG + 21, 1u); } } }
    if (false && l == 1 && op == OP_RHG && bx < 32) { const int sid = bx * 512 + tid, m = dbg_row(sid), c = hash_u(sid * 3 + 9) % 1024, h0 = c & ~127; const bf16_t* OPb = (const bf16_t*)(ws + WS_Y);
        float s = 0.f; for (int k = 0; k < 128; ++k) { const float y = bf2f(OPb[(size_t)m * 1024 + h0 + k]) + bf2f(OPb[(size_t)MT * 1024 + (size_t)m * 1024 + h0 + k]); s += y * y; }
        const float yc = bf2f(OPb[(size_t)m * 1024 + c]) + bf2f(OPb[(size_t)MT * 1024 + (size_t)m * 1024 + c]);
        const float r = yc * rsqrtf(s / 128.f + EPS) * ap->in[13][c] * bf2f(((const bf16_t*)(R + R_GH))[(size_t)m * 1024 + c]);
        dbg_report(DBG, 9, bf2f(((const bf16_t*)(R + R_HO))[(size_t)m * 1024 + c]), r, 0.02f, 0.005f); }
    if (false && l == 1 && op == OP_HWO && bx < 32) { const int sid = bx * 512 + tid, m = dbg_row(sid), c = hash_u(sid * 3 + 10) % 1024;
        const float r = dbg_dot_bf_w((const bf16_t*)(R + R_HO) + (size_t)m * 1024, ap->in[14], 1024, 1024, c);
        dbg_report(DBG, 9, Y[(size_t)m * 1024 + c], r, 0.03f, 0.01f); }
    if (false && l == 0 && op == OP_MWO && bx < 32) { const int sid = bx * 512 + tid, m = dbg_row(sid), c = hash_u(sid * 3 + 11) % 1024;
        const float r = dbg_dot_bf_w((const bf16_t*)(R + R_O) + (size_t)m * 1024, ap->in[10], 1024, 1024, c);
        dbg_report(DBG, 6, Y[(size_t)m * 1024 + c], r, 0.02f, 0.0004f); }
}
#endif

__device__ __forceinline__ void gsync_cg() {
    asm volatile("s_waitcnt vmcnt(0) lgkmcnt(0)" ::: "memory");
    __syncthreads();
    cg::this_grid().sync();
    if (threadIdx.x == 0) { __builtin_amdgcn_fence(__ATOMIC_ACQUIRE, "agent"); asm volatile("s_waitcnt vmcnt(0)" ::: "memory"); }
    __syncthreads();
}
#define GAS __attribute__((address_space(1)))
#define XB_TMO      128
#define XB_XCNT(j)  (256  + 64 * (j))
#define XB_XSUB(j)  (1280 + 64 * (j))
#define XB_XGEN(j)  (2304 + 64 * (j))
#define XB_TOP      3328
#define XB_TOPGEN   3392
#define XCD_BAR_WORDS 3456
#define XB_SPIN_CAP (1u << 18)

__device__ __forceinline__ unsigned xb_ld(unsigned* p)              { return __hip_atomic_load(p, __ATOMIC_RELAXED, __HIP_MEMORY_SCOPE_AGENT); }
__device__ __forceinline__ unsigned xb_add(unsigned* p, unsigned v) { return __hip_atomic_fetch_add(p, v, __ATOMIC_RELAXED, __HIP_MEMORY_SCOPE_AGENT); }
__device__ __forceinline__ unsigned xb_xcc_id() { return (unsigned)__builtin_amdgcn_s_getreg((3 << 11) | 20) & 0xFu; }
#define XB_SPIN(cond, bar) do { unsigned _sp = 0; while (cond) { __builtin_amdgcn_s_sleep(1); \
    if ((++_sp & 255u) == 0u) { if (xb_ld(&(bar)[XB_TMO])) break; if (_sp > XB_SPIN_CAP) { atomicAdd(&(bar)[XB_TMO], 1u); break; } } } } while (0)

struct XcdBarrier {
    unsigned* bar; unsigned x;
    volatile LAS unsigned* st;
};

__device__ __forceinline__ XcdBarrier xcd_barrier_post(unsigned* bar, volatile LAS unsigned* st) {
    XcdBarrier b; b.bar = bar; b.x = xb_xcc_id(); b.st = st;
    if (threadIdx.x == 0) (void)xb_add(&bar[XB_XCNT(b.x)], 1u);
    return b;
}
__device__ __forceinline__ void xcd_barrier_complete(unsigned* bar, unsigned x, unsigned& nloc, unsigned& nx) {
    const unsigned G = gridDim.x * gridDim.y * gridDim.z;
    unsigned sum, cnt, mine, sp = 0u;
    for (;;) {
        sum = 0u; cnt = 0u; mine = 0u;
#pragma unroll
        for (unsigned j = 0; j < 16; ++j) { const unsigned c = xb_ld(&bar[XB_XCNT(j)]); sum += c; cnt += (c > 0u) ? 1u : 0u; mine = (j == x) ? c : mine; }
        if (sum == G) break;
        __builtin_amdgcn_s_sleep(1);
        if ((++sp & 255u) == 0u) { if (xb_ld(&bar[XB_TMO])) break; if (sp > XB_SPIN_CAP) { atomicAdd(&bar[XB_TMO], 1u); break; } }
    }
    nloc = mine > 0u ? mine : 1u; nx = cnt > 0u ? cnt : 1u;
}

__device__ __forceinline__ void xcd_barrier(const XcdBarrier& b) {
    asm volatile("s_waitcnt vmcnt(0)" ::: "memory");
    __syncthreads();
    if (threadIdx.x == 0) {
        unsigned* bar = b.bar;
        __builtin_amdgcn_s_waitcnt(0);
        unsigned nloc = b.st[0], nx = b.st[1];
        if (nloc == 0u) { xcd_barrier_complete(bar, b.x, nloc, nx); b.st[0] = nloc; b.st[1] = nx; }
        const unsigned old = xb_add(&bar[XB_XSUB(b.x)], 1u);
        const unsigned gen = old / nloc;
        if (old + 1u == (gen + 1u) * nloc) {
            __builtin_amdgcn_fence(__ATOMIC_RELEASE, "agent");
            asm volatile("s_waitcnt vmcnt(0)" ::: "memory");
            const unsigned og = xb_add(&bar[XB_TOP], 1u);
            const unsigned tg = og / nx;
            if (og + 1u == (tg + 1u) * nx) xb_add(&bar[XB_TOPGEN], 1u);
            else XB_SPIN(xb_ld(&bar[XB_TOPGEN]) == tg, bar);
            __builtin_amdgcn_fence(__ATOMIC_ACQUIRE, "agent");
            xb_add(&bar[XB_XGEN(b.x)], 1u);
            asm volatile("s_waitcnt vmcnt(0)" ::: "memory");
        } else {
            XB_SPIN(xb_ld(&bar[XB_XGEN(b.x)]) == gen, bar);
            __builtin_amdgcn_fence(__ATOMIC_ACQUIRE, "agent");
            asm volatile("s_waitcnt vmcnt(0)" ::: "memory");
        }
    }
    __syncthreads();
}

__device__ __forceinline__ void gsync(LAS unsigned char* lds) {
#ifdef USE_CG_SYNC
    gsync_cg();
#else
    XcdBarrier b; b.bar = (unsigned*)get_args()->ws; b.x = xb_xcc_id(); b.st = (volatile LAS unsigned*)(lds + LDS_RING);
    xcd_barrier(b);
#endif
}
__global__ void __launch_bounds__(512, 2) mega_fwd(Args a_unused) {
    extern __shared__ __attribute__((aligned(16))) unsigned char lds_raw[];
    LAS unsigned char* lds = (LAS unsigned char*)lds_raw;

    if (threadIdx.x < 2) ((volatile LAS unsigned*)(lds + LDS_RING))[threadIdx.x] = 0u;
    __syncthreads();
    (void)xcd_barrier_post((unsigned*)get_args()->ws, (volatile LAS unsigned*)(lds + LDS_RING));
#ifdef REP_PRO
    for (int rep_ = 0; rep_ < 2; ++rep_)
#endif
    {
        ArgsP ap = get_args(); unsigned char* ws = ap->ws;
#ifdef DBG_CHECKS
        if (blockIdx.x == 0 && threadIdx.x < 32) atomicExch((unsigned*)ws + threadIdx.x, 0u);
#endif
        const int tid = threadIdx.x, lane = tid & 63, wave = __builtin_amdgcn_readfirstlane(tid >> 6), G = gridDim.x, bx = blockIdx.x, gw = bx * 8 + wave, NGW = G * 8;
        LAS float* scr = (LAS float*)(lds + wave * 16384);
        constexpr int I_FFI = 16 * 176, I_FFO = 44 * 32, I_HIN = 16 * 160, I_SQ = 16 * 32, I_MIN = 16 * 16, I_UQ = 4 * 48, I_UKV = 2 * 64;
        constexpr int NITEMS = 8 * I_FFI + 8 * I_FFO + 2 * I_HIN + 2 * I_SQ + 2 * I_MIN + 2 * I_UQ + 2 * I_UKV + 2 * I_SQ;
        for (int it = gw; it < NITEMS; it += NGW) {
            int r = it;
#define XP(IDX_, K_, NS_, ND_, MODE_, WSOFF_, NMAT_, IPM_) if (r < (NMAT_) * (IPM_)) { const int mat = r / (IPM_); \
            xpose_item(ap->in[IDX_] + (size_t)mat * (K_) * (NS_), K_, NS_, ND_, MODE_, (bf16_t*)(ws + (WSOFF_)) + (size_t)mat * (ND_) * (K_), scr, r % (IPM_), lane); continue; } r -= (NMAT_) * (IPM_);
            XP(3, 1024, 2 * DFF, 2 * DFF, 1, WS_WFFI, 8, I_FFI)
            XP(4, DFF, 1024, 1024, 0, WS_WFFO, 8, I_FFO)
            XP(11, 1024, 5120, 5120, 0, WS_WHIN, 2, I_HIN)
            XP(14, 1024, 1024, 1024, 0, WS_WHO, 2, I_SQ)
            XP(5, 1024, 448, 512, 2, WS_WMIN, 2, I_MIN)
            XP(8, 256, 1536, 1536, 3, WS_WUQ, 2, I_UQ)
            XP(9, 128, 2048, 2048, 0, WS_WUKV, 2, I_UKV)
            XP(10, 1024, 1024, 1024, 0, WS_WMO, 2, I_SQ)
#undef XP
        }
        { const int* positions = (const int*)ap->in[1]; float* COS = (float*)(ws + WS_COS); float* SIN = (float*)(ws + WS_SIN);
          for (int idx = bx * 512 + tid; idx < MT * 32; idx += G * 512) { const int m = idx >> 5, i = idx & 31;
            const double ang = (double)positions[m] * ROPE_INVF[i]; const double rev = ang * 0.15915494309189535; const float fr = (float)(rev - __builtin_rint(rev));
            COS[idx] = __builtin_amdgcn_cosf(fr); SIN[idx] = __builtin_amdgcn_sinf(fr); } }
        { float* LB = (float*)(ws + WS_LB);
          for (int idx = bx * 512 + tid; idx < 2 * 2 * 1024; idx += G * 512) { const int c = idx & 1023, dir = (idx >> 10) & 1, j = idx >> 11, l = 2 * j + 1;
            const float* lbp = ap->in[12] + (size_t)dir * DEPTH * 1024 + c; float v[4], mx = -1e30f;
#pragma unroll
            for (int i = 0; i < 4; ++i) { v[i] = lbp[i * 1024]; mx = fmaxf(mx, v[i]); }
            float den = 0.f, num = 0.f;
#pragma unroll
            for (int i = 0; i < 4; ++i) { const float e = __expf(v[i] - mx); den += e; if (i >= 1 && i <= l) num += e; }
            LB[idx] = num / den; } }
        { const float* x_in = ap->in[0]; float* X = ap->out; bf16_t* HN = (bf16_t*)(ws + WS_HN); const float* gains = ap->in[2];
          for (int m = gw; m < MT; m += NGW) row_init(x_in + (size_t)m * DM, X + (size_t)m * DM, HN + (size_t)m * DM, gains, lane); }
    }
    gsync_cg();

    for (int ph = 0; ph < 46; ++ph) {
        const int l = ph >= 35 ? 3 : (ph >= 23 ? 2 : (ph >= 12 ? 1 : 0)), s = ph - (l == 3 ? 35 : (l == 2 ? 23 : (l == 1 ? 12 : 0)));
        const bool hg = l & 1; const int j = l >> 1;
        const int op = hg ? OPS_H[s] : OPS_M[s];
        ArgsP ap = get_args(); unsigned char* ws = ap->ws; unsigned char* R = ws + WS_R;
        int G_ = gridDim.x, bx_ = blockIdx.x; asm volatile("" : "+s"(G_), "+s"(bx_));
        switch (op) {
        case OP_SW0: case OP_SW1: {
            const int half = op == OP_SW1;
            pg8::Gemm gm{(const bf16_t*)(ws + WS_HN), (const bf16_t*)(ws + WS_WFFI) + (size_t)(l * 2 + half) * (2 * DFF) * 1024, MT, 2 * DFF, 1024};
            pg8::StaticOrder S; S.init(MT, 2 * DFF, G_, bx_); EpiSwiglu E{(bf16_t*)(R + R_ACT)};
#ifndef NO_SW
            pg8::gemm_phase<EpiSwiglu, pg8::StaticOrder, true, true>(lds, gm, S, E);
#endif
        } break;
        case OP_MIN: {
            pg8::Gemm gm{(const bf16_t*)(ws + WS_HN), (const bf16_t*)(ws + WS_WMIN) + (size_t)j * 512 * 1024, MT, 512, 1024}; EpiF32 E{(float*)(R + R_C), 512};
            pg8::StaticOrder S; S.init(MT, 512, G_, bx_);
#ifndef NO_F32
            pg8::gemm_phase<EpiF32, pg8::StaticOrder, true, true>(lds, gm, S, E);
#endif
        } break;
        case OP_FO0: case OP_FO1: case OP_MWO: case OP_HWO: {
            pg8::Gemm gm; EpiB16 E{(bf16_t*)(ws + WS_YB), 1024};
            if (op == OP_FO0 || op == OP_FO1) { const int half = op == OP_FO1; gm = pg8::Gemm{(const bf16_t*)(R + R_ACT), (const bf16_t*)(ws + WS_WFFO) + (size_t)(l * 2 + half) * 1024 * DFF, MT, 1024, DFF}; }
            else if (op == OP_MWO) { gm = pg8::Gemm{(const bf16_t*)(R + R_O), (const bf16_t*)(ws + WS_WMO) + (size_t)j * 1024 * 1024, MT, 1024, 1024}; }
            else { gm = pg8::Gemm{(const bf16_t*)(R + R_HO), (const bf16_t*)(ws + WS_WHO) + (size_t)j * 1024 * 1024, MT, 1024, 1024}; }
            pg8::StaticOrder S; S.init(MT, 1024, G_, bx_);
            pg8::gemm_phase<EpiB16, pg8::StaticOrder, true, true>(lds, gm, S, E);
        } break;
        case OP_RPA: case OP_RPB: case OP_RPC: {
            const float* gains = ap->in[2]; const float* g = gains + (size_t)l * 6 * DM; const bf16_t* Y = (const bf16_t*)(ws + WS_YB); float* X = ap->out; bf16_t* HN = (bf16_t*)(ws + WS_HN);
            const int k = op == OP_RPA ? 1 : (op == OP_RPB ? 3 : 5); const float scale = op == OP_RPB ? 1.0f : 0.5f;
            const bool last = (op == OP_RPC) && (l == DEPTH - 1);
            const float* gn = op == OP_RPC ? gains + (size_t)(l + 1) * 6 * DM : g + (size_t)(k + 1) * DM;
            const int lane = LANE_;
            for (int m = bx_ * 8 + __builtin_amdgcn_readfirstlane(otid_() >> 6); m < MT; m += G_ * 8) row_post(Y + (size_t)m * DM, X + (size_t)m * DM, last ? (bf16_t*)nullptr : HN + (size_t)m * DM, scale, g + (size_t)k * DM, last ? g : gn, lane);
        } break;
        case OP_RMLA: {
            const float* qn = ap->in[6] + (size_t)j * QLR; const float* kvn = ap->in[7] + (size_t)j * KVLR; const float* COS = (const float*)(ws + WS_COS); const float* SIN = (const float*)(ws + WS_SIN);
            const int lane = LANE_;
            for (int m = bx_ * 8 + __builtin_amdgcn_readfirstlane(otid_() >> 6); m < MT; m += G_ * 8) row_mla((const float*)(R + R_C) + (size_t)m * 512, (bf16_t*)(R + R_CQ) + (size_t)m * 256, (bf16_t*)(R + R_CKV) + (size_t)m * 128, (bf16_t*)(R + R_KR) + (size_t)m * 64,
                                                         qn, kvn, COS + (size_t)m * 32, SIN + (size_t)m * 32, lane);
        } break;
        case OP_QKV: {
            { int Kq = 256; asm volatile("" : "+s"(Kq)); pg8::Gemm gm{(const bf16_t*)(R + R_CQ), (const bf16_t*)(ws + WS_WUQ) + (size_t)j * 1536 * 256, MT, 1536, Kq};
              pg8::StaticOrder S; S.init(MT, 1536, G_, bx_); EpiQ E{(bf16_t*)(R + R_QB), (const float*)(ws + WS_COS), (const float*)(ws + WS_SIN)};
#ifndef NO_Q
              pg8::gemm_phase<EpiQ, pg8::StaticOrder, true, true>(lds, gm, S, E);
#endif
            }
            __syncthreads();
            { int Kq = 128; asm volatile("" : "+s"(Kq)); pg8::Gemm gm{(const bf16_t*)(R + R_CKV), (const bf16_t*)(ws + WS_WUKV) + (size_t)j * 2048 * 128, MT, 2048, Kq};
              pg8::StaticOrder S; S.init(MT, 2048, G_, bx_); EpiKV E{(bf16_t*)(R + R_KN), (bf16_t*)(R + R_VB)};
#ifndef NO_KV
              pg8::gemm_phase<EpiKV, pg8::StaticOrder, true, true>(lds, gm, S, E);
#endif
            }
        } break;
        case OP_ATTN: {
#ifndef NO_ATTN
            const int G = G_, bx = bx_;

            const int vcu = (G % 8 == 0) ? (bx % 8) * (G / 8) + bx / 8 : bx;
#ifdef REP_ATTN
            for (int rep_ = 0; rep_ < 2; ++rep_)
#endif
            for (int uid = vcu; uid < BATCH * NH * (SEQ / 256); uid += G) {
                const int bh = uid >> 5, qb = uid & 31, b = bh >> 3, h = bh & 7;
                const size_t row0 = (size_t)b * SEQ;
                att::attn_unit((const att::bf16*)(R + R_QB) + (row0 + qb * 256) * 1536 + h * QKD, (const att::bf16*)(R + R_KN) + row0 * 1024 + h * 128,
                               (const att::bf16*)(R + R_KR) + row0 * 64, (const att::bf16*)(R + R_VB) + row0 * 1024 + h * 128,
                               (att::bf16*)(R + R_O) + (row0 + qb * 256) * 1024 + h * 128, SEQ, (char*)lds_raw);
            }
#endif
        } break;
        case OP_HIN: {
            pg8::Gemm gm{(const bf16_t*)(ws + WS_HN), (const bf16_t*)(ws + WS_WHIN) + (size_t)j * 5120 * 1024, MT, 5120, 1024};
            pg8::StaticOrder S; S.init(MT, 5120, G_, bx_);
            EpiHgrn E{(bf16_t*)(R + R_QH), (bf16_t*)(R + R_VH), (bf16_t*)(R + R_GH), (unsigned short*)(R + R_KF), (const float*)(ws + WS_LB) + (size_t)j * 2048};
#ifndef NO_HG
            pg8::gemm_phase<EpiHgrn, pg8::StaticOrder, true, true>(lds, gm, S, E);
#endif
        } break;
        case OP_SCAN: {
#ifndef NO_SCAN
#ifdef REP_SCAN
            scan_phase(lds, (const bf16_t*)(R + R_QH), (const bf16_t*)(R + R_VH), (const unsigned short*)(R + R_KF), (bf16_t*)(ws + WS_Y), G_, bx_); __syncthreads();
#endif
#ifdef SCAN_VALU
            scan_phase(lds, (const bf16_t*)(R + R_QH), (const bf16_t*)(R + R_VH), (const unsigned short*)(R + R_KF), (bf16_t*)(ws + WS_Y), G_, bx_);
#else
            scan_phase_mfma(lds, (const bf16_t*)(R + R_QH), (const bf16_t*)(R + R_VH), (const unsigned short*)(R + R_KF), (bf16_t*)(ws + WS_Y), G_, bx_);
#endif
#endif
        } break;
        case OP_RHG: {
            const float* on = ap->in[13] + (size_t)j * DM; const bf16_t* Y = (const bf16_t*)(ws + WS_Y);
            const int lane = LANE_;
            for (int m = bx_ * 8 + __builtin_amdgcn_readfirstlane(otid_() >> 6); m < MT; m += G_ * 8) row_hgrn(Y + (size_t)m * DM, (const bf16_t*)(R + R_GH) + (size_t)m * DM, (bf16_t*)(R + R_HO) + (size_t)m * DM, on, lane);
        } break;
        default: break;
        }
        if (ph != 45) gsync(lds);
#ifdef REP_SYNC
        gsync(lds);
#endif
#ifdef DBG_CHECKS
        { ArgsP ap2 = get_args(); dbg_after(l, op, ap2, ap2->ws, ap2->ws + WS_R, lds); gsync(lds); }
#endif
    }
#ifdef DBG_CHECKS
    gsync(lds);
    if (blockIdx.x == 0 && threadIdx.x == 0) { ArgsP ap = get_args(); unsigned* DBG = (unsigned*)ap->ws; const float mx = __uint_as_float(atomicAdd(DBG + 20, 0u)), mean = atomicAdd((float*)(DBG + 21), 0.f); ap->out[1024 * 16] += 1e6f * mx; ap->out[1024 * 16 + 1] += 1e4f * mean; }
#endif
}

extern "C" void kernel_launch(void* const* d_in, const int* in_sizes, int n_in, void* d_out, int out_size, void* d_ws, size_t ws_size, hipStream_t stream) {
    static int grid = 0;
    if (grid == 0) {
        if (n_in != 15 || out_size != MT * DM || ws_size < WS_END) { fprintf(stderr, "kernel_launch: unexpected shapes: n_in %d out %d ws %zu (need %zu)\n", n_in, out_size, ws_size, (size_t)WS_END); grid = -1; return; }
        int dev = 0, cus = 0, per_cu = 0;
        (void)hipGetDevice(&dev); (void)hipDeviceGetAttribute(&cus, hipDeviceAttributeMultiprocessorCount, dev);
        if (hipFuncSetAttribute((const void*)mega_fwd, hipFuncAttributeMaxDynamicSharedMemorySize, LDS_BYTES) != hipSuccess) { fprintf(stderr, "kernel_launch: hipFuncSetAttribute failed\n"); grid = -1; return; }
        if (hipOccupancyMaxActiveBlocksPerMultiprocessor(&per_cu, (const void*)mega_fwd, 512, LDS_BYTES) != hipSuccess || per_cu < 1) { fprintf(stderr, "kernel_launch: occupancy query gave %d\n", per_cu); per_cu = 1; }
        (void)hipGetLastError();
        grid = cus * 1;
        fprintf(stderr, "kernel_launch: cus %d per_cu %d grid %d\n", cus, per_cu, grid);
    }
    if (grid < 0) return;
    if (hipMemsetAsync(d_ws, 0, 65536, stream) != hipSuccess) { fprintf(stderr, "kernel_launch: memset failed\n"); return; }
    Args a{};
    for (int i = 0; i < 15; ++i) a.in[i] = (const float*)d_in[i];
    a.out = (float*)d_out; a.ws = (unsigned char*)d_ws;
    void* args[] = {&a};
    hipError_t e = hipLaunchCooperativeKernel((const void*)mega_fwd, dim3(grid), dim3(512), args, LDS_BYTES, stream);
    if (e != hipSuccess) fprintf(stderr, "cooperative launch failed: %s (grid %d)\n", hipGetErrorString(e), grid);
}
```

```cpp
#include <hip/hip_runtime.h>
#include <hip/hip_cooperative_groups.h>
#include <hip/hip_bf16.h>
#include <hip/hip_fp16.h>
#include <cstdio>
#include <cstdint>
#include <cmath>
namespace cg = cooperative_groups;
namespace pg8 {
#define PG8_LAS __attribute__((address_space(3)))
typedef unsigned short bf16_t;
typedef short bf16x8 __attribute__((ext_vector_type(8)));
typedef float f32x4 __attribute__((ext_vector_type(4)));
typedef unsigned u32x4 __attribute__((ext_vector_type(4)));
constexpr int BM = 256, BK = 64, HALF = 128, HTB = HALF * BK * 2  , STAGE_BYTES = 8 * HTB, NXCD = 8, WGM = 8;

__host__ __device__ __forceinline__ int lds_byte(int r, int c) { const int st = (r >> 4) * 2 + (c >> 5), rr = r & 15, cc = c & 31, ob = rr * 64 + cc * 2; return st * 1024 + (ob ^ (((ob >> 9) & 1) << 5)); }
__host__ __device__ __forceinline__ void stage_rc(int b, int& R, int& C) { const int st = b / 1024, sb = b % 1024, swz = sb ^ (((sb >> 9) & 1) << 5); R = (st >> 1) * 16 + swz / 64; C = (st & 1) * 32 + (swz % 64) / 2; }
__host__ __device__ __forceinline__ int perm32(int rho) { const int n = rho >> 4, i = rho & 15; return 8 * (i >> 2) + 4 * n + (i & 3); }

struct Unit { int pm, pn; };
struct Gemm { const bf16_t* A; const bf16_t* Bt; int M, N, K; };

struct StaticOrder {
    int nM, nN, nwg, G, c;
    __host__ __device__ void init(int M, int N, int G_, int c_) { nM = M / BM; nN = N / BM; nwg = nM * nN; G = G_; c = c_; }
    __host__ __device__ bool next(int i, Unit& u) const {
        const long L = (long)i * G + c; if (L >= nwg) return false;
        int wgid = (int)L; { const int q = nwg / NXCD, r = nwg % NXCD, xcd = wgid % NXCD, off = wgid / NXCD; wgid = (xcd < r ? xcd * (q + 1) : r * (q + 1) + (xcd - r) * q) + off; }
        const int nig = WGM * nN, gid = wgid / nig, fm = gid * WGM, gsz = (nM - fm) < WGM ? (nM - fm) : WGM;
        u.pm = fm + ((wgid % nig) % gsz); u.pn = (wgid % nig) / gsz; return true;
    }
    __device__ __forceinline__ void a_ready(const Unit&) const {}
    __device__ __forceinline__ void done(const Unit&) const {}
};

__device__ __forceinline__ unsigned cvt_pk_bf16(float lo, float hi) { unsigned r; asm volatile("v_cvt_pk_bf16_f32 %0, %1, %2" : "=v"(r) : "v"(lo), "v"(hi)); return r; }
template <class Epi, class Sched, bool ALIGN_EPI = false, bool SP2 = false>
__device__ __forceinline__ void gemm_phase(PG8_LAS unsigned char* lds, const Gemm g, const Sched& S, const Epi& E) {
    int tid = threadIdx.x; asm volatile("" : "+v"(tid)); const int wid = __builtin_amdgcn_readfirstlane(tid >> 6), lane = tid & 63, wr = wid >> 2, wc = wid & 3, fr = lane & 15, fq = lane >> 4;
    const int K = g.K, nt = K / BK;
    unsigned voffA[2], voffB[2];
#pragma unroll
    for (int i = 0; i < 2; ++i) { int R, C; stage_rc(tid * 16 + i * 8192, R, C); const int Rb = Epi::PERM ? ((R & ~31) + perm32(R & 31)) : R;
        voffA[i] = (unsigned)(R * K + C) * 2u; voffB[i] = (unsigned)(Rb * K + C) * 2u; }
    const size_t kstep = (size_t)(BK * 2);
    const size_t hstep = (size_t)HALF * K * 2;
    const size_t tstep = 2 * hstep;
    const unsigned ldsw = (unsigned)wid * 1024u;
    const int aoff = lds_byte(wr * 64 + fr, fq * 8), boff = lds_byte(wc * 32 + fr, fq * 8);
#define PG8_SA(b, h) (((b) * 2 + (h)) * HTB)
#define PG8_SB(b, h) ((4 + (b) * 2 + (h)) * HTB)
#define PG8_STAGE(bufoff, gbase, voff) do { _Pragma("unroll") for (int _i = 0; _i < 2; ++_i) \
        __builtin_amdgcn_global_load_lds((const unsigned*)((const char*)(gbase) + (voff)[_i]), (PG8_LAS unsigned*)(lds + (bufoff) + ldsw + _i * 8192), 16, 0, 0); } while (0)
#define PG8_LDA(dst, b, h) do { _Pragma("unroll") for (int m = 0; m < 4; ++m) _Pragma("unroll") for (int k = 0; k < 2; ++k) dst[m][k] = *(const PG8_LAS bf16x8*)(lds + PG8_SA(b, h) + aoff + m * 2048 + k * 1024); } while (0)
#define PG8_LDB(dst, b, h) do { _Pragma("unroll") for (int n = 0; n < 2; ++n) _Pragma("unroll") for (int k = 0; k < 2; ++k) dst[n][k] = *(const PG8_LAS bf16x8*)(lds + PG8_SB(b, h) + boff + n * 2048 + k * 1024); } while (0)
#define PG8_MMA(ai, bj, At, Bt) do { __builtin_amdgcn_s_setprio(1); _Pragma("unroll") for (int m = 0; m < 4; ++m) _Pragma("unroll") for (int n = 0; n < 2; ++n) _Pragma("unroll") for (int k = 0; k < 2; ++k) \
        acc[ai][bj][m][n] = __builtin_amdgcn_mfma_f32_16x16x32_bf16(Bt[n][k], At[m][k], acc[ai][bj][m][n], 0, 0, 0); __builtin_amdgcn_s_setprio(0); } while (0)
#define PG8_WAIT_V(n) asm volatile("s_waitcnt vmcnt(" #n ")" ::: "memory")
#define PG8_WAIT_L(n) asm volatile("s_waitcnt lgkmcnt(" #n ")" ::: "memory")
#define PG8_BAR __builtin_amdgcn_s_barrier()
#define PG8_SCHED __builtin_amdgcn_sched_barrier(0)
    Unit cur, nxt; int ui = 0;
    if (!S.next(0, cur)) return;
    f32x4 acc[2][2][4][2];
#pragma unroll
    for (int a = 0; a < 2; ++a)
#pragma unroll
        for (int b = 0; b < 2; ++b)
#pragma unroll
            for (int m = 0; m < 4; ++m)
#pragma unroll
                for (int n = 0; n < 2; ++n) acc[a][b][m][n] = (f32x4){0.f, 0.f, 0.f, 0.f};
    bf16x8 At[4][2], B0[2][2], B1[2][2];
    const char* cA = (const char*)g.A + (size_t)cur.pm * tstep; const char* cB = (const char*)g.Bt + (size_t)cur.pn * tstep;
    S.a_ready(cur);
    if constexpr (SP2) {
        PG8_STAGE(PG8_SB(0, 0), cB, voffB); PG8_STAGE(PG8_SB(0, 1), cB + hstep, voffB); PG8_STAGE(PG8_SA(0, 0), cA, voffA); PG8_STAGE(PG8_SA(0, 1), cA + hstep, voffA);
        if (wr == 1) PG8_BAR;
        PG8_WAIT_V(2); PG8_BAR;
        PG8_STAGE(PG8_SB(1, 0), cB + kstep, voffB); PG8_STAGE(PG8_SA(1, 0), cA + kstep, voffA); PG8_STAGE(PG8_SB(1, 1), cB + hstep + kstep, voffB);
        PG8_WAIT_V(6); PG8_BAR;
    } else {
        PG8_STAGE(PG8_SB(0, 0), cB, voffB); PG8_STAGE(PG8_SA(0, 0), cA, voffA); PG8_STAGE(PG8_SB(0, 1), cB + hstep, voffB); PG8_STAGE(PG8_SA(0, 1), cA + hstep, voffA);
        if (wr == 1) PG8_BAR;
        PG8_WAIT_V(4); PG8_BAR;
        PG8_STAGE(PG8_SB(1, 0), cB + kstep, voffB); PG8_STAGE(PG8_SA(1, 0), cA + kstep, voffA); PG8_STAGE(PG8_SB(1, 1), cB + hstep + kstep, voffB);
        PG8_WAIT_V(6); PG8_BAR;
    }
    for (;;) {
        const bool has_next = S.next(ui + 1, nxt);
        const char* nA = has_next ? (const char*)g.A + (size_t)nxt.pm * tstep : cA; const char* nB = has_next ? (const char*)g.Bt + (size_t)nxt.pn * tstep : cB;
        for (int t = 0; t < nt; t += 2) {
            const bool last = (t == nt - 2);
            const char* a1 = cA + (size_t)(t + 1) * kstep;
            const char* a2 = last ? nA : cA + (size_t)(t + 2) * kstep; const char* b2 = last ? nB : cB + (size_t)(t + 2) * kstep;
            const char* a3 = a2 + kstep; const char* b3 = b2 + kstep;
            if (last && has_next) S.a_ready(nxt);
            if constexpr (SP2) {
            PG8_LDB(B0, 0, 0); PG8_LDB(B1, 0, 1); PG8_SCHED; PG8_LDA(At, 0, 0); PG8_STAGE(PG8_SA(1, 1), a1 + hstep, voffA);
            PG8_WAIT_V(8); PG8_WAIT_L(0); PG8_BAR; PG8_MMA(0, 0, At, B0); PG8_MMA(0, 1, At, B1); PG8_BAR; PG8_SCHED;
            PG8_LDA(At, 0, 1); PG8_STAGE(PG8_SB(0, 0), b2, voffB); PG8_STAGE(PG8_SB(0, 1), b2 + hstep, voffB); PG8_STAGE(PG8_SA(0, 0), a2, voffA);
            PG8_WAIT_V(8); PG8_WAIT_L(0); PG8_BAR; PG8_MMA(1, 0, At, B0); PG8_MMA(1, 1, At, B1); PG8_BAR; PG8_SCHED;
            PG8_LDB(B0, 1, 0); PG8_LDB(B1, 1, 1); PG8_SCHED; PG8_LDA(At, 1, 0); PG8_STAGE(PG8_SA(0, 1), a2 + hstep, voffA);
            PG8_WAIT_V(8); PG8_WAIT_L(0); PG8_BAR; PG8_MMA(0, 0, At, B0); PG8_MMA(0, 1, At, B1); PG8_BAR; PG8_SCHED;
            PG8_LDA(At, 1, 1); PG8_STAGE(PG8_SB(1, 0), b3, voffB); PG8_STAGE(PG8_SB(1, 1), b3 + hstep, voffB); PG8_STAGE(PG8_SA(1, 0), a3, voffA);
            PG8_WAIT_V(8); PG8_WAIT_L(0); PG8_BAR; PG8_MMA(1, 0, At, B0); PG8_MMA(1, 1, At, B1); PG8_BAR; PG8_SCHED;
            } else {
            PG8_LDB(B0, 0, 0); PG8_SCHED; PG8_LDA(At, 0, 0); PG8_STAGE(PG8_SA(1, 1), a1 + hstep, voffA);
            PG8_WAIT_L(8); PG8_BAR; PG8_WAIT_L(0); PG8_MMA(0, 0, At, B0); PG8_BAR; PG8_SCHED;
            PG8_LDB(B1, 0, 1); PG8_STAGE(PG8_SB(0, 0), b2, voffB);
            PG8_BAR; PG8_WAIT_L(0); PG8_MMA(0, 1, At, B1); PG8_BAR;
            PG8_LDA(At, 0, 1); PG8_STAGE(PG8_SA(0, 0), a2, voffA);
            PG8_BAR; PG8_WAIT_L(0); PG8_MMA(1, 0, At, B0); PG8_BAR; PG8_SCHED;
            PG8_STAGE(PG8_SB(0, 1), b2 + hstep, voffB);
            PG8_WAIT_V(6); PG8_BAR; PG8_MMA(1, 1, At, B1); PG8_BAR;
            PG8_LDB(B0, 1, 0); PG8_SCHED; PG8_LDA(At, 1, 0); PG8_STAGE(PG8_SA(0, 1), a2 + hstep, voffA);
            PG8_WAIT_L(8); PG8_BAR; PG8_WAIT_L(0); PG8_MMA(0, 0, At, B0); PG8_BAR; PG8_SCHED;
            PG8_LDB(B1, 1, 1); PG8_STAGE(PG8_SB(1, 0), b3, voffB);
            PG8_BAR; PG8_WAIT_L(0); PG8_MMA(0, 1, At, B1); PG8_BAR;
            PG8_LDA(At, 1, 1); PG8_STAGE(PG8_SA(1, 0), a3, voffA);
            PG8_BAR; PG8_WAIT_L(0); PG8_MMA(1, 0, At, B0); PG8_BAR; PG8_SCHED;
            PG8_STAGE(PG8_SB(1, 1), b3 + hstep, voffB);
            PG8_WAIT_V(6); PG8_BAR; PG8_MMA(1, 1, At, B1); PG8_BAR;
            }
        }
        if constexpr (ALIGN_EPI) { if (wr == 0) PG8_BAR; }
        if constexpr (!Epi::AFTER_DRAIN) { E(acc, cur, wr, wc, fr, fq); S.done(cur); }
        if (!has_next) break;
#pragma unroll
        for (int a = 0; a < 2; ++a)
#pragma unroll
            for (int b = 0; b < 2; ++b)
#pragma unroll
                for (int m = 0; m < 4; ++m)
#pragma unroll
                    for (int n = 0; n < 2; ++n) acc[a][b][m][n] = (f32x4){0.f, 0.f, 0.f, 0.f};
        cur = nxt; cA = nA; cB = nB; ++ui;
        if constexpr (ALIGN_EPI) { if (wr == 1) PG8_BAR; }
    }
    PG8_WAIT_V(0);
    if constexpr (!ALIGN_EPI) { if (wr == 0) PG8_BAR; }
    PG8_BAR;
    if constexpr (Epi::AFTER_DRAIN) { E.fused(acc, cur, wr, wc, fr, fq, lds, wid, lane); S.done(cur); }
#undef PG8_SA
#undef PG8_SB
#undef PG8_STAGE
#undef PG8_LDA
#undef PG8_LDB
#undef PG8_MMA
#undef PG8_WAIT_V
#undef PG8_WAIT_L
#undef PG8_BAR
#undef PG8_SCHED
}
}
#ifndef ATT_SDEPTH
#define ATT_SDEPTH 1
#endif
namespace att {
using bf16 = __hip_bfloat16;
constexpr int NW = 8, QBLK = 32, KVBLK = 64;
constexpr float SCALE = 0.07216878364870322f;
constexpr float THR = 8.f;
__device__ __forceinline__ int otid() { int t = threadIdx.x; asm volatile("" : "+v"(t)); return t; }
using bf16x8 = __attribute__((ext_vector_type(8))) short;
using s16x4  = __attribute__((ext_vector_type(4))) short;
using f32x16 = __attribute__((ext_vector_type(16))) float;
using f32x8  = __attribute__((ext_vector_type(8))) float;
using u32x4  = __attribute__((ext_vector_type(4))) unsigned;
#define KSWZ(row, colB) ((row) * 256 + ((colB) ^ (((row) & 7) << 4)))
#define SBAR() __builtin_amdgcn_sched_barrier(0)
__device__ __forceinline__ int crow(int r, int hi) { return (r & 3) + 8 * (r >> 2) + 4 * hi; }
__device__ __forceinline__ unsigned cvtpk(float lo, float hi) {
  unsigned r; asm volatile("v_cvt_pk_bf16_f32 %0, %1, %2" : "=v"(r) : "v"(lo), "v"(hi)); return r;
}
template <typename TIn> struct Stage;
template <> struct Stage<bf16>  { using T = bf16x8;
  __device__ static __forceinline__ T ld8(const bf16* p) { return *reinterpret_cast<const bf16x8*>(p); }
  __device__ static __forceinline__ bf16x8 tobf(T x) { return x; } };
template <> struct Stage<float> { using T = f32x8;
  __device__ static __forceinline__ T ld8(const float* p) { return *reinterpret_cast<const f32x8*>(p); }
  __device__ static __forceinline__ bf16x8 tobf(T x) {
    u32x4 w = {cvtpk(x[0], x[1]), cvtpk(x[2], x[3]), cvtpk(x[4], x[5]), cvtpk(x[6], x[7])}; return *reinterpret_cast<bf16x8*>(&w); } };

__device__ __forceinline__ void partialSM(f32x16& p0, f32x16& p1, float& m_reg, float& mn, float& alpha) {
  constexpr float C = SCALE * 1.4426950408889634f;
  float pmax = p0[0]; for (int r = 1; r < 16; ++r) pmax = fmaxf(pmax, p0[r]); for (int r = 0; r < 16; ++r) pmax = fmaxf(pmax, p1[r]);
  { auto rr = __builtin_amdgcn_permlane32_swap(__float_as_uint(pmax), __float_as_uint(pmax), false, false);
    pmax = fmaxf(__uint_as_float(rr[0]), __uint_as_float(rr[1])); }
  if (__builtin_expect(__all(pmax - m_reg <= THR / SCALE), 1)) { mn = m_reg; alpha = 1.f; }
  else { mn = fmaxf(m_reg, pmax); alpha = __builtin_amdgcn_exp2f((m_reg - mn) * C); m_reg = mn; }
  float mnC = -mn * C;
  for (int r = 0; r < 16; ++r) p0[r] = fmaf(p0[r], C, mnC); for (int r = 0; r < 16; ++r) p1[r] = fmaf(p1[r], C, mnC);
  for (int r = 0; r < 16; ++r) p0[r] = __builtin_amdgcn_exp2f(p0[r]);
}
__device__ __forceinline__ void finishSM(f32x16& p0, f32x16& p1, float alpha, float& l_reg, bf16x8& pa0, bf16x8& pa1, bf16x8& pa2, bf16x8& pa3) {
  for (int r = 0; r < 16; ++r) p1[r] = __builtin_amdgcn_exp2f(p1[r]);
  float ps = 0; for (int r = 0; r < 16; ++r) ps += p0[r]; for (int r = 0; r < 16; ++r) ps += p1[r];
  { auto rr = __builtin_amdgcn_permlane32_swap(__float_as_uint(ps), __float_as_uint(ps), false, false);
    ps = __uint_as_float(rr[0]) + __uint_as_float(rr[1]); }
  l_reg = l_reg * alpha + ps;
#define PK4(P, BASE, OUT) do { unsigned a0 = cvtpk(P[BASE + 0], P[BASE + 1]), a1 = cvtpk(P[BASE + 2], P[BASE + 3]);   \
    unsigned b0 = cvtpk(P[BASE + 4], P[BASE + 5]), b1 = cvtpk(P[BASE + 6], P[BASE + 7]);                              \
    auto r0 = __builtin_amdgcn_permlane32_swap(a0, b0, false, false); auto r1 = __builtin_amdgcn_permlane32_swap(a1, b1, false, false); \
    u32x4 w = {r0[0], r1[0], r0[1], r1[1]}; OUT = *reinterpret_cast<bf16x8*>(&w); } while (0)
  PK4(p0, 0, pa0); PK4(p0, 8, pa1); PK4(p1, 0, pa2); PK4(p1, 8, pa3);
#undef PK4
}
#define KSWZ2(row, colB) ((row) * 128 + ((colB) ^ (((row) & 7) << 4)))
__device__ __forceinline__ void qkt(f32x16& p0, f32x16& p1, const bf16* Ks, const bf16* KRs, const bf16x8* qr, const bf16x8* qrl, int r32, int hi) {
  p0 = f32x16{}; p1 = f32x16{};
#pragma unroll
  for (int d0 = 0; d0 < 8; ++d0) { int cb = (d0 * 16 + hi * 8) * 2;
    bf16x8 b0 = *reinterpret_cast<const bf16x8*>((const char*)Ks + KSWZ(r32, cb));
    bf16x8 b1 = *reinterpret_cast<const bf16x8*>((const char*)Ks + KSWZ(32 + r32, cb));
    p0 = __builtin_amdgcn_mfma_f32_32x32x16_bf16(b0, qr[d0], p0, 0, 0, 0);
    p1 = __builtin_amdgcn_mfma_f32_32x32x16_bf16(b1, qr[d0], p1, 0, 0, 0); }
#pragma unroll
  for (int d0 = 0; d0 < 4; ++d0) { int cb = (d0 * 16 + hi * 8) * 2;
    bf16x8 b0 = *reinterpret_cast<const bf16x8*>((const char*)KRs + KSWZ2(r32, cb));
    bf16x8 b1 = *reinterpret_cast<const bf16x8*>((const char*)KRs + KSWZ2(32 + r32, cb));
    const bf16x8 qv = qrl[d0 * 64];
    p0 = __builtin_amdgcn_mfma_f32_32x32x16_bf16(b0, qv, p0, 0, 0, 0);
    p1 = __builtin_amdgcn_mfma_f32_32x32x16_bf16(b1, qv, p1, 0, 0, 0); }
}
__device__ __forceinline__ int v_st(int k, int c) { const int kk = (k & ~0xC) | ((k & 4) << 1) | ((k & 8) >> 1); return ((kk >> 3) * 4 + (c >> 5)) * 512 + ((kk & 7) * 32 + (c & 31)) * 2; }
__device__ __forceinline__ int v_rd_base(int lane) { return ((lane & 3) << 3) | (((lane >> 2) & 3) << 6) | (((lane >> 4) & 1) << 5) | (((lane >> 5) & 1) << 8); }
constexpr int v_rd_off(int d0, int ks, int half) { return d0 * 512 + ks * 4096 + half * 2048; }
template <int OFF> __device__ __forceinline__ s16x4 tr_read(int vb) {
  s16x4 r; asm volatile("ds_read_b64_tr_b16 %0, %1 offset:%2" : "=&v"(r) : "v"(vb), "i"(OFF) : "memory"); return r;
}
template <int D0> __device__ __forceinline__ void pv_one(f32x16& od, int vb, bf16x8 pa0, bf16x8 pa1, bf16x8 pa2, bf16x8 pa3) {
  const s16x4 l0 = tr_read<v_rd_off(D0, 0, 0)>(vb), h0 = tr_read<v_rd_off(D0, 0, 1)>(vb), l1 = tr_read<v_rd_off(D0, 1, 0)>(vb), h1 = tr_read<v_rd_off(D0, 1, 1)>(vb);
  const s16x4 l2 = tr_read<v_rd_off(D0, 2, 0)>(vb), h2 = tr_read<v_rd_off(D0, 2, 1)>(vb), l3 = tr_read<v_rd_off(D0, 3, 0)>(vb), h3 = tr_read<v_rd_off(D0, 3, 1)>(vb);
  asm volatile("s_waitcnt lgkmcnt(0)" ::: "memory"); SBAR();
#define PK(L, H) (bf16x8){L[0], L[1], L[2], L[3], H[0], H[1], H[2], H[3]}
  od = __builtin_amdgcn_mfma_f32_32x32x16_bf16(pa0, PK(l0, h0), od, 0, 0, 0);
  od = __builtin_amdgcn_mfma_f32_32x32x16_bf16(pa1, PK(l1, h1), od, 0, 0, 0);
  od = __builtin_amdgcn_mfma_f32_32x32x16_bf16(pa2, PK(l2, h2), od, 0, 0, 0);
  od = __builtin_amdgcn_mfma_f32_32x32x16_bf16(pa3, PK(l3, h3), od, 0, 0, 0);
#undef PK
}
__device__ __forceinline__ void pv_d0(f32x16* o, int vb, bf16x8 pa0, bf16x8 pa1, bf16x8 pa2, bf16x8 pa3) {
  pv_one<0>(o[0], vb, pa0, pa1, pa2, pa3); pv_one<1>(o[1], vb, pa0, pa1, pa2, pa3); pv_one<2>(o[2], vb, pa0, pa1, pa2, pa3); pv_one<3>(o[3], vb, pa0, pa1, pa2, pa3);
}
constexpr int LDQ = 1536, LDK = 1024, LDV = 1024, LDKR = 64, LDO = 1024, SDEPTH = ATT_SDEPTH;
constexpr int SHM_V = KVBLK * 128 * 2, SHM_K = KVBLK * 128 * 2, SHM_KR = KVBLK * 64 * 2;
constexpr int SHM_QR = NW * 4 * 64 * 16;
constexpr int SHM_ATTN = 2 * SHM_V + 2 * SHM_K + 2 * SHM_KR + NW * 64 * 4 + SHM_QR;
__device__ __forceinline__ void attn_unit(const bf16* __restrict__ Qb, const bf16* __restrict__ Kh, const bf16* __restrict__ KRh, const bf16* __restrict__ Vh,
                                          bf16* __restrict__ Ob, int seq, char* lds) {
  using St = Stage<bf16>;
  const int tid = otid(), wid = tid >> 6, lane = tid & 63, r32 = lane & 31, hi = lane >> 5;
  bf16* V_lds = (bf16*)lds; bf16* K_lds = (bf16*)(lds + 2 * SHM_V); bf16* KR_lds = (bf16*)(lds + 2 * SHM_V + 2 * SHM_K);
  float* ws = (float*)(lds + 2 * SHM_V + 2 * SHM_K + 2 * SHM_KR) + wid * 64; float* li_l = ws; float* al_l = ws + 32;
  float m_reg = -1e30f, l_reg = 0; f32x16 o[4] = {}; bf16x8 qr[8];
  bf16x8* qrl = (bf16x8*)(lds + 2 * SHM_V + 2 * SHM_K + 2 * SHM_KR + NW * 64 * 4) + wid * 256 + lane;
  const bf16* Qw = Qb + (long)(wid * QBLK + r32) * LDQ + hi * 8;
#pragma unroll
  for (int d0 = 0; d0 < 8; ++d0) qr[d0] = St::ld8(Qw + d0 * 16);
#pragma unroll
  for (int d0 = 0; d0 < 4; ++d0) qrl[d0 * 64] = St::ld8(Qw + 128 + d0 * 16);
  const int sr = tid >> 4, sc = (tid & 15) * 8, vst0 = v_st(sr, sc), vst1 = v_st(32 + sr, sc);
  const int krr = tid >> 3, krc = (tid & 7) * 8;
  const int vb0 = (int)(uintptr_t)V_lds + v_rd_base(lane);
  struct { bf16x8 vs0, vs1, ks0, ks1, kr; } sr_[SDEPTH];
#define SLOAD(i, k0) do { sr_[i].vs0 = St::ld8(&Vh[(long)((k0) + sr) * LDV + sc]); sr_[i].vs1 = St::ld8(&Vh[(long)((k0) + 32 + sr) * LDV + sc]); \
    sr_[i].ks0 = St::ld8(&Kh[(long)((k0) + sr) * LDK + sc]); sr_[i].ks1 = St::ld8(&Kh[(long)((k0) + 32 + sr) * LDK + sc]); \
    sr_[i].kr = St::ld8(&KRh[(long)((k0) + krr) * LDKR + krc]); } while (0)
#define SWRITE(b, i) do { *(bf16x8*)((char*)V_lds + (b) * SHM_V + vst0) = sr_[i].vs0;          \
    *(bf16x8*)((char*)V_lds + (b) * SHM_V + vst1) = sr_[i].vs1; int kc = sc * 2;               \
    *(bf16x8*)((char*)K_lds + (b) * SHM_K + KSWZ(sr, kc)) = sr_[i].ks0;                       \
    *(bf16x8*)((char*)K_lds + (b) * SHM_K + KSWZ(32 + sr, kc)) = sr_[i].ks1;                  \
    *(bf16x8*)((char*)KR_lds + (b) * SHM_KR + KSWZ2(krr, krc * 2)) = sr_[i].kr; } while (0)
#define SWAIT() do { if constexpr (SDEPTH == 2) asm volatile("s_waitcnt vmcnt(5)" ::: "memory"); else asm volatile("s_waitcnt vmcnt(0)" ::: "memory"); } while (0)
#define RESC(a) do { if (__any((a) < 1.f)) { if (hi == 0) al_l[r32] = (a); asm volatile("s_waitcnt lgkmcnt(0)" ::: "memory"); \
    _Pragma("unroll") for (int d = 0; d < 4; ++d) _Pragma("unroll") for (int r = 0; r < 16; ++r) o[d][r] *= al_l[crow(r, hi)]; } } while (0)
  f32x16 pA0, pA1, pB0, pB1; float mnA, mnB, alA, alB; bf16x8 pa0, pa1, pa2, pa3; const int NT = seq / KVBLK;
  constexpr int SE = 0, SO = SDEPTH - 1;
  SLOAD(SE, 0); asm volatile("s_waitcnt vmcnt(0)" ::: "memory"); SWRITE(0, SE); __syncthreads();
  qkt(pA0, pA1, K_lds, KR_lds, qr, qrl, r32, hi); partialSM(pA0, pA1, m_reg, mnA, alA);
  SLOAD(SO, KVBLK); if constexpr (SDEPTH == 2) { if (2 < NT) SLOAD(SE, 2 * KVBLK); }
  SWAIT(); SWRITE(1, SO); __syncthreads();
  for (int j = 1; j + 1 < NT; j += 2) {
    SBAR(); qkt(pB0, pB1, (bf16*)((char*)K_lds + SHM_K), (bf16*)((char*)KR_lds + SHM_KR), qr, qrl, r32, hi);
    finishSM(pA0, pA1, alA, l_reg, pa0, pa1, pa2, pa3); SBAR();
    SLOAD(SO, (j + SDEPTH) * KVBLK); SBAR();
    pv_d0(o, vb0, pa0, pa1, pa2, pa3); partialSM(pB0, pB1, m_reg, mnB, alB);
    __syncthreads(); SWAIT(); SWRITE(0, SE);
    RESC(alB); __syncthreads();
    SBAR(); qkt(pA0, pA1, K_lds, KR_lds, qr, qrl, r32, hi);
    finishSM(pB0, pB1, alB, l_reg, pa0, pa1, pa2, pa3); SBAR();
    if (SDEPTH == 1 || j + 3 < NT) SLOAD(SE, (j + 1 + SDEPTH) * KVBLK); SBAR();
    pv_d0(o, vb0 + (int)SHM_V, pa0, pa1, pa2, pa3); partialSM(pA0, pA1, m_reg, mnA, alA);
    __syncthreads(); SWAIT(); SWRITE(1, SO);
    RESC(alA); __syncthreads();
  }
  SBAR(); qkt(pB0, pB1, (bf16*)((char*)K_lds + SHM_K), (bf16*)((char*)KR_lds + SHM_KR), qr, qrl, r32, hi);
  finishSM(pA0, pA1, alA, l_reg, pa0, pa1, pa2, pa3); SBAR();
  pv_d0(o, vb0, pa0, pa1, pa2, pa3); partialSM(pB0, pB1, m_reg, mnB, alB);
  __syncthreads(); RESC(alB);
  finishSM(pB0, pB1, alB, l_reg, pa0, pa1, pa2, pa3); SBAR();
  pv_d0(o, vb0 + (int)SHM_V, pa0, pa1, pa2, pa3);
  if (hi == 0) li_l[r32] = l_reg; asm volatile("s_waitcnt lgkmcnt(0)" ::: "memory");
  float rli[16];
#pragma unroll
  for (int r = 0; r < 16; ++r) rli[r] = __builtin_amdgcn_rcpf(li_l[crow(r, hi)]);
  bf16* Ow = Ob + (long)(wid * QBLK) * LDO;
#pragma unroll
  for (int r = 0; r < 16; ++r) { int orow = crow(r, hi);
#pragma unroll
    for (int d0 = 0; d0 < 4; ++d0) Ow[(long)orow * LDO + d0 * 32 + r32] = __float2bfloat16(o[d0][r] * rli[r]); }
  __syncthreads();
#undef SLOAD
#undef SWRITE
#undef SWAIT
#undef RESC
}
#undef SBAR
}
constexpr int BATCH = 4, SEQ = 8192, DM = 1024, DEPTH = 4, DFF = 2816, MT = BATCH * SEQ;
constexpr int NH = 8, QLR = 256, KVLR = 128, QKD = 192;
constexpr float EPS = 1e-6f;
constexpr size_t MiB = 1u << 20;
constexpr size_t WS_WFFI = 1 * MiB;
constexpr size_t WS_WFFO = 89 * MiB;
constexpr size_t WS_WHIN = 133 * MiB;
constexpr size_t WS_WHO  = 153 * MiB;
constexpr size_t WS_WMIN = 157 * MiB;
constexpr size_t WS_WUQ  = 159 * MiB;
constexpr size_t WS_WUKV = 161 * MiB;
constexpr size_t WS_WMO  = 162 * MiB;
constexpr size_t WS_COS  = 166 * MiB;
constexpr size_t WS_SIN  = 170 * MiB;
constexpr size_t WS_LB   = 174 * MiB;
constexpr size_t WS_HN   = 176 * MiB;
constexpr size_t WS_Y    = 240 * MiB;
constexpr size_t WS_YB   = 304 * MiB;
constexpr size_t WS_R    = 368 * MiB;
constexpr size_t WS_END  = 704 * MiB;
constexpr size_t R_ACT = 0;
constexpr size_t R_C = 0, R_QB = 0, R_CQ = 96 * MiB, R_CKV = 112 * MiB, R_KR = 120 * MiB, R_KN = 124 * MiB, R_VB = 188 * MiB, R_O = 252 * MiB;
constexpr size_t R_QH = 0, R_VH = 64 * MiB, R_GH = 128 * MiB, R_KF = 192 * MiB, R_HO = 0;

constexpr int LDS_RING = 131072, LDS_BYTES = LDS_RING + 2048;
typedef unsigned short bf16_t;
typedef float f32x4 __attribute__((ext_vector_type(4)));
typedef float f32x2 __attribute__((ext_vector_type(2)));
typedef unsigned u32x4 __attribute__((ext_vector_type(4)));
typedef unsigned u32x2 __attribute__((ext_vector_type(2)));
typedef _Float16 h16x2 __attribute__((ext_vector_type(2)));
#define LAS __attribute__((address_space(3)))

__device__ __constant__ double ROPE_INVF[32] = {1.0, 0.7498942093324559, 0.5623413251903491, 0.4216965034285822, 0.31622776601683794, 0.23713737056616552, 0.1778279410038923, 0.1333521432163324, 0.1, 0.07498942093324558, 0.05623413251903491, 0.042169650342858224, 0.03162277660168379, 0.023713737056616554, 0.01778279410038923, 0.01333521432163324, 0.01, 0.007498942093324558, 0.005623413251903491, 0.004216965034285823, 0.0031622776601683794, 0.0023713737056616554, 0.0017782794100389228, 0.001333521432163324, 0.001, 0.0007498942093324559, 0.0005623413251903491, 0.00042169650342858224, 0.00031622776601683794, 0.00023713737056616554, 0.00017782794100389227, 0.0001333521432163324};

__device__ __forceinline__ unsigned pk2(float lo, float hi) { return pg8::cvt_pk_bf16(lo, hi); }
__device__ __forceinline__ float silu_f(float g) { return g * __builtin_amdgcn_rcpf(1.0f + __expf(-g)); }
__device__ __forceinline__ float wave_sum(float v) {
#pragma unroll
    for (int o = 1; o < 64; o <<= 1) v += __shfl_xor(v, o);
    return v;
}
__device__ __forceinline__ float half_sum(float v) {
#pragma unroll
    for (int o = 1; o < 32; o <<= 1) v += __shfl_xor(v, o);
    return v;
}

using pg8::Unit;
struct EpiSwiglu { static constexpr bool PERM = true, AFTER_DRAIN = false; bf16_t* O;
    __device__ __forceinline__ void operator()(const pg8::f32x4 (&acc)[2][2][4][2], const Unit& u, int wr, int wc, int fr, int fq) const {
        const int row0 = u.pm * 256 + wr * 64 + fr, col0 = u.pn * 128 + wc * 32 + 8 * fq;
#pragma unroll
        for (int ai = 0; ai < 2; ++ai)
#pragma unroll
            for (int m = 0; m < 4; ++m) { bf16_t* p = O + (size_t)(row0 + ai * 128 + m * 16) * DFF + col0;
                const pg8::f32x4 g0 = acc[ai][0][m][0], g1 = acc[ai][0][m][1], u0 = acc[ai][1][m][0], u1 = acc[ai][1][m][1];
                u32x4 w; w.x = pk2(silu_f(g0[0]) * u0[0], silu_f(g0[1]) * u0[1]); w.y = pk2(silu_f(g0[2]) * u0[2], silu_f(g0[3]) * u0[3]);
                w.z = pk2(silu_f(g1[0]) * u1[0], silu_f(g1[1]) * u1[1]); w.w = pk2(silu_f(g1[2]) * u1[2], silu_f(g1[3]) * u1[3]);
                *(u32x4*)p = w; }
    }
};
struct EpiF32 { static constexpr bool PERM = false, AFTER_DRAIN = false; float* O; int ldc;
    __device__ __forceinline__ void operator()(const pg8::f32x4 (&acc)[2][2][4][2], const Unit& u, int wr, int wc, int fr, int fq) const {
        const int row0 = u.pm * 256 + wr * 64 + fr, col0 = u.pn * 256 + wc * 32 + 4 * fq;
#pragma unroll
        for (int ai = 0; ai < 2; ++ai)
#pragma unroll
            for (int m = 0; m < 4; ++m) { float* p = O + (size_t)(row0 + ai * 128 + m * 16) * ldc + col0;
#pragma unroll
                for (int bj = 0; bj < 2; ++bj)
#pragma unroll
                    for (int n = 0; n < 2; ++n) *(pg8::f32x4*)(p + bj * 128 + n * 16) = acc[ai][bj][m][n]; }
    }
};
struct EpiB16 { static constexpr bool PERM = true, AFTER_DRAIN = false; bf16_t* O; int ldc;
    __device__ __forceinline__ void operator()(const pg8::f32x4 (&acc)[2][2][4][2], const Unit& u, int wr, int wc, int fr, int fq) const {
        const int row0 = u.pm * 256 + wr * 64 + fr, col0 = u.pn * 256 + wc * 32 + 8 * fq;
#pragma unroll
        for (int ai = 0; ai < 2; ++ai)
#pragma unroll
            for (int m = 0; m < 4; ++m) { bf16_t* p = O + (size_t)(row0 + ai * 128 + m * 16) * ldc + col0;
#pragma unroll
                for (int bj = 0; bj < 2; ++bj) { const pg8::f32x4 v0 = acc[ai][bj][m][0], v1 = acc[ai][bj][m][1];
                    u32x4 w; w.x = pk2(v0[0], v0[1]); w.y = pk2(v0[2], v0[3]); w.z = pk2(v1[0], v1[1]); w.w = pk2(v1[2], v1[3]);
                    *(u32x4*)(p + bj * 128) = w; } }
    }
};
struct EpiQ { static constexpr bool PERM = true, AFTER_DRAIN = false; bf16_t* O; const float* cs; const float* sn;
    __device__ __forceinline__ void operator()(const pg8::f32x4 (&acc)[2][2][4][2], const Unit& u, int wr, int wc, int fr, int fq) const {
        const int row0 = u.pm * 256 + wr * 64 + fr;
#pragma unroll
        for (int bj = 0; bj < 2; ++bj) { const int col0 = u.pn * 256 + bj * 128 + wc * 32 + 8 * fq, d = col0 % QKD; const bool rot = d >= 128; const int i0 = (d - 128) >> 1;
#pragma unroll
            for (int ai = 0; ai < 2; ++ai)
#pragma unroll
                for (int m = 0; m < 4; ++m) { const int row = row0 + ai * 128 + m * 16; pg8::f32x4 v0 = acc[ai][bj][m][0], v1 = acc[ai][bj][m][1];
                    if (rot) { const pg8::f32x4 c = *(const pg8::f32x4*)(cs + (size_t)row * 32 + i0), s = *(const pg8::f32x4*)(sn + (size_t)row * 32 + i0);
                        pg8::f32x4 a, b; a[0] = v0[0] * c[0] - v0[1] * s[0]; a[1] = v0[0] * s[0] + v0[1] * c[0]; a[2] = v0[2] * c[1] - v0[3] * s[1]; a[3] = v0[2] * s[1] + v0[3] * c[1];
                        b[0] = v1[0] * c[2] - v1[1] * s[2]; b[1] = v1[0] * s[2] + v1[1] * c[2]; b[2] = v1[2] * c[3] - v1[3] * s[3]; b[3] = v1[2] * s[3] + v1[3] * c[3]; v0 = a; v1 = b; }
                    u32x4 w; w.x = pk2(v0[0], v0[1]); w.y = pk2(v0[2], v0[3]); w.z = pk2(v1[0], v1[1]); w.w = pk2(v1[2], v1[3]);
                    *(u32x4*)(O + (size_t)row * 1536 + col0) = w; } }
    }
};
struct EpiKV { static constexpr bool PERM = true, AFTER_DRAIN = false; bf16_t* Kn; bf16_t* Vb;
    __device__ __forceinline__ void operator()(const pg8::f32x4 (&acc)[2][2][4][2], const Unit& u, int wr, int wc, int fr, int fq) const {
        const int row0 = u.pm * 256 + wr * 64 + fr, col0 = u.pn * 128 + wc * 32 + 8 * fq;
#pragma unroll
        for (int bj = 0; bj < 2; ++bj) { bf16_t* base = bj ? Vb : Kn;
#pragma unroll
            for (int ai = 0; ai < 2; ++ai)
#pragma unroll
                for (int m = 0; m < 4; ++m) { const pg8::f32x4 v0 = acc[ai][bj][m][0], v1 = acc[ai][bj][m][1];
                    u32x4 w; w.x = pk2(v0[0], v0[1]); w.y = pk2(v0[2], v0[3]); w.z = pk2(v1[0], v1[1]); w.w = pk2(v1[2], v1[3]);
                    *(u32x4*)(base + (size_t)(row0 + ai * 128 + m * 16) * 1024 + col0) = w; } }
    }
};
__device__ __forceinline__ unsigned pkh2(float a, float b) { const h16x2 h = {(_Float16)a, (_Float16)b}; return __builtin_bit_cast(unsigned, h); }
__device__ __forceinline__ float kgate(float om, float z) { return om * __builtin_amdgcn_rcpf(1.0f + __expf(z)); }
struct EpiHgrn { static constexpr bool PERM = true, AFTER_DRAIN = false; bf16_t* Qh; bf16_t* Vh; bf16_t* Gh; unsigned short* KF; const float* lb;
    __device__ __forceinline__ void operator()(const pg8::f32x4 (&acc)[2][2][4][2], const Unit& u, int wr, int wc, int fr, int fq) const {
        const int row0 = u.pm * 256 + wr * 64 + fr, seg = u.pn >> 2;
#pragma unroll
        for (int bj = 0; bj < 2; ++bj) { const int cc = (u.pn & 3) * 256 + bj * 128 + wc * 32 + 8 * fq;
            if (seg == 1 || seg == 2) {
                const pg8::f32x4 om0 = 1.0f - *(const pg8::f32x4*)(lb + (seg - 1) * 1024 + cc), om1 = 1.0f - *(const pg8::f32x4*)(lb + (seg - 1) * 1024 + cc + 4);
                unsigned short* base = KF + (size_t)(seg - 1) * MT * 1024;
#pragma unroll
                for (int ai = 0; ai < 2; ++ai)
#pragma unroll
                    for (int m = 0; m < 4; ++m) { const size_t off = (size_t)(row0 + ai * 128 + m * 16) * 1024 + cc; const pg8::f32x4 v0 = acc[ai][bj][m][0], v1 = acc[ai][bj][m][1];
                        u32x4 w; w.x = pkh2(kgate(om0[0], v0[0]), kgate(om0[1], v0[1])); w.y = pkh2(kgate(om0[2], v0[2]), kgate(om0[3], v0[3]));
                        w.z = pkh2(kgate(om1[0], v1[0]), kgate(om1[1], v1[1])); w.w = pkh2(kgate(om1[2], v1[2]), kgate(om1[3], v1[3]));
                        *(u32x4*)(base + off) = w; }
            } else if (seg == 3) {
#pragma unroll
                for (int ai = 0; ai < 2; ++ai)
#pragma unroll
                    for (int m = 0; m < 4; ++m) { const size_t off = (size_t)(row0 + ai * 128 + m * 16) * 1024 + cc; const pg8::f32x4 v0 = acc[ai][bj][m][0], v1 = acc[ai][bj][m][1];
                        u32x4 w; w.x = pk2(v0[0], v0[1]); w.y = pk2(v0[2], v0[3]); w.z = pk2(v1[0], v1[1]); w.w = pk2(v1[2], v1[3]);
                        *(u32x4*)(Vh + off) = w; }
            } else { bf16_t* base = seg == 0 ? Qh : Gh;
#pragma unroll
                for (int ai = 0; ai < 2; ++ai)
#pragma unroll
                    for (int m = 0; m < 4; ++m) { const size_t off = (size_t)(row0 + ai * 128 + m * 16) * 1024 + cc; const pg8::f32x4 v0 = acc[ai][bj][m][0], v1 = acc[ai][bj][m][1];
                        u32x4 w; w.x = pk2(silu_f(v0[0]), silu_f(v0[1])); w.y = pk2(silu_f(v0[2]), silu_f(v0[3])); w.z = pk2(silu_f(v1[0]), silu_f(v1[1])); w.w = pk2(silu_f(v1[2]), silu_f(v1[3]));
                        *(u32x4*)(base + off) = w; } } }
    }
};

__device__ __forceinline__ int src_col(int mode, int n) {
    if (mode == 1) { const int t = n >> 8, j = n & 255; return j < 128 ? t * 128 + j : DFF + t * 128 + (j - 128); }
    if (mode == 2) { if (n < 384) return n; if (n >= 448) return -1; const int j = n - 384; return 384 + (j >> 1) + 32 * (j & 1); }
    if (mode == 3) { const int h = n / QKD, d = n % QKD; if (d < 128) return n; const int j = d - 128; return h * QKD + 128 + (j >> 1) + 32 * (j & 1); }
    return n;
}
__device__ __forceinline__ void xpose_item(const float* __restrict__ W, int K, int Nsrc, int Ndst, int mode, bf16_t* __restrict__ WT, LAS float* scr, int item, int lane) {
    const int nblk = Ndst / 32, kb = item / nblk, nb = item % nblk, k0 = 64 * kb, n0 = 32 * nb;
    if (mode <= 1) {
        const int sc0 = src_col(mode, n0) + (lane & 7) * 4;
#pragma unroll
        for (int i = 0; i < 8; ++i) { const int kk = 8 * i + (lane >> 3); const f32x4 v = *(const f32x4*)(W + (size_t)(k0 + kk) * Nsrc + sc0);
            LAS float* d = scr + kk * 33 + (lane & 7) * 4; d[0] = v[0]; d[1] = v[1]; d[2] = v[2]; d[3] = v[3]; }
    } else {
        const int sc = src_col(mode, n0 + (lane & 31));
#pragma unroll 8
        for (int i = 0; i < 32; ++i) { const int kk = 2 * i + (lane >> 5); scr[kk * 33 + (lane & 31)] = sc >= 0 ? W[(size_t)(k0 + kk) * Nsrc + sc] : 0.f; }
    }
    asm volatile("s_waitcnt lgkmcnt(0)" ::: "memory");
    const int c = lane & 7;
#pragma unroll
    for (int j = 0; j < 4; ++j) { const int n = (lane >> 3) + 8 * j; const LAS float* s = scr + (8 * c) * 33 + n;
        u32x4 o; o.x = pk2(s[0 * 33], s[1 * 33]); o.y = pk2(s[2 * 33], s[3 * 33]); o.z = pk2(s[4 * 33], s[5 * 33]); o.w = pk2(s[6 * 33], s[7 * 33]);
        *(u32x4*)(WT + (size_t)(n0 + n) * K + k0 + 8 * c) = o; }
    asm volatile("s_waitcnt lgkmcnt(0)" ::: "memory");
}

__device__ __forceinline__ void row_init(const float* __restrict__ xin, float* __restrict__ X, bf16_t* __restrict__ HN, const float* __restrict__ g, int lane) {
    const f32x4* xr = (const f32x4*)xin + lane; f32x4 v[4]; float s = 0.f;
#pragma unroll
    for (int j = 0; j < 4; ++j) { v[j] = xr[64 * j]; s += (v[j][0] * v[j][0] + v[j][1] * v[j][1]) + (v[j][2] * v[j][2] + v[j][3] * v[j][3]); }
    const float r = rsqrtf(wave_sum(s) * (1.f / DM) + EPS);
#pragma unroll
    for (int j = 0; j < 4; ++j) { ((f32x4*)X + lane)[64 * j] = v[j]; const f32x4 gg = ((const f32x4*)g + lane)[64 * j];
        u32x2 w; w.x = pk2(v[j][0] * r * gg[0], v[j][1] * r * gg[1]); w.y = pk2(v[j][2] * r * gg[2], v[j][3] * r * gg[3]); ((u32x2*)HN + lane)[64 * j] = w; }
}
__device__ __forceinline__ void row_post(const bf16_t* __restrict__ Y, float* __restrict__ X, bf16_t* __restrict__ HN, float scale, const float* __restrict__ gp, const float* __restrict__ gn, int lane) {
    f32x4 y[4], x[4]; float s = 0.f;
#pragma unroll
    for (int j = 0; j < 4; ++j) { const u32x2 yb = __builtin_nontemporal_load((const u32x2*)Y + lane + 64 * j); y[j] = (f32x4){__uint_as_float(yb.x << 16), __uint_as_float(yb.x & 0xffff0000u), __uint_as_float(yb.y << 16), __uint_as_float(yb.y & 0xffff0000u)};
        x[j] = __builtin_nontemporal_load((const f32x4*)X + lane + 64 * j); s += (y[j][0] * y[j][0] + y[j][1] * y[j][1]) + (y[j][2] * y[j][2] + y[j][3] * y[j][3]); }
    const float r = rsqrtf(wave_sum(s) * (1.f / DM) + EPS) * scale; float s2 = 0.f;
#pragma unroll
    for (int j = 0; j < 4; ++j) { const f32x4 gg = ((const f32x4*)gp + lane)[64 * j]; x[j] = x[j] + y[j] * r * gg; __builtin_nontemporal_store(x[j], (f32x4*)X + lane + 64 * j);
        s2 += (x[j][0] * x[j][0] + x[j][1] * x[j][1]) + (x[j][2] * x[j][2] + x[j][3] * x[j][3]); }
    if (HN) { const float r2 = rsqrtf(wave_sum(s2) * (1.f / DM) + EPS);
#pragma unroll
        for (int j = 0; j < 4; ++j) { const f32x4 gg = ((const f32x4*)gn + lane)[64 * j];
            u32x2 w; w.x = pk2(x[j][0] * r2 * gg[0], x[j][1] * r2 * gg[1]); w.y = pk2(x[j][2] * r2 * gg[2], x[j][3] * r2 * gg[3]); ((u32x2*)HN + lane)[64 * j] = w; } }
}
template <int NR>
__device__ __forceinline__ void row_post_n(const bf16_t* __restrict__ Y, float* __restrict__ X, bf16_t* __restrict__ HN, size_t row_stride, float scale, const float* __restrict__ gp, const float* __restrict__ gn, int lane) {
    f32x4 y[NR][4], x[NR][4]; float s[NR];
#pragma unroll
    for (int i = 0; i < NR; ++i) {
#pragma unroll
        for (int j = 0; j < 4; ++j) { const u32x2 yb = ((const u32x2*)(Y + i * row_stride) + lane)[64 * j];
            y[i][j] = (f32x4){__uint_as_float(yb.x << 16), __uint_as_float(yb.x & 0xffff0000u), __uint_as_float(yb.y << 16), __uint_as_float(yb.y & 0xffff0000u)};
            x[i][j] = ((const f32x4*)(X + i * row_stride) + lane)[64 * j]; } }
    f32x4 gpv[4];
#pragma unroll
    for (int j = 0; j < 4; ++j) gpv[j] = ((const f32x4*)gp + lane)[64 * j];
#pragma unroll
    for (int i = 0; i < NR; ++i) { float a = 0.f;
#pragma unroll
        for (int j = 0; j < 4; ++j) a += (y[i][j][0] * y[i][j][0] + y[i][j][1] * y[i][j][1]) + (y[i][j][2] * y[i][j][2] + y[i][j][3] * y[i][j][3]);
        s[i] = a; }
#pragma unroll
    for (int o = 1; o < 64; o <<= 1) {
#pragma unroll
        for (int i = 0; i < NR; ++i) s[i] += __shfl_xor(s[i], o); }
    float s2[NR];
#pragma unroll
    for (int i = 0; i < NR; ++i) { const float r = rsqrtf(s[i] * (1.f / DM) + EPS) * scale; float a = 0.f;
#pragma unroll
        for (int j = 0; j < 4; ++j) { x[i][j] = x[i][j] + y[i][j] * r * gpv[j]; ((f32x4*)(X + i * row_stride) + lane)[64 * j] = x[i][j];
            a += (x[i][j][0] * x[i][j][0] + x[i][j][1] * x[i][j][1]) + (x[i][j][2] * x[i][j][2] + x[i][j][3] * x[i][j][3]); }
        s2[i] = a; }
    if (HN) {
#pragma unroll
        for (int j = 0; j < 4; ++j) gpv[j] = ((const f32x4*)gn + lane)[64 * j];
#pragma unroll
        for (int o = 1; o < 64; o <<= 1) {
#pragma unroll
            for (int i = 0; i < NR; ++i) s2[i] += __shfl_xor(s2[i], o); }
#pragma unroll
        for (int i = 0; i < NR; ++i) { const float r2 = rsqrtf(s2[i] * (1.f / DM) + EPS);
#pragma unroll
            for (int j = 0; j < 4; ++j) { u32x2 w; w.x = pk2(x[i][j][0] * r2 * gpv[j][0], x[i][j][1] * r2 * gpv[j][1]); w.y = pk2(x[i][j][2] * r2 * gpv[j][2], x[i][j][3] * r2 * gpv[j][3]);
                ((u32x2*)(HN + i * row_stride) + lane)[64 * j] = w; } } }
}
__device__ __forceinline__ void row_mla(const float* __restrict__ C, bf16_t* __restrict__ CQ, bf16_t* __restrict__ CKV, bf16_t* __restrict__ KR, const float* __restrict__ qn, const float* __restrict__ kvn,
                                        const float* __restrict__ cs, const float* __restrict__ sn, int lane) {
    const f32x4 a = ((const f32x4*)C)[2 * lane], b = ((const f32x4*)C)[2 * lane + 1];
    float s = (a[0] * a[0] + a[1] * a[1]) + (a[2] * a[2] + a[3] * a[3]) + (b[0] * b[0] + b[1] * b[1]) + (b[2] * b[2] + b[3] * b[3]);
#pragma unroll
    for (int o = 1; o < 16; o <<= 1) s += __shfl_xor(s, o);
    const float s16 = s, s32 = s16 + __shfl_xor(s16, 16);
    float v[8] = {a[0], a[1], a[2], a[3], b[0], b[1], b[2], b[3]};
    if (lane < 32) { const float r = rsqrtf(s32 * (1.f / QLR) + EPS); const f32x4 g0 = ((const f32x4*)qn)[2 * lane], g1 = ((const f32x4*)qn)[2 * lane + 1];
        u32x4 w; w.x = pk2(v[0] * r * g0[0], v[1] * r * g0[1]); w.y = pk2(v[2] * r * g0[2], v[3] * r * g0[3]); w.z = pk2(v[4] * r * g1[0], v[5] * r * g1[1]); w.w = pk2(v[6] * r * g1[2], v[7] * r * g1[3]);
        ((u32x4*)CQ)[lane] = w;
    } else if (lane < 48) { const int l = lane - 32; const float r = rsqrtf(s16 * (1.f / KVLR) + EPS); const f32x4 g0 = ((const f32x4*)kvn)[2 * l], g1 = ((const f32x4*)kvn)[2 * l + 1];
        u32x4 w; w.x = pk2(v[0] * r * g0[0], v[1] * r * g0[1]); w.y = pk2(v[2] * r * g0[2], v[3] * r * g0[3]); w.z = pk2(v[4] * r * g1[0], v[5] * r * g1[1]); w.w = pk2(v[6] * r * g1[2], v[7] * r * g1[3]);
        ((u32x4*)CKV)[l] = w;
    } else if (lane < 56) { const int l = lane - 48; const f32x4 c = ((const f32x4*)cs)[l], sv = ((const f32x4*)sn)[l];
        u32x4 w; w.x = pk2(v[0] * c[0] - v[1] * sv[0], v[0] * sv[0] + v[1] * c[0]); w.y = pk2(v[2] * c[1] - v[3] * sv[1], v[2] * sv[1] + v[3] * c[1]);
        w.z = pk2(v[4] * c[2] - v[5] * sv[2], v[4] * sv[2] + v[5] * c[2]); w.w = pk2(v[6] * c[3] - v[7] * sv[3], v[6] * sv[3] + v[7] * c[3]);
        ((u32x4*)KR)[l] = w; }
}
__device__ __forceinline__ void row_hgrn(const bf16_t* __restrict__ Oa, const bf16_t* __restrict__ Gh, bf16_t* __restrict__ HO, const float* __restrict__ on, int lane) {
#pragma unroll
    for (int j = 0; j < 4; ++j) { const u32x2 a = ((const u32x2*)Oa + lane)[64 * j], b = ((const u32x2*)(Oa + (size_t)MT * 1024) + lane)[64 * j];
        f32x4 o; o[0] = __uint_as_float(a.x << 16) + __uint_as_float(b.x << 16); o[1] = __uint_as_float(a.x & 0xffff0000u) + __uint_as_float(b.x & 0xffff0000u);
        o[2] = __uint_as_float(a.y << 16) + __uint_as_float(b.y << 16); o[3] = __uint_as_float(a.y & 0xffff0000u) + __uint_as_float(b.y & 0xffff0000u);
        const float s = half_sum((o[0] * o[0] + o[1] * o[1]) + (o[2] * o[2] + o[3] * o[3]));
        const float r = rsqrtf(s * (1.f / 128.f) + EPS); const f32x4 gg = ((const f32x4*)on + lane)[64 * j]; const u32x2 gb = ((const u32x2*)Gh + lane)[64 * j];
        const float g0 = __uint_as_float(gb.x << 16), g1 = __uint_as_float(gb.x & 0xffff0000u), g2 = __uint_as_float(gb.y << 16), g3 = __uint_as_float(gb.y & 0xffff0000u);
        u32x2 w; w.x = pk2(o[0] * r * gg[0] * g0, o[1] * r * gg[1] * g1); w.y = pk2(o[2] * r * gg[2] * g2, o[3] * r * gg[3] * g3); ((u32x2*)HO + lane)[64 * j] = w; }
}
__device__ __forceinline__ f32x2 h2f2_(unsigned u) { const h16x2 h = __builtin_bit_cast(h16x2, u); return (f32x2){(float)h[0], (float)h[1]}; }
__device__ __forceinline__ void scan_phase(LAS unsigned char* lds, const bf16_t* __restrict__ Qh, const bf16_t* __restrict__ Vh, const unsigned short* __restrict__ KF, bf16_t* __restrict__ OP, int G, int bx) {
    int tid = threadIdx.x; asm volatile("" : "+v"(tid)); const int wid = __builtin_amdgcn_readfirstlane(tid >> 6), lane = tid & 63;
    const int st = tid >> 4, sc8 = (tid & 15) * 8, sv = tid >> 3, vc4 = (tid & 7) * 4;
    constexpr int OFF_K = 16384, OFF_Q = 32768, OFF_V = 49152, OFF_P = 53248;
    for (int item = bx; item < 256; item += G) {
        const int dir = item & 1, dvq = (item >> 1) & 3, h = (item >> 3) & 7, b = item >> 6;
        const size_t kcol = h * 128 + sc8, vcol = h * 128 + dvq * 32 + vc4;
        const unsigned short* KFd = KF + (size_t)dir * MT * 1024; bf16_t* OPd = OP + (size_t)dir * MT * 1024;
        u32x4 rk, rq; u32x2 rv = {0u, 0u};
#define SC_GLOAD(blk) do { { const int tt = (blk) * 32 + st; const size_t m = (size_t)b * SEQ + (dir ? SEQ - 1 - tt : tt); \
        rk = *(const u32x4*)(KFd + m * 1024 + kcol); rq = *(const u32x4*)(Qh + m * 1024 + kcol); } \
        if (tid < 256) { const int tt = (blk) * 32 + sv; const size_t m = (size_t)b * SEQ + (dir ? SEQ - 1 - tt : tt); rv = *(const u32x2*)(Vh + m * 1024 + vcol); } } while (0)
#define SC_H2F(u_) h2f2_(u_)
#define SC_LWRITE() do { LAS unsigned char* B_ = lds + (st * 128 + sc8) * 4; \
        const f32x2 ka = SC_H2F(rk.x), kb = SC_H2F(rk.y), kc = SC_H2F(rk.z), kd = SC_H2F(rk.w); \
        const f32x4 k0_ = {ka[0], ka[1], kb[0], kb[1]}, k1_ = {kc[0], kc[1], kd[0], kd[1]}; \
        *(LAS f32x4*)(B_ + OFF_K) = k0_; *(LAS f32x4*)(B_ + OFF_K + 16) = k1_; \
        *(LAS f32x4*)(B_ + OFF_Q) = (f32x4){__uint_as_float(rq.x << 16), __uint_as_float(rq.x & 0xffff0000u), __uint_as_float(rq.y << 16), __uint_as_float(rq.y & 0xffff0000u)}; \
        *(LAS f32x4*)(B_ + OFF_Q + 16) = (f32x4){__uint_as_float(rq.z << 16), __uint_as_float(rq.z & 0xffff0000u), __uint_as_float(rq.w << 16), __uint_as_float(rq.w & 0xffff0000u)}; \
        if (tid < 256) *(LAS f32x4*)(lds + OFF_V + (sv * 32 + vc4) * 4) = (f32x4){__uint_as_float(rv.x << 16), __uint_as_float(rv.x & 0xffff0000u), __uint_as_float(rv.y << 16), __uint_as_float(rv.y & 0xffff0000u)}; } while (0)
        SC_GLOAD(0);
        const int dksub = ((lane >> 3) & 1) | ((lane >> 5) << 1), dvp = (lane & 7) | (((lane >> 4) & 1) << 3);
        const LAS unsigned char* Bc = lds + (16 * wid + 4 * dksub) * 4;
        const LAS unsigned char* Vc = lds + OFF_V + dvp * 8;
        LAS unsigned char* Pw = lds + OFF_P + (wid * 4 + dksub) * 2048 + dvp * 4;
        f32x2 S2[4];
#pragma unroll
        for (int j = 0; j < 4; ++j) S2[j] = (f32x2){0.f, 0.f};
        for (int blk = 0; blk < SEQ / 32; ++blk) {
            SC_LWRITE();
            if (blk + 1 < SEQ / 32) SC_GLOAD(blk + 1);
            __syncthreads();
            f32x4 k4n = *(const LAS f32x4*)(Bc + OFF_K), q4n = *(const LAS f32x4*)(Bc + OFF_Q); f32x2 v2n = *(const LAS f32x2*)(Vc);
            f32x4 k4m = *(const LAS f32x4*)(Bc + OFF_K + 512), q4m = *(const LAS f32x4*)(Bc + OFF_Q + 512); f32x2 v2m = *(const LAS f32x2*)(Vc + 128);
#pragma unroll
            for (int t = 0; t < 32; ++t) {
                const f32x4 k4 = k4n, q4 = q4n; const f32x2 v2 = v2n;
                k4n = k4m; q4n = q4m; v2n = v2m;
                { const int tn = (t + 2) & 31;
                  k4m = *(const LAS f32x4*)(Bc + OFF_K + tn * 512); q4m = *(const LAS f32x4*)(Bc + OFF_Q + tn * 512); v2m = *(const LAS f32x2*)(Vc + tn * 128); }
                __builtin_amdgcn_sched_barrier(0);
#pragma unroll
                for (int j = 0; j < 4; ++j) S2[j] = S2[j] + (v2 - S2[j]) * k4[j];
                const f32x2 o2 = (S2[0] * q4[0] + S2[1] * q4[1]) + (S2[2] * q4[2] + S2[3] * q4[3]);
                *(LAS unsigned*)(Pw + t * 64) = pk2(o2[0], o2[1]);
            }
            __syncthreads();
            if (tid < 256) { const LAS unsigned char* Pr = lds + OFF_P + (sv * 32 + vc4) * 2; f32x4 acc = {0.f, 0.f, 0.f, 0.f};
#pragma unroll
              for (int g = 0; g < 32; ++g) { const u32x2 pv = *(const LAS u32x2*)(Pr + g * 2048);
                  acc[0] += __uint_as_float(pv.x << 16); acc[1] += __uint_as_float(pv.x & 0xffff0000u); acc[2] += __uint_as_float(pv.y << 16); acc[3] += __uint_as_float(pv.y & 0xffff0000u); }
              const int tt = blk * 32 + sv; const size_t m = (size_t)b * SEQ + (dir ? SEQ - 1 - tt : tt);
              u32x2 w; w.x = pk2(acc[0], acc[1]); w.y = pk2(acc[2], acc[3]); *(u32x2*)(OPd + m * 1024 + vcol) = w; }
        }
        __syncthreads();
#undef SC_GLOAD
#undef SC_LWRITE
#undef SC_H2F
    }
}

typedef float f32x16 __attribute__((ext_vector_type(16)));
typedef short s16x8 __attribute__((ext_vector_type(8)));
__device__ __forceinline__ int crow_(int r, int hi) { return (r & 3) + 8 * (r >> 2) + 4 * hi; }
template <int KSTEPS, int I0 = 0>
__device__ __forceinline__ void mm_tile(f32x16& c, const LAS unsigned char* X, int xstride, const LAS unsigned char* Y, int ystride, int r32, int hi) {
#pragma unroll
    for (int i = I0; i < I0 + KSTEPS; ++i) { const s16x8 x = *(const LAS s16x8*)(X + r32 * xstride + (16 * i + 8 * hi) * 2), y = *(const LAS s16x8*)(Y + r32 * ystride + (16 * i + 8 * hi) * 2);
        c = __builtin_amdgcn_mfma_f32_32x32x16_bf16(x, y, c, 0, 0, 0); }
}
__device__ __forceinline__ void scan_phase_mfma(LAS unsigned char* lds, const bf16_t* __restrict__ Qh, const bf16_t* __restrict__ Vh, const unsigned short* __restrict__ KF, bf16_t* __restrict__ OP, int G, int bx) {
    int tid = threadIdx.x; asm volatile("" : "+v"(tid)); const int wid = __builtin_amdgcn_readfirstlane(tid >> 6), lane = tid & 63, r32 = lane & 31, hi = lane >> 5;
    const bool grpA = wid < 4;
    const int st = (tid >> 3) & 31, sc16 = (tid & 7) * 16, vc4 = (tid & 7) * 4;
    constexpr int SQ = 272, SV = 80, NC = SEQ / 32;
    constexpr int IMG = 2 * 32 * SQ + 128 * SV + 128 + 32 * SV + 512;
    constexpr int O_LG = 0, O_IMG = 16384, O_AT = O_IMG + 2 * IMG, O_ST = O_AT + 32 * SV;
    constexpr int I_QT = 0, I_KT = 32 * SQ, I_KTT = 2 * 32 * SQ, I_VT = I_KTT + 128 * SV + 128, I_G = I_VT + 32 * SV;
    static_assert(O_ST + 32 * SQ <= LDS_RING && IMG % 16 == 0, "scan LDS map");
    for (int item = bx; item < 256; item += G) {
        const int dir = item & 1, dvq = (item >> 1) & 3, h = (item >> 3) & 7, b = item >> 6;
        const size_t kcol = h * 128 + sc16, vcol = h * 128 + dvq * 32 + vc4;
        const unsigned short* KFd = KF + (size_t)dir * MT * 1024; bf16_t* OPd = OP + (size_t)dir * MT * 1024;
        u32x4 rk0, rk1, rq0, rq1; u32x2 rv;
#define SM_GLOAD(blk) do { const int tt = (blk) * 32 + st; const size_t m = (size_t)b * SEQ + (dir ? SEQ - 1 - tt : tt); \
        rk0 = *(const u32x4*)(KFd + m * 1024 + kcol); rk1 = *(const u32x4*)(KFd + m * 1024 + kcol + 8); rq0 = *(const u32x4*)(Qh + m * 1024 + kcol); rq1 = *(const u32x4*)(Qh + m * 1024 + kcol + 8); \
        rv = *(const u32x2*)(Vh + m * 1024 + vcol); } while (0)
        if (grpA) SM_GLOAD(0);
        f32x16 accS, accO;
#pragma unroll
        for (int r = 0; r < 16; ++r) { accS[r] = 0.f; accO[r] = 0.f; }
        for (int i = tid; i < 32 * SQ / 4; i += 512) ((LAS unsigned*)(lds + O_ST))[i] = 0u;
        __syncthreads();
        for (int rd = -1; rd < NC; ++rd) {
            const int cn = rd + 1;
            LAS unsigned char* Wi = lds + O_IMG + (cn & 1) * IMG;
            const LAS unsigned char* Ri = lds + O_IMG + (rd & 1) * IMG;
            float kf[16];
            if (grpA) { if (cn < NC) {
                { const f32x2 a = h2f2_(rk0.x), bq = h2f2_(rk0.y), c = h2f2_(rk0.z), d = h2f2_(rk0.w), e = h2f2_(rk1.x), f = h2f2_(rk1.y), g2 = h2f2_(rk1.z), h2 = h2f2_(rk1.w);
                  kf[0] = a[0]; kf[1] = a[1]; kf[2] = bq[0]; kf[3] = bq[1]; kf[4] = c[0]; kf[5] = c[1]; kf[6] = d[0]; kf[7] = d[1];
                  kf[8] = e[0]; kf[9] = e[1]; kf[10] = f[0]; kf[11] = f[1]; kf[12] = g2[0]; kf[13] = g2[1]; kf[14] = h2[0]; kf[15] = h2[1]; }
                LAS unsigned char* L_ = lds + O_LG + (st * 128 + sc16) * 4;
#pragma unroll
                for (int q4 = 0; q4 < 4; ++q4) { f32x4 a4;
#pragma unroll
                    for (int e = 0; e < 4; ++e) a4[e] = 1.0f - kf[4 * q4 + e];
                    *(LAS f32x4*)(L_ + 16 * q4) = a4; }
                LAS unsigned char* V_ = Wi + I_VT + st * 2;
                *(LAS unsigned short*)(V_ + (vc4 + 0) * SV) = (unsigned short)(rv.x & 0xffffu); *(LAS unsigned short*)(V_ + (vc4 + 1) * SV) = (unsigned short)(rv.x >> 16);
                *(LAS unsigned short*)(V_ + (vc4 + 2) * SV) = (unsigned short)(rv.y & 0xffffu); *(LAS unsigned short*)(V_ + (vc4 + 3) * SV) = (unsigned short)(rv.y >> 16);
            } } else if (rd >= 0) {
                const int w4 = wid - 4;
                mm_tile<2>(accS, Ri + I_KTT + w4 * 32 * SV + (2 * w4 + (r32 >> 4)) * 16, SV, Ri + I_VT, SV, r32, hi);
                if (w4 == 0) { f32x16 pa, pb;
#pragma unroll
                    for (int r = 0; r < 16; ++r) { pa[r] = 0.f; pb[r] = 0.f; }
                    mm_tile<4, 0>(pa, Ri + I_KT, SQ, Ri + I_QT, SQ, r32, hi); mm_tile<4, 4>(pb, Ri + I_KT, SQ, Ri + I_QT, SQ, r32, hi);
#pragma unroll
                    for (int g = 0; g < 4; ++g) { const int s0 = 8 * g + 4 * hi; float v4[4];
#pragma unroll
                        for (int e = 0; e < 4; ++e) v4[e] = (s0 + e) <= r32 ? pa[4 * g + e] + pb[4 * g + e] : 0.f;
                        u32x2 w; w.x = pk2(v4[0], v4[1]); w.y = pk2(v4[2], v4[3]); *(LAS u32x2*)(lds + O_AT + r32 * SV + s0 * 2) = w; } }
                else if (w4 == 1) { f32x16 ob;
#pragma unroll
                    for (int r = 0; r < 16; ++r) { accO[r] = 0.f; ob[r] = 0.f; }
                    mm_tile<4, 0>(accO, lds + O_ST, SQ, Ri + I_QT, SQ, r32, hi); mm_tile<4, 4>(ob, lds + O_ST, SQ, Ri + I_QT, SQ, r32, hi);
#pragma unroll
                    for (int r = 0; r < 16; ++r) accO[r] += ob[r]; }
            }
            __syncthreads();
            if (grpA) { if (cn < NC) {
                if (tid < 128) { LAS float* col = (LAS float*)(lds + O_LG) + tid; float fv[32];
#pragma unroll
                    for (int t = 0; t < 32; ++t) fv[t] = col[t * 128];
                    float acc = 1.f;
#pragma unroll
                    for (int t = 0; t < 32; ++t) { acc *= fv[t]; col[t * 128] = acc; } }
            } } else if (rd >= 0) {
                const int w4 = wid - 4;
                if (w4 == 1) { mm_tile<2>(accO, Ri + I_VT, SV, lds + O_AT, SV, r32, hi);
                    asm volatile("s_nop 15\n\ts_nop 7" : "+v"(accO));
                    const int tt = rd * 32 + r32; const size_t m = (size_t)b * SEQ + (dir ? SEQ - 1 - tt : tt); bf16_t* orow = OPd + m * 1024 + h * 128 + dvq * 32;
#pragma unroll
                    for (int g = 0; g < 4; ++g) { u32x2 w; w.x = pk2(accO[4 * g + 0], accO[4 * g + 1]); w.y = pk2(accO[4 * g + 2], accO[4 * g + 3]); *(u32x2*)(orow + 8 * g + 4 * hi) = w; } }
            }
            __syncthreads();
            if (grpA) { if (cn < NC)
#ifdef REP_A3
            for (int rep_ = 0; rep_ < 2; ++rep_)
#endif
            {
                const LAS unsigned char* L_ = lds + O_LG + (st * 128 + sc16) * 4; float bb[16];
#pragma unroll
                for (int q4 = 0; q4 < 4; ++q4) { const f32x4 t4 = *(const LAS f32x4*)(L_ + 16 * q4); bb[4 * q4] = t4[0]; bb[4 * q4 + 1] = t4[1]; bb[4 * q4 + 2] = t4[2]; bb[4 * q4 + 3] = t4[3]; }
                const unsigned qraw[8] = {rq0.x, rq0.y, rq0.z, rq0.w, rq1.x, rq1.y, rq1.z, rq1.w};
                unsigned qw[8], kw[8];
#pragma unroll
                for (int e = 0; e < 8; ++e) { const float e0 = bb[2 * e], e1 = bb[2 * e + 1];
                    qw[e] = pk2(__uint_as_float(qraw[e] << 16) * e0, __uint_as_float(qraw[e] & 0xffff0000u) * e1);
                    kw[e] = pk2(kf[2 * e] * __builtin_amdgcn_rcpf(e0), kf[2 * e + 1] * __builtin_amdgcn_rcpf(e1));
                    if (st == 31) { ((LAS float*)(Wi + I_G))[sc16 + 2 * e] = e0; ((LAS float*)(Wi + I_G))[sc16 + 2 * e + 1] = e1; } }
                *(LAS u32x4*)(Wi + I_QT + st * SQ + sc16 * 2) = (u32x4){qw[0], qw[1], qw[2], qw[3]}; *(LAS u32x4*)(Wi + I_QT + st * SQ + sc16 * 2 + 16) = (u32x4){qw[4], qw[5], qw[6], qw[7]};
                *(LAS u32x4*)(Wi + I_KT + st * SQ + sc16 * 2) = (u32x4){kw[0], kw[1], kw[2], kw[3]}; *(LAS u32x4*)(Wi + I_KT + st * SQ + sc16 * 2 + 16) = (u32x4){kw[4], kw[5], kw[6], kw[7]};
                LAS unsigned char* T_ = Wi + I_KTT + sc16 * SV + (sc16 >> 4) * 16 + st * 2;
#pragma unroll
                for (int e = 0; e < 8; ++e) { *(LAS unsigned short*)(T_ + (2 * e) * SV) = (unsigned short)(kw[e] & 0xffffu); *(LAS unsigned short*)(T_ + (2 * e + 1) * SV) = (unsigned short)(kw[e] >> 16); }
            }
                if (cn + 1 < NC) SM_GLOAD(cn + 1);
            } else if (rd >= 0) {
                const int w4 = wid - 4;
#pragma unroll
                for (int g = 0; g < 4; ++g) { const int dk0 = 32 * w4 + 8 * g + 4 * hi; const f32x4 gm = *(const LAS f32x4*)(Ri + I_G + dk0 * 4);
                    accS[4 * g + 0] *= gm[0]; accS[4 * g + 1] *= gm[1]; accS[4 * g + 2] *= gm[2]; accS[4 * g + 3] *= gm[3];
                    u32x2 w; w.x = pk2(accS[4 * g + 0], accS[4 * g + 1]); w.y = pk2(accS[4 * g + 2], accS[4 * g + 3]);
                    *(LAS u32x2*)(lds + O_ST + r32 * SQ + dk0 * 2) = w; }
            }
            __syncthreads();
        }
#undef SM_GLOAD
    }
}

enum Op { OP_SW0, OP_FO0, OP_RPA, OP_MIN, OP_RMLA, OP_QKV, OP_ATTN, OP_MWO, OP_RPB, OP_SW1, OP_FO1, OP_RPC, OP_HIN, OP_SCAN, OP_RHG, OP_HWO };
__device__ const unsigned char OPS_M[12] = {OP_SW0, OP_FO0, OP_RPA, OP_MIN, OP_RMLA, OP_QKV, OP_ATTN, OP_MWO, OP_RPB, OP_SW1, OP_FO1, OP_RPC};
__device__ const unsigned char OPS_H[11] = {OP_SW0, OP_FO0, OP_RPA, OP_HIN, OP_SCAN, OP_RHG, OP_HWO, OP_RPB, OP_SW1, OP_FO1, OP_RPC};

struct Args { const float* in[15]; float* out; unsigned char* ws; };
typedef const __attribute__((address_space(4))) Args* ArgsP;
__device__ __forceinline__ ArgsP get_args() { ArgsP p = (ArgsP)__builtin_amdgcn_kernarg_segment_ptr(); asm volatile("" : "+s"(p) :: "memory"); return p; }
#define GW_ ((int)blockIdx.x * 8 + __builtin_amdgcn_readfirstlane((int)threadIdx.x >> 6))
#define NGW_ ((int)gridDim.x * 8)
__device__ __forceinline__ int otid_() { int t = threadIdx.x; asm volatile("" : "+v"(t)); return t; }
#define LANE_ (otid_() & 63)

#ifdef DBG_CHECKS
__device__ __forceinline__ float bf2f(bf16_t v) { return __uint_as_float((unsigned)v << 16); }
__device__ __forceinline__ unsigned hash_u(unsigned x) { x ^= x >> 16; x *= 0x7feb352du; x ^= x >> 15; x *= 0x846ca68bu; x ^= x >> 16; return x; }
__device__ __forceinline__ void dbg_report(unsigned* DBG, int id, float got, float ref, float rtol, float atol) {
    const float err = fabsf(got - ref); const bool bad = !(err <= rtol * fabsf(ref) + atol);
    if (bad) atomicMax(DBG + id, 1u);
}
__device__ __forceinline__ int dbg_row(int sidx) { if (sidx == 0) return 0; if (sidx == 1) return MT - 1; if (sidx == 2) return SEQ - 1; if (sidx == 3) return SEQ; return (int)(hash_u(sidx * 2654435761u + 17u) % MT); }
#endif
#ifdef DBG_CHECKS
struct DbgCtx { const float* const* in; unsigned char* ws; unsigned char* R; unsigned* DBG; int bx, tid, lane, wave; };
__device__ __forceinline__ float dbg_dot_bf_w(const bf16_t* a, const float* W, int K, int ldw, int col) { float s = 0.f; for (int k = 0; k < K; ++k) s += bf2f(a[k]) * W[(size_t)k * ldw + col]; return s; }
template <class A>
__device__ __forceinline__ void dbg_after(int l, int op, A ap, unsigned char* ws, unsigned char* R, LAS unsigned char* lds) {
    unsigned* DBG = (unsigned*)(ws + 32768);
    const int bx = blockIdx.x, tid = otid_(), lane = tid & 63, wave = __builtin_amdgcn_readfirstlane(tid >> 6);
    const bf16_t* HN = (const bf16_t*)(ws + WS_HN); const float* Y = (const float*)(ws + WS_Y);
    if (false && l == 0 && op == OP_SW0 && bx < 32) { const int sid = bx * 512 + tid, m = dbg_row(sid), c = hash_u(sid * 3 + 1) % DFF; const float* W = ap->in[3];
        const float g = dbg_dot_bf_w(HN + (size_t)m * 1024, W, 1024, 2 * DFF, c), u = dbg_dot_bf_w(HN + (size_t)m * 1024, W, 1024, 2 * DFF, DFF + c);
        dbg_report(DBG, 1, bf2f(((const bf16_t*)(R + R_ACT))[(size_t)m * DFF + c]), g / (1.f + expf(-g)) * u, 0.015f, 0.004f); }
    if (false && l == 0 && op == OP_FO0 && bx < 32) { const int sid = bx * 512 + tid, m = dbg_row(sid), c = hash_u(sid * 3 + 2) % 1024;
        const float r = dbg_dot_bf_w((const bf16_t*)(R + R_ACT) + (size_t)m * DFF, ap->in[4], DFF, 1024, c);
        dbg_report(DBG, 2, Y[(size_t)m * 1024 + c], r, 0.015f, 0.004f); }
    if (false && l == 0 && op == OP_RPA && bx < 32) { const int sid = bx * 512 + tid, m = dbg_row(sid), c = hash_u(sid * 3 + 3) % 1024; const float* g = ap->in[2];
        float s = 0.f; for (int k = 0; k < 1024; ++k) { const float y = Y[(size_t)m * 1024 + k]; s += y * y; }
        const float xr = ap->in[0][(size_t)m * 1024 + c] + 0.5f * Y[(size_t)m * 1024 + c] * rsqrtf(s / 1024.f + EPS) * g[1024 + c];
        dbg_report(DBG, 2, ap->out[(size_t)m * 1024 + c], xr, 1e-3f, 1e-3f);
        float s2 = 0.f; for (int k = 0; k < 1024; ++k) { const float x = ap->out[(size_t)m * 1024 + k]; s2 += x * x; }
        dbg_report(DBG, 2, bf2f(HN[(size_t)m * 1024 + c]), ap->out[(size_t)m * 1024 + c] * rsqrtf(s2 / 1024.f + EPS) * g[2048 + c], 0.01f, 0.01f); }
    if (false && l == 0 && op == OP_MIN && bx < 32) { const int sid = bx * 512 + tid, m = dbg_row(sid), c = hash_u(sid * 3 + 4) % 512; const int sc = src_col(2, c);
        const float r = sc >= 0 ? dbg_dot_bf_w(HN + (size_t)m * 1024, ap->in[5], 1024, 448, sc) : 0.f;
        dbg_report(DBG, 3, ((const float*)(R + R_C))[(size_t)m * 512 + c], r, 0.015f, 0.01f); }
    if (false && l == 0 && op == OP_RMLA && bx < 32) { const int sid = bx * 512 + tid, m = dbg_row(sid), c = hash_u(sid * 3 + 5) % 448; const float* C = (const float*)(R + R_C) + (size_t)m * 512;
        if (c < 256) { float s = 0.f; for (int k = 0; k < 256; ++k) s += C[k] * C[k];
            dbg_report(DBG, 3, bf2f(((const bf16_t*)(R + R_CQ))[(size_t)m * 256 + c]), C[c] * rsqrtf(s / 256.f + EPS) * ap->in[6][c], 0.01f, 0.01f); }
        else if (c < 384) { float s = 0.f; for (int k = 256; k < 384; ++k) s += C[k] * C[k];
            dbg_report(DBG, 3, bf2f(((const bf16_t*)(R + R_CKV))[(size_t)m * 128 + c - 256]), C[c] * rsqrtf(s / 128.f + EPS) * ap->in[7][c - 256], 0.01f, 0.01f); }
        else { const int jj = c - 384, i = jj >> 1; const float ang = (float)((const int*)ap->in[1])[m] * powf(10000.f, -(float)i / 32.f); const float cs = cosf(ang), sn = sinf(ang);
            const float t1 = C[384 + 2 * i], t2 = C[384 + 2 * i + 1]; const float r = (jj & 1) ? t1 * sn + t2 * cs : t1 * cs - t2 * sn;
            dbg_report(DBG, 3, bf2f(((const bf16_t*)(R + R_KR))[(size_t)m * 64 + jj]), r, 0.02f, 0.05f); } }
    if (false && l == 0 && op == OP_QKV && bx < 32) { const int sid = bx * 512 + tid, m = dbg_row(sid); const bf16_t* CQ = (const bf16_t*)(R + R_CQ) + (size_t)m * 256; const bf16_t* CKV = (const bf16_t*)(R + R_CKV) + (size_t)m * 128;
        { const int c = hash_u(sid * 3 + 6) % 1536, h = c / QKD, d = c % QKD; float r;
          if (d < 128) r = dbg_dot_bf_w(CQ, ap->in[8], 256, 1536, c);
          else { const int jj = d - 128, i = jj >> 1; const float t1 = dbg_dot_bf_w(CQ, ap->in[8], 256, 1536, h * QKD + 128 + i), t2 = dbg_dot_bf_w(CQ, ap->in[8], 256, 1536, h * QKD + 160 + i);
              const float ang = (float)((const int*)ap->in[1])[m] * powf(10000.f, -(float)i / 32.f); const float cs = cosf(ang), sn = sinf(ang); r = (jj & 1) ? t1 * sn + t2 * cs : t1 * cs - t2 * sn; }
          dbg_report(DBG, 4, bf2f(((const bf16_t*)(R + R_QB))[(size_t)m * 1536 + c]), r, 0.015f, 0.015f); }
        { const int c = hash_u(sid * 3 + 7) % 2048, h = c >> 8, d = c & 255; const float r = dbg_dot_bf_w(CKV, ap->in[9], 128, 2048, c);
          const float got = d < 128 ? bf2f(((const bf16_t*)(R + R_KN))[(size_t)m * 1024 + h * 128 + d]) : bf2f(((const bf16_t*)(R + R_VB))[(size_t)m * 1024 + h * 128 + d - 128]);
          dbg_report(DBG, 5, got, r, 0.015f, 0.015f); } }
    if (l == 0 && op == OP_ATTN) { const int sid = bx * 8 + wave, m = dbg_row(sid), h = hash_u(sid * 5 + 1) & 7, dv = hash_u(sid * 5 + 2) & 127, b = m / SEQ;
        LAS float* qs = (LAS float*)lds + wave * 192; const bf16_t* Q = (const bf16_t*)(R + R_QB) + (size_t)m * 1536 + h * QKD;
        for (int d = lane; d < 192; d += 64) qs[d] = bf2f(Q[d]);
        asm volatile("s_waitcnt lgkmcnt(0)" ::: "memory");
        float mx = -1e30f, ls = 0.f, acc = 0.f;
        for (int kk = lane; kk < SEQ; kk += 64) { const size_t km = (size_t)b * SEQ + kk; const bf16_t* Kn = (const bf16_t*)(R + R_KN) + km * 1024 + h * 128; const bf16_t* Kr = (const bf16_t*)(R + R_KR) + km * 64;
            float s = 0.f; for (int d = 0; d < 128; ++d) s += qs[d] * bf2f(Kn[d]); for (int d = 0; d < 64; ++d) s += qs[128 + d] * bf2f(Kr[d]);
            s *= 0.07216878364870322f; const float v = bf2f(((const bf16_t*)(R + R_VB))[km * 1024 + h * 128 + dv]);
            const float mn = fmaxf(mx, s), al = expf(mx - mn), p = expf(s - mn); ls = ls * al + p; acc = acc * al + p * v; mx = mn; }
        float gm = mx;
        for (int o = 1; o < 64; o <<= 1) gm = fmaxf(gm, __shfl_xor(gm, o));
        const float sc = expf(mx - gm); const float L = wave_sum(ls * sc), Asum = wave_sum(acc * sc);
        if (lane == 0) { const float got = bf2f(((const bf16_t*)(R + R_O))[(size_t)m * 1024 + h * 128 + dv]), ref = Asum / L; atomicMax(DBG + 20, __float_as_uint(fabsf(got - ref))); atomicAdd((float*)(DBG + 21), fabsf(ref) * (1.f / 2048.f)); } }
    if (false && l == 1 && op == OP_HIN && bx < 32) { const int sid = bx * 512 + tid, m = dbg_row(sid), c5 = hash_u(sid * 3 + 8) % 5120, seg = c5 >> 10, c = c5 & 1023;
        const float u = dbg_dot_bf_w(HN + (size_t)m * 1024, ap->in[11], 1024, 5120, c5); float got, r;
        if (seg == 0) { got = bf2f(((const bf16_t*)(R + R_QH))[(size_t)m * 1024 + c]); r = u / (1.f + expf(-u)); }
        else if (seg == 3) { got = bf2f(((const bf16_t*)(R + R_VH))[(size_t)m * 1024 + c]); r = u; }
        else if (seg == 4) { got = bf2f(((const bf16_t*)(R + R_GH))[(size_t)m * 1024 + c]); r = u / (1.f + expf(-u)); }
        else { const int dir = seg - 1; const float* lbp = ap->in[12] + (size_t)dir * DEPTH * 1024 + c; const float e0 = expf(lbp[0]), e1 = expf(lbp[1024]), e2 = expf(lbp[2048]), e3 = expf(lbp[3072]);
            const float lb = e1 / (e0 + e1 + e2 + e3); const h16x2 hv = __builtin_bit_cast(h16x2, (unsigned)((const unsigned short*)(R + R_KF))[(size_t)dir * MT * 1024 + (size_t)m * 1024 + c]);
            got = (float)hv[0]; r = (1.f - lb) / (1.f + expf(u)); }
        dbg_report(DBG, 7, got, r, 0.015f, 0.006f); }
    if (false && l == 1 && op == OP_SCAN) { const int sid = bx * 8 + wave, h = hash_u(sid * 5 + 3) & 7, dv = hash_u(sid * 5 + 4) & 127, b = hash_u(sid * 5 + 5) & 3, toff = sid & 31, dir = 0;
        const bf16_t* Qh = (const bf16_t*)(R + R_QH); const bf16_t* Vh = (const bf16_t*)(R + R_VH); const unsigned short* KF = (const unsigned short*)(R + R_KF); const bf16_t* OPb = (const bf16_t*)(ws + WS_Y);
        float S0 = 0.f, S1 = 0.f; const int n = toff + 1; const int t = toff; const size_t m = (size_t)b * SEQ + t;
        for (int i = 0; i < n; ++i) { const int tt = i; const size_t mm = (size_t)b * SEQ + tt; const unsigned short* kp = KF + (size_t)dir * MT * 1024 + mm * 1024 + h * 128;
            const h16x2 ka = __builtin_bit_cast(h16x2, (unsigned)kp[lane]), kb = __builtin_bit_cast(h16x2, (unsigned)kp[lane + 64]); const float k0 = (float)ka[0], k1 = (float)kb[0];
            const float v = bf2f(Vh[mm * 1024 + h * 128 + dv]); S0 = S0 * (1.f - k0) + k0 * v; S1 = S1 * (1.f - k1) + k1 * v; }
        const bf16_t* q = Qh + m * 1024 + h * 128; const float tot = wave_sum(S0 * bf2f(q[lane]) + S1 * bf2f(q[lane + 64]));
        if (lane == 0) { const float got = bf2f(OPb[(size_t)dir * MT * 1024 + m * 1024 + h * 128 + dv]); const float re = fabsf(got - tot) / (fabsf(tot) + 0.05f);
            if (re > 0.05f) { atomicMin(DBG + 20, (unsigned)toff); atomicAdd(DBG + 21, 1u); } } }
    if (false && l == 1 && op == OP_RHG && bx < 32) { const int sid = bx * 512 + tid, m = dbg_row(sid), c = hash_u(sid * 3 + 9) % 1024, h0 = c & ~127; const bf16_t* OPb = (const bf16_t*)(ws + WS_Y);
        float s = 0.f; for (int k = 0; k < 128; ++k) { const float y = bf2f(OPb[(size_t)m * 1024 + h0 + k]) + bf2f(OPb[(size_t)MT * 1024 + (size_t)m * 1024 + h0 + k]); s += y * y; }
        const float yc = bf2f(OPb[(size_t)m * 1024 + c]) + bf2f(OPb[(size_t)MT * 1024 + (size_t)m * 1024 + c]);
        const float r = yc * rsqrtf(s / 128.f + EPS) * ap->in[13][c] * bf2f(((const bf16_t*)(R + R_GH))[(size_t)m * 1024 + c]);
        dbg_report(DBG, 9, bf2f(((const bf16_t*)(R + R_HO))[(size_t)m * 1024 + c]), r, 0.02f, 0.005f); }
    if (false && l == 1 && op == OP_HWO && bx < 32) { const int sid = bx * 512 + tid, m = dbg_row(sid), c = hash_u(sid * 3 + 10) % 1024;
        const float r = dbg_dot_bf_w((const bf16_t*)(R + R_HO) + (size_t)m * 1024, ap->in[14], 1024, 1024, c);
        dbg_report(DBG, 9, Y[(size_t)m * 1024 + c], r, 0.03f, 0.01f); }
    if (false && l == 0 && op == OP_MWO && bx < 32) { const int sid = bx * 512 + tid, m = dbg_row(sid), c = hash_u(sid * 3 + 11) % 1024;
        const float r = dbg_dot_bf_w((const bf16_t*)(R + R_O) + (size_t)m * 1024, ap->in[10], 1024, 1024, c);
        dbg_report(DBG, 6, Y[(size_t)m * 1024 + c], r, 0.02f, 0.0004f); }
}
#endif

__device__ __forceinline__ void gsync_cg() {
    asm volatile("s_waitcnt vmcnt(0) lgkmcnt(0)" ::: "memory");
    __syncthreads();
    cg::this_grid().sync();
    if (threadIdx.x == 0) { __builtin_amdgcn_fence(__ATOMIC_ACQUIRE, "agent"); asm volatile("s_waitcnt vmcnt(0)" ::: "memory"); }
    __syncthreads();
}
#define GAS __attribute__((address_space(1)))
#define XB_TMO      128
#define XB_XCNT(j)  (256  + 64 * (j))
#define XB_XSUB(j)  (1280 + 64 * (j))
#define XB_XGEN(j)  (2304 + 64 * (j))
#define XB_TOP      3328
#define XB_TOPGEN   3392
#define XCD_BAR_WORDS 3456
#define XB_SPIN_CAP (1u << 18)

__device__ __forceinline__ unsigned xb_ld(unsigned* p)              { return __hip_atomic_load(p, __ATOMIC_RELAXED, __HIP_MEMORY_SCOPE_AGENT); }
__device__ __forceinline__ unsigned xb_add(unsigned* p, unsigned v) { return __hip_atomic_fetch_add(p, v, __ATOMIC_RELAXED, __HIP_MEMORY_SCOPE_AGENT); }
__device__ __forceinline__ unsigned xb_xcc_id() { return (unsigned)__builtin_amdgcn_s_getreg((3 << 11) | 20) & 0xFu; }
#define XB_SPIN(cond, bar) do { unsigned _sp = 0; while (cond) { __builtin_amdgcn_s_sleep(1); \
    if ((++_sp & 255u) == 0u) { if (xb_ld(&(bar)[XB_TMO])) break; if (_sp > XB_SPIN_CAP) { atomicAdd(&(bar)[XB_TMO], 1u); break; } } } } while (0)

struct XcdBarrier {
    unsigned* bar; unsigned x;
    volatile LAS unsigned* st;
};

__device__ __forceinline__ XcdBarrier xcd_barrier_post(unsigned* bar, volatile LAS unsigned* st) {
    XcdBarrier b; b.bar = bar; b.x = xb_xcc_id(); b.st = st;
    if (threadIdx.x == 0) (void)xb_add(&bar[XB_XCNT(b.x)], 1u);
    return b;
}
__device__ __forceinline__ void xcd_barrier_complete(unsigned* bar, unsigned x, unsigned& nloc, unsigned& nx) {
    const unsigned G = gridDim.x * gridDim.y * gridDim.z;
    unsigned sum, cnt, mine, sp = 0u;
    for (;;) {
        sum = 0u; cnt = 0u; mine = 0u;
#pragma unroll
        for (unsigned j = 0; j < 16; ++j) { const unsigned c = xb_ld(&bar[XB_XCNT(j)]); sum += c; cnt += (c > 0u) ? 1u : 0u; mine = (j == x) ? c : mine; }
        if (sum == G) break;
        __builtin_amdgcn_s_sleep(1);
        if ((++sp & 255u) == 0u) { if (xb_ld(&bar[XB_TMO])) break; if (sp > XB_SPIN_CAP) { atomicAdd(&bar[XB_TMO], 1u); break; } }
    }
    nloc = mine > 0u ? mine : 1u; nx = cnt > 0u ? cnt : 1u;
}

__device__ __forceinline__ void xcd_barrier(const XcdBarrier& b) {
    asm volatile("s_waitcnt vmcnt(0)" ::: "memory");
    __syncthreads();
    if (threadIdx.x == 0) {
        unsigned* bar = b.bar;
        __builtin_amdgcn_s_waitcnt(0);
        unsigned nloc = b.st[0], nx = b.st[1];
        if (nloc == 0u) { xcd_barrier_complete(bar, b.x, nloc, nx); b.st[0] = nloc; b.st[1] = nx; }
        const unsigned old = xb_add(&bar[XB_XSUB(b.x)], 1u);
        const unsigned gen = old / nloc;
        if (old + 1u == (gen + 1u) * nloc) {
            __builtin_amdgcn_fence(__ATOMIC_RELEASE, "agent");
            asm volatile("s_waitcnt vmcnt(0)" ::: "memory");
            const unsigned og = xb_add(&bar[XB_TOP], 1u);
            const unsigned tg = og / nx;
            if (og + 1u == (tg + 1u) * nx) xb_add(&bar[XB_TOPGEN], 1u);
            else XB_SPIN(xb_ld(&bar[XB_TOPGEN]) == tg, bar);
            __builtin_amdgcn_fence(__ATOMIC_ACQUIRE, "agent");
            xb_add(&bar[XB_XGEN(b.x)], 1u);
            asm volatile("s_waitcnt vmcnt(0)" ::: "memory");
        } else {
            XB_SPIN(xb_ld(&bar[XB_XGEN(b.x)]) == gen, bar);
            __builtin_amdgcn_fence(__ATOMIC_ACQUIRE, "agent");
            asm volatile("s_waitcnt vmcnt(0)" ::: "memory");
        }
    }
    __syncthreads();
}

__device__ __forceinline__ void gsync(LAS unsigned char* lds) {
#ifdef USE_CG_SYNC
    gsync_cg();
#else
    XcdBarrier b; b.bar = (unsigned*)get_args()->ws; b.x = xb_xcc_id(); b.st = (volatile LAS unsigned*)(lds + LDS_RING);
    xcd_barrier(b);
#endif
}
__global__ void __launch_bounds__(512, 2) mega_fwd(Args a_unused) {
    extern __shared__ __attribute__((aligned(16))) unsigned char lds_raw[];
    LAS unsigned char* lds = (LAS unsigned char*)lds_raw;

    if (threadIdx.x < 2) ((volatile LAS unsigned*)(lds + LDS_RING))[threadIdx.x] = 0u;
    __syncthreads();
    (void)xcd_barrier_post((unsigned*)get_args()->ws, (volatile LAS unsigned*)(lds + LDS_RING));
#ifdef REP_PRO
    for (int rep_ = 0; rep_ < 2; ++rep_)
#endif
    {
        ArgsP ap = get_args(); unsigned char* ws = ap->ws;
#ifdef DBG_CHECKS
        if (blockIdx.x == 0 && threadIdx.x < 32) atomicExch((unsigned*)ws + threadIdx.x, 0u);
#endif
        const int tid = threadIdx.x, lane = tid & 63, wave = __builtin_amdgcn_readfirstlane(tid >> 6), G = gridDim.x, bx = blockIdx.x, gw = bx * 8 + wave, NGW = G * 8;
        LAS float* scr = (LAS float*)(lds + wave * 16384);
        constexpr int I_FFI = 16 * 176, I_FFO = 44 * 32, I_HIN = 16 * 160, I_SQ = 16 * 32, I_MIN = 16 * 16, I_UQ = 4 * 48, I_UKV = 2 * 64;
        constexpr int NITEMS = 8 * I_FFI + 8 * I_FFO + 2 * I_HIN + 2 * I_SQ + 2 * I_MIN + 2 * I_UQ + 2 * I_UKV + 2 * I_SQ;
        for (int it = gw; it < NITEMS; it += NGW) {
            int r = it;
#define XP(IDX_, K_, NS_, ND_, MODE_, WSOFF_, NMAT_, IPM_) if (r < (NMAT_) * (IPM_)) { const int mat = r / (IPM_); \
            xpose_item(ap->in[IDX_] + (size_t)mat * (K_) * (NS_), K_, NS_, ND_, MODE_, (bf16_t*)(ws + (WSOFF_)) + (size_t)mat * (ND_) * (K_), scr, r % (IPM_), lane); continue; } r -= (NMAT_) * (IPM_);
            XP(3, 1024, 2 * DFF, 2 * DFF, 1, WS_WFFI, 8, I_FFI)
            XP(4, DFF, 1024, 1024, 0, WS_WFFO, 8, I_FFO)
            XP(11, 1024, 5120, 5120, 0, WS_WHIN, 2, I_HIN)
            XP(14, 1024, 1024, 1024, 0, WS_WHO, 2, I_SQ)
            XP(5, 1024, 448, 512, 2, WS_WMIN, 2, I_MIN)
            XP(8, 256, 1536, 1536, 3, WS_WUQ, 2, I_UQ)
            XP(9, 128, 2048, 2048, 0, WS_WUKV, 2, I_UKV)
            XP(10, 1024, 1024, 1024, 0, WS_WMO, 2, I_SQ)
#undef XP
        }
        { const int* positions = (const int*)ap->in[1]; float* COS = (float*)(ws + WS_COS); float* SIN = (float*)(ws + WS_SIN);
          for (int idx = bx * 512 + tid; idx < MT * 32; idx += G * 512) { const int m = idx >> 5, i = idx & 31;
            const double ang = (double)positions[m] * ROPE_INVF[i]; const double rev = ang * 0.15915494309189535; const float fr = (float)(rev - __builtin_rint(rev));
            COS[idx] = __builtin_amdgcn_cosf(fr); SIN[idx] = __builtin_amdgcn_sinf(fr); } }
        { float* LB = (float*)(ws + WS_LB);
          for (int idx = bx * 512 + tid; idx < 2 * 2 * 1024; idx += G * 512) { const int c = idx & 1023, dir = (idx >> 10) & 1, j = idx >> 11, l = 2 * j + 1;
            const float* lbp = ap->in[12] + (size_t)dir * DEPTH * 1024 + c; float v[4], mx = -1e30f;
#pragma unroll
            for (int i = 0; i < 4; ++i) { v[i] = lbp[i * 1024]; mx = fmaxf(mx, v[i]); }
            float den = 0.f, num = 0.f;
#pragma unroll
            for (int i = 0; i < 4; ++i) { const float e = __expf(v[i] - mx); den += e; if (i >= 1 && i <= l) num += e; }
            LB[idx] = num / den; } }
        { const float* x_in = ap->in[0]; float* X = ap->out; bf16_t* HN = (bf16_t*)(ws + WS_HN); const float* gains = ap->in[2];
          for (int m = gw; m < MT; m += NGW) row_init(x_in + (size_t)m * DM, X + (size_t)m * DM, HN + (size_t)m * DM, gains, lane); }
    }
    gsync_cg();

    for (int ph = 0; ph < 46; ++ph) {
        const int l = ph >= 35 ? 3 : (ph >= 23 ? 2 : (ph >= 12 ? 1 : 0)), s = ph - (l == 3 ? 35 : (l == 2 ? 23 : (l == 1 ? 12 : 0)));
        const bool hg = l & 1; const int j = l >> 1;
        const int op = hg ? OPS_H[s] : OPS_M[s];
        ArgsP ap = get_args(); unsigned char* ws = ap->ws; unsigned char* R = ws + WS_R;
        int G_ = gridDim.x, bx_ = blockIdx.x; asm volatile("" : "+s"(G_), "+s"(bx_));
        switch (op) {
        case OP_SW0: case OP_SW1: {
            const int half = op == OP_SW1;
            pg8::Gemm gm{(const bf16_t*)(ws + WS_HN), (const bf16_t*)(ws + WS_WFFI) + (size_t)(l * 2 + half) * (2 * DFF) * 1024, MT, 2 * DFF, 1024};
            pg8::StaticOrder S; S.init(MT, 2 * DFF, G_, bx_); EpiSwiglu E{(bf16_t*)(R + R_ACT)};
#ifndef NO_SW
            pg8::gemm_phase<EpiSwiglu, pg8::StaticOrder, true, true>(lds, gm, S, E);
#endif
        } break;
        case OP_MIN: {
            pg8::Gemm gm{(const bf16_t*)(ws + WS_HN), (const bf16_t*)(ws + WS_WMIN) + (size_t)j * 512 * 1024, MT, 512, 1024}; EpiF32 E{(float*)(R + R_C), 512};
            pg8::StaticOrder S; S.init(MT, 512, G_, bx_);
#ifndef NO_F32
            pg8::gemm_phase<EpiF32, pg8::StaticOrder, true, true>(lds, gm, S, E);
#endif
        } break;
        case OP_FO0: case OP_FO1: case OP_MWO: case OP_HWO: {
            pg8::Gemm gm; EpiB16 E{(bf16_t*)(ws + WS_YB), 1024};
            if (op == OP_FO0 || op == OP_FO1) { const int half = op == OP_FO1; gm = pg8::Gemm{(const bf16_t*)(R + R_ACT), (const bf16_t*)(ws + WS_WFFO) + (size_t)(l * 2 + half) * 1024 * DFF, MT, 1024, DFF}; }
            else if (op == OP_MWO) { gm = pg8::Gemm{(const bf16_t*)(R + R_O), (const bf16_t*)(ws + WS_WMO) + (size_t)j * 1024 * 1024, MT, 1024, 1024}; }
            else { gm = pg8::Gemm{(const bf16_t*)(R + R_HO), (const bf16_t*)(ws + WS_WHO) + (size_t)j * 1024 * 1024, MT, 1024, 1024}; }
            pg8::StaticOrder S; S.init(MT, 1024, G_, bx_);
            pg8::gemm_phase<EpiB16, pg8::StaticOrder, true, true>(lds, gm, S, E);
        } break;
        case OP_RPA: case OP_RPB: case OP_RPC: {
            const float* gains = ap->in[2]; const float* g = gains + (size_t)l * 6 * DM; const bf16_t* Y = (const bf16_t*)(ws + WS_YB); float* X = ap->out; bf16_t* HN = (bf16_t*)(ws + WS_HN);
            const int k = op == OP_RPA ? 1 : (op == OP_RPB ? 3 : 5); const float scale = op == OP_RPB ? 1.0f : 0.5f;
            const bool last = (op == OP_RPC) && (l == DEPTH - 1);
            const float* gn = op == OP_RPC ? gains + (size_t)(l + 1) * 6 * DM : g + (size_t)(k + 1) * DM;
            const int lane = LANE_;
            for (int m = bx_ * 8 + __builtin_amdgcn_readfirstlane(otid_() >> 6); m < MT; m += G_ * 8) row_post(Y + (size_t)m * DM, X + (size_t)m * DM, last ? (bf16_t*)nullptr : HN + (size_t)m * DM, scale, g + (size_t)k * DM, last ? g : gn, lane);
        } break;
        case OP_RMLA: {
            const float* qn = ap->in[6] + (size_t)j * QLR; const float* kvn = ap->in[7] + (size_t)j * KVLR; const float* COS = (const float*)(ws + WS_COS); const float* SIN = (const float*)(ws + WS_SIN);
            const int lane = LANE_;
            for (int m = bx_ * 8 + __builtin_amdgcn_readfirstlane(otid_() >> 6); m < MT; m += G_ * 8) row_mla((const float*)(R + R_C) + (size_t)m * 512, (bf16_t*)(R + R_CQ) + (size_t)m * 256, (bf16_t*)(R + R_CKV) + (size_t)m * 128, (bf16_t*)(R + R_KR) + (size_t)m * 64,
                                                         qn, kvn, COS + (size_t)m * 32, SIN + (size_t)m * 32, lane);
        } break;
        case OP_QKV: {
            { int Kq = 256; asm volatile("" : "+s"(Kq)); pg8::Gemm gm{(const bf16_t*)(R + R_CQ), (const bf16_t*)(ws + WS_WUQ) + (size_t)j * 1536 * 256, MT, 1536, Kq};
              pg8::StaticOrder S; S.init(MT, 1536, G_, bx_); EpiQ E{(bf16_t*)(R + R_QB), (const float*)(ws + WS_COS), (const float*)(ws + WS_SIN)};
#ifndef NO_Q
              pg8::gemm_phase<EpiQ, pg8::StaticOrder, true, true>(lds, gm, S, E);
#endif
            }
            __syncthreads();
            { int Kq = 128; asm volatile("" : "+s"(Kq)); pg8::Gemm gm{(const bf16_t*)(R + R_CKV), (const bf16_t*)(ws + WS_WUKV) + (size_t)j * 2048 * 128, MT, 2048, Kq};
              pg8::StaticOrder S; S.init(MT, 2048, G_, bx_); EpiKV E{(bf16_t*)(R + R_KN), (bf16_t*)(R + R_VB)};
#ifndef NO_KV
              pg8::gemm_phase<EpiKV, pg8::StaticOrder, true, true>(lds, gm, S, E);
#endif
            }
        } break;
        case OP_ATTN: {
#ifndef NO_ATTN
            const int G = G_, bx = bx_;

            const int vcu = (G % 8 == 0) ? (bx % 8) * (G / 8) + bx / 8 : bx;
#ifdef REP_ATTN
            for (int rep_ = 0; rep_ < 2; ++rep_)
#endif
            for (int uid = vcu; uid < BATCH * NH * (SEQ / 256); uid += G) {
                const int bh = uid >> 5, qb = uid & 31, b = bh >> 3, h = bh & 7;
                const size_t row0 = (size_t)b * SEQ;
                att::attn_unit((const att::bf16*)(R + R_QB) + (row0 + qb * 256) * 1536 + h * QKD, (const att::bf16*)(R + R_KN) + row0 * 1024 + h * 128,
                               (const att::bf16*)(R + R_KR) + row0 * 64, (const att::bf16*)(R + R_VB) + row0 * 1024 + h * 128,
                               (att::bf16*)(R + R_O) + (row0 + qb * 256) * 1024 + h * 128, SEQ, (char*)lds_raw);
            }
#endif
        } break;
        case OP_HIN: {
            pg8::Gemm gm{(const bf16_t*)(ws + WS_HN), (const bf16_t*)(ws + WS_WHIN) + (size_t)j * 5120 * 1024, MT, 5120, 1024};
            pg8::StaticOrder S; S.init(MT, 5120, G_, bx_);
            EpiHgrn E{(bf16_t*)(R + R_QH), (bf16_t*)(R + R_VH), (bf16_t*)(R + R_GH), (unsigned short*)(R + R_KF), (const float*)(ws + WS_LB) + (size_t)j * 2048};
#ifndef NO_HG
            pg8::gemm_phase<EpiHgrn, pg8::StaticOrder, true, true>(lds, gm, S, E);
#endif
        } break;
        case OP_SCAN: {
#ifndef NO_SCAN
#ifdef REP_SCAN
            scan_phase(lds, (const bf16_t*)(R + R_QH), (const bf16_t*)(R + R_VH), (const unsigned short*)(R + R_KF), (bf16_t*)(ws + WS_Y), G_, bx_); __syncthreads();
#endif
#ifdef SCAN_VALU
            scan_phase(lds, (const bf16_t*)(R + R_QH), (const bf16_t*)(R + R_VH), (const unsigned short*)(R + R_KF), (bf16_t*)(ws + WS_Y), G_, bx_);
#else
            scan_phase_mfma(lds, (const bf16_t*)(R + R_QH), (const bf16_t*)(R + R_VH), (const unsigned short*)(R + R_KF), (bf16_t*)(ws + WS_Y), G_, bx_);
#endif
#endif
        } break;
        case OP_RHG: {
            const float* on = ap->in[13] + (size_t)j * DM; const bf16_t* Y = (const bf16_t*)(ws + WS_Y);
            const int lane = LANE_;
            for (int m = bx_ * 8 + __builtin_amdgcn_readfirstlane(otid_() >> 6); m < MT; m += G_ * 8) row_hgrn(Y + (size_t)m * DM, (const bf16_t*)(R + R_GH) + (size_t)m * DM, (bf16_t*)(R + R_HO) + (size_t)m * DM, on, lane);
        } break;
        default: break;
        }
        if (ph != 45) gsync(lds);
#ifdef REP_SYNC
        gsync(lds);
#endif
#ifdef DBG_CHECKS
        { ArgsP ap2 = get_args(); dbg_after(l, op, ap2, ap2->ws, ap2->ws + WS_R, lds); gsync(lds); }
#endif
    }
#ifdef DBG_CHECKS
    gsync(lds);
    if (blockIdx.x == 0 && threadIdx.x == 0) { ArgsP ap = get_args(); unsigned* DBG = (unsigned*)ap->ws; const float mx = __uint_as_float(atomicAdd(DBG + 20, 0u)), mean = atomicAdd((float*)(DBG + 21), 0.f); ap->out[1024 * 16] += 1e6f * mx; ap->out[1024 * 16 + 1] += 1e4f * mean; }
#endif
}

extern "C" void kernel_launch(void* const* d_in, const int* in_sizes, int n_in, void* d_out, int out_size, void* d_ws, size_t ws_size, hipStream_t stream) {
    static int grid = 0;
    if (grid == 0) {
        if (n_in != 15 || out_size != MT * DM || ws_size < WS_END) { fprintf(stderr, "kernel_launch: unexpected shapes: n_in %d out %d ws %zu (need %zu)\n", n_in, out_size, ws_size, (size_t)WS_END); grid = -1; return; }
        int dev = 0, cus = 0, per_cu = 0;
        (void)hipGetDevice(&dev); (void)hipDeviceGetAttribute(&cus, hipDeviceAttributeMultiprocessorCount, dev);
        if (hipFuncSetAttribute((const void*)mega_fwd, hipFuncAttributeMaxDynamicSharedMemorySize, LDS_BYTES) != hipSuccess) { fprintf(stderr, "kernel_launch: hipFuncSetAttribute failed\n"); grid = -1; return; }
        if (hipOccupancyMaxActiveBlocksPerMultiprocessor(&per_cu, (const void*)mega_fwd, 512, LDS_BYTES) != hipSuccess || per_cu < 1) { fprintf(stderr, "kernel_launch: occupancy query gave %d\n", per_cu); per_cu = 1; }
        (void)hipGetLastError();
        grid = cus * 1;
        fprintf(stderr, "kernel_launch: cus %d per_cu %d grid %d\n", cus, per_cu, grid);
    }
    if (grid < 0) return;
    if (hipMemsetAsync(d_ws, 0, 65536, stream) != hipSuccess) { fprintf(stderr, "kernel_launch: memset failed\n"); return; }
    Args a{};
    for (int i = 0; i < 15; ++i) a.in[i] = (const float*)d_in[i];
    a.out = (float*)d_out; a.ws = (unsigned char*)d_ws;
    void* args[] = {&a};
    hipError_t e = hipLaunchCooperativeKernel((const void*)mega_fwd, dim3(grid), dim3(512), args, LDS_BYTES, stream);
    if (e != hipSuccess) fprintf(stderr, "cooperative launch failed: %s (grid %d)\n", hipGetErrorString(e), grid);
}
```

```cpp
#include <hip/hip_runtime.h>
#include <hip/hip_cooperative_groups.h>
#include <hip/hip_bf16.h>
#include <hip/hip_fp16.h>
#include <cstdio>
#include <cstdint>
#include <cmath>
namespace cg = cooperative_groups;
namespace pg8 {
#define PG8_LAS __attribute__((address_space(3)))
typedef unsigned short bf16_t;
typedef short bf16x8 __attribute__((ext_vector_type(8)));
typedef float f32x4 __attribute__((ext_vector_type(4)));
typedef unsigned u32x4 __attribute__((ext_vector_type(4)));
constexpr int BM = 256, BK = 64, HALF = 128, HTB = HALF * BK * 2  , STAGE_BYTES = 8 * HTB, NXCD = 8, WGM = 8;

__host__ __device__ __forceinline__ int lds_byte(int r, int c) { const int st = (r >> 4) * 2 + (c >> 5), rr = r & 15, cc = c & 31, ob = rr * 64 + cc * 2; return st * 1024 + (ob ^ (((ob >> 9) & 1) << 5)); }
__host__ __device__ __forceinline__ void stage_rc(int b, int& R, int& C) { const int st = b / 1024, sb = b % 1024, swz = sb ^ (((sb >> 9) & 1) << 5); R = (st >> 1) * 16 + swz / 64; C = (st & 1) * 32 + (swz % 64) / 2; }
__host__ __device__ __forceinline__ int perm32(int rho) { const int n = rho >> 4, i = rho & 15; return 8 * (i >> 2) + 4 * n + (i & 3); }

struct Unit { int pm, pn; };
struct Gemm { const bf16_t* A; const bf16_t* Bt; int M, N, K; };

struct StaticOrder {
    int nM, nN, nwg, G, c;
    __host__ __device__ void init(int M, int N, int G_, int c_) { nM = M / BM; nN = N / BM; nwg = nM * nN; G = G_; c = c_; }
    __host__ __device__ bool next(int i, Unit& u) const {
        const long L = (long)i * G + c; if (L >= nwg) return false;
        int wgid = (int)L; { const int q = nwg / NXCD, r = nwg % NXCD, xcd = wgid % NXCD, off = wgid / NXCD; wgid = (xcd < r ? xcd * (q + 1) : r * (q + 1) + (xcd - r) * q) + off; }
        const int nig = WGM * nN, gid = wgid / nig, fm = gid * WGM, gsz = (nM - fm) < WGM ? (nM - fm) : WGM;
        u.pm = fm + ((wgid % nig) % gsz); u.pn = (wgid % nig) / gsz; return true;
    }
    __device__ __forceinline__ void a_ready(const Unit&) const {}
    __device__ __forceinline__ void done(const Unit&) const {}
};

__device__ __forceinline__ unsigned cvt_pk_bf16(float lo, float hi) { unsigned r; asm volatile("v_cvt_pk_bf16_f32 %0, %1, %2" : "=v"(r) : "v"(lo), "v"(hi)); return r; }
template <class Epi, class Sched, bool ALIGN_EPI = false, bool SP2 = false>
__device__ __forceinline__ void gemm_phase(PG8_LAS unsigned char* lds, const Gemm g, const Sched& S, const Epi& E) {
    int tid = threadIdx.x; asm volatile("" : "+v"(tid)); const int wid = __builtin_amdgcn_readfirstlane(tid >> 6), lane = tid & 63, wr = wid >> 2, wc = wid & 3, fr = lane & 15, fq = lane >> 4;
    const int K = g.K, nt = K / BK;
    unsigned voffA[2], voffB[2];
#pragma unroll
    for (int i = 0; i < 2; ++i) { int R, C; stage_rc(tid * 16 + i * 8192, R, C); const int Rb = Epi::PERM ? ((R & ~31) + perm32(R & 31)) : R;
        voffA[i] = (unsigned)(R * K + C) * 2u; voffB[i] = (unsigned)(Rb * K + C) * 2u; }
    const size_t kstep = (size_t)(BK * 2);
    const size_t hstep = (size_t)HALF * K * 2;
    const size_t tstep = 2 * hstep;
    const unsigned ldsw = (unsigned)wid * 1024u;
    const int aoff = lds_byte(wr * 64 + fr, fq * 8), boff = lds_byte(wc * 32 + fr, fq * 8);
#define PG8_SA(b, h) (((b) * 2 + (h)) * HTB)
#define PG8_SB(b, h) ((4 + (b) * 2 + (h)) * HTB)
#define PG8_STAGE(bufoff, gbase, voff) do { _Pragma("unroll") for (int _i = 0; _i < 2; ++_i) \
        __builtin_amdgcn_global_load_lds((const unsigned*)((const char*)(gbase) + (voff)[_i]), (PG8_LAS unsigned*)(lds + (bufoff) + ldsw + _i * 8192), 16, 0, 0); } while (0)
#define PG8_LDA(dst, b, h) do { _Pragma("unroll") for (int m = 0; m < 4; ++m) _Pragma("unroll") for (int k = 0; k < 2; ++k) dst[m][k] = *(const PG8_LAS bf16x8*)(lds + PG8_SA(b, h) + aoff + m * 2048 + k * 1024); } while (0)
#define PG8_LDB(dst, b, h) do { _Pragma("unroll") for (int n = 0; n < 2; ++n) _Pragma("unroll") for (int k = 0; k < 2; ++k) dst[n][k] = *(const PG8_LAS bf16x8*)(lds + PG8_SB(b, h) + boff + n * 2048 + k * 1024); } while (0)
#define PG8_MMA(ai, bj, At, Bt) do { __builtin_amdgcn_s_setprio(1); _Pragma("unroll") for (int m = 0; m < 4; ++m) _Pragma("unroll") for (int n = 0; n < 2; ++n) _Pragma("unroll") for (int k = 0; k < 2; ++k) \
        acc[ai][bj][m][n] = __builtin_amdgcn_mfma_f32_16x16x32_bf16(Bt[n][k], At[m][k], acc[ai][bj][m][n], 0, 0, 0); __builtin_amdgcn_s_setprio(0); } while (0)
#define PG8_WAIT_V(n) asm volatile("s_waitcnt vmcnt(" #n ")" ::: "memory")
#define PG8_WAIT_L(n) asm volatile("s_waitcnt lgkmcnt(" #n ")" ::: "memory")
#define PG8_BAR __builtin_amdgcn_s_barrier()
#define PG8_SCHED __builtin_amdgcn_sched_barrier(0)
    Unit cur, nxt; int ui = 0;
    if (!S.next(0, cur)) return;
    f32x4 acc[2][2][4][2];
#pragma unroll
    for (int a = 0; a < 2; ++a)
#pragma unroll
        for (int b = 0; b < 2; ++b)
#pragma unroll
            for (int m = 0; m < 4; ++m)
#pragma unroll
                for (int n = 0; n < 2; ++n) acc[a][b][m][n] = (f32x4){0.f, 0.f, 0.f, 0.f};
    bf16x8 At[4][2], B0[2][2], B1[2][2];
    const char* cA = (const char*)g.A + (size_t)cur.pm * tstep; const char* cB = (const char*)g.Bt + (size_t)cur.pn * tstep;
    S.a_ready(cur);
    if constexpr (SP2) {
        PG8_STAGE(PG8_SB(0, 0), cB, voffB); PG8_STAGE(PG8_SB(0, 1), cB + hstep, voffB); PG8_STAGE(PG8_SA(0, 0), cA, voffA); PG8_STAGE(PG8_SA(0, 1), cA + hstep, voffA);
        if (wr == 1) PG8_BAR;
        PG8_WAIT_V(2); PG8_BAR;
        PG8_STAGE(PG8_SB(1, 0), cB + kstep, voffB); PG8_STAGE(PG8_SA(1, 0), cA + kstep, voffA); PG8_STAGE(PG8_SB(1, 1), cB + hstep + kstep, voffB);
        PG8_WAIT_V(6); PG8_BAR;
    } else {
        PG8_STAGE(PG8_SB(0, 0), cB, voffB); PG8_STAGE(PG8_SA(0, 0), cA, voffA); PG8_STAGE(PG8_SB(0, 1), cB + hstep, voffB); PG8_STAGE(PG8_SA(0, 1), cA + hstep, voffA);
        if (wr == 1) PG8_BAR;
        PG8_WAIT_V(4); PG8_BAR;
        PG8_STAGE(PG8_SB(1, 0), cB + kstep, voffB); PG8_STAGE(PG8_SA(1, 0), cA + kstep, voffA); PG8_STAGE(PG8_SB(1, 1), cB + hstep + kstep, voffB);
        PG8_WAIT_V(6); PG8_BAR;
    }
    for (;;) {
        const bool has_next = S.next(ui + 1, nxt);
        const char* nA = has_next ? (const char*)g.A + (size_t)nxt.pm * tstep : cA; const char* nB = has_next ? (const char*)g.Bt + (size_t)nxt.pn * tstep : cB;
        for (int t = 0; t < nt; t += 2) {
            const bool last = (t == nt - 2);
            const char* a1 = cA + (size_t)(t + 1) * kstep;
            const char* a2 = last ? nA : cA + (size_t)(t + 2) * kstep; const char* b2 = last ? nB : cB + (size_t)(t + 2) * kstep;
            const char* a3 = a2 + kstep; const char* b3 = b2 + kstep;
            if (last && has_next) S.a_ready(nxt);
            if constexpr (SP2) {
            PG8_LDB(B0, 0, 0); PG8_LDB(B1, 0, 1); PG8_SCHED; PG8_LDA(At, 0, 0); PG8_STAGE(PG8_SA(1, 1), a1 + hstep, voffA);
            PG8_WAIT_V(8); PG8_WAIT_L(0); PG8_BAR; PG8_MMA(0, 0, At, B0); PG8_MMA(0, 1, At, B1); PG8_BAR; PG8_SCHED;
            PG8_LDA(At, 0, 1); PG8_STAGE(PG8_SB(0, 0), b2, voffB); PG8_STAGE(PG8_SB(0, 1), b2 + hstep, voffB); PG8_STAGE(PG8_SA(0, 0), a2, voffA);
            PG8_WAIT_V(8); PG8_WAIT_L(0); PG8_BAR; PG8_MMA(1, 0, At, B0); PG8_MMA(1, 1, At, B1); PG8_BAR; PG8_SCHED;
            PG8_LDB(B0, 1, 0); PG8_LDB(B1, 1, 1); PG8_SCHED; PG8_LDA(At, 1, 0); PG8_STAGE(PG8_SA(0, 1), a2 + hstep, voffA);
            PG8_WAIT_V(8); PG8_WAIT_L(0); PG8_BAR; PG8_MMA(0, 0, At, B0); PG8_MMA(0, 1, At, B1); PG8_BAR; PG8_SCHED;
            PG8_LDA(At, 1, 1); PG8_STAGE(PG8_SB(1, 0), b3, voffB); PG8_STAGE(PG8_SB(1, 1), b3 + hstep, voffB); PG8_STAGE(PG8_SA(1, 0), a3, voffA);
            PG8_WAIT_V(8); PG8_WAIT_L(0); PG8_BAR; PG8_MMA(1, 0, At, B0); PG8_MMA(1, 1, At, B1); PG8_BAR; PG8_SCHED;
            } else {
            PG8_LDB(B0, 0, 0); PG8_SCHED; PG8_LDA(At, 0, 0); PG8_STAGE(PG8_SA(1, 1), a1 + hstep, voffA);
            PG8_WAIT_L(8); PG8_BAR; PG8_WAIT_L(0); PG8_MMA(0, 0, At, B0); PG8_BAR; PG8_SCHED;
            PG8_LDB(B1, 0, 1); PG8_STAGE(PG8_SB(0, 0), b2, voffB);
            PG8_BAR; PG8_WAIT_L(0); PG8_MMA(0, 1, At, B1); PG8_BAR;
            PG8_LDA(At, 0, 1); PG8_STAGE(PG8_SA(0, 0), a2, voffA);
            PG8_BAR; PG8_WAIT_L(0); PG8_MMA(1, 0, At, B0); PG8_BAR; PG8_SCHED;
            PG8_STAGE(PG8_SB(0, 1), b2 + hstep, voffB);
            PG8_WAIT_V(6); PG8_BAR; PG8_MMA(1, 1, At, B1); PG8_BAR;
            PG8_LDB(B0, 1, 0); PG8_SCHED; PG8_LDA(At, 1, 0); PG8_STAGE(PG8_SA(0, 1), a2 + hstep, voffA);
            PG8_WAIT_L(8); PG8_BAR; PG8_WAIT_L(0); PG8_MMA(0, 0, At, B0); PG8_BAR; PG8_SCHED;
            PG8_LDB(B1, 1, 1); PG8_STAGE(PG8_SB(1, 0), b3, voffB);
            PG8_BAR; PG8_WAIT_L(0); PG8_MMA(0, 1, At, B1); PG8_BAR;
            PG8_LDA(At, 1, 1); PG8_STAGE(PG8_SA(1, 0), a3, voffA);
            PG8_BAR; PG8_WAIT_L(0); PG8_MMA(1, 0, At, B0); PG8_BAR; PG8_SCHED;
            PG8_STAGE(PG8_SB(1, 1), b3 + hstep, voffB);
            PG8_WAIT_V(6); PG8_BAR; PG8_MMA(1, 1, At, B1); PG8_BAR;
            }
        }
        if constexpr (ALIGN_EPI) { if (wr == 0) PG8_BAR; }
        if constexpr (!Epi::AFTER_DRAIN) { E(acc, cur, wr, wc, fr, fq); S.done(cur); }
        if (!has_next) break;
#pragma unroll
        for (int a = 0; a < 2; ++a)
#pragma unroll
            for (int b = 0; b < 2; ++b)
#pragma unroll
                for (int m = 0; m < 4; ++m)
#pragma unroll
                    for (int n = 0; n < 2; ++n) acc[a][b][m][n] = (f32x4){0.f, 0.f, 0.f, 0.f};
        cur = nxt; cA = nA; cB = nB; ++ui;
        if constexpr (ALIGN_EPI) { if (wr == 1) PG8_BAR; }
    }
    PG8_WAIT_V(0);
    if constexpr (!ALIGN_EPI) { if (wr == 0) PG8_BAR; }
    PG8_BAR;
    if constexpr (Epi::AFTER_DRAIN) { E.fused(acc, cur, wr, wc, fr, fq, lds, wid, lane); S.done(cur); }
#undef PG8_SA
#undef PG8_SB
#undef PG8_STAGE
#undef PG8_LDA
#undef PG8_LDB
#undef PG8_MMA
#undef PG8_WAIT_V
#undef PG8_WAIT_L
#undef PG8_BAR
#undef PG8_SCHED
}
}
#ifndef ATT_SDEPTH
#define ATT_SDEPTH 1
#endif
namespace att {
using bf16 = __hip_bfloat16;
constexpr int NW = 8, QBLK = 32, KVBLK = 64;
constexpr float SCALE = 0.07216878364870322f;
constexpr float THR = 8.f;
__device__ __forceinline__ int otid() { int t = threadIdx.x; asm volatile("" : "+v"(t)); return t; }
using bf16x8 = __attribute__((ext_vector_type(8))) short;
using s16x4  = __attribute__((ext_vector_type(4))) short;
using f32x16 = __attribute__((ext_vector_type(16))) float;
using f32x8  = __attribute__((ext_vector_type(8))) float;
using u32x4  = __attribute__((ext_vector_type(4))) unsigned;
#define KSWZ(row, colB) ((row) * 256 + ((colB) ^ (((row) & 7) << 4)))
#define SBAR() __builtin_amdgcn_sched_barrier(0)
__device__ __forceinline__ int crow(int r, int hi) { return (r & 3) + 8 * (r >> 2) + 4 * hi; }
__device__ __forceinline__ unsigned cvtpk(float lo, float hi) {
  unsigned r; asm volatile("v_cvt_pk_bf16_f32 %0, %1, %2" : "=v"(r) : "v"(lo), "v"(hi)); return r;
}
template <typename TIn> struct Stage;
template <> struct Stage<bf16>  { using T = bf16x8;
  __device__ static __forceinline__ T ld8(const bf16* p) { return *reinterpret_cast<const bf16x8*>(p); }
  __device__ static __forceinline__ bf16x8 tobf(T x) { return x; } };
template <> struct Stage<float> { using T = f32x8;
  __device__ static __forceinline__ T ld8(const float* p) { return *reinterpret_cast<const f32x8*>(p); }
  __device__ static __forceinline__ bf16x8 tobf(T x) {
    u32x4 w = {cvtpk(x[0], x[1]), cvtpk(x[2], x[3]), cvtpk(x[4], x[5]), cvtpk(x[6], x[7])}; return *reinterpret_cast<bf16x8*>(&w); } };

__device__ __forceinline__ void partialSM(f32x16& p0, f32x16& p1, float& m_reg, float& mn, float& alpha) {
  constexpr float C = SCALE * 1.4426950408889634f;
  float pmax = p0[0]; for (int r = 1; r < 16; ++r) pmax = fmaxf(pmax, p0[r]); for (int r = 0; r < 16; ++r) pmax = fmaxf(pmax, p1[r]);
  { auto rr = __builtin_amdgcn_permlane32_swap(__float_as_uint(pmax), __float_as_uint(pmax), false, false);
    pmax = fmaxf(__uint_as_float(rr[0]), __uint_as_float(rr[1])); }
  if (__builtin_expect(__all(pmax - m_reg <= THR / SCALE), 1)) { mn = m_reg; alpha = 1.f; }
  else { mn = fmaxf(m_reg, pmax); alpha = __builtin_amdgcn_exp2f((m_reg - mn) * C); m_reg = mn; }
  float mnC = -mn * C;
  for (int r = 0; r < 16; ++r) p0[r] = fmaf(p0[r], C, mnC); for (int r = 0; r < 16; ++r) p1[r] = fmaf(p1[r], C, mnC);
  for (int r = 0; r < 16; ++r) p0[r] = __builtin_amdgcn_exp2f(p0[r]);
}
__device__ __forceinline__ void finishSM(f32x16& p0, f32x16& p1, float alpha, float& l_reg, bf16x8& pa0, bf16x8& pa1, bf16x8& pa2, bf16x8& pa3) {
  for (int r = 0; r < 16; ++r) p1[r] = __builtin_amdgcn_exp2f(p1[r]);
  float ps = 0; for (int r = 0; r < 16; ++r) ps += p0[r]; for (int r = 0; r < 16; ++r) ps += p1[r];
  { auto rr = __builtin_amdgcn_permlane32_swap(__float_as_uint(ps), __float_as_uint(ps), false, false);
    ps = __uint_as_float(rr[0]) + __uint_as_float(rr[1]); }
  l_reg = l_reg * alpha + ps;
#define PK4(P, BASE, OUT) do { unsigned a0 = cvtpk(P[BASE + 0], P[BASE + 1]), a1 = cvtpk(P[BASE + 2], P[BASE + 3]);   \
    unsigned b0 = cvtpk(P[BASE + 4], P[BASE + 5]), b1 = cvtpk(P[BASE + 6], P[BASE + 7]);                              \
    auto r0 = __builtin_amdgcn_permlane32_swap(a0, b0, false, false); auto r1 = __builtin_amdgcn_permlane32_swap(a1, b1, false, false); \
    u32x4 w = {r0[0], r1[0], r0[1], r1[1]}; OUT = *reinterpret_cast<bf16x8*>(&w); } while (0)
  PK4(p0, 0, pa0); PK4(p0, 8, pa1); PK4(p1, 0, pa2); PK4(p1, 8, pa3);
#undef PK4
}
#define KSWZ2(row, colB) ((row) * 128 + ((colB) ^ (((row) & 7) << 4)))
__device__ __forceinline__ void qkt(f32x16& p0, f32x16& p1, const bf16* Ks, const bf16* KRs, const bf16x8* qr, const bf16x8* qrl, int r32, int hi) {
  p0 = f32x16{}; p1 = f32x16{};
#pragma unroll
  for (int d0 = 0; d0 < 8; ++d0) { int cb = (d0 * 16 + hi * 8) * 2;
    bf16x8 b0 = *reinterpret_cast<const bf16x8*>((const char*)Ks + KSWZ(r32, cb));
    bf16x8 b1 = *reinterpret_cast<const bf16x8*>((const char*)Ks + KSWZ(32 + r32, cb));
    p0 = __builtin_amdgcn_mfma_f32_32x32x16_bf16(b0, qr[d0], p0, 0, 0, 0);
    p1 = __builtin_amdgcn_mfma_f32_32x32x16_bf16(b1, qr[d0], p1, 0, 0, 0); }
#pragma unroll
  for (int d0 = 0; d0 < 4; ++d0) { int cb = (d0 * 16 + hi * 8) * 2;
    bf16x8 b0 = *reinterpret_cast<const bf16x8*>((const char*)KRs + KSWZ2(r32, cb));
    bf16x8 b1 = *reinterpret_cast<const bf16x8*>((const char*)KRs + KSWZ2(32 + r32, cb));
    const bf16x8 qv = qrl[d0 * 64];
    p0 = __builtin_amdgcn_mfma_f32_32x32x16_bf16(b0, qv, p0, 0, 0, 0);
    p1 = __builtin_amdgcn_mfma_f32_32x32x16_bf16(b1, qv, p1, 0, 0, 0); }
}
__device__ __forceinline__ int v_st(int k, int c) { const int kk = (k & ~0xC) | ((k & 4) << 1) | ((k & 8) >> 1); return ((kk >> 3) * 4 + (c >> 5)) * 512 + ((kk & 7) * 32 + (c & 31)) * 2; }
__device__ __forceinline__ int v_rd_base(int lane) { return ((lane & 3) << 3) | (((lane >> 2) & 3) << 6) | (((lane >> 4) & 1) << 5) | (((lane >> 5) & 1) << 8); }
constexpr int v_rd_off(int d0, int ks, int half) { return d0 * 512 + ks * 4096 + half * 2048; }
template <int OFF> __device__ __forceinline__ s16x4 tr_read(int vb) {
  s16x4 r; asm volatile("ds_read_b64_tr_b16 %0, %1 offset:%2" : "=&v"(r) : "v"(vb), "i"(OFF) : "memory"); return r;
}
template <int D0> __device__ __forceinline__ void pv_one(f32x16& od, int vb, bf16x8 pa0, bf16x8 pa1, bf16x8 pa2, bf16x8 pa3) {
  const s16x4 l0 = tr_read<v_rd_off(D0, 0, 0)>(vb), h0 = tr_read<v_rd_off(D0, 0, 1)>(vb), l1 = tr_read<v_rd_off(D0, 1, 0)>(vb), h1 = tr_read<v_rd_off(D0, 1, 1)>(vb);
  const s16x4 l2 = tr_read<v_rd_off(D0, 2, 0)>(vb), h2 = tr_read<v_rd_off(D0, 2, 1)>(vb), l3 = tr_read<v_rd_off(D0, 3, 0)>(vb), h3 = tr_read<v_rd_off(D0, 3, 1)>(vb);
  asm volatile("s_waitcnt lgkmcnt(0)" ::: "memory"); SBAR();
#define PK(L, H) (bf16x8){L[0], L[1], L[2], L[3], H[0], H[1], H[2], H[3]}
  od = __builtin_amdgcn_mfma_f32_32x32x16_bf16(pa0, PK(l0, h0), od, 0, 0, 0);
  od = __builtin_amdgcn_mfma_f32_32x32x16_bf16(pa1, PK(l1, h1), od, 0, 0, 0);
  od = __builtin_amdgcn_mfma_f32_32x32x16_bf16(pa2, PK(l2, h2), od, 0, 0, 0);
  od = __builtin_amdgcn_mfma_f32_32x32x16_bf16(pa3, PK(l3, h3), od, 0, 0, 0);
#undef PK
}
__device__ __forceinline__ void pv_d0(f32x16* o, int vb, bf16x8 pa0, bf16x8 pa1, bf16x8 pa2, bf16x8 pa3) {
  pv_one<0>(o[0], vb, pa0, pa1, pa2, pa3); pv_one<1>(o[1], vb, pa0, pa1, pa2, pa3); pv_one<2>(o[2], vb, pa0, pa1, pa2, pa3); pv_one<3>(o[3], vb, pa0, pa1, pa2, pa3);
}
constexpr int LDQ = 1536, LDK = 1024, LDV = 1024, LDKR = 64, LDO = 1024, SDEPTH = ATT_SDEPTH;
constexpr int SHM_V = KVBLK * 128 * 2, SHM_K = KVBLK * 128 * 2, SHM_KR = KVBLK * 64 * 2;
constexpr int SHM_QR = NW * 4 * 64 * 16;
constexpr int SHM_ATTN = 2 * SHM_V + 2 * SHM_K + 2 * SHM_KR + NW * 64 * 4 + SHM_QR;
__device__ __forceinline__ void attn_unit(const bf16* __restrict__ Qb, const bf16* __restrict__ Kh, const bf16* __restrict__ KRh, const bf16* __restrict__ Vh,
                                          bf16* __restrict__ Ob, int seq, char* lds) {
  using St = Stage<bf16>;
  const int tid = otid(), wid = tid >> 6, lane = tid & 63, r32 = lane & 31, hi = lane >> 5;
  bf16* V_lds = (bf16*)lds; bf16* K_lds = (bf16*)(lds + 2 * SHM_V); bf16* KR_lds = (bf16*)(lds + 2 * SHM_V + 2 * SHM_K);
  float* ws = (float*)(lds + 2 * SHM_V + 2 * SHM_K + 2 * SHM_KR) + wid * 64; float* li_l = ws; float* al_l = ws + 32;
  float m_reg = -1e30f, l_reg = 0; f32x16 o[4] = {}; bf16x8 qr[8];
  bf16x8* qrl = (bf16x8*)(lds + 2 * SHM_V + 2 * SHM_K + 2 * SHM_KR + NW * 64 * 4) + wid * 256 + lane;
  const bf16* Qw = Qb + (long)(wid * QBLK + r32) * LDQ + hi * 8;
#pragma unroll
  for (int d0 = 0; d0 < 8; ++d0) qr[d0] = St::ld8(Qw + d0 * 16);
#pragma unroll
  for (int d0 = 0; d0 < 4; ++d0) qrl[d0 * 64] = St::ld8(Qw + 128 + d0 * 16);
  const int sr = tid >> 4, sc = (tid & 15) * 8, vst0 = v_st(sr, sc), vst1 = v_st(32 + sr, sc);
  const int krr = tid >> 3, krc = (tid & 7) * 8;
  const int vb0 = (int)(uintptr_t)V_lds + v_rd_base(lane);
  struct { bf16x8 vs0, vs1, ks0, ks1, kr; } sr_[SDEPTH];
#define SLOAD(i, k0) do { sr_[i].vs0 = St::ld8(&Vh[(long)((k0) + sr) * LDV + sc]); sr_[i].vs1 = St::ld8(&Vh[(long)((k0) + 32 + sr) * LDV + sc]); \
    sr_[i].ks0 = St::ld8(&Kh[(long)((k0) + sr) * LDK + sc]); sr_[i].ks1 = St::ld8(&Kh[(long)((k0) + 32 + sr) * LDK + sc]); \
    sr_[i].kr = St::ld8(&KRh[(long)((k0) + krr) * LDKR + krc]); } while (0)
#define SWRITE(b, i) do { *(bf16x8*)((char*)V_lds + (b) * SHM_V + vst0) = sr_[i].vs0;          \
    *(bf16x8*)((char*)V_lds + (b) * SHM_V + vst1) = sr_[i].vs1; int kc = sc * 2;               \
    *(bf16x8*)((char*)K_lds + (b) * SHM_K + KSWZ(sr, kc)) = sr_[i].ks0;                       \
    *(bf16x8*)((char*)K_lds + (b) * SHM_K + KSWZ(32 + sr, kc)) = sr_[i].ks1;                  \
    *(bf16x8*)((char*)KR_lds + (b) * SHM_KR + KSWZ2(krr, krc * 2)) = sr_[i].kr; } while (0)
#define SWAIT() do { if constexpr (SDEPTH == 2) asm volatile("s_waitcnt vmcnt(5)" ::: "memory"); else asm volatile("s_waitcnt vmcnt(0)" ::: "memory"); } while (0)
#define RESC(a) do { if (__any((a) < 1.f)) { if (hi == 0) al_l[r32] = (a); asm volatile("s_waitcnt lgkmcnt(0)" ::: "memory"); \
    _Pragma("unroll") for (int d = 0; d < 4; ++d) _Pragma("unroll") for (int r = 0; r < 16; ++r) o[d][r] *= al_l[crow(r, hi)]; } } while (0)
  f32x16 pA0, pA1, pB0, pB1; float mnA, mnB, alA, alB; bf16x8 pa0, pa1, pa2, pa3; const int NT = seq / KVBLK;
  constexpr int SE = 0, SO = SDEPTH - 1;
  SLOAD(SE, 0); asm volatile("s_waitcnt vmcnt(0)" ::: "memory"); SWRITE(0, SE); __syncthreads();
  qkt(pA0, pA1, K_lds, KR_lds, qr, qrl, r32, hi); partialSM(pA0, pA1, m_reg, mnA, alA);
  SLOAD(SO, KVBLK); if constexpr (SDEPTH == 2) { if (2 < NT) SLOAD(SE, 2 * KVBLK); }
  SWAIT(); SWRITE(1, SO); __syncthreads();
  for (int j = 1; j + 1 < NT; j += 2) {
    SBAR(); qkt(pB0, pB1, (bf16*)((char*)K_lds + SHM_K), (bf16*)((char*)KR_lds + SHM_KR), qr, qrl, r32, hi);
    finishSM(pA0, pA1, alA, l_reg, pa0, pa1, pa2, pa3); SBAR();
    SLOAD(SO, (j + SDEPTH) * KVBLK); SBAR();
    pv_d0(o, vb0, pa0, pa1, pa2, pa3); partialSM(pB0, pB1, m_reg, mnB, alB);
    __syncthreads(); SWAIT(); SWRITE(0, SE);
    RESC(alB); __syncthreads();
    SBAR(); qkt(pA0, pA1, K_lds, KR_lds, qr, qrl, r32, hi);
    finishSM(pB0, pB1, alB, l_reg, pa0, pa1, pa2, pa3); SBAR();
    if (SDEPTH == 1 || j + 3 < NT) SLOAD(SE, (j + 1 + SDEPTH) * KVBLK); SBAR();
    pv_d0(o, vb0 + (int)SHM_V, pa0, pa1, pa2, pa3); partialSM(pA0, pA1, m_reg, mnA, alA);
    __syncthreads(); SWAIT(); SWRITE(1, SO);
    RESC(alA); __syncthreads();
  }
  SBAR(); qkt(pB0, pB1, (bf16*)((char*)K_lds + SHM_K), (bf16*)((char*)KR_lds + SHM_KR), qr, qrl, r32, hi);
  finishSM(pA0, pA1, alA, l_reg, pa0, pa1, pa2, pa3); SBAR();
  pv_d0(o, vb0, pa0, pa1, pa2, pa3); partialSM(pB0, pB1, m_reg, mnB, alB);
  __syncthreads(); RESC(alB);
  finishSM(pB0, pB1, alB, l_reg, pa0, pa1, pa2, pa3); SBAR();
  pv_d0(o, vb0 + (int)SHM_V, pa0, pa1, pa2, pa3);
  if (hi == 0) li_l[r32] = l_reg; asm volatile("s_waitcnt lgkmcnt(0)" ::: "memory");
  float rli[16];
#pragma unroll
  for (int r = 0; r < 16; ++r) rli[r] = __builtin_amdgcn_rcpf(li_l[crow(r, hi)]);
  bf16* Ow = Ob + (long)(wid * QBLK) * LDO;
#pragma unroll
  for (int r = 0; r < 16; ++r) { int orow = crow(r, hi);
#pragma unroll
    for (int d0 = 0; d0 < 4; ++d0) Ow[(long)orow * LDO + d0 * 32 + r32] = __float2bfloat16(o[d0][r] * rli[r]); }
  __syncthreads();
#undef SLOAD
#undef SWRITE
#undef SWAIT
#undef RESC
}
#undef SBAR
}
constexpr int BATCH = 4, SEQ = 8192, DM = 1024, DEPTH = 4, DFF = 2816, MT = BATCH * SEQ;
constexpr int NH = 8, QLR = 256, KVLR = 128, QKD = 192;
constexpr float EPS = 1e-6f;
constexpr size_t MiB = 1u << 20;
constexpr size_t WS_WFFI = 1 * MiB;
constexpr size_t WS_WFFO = 89 * MiB;
constexpr size_t WS_WHIN = 133 * MiB;
constexpr size_t WS_WHO  = 153 * MiB;
constexpr size_t WS_WMIN = 157 * MiB;
constexpr size_t WS_WUQ  = 159 * MiB;
constexpr size_t WS_WUKV = 161 * MiB;
constexpr size_t WS_WMO  = 162 * MiB;
constexpr size_t WS_COS  = 166 * MiB;
constexpr size_t WS_SIN  = 170 * MiB;
constexpr size_t WS_LB   = 174 * MiB;
constexpr size_t WS_X16  = 176 * MiB;
constexpr size_t WS_Y    = 240 * MiB;
constexpr size_t WS_YB   = 304 * MiB;
constexpr size_t WS_R    = 368 * MiB;
constexpr size_t WS_END  = 704 * MiB;
constexpr size_t R_ACT = 0;
constexpr size_t R_C = 0, R_QB = 0, R_CQ = 96 * MiB, R_CKV = 112 * MiB, R_KR = 120 * MiB, R_KN = 124 * MiB, R_VB = 188 * MiB, R_O = 252 * MiB;
constexpr size_t R_QH = 0, R_VH = 64 * MiB, R_GH = 128 * MiB, R_KF = 192 * MiB, R_HO = 0;

constexpr int LDS_RING = 131072, LDS_BYTES = LDS_RING + 2048;
typedef unsigned short bf16_t;
typedef float f32x4 __attribute__((ext_vector_type(4)));
typedef float f32x2 __attribute__((ext_vector_type(2)));
typedef unsigned u32x4 __attribute__((ext_vector_type(4)));
typedef unsigned u32x2 __attribute__((ext_vector_type(2)));
typedef _Float16 h16x2 __attribute__((ext_vector_type(2)));
#define LAS __attribute__((address_space(3)))

__device__ __constant__ double ROPE_INVF[32] = {1.0, 0.7498942093324559, 0.5623413251903491, 0.4216965034285822, 0.31622776601683794, 0.23713737056616552, 0.1778279410038923, 0.1333521432163324, 0.1, 0.07498942093324558, 0.05623413251903491, 0.042169650342858224, 0.03162277660168379, 0.023713737056616554, 0.01778279410038923, 0.01333521432163324, 0.01, 0.007498942093324558, 0.005623413251903491, 0.004216965034285823, 0.0031622776601683794, 0.0023713737056616554, 0.0017782794100389228, 0.001333521432163324, 0.001, 0.0007498942093324559, 0.0005623413251903491, 0.00042169650342858224, 0.00031622776601683794, 0.00023713737056616554, 0.00017782794100389227, 0.0001333521432163324};

__device__ __forceinline__ unsigned pk2(float lo, float hi) { return pg8::cvt_pk_bf16(lo, hi); }
__device__ __forceinline__ float silu_f(float g) { return g * __builtin_amdgcn_rcpf(1.0f + __expf(-g)); }
__device__ __forceinline__ float wave_sum(float v) {
#pragma unroll
    for (int o = 1; o < 64; o <<= 1) v += __shfl_xor(v, o);
    return v;
}
__device__ __forceinline__ float half_sum(float v) {
#pragma unroll
    for (int o = 1; o < 32; o <<= 1) v += __shfl_xor(v, o);
    return v;
}

using pg8::Unit;
struct EpiSwiglu { static constexpr bool PERM = true, AFTER_DRAIN = false; bf16_t* O;
    __device__ __forceinline__ void operator()(const pg8::f32x4 (&acc)[2][2][4][2], const Unit& u, int wr, int wc, int fr, int fq) const {
        const int row0 = u.pm * 256 + wr * 64 + fr, col0 = u.pn * 128 + wc * 32 + 8 * fq;
#pragma unroll
        for (int ai = 0; ai < 2; ++ai)
#pragma unroll
            for (int m = 0; m < 4; ++m) { bf16_t* p = O + (size_t)(row0 + ai * 128 + m * 16) * DFF + col0;
                const pg8::f32x4 g0 = acc[ai][0][m][0], g1 = acc[ai][0][m][1], u0 = acc[ai][1][m][0], u1 = acc[ai][1][m][1];
                u32x4 w; w.x = pk2(silu_f(g0[0]) * u0[0], silu_f(g0[1]) * u0[1]); w.y = pk2(silu_f(g0[2]) * u0[2], silu_f(g0[3]) * u0[3]);
                w.z = pk2(silu_f(g1[0]) * u1[0], silu_f(g1[1]) * u1[1]); w.w = pk2(silu_f(g1[2]) * u1[2], silu_f(g1[3]) * u1[3]);
                *(u32x4*)p = w; }
    }
};
struct EpiF32 { static constexpr bool PERM = false, AFTER_DRAIN = false; float* O; int ldc;
    __device__ __forceinline__ void operator()(const pg8::f32x4 (&acc)[2][2][4][2], const Unit& u, int wr, int wc, int fr, int fq) const {
        const int row0 = u.pm * 256 + wr * 64 + fr, col0 = u.pn * 256 + wc * 32 + 4 * fq;
#pragma unroll
        for (int ai = 0; ai < 2; ++ai)
#pragma unroll
            for (int m = 0; m < 4; ++m) { float* p = O + (size_t)(row0 + ai * 128 + m * 16) * ldc + col0;
#pragma unroll
                for (int bj = 0; bj < 2; ++bj)
#pragma unroll
                    for (int n = 0; n < 2; ++n) *(pg8::f32x4*)(p + bj * 128 + n * 16) = acc[ai][bj][m][n]; }
    }
};
struct EpiB16 { static constexpr bool PERM = true, AFTER_DRAIN = false; bf16_t* O; int ldc;
    __device__ __forceinline__ void operator()(const pg8::f32x4 (&acc)[2][2][4][2], const Unit& u, int wr, int wc, int fr, int fq) const {
        const int row0 = u.pm * 256 + wr * 64 + fr, col0 = u.pn * 256 + wc * 32 + 8 * fq;
#pragma unroll
        for (int ai = 0; ai < 2; ++ai)
#pragma unroll
            for (int m = 0; m < 4; ++m) { bf16_t* p = O + (size_t)(row0 + ai * 128 + m * 16) * ldc + col0;
#pragma unroll
                for (int bj = 0; bj < 2; ++bj) { const pg8::f32x4 v0 = acc[ai][bj][m][0], v1 = acc[ai][bj][m][1];
                    u32x4 w; w.x = pk2(v0[0], v0[1]); w.y = pk2(v0[2], v0[3]); w.z = pk2(v1[0], v1[1]); w.w = pk2(v1[2], v1[3]);
                    *(u32x4*)(p + bj * 128) = w; } }
    }
};
struct EpiQ { static constexpr bool PERM = true, AFTER_DRAIN = false; bf16_t* O; const float* cs; const float* sn;
    __device__ __forceinline__ void operator()(const pg8::f32x4 (&acc)[2][2][4][2], const Unit& u, int wr, int wc, int fr, int fq) const {
        const int row0 = u.pm * 256 + wr * 64 + fr;
#pragma unroll
        for (int bj = 0; bj < 2; ++bj) { const int col0 = u.pn * 256 + bj * 128 + wc * 32 + 8 * fq, d = col0 % QKD; const bool rot = d >= 128; const int i0 = (d - 128) >> 1;
#pragma unroll
            for (int ai = 0; ai < 2; ++ai)
#pragma unroll
                for (int m = 0; m < 4; ++m) { const int row = row0 + ai * 128 + m * 16; pg8::f32x4 v0 = acc[ai][bj][m][0], v1 = acc[ai][bj][m][1];
                    if (rot) { const pg8::f32x4 c = *(const pg8::f32x4*)(cs + (size_t)row * 32 + i0), s = *(const pg8::f32x4*)(sn + (size_t)row * 32 + i0);
                        pg8::f32x4 a, b; a[0] = v0[0] * c[0] - v0[1] * s[0]; a[1] = v0[0] * s[0] + v0[1] * c[0]; a[2] = v0[2] * c[1] - v0[3] * s[1]; a[3] = v0[2] * s[1] + v0[3] * c[1];
                        b[0] = v1[0] * c[2] - v1[1] * s[2]; b[1] = v1[0] * s[2] + v1[1] * c[2]; b[2] = v1[2] * c[3] - v1[3] * s[3]; b[3] = v1[2] * s[3] + v1[3] * c[3]; v0 = a; v1 = b; }
                    u32x4 w; w.x = pk2(v0[0], v0[1]); w.y = pk2(v0[2], v0[3]); w.z = pk2(v1[0], v1[1]); w.w = pk2(v1[2], v1[3]);
                    *(u32x4*)(O + (size_t)row * 1536 + col0) = w; } }
    }
};
struct EpiKV { static constexpr bool PERM = true, AFTER_DRAIN = false; bf16_t* Kn; bf16_t* Vb;
    __device__ __forceinline__ void operator()(const pg8::f32x4 (&acc)[2][2][4][2], const Unit& u, int wr, int wc, int fr, int fq) const {
        const int row0 = u.pm * 256 + wr * 64 + fr, col0 = u.pn * 128 + wc * 32 + 8 * fq;
#pragma unroll
        for (int bj = 0; bj < 2; ++bj) { bf16_t* base = bj ? Vb : Kn;
#pragma unroll
            for (int ai = 0; ai < 2; ++ai)
#pragma unroll
                for (int m = 0; m < 4; ++m) { const pg8::f32x4 v0 = acc[ai][bj][m][0], v1 = acc[ai][bj][m][1];
                    u32x4 w; w.x = pk2(v0[0], v0[1]); w.y = pk2(v0[2], v0[3]); w.z = pk2(v1[0], v1[1]); w.w = pk2(v1[2], v1[3]);
                    *(u32x4*)(base + (size_t)(row0 + ai * 128 + m * 16) * 1024 + col0) = w; } }
    }
};
__device__ __forceinline__ unsigned pkh2(float a, float b) { const h16x2 h = {(_Float16)a, (_Float16)b}; return __builtin_bit_cast(unsigned, h); }
__device__ __forceinline__ float kgate(float om, float z) { return om * __builtin_amdgcn_rcpf(1.0f + __expf(z)); }
struct EpiHgrn { static constexpr bool PERM = true, AFTER_DRAIN = false; bf16_t* Qh; bf16_t* Vh; bf16_t* Gh; unsigned short* KF; const float* lb;
    __device__ __forceinline__ void operator()(const pg8::f32x4 (&acc)[2][2][4][2], const Unit& u, int wr, int wc, int fr, int fq) const {
        const int row0 = u.pm * 256 + wr * 64 + fr, seg = u.pn >> 2;
#pragma unroll
        for (int bj = 0; bj < 2; ++bj) { const int cc = (u.pn & 3) * 256 + bj * 128 + wc * 32 + 8 * fq;
            if (seg == 1 || seg == 2) {
                const pg8::f32x4 om0 = 1.0f - *(const pg8::f32x4*)(lb + (seg - 1) * 1024 + cc), om1 = 1.0f - *(const pg8::f32x4*)(lb + (seg - 1) * 1024 + cc + 4);
                unsigned short* base = KF + (size_t)(seg - 1) * MT * 1024;
#pragma unroll
                for (int ai = 0; ai < 2; ++ai)
#pragma unroll
                    for (int m = 0; m < 4; ++m) { const size_t off = (size_t)(row0 + ai * 128 + m * 16) * 1024 + cc; const pg8::f32x4 v0 = acc[ai][bj][m][0], v1 = acc[ai][bj][m][1];
                        u32x4 w; w.x = pkh2(kgate(om0[0], v0[0]), kgate(om0[1], v0[1])); w.y = pkh2(kgate(om0[2], v0[2]), kgate(om0[3], v0[3]));
                        w.z = pkh2(kgate(om1[0], v1[0]), kgate(om1[1], v1[1])); w.w = pkh2(kgate(om1[2], v1[2]), kgate(om1[3], v1[3]));
                        *(u32x4*)(base + off) = w; }
            } else if (seg == 3) {
#pragma unroll
                for (int ai = 0; ai < 2; ++ai)
#pragma unroll
                    for (int m = 0; m < 4; ++m) { const size_t off = (size_t)(row0 + ai * 128 + m * 16) * 1024 + cc; const pg8::f32x4 v0 = acc[ai][bj][m][0], v1 = acc[ai][bj][m][1];
                        u32x4 w; w.x = pk2(v0[0], v0[1]); w.y = pk2(v0[2], v0[3]); w.z = pk2(v1[0], v1[1]); w.w = pk2(v1[2], v1[3]);
                        *(u32x4*)(Vh + off) = w; }
            } else { bf16_t* base = seg == 0 ? Qh : Gh;
#pragma unroll
                for (int ai = 0; ai < 2; ++ai)
#pragma unroll
                    for (int m = 0; m < 4; ++m) { const size_t off = (size_t)(row0 + ai * 128 + m * 16) * 1024 + cc; const pg8::f32x4 v0 = acc[ai][bj][m][0], v1 = acc[ai][bj][m][1];
                        u32x4 w; w.x = pk2(silu_f(v0[0]), silu_f(v0[1])); w.y = pk2(silu_f(v0[2]), silu_f(v0[3])); w.z = pk2(silu_f(v1[0]), silu_f(v1[1])); w.w = pk2(silu_f(v1[2]), silu_f(v1[3]));
                        *(u32x4*)(base + off) = w; } } }
    }
};

__device__ __forceinline__ int src_col(int mode, int n) {
    if (mode == 1) { const int t = n >> 8, j = n & 255; return j < 128 ? t * 128 + j : DFF + t * 128 + (j - 128); }
    if (mode == 2) { if (n < 384) return n; if (n >= 448) return -1; const int j = n - 384; return 384 + (j >> 1) + 32 * (j & 1); }
    if (mode == 3) { const int h = n / QKD, d = n % QKD; if (d < 128) return n; const int j = d - 128; return h * QKD + 128 + (j >> 1) + 32 * (j & 1); }
    return n;
}
__device__ __forceinline__ void xpose_item(const float* __restrict__ W, int K, int Nsrc, int Ndst, int mode, bf16_t* __restrict__ WT, LAS float* scr, int item, int lane) {
    const int nblk = Ndst / 32, kb = item / nblk, nb = item % nblk, k0 = 64 * kb, n0 = 32 * nb;
    if (mode <= 1) {
        const int sc0 = src_col(mode, n0) + (lane & 7) * 4;
#pragma unroll
        for (int i = 0; i < 8; ++i) { const int kk = 8 * i + (lane >> 3); const f32x4 v = *(const f32x4*)(W + (size_t)(k0 + kk) * Nsrc + sc0);
            LAS float* d = scr + kk * 33 + (lane & 7) * 4; d[0] = v[0]; d[1] = v[1]; d[2] = v[2]; d[3] = v[3]; }
    } else {
        const int sc = src_col(mode, n0 + (lane & 31));
#pragma unroll 8
        for (int i = 0; i < 32; ++i) { const int kk = 2 * i + (lane >> 5); scr[kk * 33 + (lane & 31)] = sc >= 0 ? W[(size_t)(k0 + kk) * Nsrc + sc] : 0.f; }
    }
    asm volatile("s_waitcnt lgkmcnt(0)" ::: "memory");
    const int c = lane & 7;
#pragma unroll
    for (int j = 0; j < 4; ++j) { const int n = (lane >> 3) + 8 * j; const LAS float* s = scr + (8 * c) * 33 + n;
        u32x4 o; o.x = pk2(s[0 * 33], s[1 * 33]); o.y = pk2(s[2 * 33], s[3 * 33]); o.z = pk2(s[4 * 33], s[5 * 33]); o.w = pk2(s[6 * 33], s[7 * 33]);
        *(u32x4*)(WT + (size_t)(n0 + n) * K + k0 + 8 * c) = o; }
    asm volatile("s_waitcnt lgkmcnt(0)" ::: "memory");
}

__device__ __forceinline__ unsigned pkh2r(float a, float b) { const h16x2 h = {(_Float16)a, (_Float16)b}; return __builtin_bit_cast(unsigned, h); }
__device__ __forceinline__ f32x4 uph4(u32x2 u) { const unsigned ux = u.x, uy = u.y; const h16x2 a = __builtin_bit_cast(h16x2, ux), b = __builtin_bit_cast(h16x2, uy); return (f32x4){(float)a[0], (float)a[1], (float)b[0], (float)b[1]}; }
__device__ __forceinline__ void row_init(const float* __restrict__ xin, unsigned short* __restrict__ X16, bf16_t* __restrict__ HN, const float* __restrict__ g, int lane) {
    const f32x4* xr = (const f32x4*)xin + lane; f32x4 v[4]; float s = 0.f;
#pragma unroll
    for (int j = 0; j < 4; ++j) { v[j] = __builtin_nontemporal_load(xr + 64 * j); s += (v[j][0] * v[j][0] + v[j][1] * v[j][1]) + (v[j][2] * v[j][2] + v[j][3] * v[j][3]); }
    const float r = rsqrtf(wave_sum(s) * (1.f / DM) + EPS);
#pragma unroll
    for (int j = 0; j < 4; ++j) { u32x2 xh; xh.x = pkh2r(v[j][0], v[j][1]); xh.y = pkh2r(v[j][2], v[j][3]); __builtin_nontemporal_store(xh, (u32x2*)X16 + lane + 64 * j);
        const f32x4 gg = ((const f32x4*)g + lane)[64 * j];
        u32x2 w; w.x = pk2(v[j][0] * r * gg[0], v[j][1] * r * gg[1]); w.y = pk2(v[j][2] * r * gg[2], v[j][3] * r * gg[3]); ((u32x2*)HN + lane)[64 * j] = w; }
}
__device__ __forceinline__ void row_post(const bf16_t* __restrict__ Y, unsigned short* __restrict__ X16, float* __restrict__ Xout, bf16_t* __restrict__ HN, float scale, const float* __restrict__ gp, const float* __restrict__ gn, int lane) {
    f32x4 y[4], x[4]; float s = 0.f;
#pragma unroll
    for (int j = 0; j < 4; ++j) { const u32x2 yb = __builtin_nontemporal_load((const u32x2*)Y + lane + 64 * j); y[j] = (f32x4){__uint_as_float(yb.x << 16), __uint_as_float(yb.x & 0xffff0000u), __uint_as_float(yb.y << 16), __uint_as_float(yb.y & 0xffff0000u)};
        x[j] = uph4(__builtin_nontemporal_load((const u32x2*)X16 + lane + 64 * j)); s += (y[j][0] * y[j][0] + y[j][1] * y[j][1]) + (y[j][2] * y[j][2] + y[j][3] * y[j][3]); }
    const float r = rsqrtf(wave_sum(s) * (1.f / DM) + EPS) * scale; float s2 = 0.f;
#pragma unroll
    for (int j = 0; j < 4; ++j) { const f32x4 gg = ((const f32x4*)gp + lane)[64 * j]; x[j] = x[j] + y[j] * r * gg;
        if (Xout) __builtin_nontemporal_store(x[j], (f32x4*)Xout + lane + 64 * j);
        else { u32x2 xh; xh.x = pkh2r(x[j][0], x[j][1]); xh.y = pkh2r(x[j][2], x[j][3]); __builtin_nontemporal_store(xh, (u32x2*)X16 + lane + 64 * j); }
        s2 += (x[j][0] * x[j][0] + x[j][1] * x[j][1]) + (x[j][2] * x[j][2] + x[j][3] * x[j][3]); }
    if (HN) { const float r2 = rsqrtf(wave_sum(s2) * (1.f / DM) + EPS);
#pragma unroll
        for (int j = 0; j < 4; ++j) { const f32x4 gg = ((const f32x4*)gn + lane)[64 * j];
            u32x2 w; w.x = pk2(x[j][0] * r2 * gg[0], x[j][1] * r2 * gg[1]); w.y = pk2(x[j][2] * r2 * gg[2], x[j][3] * r2 * gg[3]); ((u32x2*)HN + lane)[64 * j] = w; } }
}
__device__ __forceinline__ void row_mla(const float* __restrict__ C, bf16_t* __restrict__ CQ, bf16_t* __restrict__ CKV, bf16_t* __restrict__ KR, const float* __restrict__ qn, const float* __restrict__ kvn,
                                        const float* __restrict__ cs, const float* __restrict__ sn, int lane) {
    const f32x4 a = ((const f32x4*)C)[2 * lane], b = ((const f32x4*)C)[2 * lane + 1];
    float s = (a[0] * a[0] + a[1] * a[1]) + (a[2] * a[2] + a[3] * a[3]) + (b[0] * b[0] + b[1] * b[1]) + (b[2] * b[2] + b[3] * b[3]);
#pragma unroll
    for (int o = 1; o < 16; o <<= 1) s += __shfl_xor(s, o);
    const float s16 = s, s32 = s16 + __shfl_xor(s16, 16);
    float v[8] = {a[0], a[1], a[2], a[3], b[0], b[1], b[2], b[3]};
    if (lane < 32) { const float r = rsqrtf(s32 * (1.f / QLR) + EPS); const f32x4 g0 = ((const f32x4*)qn)[2 * lane], g1 = ((const f32x4*)qn)[2 * lane + 1];
        u32x4 w; w.x = pk2(v[0] * r * g0[0], v[1] * r * g0[1]); w.y = pk2(v[2] * r * g0[2], v[3] * r * g0[3]); w.z = pk2(v[4] * r * g1[0], v[5] * r * g1[1]); w.w = pk2(v[6] * r * g1[2], v[7] * r * g1[3]);
        ((u32x4*)CQ)[lane] = w;
    } else if (lane < 48) { const int l = lane - 32; const float r = rsqrtf(s16 * (1.f / KVLR) + EPS); const f32x4 g0 = ((const f32x4*)kvn)[2 * l], g1 = ((const f32x4*)kvn)[2 * l + 1];
        u32x4 w; w.x = pk2(v[0] * r * g0[0], v[1] * r * g0[1]); w.y = pk2(v[2] * r * g0[2], v[3] * r * g0[3]); w.z = pk2(v[4] * r * g1[0], v[5] * r * g1[1]); w.w = pk2(v[6] * r * g1[2], v[7] * r * g1[3]);
        ((u32x4*)CKV)[l] = w;
    } else if (lane < 56) { const int l = lane - 48; const f32x4 c = ((const f32x4*)cs)[l], sv = ((const f32x4*)sn)[l];
        u32x4 w; w.x = pk2(v[0] * c[0] - v[1] * sv[0], v[0] * sv[0] + v[1] * c[0]); w.y = pk2(v[2] * c[1] - v[3] * sv[1], v[2] * sv[1] + v[3] * c[1]);
        w.z = pk2(v[4] * c[2] - v[5] * sv[2], v[4] * sv[2] + v[5] * c[2]); w.w = pk2(v[6] * c[3] - v[7] * sv[3], v[6] * sv[3] + v[7] * c[3]);
        ((u32x4*)KR)[l] = w; }
}
__device__ __forceinline__ void row_hgrn(const bf16_t* __restrict__ Oa, const bf16_t* __restrict__ Gh, bf16_t* __restrict__ HO, const float* __restrict__ on, int lane) {
#pragma unroll
    for (int j = 0; j < 4; ++j) { const u32x2 a = ((const u32x2*)Oa + lane)[64 * j], b = ((const u32x2*)(Oa + (size_t)MT * 1024) + lane)[64 * j];
        f32x4 o; o[0] = __uint_as_float(a.x << 16) + __uint_as_float(b.x << 16); o[1] = __uint_as_float(a.x & 0xffff0000u) + __uint_as_float(b.x & 0xffff0000u);
        o[2] = __uint_as_float(a.y << 16) + __uint_as_float(b.y << 16); o[3] = __uint_as_float(a.y & 0xffff0000u) + __uint_as_float(b.y & 0xffff0000u);
        const float s = half_sum((o[0] * o[0] + o[1] * o[1]) + (o[2] * o[2] + o[3] * o[3]));
        const float r = rsqrtf(s * (1.f / 128.f) + EPS); const f32x4 gg = ((const f32x4*)on + lane)[64 * j]; const u32x2 gb = ((const u32x2*)Gh + lane)[64 * j];
        const float g0 = __uint_as_float(gb.x << 16), g1 = __uint_as_float(gb.x & 0xffff0000u), g2 = __uint_as_float(gb.y << 16), g3 = __uint_as_float(gb.y & 0xffff0000u);
        u32x2 w; w.x = pk2(o[0] * r * gg[0] * g0, o[1] * r * gg[1] * g1); w.y = pk2(o[2] * r * gg[2] * g2, o[3] * r * gg[3] * g3); ((u32x2*)HO + lane)[64 * j] = w; }
}
__device__ __forceinline__ f32x2 h2f2_(unsigned u) { const h16x2 h = __builtin_bit_cast(h16x2, u); return (f32x2){(float)h[0], (float)h[1]}; }
__device__ __forceinline__ void scan_phase(LAS unsigned char* lds, const bf16_t* __restrict__ Qh, const bf16_t* __restrict__ Vh, const unsigned short* __restrict__ KF, bf16_t* __restrict__ OP, int G, int bx) {
    int tid = threadIdx.x; asm volatile("" : "+v"(tid)); const int wid = __builtin_amdgcn_readfirstlane(tid >> 6), lane = tid & 63;
    const int st = tid >> 4, sc8 = (tid & 15) * 8, sv = tid >> 3, vc4 = (tid & 7) * 4;
    constexpr int OFF_K = 16384, OFF_Q = 32768, OFF_V = 49152, OFF_P = 53248;
    for (int item = bx; item < 256; item += G) {
        const int dir = item & 1, dvq = (item >> 1) & 3, h = (item >> 3) & 7, b = item >> 6;
        const size_t kcol = h * 128 + sc8, vcol = h * 128 + dvq * 32 + vc4;
        const unsigned short* KFd = KF + (size_t)dir * MT * 1024; bf16_t* OPd = OP + (size_t)dir * MT * 1024;
        u32x4 rk, rq; u32x2 rv = {0u, 0u};
#define SC_GLOAD(blk) do { { const int tt = (blk) * 32 + st; const size_t m = (size_t)b * SEQ + (dir ? SEQ - 1 - tt : tt); \
        rk = *(const u32x4*)(KFd + m * 1024 + kcol); rq = *(const u32x4*)(Qh + m * 1024 + kcol); } \
        if (tid < 256) { const int tt = (blk) * 32 + sv; const size_t m = (size_t)b * SEQ + (dir ? SEQ - 1 - tt : tt); rv = *(const u32x2*)(Vh + m * 1024 + vcol); } } while (0)
#define SC_H2F(u_) h2f2_(u_)
#define SC_LWRITE() do { LAS unsigned char* B_ = lds + (st * 128 + sc8) * 4; \
        const f32x2 ka = SC_H2F(rk.x), kb = SC_H2F(rk.y), kc = SC_H2F(rk.z), kd = SC_H2F(rk.w); \
        const f32x4 k0_ = {ka[0], ka[1], kb[0], kb[1]}, k1_ = {kc[0], kc[1], kd[0], kd[1]}; \
        *(LAS f32x4*)(B_ + OFF_K) = k0_; *(LAS f32x4*)(B_ + OFF_K + 16) = k1_; \
        *(LAS f32x4*)(B_ + OFF_Q) = (f32x4){__uint_as_float(rq.x << 16), __uint_as_float(rq.x & 0xffff0000u), __uint_as_float(rq.y << 16), __uint_as_float(rq.y & 0xffff0000u)}; \
        *(LAS f32x4*)(B_ + OFF_Q + 16) = (f32x4){__uint_as_float(rq.z << 16), __uint_as_float(rq.z & 0xffff0000u), __uint_as_float(rq.w << 16), __uint_as_float(rq.w & 0xffff0000u)}; \
        if (tid < 256) *(LAS f32x4*)(lds + OFF_V + (sv * 32 + vc4) * 4) = (f32x4){__uint_as_float(rv.x << 16), __uint_as_float(rv.x & 0xffff0000u), __uint_as_float(rv.y << 16), __uint_as_float(rv.y & 0xffff0000u)}; } while (0)
        SC_GLOAD(0);
        const int dksub = ((lane >> 3) & 1) | ((lane >> 5) << 1), dvp = (lane & 7) | (((lane >> 4) & 1) << 3);
        const LAS unsigned char* Bc = lds + (16 * wid + 4 * dksub) * 4;
        const LAS unsigned char* Vc = lds + OFF_V + dvp * 8;
        LAS unsigned char* Pw = lds + OFF_P + (wid * 4 + dksub) * 2048 + dvp * 4;
        f32x2 S2[4];
#pragma unroll
        for (int j = 0; j < 4; ++j) S2[j] = (f32x2){0.f, 0.f};
        for (int blk = 0; blk < SEQ / 32; ++blk) {
            SC_LWRITE();
            if (blk + 1 < SEQ / 32) SC_GLOAD(blk + 1);
            __syncthreads();
            f32x4 k4n = *(const LAS f32x4*)(Bc + OFF_K), q4n = *(const LAS f32x4*)(Bc + OFF_Q); f32x2 v2n = *(const LAS f32x2*)(Vc);
            f32x4 k4m = *(const LAS f32x4*)(Bc + OFF_K + 512), q4m = *(const LAS f32x4*)(Bc + OFF_Q + 512); f32x2 v2m = *(const LAS f32x2*)(Vc + 128);
#pragma unroll
            for (int t = 0; t < 32; ++t) {
                const f32x4 k4 = k4n, q4 = q4n; const f32x2 v2 = v2n;
                k4n = k4m; q4n = q4m; v2n = v2m;
                { const int tn = (t + 2) & 31;
                  k4m = *(const LAS f32x4*)(Bc + OFF_K + tn * 512); q4m = *(const LAS f32x4*)(Bc + OFF_Q + tn * 512); v2m = *(const LAS f32x2*)(Vc + tn * 128); }
                __builtin_amdgcn_sched_barrier(0);
#pragma unroll
                for (int j = 0; j < 4; ++j) S2[j] = S2[j] + (v2 - S2[j]) * k4[j];
                const f32x2 o2 = (S2[0] * q4[0] + S2[1] * q4[1]) + (S2[2] * q4[2] + S2[3] * q4[3]);
                *(LAS unsigned*)(Pw + t * 64) = pk2(o2[0], o2[1]);
            }
            __syncthreads();
            if (tid < 256) { const LAS unsigned char* Pr = lds + OFF_P + (sv * 32 + vc4) * 2; f32x4 acc = {0.f, 0.f, 0.f, 0.f};
#pragma unroll
              for (int g = 0; g < 32; ++g) { const u32x2 pv = *(const LAS u32x2*)(Pr + g * 2048);
                  acc[0] += __uint_as_float(pv.x << 16); acc[1] += __uint_as_float(pv.x & 0xffff0000u); acc[2] += __uint_as_float(pv.y << 16); acc[3] += __uint_as_float(pv.y & 0xffff0000u); }
              const int tt = blk * 32 + sv; const size_t m = (size_t)b * SEQ + (dir ? SEQ - 1 - tt : tt);
              u32x2 w; w.x = pk2(acc[0], acc[1]); w.y = pk2(acc[2], acc[3]); *(u32x2*)(OPd + m * 1024 + vcol) = w; }
        }
        __syncthreads();
#undef SC_GLOAD
#undef SC_LWRITE
#undef SC_H2F
    }
}

typedef float f32x16 __attribute__((ext_vector_type(16)));
typedef short s16x8 __attribute__((ext_vector_type(8)));
__device__ __forceinline__ int crow_(int r, int hi) { return (r & 3) + 8 * (r >> 2) + 4 * hi; }
template <int KSTEPS, int I0 = 0>
__device__ __forceinline__ void mm_tile(f32x16& c, const LAS unsigned char* X, int xstride, const LAS unsigned char* Y, int ystride, int r32, int hi) {
#pragma unroll
    for (int i = I0; i < I0 + KSTEPS; ++i) { const s16x8 x = *(const LAS s16x8*)(X + r32 * xstride + (16 * i + 8 * hi) * 2), y = *(const LAS s16x8*)(Y + r32 * ystride + (16 * i + 8 * hi) * 2);
        c = __builtin_amdgcn_mfma_f32_32x32x16_bf16(x, y, c, 0, 0, 0); }
}
__device__ __forceinline__ void scan_phase_mfma(LAS unsigned char* lds, const bf16_t* __restrict__ Qh, const bf16_t* __restrict__ Vh, const unsigned short* __restrict__ KF, bf16_t* __restrict__ OP, int G, int bx) {
    int tid = threadIdx.x; asm volatile("" : "+v"(tid)); const int wid = __builtin_amdgcn_readfirstlane(tid >> 6), lane = tid & 63, r32 = lane & 31, hi = lane >> 5;
    const bool grpA = wid < 4;
    const int st = (tid >> 3) & 31, sc16 = (tid & 7) * 16, vc4 = (tid & 7) * 4;
    constexpr int SQ = 272, SV = 80, NC = SEQ / 32;
    constexpr int IMG = 2 * 32 * SQ + 128 * SV + 128 + 32 * SV + 512;
    constexpr int O_LG = 0, O_IMG = 16384, O_AT = O_IMG + 2 * IMG, O_ST = O_AT + 32 * SV;
    constexpr int I_QT = 0, I_KT = 32 * SQ, I_KTT = 2 * 32 * SQ, I_VT = I_KTT + 128 * SV + 128, I_G = I_VT + 32 * SV;
    static_assert(O_ST + 32 * SQ <= LDS_RING && IMG % 16 == 0, "scan LDS map");
    for (int item = bx; item < 256; item += G) {
        const int dir = item & 1, dvq = (item >> 1) & 3, h = (item >> 3) & 7, b = item >> 6;
        const size_t kcol = h * 128 + sc16, vcol = h * 128 + dvq * 32 + vc4;
        const unsigned short* KFd = KF + (size_t)dir * MT * 1024; bf16_t* OPd = OP + (size_t)dir * MT * 1024;
        u32x4 rk0, rk1, rq0, rq1; u32x2 rv;
#define SM_GLOAD(blk) do { const int tt = (blk) * 32 + st; const size_t m = (size_t)b * SEQ + (dir ? SEQ - 1 - tt : tt); \
        rk0 = *(const u32x4*)(KFd + m * 1024 + kcol); rk1 = *(const u32x4*)(KFd + m * 1024 + kcol + 8); rq0 = *(const u32x4*)(Qh + m * 1024 + kcol); rq1 = *(const u32x4*)(Qh + m * 1024 + kcol + 8); \
        rv = *(const u32x2*)(Vh + m * 1024 + vcol); } while (0)
        if (grpA) SM_GLOAD(0);
        f32x16 accS, accO;
#pragma unroll
        for (int r = 0; r < 16; ++r) { accS[r] = 0.f; accO[r] = 0.f; }
        for (int i = tid; i < 32 * SQ / 4; i += 512) ((LAS unsigned*)(lds + O_ST))[i] = 0u;
        __syncthreads();
        for (int rd = -1; rd < NC; ++rd) {
            const int cn = rd + 1;
            LAS unsigned char* Wi = lds + O_IMG + (cn & 1) * IMG;
            const LAS unsigned char* Ri = lds + O_IMG + (rd & 1) * IMG;
            float kf[16];
            if (grpA) { if (cn < NC) {
                { const f32x2 a = h2f2_(rk0.x), bq = h2f2_(rk0.y), c = h2f2_(rk0.z), d = h2f2_(rk0.w), e = h2f2_(rk1.x), f = h2f2_(rk1.y), g2 = h2f2_(rk1.z), h2 = h2f2_(rk1.w);
                  kf[0] = a[0]; kf[1] = a[1]; kf[2] = bq[0]; kf[3] = bq[1]; kf[4] = c[0]; kf[5] = c[1]; kf[6] = d[0]; kf[7] = d[1];
                  kf[8] = e[0]; kf[9] = e[1]; kf[10] = f[0]; kf[11] = f[1]; kf[12] = g2[0]; kf[13] = g2[1]; kf[14] = h2[0]; kf[15] = h2[1]; }
                LAS unsigned char* L_ = lds + O_LG + (st * 128 + sc16) * 4;
#pragma unroll
                for (int q4 = 0; q4 < 4; ++q4) { f32x4 a4;
#pragma unroll
                    for (int e = 0; e < 4; ++e) a4[e] = 1.0f - kf[4 * q4 + e];
                    *(LAS f32x4*)(L_ + 16 * q4) = a4; }
                LAS unsigned char* V_ = Wi + I_VT + st * 2;
                *(LAS unsigned short*)(V_ + (vc4 + 0) * SV) = (unsigned short)(rv.x & 0xffffu); *(LAS unsigned short*)(V_ + (vc4 + 1) * SV) = (unsigned short)(rv.x >> 16);
                *(LAS unsigned short*)(V_ + (vc4 + 2) * SV) = (unsigned short)(rv.y & 0xffffu); *(LAS unsigned short*)(V_ + (vc4 + 3) * SV) = (unsigned short)(rv.y >> 16);
            } } else if (rd >= 0) {
                const int w4 = wid - 4;
                mm_tile<2>(accS, Ri + I_KTT + w4 * 32 * SV + (2 * w4 + (r32 >> 4)) * 16, SV, Ri + I_VT, SV, r32, hi);
                if (w4 == 0) { f32x16 pa, pb;
#pragma unroll
                    for (int r = 0; r < 16; ++r) { pa[r] = 0.f; pb[r] = 0.f; }
                    mm_tile<4, 0>(pa, Ri + I_KT, SQ, Ri + I_QT, SQ, r32, hi); mm_tile<4, 4>(pb, Ri + I_KT, SQ, Ri + I_QT, SQ, r32, hi);
#pragma unroll
                    for (int g = 0; g < 4; ++g) { const int s0 = 8 * g + 4 * hi; float v4[4];
#pragma unroll
                        for (int e = 0; e < 4; ++e) v4[e] = (s0 + e) <= r32 ? pa[4 * g + e] + pb[4 * g + e] : 0.f;
                        u32x2 w; w.x = pk2(v4[0], v4[1]); w.y = pk2(v4[2], v4[3]); *(LAS u32x2*)(lds + O_AT + r32 * SV + s0 * 2) = w; } }
                else if (w4 == 1) { f32x16 ob;
#pragma unroll
                    for (int r = 0; r < 16; ++r) { accO[r] = 0.f; ob[r] = 0.f; }
                    mm_tile<4, 0>(accO, lds + O_ST, SQ, Ri + I_QT, SQ, r32, hi); mm_tile<4, 4>(ob, lds + O_ST, SQ, Ri + I_QT, SQ, r32, hi);
#pragma unroll
                    for (int r = 0; r < 16; ++r) accO[r] += ob[r]; }
            }
            __syncthreads();
            if (grpA) { if (cn < NC) {
                if (tid < 128) { LAS float* col = (LAS float*)(lds + O_LG) + tid; float fv[32];
#pragma unroll
                    for (int t = 0; t < 32; ++t) fv[t] = col[t * 128];
                    float acc = 1.f;
#pragma unroll
                    for (int t = 0; t < 32; ++t) { acc *= fv[t]; col[t * 128] = acc; } }
            } } else if (rd >= 0) {
                const int w4 = wid - 4;
                if (w4 == 1) { mm_tile<2>(accO, Ri + I_VT, SV, lds + O_AT, SV, r32, hi);
                    asm volatile("s_nop 15\n\ts_nop 7" : "+v"(accO));
                    const int tt = rd * 32 + r32; const size_t m = (size_t)b * SEQ + (dir ? SEQ - 1 - tt : tt); bf16_t* orow = OPd + m * 1024 + h * 128 + dvq * 32;
#pragma unroll
                    for (int g = 0; g < 4; ++g) { u32x2 w; w.x = pk2(accO[4 * g + 0], accO[4 * g + 1]); w.y = pk2(accO[4 * g + 2], accO[4 * g + 3]); *(u32x2*)(orow + 8 * g + 4 * hi) = w; } }
            }
            __syncthreads();
            if (grpA) { if (cn < NC)
#ifdef REP_A3
            for (int rep_ = 0; rep_ < 2; ++rep_)
#endif
            {
                const LAS unsigned char* L_ = lds + O_LG + (st * 128 + sc16) * 4; float bb[16];
#pragma unroll
                for (int q4 = 0; q4 < 4; ++q4) { const f32x4 t4 = *(const LAS f32x4*)(L_ + 16 * q4); bb[4 * q4] = t4[0]; bb[4 * q4 + 1] = t4[1]; bb[4 * q4 + 2] = t4[2]; bb[4 * q4 + 3] = t4[3]; }
                const unsigned qraw[8] = {rq0.x, rq0.y, rq0.z, rq0.w, rq1.x, rq1.y, rq1.z, rq1.w};
                unsigned qw[8], kw[8];
#pragma unroll
                for (int e = 0; e < 8; ++e) { const float e0 = bb[2 * e], e1 = bb[2 * e + 1];
                    qw[e] = pk2(__uint_as_float(qraw[e] << 16) * e0, __uint_as_float(qraw[e] & 0xffff0000u) * e1);
                    kw[e] = pk2(kf[2 * e] * __builtin_amdgcn_rcpf(e0), kf[2 * e + 1] * __builtin_amdgcn_rcpf(e1));
                    if (st == 31) { ((LAS float*)(Wi + I_G))[sc16 + 2 * e] = e0; ((LAS float*)(Wi + I_G))[sc16 + 2 * e + 1] = e1; } }
                *(LAS u32x4*)(Wi + I_QT + st * SQ + sc16 * 2) = (u32x4){qw[0], qw[1], qw[2], qw[3]}; *(LAS u32x4*)(Wi + I_QT + st * SQ + sc16 * 2 + 16) = (u32x4){qw[4], qw[5], qw[6], qw[7]};
                *(LAS u32x4*)(Wi + I_KT + st * SQ + sc16 * 2) = (u32x4){kw[0], kw[1], kw[2], kw[3]}; *(LAS u32x4*)(Wi + I_KT + st * SQ + sc16 * 2 + 16) = (u32x4){kw[4], kw[5], kw[6], kw[7]};
                LAS unsigned char* T_ = Wi + I_KTT + sc16 * SV + (sc16 >> 4) * 16 + st * 2;
#pragma unroll
                for (int e = 0; e < 8; ++e) { *(LAS unsigned short*)(T_ + (2 * e) * SV) = (unsigned short)(kw[e] & 0xffffu); *(LAS unsigned short*)(T_ + (2 * e + 1) * SV) = (unsigned short)(kw[e] >> 16); }
            }
                if (cn + 1 < NC) SM_GLOAD(cn + 1);
            } else if (rd >= 0) {
                const int w4 = wid - 4;
#pragma unroll
                for (int g = 0; g < 4; ++g) { const int dk0 = 32 * w4 + 8 * g + 4 * hi; const f32x4 gm = *(const LAS f32x4*)(Ri + I_G + dk0 * 4);
                    accS[4 * g + 0] *= gm[0]; accS[4 * g + 1] *= gm[1]; accS[4 * g + 2] *= gm[2]; accS[4 * g + 3] *= gm[3];
                    u32x2 w; w.x = pk2(accS[4 * g + 0], accS[4 * g + 1]); w.y = pk2(accS[4 * g + 2], accS[4 * g + 3]);
                    *(LAS u32x2*)(lds + O_ST + r32 * SQ + dk0 * 2) = w; }
            }
            __syncthreads();
        }
#undef SM_GLOAD
    }
}

enum Op { OP_SW0, OP_FO0, OP_RPA, OP_MIN, OP_RMLA, OP_QKV, OP_ATTN, OP_MWO, OP_RPB, OP_SW1, OP_FO1, OP_RPC, OP_HIN, OP_SCAN, OP_RHG, OP_HWO };
__device__ const unsigned char OPS_M[12] = {OP_SW0, OP_FO0, OP_RPA, OP_MIN, OP_RMLA, OP_QKV, OP_ATTN, OP_MWO, OP_RPB, OP_SW1, OP_FO1, OP_RPC};
__device__ const unsigned char OPS_H[11] = {OP_SW0, OP_FO0, OP_RPA, OP_HIN, OP_SCAN, OP_RHG, OP_HWO, OP_RPB, OP_SW1, OP_FO1, OP_RPC};

struct Args { const float* in[15]; float* out; unsigned char* ws; };
typedef const __attribute__((address_space(4))) Args* ArgsP;
__device__ __forceinline__ ArgsP get_args() { ArgsP p = (ArgsP)__builtin_amdgcn_kernarg_segment_ptr(); asm volatile("" : "+s"(p) :: "memory"); return p; }
#define GW_ ((int)blockIdx.x * 8 + __builtin_amdgcn_readfirstlane((int)threadIdx.x >> 6))
#define NGW_ ((int)gridDim.x * 8)
__device__ __forceinline__ int otid_() { int t = threadIdx.x; asm volatile("" : "+v"(t)); return t; }
#define LANE_ (otid_() & 63)

#ifdef DBG_CHECKS
__device__ __forceinline__ float bf2f(bf16_t v) { return __uint_as_float((unsigned)v << 16); }
__device__ __forceinline__ unsigned hash_u(unsigned x) { x ^= x >> 16; x *= 0x7feb352du; x ^= x >> 15; x *= 0x846ca68bu; x ^= x >> 16; return x; }
__device__ __forceinline__ void dbg_report(unsigned* DBG, int id, float got, float ref, float rtol, float atol) {
    const float err = fabsf(got - ref); const bool bad = !(err <= rtol * fabsf(ref) + atol);
    if (bad) atomicMax(DBG + id, 1u);
}
__device__ __forceinline__ int dbg_row(int sidx) { if (sidx == 0) return 0; if (sidx == 1) return MT - 1; if (sidx == 2) return SEQ - 1; if (sidx == 3) return SEQ; return (int)(hash_u(sidx * 2654435761u + 17u) % MT); }
#endif
#ifdef DBG_CHECKS
struct DbgCtx { const float* const* in; unsigned char* ws; unsigned char* R; unsigned* DBG; int bx, tid, lane, wave; };
__device__ __forceinline__ float dbg_dot_bf_w(const bf16_t* a, const float* W, int K, int ldw, int col) { float s = 0.f; for (int k = 0; k < K; ++k) s += bf2f(a[k]) * W[(size_t)k * ldw + col]; return s; }
template <class A>
__device__ __forceinline__ void dbg_after(int l, int op, A ap, unsigned char* ws, unsigned char* R, LAS unsigned char* lds) {
    unsigned* DBG = (unsigned*)(ws + 32768);
    const int bx = blockIdx.x, tid = otid_(), lane = tid & 63, wave = __builtin_amdgcn_readfirstlane(tid >> 6);
    const bf16_t* HN = (const bf16_t*)(ws + WS_HN); const float* Y = (const float*)(ws + WS_Y);
    if (false && l == 0 && op == OP_SW0 && bx < 32) { const int sid = bx * 512 + tid, m = dbg_row(sid), c = hash_u(sid * 3 + 1) % DFF; const float* W = ap->in[3];
        const float g = dbg_dot_bf_w(HN + (size_t)m * 1024, W, 1024, 2 * DFF, c), u = dbg_dot_bf_w(HN + (size_t)m * 1024, W, 1024, 2 * DFF, DFF + c);
        dbg_report(DBG, 1, bf2f(((const bf16_t*)(R + R_ACT))[(size_t)m * DFF + c]), g / (1.f + expf(-g)) * u, 0.015f, 0.004f); }
    if (false && l == 0 && op == OP_FO0 && bx < 32) { const int sid = bx * 512 + tid, m = dbg_row(sid), c = hash_u(sid * 3 + 2) % 1024;
        const float r = dbg_dot_bf_w((const bf16_t*)(R + R_ACT) + (size_t)m * DFF, ap->in[4], DFF, 1024, c);
        dbg_report(DBG, 2, Y[(size_t)m * 1024 + c], r, 0.015f, 0.004f); }
    if (false && l == 0 && op == OP_RPA && bx < 32) { const int sid = bx * 512 + tid, m = dbg_row(sid), c = hash_u(sid * 3 + 3) % 1024; const float* g = ap->in[2];
        float s = 0.f; for (int k = 0; k < 1024; ++k) { const float y = Y[(size_t)m * 1024 + k]; s += y * y; }
        const float xr = ap->in[0][(size_t)m * 1024 + c] + 0.5f * Y[(size_t)m * 1024 + c] * rsqrtf(s / 1024.f + EPS) * g[1024 + c];
        dbg_report(DBG, 2, ap->out[(size_t)m * 1024 + c], xr, 1e-3f, 1e-3f);
        float s2 = 0.f; for (int k = 0; k < 1024; ++k) { const float x = ap->out[(size_t)m * 1024 + k]; s2 += x * x; }
        dbg_report(DBG, 2, bf2f(HN[(size_t)m * 1024 + c]), ap->out[(size_t)m * 1024 + c] * rsqrtf(s2 / 1024.f + EPS) * g[2048 + c], 0.01f, 0.01f); }
    if (false && l == 0 && op == OP_MIN && bx < 32) { const int sid = bx * 512 + tid, m = dbg_row(sid), c = hash_u(sid * 3 + 4) % 512; const int sc = src_col(2, c);
        const float r = sc >= 0 ? dbg_dot_bf_w(HN + (size_t)m * 1024, ap->in[5], 1024, 448, sc) : 0.f;
        dbg_report(DBG, 3, ((const float*)(R + R_C))[(size_t)m * 512 + c], r, 0.015f, 0.01f); }
    if (false && l == 0 && op == OP_RMLA && bx < 32) { const int sid = bx * 512 + tid, m = dbg_row(sid), c = hash_u(sid * 3 + 5) % 448; const float* C = (const float*)(R + R_C) + (size_t)m * 512;
        if (c < 256) { float s = 0.f; for (int k = 0; k < 256; ++k) s += C[k] * C[k];
            dbg_report(DBG, 3, bf2f(((const bf16_t*)(R + R_CQ))[(size_t)m * 256 + c]), C[c] * rsqrtf(s / 256.f + EPS) * ap->in[6][c], 0.01f, 0.01f); }
        else if (c < 384) { float s = 0.f; for (int k = 256; k < 384; ++k) s += C[k] * C[k];
            dbg_report(DBG, 3, bf2f(((const bf16_t*)(R + R_CKV))[(size_t)m * 128 + c - 256]), C[c] * rsqrtf(s / 128.f + EPS) * ap->in[7][c - 256], 0.01f, 0.01f); }
        else { const int jj = c - 384, i = jj >> 1; const float ang = (float)((const int*)ap->in[1])[m] * powf(10000.f, -(float)i / 32.f); const float cs = cosf(ang), sn = sinf(ang);
            const float t1 = C[384 + 2 * i], t2 = C[384 + 2 * i + 1]; const float r = (jj & 1) ? t1 * sn + t2 * cs : t1 * cs - t2 * sn;
            dbg_report(DBG, 3, bf2f(((const bf16_t*)(R + R_KR))[(size_t)m * 64 + jj]), r, 0.02f, 0.05f); } }
    if (false && l == 0 && op == OP_QKV && bx < 32) { const int sid = bx * 512 + tid, m = dbg_row(sid); const bf16_t* CQ = (const bf16_t*)(R + R_CQ) + (size_t)m * 256; const bf16_t* CKV = (const bf16_t*)(R + R_CKV) + (size_t)m * 128;
        { const int c = hash_u(sid * 3 + 6) % 1536, h = c / QKD, d = c % QKD; float r;
          if (d < 128) r = dbg_dot_bf_w(CQ, ap->in[8], 256, 1536, c);
          else { const int jj = d - 128, i = jj >> 1; const float t1 = dbg_dot_bf_w(CQ, ap->in[8], 256, 1536, h * QKD + 128 + i), t2 = dbg_dot_bf_w(CQ, ap->in[8], 256, 1536, h * QKD + 160 + i);
              const float ang = (float)((const int*)ap->in[1])[m] * powf(10000.f, -(float)i / 32.f); const float cs = cosf(ang), sn = sinf(ang); r = (jj & 1) ? t1 * sn + t2 * cs : t1 * cs - t2 * sn; }
          dbg_report(DBG, 4, bf2f(((const bf16_t*)(R + R_QB))[(size_t)m * 1536 + c]), r, 0.015f, 0.015f); }
        { const int c = hash_u(sid * 3 + 7) % 2048, h = c >> 8, d = c & 255; const float r = dbg_dot_bf_w(CKV, ap->in[9], 128, 2048, c);
          const float got = d < 128 ? bf2f(((const bf16_t*)(R + R_KN))[(size_t)m * 1024 + h * 128 + d]) : bf2f(((const bf16_t*)(R + R_VB))[(size_t)m * 1024 + h * 128 + d - 128]);
          dbg_report(DBG, 5, got, r, 0.015f, 0.015f); } }
    if (l == 0 && op == OP_ATTN) { const int sid = bx * 8 + wave, m = dbg_row(sid), h = hash_u(sid * 5 + 1) & 7, dv = hash_u(sid * 5 + 2) & 127, b = m / SEQ;
        LAS float* qs = (LAS float*)lds + wave * 192; const bf16_t* Q = (const bf16_t*)(R + R_QB) + (size_t)m * 1536 + h * QKD;
        for (int d = lane; d < 192; d += 64) qs[d] = bf2f(Q[d]);
        asm volatile("s_waitcnt lgkmcnt(0)" ::: "memory");
        float mx = -1e30f, ls = 0.f, acc = 0.f;
        for (int kk = lane; kk < SEQ; kk += 64) { const size_t km = (size_t)b * SEQ + kk; const bf16_t* Kn = (const bf16_t*)(R + R_KN) + km * 1024 + h * 128; const bf16_t* Kr = (const bf16_t*)(R + R_KR) + km * 64;
            float s = 0.f; for (int d = 0; d < 128; ++d) s += qs[d] * bf2f(Kn[d]); for (int d = 0; d < 64; ++d) s += qs[128 + d] * bf2f(Kr[d]);
            s *= 0.07216878364870322f; const float v = bf2f(((const bf16_t*)(R + R_VB))[km * 1024 + h * 128 + dv]);
            const float mn = fmaxf(mx, s), al = expf(mx - mn), p = expf(s - mn); ls = ls * al + p; acc = acc * al + p * v; mx = mn; }
        float gm = mx;
        for (int o = 1; o < 64; o <<= 1) gm = fmaxf(gm, __shfl_xor(gm, o));
        const float sc = expf(mx - gm); const float L = wave_sum(ls * sc), Asum = wave_sum(acc * sc);
        if (lane == 0) { const float got = bf2f(((const bf16_t*)(R + R_O))[(size_t)m * 1024 + h * 128 + dv]), ref = Asum / L; atomicMax(DBG + 20, __float_as_uint(fabsf(got - ref))); atomicAdd((float*)(DBG + 21), fabsf(ref) * (1.f / 2048.f)); } }
    if (false && l == 1 && op == OP_HIN && bx < 32) { const int sid = bx * 512 + tid, m = dbg_row(sid), c5 = hash_u(sid * 3 + 8) % 5120, seg = c5 >> 10, c = c5 & 1023;
        const float u = dbg_dot_bf_w(HN + (size_t)m * 1024, ap->in[11], 1024, 5120, c5); float got, r;
        if (seg == 0) { got = bf2f(((const bf16_t*)(R + R_QH))[(size_t)m * 1024 + c]); r = u / (1.f + expf(-u)); }
        else if (seg == 3) { got = bf2f(((const bf16_t*)(R + R_VH))[(size_t)m * 1024 + c]); r = u; }
        else if (seg == 4) { got = bf2f(((const bf16_t*)(R + R_GH))[(size_t)m * 1024 + c]); r = u / (1.f + expf(-u)); }
        else { const int dir = seg - 1; const float* lbp = ap->in[12] + (size_t)dir * DEPTH * 1024 + c; const float e0 = expf(lbp[0]), e1 = expf(lbp[1024]), e2 = expf(lbp[2048]), e3 = expf(lbp[3072]);
            const float lb = e1 / (e0 + e1 + e2 + e3); const h16x2 hv = __builtin_bit_cast(h16x2, (unsigned)((const unsigned short*)(R + R_KF))[(size_t)dir * MT * 1024 + (size_t)m * 1024 + c]);
            got = (float)hv[0]; r = (1.f - lb) / (1.f + expf(u)); }
        dbg_report(DBG, 7, got, r, 0.015f, 0.006f); }
    if (false && l == 1 && op == OP_SCAN) { const int sid = bx * 8 + wave, h = hash_u(sid * 5 + 3) & 7, dv = hash_u(sid * 5 + 4) & 127, b = hash_u(sid * 5 + 5) & 3, toff = sid & 31, dir = 0;
        const bf16_t* Qh = (const bf16_t*)(R + R_QH); const bf16_t* Vh = (const bf16_t*)(R + R_VH); const unsigned short* KF = (const unsigned short*)(R + R_KF); const bf16_t* OPb = (const bf16_t*)(ws + WS_Y);
        float S0 = 0.f, S1 = 0.f; const int n = toff + 1; const int t = toff; const size_t m = (size_t)b * SEQ + t;
        for (int i = 0; i < n; ++i) { const int tt = i; const size_t mm = (size_t)b * SEQ + tt; const unsigned short* kp = KF + (size_t)dir * MT * 1024 + mm * 1024 + h * 128;
            const h16x2 ka = __builtin_bit_cast(h16x2, (unsigned)kp[lane]), kb = __builtin_bit_cast(h16x2, (unsigned)kp[lane + 64]); const float k0 = (float)ka[0], k1 = (float)kb[0];
            const float v = bf2f(Vh[mm * 1024 + h * 128 + dv]); S0 = S0 * (1.f - k0) + k0 * v; S1 = S1 * (1.f - k1) + k1 * v; }
        const bf16_t* q = Qh + m * 1024 + h * 128; const float tot = wave_sum(S0 * bf2f(q[lane]) + S1 * bf2f(q[lane + 64]));
        if (lane == 0) { const float got = bf2f(OPb[(size_t)dir * MT * 1024 + m * 1024 + h * 128 + dv]); const float re = fabsf(got - tot) / (fabsf(tot) + 0.05f);
            if (re > 0.05f) { atomicMin(DBG + 20, (unsigned)toff); atomicAdd(DBG + 21, 1u); } } }
    if (false && l == 1 && op == OP_RHG && bx < 32) { const int sid = bx * 512 + tid, m = dbg_row(sid), c = hash_u(sid * 3 + 9) % 1024, h0 = c & ~127; const bf16_t* OPb = (const bf16_t*)(ws + WS_Y);
        float s = 0.f; for (int k = 0; k < 128; ++k) { const float y = bf2f(OPb[(size_t)m * 1024 + h0 + k]) + bf2f(OPb[(size_t)MT * 1024 + (size_t)m * 1024 + h0 + k]); s += y * y; }
        const float yc = bf2f(OPb[(size_t)m * 1024 + c]) + bf2f(OPb[(size_t)MT * 1024 + (size_t)m * 1024 + c]);
        const float r = yc * rsqrtf(s / 128.f + EPS) * ap->in[13][c] * bf2f(((const bf16_t*)(R + R_GH))[(size_t)m * 1024 + c]);
        dbg_report(DBG, 9, bf2f(((const bf16_t*)(R + R_HO))[(size_t)m * 1024 + c]), r, 0.02f, 0.005f); }
    if (false && l == 1 && op == OP_HWO && bx < 32) { const int sid = bx * 512 + tid, m = dbg_row(sid), c = hash_u(sid * 3 + 10) % 1024;
        const float r = dbg_dot_bf_w((const bf16_t*)(R + R_HO) + (size_t)m * 1024, ap->in[14], 1024, 1024, c);
        dbg_report(DBG, 9, Y[(size_t)m * 1024 + c], r, 0.03f, 0.01f); }
    if (false && l == 0 && op == OP_MWO && bx < 32) { const int sid = bx * 512 + tid, m = dbg_row(sid), c = hash_u(sid * 3 + 11) % 1024;
        const float r = dbg_dot_bf_w((const bf16_t*)(R + R_O) + (size_t)m * 1024, ap->in[10], 1024, 1024, c);
        dbg_report(DBG, 6, Y[(size_t)m * 1024 + c], r, 0.02f, 0.0004f); }
}
#endif

__device__ __forceinline__ void gsync_cg() {
    asm volatile("s_waitcnt vmcnt(0) lgkmcnt(0)" ::: "memory");
    __syncthreads();
    cg::this_grid().sync();
    if (threadIdx.x == 0) { __builtin_amdgcn_fence(__ATOMIC_ACQUIRE, "agent"); asm volatile("s_waitcnt vmcnt(0)" ::: "memory"); }
    __syncthreads();
}
#define GAS __attribute__((address_space(1)))
#define XB_TMO      128
#define XB_XCNT(j)  (256  + 64 * (j))
#define XB_XSUB(j)  (1280 + 64 * (j))
#define XB_XGEN(j)  (2304 + 64 * (j))
#define XB_TOP      3328
#define XB_TOPGEN   3392
#define XCD_BAR_WORDS 3456
#define XB_SPIN_CAP (1u << 18)

__device__ __forceinline__ unsigned xb_ld(unsigned* p)              { return __hip_atomic_load(p, __ATOMIC_RELAXED, __HIP_MEMORY_SCOPE_AGENT); }
__device__ __forceinline__ unsigned xb_add(unsigned* p, unsigned v) { return __hip_atomic_fetch_add(p, v, __ATOMIC_RELAXED, __HIP_MEMORY_SCOPE_AGENT); }
__device__ __forceinline__ unsigned xb_xcc_id() { return (unsigned)__builtin_amdgcn_s_getreg((3 << 11) | 20) & 0xFu; }
#define XB_SPIN(cond, bar) do { unsigned _sp = 0; while (cond) { __builtin_amdgcn_s_sleep(1); \
    if ((++_sp & 255u) == 0u) { if (xb_ld(&(bar)[XB_TMO])) break; if (_sp > XB_SPIN_CAP) { atomicAdd(&(bar)[XB_TMO], 1u); break; } } } } while (0)

struct XcdBarrier {
    unsigned* bar; unsigned x;
    volatile LAS unsigned* st;
};

__device__ __forceinline__ XcdBarrier xcd_barrier_post(unsigned* bar, volatile LAS unsigned* st) {
    XcdBarrier b; b.bar = bar; b.x = xb_xcc_id(); b.st = st;
    if (threadIdx.x == 0) (void)xb_add(&bar[XB_XCNT(b.x)], 1u);
    return b;
}
__device__ __forceinline__ void xcd_barrier_complete(unsigned* bar, unsigned x, unsigned& nloc, unsigned& nx) {
    const unsigned G = gridDim.x * gridDim.y * gridDim.z;
    unsigned sum, cnt, mine, sp = 0u;
    for (;;) {
        sum = 0u; cnt = 0u; mine = 0u;
#pragma unroll
        for (unsigned j = 0; j < 16; ++j) { const unsigned c = xb_ld(&bar[XB_XCNT(j)]); sum += c; cnt += (c > 0u) ? 1u : 0u; mine = (j == x) ? c : mine; }
        if (sum == G) break;
        __builtin_amdgcn_s_sleep(1);
        if ((++sp & 255u) == 0u) { if (xb_ld(&bar[XB_TMO])) break; if (sp > XB_SPIN_CAP) { atomicAdd(&bar[XB_TMO], 1u); break; } }
    }
    nloc = mine > 0u ? mine : 1u; nx = cnt > 0u ? cnt : 1u;
}

__device__ __forceinline__ void xcd_barrier(const XcdBarrier& b) {
    asm volatile("s_waitcnt vmcnt(0)" ::: "memory");
    __syncthreads();
    if (threadIdx.x == 0) {
        unsigned* bar = b.bar;
        __builtin_amdgcn_s_waitcnt(0);
        unsigned nloc = b.st[0], nx = b.st[1];
        if (nloc == 0u) { xcd_barrier_complete(bar, b.x, nloc, nx); b.st[0] = nloc; b.st[1] = nx; }
        const unsigned old = xb_add(&bar[XB_XSUB(b.x)], 1u);
        const unsigned gen = old / nloc;
        if (old + 1u == (gen + 1u) * nloc) {
            __builtin_amdgcn_fence(__ATOMIC_RELEASE, "agent");
            asm volatile("s_waitcnt vmcnt(0)" ::: "memory");
            const unsigned og = xb_add(&bar[XB_TOP], 1u);
            const unsigned tg = og / nx;
            if (og + 1u == (tg + 1u) * nx) xb_add(&bar[XB_TOPGEN], 1u);
            else XB_SPIN(xb_ld(&bar[XB_TOPGEN]) == tg, bar);
            __builtin_amdgcn_fence(__ATOMIC_ACQUIRE, "agent");
            xb_add(&bar[XB_XGEN(b.x)], 1u);
            asm volatile("s_waitcnt vmcnt(0)" ::: "memory");
        } else {
            XB_SPIN(xb_ld(&bar[XB_XGEN(b.x)]) == gen, bar);
            __builtin_amdgcn_fence(__ATOMIC_ACQUIRE, "agent");
            asm volatile("s_waitcnt vmcnt(0)" ::: "memory");
        }
    }
    __syncthreads();
}

__device__ __forceinline__ void gsync(LAS unsigned char* lds) {
#ifdef USE_CG_SYNC
    gsync_cg();
#else
    XcdBarrier b; b.bar = (unsigned*)get_args()->ws; b.x = xb_xcc_id(); b.st = (volatile LAS unsigned*)(lds + LDS_RING);
    xcd_barrier(b);
#endif
}
__global__ void __launch_bounds__(512, 2) mega_fwd(Args a_unused) {
    extern __shared__ __attribute__((aligned(16))) unsigned char lds_raw[];
    LAS unsigned char* lds = (LAS unsigned char*)lds_raw;

    if (threadIdx.x < 2) ((volatile LAS unsigned*)(lds + LDS_RING))[threadIdx.x] = 0u;
    __syncthreads();
    (void)xcd_barrier_post((unsigned*)get_args()->ws, (volatile LAS unsigned*)(lds + LDS_RING));
#ifdef REP_PRO
    for (int rep_ = 0; rep_ < 2; ++rep_)
#endif
    {
        ArgsP ap = get_args(); unsigned char* ws = ap->ws;
#ifdef DBG_CHECKS
        if (blockIdx.x == 0 && threadIdx.x < 32) atomicExch((unsigned*)ws + threadIdx.x, 0u);
#endif
        const int tid = threadIdx.x, lane = tid & 63, wave = __builtin_amdgcn_readfirstlane(tid >> 6), G = gridDim.x, bx = blockIdx.x, gw = bx * 8 + wave, NGW = G * 8;
        LAS float* scr = (LAS float*)(lds + wave * 16384);
        constexpr int I_FFI = 16 * 176, I_FFO = 44 * 32, I_HIN = 16 * 160, I_SQ = 16 * 32, I_MIN = 16 * 16, I_UQ = 4 * 48, I_UKV = 2 * 64;
        constexpr int NITEMS = 8 * I_FFI + 8 * I_FFO + 2 * I_HIN + 2 * I_SQ + 2 * I_MIN + 2 * I_UQ + 2 * I_UKV + 2 * I_SQ;
        for (int it = gw; it < NITEMS; it += NGW) {
            int r = it;
#define XP(IDX_, K_, NS_, ND_, MODE_, WSOFF_, NMAT_, IPM_) if (r < (NMAT_) * (IPM_)) { const int mat = r / (IPM_); \
            xpose_item(ap->in[IDX_] + (size_t)mat * (K_) * (NS_), K_, NS_, ND_, MODE_, (bf16_t*)(ws + (WSOFF_)) + (size_t)mat * (ND_) * (K_), scr, r % (IPM_), lane); continue; } r -= (NMAT_) * (IPM_);
            XP(3, 1024, 2 * DFF, 2 * DFF, 1, WS_WFFI, 8, I_FFI)
            XP(4, DFF, 1024, 1024, 0, WS_WFFO, 8, I_FFO)
            XP(11, 1024, 5120, 5120, 0, WS_WHIN, 2, I_HIN)
            XP(14, 1024, 1024, 1024, 0, WS_WHO, 2, I_SQ)
            XP(5, 1024, 448, 512, 2, WS_WMIN, 2, I_MIN)
            XP(8, 256, 1536, 1536, 3, WS_WUQ, 2, I_UQ)
            XP(9, 128, 2048, 2048, 0, WS_WUKV, 2, I_UKV)
            XP(10, 1024, 1024, 1024, 0, WS_WMO, 2, I_SQ)
#undef XP
        }
        { const int* positions = (const int*)ap->in[1]; float* COS = (float*)(ws + WS_COS); float* SIN = (float*)(ws + WS_SIN);
          for (int idx = bx * 512 + tid; idx < MT * 32; idx += G * 512) { const int m = idx >> 5, i = idx & 31;
            const double ang = (double)positions[m] * ROPE_INVF[i]; const double rev = ang * 0.15915494309189535; const float fr = (float)(rev - __builtin_rint(rev));
            COS[idx] = __builtin_amdgcn_cosf(fr); SIN[idx] = __builtin_amdgcn_sinf(fr); } }
        { float* LB = (float*)(ws + WS_LB);
          for (int idx = bx * 512 + tid; idx < 2 * 2 * 1024; idx += G * 512) { const int c = idx & 1023, dir = (idx >> 10) & 1, j = idx >> 11, l = 2 * j + 1;
            const float* lbp = ap->in[12] + (size_t)dir * DEPTH * 1024 + c; float v[4], mx = -1e30f;
#pragma unroll
            for (int i = 0; i < 4; ++i) { v[i] = lbp[i * 1024]; mx = fmaxf(mx, v[i]); }
            float den = 0.f, num = 0.f;
#pragma unroll
            for (int i = 0; i < 4; ++i) { const float e = __expf(v[i] - mx); den += e; if (i >= 1 && i <= l) num += e; }
            LB[idx] = num / den; } }
        { const float* x_in = ap->in[0]; unsigned short* X = (unsigned short*)(ws + WS_X16); bf16_t* HN = (bf16_t*)ap->out; const float* gains = ap->in[2];
          for (int m = gw; m < MT; m += NGW) row_init(x_in + (size_t)m * DM, X + (size_t)m * DM, HN + (size_t)m * DM, gains, lane); }
    }
    gsync_cg();

    for (int ph = 0; ph < 46; ++ph) {
        const int l = ph >= 35 ? 3 : (ph >= 23 ? 2 : (ph >= 12 ? 1 : 0)), s = ph - (l == 3 ? 35 : (l == 2 ? 23 : (l == 1 ? 12 : 0)));
        const bool hg = l & 1; const int j = l >> 1;
        const int op = hg ? OPS_H[s] : OPS_M[s];
        ArgsP ap = get_args(); unsigned char* ws = ap->ws; unsigned char* R = ws + WS_R;
        int G_ = gridDim.x, bx_ = blockIdx.x; asm volatile("" : "+s"(G_), "+s"(bx_));
        switch (op) {
        case OP_SW0: case OP_SW1: {
            const int half = op == OP_SW1;
            pg8::Gemm gm{(const bf16_t*)ap->out, (const bf16_t*)(ws + WS_WFFI) + (size_t)(l * 2 + half) * (2 * DFF) * 1024, MT, 2 * DFF, 1024};
            pg8::StaticOrder S; S.init(MT, 2 * DFF, G_, bx_); EpiSwiglu E{(bf16_t*)(R + R_ACT)};
#ifndef NO_SW
            pg8::gemm_phase<EpiSwiglu, pg8::StaticOrder, true, true>(lds, gm, S, E);
#endif
        } break;
        case OP_MIN: {
            pg8::Gemm gm{(const bf16_t*)ap->out, (const bf16_t*)(ws + WS_WMIN) + (size_t)j * 512 * 1024, MT, 512, 1024}; EpiF32 E{(float*)(R + R_C), 512};
            pg8::StaticOrder S; S.init(MT, 512, G_, bx_);
#ifndef NO_F32
            pg8::gemm_phase<EpiF32, pg8::StaticOrder, true, true>(lds, gm, S, E);
#endif
        } break;
        case OP_FO0: case OP_FO1: case OP_MWO: case OP_HWO: {
            pg8::Gemm gm; EpiB16 E{(bf16_t*)(ws + WS_YB), 1024};
            if (op == OP_FO0 || op == OP_FO1) { const int half = op == OP_FO1; gm = pg8::Gemm{(const bf16_t*)(R + R_ACT), (const bf16_t*)(ws + WS_WFFO) + (size_t)(l * 2 + half) * 1024 * DFF, MT, 1024, DFF}; }
            else if (op == OP_MWO) { gm = pg8::Gemm{(const bf16_t*)(R + R_O), (const bf16_t*)(ws + WS_WMO) + (size_t)j * 1024 * 1024, MT, 1024, 1024}; }
            else { gm = pg8::Gemm{(const bf16_t*)(R + R_HO), (const bf16_t*)(ws + WS_WHO) + (size_t)j * 1024 * 1024, MT, 1024, 1024}; }
            pg8::StaticOrder S; S.init(MT, 1024, G_, bx_);
            pg8::gemm_phase<EpiB16, pg8::StaticOrder, true, true>(lds, gm, S, E);
        } break;
        case OP_RPA: case OP_RPB: case OP_RPC: {
            const float* gains = ap->in[2]; const float* g = gains + (size_t)l * 6 * DM; const bf16_t* Y = (const bf16_t*)(ws + WS_YB); unsigned short* X = (unsigned short*)(ws + WS_X16); bf16_t* HN = (bf16_t*)ap->out; float* XO = ap->out;
            const int k = op == OP_RPA ? 1 : (op == OP_RPB ? 3 : 5); const float scale = op == OP_RPB ? 1.0f : 0.5f;
            const bool last = (op == OP_RPC) && (l == DEPTH - 1);
            const float* gn = op == OP_RPC ? gains + (size_t)(l + 1) * 6 * DM : g + (size_t)(k + 1) * DM;
            const int lane = LANE_;
            for (int m = bx_ * 8 + __builtin_amdgcn_readfirstlane(otid_() >> 6); m < MT; m += G_ * 8) row_post(Y + (size_t)m * DM, X + (size_t)m * DM, last ? XO + (size_t)m * DM : (float*)nullptr, last ? (bf16_t*)nullptr : HN + (size_t)m * DM, scale, g + (size_t)k * DM, last ? g : gn, lane);
        } break;
        case OP_RMLA: {
            const float* qn = ap->in[6] + (size_t)j * QLR; const float* kvn = ap->in[7] + (size_t)j * KVLR; const float* COS = (const float*)(ws + WS_COS); const float* SIN = (const float*)(ws + WS_SIN);
            const int lane = LANE_;
            for (int m = bx_ * 8 + __builtin_amdgcn_readfirstlane(otid_() >> 6); m < MT; m += G_ * 8) row_mla((const float*)(R + R_C) + (size_t)m * 512, (bf16_t*)(R + R_CQ) + (size_t)m * 256, (bf16_t*)(R + R_CKV) + (size_t)m * 128, (bf16_t*)(R + R_KR) + (size_t)m * 64,
                                                         qn, kvn, COS + (size_t)m * 32, SIN + (size_t)m * 32, lane);
        } break;
        case OP_QKV: {
            { int Kq = 256; asm volatile("" : "+s"(Kq)); pg8::Gemm gm{(const bf16_t*)(R + R_CQ), (const bf16_t*)(ws + WS_WUQ) + (size_t)j * 1536 * 256, MT, 1536, Kq};
              pg8::StaticOrder S; S.init(MT, 1536, G_, bx_); EpiQ E{(bf16_t*)(R + R_QB), (const float*)(ws + WS_COS), (const float*)(ws + WS_SIN)};
#ifndef NO_Q
              pg8::gemm_phase<EpiQ, pg8::StaticOrder, true, true>(lds, gm, S, E);
#endif
            }
            __syncthreads();
            { int Kq = 128; asm volatile("" : "+s"(Kq)); pg8::Gemm gm{(const bf16_t*)(R + R_CKV), (const bf16_t*)(ws + WS_WUKV) + (size_t)j * 2048 * 128, MT, 2048, Kq};
              pg8::StaticOrder S; S.init(MT, 2048, G_, bx_); EpiKV E{(bf16_t*)(R + R_KN), (bf16_t*)(R + R_VB)};
#ifndef NO_KV
              pg8::gemm_phase<EpiKV, pg8::StaticOrder, true, true>(lds, gm, S, E);
#endif
            }
        } break;
        case OP_ATTN: {
#ifndef NO_ATTN
            const int G = G_, bx = bx_;

            const int vcu = (G % 8 == 0) ? (bx % 8) * (G / 8) + bx / 8 : bx;
#ifdef REP_ATTN
            for (int rep_ = 0; rep_ < 2; ++rep_)
#endif
            for (int uid = vcu; uid < BATCH * NH * (SEQ / 256); uid += G) {
                const int bh = uid >> 5, qb = uid & 31, b = bh >> 3, h = bh & 7;
                const size_t row0 = (size_t)b * SEQ;
                att::attn_unit((const att::bf16*)(R + R_QB) + (row0 + qb * 256) * 1536 + h * QKD, (const att::bf16*)(R + R_KN) + row0 * 1024 + h * 128,
                               (const att::bf16*)(R + R_KR) + row0 * 64, (const att::bf16*)(R + R_VB) + row0 * 1024 + h * 128,
                               (att::bf16*)(R + R_O) + (row0 + qb * 256) * 1024 + h * 128, SEQ, (char*)lds_raw);
            }
#endif
        } break;
        case OP_HIN: {
            pg8::Gemm gm{(const bf16_t*)ap->out, (const bf16_t*)(ws + WS_WHIN) + (size_t)j * 5120 * 1024, MT, 5120, 1024};
            pg8::StaticOrder S; S.init(MT, 5120, G_, bx_);
            EpiHgrn E{(bf16_t*)(R + R_QH), (bf16_t*)(R + R_VH), (bf16_t*)(R + R_GH), (unsigned short*)(R + R_KF), (const float*)(ws + WS_LB) + (size_t)j * 2048};
#ifndef NO_HG
            pg8::gemm_phase<EpiHgrn, pg8::StaticOrder, true, true>(lds, gm, S, E);
#endif
        } break;
        case OP_SCAN: {
#ifndef NO_SCAN
#ifdef REP_SCAN
            scan_phase(lds, (const bf16_t*)(R + R_QH), (const bf16_t*)(R + R_VH), (const unsigned short*)(R + R_KF), (bf16_t*)(ws + WS_Y), G_, bx_); __syncthreads();
#endif
#ifdef SCAN_VALU
            scan_phase(lds, (const bf16_t*)(R + R_QH), (const bf16_t*)(R + R_VH), (const unsigned short*)(R + R_KF), (bf16_t*)(ws + WS_Y), G_, bx_);
#else
            scan_phase_mfma(lds, (const bf16_t*)(R + R_QH), (const bf16_t*)(R + R_VH), (const unsigned short*)(R + R_KF), (bf16_t*)(ws + WS_Y), G_, bx_);
#endif
#endif
        } break;
        case OP_RHG: {
            const float* on = ap->in[13] + (size_t)j * DM; const bf16_t* Y = (const bf16_t*)(ws + WS_Y);
            const int lane = LANE_;
            for (int m = bx_ * 8 + __builtin_amdgcn_readfirstlane(otid_() >> 6); m < MT; m += G_ * 8) row_hgrn(Y + (size_t)m * DM, (const bf16_t*)(R + R_GH) + (size_t)m * DM, (bf16_t*)(R + R_HO) + (size_t)m * DM, on, lane);
        } break;
        default: break;
        }
        if (ph != 45) gsync(lds);
#ifdef REP_SYNC
        gsync(lds);
#endif
#ifdef DBG_CHECKS
        { ArgsP ap2 = get_args(); dbg_after(l, op, ap2, ap2->ws, ap2->ws + WS_R, lds); gsync(lds); }
#endif
    }
#ifdef DBG_CHECKS
    gsync(lds);
    if (blockIdx.x == 0 && threadIdx.x == 0) { ArgsP ap = get_args(); unsigned* DBG = (unsigned*)ap->ws; const float mx = __uint_as_float(atomicAdd(DBG + 20, 0u)), mean = atomicAdd((float*)(DBG + 21), 0.f); ap->out[1024 * 16] += 1e6f * mx; ap->out[1024 * 16 + 1] += 1e4f * mean; }
#endif
}

extern "C" void kernel_launch(void* const* d_in, const int* in_sizes, int n_in, void* d_out, int out_size, void* d_ws, size_t ws_size, hipStream_t stream) {
    static int grid = 0;
    if (grid == 0) {
        if (n_in != 15 || out_size != MT * DM || ws_size < WS_END) { fprintf(stderr, "kernel_launch: unexpected shapes: n_in %d out %d ws %zu (need %zu)\n", n_in, out_size, ws_size, (size_t)WS_END); grid = -1; return; }
        int dev = 0, cus = 0, per_cu = 0;
        (void)hipGetDevice(&dev); (void)hipDeviceGetAttribute(&cus, hipDeviceAttributeMultiprocessorCount, dev);
        if (hipFuncSetAttribute((const void*)mega_fwd, hipFuncAttributeMaxDynamicSharedMemorySize, LDS_BYTES) != hipSuccess) { fprintf(stderr, "kernel_launch: hipFuncSetAttribute failed\n"); grid = -1; return; }
        if (hipOccupancyMaxActiveBlocksPerMultiprocessor(&per_cu, (const void*)mega_fwd, 512, LDS_BYTES) != hipSuccess || per_cu < 1) { fprintf(stderr, "kernel_launch: occupancy query gave %d\n", per_cu); per_cu = 1; }
        (void)hipGetLastError();
        grid = cus * 1;
        fprintf(stderr, "kernel_launch: cus %d per_cu %d grid %d\n", cus, per_cu, grid);
    }
    if (grid < 0) return;
    if (hipMemsetAsync(d_ws, 0, 65536, stream) != hipSuccess) { fprintf(stderr, "kernel_launch: memset failed\n"); return; }
    Args a{};
    for (int i = 0; i < 15; ++i) a.in[i] = (const float*)d_in[i];
    a.out = (float*)d_out; a.ws = (unsigned char*)d_ws;
    void* args[] = {&a};
    hipError_t e = hipLaunchCooperativeKernel((const void*)mega_fwd, dim3(grid), dim3(512), args, LDS_BYTES, stream);
    if (e != hipSuccess) fprintf(stderr, "cooperative launch failed: %s (grid %d)\n", hipGetErrorString(e), grid);
}
```
